# Optimizing an MI355X kernel written in HIP

```python
import jax
import jax.numpy as jnp
from jax import lax
import numpy as np

D_MODEL = 1024
BATCH = 2
SEQ = 8192
DEPTH = 2
DEC_BATCH = 128
DEC_SEQ = 4
PAST_LEN = 8192
PAGE_SIZE = 128

N_A_LAYERS = DEPTH // 2
N_B_LAYERS = DEPTH - N_A_LAYERS
D_FF = ((8 * D_MODEL // 3 + 127) // 128) * 128
CONV_W = 3
N_HEADS = D_MODEL // 128
NOPE_DIM = 128
ROPE_DIM = 64
V_DIM = 128
Q_RANK = D_MODEL // 2
KV_RANK = D_MODEL // 4
Q_BLOCK = 128
ROPE_THETA = 10000.0
EPS = 1e-6
SCALE = (NOPE_DIM + ROPE_DIM) ** -0.5
NEG = -1e30

kernel_name = 'hybrid_shortconv_mla_yoco_step'


def rmsnorm(x, g):
    xf = x.astype(jnp.float32)
    y = xf * lax.rsqrt(jnp.mean(xf * xf, axis=-1, keepdims=True) + EPS)
    return (y * g.astype(jnp.float32)).astype(x.dtype)


def swiglu(x, w_gu, w_down):
    gate, up = jnp.split(x @ w_gu, 2, axis=-1)
    return (jax.nn.silu(gate) * up) @ w_down


def rope(x, pos):
    half = x.shape[-1] // 2
    freqs = ROPE_THETA ** (-jnp.arange(half, dtype=jnp.float32) / half)
    ang = pos.astype(jnp.float32)[:, None] * freqs
    bshape = (pos.shape[0],) + (1,) * (x.ndim - 3) + (half,)
    cos = jnp.cos(ang).reshape(bshape)
    sin = jnp.sin(ang).reshape(bshape)
    xf = x.astype(jnp.float32)
    x1, x2 = xf[..., :half], xf[..., half:]
    return jnp.concatenate([x1 * cos - x2 * sin, x2 * cos + x1 * sin], axis=-1).astype(x.dtype)


def short_conv_mixer(xn, prev, w_in, w_conv, w_out):
    b, c, h = jnp.split(xn @ w_in, 3, axis=-1)
    u = c * h
    ext = jnp.concatenate([prev.astype(u.dtype), u], axis=1)
    s = u.shape[1]
    y = w_conv[0] * ext[:, 0:s]
    for j in range(1, CONV_W):
        y = y + w_conv[j] * ext[:, j:j + s]
    return (b * y) @ w_out, ext[:, s:]


def shared_kv(h, pos, norm_kv_in, w_dkv, kv_norm, k_pe_norm):
    ckv = rmsnorm(h, norm_kv_in) @ w_dkv
    lat = rmsnorm(ckv[..., :KV_RANK], kv_norm)
    kpe = rope(rmsnorm(ckv[..., KV_RANK:], k_pe_norm), pos)
    return lat, kpe


def expand_kv(lat, w_uk, w_uv, k_nope_norm):
    lead = lat.shape[:-1]
    kn = rmsnorm((lat @ w_uk).reshape(lead + (N_HEADS, NOPE_DIM)), k_nope_norm)
    v = (lat @ w_uv).reshape(lead + (N_HEADS, V_DIM))
    return kn, v


def mla_queries(xn, pos, w_dq, q_norm, w_uq, q_nope_norm, q_pe_norm):
    cq = rmsnorm(xn @ w_dq, q_norm)
    q = (cq @ w_uq).reshape(xn.shape[:-1] + (N_HEADS, NOPE_DIM + ROPE_DIM))
    qn = rmsnorm(q[..., :NOPE_DIM], q_nope_norm)
    qp = rope(rmsnorm(q[..., NOPE_DIM:], q_pe_norm), pos)
    return qn, qp


def attend(qn, qp, kn, kp, v, q_pos, k_pos):
    s = (jnp.einsum('bqhd,bkhd->bhqk', qn, kn)
         + jnp.einsum('bqhr,bkr->bhqk', qp, kp)).astype(jnp.float32) * SCALE
    s = jnp.where(q_pos[:, None] >= k_pos[None, :], s, NEG)
    p = jax.nn.softmax(s, axis=-1).astype(v.dtype)
    return jnp.einsum('bhqk,bkhd->bqhd', p, v)


def forward(x, pos, conv_prev, attn_core, p):
    conv_states = []
    lat = None
    kpe = None
    for l in range(DEPTH):
        x = x + 0.5 * swiglu(rmsnorm(x, p['norm_ffn1'][l]), p['w_ffn1_gu'][l], p['w_ffn1_down'][l])
        xn = rmsnorm(x, p['norm_mix'][l])
        if l < N_A_LAYERS:
            mix, st = short_conv_mixer(xn, conv_prev[l], p['w_conv_in'][l], p['conv_w'][l], p['w_conv_out'][l])
            conv_states.append(st)
        else:
            j = l - N_A_LAYERS
            qn, qp = mla_queries(xn, pos, p['w_dq'][j], p['q_norm'][j], p['w_uq'][j],
                                 p['q_nope_norm'][j], p['q_pe_norm'][j])
            o = attn_core(qn, qp, lat, kpe)
            mix = o.reshape(o.shape[:2] + (N_HEADS * V_DIM,)) @ p['w_o'][j]
        x = x + mix
        x = x + 0.5 * swiglu(rmsnorm(x, p['norm_ffn2'][l]), p['w_ffn2_gu'][l], p['w_ffn2_down'][l])
        if l == N_A_LAYERS - 1:
            lat, kpe = shared_kv(x, pos, p['norm_kv_in'], p['w_dkv'], p['kv_norm'], p['k_pe_norm'])
    return x, jnp.stack(conv_states), lat, kpe


def setup_inputs(seed: int = 0) -> dict:
    key = jax.random.key(seed)
    ks = list(jax.random.split(key, 40))
    f32 = jnp.float32

    def w(shape, fan_in):
        return jax.random.normal(ks.pop(), shape, f32) * (fan_in ** -0.5)

    def g(shape):
        return 1.0 + 0.1 * jax.random.normal(ks.pop(), shape, f32)

    n_pages = PAST_LEN // PAGE_SIZE
    n_phys = (DEC_BATCH * n_pages * 5) // 4
    perm = jax.random.permutation(ks.pop(), n_phys)
    page_table = perm[:DEC_BATCH * n_pages].reshape(DEC_BATCH, n_pages).astype(jnp.int32)
    return {
        'x_prompt': jax.random.normal(ks.pop(), (BATCH, SEQ, D_MODEL), f32),
        'x_sample': jax.random.normal(ks.pop(), (DEC_BATCH, DEC_SEQ, D_MODEL), f32),
        'cache_latent': jax.random.normal(ks.pop(), (n_phys, PAGE_SIZE, KV_RANK), f32),
        'cache_kpe': jax.random.normal(ks.pop(), (n_phys, PAGE_SIZE, ROPE_DIM), f32),
        'state_conv': jax.random.normal(ks.pop(), (N_A_LAYERS, DEC_BATCH, CONV_W - 1, D_MODEL), f32),
        'page_table': page_table,
        'norm_ffn1': g((DEPTH, D_MODEL)),
        'w_ffn1_gu': w((DEPTH, D_MODEL, 2 * D_FF), D_MODEL),
        'w_ffn1_down': w((DEPTH, D_FF, D_MODEL), D_FF),
        'norm_mix': g((DEPTH, D_MODEL)),
        'norm_ffn2': g((DEPTH, D_MODEL)),
        'w_ffn2_gu': w((DEPTH, D_MODEL, 2 * D_FF), D_MODEL),
        'w_ffn2_down': w((DEPTH, D_FF, D_MODEL), D_FF),
        'w_conv_in': w((N_A_LAYERS, D_MODEL, 3 * D_MODEL), D_MODEL),
        'conv_w': w((N_A_LAYERS, CONV_W, D_MODEL), CONV_W),
        'w_conv_out': w((N_A_LAYERS, D_MODEL, D_MODEL), D_MODEL),
        'w_dq': w((N_B_LAYERS, D_MODEL, Q_RANK), D_MODEL),
        'q_norm': g((N_B_LAYERS, Q_RANK)),
        'w_uq': w((N_B_LAYERS, Q_RANK, N_HEADS * (NOPE_DIM + ROPE_DIM)), Q_RANK),
        'q_nope_norm': g((N_B_LAYERS, NOPE_DIM)),
        'q_pe_norm': g((N_B_LAYERS, ROPE_DIM)),
        'w_o': w((N_B_LAYERS, N_HEADS * V_DIM, D_MODEL), N_HEADS * V_DIM),
        'norm_kv_in': g((D_MODEL,)),
        'w_dkv': w((D_MODEL, KV_RANK + ROPE_DIM), D_MODEL),
        'kv_norm': g((KV_RANK,)),
        'k_pe_norm': g((ROPE_DIM,)),
        'w_uk': w((KV_RANK, N_HEADS * NOPE_DIM), KV_RANK),
        'w_uv': w((KV_RANK, N_HEADS * V_DIM), KV_RANK),
        'k_nope_norm': g((NOPE_DIM,)),
    }


def reference(x_prompt, x_sample, cache_latent, cache_kpe, state_conv, page_table,
              norm_ffn1, w_ffn1_gu, w_ffn1_down, norm_mix, norm_ffn2, w_ffn2_gu, w_ffn2_down,
              w_conv_in, conv_w, w_conv_out,
              w_dq, q_norm, w_uq, q_nope_norm, q_pe_norm, w_o,
              norm_kv_in, w_dkv, kv_norm, k_pe_norm, w_uk, w_uv, k_nope_norm):
    p = dict(norm_ffn1=norm_ffn1, w_ffn1_gu=w_ffn1_gu, w_ffn1_down=w_ffn1_down,
             norm_mix=norm_mix, norm_ffn2=norm_ffn2, w_ffn2_gu=w_ffn2_gu, w_ffn2_down=w_ffn2_down,
             w_conv_in=w_conv_in, conv_w=conv_w, w_conv_out=w_conv_out,
             w_dq=w_dq, q_norm=q_norm, w_uq=w_uq, q_nope_norm=q_nope_norm, q_pe_norm=q_pe_norm,
             w_o=w_o, norm_kv_in=norm_kv_in, w_dkv=w_dkv, kv_norm=kv_norm, k_pe_norm=k_pe_norm)

    def prompt_attn(qn, qp, lat, kpe):
        kn, v = expand_kv(lat, w_uk, w_uv, k_nope_norm)
        s_len = qn.shape[1]
        pos = jnp.arange(s_len)
        outs = []
        for i in range(s_len // Q_BLOCK):
            lo, hi = i * Q_BLOCK, (i + 1) * Q_BLOCK
            outs.append(attend(qn[:, lo:hi], qp[:, lo:hi], kn[:, :hi], kpe[:, :hi], v[:, :hi],
                               pos[lo:hi], pos[:hi]))
        return jnp.concatenate(outs, axis=1)

    def sample_attn(qn, qp, lat_new, kpe_new):
        s_new = qn.shape[1]
        n_past = page_table.shape[1] * PAGE_SIZE
        q_pos = n_past + jnp.arange(s_new)
        k_pos = jnp.arange(n_past + s_new)

        def one_seq(args):
            qn_b, qp_b, pt_b, lat_b, kpe_b = args
            lat_all = jnp.concatenate([cache_latent[pt_b].reshape(n_past, KV_RANK), lat_b], axis=0)
            kpe_all = jnp.concatenate([cache_kpe[pt_b].reshape(n_past, ROPE_DIM), kpe_b], axis=0)
            kn, v = expand_kv(lat_all, w_uk, w_uv, k_nope_norm)
            return attend(qn_b[None], qp_b[None], kn[None], kpe_all[None], v[None], q_pos, k_pos)[0]

        return lax.map(one_seq, (qn, qp, page_table, lat_new, kpe_new))

    pos_prompt = jnp.arange(x_prompt.shape[1])
    pos_sample = page_table.shape[1] * PAGE_SIZE + jnp.arange(x_sample.shape[1])
    conv_zero = jnp.zeros((N_A_LAYERS, x_prompt.shape[0], CONV_W - 1, D_MODEL), x_prompt.dtype)

    y_prompt, conv_p, lat_p, kpe_p = forward(x_prompt, pos_prompt, conv_zero, prompt_attn, p)
    y_sample, conv_s, lat_s, kpe_s = forward(x_sample, pos_sample, state_conv, sample_attn, p)
    return (y_prompt, y_sample, conv_p, conv_s, lat_p, kpe_p, lat_s, kpe_s)
```

```cpp
#include <hip/hip_runtime.h>
#include <cstdio>
#include <cstdint>
namespace pg8 {
#define PG8_LAS __attribute__((address_space(3)))
typedef unsigned short bf16_t;
typedef short bf16x8 __attribute__((ext_vector_type(8)));
typedef float f32x4 __attribute__((ext_vector_type(4)));
typedef unsigned u32x4 __attribute__((ext_vector_type(4)));
constexpr int BM = 256, BK = 64, HALF = 128, HTB = HALF * BK * 2  , STAGE_BYTES = 8 * HTB, NXCD = 8, WGM = 8;

__host__ __device__ __forceinline__ int lds_byte(int r, int c) { const int st = (r >> 4) * 2 + (c >> 5), rr = r & 15, cc = c & 31, ob = rr * 64 + cc * 2; return st * 1024 + (ob ^ (((ob >> 9) & 1) << 5)); }
__host__ __device__ __forceinline__ void stage_rc(int b, int& R, int& C) { const int st = b / 1024, sb = b % 1024, swz = sb ^ (((sb >> 9) & 1) << 5); R = (st >> 1) * 16 + swz / 64; C = (st & 1) * 32 + (swz % 64) / 2; }
__host__ __device__ __forceinline__ int perm32(int rho) { const int n = rho >> 4, i = rho & 15; return 8 * (i >> 2) + 4 * n + (i & 3); }

struct Unit { int pm, pn; };
struct Gemm { const bf16_t* A; const bf16_t* Bt; int M, N, K; };

struct StaticOrder {
    int nM, nN, nwg, G, c;
    __host__ __device__ void init(int M, int N, int G_, int c_) { nM = M / BM; nN = N / BM; nwg = nM * nN; G = G_; c = c_; }
    __host__ __device__ bool next(int i, Unit& u) const {
        const long L = (long)i * G + c; if (L >= nwg) return false;
        int wgid = (int)L; { const int q = nwg / NXCD, r = nwg % NXCD, xcd = wgid % NXCD, off = wgid / NXCD; wgid = (xcd < r ? xcd * (q + 1) : r * (q + 1) + (xcd - r) * q) + off; }
        const int nig = WGM * nN, gid = wgid / nig, fm = gid * WGM, gsz = (nM - fm) < WGM ? (nM - fm) : WGM;
        u.pm = fm + ((wgid % nig) % gsz); u.pn = (wgid % nig) / gsz; return true;
    }
    __device__ __forceinline__ void a_ready(const Unit&) const {}
    __device__ __forceinline__ void done(const Unit&) const {}
};

__device__ __forceinline__ unsigned cvt_pk_bf16(float lo, float hi) { unsigned r; asm volatile("v_cvt_pk_bf16_f32 %0, %1, %2" : "=v"(r) : "v"(lo), "v"(hi)); return r; }
typedef float f32x2 __attribute__((ext_vector_type(2)));
template <class Epi, class Sched, bool ALIGN_EPI = false, bool SP2 = false>
__device__ __forceinline__ void gemm_phase(PG8_LAS unsigned char* lds, const Gemm g, const Sched& S, const Epi& E) {
    const int tid = threadIdx.x, wid = __builtin_amdgcn_readfirstlane(tid >> 6), lane = tid & 63, wr = wid >> 2, wc = wid & 3, fr = lane & 15, fq = lane >> 4;
    const int K = g.K, nt = K / BK;
    unsigned voffA[2], voffB[2];
#pragma unroll
    for (int i = 0; i < 2; ++i) { int R, C; stage_rc(tid * 16 + i * 8192, R, C); const int Rb = Epi::PERM ? ((R & ~31) + perm32(R & 31)) : R;
        voffA[i] = (unsigned)(R * K + C) * 2u; voffB[i] = (unsigned)(Rb * K + C) * 2u; }
    const size_t kstep = (size_t)(BK * 2);
    const size_t hstep = (size_t)HALF * K * 2;
    const size_t tstep = 2 * hstep;
    const unsigned ldsw = (unsigned)wid * 1024u;
    const int aoff = lds_byte(wr * 64 + fr, fq * 8), boff = lds_byte(wc * 32 + fr, fq * 8);
#define PG8_SA(b, h) (((b) * 2 + (h)) * HTB)
#define PG8_SB(b, h) ((4 + (b) * 2 + (h)) * HTB)
#define PG8_STAGE(bufoff, gbase, voff) do { _Pragma("unroll") for (int _i = 0; _i < 2; ++_i) \
        __builtin_amdgcn_global_load_lds((const unsigned*)((const char*)(gbase) + (voff)[_i]), (PG8_LAS unsigned*)(lds + (bufoff) + ldsw + _i * 8192), 16, 0, 0); } while (0)
#define PG8_LDA(dst, b, h) do { _Pragma("unroll") for (int m = 0; m < 4; ++m) _Pragma("unroll") for (int k = 0; k < 2; ++k) dst[m][k] = *(const PG8_LAS bf16x8*)(lds + PG8_SA(b, h) + aoff + m * 2048 + k * 1024); } while (0)
#define PG8_LDB(dst, b, h) do { _Pragma("unroll") for (int n = 0; n < 2; ++n) _Pragma("unroll") for (int k = 0; k < 2; ++k) dst[n][k] = *(const PG8_LAS bf16x8*)(lds + PG8_SB(b, h) + boff + n * 2048 + k * 1024); } while (0)
#define PG8_MMA(ai, bj, At, Bt) do { __builtin_amdgcn_s_setprio(1); _Pragma("unroll") for (int m = 0; m < 4; ++m) _Pragma("unroll") for (int n = 0; n < 2; ++n) _Pragma("unroll") for (int k = 0; k < 2; ++k) \
        acc[ai][bj][m][n] = __builtin_amdgcn_mfma_f32_16x16x32_bf16(Bt[n][k], At[m][k], acc[ai][bj][m][n], 0, 0, 0); __builtin_amdgcn_s_setprio(0); } while (0)
#define PG8_WAIT_V(n) asm volatile("s_waitcnt vmcnt(" #n ")" ::: "memory")
#define PG8_WAIT_L(n) asm volatile("s_waitcnt lgkmcnt(" #n ")" ::: "memory")
#define PG8_BAR __builtin_amdgcn_s_barrier()
#define PG8_SCHED __builtin_amdgcn_sched_barrier(0)
    Unit cur, nxt; int ui = 0;
    if (!S.next(0, cur)) return;
    f32x4 acc[2][2][4][2];
#pragma unroll
    for (int a = 0; a < 2; ++a)
#pragma unroll
        for (int b = 0; b < 2; ++b)
#pragma unroll
            for (int m = 0; m < 4; ++m)
#pragma unroll
                for (int n = 0; n < 2; ++n) acc[a][b][m][n] = (f32x4){0.f, 0.f, 0.f, 0.f};
    bf16x8 At[4][2], B0[2][2], B1[2][2];
    const char* cA = (const char*)g.A + (size_t)cur.pm * tstep; const char* cB = (const char*)g.Bt + (size_t)cur.pn * tstep;
    S.a_ready(cur);
    if constexpr (SP2) {
        PG8_STAGE(PG8_SB(0, 0), cB, voffB); PG8_STAGE(PG8_SB(0, 1), cB + hstep, voffB); PG8_STAGE(PG8_SA(0, 0), cA, voffA); PG8_STAGE(PG8_SA(0, 1), cA + hstep, voffA);
        if (wr == 1) PG8_BAR;
        PG8_WAIT_V(2); PG8_BAR;
        PG8_STAGE(PG8_SB(1, 0), cB + kstep, voffB); PG8_STAGE(PG8_SA(1, 0), cA + kstep, voffA); PG8_STAGE(PG8_SB(1, 1), cB + hstep + kstep, voffB);
        PG8_WAIT_V(6); PG8_BAR;
    } else {
        PG8_STAGE(PG8_SB(0, 0), cB, voffB); PG8_STAGE(PG8_SA(0, 0), cA, voffA); PG8_STAGE(PG8_SB(0, 1), cB + hstep, voffB); PG8_STAGE(PG8_SA(0, 1), cA + hstep, voffA);
        if (wr == 1) PG8_BAR;
        PG8_WAIT_V(4); PG8_BAR;
        PG8_STAGE(PG8_SB(1, 0), cB + kstep, voffB); PG8_STAGE(PG8_SA(1, 0), cA + kstep, voffA); PG8_STAGE(PG8_SB(1, 1), cB + hstep + kstep, voffB);
        PG8_WAIT_V(6); PG8_BAR;
    }
    for (;;) {
        const bool has_next = S.next(ui + 1, nxt);
        const char* nA = has_next ? (const char*)g.A + (size_t)nxt.pm * tstep : cA; const char* nB = has_next ? (const char*)g.Bt + (size_t)nxt.pn * tstep : cB;
        for (int t = 0; t < nt; t += 2) {
            const bool last = (t == nt - 2);
            const char* a1 = cA + (size_t)(t + 1) * kstep;
            const char* a2 = last ? nA : cA + (size_t)(t + 2) * kstep; const char* b2 = last ? nB : cB + (size_t)(t + 2) * kstep;
            const char* a3 = a2 + kstep; const char* b3 = b2 + kstep;
            if (last && has_next) S.a_ready(nxt);
            if constexpr (SP2) {
            PG8_LDB(B0, 0, 0); PG8_LDB(B1, 0, 1); PG8_SCHED; PG8_LDA(At, 0, 0); PG8_STAGE(PG8_SA(1, 1), a1 + hstep, voffA);
            PG8_WAIT_V(8); PG8_WAIT_L(0); PG8_BAR; PG8_MMA(0, 0, At, B0); PG8_MMA(0, 1, At, B1); PG8_BAR; PG8_SCHED;
            PG8_LDA(At, 0, 1); PG8_STAGE(PG8_SB(0, 0), b2, voffB); PG8_STAGE(PG8_SB(0, 1), b2 + hstep, voffB); PG8_STAGE(PG8_SA(0, 0), a2, voffA);
            PG8_WAIT_V(8); PG8_WAIT_L(0); PG8_BAR; PG8_MMA(1, 0, At, B0); PG8_MMA(1, 1, At, B1); PG8_BAR; PG8_SCHED;
            PG8_LDB(B0, 1, 0); PG8_LDB(B1, 1, 1); PG8_SCHED; PG8_LDA(At, 1, 0); PG8_STAGE(PG8_SA(0, 1), a2 + hstep, voffA);
            PG8_WAIT_V(8); PG8_WAIT_L(0); PG8_BAR; PG8_MMA(0, 0, At, B0); PG8_MMA(0, 1, At, B1); PG8_BAR; PG8_SCHED;
            PG8_LDA(At, 1, 1); PG8_STAGE(PG8_SB(1, 0), b3, voffB); PG8_STAGE(PG8_SB(1, 1), b3 + hstep, voffB); PG8_STAGE(PG8_SA(1, 0), a3, voffA);
            PG8_WAIT_V(8); PG8_WAIT_L(0); PG8_BAR; PG8_MMA(1, 0, At, B0); PG8_MMA(1, 1, At, B1); PG8_BAR; PG8_SCHED;
            } else {
            PG8_LDB(B0, 0, 0); PG8_SCHED; PG8_LDA(At, 0, 0); PG8_STAGE(PG8_SA(1, 1), a1 + hstep, voffA);
            PG8_WAIT_L(8); PG8_BAR; PG8_WAIT_L(0); PG8_MMA(0, 0, At, B0); PG8_BAR; PG8_SCHED;
            PG8_LDB(B1, 0, 1); PG8_STAGE(PG8_SB(0, 0), b2, voffB);
            PG8_BAR; PG8_WAIT_L(0); PG8_MMA(0, 1, At, B1); PG8_BAR;
            PG8_LDA(At, 0, 1); PG8_STAGE(PG8_SA(0, 0), a2, voffA);
            PG8_BAR; PG8_WAIT_L(0); PG8_MMA(1, 0, At, B0); PG8_BAR; PG8_SCHED;
            PG8_STAGE(PG8_SB(0, 1), b2 + hstep, voffB);
            PG8_WAIT_V(6); PG8_BAR; PG8_MMA(1, 1, At, B1); PG8_BAR;
            PG8_LDB(B0, 1, 0); PG8_SCHED; PG8_LDA(At, 1, 0); PG8_STAGE(PG8_SA(0, 1), a2 + hstep, voffA);
            PG8_WAIT_L(8); PG8_BAR; PG8_WAIT_L(0); PG8_MMA(0, 0, At, B0); PG8_BAR; PG8_SCHED;
            PG8_LDB(B1, 1, 1); PG8_STAGE(PG8_SB(1, 0), b3, voffB);
            PG8_BAR; PG8_WAIT_L(0); PG8_MMA(0, 1, At, B1); PG8_BAR;
            PG8_LDA(At, 1, 1); PG8_STAGE(PG8_SA(1, 0), a3, voffA);
            PG8_BAR; PG8_WAIT_L(0); PG8_MMA(1, 0, At, B0); PG8_BAR; PG8_SCHED;
            PG8_STAGE(PG8_SB(1, 1), b3 + hstep, voffB);
            PG8_WAIT_V(6); PG8_BAR; PG8_MMA(1, 1, At, B1); PG8_BAR;
            }
        }
        if constexpr (ALIGN_EPI) { if (wr == 0) PG8_BAR; }
        if constexpr (!Epi::AFTER_DRAIN) { E(acc, cur, wr, wc, fr, fq); S.done(cur); }
        if (!has_next) break;
#pragma unroll
        for (int a = 0; a < 2; ++a)
#pragma unroll
            for (int b = 0; b < 2; ++b)
#pragma unroll
                for (int m = 0; m < 4; ++m)
#pragma unroll
                    for (int n = 0; n < 2; ++n) acc[a][b][m][n] = (f32x4){0.f, 0.f, 0.f, 0.f};
        cur = nxt; cA = nA; cB = nB; ++ui;
        if constexpr (ALIGN_EPI) { if (wr == 1) PG8_BAR; }
    }
    PG8_WAIT_V(0);
    if constexpr (!ALIGN_EPI) { if (wr == 0) PG8_BAR; }
    PG8_BAR;
    if constexpr (Epi::AFTER_DRAIN) { E.fused(acc, cur, wr, wc, fr, fq, lds, wid, lane); S.done(cur); }
#undef PG8_SA
#undef PG8_SB
#undef PG8_STAGE
#undef PG8_LDA
#undef PG8_LDB
#undef PG8_MMA
#undef PG8_WAIT_V
#undef PG8_WAIT_L
#undef PG8_BAR
#undef PG8_SCHED
}
}
#define PG8_SP2 true
#define PG8_ALIGN true
#define GAS __attribute__((address_space(1)))
#define LAS __attribute__((address_space(3)))
typedef unsigned short bf16;
typedef unsigned v4u __attribute__((ext_vector_type(4)));
typedef float f32x4 __attribute__((ext_vector_type(4)));
typedef short bf16x8 __attribute__((ext_vector_type(8)));
typedef GAS unsigned gu32;
typedef GAS unsigned long long gu64;
#define RLX_AGENT __ATOMIC_RELAXED, __HIP_MEMORY_SCOPE_AGENT
#define LDS_WAIT() asm volatile("s_waitcnt lgkmcnt(0)" ::: "memory")
#define VM_WAIT() asm volatile("s_waitcnt vmcnt(0)" ::: "memory")
__device__ __forceinline__ unsigned long long rt() { return __builtin_amdgcn_s_memrealtime(); }
__device__ __forceinline__ unsigned f2bf(float f) { unsigned u = __builtin_bit_cast(unsigned, f); return (u + 0x7fffu + ((u >> 16) & 1u)) >> 16; }
__device__ __forceinline__ unsigned pk2(float lo, float hi) { return f2bf(lo) | (f2bf(hi) << 16); }
#define XB_TMO      128
#define XB_XCNT(j)  (256  + 64 * (j))
#define XB_XSUB(j)  (1280 + 64 * (j))
#define XB_XGEN(j)  (2304 + 64 * (j))
#define XB_TOP      3328
#define XB_TOPGEN   3392
#define XCD_BAR_WORDS 3456
#define XB_SPIN_CAP (1u << 18)

__device__ __forceinline__ unsigned xb_ld(unsigned* p)              { return __hip_atomic_load(p, __ATOMIC_RELAXED, __HIP_MEMORY_SCOPE_AGENT); }
__device__ __forceinline__ unsigned xb_add(unsigned* p, unsigned v) { return __hip_atomic_fetch_add(p, v, __ATOMIC_RELAXED, __HIP_MEMORY_SCOPE_AGENT); }
__device__ __forceinline__ unsigned xb_xcc_id() { return (unsigned)__builtin_amdgcn_s_getreg((3 << 11) | 20) & 0xFu; }
#define XB_SPIN(cond, bar) do { unsigned _sp = 0; while (cond) { __builtin_amdgcn_s_sleep(1); \
    if ((++_sp & 255u) == 0u) { if (xb_ld(&(bar)[XB_TMO])) break; if (_sp > XB_SPIN_CAP) { atomicAdd(&(bar)[XB_TMO], 1u); break; } } } } while (0)

struct XcdBarrier {
    unsigned* bar; unsigned x;
    volatile LAS unsigned* st;
};

__device__ __forceinline__ XcdBarrier xcd_barrier_post(unsigned* bar, volatile LAS unsigned* st) {
    XcdBarrier b; b.bar = bar; b.x = xb_xcc_id(); b.st = st;
    if (threadIdx.x == 0) (void)xb_add(&bar[XB_XCNT(b.x)], 1u);
    return b;
}
__device__ __forceinline__ void xcd_barrier_complete(unsigned* bar, unsigned x, unsigned& nloc, unsigned& nx) {
    const unsigned G = gridDim.x * gridDim.y * gridDim.z;
    unsigned sum, cnt, mine, sp = 0u;
    for (;;) {
        sum = 0u; cnt = 0u; mine = 0u;
#pragma unroll
        for (unsigned j = 0; j < 16; ++j) { const unsigned c = xb_ld(&bar[XB_XCNT(j)]); sum += c; cnt += (c > 0u) ? 1u : 0u; mine = (j == x) ? c : mine; }
        if (sum == G) break;
        __builtin_amdgcn_s_sleep(1);
        if ((++sp & 255u) == 0u) { if (xb_ld(&bar[XB_TMO])) break; if (sp > XB_SPIN_CAP) { atomicAdd(&bar[XB_TMO], 1u); break; } }
    }
    nloc = mine > 0u ? mine : 1u; nx = cnt > 0u ? cnt : 1u;
}

__device__ __forceinline__ void xcd_barrier(const XcdBarrier& b) {
    asm volatile("s_waitcnt vmcnt(0)" ::: "memory");
    __syncthreads();
    if (threadIdx.x == 0) {
        unsigned* bar = b.bar;
        __builtin_amdgcn_s_waitcnt(0);
        unsigned nloc = b.st[0], nx = b.st[1];
        if (nloc == 0u) { xcd_barrier_complete(bar, b.x, nloc, nx); b.st[0] = nloc; b.st[1] = nx; }
        const unsigned old = xb_add(&bar[XB_XSUB(b.x)], 1u);
        const unsigned gen = old / nloc;
        if (old + 1u == (gen + 1u) * nloc) {
            __builtin_amdgcn_fence(__ATOMIC_RELEASE, "agent");
            asm volatile("s_waitcnt vmcnt(0)" ::: "memory");
            const unsigned og = xb_add(&bar[XB_TOP], 1u);
            const unsigned tg = og / nx;
            if (og + 1u == (tg + 1u) * nx) xb_add(&bar[XB_TOPGEN], 1u);
            else XB_SPIN(xb_ld(&bar[XB_TOPGEN]) == tg, bar);
            __builtin_amdgcn_fence(__ATOMIC_ACQUIRE, "agent");
            xb_add(&bar[XB_XGEN(b.x)], 1u);
            asm volatile("s_waitcnt vmcnt(0)" ::: "memory");
        } else {
            XB_SPIN(xb_ld(&bar[XB_XGEN(b.x)]) == gen, bar);
            __builtin_amdgcn_fence(__ATOMIC_ACQUIRE, "agent");
            asm volatile("s_waitcnt vmcnt(0)" ::: "memory");
        }
    }
    __syncthreads();
}

constexpr int NWAVES = 8;
constexpr int D = 1024, TP = 16384, TS = 512, T = TP + TS, FF = 2816, NH = 8, KVR = 256, ROPE = 64, QRANK = 512, NQ = 1536, HD = 192;
constexpr int SEQ = 8192, DB = 128, DS = 4, PAGE = 128, NPG = 64, CKVW = 320;
constexpr int NCK = DB * SEQ;
constexpr float EPS = 1e-6f;
constexpr float QSCALE = 0.07216878364870322f * 1.4426950408889634f;
constexpr size_t OUT_Y = 0, OUT_CSP = 17301504, OUT_CSS = 17305600, OUT_LATP = 17567744, OUT_KPEP = 21762048, OUT_LATS = 22810624, OUT_KPES = 22941696, OUT_TOTAL = 22974464;
constexpr size_t MiB = 1u << 20;
constexpr size_t WS_CTL = 0, CTL_BYTES = 4 * MiB;
constexpr size_t WS_WGU0 = 4 * MiB, WS_WGU1 = 15 * MiB, WS_WGU2 = 26 * MiB, WS_WGU3 = 38 * MiB;
constexpr size_t WS_WDN0 = 49 * MiB, WS_WDN1 = 55 * MiB, WS_WDN2 = 61 * MiB, WS_WDN3 = 67 * MiB;
constexpr size_t WS_WCI = 73 * MiB, WS_WCO = 79 * MiB, WS_WDQ = 81 * MiB, WS_WUQ = 82 * MiB, WS_WO = 84 * MiB, WS_WUKV = 86 * MiB;
constexpr size_t WS_ROPE = 88 * MiB;
constexpr size_t WS_XB = 92 * MiB, WS_HB = 126 * MiB, WS_BB = 218 * MiB, WS_UB = 252 * MiB, WS_ZB = 286 * MiB, WS_CKV = 320 * MiB;
constexpr size_t WS_LATB = 342 * MiB, WS_KPEB = 352 * MiB, WS_KN = 356 * MiB, WS_VB = 390 * MiB, WS_CQB = 424 * MiB, WS_QB = 442 * MiB;
constexpr size_t WS_OB = 493 * MiB, WS_RPT = 527 * MiB, WS_RTS = 529 * MiB, WS_QS = 530 * MiB, WS_PO = 534 * MiB, WS_PML = 543 * MiB;
constexpr size_t WS_CLB = 544 * MiB, WS_CKB = 1056 * MiB, WS_RP = 1184 * MiB, WS_END = 1248 * MiB;
constexpr int CW_BAR = 4096;
constexpr int F_SSQX = 16384, F_SSQLAT = F_SSQX + 6 * T, F_SSQKPE = F_SSQX + 7 * T, F_SSQCQ = F_SSQX + 8 * T, F_SSQQ = F_SSQX + 9 * T;
static_assert((size_t)(F_SSQQ + 16 * T) * 4 <= CTL_BYTES, "ctl");
constexpr int RING_OFF = 0, RING_BYTES = 131072, MISC_OFF = 131072, QS_OFF = 131584, QS_STRIDE = 656, SCR_OFF = QS_OFF + 32 * QS_STRIDE, LDS_BYTES = 155648;
static_assert(SCR_OFF + 8 * 256 <= LDS_BYTES, "lds");

typedef unsigned short bf16_t;
typedef unsigned u32x2 __attribute__((ext_vector_type(2)));
typedef float f32x2 __attribute__((ext_vector_type(2)));
using pg8::cvt_pk_bf16;
__device__ __forceinline__ float bf2f(unsigned short h) { return __builtin_bit_cast(float, (unsigned)h << 16); }
__device__ __forceinline__ float bflo(unsigned w) { return __builtin_bit_cast(float, w << 16); }
__device__ __forceinline__ float bfhi(unsigned w) { return __builtin_bit_cast(float, w & 0xffff0000u); }
__device__ __forceinline__ v4u pack8f(const float* v) { v4u o; o.x = cvt_pk_bf16(v[0], v[1]); o.y = cvt_pk_bf16(v[2], v[3]); o.z = cvt_pk_bf16(v[4], v[5]); o.w = cvt_pk_bf16(v[6], v[7]); return o; }
__device__ __forceinline__ void unpack8f(v4u w, float* v) { v[0] = bflo(w.x); v[1] = bfhi(w.x); v[2] = bflo(w.y); v[3] = bfhi(w.y); v[4] = bflo(w.z); v[5] = bfhi(w.z); v[6] = bflo(w.w); v[7] = bfhi(w.w); }
__device__ __forceinline__ float fq_sum(float s) { s += __shfl_xor(s, 16); s += __shfl_xor(s, 32); return s; }
__device__ __forceinline__ float wave_sum(float v) {
#pragma unroll
    for (int o = 1; o < 64; o <<= 1) v += __shfl_xor(v, o);
    return v;
}
__device__ __forceinline__ float rsq(float x) { return 1.0f / sqrtf(x); }
__device__ __forceinline__ void atomic_addf(float* p, float v) { unsafeAtomicAdd(p, v); }

namespace epi {
using pg8::Unit; using pg8::f32x4; using pg8::BM; using pg8::HALF;
typedef f32x4 Acc[2][2][4][2];

struct Swiglu {
    static constexpr bool PERM = true, AFTER_DRAIN = false;
    bf16_t* HB; const float* ssq; float* ckv; float* ssq_lat; float* ssq_kpe; int ngu;
    __device__ __forceinline__ void operator()(const f32x4 (&acc)[2][2][4][2], const Unit& u, int wr, int wc, int fr, int fq) const {
#pragma unroll
        for (int ai = 0; ai < 2; ++ai)
#pragma unroll
            for (int m = 0; m < 4; ++m) {
                const int row = u.pm * BM + ai * HALF + wr * 64 + m * 16 + fr;
                const float rs = rsq(ssq[row] * (1.0f / D) + EPS);
                if (u.pn < ngu) {
                    float h[8];
#pragma unroll
                    for (int n = 0; n < 2; ++n)
#pragma unroll
                        for (int j = 0; j < 4; ++j) { const float g = acc[ai][0][m][n][j] * rs, up = acc[ai][1][m][n][j] * rs;
                            const float sg = g * __builtin_amdgcn_rcpf(1.0f + __builtin_amdgcn_exp2f(-1.4426950408889634f * g)); h[4 * n + j] = sg * up; }
                    *(v4u*)(HB + (size_t)row * FF + 128 * u.pn + 32 * wc + 8 * fq) = pack8f(h);
                } else if (u.pn == ngu) {
                    float ss = 0.f;
#pragma unroll
                    for (int bj = 0; bj < 2; ++bj)
#pragma unroll
                        for (int n = 0; n < 2; ++n) { const f32x4 v = acc[ai][bj][m][n] * rs; ss += (v[0] * v[0] + v[1] * v[1]) + (v[2] * v[2] + v[3] * v[3]);
                            *(f32x4*)(ckv + (size_t)row * CKVW + 128 * bj + 32 * wc + 8 * fq + 4 * n) = v; }
                    ss = fq_sum(ss); if (fq == 0) atomic_addf(ssq_lat + row, ss);
                } else {
                    if (wc < 2) { float ss = 0.f;
#pragma unroll
                        for (int n = 0; n < 2; ++n) { const f32x4 v = acc[ai][0][m][n] * rs; ss += (v[0] * v[0] + v[1] * v[1]) + (v[2] * v[2] + v[3] * v[3]);
                            *(f32x4*)(ckv + (size_t)row * CKVW + 256 + 32 * wc + 8 * fq + 4 * n) = v; }
                        ss = fq_sum(ss); if (fq == 0) atomic_addf(ssq_kpe + row, ss); }
                }
            }
    }
};
struct Resid {
    static constexpr bool PERM = true, AFTER_DRAIN = false;
    float* X; bf16_t* XB; float* ssq_out; float alpha;
    __device__ __forceinline__ void operator()(const f32x4 (&acc)[2][2][4][2], const Unit& u, int wr, int wc, int fr, int fq) const {
#pragma unroll
        for (int ai = 0; ai < 2; ++ai)
#pragma unroll
            for (int m = 0; m < 4; ++m) {
                const int row = u.pm * BM + ai * HALF + wr * 64 + m * 16 + fr;
                const size_t off = (size_t)row * D + 256 * u.pn + 32 * wc + 8 * fq;
                float ss = 0.f;
#pragma unroll
                for (int bj = 0; bj < 2; ++bj) {
                    float* xp = X + off + 128 * bj;
                    const f32x4 v0 = *(const f32x4*)xp + acc[ai][bj][m][0] * alpha, v1 = *(const f32x4*)(xp + 4) + acc[ai][bj][m][1] * alpha;
                    *(f32x4*)xp = v0; *(f32x4*)(xp + 4) = v1;
                    ss += (v0[0] * v0[0] + v0[1] * v0[1]) + (v0[2] * v0[2] + v0[3] * v0[3]) + (v1[0] * v1[0] + v1[1] * v1[1]) + (v1[2] * v1[2] + v1[3] * v1[3]);
                    if (XB) { v4u w; w.x = cvt_pk_bf16(v0[0], v0[1]); w.y = cvt_pk_bf16(v0[2], v0[3]); w.z = cvt_pk_bf16(v1[0], v1[1]); w.w = cvt_pk_bf16(v1[2], v1[3]); *(v4u*)(XB + off + 128 * bj) = w; }
                }
                if (ssq_out) { ss = fq_sum(ss); if (fq == 0) atomic_addf(ssq_out + row, ss); }
            }
    }
};
struct ConvIn {
    static constexpr bool PERM = true, AFTER_DRAIN = false;
    bf16_t* BB; bf16_t* UB; const float* ssq; float* csp; float* css;
    __device__ __forceinline__ void operator()(const f32x4 (&acc)[2][2][4][2], const Unit& u, int wr, int wc, int fr, int fq) const {
#pragma unroll
        for (int ai = 0; ai < 2; ++ai)
#pragma unroll
            for (int m = 0; m < 4; ++m) {
                const int row = u.pm * BM + ai * HALF + wr * 64 + m * 16 + fr;
                const float rs = rsq(ssq[row] * (1.0f / D) + EPS);
                if (u.pn < 4) {
#pragma unroll
                    for (int bj = 0; bj < 2; ++bj) { const f32x4 v0 = acc[ai][bj][m][0] * rs, v1 = acc[ai][bj][m][1] * rs;
                        v4u w; w.x = cvt_pk_bf16(v0[0], v0[1]); w.y = cvt_pk_bf16(v0[2], v0[3]); w.z = cvt_pk_bf16(v1[0], v1[1]); w.w = cvt_pk_bf16(v1[2], v1[3]);
                        *(v4u*)(BB + (size_t)row * D + 256 * u.pn + 128 * bj + 32 * wc + 8 * fq) = w; }
                } else {
                    const int ch0 = 128 * (u.pn - 4) + 32 * wc + 8 * fq;
                    const f32x4 u0 = (acc[ai][0][m][0] * rs) * (acc[ai][1][m][0] * rs), u1 = (acc[ai][0][m][1] * rs) * (acc[ai][1][m][1] * rs);
                    v4u w; w.x = cvt_pk_bf16(u0[0], u0[1]); w.y = cvt_pk_bf16(u0[2], u0[3]); w.z = cvt_pk_bf16(u1[0], u1[1]); w.w = cvt_pk_bf16(u1[2], u1[3]);
                    *(v4u*)(UB + (size_t)row * D + ch0) = w;
                    float* dst = nullptr;
                    if (row < TP) { const int t = row & (SEQ - 1); if (t >= SEQ - 2) dst = csp + (size_t)((row >> 13) * 2 + (t - (SEQ - 2))) * D + ch0; }
                    else { const int rs_ = row - TP, i = rs_ & 3; if (i >= 2) dst = css + (size_t)((rs_ >> 2) * 2 + (i - 2)) * D + ch0; }
                    if (dst) { *(f32x4*)dst = u0; *(f32x4*)(dst + 4) = u1; }
                }
            }
    }
};
struct Dq {
    static constexpr bool PERM = true, AFTER_DRAIN = false;
    bf16_t* CQB; const float* ssq; float* ssq_out;
    __device__ __forceinline__ void operator()(const f32x4 (&acc)[2][2][4][2], const Unit& u, int wr, int wc, int fr, int fq) const {
#pragma unroll
        for (int ai = 0; ai < 2; ++ai)
#pragma unroll
            for (int m = 0; m < 4; ++m) {
                const int row = u.pm * BM + ai * HALF + wr * 64 + m * 16 + fr;
                const float rs = rsq(ssq[row] * (1.0f / D) + EPS);
                float ss = 0.f;
#pragma unroll
                for (int bj = 0; bj < 2; ++bj) { const f32x4 v0 = acc[ai][bj][m][0] * rs, v1 = acc[ai][bj][m][1] * rs;
                    ss += (v0[0] * v0[0] + v0[1] * v0[1]) + (v0[2] * v0[2] + v0[3] * v0[3]) + (v1[0] * v1[0] + v1[1] * v1[1]) + (v1[2] * v1[2] + v1[3] * v1[3]);
                    v4u w; w.x = cvt_pk_bf16(v0[0], v0[1]); w.y = cvt_pk_bf16(v0[2], v0[3]); w.z = cvt_pk_bf16(v1[0], v1[1]); w.w = cvt_pk_bf16(v1[2], v1[3]);
                    *(v4u*)(CQB + (size_t)row * QRANK + 256 * u.pn + 128 * bj + 32 * wc + 8 * fq) = w; }
                ss = fq_sum(ss); if (fq == 0) atomic_addf(ssq_out + row, ss);
            }
    }
};
struct Uq {
    static constexpr bool PERM = true, AFTER_DRAIN = false;
    bf16_t* QB; const float* ssq; float* ssq_q;
    __device__ __forceinline__ void operator()(const f32x4 (&acc)[2][2][4][2], const Unit& u, int wr, int wc, int fr, int fq) const {
#pragma unroll
        for (int ai = 0; ai < 2; ++ai)
#pragma unroll
            for (int m = 0; m < 4; ++m) {
                const int row = u.pm * BM + ai * HALF + wr * 64 + m * 16 + fr;
                const float rs = rsq(ssq[row] * (1.0f / QRANK) + EPS);
#pragma unroll
                for (int bj = 0; bj < 2; ++bj) { const f32x4 v0 = acc[ai][bj][m][0] * rs, v1 = acc[ai][bj][m][1] * rs;
                    float ss = (v0[0] * v0[0] + v0[1] * v0[1]) + (v0[2] * v0[2] + v0[3] * v0[3]) + (v1[0] * v1[0] + v1[1] * v1[1]) + (v1[2] * v1[2] + v1[3] * v1[3]);
                    const int cb = 256 * u.pn + 128 * bj + 32 * wc;
                    const int hh = cb / HD, seg = 2 * hh + ((cb - hh * HD) >= 128 ? 1 : 0);
                    v4u w; w.x = cvt_pk_bf16(v0[0], v0[1]); w.y = cvt_pk_bf16(v0[2], v0[3]); w.z = cvt_pk_bf16(v1[0], v1[1]); w.w = cvt_pk_bf16(v1[2], v1[3]);
                    *(v4u*)(QB + (size_t)row * NQ + cb + 8 * fq) = w;
                    ss = fq_sum(ss); if (fq == 0) atomic_addf(ssq_q + (size_t)row * 16 + seg, ss); }
            }
    }
};
struct Kv {
    static constexpr bool PERM = true, AFTER_DRAIN = false;
    bf16_t* KU; bf16_t* VB; float* RP; size_t nrows;
    __device__ __forceinline__ void operator()(const f32x4 (&acc)[2][2][4][2], const Unit& u, int wr, int wc, int fr, int fq) const {
#pragma unroll
        for (int ai = 0; ai < 2; ++ai)
#pragma unroll
            for (int m = 0; m < 4; ++m) {
                const unsigned row = (unsigned)(u.pm * BM + ai * HALF + wr * 64 + m * 16 + fr);
                if (u.pn < 4) {
                    const int head = 2 * u.pn + (wc >> 1);
                    float ss = 0.f;
#pragma unroll
                    for (int bj = 0; bj < 2; ++bj) { const f32x4 v0 = acc[ai][bj][m][0], v1 = acc[ai][bj][m][1];
                        ss += (v0[0] * v0[0] + v0[1] * v0[1]) + (v0[2] * v0[2] + v0[3] * v0[3]) + (v1[0] * v1[0] + v1[1] * v1[1]) + (v1[2] * v1[2] + v1[3] * v1[3]);
                        if (KU) { v4u w; w.x = cvt_pk_bf16(v0[0], v0[1]); w.y = cvt_pk_bf16(v0[2], v0[3]); w.z = cvt_pk_bf16(v1[0], v1[1]); w.w = cvt_pk_bf16(v1[2], v1[3]);
                            *(v4u*)(KU + (size_t)(row * D + 128 * head + 64 * (wc & 1) + 32 * bj + 8 * fq)) = w; } }
                    ss = fq_sum(ss); if (fq == 0) RP[(size_t)((unsigned)(2 * head + (wc & 1)) * (unsigned)nrows + row)] = ss;
                } else if (VB) {
#pragma unroll
                    for (int bj = 0; bj < 2; ++bj) { const f32x4 v0 = acc[ai][bj][m][0], v1 = acc[ai][bj][m][1];
                        v4u w; w.x = cvt_pk_bf16(v0[0], v0[1]); w.y = cvt_pk_bf16(v0[2], v0[3]); w.z = cvt_pk_bf16(v1[0], v1[1]); w.w = cvt_pk_bf16(v1[2], v1[3]);
                        *(v4u*)(VB + (size_t)(row * D + 256 * (u.pn - 4) + 128 * bj + 32 * wc + 8 * fq)) = w; }
                }
            }
    }
};
}

struct Ctx {
    LAS unsigned char* lds;
    int tid, lane, wave, vcu, G;
};
__device__ __forceinline__ void prep_block(const float* W, int K, int N, const float* gain, bf16_t* WT, int drow0, int kb, int nb, LAS float* scr, int lane) {
    const int k0 = 64 * kb, n0 = 32 * nb;
#pragma unroll 8
    for (int i = 0; i < 32; ++i) { const int kk = 2 * i + (lane >> 5); float v = W[(size_t)(k0 + kk) * N + n0 + (lane & 31)]; if (gain) v *= gain[k0 + kk]; scr[kk * 33 + (lane & 31)] = v; }
    LDS_WAIT(); asm volatile("" ::: "memory");
    const int c = lane & 7;
#pragma unroll
    for (int j = 0; j < 4; ++j) { const int n = (lane >> 3) + 8 * j; const LAS float* s = scr + (8 * c) * 33 + n;
        v4u o; o.x = cvt_pk_bf16(s[0 * 33], s[1 * 33]); o.y = cvt_pk_bf16(s[2 * 33], s[3 * 33]); o.z = cvt_pk_bf16(s[4 * 33], s[5 * 33]); o.w = cvt_pk_bf16(s[6 * 33], s[7 * 33]);
        *(v4u*)(WT + (size_t)(drow0 + n) * K + k0 + 8 * c) = o; }
    LDS_WAIT(); asm volatile("" ::: "memory");
}
__device__ __forceinline__ int gu_map(int nb) { const int up = nb >= 88 ? 1 : 0, hb = nb - 88 * up; return 256 * (hb >> 2) + 128 * up + 32 * (hb & 3); }
__device__ __forceinline__ int ci_map(int nb) { if (nb < 32) return 32 * nb; const int hh = nb >= 64 ? 1 : 0, cb = nb - 32 - 32 * hh; return 256 * (4 + (cb >> 2)) + 128 * hh + 32 * (cb & 3); }
__device__ __forceinline__ int uk_map(int nb) { const int h = nb >> 2, dq = nb & 3; return 256 * (h >> 1) + 128 * (dq & 1) + 32 * (2 * (h & 1) + (dq >> 1)); }
__device__ __forceinline__ int uk_row(int h, int d) { return 256 * (h >> 1) + 128 * ((d >> 5) & 1) + 32 * (2 * (h & 1) + (d >> 6)) + (d & 31); }

struct Ptrs {
    const float* in[29]; float* out; unsigned char* ws;
};
typedef const __attribute__((address_space(4))) Ptrs CPtrs;

__device__ __forceinline__ void phase_prologue(const Ctx& C, CPtrs& P) {
    unsigned char* ws = P.ws;
    LAS float* scr = (LAS float*)(C.lds + RING_OFF + C.wave * 16384);
    const int gw = C.vcu * NWAVES + C.wave, NGW = C.G * NWAVES, lane = C.lane;
    constexpr int I_GU = 16 * 176, I_DKV = 16 * 10, I_DN = 44 * 32, I_CI = 16 * 96, I_SQ = 16 * 32, I_DQ = 16 * 16, I_UQ = 8 * 48, I_UKV = 4 * 32, I_Z = 192;
    constexpr int NITEMS = 4 * I_GU + I_DKV + 4 * I_DN + I_CI + I_SQ + I_DQ + I_UQ + I_SQ + 2 * I_UKV + I_Z;
    for (int it = gw; it < NITEMS; it += NGW) {
        int r = it;
        if (r < 4 * I_GU) { const int mi = r / I_GU; r -= mi * I_GU; const int kb = r / 176, nb = r % 176;
            const float* W = (mi & 1 ? P.in[11] : P.in[7]) + (size_t)(mi >> 1) * D * 2 * FF; const float* g = (mi & 1 ? P.in[10] : P.in[6]) + (mi >> 1) * D;
            bf16_t* dst = (bf16_t*)(ws + (mi == 0 ? WS_WGU0 : mi == 1 ? WS_WGU1 : mi == 2 ? WS_WGU2 : WS_WGU3));
            prep_block(W, D, 2 * FF, g, dst, gu_map(nb), kb, nb, scr, lane); continue; } r -= 4 * I_GU;
        if (r < I_DKV) { const int kb = r / 10, nb = r % 10; prep_block(P.in[23], D, CKVW, P.in[22], (bf16_t*)(ws + WS_WGU2), 5632 + 32 * nb, kb, nb, scr, lane); continue; } r -= I_DKV;
        if (r < 4 * I_DN) { const int mi = r / I_DN; r -= mi * I_DN; const int kb = r / 32, nb = r % 32;
            const float* W = (mi & 1 ? P.in[12] : P.in[8]) + (size_t)(mi >> 1) * FF * D;
            bf16_t* dst = (bf16_t*)(ws + (mi == 0 ? WS_WDN0 : mi == 1 ? WS_WDN1 : mi == 2 ? WS_WDN2 : WS_WDN3));
            prep_block(W, FF, D, nullptr, dst, 32 * nb, kb, nb, scr, lane); continue; } r -= 4 * I_DN;
        if (r < I_CI) { const int kb = r / 96, nb = r % 96; prep_block(P.in[13], D, 3 * D, P.in[9], (bf16_t*)(ws + WS_WCI), ci_map(nb), kb, nb, scr, lane); continue; } r -= I_CI;
        if (r < I_SQ) { const int kb = r / 32, nb = r % 32; prep_block(P.in[15], D, D, nullptr, (bf16_t*)(ws + WS_WCO), 32 * nb, kb, nb, scr, lane); continue; } r -= I_SQ;
        if (r < I_DQ) { const int kb = r / 16, nb = r % 16; prep_block(P.in[16], D, QRANK, P.in[9] + D, (bf16_t*)(ws + WS_WDQ), 32 * nb, kb, nb, scr, lane); continue; } r -= I_DQ;
        if (r < I_UQ) { const int kb = r / 48, nb = r % 48; prep_block(P.in[18], QRANK, NQ, P.in[17], (bf16_t*)(ws + WS_WUQ), 32 * nb, kb, nb, scr, lane); continue; } r -= I_UQ;
        if (r < I_SQ) { const int kb = r / 32, nb = r % 32; prep_block(P.in[21], D, D, nullptr, (bf16_t*)(ws + WS_WO), 32 * nb, kb, nb, scr, lane); continue; } r -= I_SQ;
        if (r < I_UKV) { const int kb = r / 32, nb = r % 32; prep_block(P.in[26], KVR, D, nullptr, (bf16_t*)(ws + WS_WUKV), uk_map(nb), kb, nb, scr, lane); continue; } r -= I_UKV;
        if (r < I_UKV) { const int kb = r / 32, nb = r % 32; prep_block(P.in[27], KVR, D, nullptr, (bf16_t*)(ws + WS_WUKV), 1024 + 32 * nb, kb, nb, scr, lane); continue; } r -= I_UKV;
        { bf16_t* dst = (bf16_t*)(ws + WS_WGU2) + (size_t)(5952 + r) * D; const v4u z = {0u, 0u, 0u, 0u};
#pragma unroll
          for (int j = 0; j < 2; ++j) *(v4u*)(dst + 8 * (lane + 64 * j)) = z; }
    }
    {
        f32x2* tab = (f32x2*)(ws + WS_ROPE);
        for (int e = (C.vcu * NWAVES * 64) + C.tid; e < (SEQ + DS) * 32; e += C.G * NWAVES * 64) {
            const int pos = e >> 5, j = e & 31;
            double f = 1.0; for (int i = 0; i < j; ++i) f *= 0.74989420933245582730;
            const double ang = (double)pos * f;
            const double k = __builtin_rint(ang * 0.15915494309189533577);
            double r = __builtin_fma(-k, 6.283185307179586232, ang); r = __builtin_fma(-k, 2.4492935982947064e-16, r);
            const double r2 = r * r; double ts = 1.0, tc = 1.0, ss = 1.0, cs = 1.0;
#pragma unroll
            for (int q = 1; q <= 14; ++q) { tc *= -r2 / (double)((2 * q - 1) * (2 * q)); cs += tc; ts *= -r2 / (double)((2 * q) * (2 * q + 1)); ss += ts; }
            tab[e] = (f32x2){(float)cs, (float)(ss * r)};
        }
    }
    {
        float* X = P.out + OUT_Y; bf16_t* XB = (bf16_t*)(ws + WS_XB); float* ssq = (float*)(ws + WS_CTL) + F_SSQX;
        for (int row = gw; row < T; row += NGW) {
            const float* src = row < TP ? P.in[0] + (size_t)row * D : P.in[1] + (size_t)(row - TP) * D;
            f32x4 v[4]; float s = 0.f;
#pragma unroll
            for (int j = 0; j < 4; ++j) { v[j] = *((const f32x4*)src + lane + 64 * j); s += (v[j].x * v[j].x + v[j].y * v[j].y) + (v[j].z * v[j].z + v[j].w * v[j].w); }
            s = wave_sum(s);
#pragma unroll
            for (int j = 0; j < 4; ++j) { *((f32x4*)(X + (size_t)row * D) + lane + 64 * j) = v[j];
                u32x2 w; w.x = cvt_pk_bf16(v[j].x, v[j].y); w.y = cvt_pk_bf16(v[j].z, v[j].w); *((u32x2*)(XB + (size_t)row * D) + lane + 64 * j) = w; }
            if (lane == 0) ssq[row] = s;
        }
    }
    {
        const int* pt = (const int*)P.in[5]; bf16_t* CLB = (bf16_t*)(ws + WS_CLB); bf16_t* CKB = (bf16_t*)(ws + WS_CKB);
        for (int pg = gw; pg < DB * NPG; pg += NGW) {
            const int phys = pt[pg];
            const float* sl = P.in[2] + (size_t)phys * PAGE * KVR; bf16_t* dl = CLB + (size_t)pg * PAGE * KVR;
#pragma unroll 4
            for (int i = 0; i < 64; ++i) { const f32x4 a = *((const f32x4*)sl + 2 * (lane + 64 * i)), b = *((const f32x4*)sl + 2 * (lane + 64 * i) + 1);
                v4u w; w.x = cvt_pk_bf16(a.x, a.y); w.y = cvt_pk_bf16(a.z, a.w); w.z = cvt_pk_bf16(b.x, b.y); w.w = cvt_pk_bf16(b.z, b.w); *((v4u*)dl + lane + 64 * i) = w; }
            const float* sk = P.in[3] + (size_t)phys * PAGE * ROPE; bf16_t* dk = CKB + (size_t)pg * PAGE * ROPE;
#pragma unroll 4
            for (int i = 0; i < 16; ++i) { const f32x4 a = *((const f32x4*)sk + 2 * (lane + 64 * i)), b = *((const f32x4*)sk + 2 * (lane + 64 * i) + 1);
                v4u w; w.x = cvt_pk_bf16(a.x, a.y); w.y = cvt_pk_bf16(a.z, a.w); w.z = cvt_pk_bf16(b.x, b.y); w.w = cvt_pk_bf16(b.z, b.w); *((v4u*)dk + lane + 64 * i) = w; }
        }
    }
}

__device__ __forceinline__ void phase_conv(const Ctx& C, CPtrs& P) {
    unsigned char* ws = P.ws; const bf16_t* BB = (const bf16_t*)(ws + WS_BB); const bf16_t* UB = (const bf16_t*)(ws + WS_UB); bf16_t* ZB = (bf16_t*)(ws + WS_ZB);
    const float* cw = P.in[14]; const float* st = P.in[4];
    const int gw = C.vcu * NWAVES + C.wave, NGW = C.G * NWAVES, lane = C.lane;
    for (int row = gw; row < T; row += NGW) {
        int have1, have2; const float* s1 = nullptr; const float* s2 = nullptr;
        if (row < TP) { const int t = row & (SEQ - 1); have1 = t >= 1; have2 = t >= 2; }
        else { const int r = row - TP, i = r & 3, b = r >> 2; have1 = i >= 1; have2 = i >= 2;
            if (!have1) s1 = st + (size_t)(b * 2 + 1) * D; if (!have2) s2 = st + (size_t)(b * 2 + i) * D; }
#pragma unroll
        for (int j = 0; j < 2; ++j) {
            const int ch = 8 * lane + 512 * j;
            float b8[8], u0[8], u1[8], u2[8], z[8];
            unpack8f(*(const v4u*)(BB + (size_t)row * D + ch), b8); unpack8f(*(const v4u*)(UB + (size_t)row * D + ch), u0);
            if (have1) unpack8f(*(const v4u*)(UB + (size_t)(row - 1) * D + ch), u1);
            else if (s1) { const f32x4 a = *(const f32x4*)(s1 + ch), b = *(const f32x4*)(s1 + ch + 4); u1[0] = a.x; u1[1] = a.y; u1[2] = a.z; u1[3] = a.w; u1[4] = b.x; u1[5] = b.y; u1[6] = b.z; u1[7] = b.w; }
            else {
#pragma unroll
                for (int e = 0; e < 8; ++e) u1[e] = 0.f; }
            if (have2) unpack8f(*(const v4u*)(UB + (size_t)(row - 2) * D + ch), u2);
            else if (s2) { const f32x4 a = *(const f32x4*)(s2 + ch), b = *(const f32x4*)(s2 + ch + 4); u2[0] = a.x; u2[1] = a.y; u2[2] = a.z; u2[3] = a.w; u2[4] = b.x; u2[5] = b.y; u2[6] = b.z; u2[7] = b.w; }
            else {
#pragma unroll
                for (int e = 0; e < 8; ++e) u2[e] = 0.f; }
#pragma unroll
            for (int e = 0; e < 8; ++e) z[e] = b8[e] * (cw[ch + e] * u2[e] + cw[D + ch + e] * u1[e] + cw[2 * D + ch + e] * u0[e]);
            *(v4u*)(ZB + (size_t)row * D + ch) = pack8f(z);
        }
    }
}

__device__ __forceinline__ void phase_kvfin(const Ctx& C, CPtrs& P) {
    unsigned char* ws = P.ws; const float* ckv = (const float*)(ws + WS_CKV); const float* ctl = (const float*)(ws + WS_CTL);
    bf16_t* LATB = (bf16_t*)(ws + WS_LATB); bf16_t* KPEB = (bf16_t*)(ws + WS_KPEB); const f32x2* tab = (const f32x2*)(ws + WS_ROPE);
    int lane = C.lane; asm volatile("" : "+v"(lane));
    const int gw = C.vcu * NWAVES + C.wave, NGW = C.G * NWAVES;
    const f32x4 gl = *((const f32x4*)P.in[24] + lane); const float gk = P.in[25][lane];
    for (int row = gw; row < T; row += NGW) {
        const float rl = rsq(ctl[F_SSQLAT + row] * (1.0f / KVR) + EPS), rk = rsq(ctl[F_SSQKPE + row] * (1.0f / ROPE) + EPS);
        const f32x4 v = *((const f32x4*)(ckv + (size_t)row * CKVW) + lane) * rl * gl;
        float* ol = row < TP ? P.out + OUT_LATP + (size_t)row * KVR : P.out + OUT_LATS + (size_t)(row - TP) * KVR;
        *((f32x4*)ol + lane) = v;
        u32x2 w; w.x = cvt_pk_bf16(v.x, v.y); w.y = cvt_pk_bf16(v.z, v.w); *((u32x2*)(LATB + (size_t)row * KVR) + lane) = w;
        const int pos = row < TP ? (row & (SEQ - 1)) : SEQ + ((row - TP) & 3);
        const float xn = ckv[(size_t)row * CKVW + KVR + lane] * rk * gk, pr = __shfl_xor(xn, 32);
        const f32x2 cs = tab[pos * 32 + (lane & 31)];
        const float o = lane < 32 ? xn * cs.x - pr * cs.y : xn * cs.x + pr * cs.y;
        float* ok = row < TP ? P.out + OUT_KPEP + (size_t)row * ROPE : P.out + OUT_KPES + (size_t)(row - TP) * ROPE;
        ok[lane] = o;
        const float on = __shfl_xor(o, 1);
        if ((lane & 1) == 0) *(unsigned*)(KPEB + (size_t)row * ROPE + lane) = cvt_pk_bf16(o, on);
    }
}

__device__ __forceinline__ void phase_qkfin(const Ctx& C, CPtrs& P) {
    unsigned char* ws = P.ws; const float* ctl = (const float*)(ws + WS_CTL); bf16_t* QB = (bf16_t*)(ws + WS_QB); bf16_t* KN = (bf16_t*)(ws + WS_KN);
    const float* RPT = (const float*)(ws + WS_RPT); const f32x2* tab = (const f32x2*)(ws + WS_ROPE);
    const float* gqn = P.in[19]; const float* gqp = P.in[20]; const float* gkn = P.in[28];
    const int gw = C.vcu * NWAVES + C.wave, NGW = C.G * NWAVES, lane = C.lane;
    for (int row = gw; row < TP; row += NGW) {
        const int pos = row & (SEQ - 1);
        const float* sq = ctl + F_SSQQ + (size_t)row * 16;
#pragma unroll
        for (int it = 0; it < 2; ++it) { const int h = 4 * it + (lane >> 4), c = lane & 15; bf16_t* p = QB + (size_t)row * NQ + HD * h + 8 * c;
            const float rs = rsq(sq[2 * h] * (1.0f / 128) + EPS) * QSCALE; float x[8]; unpack8f(*(const v4u*)p, x);
#pragma unroll
            for (int e = 0; e < 8; ++e) x[e] = x[e] * rs * gqn[8 * c + e];
            *(v4u*)p = pack8f(x); }
        { const int h = lane >> 3, c = lane & 7; bf16_t* p = QB + (size_t)row * NQ + HD * h + 128 + 8 * c;
            const float rs = rsq(sq[2 * h + 1] * (1.0f / 64) + EPS); float x[8], y[8]; unpack8f(*(const v4u*)p, x);
#pragma unroll
            for (int e = 0; e < 8; ++e) x[e] = x[e] * rs * gqp[8 * c + e];
#pragma unroll
            for (int e = 0; e < 8; ++e) { const float pr = __shfl_xor(x[e], 4); const f32x2 cs = tab[pos * 32 + ((8 * c + e) & 31)];
                y[e] = (c < 4 ? x[e] * cs.x - pr * cs.y : x[e] * cs.x + pr * cs.y) * QSCALE; }
            *(v4u*)p = pack8f(y); }
#pragma unroll
        for (int jj = 0; jj < 2; ++jj) { const int ci = lane + 64 * jj, h = ci >> 4, c = ci & 15; bf16_t* p = KN + (size_t)row * D + 128 * h + 8 * c;
            const float rs = rsq((RPT[(size_t)(2 * h) * T + row] + RPT[(size_t)(2 * h + 1) * T + row]) * (1.0f / 128) + EPS); float x[8]; unpack8f(*(const v4u*)p, x);
#pragma unroll
            for (int e = 0; e < 8; ++e) x[e] = x[e] * rs * gkn[8 * c + e];
            *(v4u*)p = pack8f(x); }
    }
    { float* RP = (float*)(ws + WS_RP);
      for (size_t i = (size_t)C.vcu * (NWAVES * 64) + C.tid; i < (size_t)NH * (NCK / 4); i += (size_t)C.G * (NWAVES * 64)) { const size_t h = i / (NCK / 4), k4 = i % (NCK / 4);
          f32x4* p0 = (f32x4*)(RP + (2 * h) * NCK) + k4; const f32x4 a = *p0, c = *((const f32x4*)(RP + (2 * h + 1) * NCK) + k4); f32x4 r;
#pragma unroll
          for (int e = 0; e < 4; ++e) r[e] = rsq((a[e] + c[e]) * (1.0f / 128) + EPS);
          *p0 = r; } }
    { float* RTS = (float*)(ws + WS_RTS);
      for (int i = C.vcu * (NWAVES * 64) + C.tid; i < TS * NH; i += C.G * (NWAVES * 64)) { const int rsi = i >> 3, h = i & 7; const size_t rw = (size_t)TP + rsi;
          RTS[i] = rsq((RPT[(size_t)(2 * h) * T + rw] + RPT[(size_t)(2 * h + 1) * T + rw]) * (1.0f / 128) + EPS); } }
    {
        LAS float* A = (LAS float*)(C.lds + RING_OFF); LAS float* R = A + 128; LAS float* PP = A + 256;
        const bf16_t* WUK = (const bf16_t*)(ws + WS_WUKV); bf16_t* QS = (bf16_t*)(ws + WS_QS);
        for (int item = C.vcu; item < TS * NH; item += C.G) {
            const int rsi = item >> 3, h = item & 7, row = TP + rsi, tid = C.tid;
            const float* sq = ctl + F_SSQQ + (size_t)row * 16;
            if (tid < 128) A[tid] = bf2f(QB[(size_t)row * NQ + HD * h + tid]) * rsq(sq[2 * h] * (1.0f / 128) + EPS) * gqn[tid] * gkn[tid];
            else if (tid < 192) { const int e = tid - 128; R[e] = bf2f(QB[(size_t)row * NQ + HD * h + 128 + e]) * rsq(sq[2 * h + 1] * (1.0f / 64) + EPS) * gqp[e]; }
            __syncthreads();
            if (tid < 64) { const int e = tid, pos = SEQ + (rsi & 3); const float x = R[e], pr = R[e ^ 32]; const f32x2 cs = tab[pos * 32 + (e & 31)];
                const float o = (e < 32 ? x * cs.x - pr * cs.y : x * cs.x + pr * cs.y) * QSCALE;
                QS[(size_t)item * 320 + 256 + e] = (bf16_t)(cvt_pk_bf16(o, 0.f) & 0xffffu); }
            { const int n = tid & 255, half = tid >> 8; float acc = 0.f;
#pragma unroll 8
              for (int d = 64 * half; d < 64 * half + 64; ++d) acc += bf2f(WUK[(size_t)uk_row(h, d) * KVR + n]) * A[d];
              PP[half * 256 + n] = acc; }
            __syncthreads();
            if (tid < 256) QS[(size_t)item * 320 + tid] = (bf16_t)(cvt_pk_bf16((PP[tid] + PP[256 + tid]) * QSCALE, 0.f) & 0xffffu);
            __syncthreads();
        }
    }
}

__device__ __forceinline__ void phase_scomb(const Ctx& C, CPtrs& P) {
    unsigned char* ws = P.ws; const float* PO = (const float*)(ws + WS_PO); const float* PML = (const float*)(ws + WS_PML); bf16_t* OB = (bf16_t*)(ws + WS_OB);
    const float* wuv = P.in[27];
    LAS float* OL = (LAS float*)(C.lds + RING_OFF); LAS float* PT = OL + 256;
    for (int item = C.vcu; item < TS * NH; item += C.G) {
        const int rsi = item >> 3, h = item & 7, b = rsi >> 2, q = rsi & 3, rho = q * 8 + h, tid = C.tid;
        const size_t i0 = (size_t)(b * 2 + 0) * 32 + rho, i1 = (size_t)(b * 2 + 1) * 32 + rho;
        const float m0 = PML[i0 * 2], l0 = PML[i0 * 2 + 1], m1 = PML[i1 * 2], l1 = PML[i1 * 2 + 1];
        const float mm = fmaxf(m0, m1), f0 = __builtin_amdgcn_exp2f(m0 - mm), f1 = __builtin_amdgcn_exp2f(m1 - mm), inv = 1.0f / (l0 * f0 + l1 * f1);
        if (tid < 256) OL[tid] = (PO[i0 * 256 + tid] * f0 + PO[i1 * 256 + tid] * f1) * inv;
        __syncthreads();
        { const int d = tid & 127, nq = tid >> 7; float acc = 0.f;
#pragma unroll 8
          for (int n = 64 * nq; n < 64 * nq + 64; ++n) acc += OL[n] * wuv[(size_t)n * D + 128 * h + d];
          PT[nq * 128 + d] = acc; }
        __syncthreads();
        if (tid < 128) { const float o = (PT[tid] + PT[128 + tid]) + (PT[256 + tid] + PT[384 + tid]);
            const float on = __shfl_xor(o, 1);
            if ((tid & 1) == 0) *(unsigned*)(OB + (size_t)(TP + rsi) * D + 128 * h + tid) = cvt_pk_bf16(o, on); }
        __syncthreads();
    }
}

namespace att {
typedef short bf16x8 __attribute__((ext_vector_type(8)));
typedef short s16x4 __attribute__((ext_vector_type(4)));
typedef float f32x16 __attribute__((ext_vector_type(16)));
typedef float f32x4 __attribute__((ext_vector_type(4)));
typedef unsigned u32x4 __attribute__((ext_vector_type(4)));
constexpr float THR = 11.5f;
#define SBAR() __builtin_amdgcn_sched_barrier(0)
__device__ __forceinline__ int crow(int r, int hi) { return (r & 3) + 8 * (r >> 2) + 4 * hi; }
__device__ __forceinline__ unsigned cvtpk(float lo, float hi) { unsigned r; asm volatile("v_cvt_pk_bf16_f32 %0, %1, %2" : "=v"(r) : "v"(lo), "v"(hi)); return r; }
__device__ __forceinline__ float xmax32(float v) { auto rr = __builtin_amdgcn_permlane32_swap(__float_as_uint(v), __float_as_uint(v), false, false); return fmaxf(__uint_as_float(rr[0]), __uint_as_float(rr[1])); }
__device__ __forceinline__ float xsum32(float v) { auto rr = __builtin_amdgcn_permlane32_swap(__float_as_uint(v), __float_as_uint(v), false, false); return __uint_as_float(rr[0]) + __uint_as_float(rr[1]); }
#define PK4(P, B_, OUT) do { unsigned a0 = cvtpk(P[B_+0], P[B_+1]), a1 = cvtpk(P[B_+2], P[B_+3]);                          \
        unsigned b0 = cvtpk(P[B_+4], P[B_+5]), b1 = cvtpk(P[B_+6], P[B_+7]);                                             \
        auto r0 = __builtin_amdgcn_permlane32_swap(a0, b0, false, false); auto r1 = __builtin_amdgcn_permlane32_swap(a1, b1, false, false); \
        u32x4 w = {r0[0], r1[0], r0[1], r1[1]}; OUT = *reinterpret_cast<bf16x8*>(&w); } while (0)

namespace pa {
constexpr int KVBLK = 64, QBLK = 32, QB = 256;
constexpr int SHM_V = 16384, SHM_K = 16384, SHM_R = 8192;
constexpr int OFF_V = 0, OFF_K = 2 * SHM_V, OFF_R = OFF_K + 2 * SHM_K, OFF_WS = OFF_R + 2 * SHM_R;
#define KSWZ(row, colB) ((row) * 256 + ((colB) ^ (((row) & 7) << 4)))
__device__ __forceinline__ int v_st(int k, int c) { const int kk = (k & ~0xC) | ((k & 4) << 1) | ((k & 8) >> 1); return ((kk >> 3) * 4 + (c >> 5)) * 512 + ((kk & 7) * 32 + (c & 31)) * 2; }
__device__ __forceinline__ int v_rd_base(int lane) { return ((lane & 3) << 3) | (((lane >> 2) & 3) << 6) | (((lane >> 4) & 1) << 5) | (((lane >> 5) & 1) << 8); }
constexpr int v_rd_off(int d0, int ks, int half) { return d0 * 512 + ks * 4096 + half * 2048; }
__device__ __forceinline__ void mask_tile(f32x16& p0, f32x16& p1, int dq) {
    const float NEG = -__builtin_inff();
#pragma unroll
    for (int r = 0; r < 16; ++r) { const int c = (r & 3) + 8 * (r >> 2); if (dq - c < 0) p0[r] = NEG; if (dq - c - 32 < 0) p1[r] = NEG; }
}
__device__ __forceinline__ void softmax_tile(f32x16& p0, f32x16& p1, float& m_reg, float& l_reg, float& alpha, bf16x8& pa0, bf16x8& pa1, bf16x8& pa2, bf16x8& pa3) {
    float pmax = p0[0];
#pragma unroll
    for (int r = 1; r < 16; ++r) pmax = fmaxf(pmax, p0[r]);
#pragma unroll
    for (int r = 0; r < 16; ++r) pmax = fmaxf(pmax, p1[r]);
    pmax = xmax32(pmax);
    float mn;
    if (__builtin_expect(__all((pmax - m_reg) <= THR), 1)) { mn = m_reg; alpha = 1.f; }
    else { mn = fmaxf(m_reg, pmax); alpha = __builtin_amdgcn_exp2f(m_reg - mn); m_reg = mn; }
#pragma unroll
    for (int r = 0; r < 16; ++r) { p0[r] = __builtin_amdgcn_exp2f(p0[r] - mn); p1[r] = __builtin_amdgcn_exp2f(p1[r] - mn); }
    float ps = 0.f;
#pragma unroll
    for (int r = 0; r < 16; ++r) ps += p0[r];
#pragma unroll
    for (int r = 0; r < 16; ++r) ps += p1[r];
    ps = xsum32(ps);
    l_reg = l_reg * alpha + ps;
    PK4(p0, 0, pa0); PK4(p0, 8, pa1); PK4(p1, 0, pa2); PK4(p1, 8, pa3);
}
template <int KB>
__device__ __forceinline__ void qkt(f32x16& p0, f32x16& p1, const char* lds, int r32, int hi, const bf16x8* qr) {
    p0 = f32x16{}; p1 = f32x16{};
    const char* kb[4];
#pragma unroll
    for (int dd = 0; dd < 4; ++dd) kb[dd] = lds + OFF_K + KB * SHM_K + KSWZ(r32, (dd * 16 + hi * 8) * 2);
#pragma unroll
    for (int d0 = 0; d0 < 8; ++d0) { const char* a = kb[d0 & 3] + (d0 >> 2) * 128;
        const bf16x8 b0 = *reinterpret_cast<const bf16x8*>(a), b1 = *reinterpret_cast<const bf16x8*>(a + 32 * 256);
        p0 = __builtin_amdgcn_mfma_f32_32x32x16_bf16(b0, qr[d0], p0, 0, 0, 0);
        p1 = __builtin_amdgcn_mfma_f32_32x32x16_bf16(b1, qr[d0], p1, 0, 0, 0); }
    const int sw = (r32 >> 1) & 7; const char* rb = lds + OFF_R + KB * SHM_R + r32 * 128;
#pragma unroll
    for (int s = 0; s < 4; ++s) { const char* a = rb + (((2 * s + hi) ^ sw) << 4);
        const bf16x8 b0 = *reinterpret_cast<const bf16x8*>(a), b1 = *reinterpret_cast<const bf16x8*>(a + 32 * 128);
        p0 = __builtin_amdgcn_mfma_f32_32x32x16_bf16(b0, qr[8 + s], p0, 0, 0, 0);
        p1 = __builtin_amdgcn_mfma_f32_32x32x16_bf16(b1, qr[8 + s], p1, 0, 0, 0); }
}
template <int VB>
__device__ __forceinline__ void pv_tile(f32x16* o, int vb0, bf16x8 pa0, bf16x8 pa1, bf16x8 pa2, bf16x8 pa3) {
#define TRRD(dst, off) asm volatile("ds_read_b64_tr_b16 %0, %1 offset:%2" : "=&v"(dst) : "v"(vb0), "i"(off) : "memory")
#define PV_D0(d0) do { s16x4 l0, l1, l2, l3, h0, h1, h2, h3; constexpr int b_ = OFF_V + VB * SHM_V + v_rd_off(d0, 0, 0);   \
        TRRD(l0, b_); TRRD(h0, b_ + 2048); TRRD(l1, b_ + 4096); TRRD(h1, b_ + 6144); TRRD(l2, b_ + 8192); TRRD(h2, b_ + 10240); TRRD(l3, b_ + 12288); TRRD(h3, b_ + 14336); \
        asm volatile("s_waitcnt lgkmcnt(0)" ::: "memory"); SBAR();   \
        o[d0] = __builtin_amdgcn_mfma_f32_32x32x16_bf16(pa0, (bf16x8){l0[0], l0[1], l0[2], l0[3], h0[0], h0[1], h0[2], h0[3]}, o[d0], 0, 0, 0);   \
        o[d0] = __builtin_amdgcn_mfma_f32_32x32x16_bf16(pa1, (bf16x8){l1[0], l1[1], l1[2], l1[3], h1[0], h1[1], h1[2], h1[3]}, o[d0], 0, 0, 0);   \
        o[d0] = __builtin_amdgcn_mfma_f32_32x32x16_bf16(pa2, (bf16x8){l2[0], l2[1], l2[2], l2[3], h2[0], h2[1], h2[2], h2[3]}, o[d0], 0, 0, 0);   \
        o[d0] = __builtin_amdgcn_mfma_f32_32x32x16_bf16(pa3, (bf16x8){l3[0], l3[1], l3[2], l3[3], h3[0], h3[1], h3[2], h3[3]}, o[d0], 0, 0, 0); } while (0)
    PV_D0(0); PV_D0(1); PV_D0(2); PV_D0(3);
#undef PV_D0
#undef TRRD
}
__device__ __forceinline__ void unit(int b, int h, int qb, const bf16_t* __restrict__ QF, const bf16_t* __restrict__ KN, const bf16_t* __restrict__ KPE, const bf16_t* __restrict__ VBg, bf16_t* OB, char* lds) {
    const int tid = threadIdx.x, wid = __builtin_amdgcn_readfirstlane(tid >> 6), lane = tid & 63, r32 = lane & 31, hi = lane >> 5;
    const size_t rowb = (size_t)b * SEQ; const int q0 = qb * QB, qlo = q0 + wid * QBLK, qm = qlo + r32 - 4 * hi;
    const int NT = (q0 + QB) / KVBLK;
    float* wsf = (float*)(lds + OFF_WS) + wid * 64; float* li_l = wsf; float* al_l = wsf + 32;
    bf16x8 qr[12];
    { const bf16_t* qp = QF + (rowb + qlo + r32) * NQ + HD * h + hi * 8;
#pragma unroll
      for (int d0 = 0; d0 < 12; ++d0) qr[d0] = *reinterpret_cast<const bf16x8*>(qp + d0 * 16); }
    const int sr = tid >> 4, sc = (tid & 15) * 8, rr = tid >> 3, rc = tid & 7;
    const int kws = KSWZ(sr, sc * 2), vst0 = v_st(sr, sc), vst1 = v_st(32 + sr, sc), rws = rr * 128 + ((rc ^ ((rr >> 1) & 7)) << 4);
    const bf16_t* Kg = KN + (rowb + sr) * D + 128 * h + sc; const bf16_t* Vg = VBg + (rowb + sr) * D + 128 * h + sc; const bf16_t* Rg = KPE + (rowb + rr) * ROPE + rc * 8;
    bf16x8 st_k0, st_k1, st_v0, st_v1, st_r;
#define SLOAD(t) do { const size_t ko = (size_t)(t) * KVBLK * D; st_k0 = *reinterpret_cast<const bf16x8*>(Kg + ko); st_k1 = *reinterpret_cast<const bf16x8*>(Kg + ko + 32 * D); \
        st_v0 = *reinterpret_cast<const bf16x8*>(Vg + ko); st_v1 = *reinterpret_cast<const bf16x8*>(Vg + ko + 32 * D); st_r = *reinterpret_cast<const bf16x8*>(Rg + (size_t)(t) * KVBLK * ROPE); } while (0)
#define SWRITE(bf) do { *(bf16x8*)(lds + OFF_K + (bf) * SHM_K + kws) = st_k0; *(bf16x8*)(lds + OFF_K + (bf) * SHM_K + kws + 32 * 256) = st_k1; \
        *(bf16x8*)(lds + OFF_V + (bf) * SHM_V + vst0) = st_v0; *(bf16x8*)(lds + OFF_V + (bf) * SHM_V + vst1) = st_v1; *(bf16x8*)(lds + OFF_R + (bf) * SHM_R + rws) = st_r; } while (0)
    const int vb0 = (int)(uintptr_t)lds + v_rd_base(lane);
    float m_reg = -1e30f, l_reg = 0.f, alpha; f32x16 o[4] = {}; f32x16 p0, p1; bf16x8 pa0, pa1, pa2, pa3;
    SLOAD(0); SWRITE(0); __syncthreads();
#define STEP(t, CB) do { if ((t) + 1 < NT) SLOAD((t) + 1); SBAR();                                                            \
        qkt<CB>(p0, p1, lds, r32, hi, qr);                                                                                    \
        if (KVBLK * (t) + KVBLK - 1 > qlo) mask_tile(p0, p1, qm - KVBLK * (t));                                               \
        softmax_tile(p0, p1, m_reg, l_reg, alpha, pa0, pa1, pa2, pa3);                                                        \
        if (__any(alpha < 1.f)) { if (hi == 0) al_l[r32] = alpha; asm volatile("s_waitcnt lgkmcnt(0)" ::: "memory");         \
            _Pragma("unroll") for (int d_ = 0; d_ < 4; ++d_) _Pragma("unroll") for (int r = 0; r < 16; ++r) o[d_][r] *= al_l[crow(r, hi)]; } \
        SBAR(); pv_tile<CB>(o, vb0, pa0, pa1, pa2, pa3);                                                                      \
        if ((t) + 1 < NT) SWRITE(1 - (CB));                                                                                   \
        __syncthreads(); } while (0)
    for (int t = 0; t < NT; t += 2) { STEP(t, 0); STEP(t + 1, 1); }
#undef STEP
#undef SLOAD
#undef SWRITE
    if (hi == 0) li_l[r32] = l_reg; asm volatile("s_waitcnt lgkmcnt(0)" ::: "memory");
    float rli[16];
#pragma unroll
    for (int r = 0; r < 16; ++r) rli[r] = __builtin_amdgcn_rcpf(li_l[crow(r, hi)]);
    bf16_t* Ow = OB + (rowb + qlo) * D + 128 * h;
#pragma unroll
    for (int r = 0; r < 16; ++r) { const int orow = crow(r, hi);
#pragma unroll
        for (int d0 = 0; d0 < 4; ++d0) { const float v = o[d0][r] * rli[r]; const float vn = __shfl_xor(v, 1);
            if ((r32 & 1) == 0) *(unsigned*)(Ow + (size_t)orow * D + d0 * 32 + r32) = cvtpk(v, vn); } }
    __syncthreads();
}
}

namespace sa {
constexpr int TILE = 16384;
struct Src { const bf16_t* CLB; const bf16_t* CKB; const float* RP; const bf16_t* LATB; const bf16_t* KPEB; const float* RTS; };
template <bool TAIL>
__device__ __forceinline__ void tile(const Src& S, int b, int k0, LAS unsigned char* ldsu, char* lds, int wid, int lane, f32x16 (&o)[8], float& m_reg, float& l_reg, float* al_l) {
    asm volatile("" : "+v"(lane));
    const int r32 = lane & 31, hi = lane >> 5, h = r32 & 7;
    LAS unsigned char* tl = ldsu + wid * TILE; const char* tg = lds + wid * TILE;
    asm volatile("s_waitcnt lgkmcnt(0)" ::: "memory");
    {
        const int rlo = (lane >> 2) & 7, chh = lane >> 5, x4 = (lane >> 4) & 1;
        if constexpr (TAIL) {
            const char* ub = (const char*)(S.LATB + (size_t)(TP + 4 * b) * KVR);
#pragma unroll
            for (int P = 0; P < 16; ++P) { const int img = P >> 3, pp = P & 7, row = 8 * (pp >> 1) + rlo, ch = 8 * (pp & 1) + 4 * chh + ((lane & 3) ^ (2 * ((pp >> 1) & 1) + x4));
                const unsigned lo = (unsigned)((row < 3 ? row : 3) * (KVR * 2) + (128 * img + 8 * ch) * 2);
                __builtin_amdgcn_global_load_lds((const unsigned*)(ub + lo), (LAS unsigned*)(tl + P * 1024), 16, 0, 0); }
        } else {
            const char* ub = (const char*)(S.CLB + ((size_t)b * SEQ + k0) * KVR);
            const unsigned loA = (unsigned)(rlo * 512 + 64 * chh + 16 * ((lane & 3) ^ x4)), loB = (unsigned)(rlo * 512 + 64 * chh + 16 * ((lane & 3) ^ (2 + x4)));
#pragma unroll
            for (int P = 0; P < 16; ++P) { const int img = P >> 3, pp = P & 7; const unsigned cst = (unsigned)((8 * (pp >> 1)) * 512 + 256 * img + 128 * (pp & 1));
                __builtin_amdgcn_global_load_lds((const unsigned*)(ub + cst + (((pp >> 1) & 1) ? loB : loA)), (LAS unsigned*)(tl + P * 1024), 16, 0, 0); }
        }
    }
    bf16x8 kp[4]; float rf[16];
    {
        const bf16_t* kr = TAIL ? S.KPEB + (size_t)(TP + 4 * b + (r32 < 3 ? r32 : 3)) * ROPE : S.CKB + ((size_t)b * SEQ + k0 + r32) * ROPE;
#pragma unroll
        for (int s = 0; s < 4; ++s) kp[s] = *reinterpret_cast<const bf16x8*>(kr + 16 * s + 8 * hi);
        if constexpr (TAIL) {
#pragma unroll
            for (int r = 0; r < 16; ++r) { const int j = crow(r, hi), jc = j < 3 ? j : 3; rf[r] = S.RTS[(4 * b + jc) * 8 + h]; }
        } else {
            const float* r0 = S.RP + (size_t)(2 * h) * NCK + (size_t)b * SEQ + k0 + 4 * hi;
#pragma unroll
            for (int j = 0; j < 4; ++j) { const f32x4 a = *(const f32x4*)(r0 + 8 * j);
#pragma unroll
                for (int e = 0; e < 4; ++e) rf[4 * j + e] = a[e]; }
        }
    }
    asm volatile("s_waitcnt vmcnt(0)" ::: "memory");
    f32x16 p = {}, pn = {};
    {
        const int x = (r32 >> 2) & 3; const char* kbase = tg + 2048 * (r32 >> 3) + 64 * (r32 & 7);
        const char* kE = kbase + 16 * (hi ^ x); const char* kO = kbase + 16 * ((2 + hi) ^ x);
        const char* qb = lds + QS_OFF + r32 * QS_STRIDE + hi * 16;
#pragma unroll
        for (int s = 0; s < 4; ++s) p = __builtin_amdgcn_mfma_f32_32x32x16_bf16(kp[s], *reinterpret_cast<const bf16x8*>(qb + (16 + s) * 32), p, 0, 0, 0);
#pragma unroll
        for (int s = 0; s < 16; ++s) { const int img = s >> 3, ss = s & 7; const char* a = ((ss & 1) ? kO : kE) + 8192 * img + 512 * (ss >> 1);
            pn = __builtin_amdgcn_mfma_f32_32x32x16_bf16(*reinterpret_cast<const bf16x8*>(a), *reinterpret_cast<const bf16x8*>(qb + s * 32), pn, 0, 0, 0); }
    }
#pragma unroll
    for (int r = 0; r < 16; ++r) p[r] = pn[r] * rf[r] + p[r];
    if constexpr (TAIL) { const int q = r32 >> 3;
#pragma unroll
        for (int r = 0; r < 16; ++r) if (crow(r, hi) > q) p[r] = -__builtin_inff(); }
    float pmax = p[0];
#pragma unroll
    for (int r = 1; r < 16; ++r) pmax = fmaxf(pmax, p[r]);
    pmax = xmax32(pmax);
    float mn, alpha;
    if (__builtin_expect(__all((pmax - m_reg) <= THR), 1)) { mn = m_reg; alpha = 1.f; }
    else { mn = fmaxf(m_reg, pmax); alpha = __builtin_amdgcn_exp2f(m_reg - mn); m_reg = mn; }
    float ps = 0.f;
#pragma unroll
    for (int r = 0; r < 16; ++r) { p[r] = __builtin_amdgcn_exp2f(p[r] - mn); ps += p[r]; }
    ps = xsum32(ps); l_reg = l_reg * alpha + ps;
    bf16x8 pa0, pa1; PK4(p, 0, pa0); PK4(p, 8, pa1);
    if (__any(alpha < 1.f)) { if (hi == 0) al_l[r32] = alpha; asm volatile("s_waitcnt lgkmcnt(0)" ::: "memory");
#pragma unroll
        for (int c = 0; c < 8; ++c)
#pragma unroll
            for (int r = 0; r < 16; ++r) o[c][r] *= al_l[crow(r, hi)]; }
    {
        const int hh = lane >> 5, blk = (lane >> 4) & 1, q4 = (lane & 15) >> 2, pp = lane & 3;
        const int tb = (int)(uintptr_t)tg + 2048 * hh + 64 * q4 + 8 * (pp & 1);
        const int t0 = tb + 16 * ((2 * blk + (pp >> 1)) ^ (2 * hh)), t1 = tb + 256 + 16 * ((2 * blk + (pp >> 1)) ^ (2 * hh + 1));
#define TR0(dst, off) asm volatile("ds_read_b64_tr_b16 %0, %1 offset:%2" : "=&v"(dst) : "v"(t0), "i"(off) : "memory")
#define TR1(dst, off) asm volatile("ds_read_b64_tr_b16 %0, %1 offset:%2" : "=&v"(dst) : "v"(t1), "i"(off) : "memory")
#define PVC(c) do { s16x4 a0, a1, b0, b1; constexpr int f_ = 8192 * ((c) >> 2) + 512 * ((c) & 3);                               \
        TR0(a0, f_); TR1(a1, f_); TR0(b0, f_ + 4096); TR1(b1, f_ + 4096);                                                        \
        asm volatile("s_waitcnt lgkmcnt(0)" ::: "memory"); SBAR();                                                                \
        o[c] = __builtin_amdgcn_mfma_f32_32x32x16_bf16(pa0, (bf16x8){a0[0], a0[1], a0[2], a0[3], a1[0], a1[1], a1[2], a1[3]}, o[c], 0, 0, 0); \
        o[c] = __builtin_amdgcn_mfma_f32_32x32x16_bf16(pa1, (bf16x8){b0[0], b0[1], b0[2], b0[3], b1[0], b1[1], b1[2], b1[3]}, o[c], 0, 0, 0); } while (0)
        PVC(0); PVC(1); PVC(2); PVC(3); PVC(4); PVC(5); PVC(6); PVC(7);
#undef PVC
#undef TR0
#undef TR1
    }
}
__device__ __forceinline__ void unit(const Src& S, const bf16_t* QS, float* PO, float* PML, int b, int s, LAS unsigned char* ldsu, char* lds) {
    const int tid = threadIdx.x, wid = __builtin_amdgcn_readfirstlane(tid >> 6), lane = tid & 63, r32 = lane & 31, hi = lane >> 5;
    for (int c = tid; c < 32 * 40; c += 512) { const int rho = c / 40, ch = c % 40; *(v4u*)(lds + QS_OFF + rho * QS_STRIDE + ch * 16) = *(const v4u*)(QS + ((size_t)b * 32 + rho) * 320 + ch * 8); }
    __syncthreads();
    float* al_l = (float*)(lds + SCR_OFF) + wid * 64;
    float m_reg = -1e30f, l_reg = 0.f; f32x16 o[8] = {};
    const int kbase = (8 * s + wid) * 512;
    for (int i = 0; i < 16; ++i) tile<false>(S, b, kbase + 32 * i, ldsu, lds, wid, lane, o, m_reg, l_reg, al_l);
    if (s == 1 && wid == 7) tile<true>(S, b, 0, ldsu, lds, wid, lane, o, m_reg, l_reg, al_l);
    asm volatile("s_waitcnt lgkmcnt(0)" ::: "memory");
    __syncthreads();
    float* ST = (float*)(lds + 32768);
    float* OL = (float*)lds;
    if (hi == 0) { ST[(wid * 32 + r32) * 2] = m_reg; ST[(wid * 32 + r32) * 2 + 1] = l_reg; }
    __syncthreads();
    float sc[16];
#pragma unroll
    for (int r = 0; r < 16; ++r) { const int row = crow(r, hi); float M = ST[row * 2];
#pragma unroll
        for (int w = 1; w < 8; ++w) M = fmaxf(M, ST[(w * 32 + row) * 2]);
        sc[r] = __builtin_amdgcn_exp2f(ST[(wid * 32 + row) * 2] - M); }
    for (int w = 0; w < 8; ++w) {
        if (wid == w) {
#pragma unroll
            for (int c = 0; c < 8; ++c)
#pragma unroll
                for (int r = 0; r < 16; ++r) { float* d = OL + crow(r, hi) * 256 + 32 * c + r32; const float v = o[c][r] * sc[r]; *d = (w == 0) ? v : *d + v; }
        }
        __syncthreads();
    }
    if (tid < 32) { float M = ST[tid * 2];
        for (int w = 1; w < 8; ++w) M = fmaxf(M, ST[(w * 32 + tid) * 2]);
        float L = 0.f; for (int w = 0; w < 8; ++w) L += ST[(w * 32 + tid) * 2 + 1] * __builtin_amdgcn_exp2f(ST[(w * 32 + tid) * 2] - M);
        PML[((size_t)(b * 2 + s) * 32 + tid) * 2] = M; PML[((size_t)(b * 2 + s) * 32 + tid) * 2 + 1] = L; }
    for (int c = tid; c < 32 * 64; c += 512) *((f32x4*)(PO + (size_t)(b * 2 + s) * 32 * 256) + c) = *((const f32x4*)OL + c);
    __syncthreads();
}
}
#undef SBAR
#undef PK4
}

#ifndef MK_SPLIT
#define MK_SPLIT 0
#endif
constexpr int NPHASE = 19;
struct Args { Ptrs P; int ph_lo, ph_hi; };
typedef const __attribute__((address_space(4))) Args CArgs;
__global__ void __launch_bounds__(NWAVES * 64, 2) fwd(Args args) {
    extern __shared__ __attribute__((aligned(16))) unsigned char lds[];
    Ctx C; C.lds = (LAS unsigned char*)lds; C.tid = threadIdx.x; C.lane = C.tid & 63; C.wave = __builtin_amdgcn_readfirstlane(C.tid >> 6);
    C.G = gridDim.x; { const int bx = blockIdx.x; C.vcu = (C.G % 8 == 0) ? (bx % 8) * (C.G / 8) + bx / 8 : bx; }
    volatile LAS unsigned* MISC = (volatile LAS unsigned*)(C.lds + MISC_OFF);
    if (C.tid < 32) MISC[C.tid] = 0u;
    __syncthreads();
    XcdBarrier bar; bar.bar = (unsigned*)(args.P.ws + WS_CTL) + CW_BAR; bar.x = 0; bar.st = nullptr;
    if (!MK_SPLIT) bar = xcd_barrier_post((unsigned*)(args.P.ws + WS_CTL) + CW_BAR, MISC + 8);
    const int lo = args.ph_lo, hi = args.ph_hi;
#ifndef PHASE_MASK
#define PHASE_MASK 0xFFFFFFFFu
#endif
#define IN(k) (((PHASE_MASK >> (k)) & 1u) && lo <= (k) && (k) < hi)
#define SEAM(k) do { if (IN(k) && IN((k) + 1)) xcd_barrier(bar); } while (0)
#define PH_BEGIN CArgs* ka_ = (CArgs*)__builtin_amdgcn_kernarg_segment_ptr(); asm volatile("" : "+s"(ka_)); CPtrs& P = ka_->P; unsigned char* ws = P.ws; float* ctl = (float*)(ws + WS_CTL); \
        bf16_t* XB = (bf16_t*)(ws + WS_XB); bf16_t* HB = (bf16_t*)(ws + WS_HB); float* X = P.out + OUT_Y; float* ssqx = ctl + F_SSQX; (void)XB; (void)HB; (void)X; (void)ssqx; (void)ctl;
    LAS unsigned char* ring = C.lds + RING_OFF;
    const int bx = (int)blockIdx.x;
#define GEMM(EPI, Aptr, Bptr, M_, N_, K_, Eobj) do { int k_ = (K_); asm volatile("" : "+s"(k_));   \
        pg8::Gemm g{(const bf16_t*)(Aptr), (const bf16_t*)(Bptr), (M_), (N_), k_}; pg8::StaticOrder S; S.init((M_), (N_), C.G, bx); \
        pg8::gemm_phase<EPI, pg8::StaticOrder, PG8_ALIGN, PG8_SP2>(ring, g, S, Eobj); } while (0)

    if (IN(0)) { PH_BEGIN phase_prologue(C, P); } SEAM(0);
    if (IN(1)) { PH_BEGIN epi::Swiglu E{HB, ssqx + 0 * T, nullptr, nullptr, nullptr, 22}; GEMM(epi::Swiglu, XB, ws + WS_WGU0, T, 2 * FF, D, E); } SEAM(1);
    if (IN(2)) { PH_BEGIN epi::Resid E{X, XB, ssqx + 1 * T, 0.5f}; GEMM(epi::Resid, HB, ws + WS_WDN0, T, D, FF, E); } SEAM(2);
    if (IN(3)) { PH_BEGIN epi::ConvIn E{(bf16_t*)(ws + WS_BB), (bf16_t*)(ws + WS_UB), ssqx + 1 * T, P.out + OUT_CSP, P.out + OUT_CSS}; GEMM(epi::ConvIn, XB, ws + WS_WCI, T, 3 * D, D, E); } SEAM(3);
    if (IN(4)) { PH_BEGIN phase_conv(C, P); } SEAM(4);
    if (IN(5)) { PH_BEGIN epi::Resid E{X, XB, ssqx + 2 * T, 1.0f}; GEMM(epi::Resid, ws + WS_ZB, ws + WS_WCO, T, D, D, E); } SEAM(5);
    if (IN(6)) { PH_BEGIN epi::Swiglu E{HB, ssqx + 2 * T, nullptr, nullptr, nullptr, 22}; GEMM(epi::Swiglu, XB, ws + WS_WGU1, T, 2 * FF, D, E); } SEAM(6);
    if (IN(7)) { PH_BEGIN epi::Resid E{X, XB, ssqx + 3 * T, 0.5f}; GEMM(epi::Resid, HB, ws + WS_WDN1, T, D, FF, E); } SEAM(7);
    if (IN(8)) { PH_BEGIN epi::Swiglu E{HB, ssqx + 3 * T, (float*)(ws + WS_CKV), ctl + F_SSQLAT, ctl + F_SSQKPE, 22}; GEMM(epi::Swiglu, XB, ws + WS_WGU2, T, 2 * FF + 512, D, E); } SEAM(8);
    if (IN(9)) { PH_BEGIN epi::Resid E{X, XB, ssqx + 4 * T, 0.5f}; GEMM(epi::Resid, HB, ws + WS_WDN2, T, D, FF, E); phase_kvfin(C, P); } SEAM(9);
    if (IN(10)) { PH_BEGIN { epi::Dq E{(bf16_t*)(ws + WS_CQB), ssqx + 4 * T, ctl + F_SSQCQ}; GEMM(epi::Dq, XB, ws + WS_WDQ, T, QRANK, D, E); }
                  { epi::Kv E{(bf16_t*)(ws + WS_KN), (bf16_t*)(ws + WS_VB), (float*)(ws + WS_RPT), (size_t)T}; GEMM(epi::Kv, ws + WS_LATB, ws + WS_WUKV, T, 2 * D, KVR, E); } } SEAM(10);
    if (IN(11)) { PH_BEGIN epi::Uq E{(bf16_t*)(ws + WS_QB), ctl + F_SSQCQ, ctl + F_SSQQ}; GEMM(epi::Uq, ws + WS_CQB, ws + WS_WUQ, T, NQ, QRANK, E); } SEAM(11);
    if (IN(12)) { PH_BEGIN epi::Kv E{nullptr, nullptr, (float*)(ws + WS_RP), (size_t)NCK}; GEMM(epi::Kv, ws + WS_CLB, ws + WS_WUKV, NCK, D, KVR, E); } SEAM(12);
    if (IN(13)) { PH_BEGIN phase_qkfin(C, P); } SEAM(13);
    if (IN(14)) { PH_BEGIN
        const bf16_t* QF = (const bf16_t*)(ws + WS_QB); const bf16_t* KN = (const bf16_t*)(ws + WS_KN); const bf16_t* KPE = (const bf16_t*)(ws + WS_KPEB);
        const bf16_t* VBp = (const bf16_t*)(ws + WS_VB); bf16_t* OB = (bf16_t*)(ws + WS_OB);
#ifndef ATT_SEL
#define ATT_SEL 3
#endif
        if (ATT_SEL & 1) for (int v = C.vcu; v < 256; v += C.G) { const int bh = v >> 4, s = v & 15;
            att::pa::unit(bh >> 3, bh & 7, s, QF, KN, KPE, VBp, OB, (char*)lds);
            att::pa::unit(bh >> 3, bh & 7, 31 - s, QF, KN, KPE, VBp, OB, (char*)lds); }
        att::sa::Src S{(const bf16_t*)(ws + WS_CLB), (const bf16_t*)(ws + WS_CKB), (const float*)(ws + WS_RP), (const bf16_t*)(ws + WS_LATB), KPE, (const float*)(ws + WS_RTS)};
        if (ATT_SEL & 2) for (int v = C.vcu; v < 2 * DB; v += C.G) att::sa::unit(S, (const bf16_t*)(ws + WS_QS), (float*)(ws + WS_PO), (float*)(ws + WS_PML), v >> 1, v & 1, C.lds, (char*)lds);
    } SEAM(14);
    if (IN(15)) { PH_BEGIN phase_scomb(C, P); } SEAM(15);
    if (IN(16)) { PH_BEGIN epi::Resid E{X, XB, ssqx + 5 * T, 1.0f}; GEMM(epi::Resid, ws + WS_OB, ws + WS_WO, T, D, D, E); } SEAM(16);
    if (IN(17)) { PH_BEGIN epi::Swiglu E{HB, ssqx + 5 * T, nullptr, nullptr, nullptr, 22}; GEMM(epi::Swiglu, XB, ws + WS_WGU3, T, 2 * FF, D, E); } SEAM(17);
    if (IN(18)) { PH_BEGIN epi::Resid E{X, nullptr, nullptr, 0.5f}; GEMM(epi::Resid, HB, ws + WS_WDN3, T, D, FF, E); }
#undef IN
#undef SEAM
#undef GEMM
}

extern "C" void kernel_launch(void* const* d_in, const int* in_sizes, int n_in, void* d_out, int out_size, void* d_ws, size_t ws_size, hipStream_t stream) {
    static int grid = 0;
    if (grid == 0) {
        if (n_in != 29 || out_size != (int)OUT_TOTAL || ws_size < WS_END) { fprintf(stderr, "kernel_launch: unexpected shapes (n_in %d, out %d, ws %zu); nothing launched\n", n_in, out_size, ws_size); grid = -1; return; }
        int dev = 0, cus = 0, per_cu = 0;
        if (hipGetDevice(&dev) != hipSuccess || hipDeviceGetAttribute(&cus, hipDeviceAttributeMultiprocessorCount, dev) != hipSuccess) { grid = -1; return; }
        if (hipFuncSetAttribute((const void*)fwd, hipFuncAttributeMaxDynamicSharedMemorySize, LDS_BYTES) != hipSuccess) { fprintf(stderr, "kernel_launch: hipFuncSetAttribute failed\n"); grid = -1; return; }
        if (hipOccupancyMaxActiveBlocksPerMultiprocessor(&per_cu, (const void*)fwd, NWAVES * 64, LDS_BYTES) != hipSuccess || per_cu < 1)
            fprintf(stderr, "kernel_launch: note: occupancy query reports %d workgroups per CU\n", per_cu);
        (void)hipGetLastError();
        grid = cus;
    }
    if (grid < 0) return;
    if (hipMemsetAsync((char*)d_ws + WS_CTL, 0, CTL_BYTES, stream) != hipSuccess) { fprintf(stderr, "kernel_launch: memset failed\n"); return; }
    Args a{};
    for (int i = 0; i < 29; ++i) a.P.in[i] = (const float*)d_in[i];
    a.P.out = (float*)d_out; a.P.ws = (unsigned char*)d_ws;
#if MK_SPLIT
    for (int ph = 0; ph < NPHASE; ++ph) { a.ph_lo = ph; a.ph_hi = ph + 1; hipLaunchKernelGGL(fwd, dim3(grid), dim3(NWAVES * 64), LDS_BYTES, stream, a); }
#else
    a.ph_lo = 0; a.ph_hi = NPHASE;
    hipLaunchKernelGGL(fwd, dim3(grid), dim3(NWAVES * 64), LDS_BYTES, stream, a);
#endif
    const hipError_t le = hipPeekAtLastError();
    if (le != hipSuccess) fprintf(stderr, "kernel_launch: launch failed: %s\n", hipGetErrorName(le));
}
```

```cpp
#include <hip/hip_runtime.h>
#include <cstdio>
#include <cstdint>
namespace pg8 {
#define PG8_LAS __attribute__((address_space(3)))
typedef unsigned short bf16_t;
typedef short bf16x8 __attribute__((ext_vector_type(8)));
typedef float f32x4 __attribute__((ext_vector_type(4)));
typedef unsigned u32x4 __attribute__((ext_vector_type(4)));
constexpr int BM = 256, BK = 64, HALF = 128, HTB = HALF * BK * 2  , STAGE_BYTES = 8 * HTB, NXCD = 8, WGM = 8;

__host__ __device__ __forceinline__ int lds_byte(int r, int c) { const int st = (r >> 4) * 2 + (c >> 5), rr = r & 15, cc = c & 31, ob = rr * 64 + cc * 2; return st * 1024 + (ob ^ (((ob >> 9) & 1) << 5)); }
__host__ __device__ __forceinline__ void stage_rc(int b, int& R, int& C) { const int st = b / 1024, sb = b % 1024, swz = sb ^ (((sb >> 9) & 1) << 5); R = (st >> 1) * 16 + swz / 64; C = (st & 1) * 32 + (swz % 64) / 2; }
__host__ __device__ __forceinline__ int perm32(int rho) { const int n = rho >> 4, i = rho & 15; return 8 * (i >> 2) + 4 * n + (i & 3); }

struct Unit { int pm, pn; int ko; };
struct Gemm { const bf16_t* A; const bf16_t* Bt; int M, N, K; int ld; };

struct StaticOrder {
    int nM, nN, nwg, G, c;
    __host__ __device__ void init(int M, int N, int G_, int c_) { nM = M / BM; nN = N / BM; nwg = nM * nN; G = G_; c = c_; }
    __host__ __device__ bool next(int i, Unit& u) const {
        const long L = (long)i * G + c; if (L >= nwg) return false;
        int wgid = (int)L; { const int q = nwg / NXCD, r = nwg % NXCD, xcd = wgid % NXCD, off = wgid / NXCD; wgid = (xcd < r ? xcd * (q + 1) : r * (q + 1) + (xcd - r) * q) + off; }
        const int nig = WGM * nN, gid = wgid / nig, fm = gid * WGM, gsz = (nM - fm) < WGM ? (nM - fm) : WGM;
        u.pm = fm + ((wgid % nig) % gsz); u.pn = (wgid % nig) / gsz; u.ko = 0; return true;
    }
    __device__ __forceinline__ void a_ready(const Unit&) const {}
    __device__ __forceinline__ void done(const Unit&) const {}
};

__device__ __forceinline__ unsigned cvt_pk_bf16(float lo, float hi) { unsigned r; asm volatile("v_cvt_pk_bf16_f32 %0, %1, %2" : "=v"(r) : "v"(lo), "v"(hi)); return r; }
typedef float f32x2 __attribute__((ext_vector_type(2)));
typedef int i32x4 __attribute__((ext_vector_type(4)));
template <bool I8> __device__ __forceinline__ f32x4 mma16(bf16x8 b, bf16x8 a, f32x4 c) {
    if constexpr (I8) return __builtin_bit_cast(f32x4, __builtin_amdgcn_mfma_i32_16x16x64_i8(__builtin_bit_cast(i32x4, b), __builtin_bit_cast(i32x4, a), __builtin_bit_cast(i32x4, c), 0, 0, 0));
    else return __builtin_amdgcn_mfma_f32_16x16x32_bf16(b, a, c, 0, 0, 0);
}
template <class Epi, class Sched, bool ALIGN_EPI = false, bool SP2 = false, bool I8 = false>
__device__ __forceinline__ void gemm_phase(PG8_LAS unsigned char* lds, const Gemm g, const Sched& S, const Epi& E) {
    int tid_ = threadIdx.x; asm volatile("" : "+v"(tid_));
    const int tid = tid_, wid = __builtin_amdgcn_readfirstlane(tid >> 6), lane = tid & 63, wr = wid >> 2, wc = wid & 3, fr = lane & 15, fq = lane >> 4;
    const int K = g.K, nt = K / BK;
    unsigned voffA[2], voffB[2];
#pragma unroll
    for (int i = 0; i < 2; ++i) { int R, C; stage_rc(tid * 16 + i * 8192, R, C); const int Rb = Epi::PERM ? ((R & ~31) + perm32(R & 31)) : R;
        voffA[i] = (unsigned)(R * g.ld + C) * 2u; voffB[i] = (unsigned)(Rb * g.ld + C) * 2u; }
    const size_t kstep = (size_t)(BK * 2);
    const size_t hstep = (size_t)HALF * g.ld * 2;
    const size_t tstep = 2 * hstep;
    const unsigned ldsw = (unsigned)wid * 1024u;
    const int aoff = lds_byte(wr * 64 + fr, fq * 8), boff = lds_byte(wc * 32 + fr, fq * 8);
#define PG8_SA(b, h) (((b) * 2 + (h)) * HTB)
#define PG8_SB(b, h) ((4 + (b) * 2 + (h)) * HTB)
#define PG8_STAGE(bufoff, gbase, voff) do { _Pragma("unroll") for (int _i = 0; _i < 2; ++_i) \
        __builtin_amdgcn_global_load_lds((const unsigned*)((const char*)(gbase) + (voff)[_i]), (PG8_LAS unsigned*)(lds + (bufoff) + ldsw + _i * 8192), 16, 0, 0); } while (0)
#define PG8_LDA(dst, b, h) do { _Pragma("unroll") for (int m = 0; m < 4; ++m) _Pragma("unroll") for (int k = 0; k < 2; ++k) dst[m][k] = *(const PG8_LAS bf16x8*)(lds + PG8_SA(b, h) + aoff + m * 2048 + k * 1024); } while (0)
#define PG8_LDB(dst, b, h) do { _Pragma("unroll") for (int n = 0; n < 2; ++n) _Pragma("unroll") for (int k = 0; k < 2; ++k) dst[n][k] = *(const PG8_LAS bf16x8*)(lds + PG8_SB(b, h) + boff + n * 2048 + k * 1024); } while (0)
#define PG8_MMA(ai, bj, At, Bt) do { __builtin_amdgcn_s_setprio(1); _Pragma("unroll") for (int m = 0; m < 4; ++m) _Pragma("unroll") for (int n = 0; n < 2; ++n) _Pragma("unroll") for (int k = 0; k < 2; ++k) \
        acc[ai][bj][m][n] = mma16<I8>(Bt[n][k], At[m][k], acc[ai][bj][m][n]); __builtin_amdgcn_s_setprio(0); } while (0)
#define PG8_WAIT_V(n) asm volatile("s_waitcnt vmcnt(" #n ")" ::: "memory")
#define PG8_WAIT_L(n) asm volatile("s_waitcnt lgkmcnt(" #n ")" ::: "memory")
#define PG8_BAR __builtin_amdgcn_s_barrier()
#define PG8_SCHED __builtin_amdgcn_sched_barrier(0)
    Unit cur, nxt; int ui = 0;
    if (!S.next(0, cur)) return;
    f32x4 acc[2][2][4][2];
#pragma unroll
    for (int a = 0; a < 2; ++a)
#pragma unroll
        for (int b = 0; b < 2; ++b)
#pragma unroll
            for (int m = 0; m < 4; ++m)
#pragma unroll
                for (int n = 0; n < 2; ++n) acc[a][b][m][n] = (f32x4){0.f, 0.f, 0.f, 0.f};
    bf16x8 At[4][2], B0[2][2], B1[2][2];
    const char* cA = (const char*)g.A + (size_t)cur.pm * tstep + cur.ko; const char* cB = (const char*)g.Bt + (size_t)cur.pn * tstep + cur.ko;
    S.a_ready(cur);
    if constexpr (SP2) {
        PG8_STAGE(PG8_SB(0, 0), cB, voffB); PG8_STAGE(PG8_SB(0, 1), cB + hstep, voffB); PG8_STAGE(PG8_SA(0, 0), cA, voffA); PG8_STAGE(PG8_SA(0, 1), cA + hstep, voffA);
        if (wr == 1) PG8_BAR;
        PG8_WAIT_V(2); PG8_BAR;
        PG8_STAGE(PG8_SB(1, 0), cB + kstep, voffB); PG8_STAGE(PG8_SA(1, 0), cA + kstep, voffA); PG8_STAGE(PG8_SB(1, 1), cB + hstep + kstep, voffB);
        PG8_WAIT_V(6); PG8_BAR;
    } else {
        PG8_STAGE(PG8_SB(0, 0), cB, voffB); PG8_STAGE(PG8_SA(0, 0), cA, voffA); PG8_STAGE(PG8_SB(0, 1), cB + hstep, voffB); PG8_STAGE(PG8_SA(0, 1), cA + hstep, voffA);
        if (wr == 1) PG8_BAR;
        PG8_WAIT_V(4); PG8_BAR;
        PG8_STAGE(PG8_SB(1, 0), cB + kstep, voffB); PG8_STAGE(PG8_SA(1, 0), cA + kstep, voffA); PG8_STAGE(PG8_SB(1, 1), cB + hstep + kstep, voffB);
        PG8_WAIT_V(6); PG8_BAR;
    }
    for (;;) {
        const bool has_next = S.next(ui + 1, nxt);
        const char* nA = has_next ? (const char*)g.A + (size_t)nxt.pm * tstep + nxt.ko : cA; const char* nB = has_next ? (const char*)g.Bt + (size_t)nxt.pn * tstep + nxt.ko : cB;
        for (int t = 0; t < nt; t += 2) {
            const bool last = (t == nt - 2);
            const char* a1 = cA + (size_t)(t + 1) * kstep;
            const char* a2 = last ? nA : cA + (size_t)(t + 2) * kstep; const char* b2 = last ? nB : cB + (size_t)(t + 2) * kstep;
            const char* a3 = a2 + kstep; const char* b3 = b2 + kstep;
            if (last && has_next) S.a_ready(nxt);
            if constexpr (SP2) {
            PG8_LDB(B0, 0, 0); PG8_LDB(B1, 0, 1); PG8_SCHED; PG8_LDA(At, 0, 0); PG8_STAGE(PG8_SA(1, 1), a1 + hstep, voffA);
            PG8_WAIT_V(8); PG8_WAIT_L(0); PG8_BAR; PG8_MMA(0, 0, At, B0); PG8_MMA(0, 1, At, B1); PG8_BAR; PG8_SCHED;
            PG8_LDA(At, 0, 1); PG8_STAGE(PG8_SB(0, 0), b2, voffB); PG8_STAGE(PG8_SB(0, 1), b2 + hstep, voffB); PG8_STAGE(PG8_SA(0, 0), a2, voffA);
            PG8_WAIT_V(8); PG8_WAIT_L(0); PG8_BAR; PG8_MMA(1, 0, At, B0); PG8_MMA(1, 1, At, B1); PG8_BAR; PG8_SCHED;
            PG8_LDB(B0, 1, 0); PG8_LDB(B1, 1, 1); PG8_SCHED; PG8_LDA(At, 1, 0); PG8_STAGE(PG8_SA(0, 1), a2 + hstep, voffA);
            PG8_WAIT_V(8); PG8_WAIT_L(0); PG8_BAR; PG8_MMA(0, 0, At, B0); PG8_MMA(0, 1, At, B1); PG8_BAR; PG8_SCHED;
            PG8_LDA(At, 1, 1); PG8_STAGE(PG8_SB(1, 0), b3, voffB); PG8_STAGE(PG8_SB(1, 1), b3 + hstep, voffB); PG8_STAGE(PG8_SA(1, 0), a3, voffA);
            PG8_WAIT_V(8); PG8_WAIT_L(0); PG8_BAR; PG8_MMA(1, 0, At, B0); PG8_MMA(1, 1, At, B1); PG8_BAR; PG8_SCHED;
            } else {
            PG8_LDB(B0, 0, 0); PG8_SCHED; PG8_LDA(At, 0, 0); PG8_STAGE(PG8_SA(1, 1), a1 + hstep, voffA);
            PG8_WAIT_L(8); PG8_BAR; PG8_WAIT_L(0); PG8_MMA(0, 0, At, B0); PG8_BAR; PG8_SCHED;
            PG8_LDB(B1, 0, 1); PG8_STAGE(PG8_SB(0, 0), b2, voffB);
            PG8_BAR; PG8_WAIT_L(0); PG8_MMA(0, 1, At, B1); PG8_BAR;
            PG8_LDA(At, 0, 1); PG8_STAGE(PG8_SA(0, 0), a2, voffA);
            PG8_BAR; PG8_WAIT_L(0); PG8_MMA(1, 0, At, B0); PG8_BAR; PG8_SCHED;
            PG8_STAGE(PG8_SB(0, 1), b2 + hstep, voffB);
            PG8_WAIT_V(6); PG8_BAR; PG8_MMA(1, 1, At, B1); PG8_BAR;
            PG8_LDB(B0, 1, 0); PG8_SCHED; PG8_LDA(At, 1, 0); PG8_STAGE(PG8_SA(0, 1), a2 + hstep, voffA);
            PG8_WAIT_L(8); PG8_BAR; PG8_WAIT_L(0); PG8_MMA(0, 0, At, B0); PG8_BAR; PG8_SCHED;
            PG8_LDB(B1, 1, 1); PG8_STAGE(PG8_SB(1, 0), b3, voffB);
            PG8_BAR; PG8_WAIT_L(0); PG8_MMA(0, 1, At, B1); PG8_BAR;
            PG8_LDA(At, 1, 1); PG8_STAGE(PG8_SA(1, 0), a3, voffA);
            PG8_BAR; PG8_WAIT_L(0); PG8_MMA(1, 0, At, B0); PG8_BAR; PG8_SCHED;
            PG8_STAGE(PG8_SB(1, 1), b3 + hstep, voffB);
            PG8_WAIT_V(6); PG8_BAR; PG8_MMA(1, 1, At, B1); PG8_BAR;
            }
        }
        if constexpr (ALIGN_EPI) { if (wr == 0) PG8_BAR; }
        if constexpr (!Epi::AFTER_DRAIN) { E(acc, cur, wr, wc, fr, fq); S.done(cur); }
        if (!has_next) break;
#pragma unroll
        for (int a = 0; a < 2; ++a)
#pragma unroll
            for (int b = 0; b < 2; ++b)
#pragma unroll
                for (int m = 0; m < 4; ++m)
#pragma unroll
                    for (int n = 0; n < 2; ++n) acc[a][b][m][n] = (f32x4){0.f, 0.f, 0.f, 0.f};
        cur = nxt; cA = nA; cB = nB; ++ui;
        if constexpr (ALIGN_EPI) { if (wr == 1) PG8_BAR; }
    }
    PG8_WAIT_V(0);
    if constexpr (!ALIGN_EPI) { if (wr == 0) PG8_BAR; }
    PG8_BAR;
    if constexpr (Epi::AFTER_DRAIN) { E.fused(acc, cur, wr, wc, fr, fq, lds, wid, lane); S.done(cur); }
#undef PG8_SA
#undef PG8_SB
#undef PG8_STAGE
#undef PG8_LDA
#undef PG8_LDB
#undef PG8_MMA
#undef PG8_WAIT_V
#undef PG8_WAIT_L
#undef PG8_BAR
#undef PG8_SCHED
}
}
#define PG8_SP2 true
#define PG8_ALIGN true
#define GAS __attribute__((address_space(1)))
#define LAS __attribute__((address_space(3)))
typedef unsigned short bf16;
typedef unsigned v4u __attribute__((ext_vector_type(4)));
typedef float f32x4 __attribute__((ext_vector_type(4)));
typedef short bf16x8 __attribute__((ext_vector_type(8)));
typedef GAS unsigned gu32;
typedef GAS unsigned long long gu64;
#define RLX_AGENT __ATOMIC_RELAXED, __HIP_MEMORY_SCOPE_AGENT
#define LDS_WAIT() asm volatile("s_waitcnt lgkmcnt(0)" ::: "memory")
#define VM_WAIT() asm volatile("s_waitcnt vmcnt(0)" ::: "memory")
__device__ __forceinline__ unsigned long long rt() { return __builtin_amdgcn_s_memrealtime(); }
__device__ __forceinline__ unsigned f2bf(float f) { unsigned u = __builtin_bit_cast(unsigned, f); return (u + 0x7fffu + ((u >> 16) & 1u)) >> 16; }
__device__ __forceinline__ unsigned pk2(float lo, float hi) { return f2bf(lo) | (f2bf(hi) << 16); }
#define XB_TMO      128
#define XB_XCNT(j)  (256  + 64 * (j))
#define XB_XSUB(j)  (1280 + 64 * (j))
#define XB_XGEN(j)  (2304 + 64 * (j))
#define XB_TOP      3328
#define XB_TOPGEN   3392
#define XCD_BAR_WORDS 3456
#define XB_SPIN_CAP (1u << 18)

__device__ __forceinline__ unsigned xb_ld(unsigned* p)              { return __hip_atomic_load(p, __ATOMIC_RELAXED, __HIP_MEMORY_SCOPE_AGENT); }
__device__ __forceinline__ unsigned xb_add(unsigned* p, unsigned v) { return __hip_atomic_fetch_add(p, v, __ATOMIC_RELAXED, __HIP_MEMORY_SCOPE_AGENT); }
__device__ __forceinline__ unsigned xb_xcc_id() { return (unsigned)__builtin_amdgcn_s_getreg((3 << 11) | 20) & 0xFu; }
#define XB_SPIN(cond, bar) do { unsigned _sp = 0; while (cond) { __builtin_amdgcn_s_sleep(1); \
    if ((++_sp & 255u) == 0u) { if (xb_ld(&(bar)[XB_TMO])) break; if (_sp > XB_SPIN_CAP) { atomicAdd(&(bar)[XB_TMO], 1u); break; } } } } while (0)

struct XcdBarrier {
    unsigned* bar; unsigned x;
    volatile LAS unsigned* st;
};

__device__ __forceinline__ XcdBarrier xcd_barrier_post(unsigned* bar, volatile LAS unsigned* st) {
    XcdBarrier b; b.bar = bar; b.x = xb_xcc_id(); b.st = st;
    if (threadIdx.x == 0) (void)xb_add(&bar[XB_XCNT(b.x)], 1u);
    return b;
}
__device__ __forceinline__ void xcd_barrier_complete(unsigned* bar, unsigned x, unsigned& nloc, unsigned& nx) {
    const unsigned G = gridDim.x * gridDim.y * gridDim.z;
    unsigned sum, cnt, mine, sp = 0u;
    for (;;) {
        sum = 0u; cnt = 0u; mine = 0u;
#pragma unroll
        for (unsigned j = 0; j < 16; ++j) { const unsigned c = xb_ld(&bar[XB_XCNT(j)]); sum += c; cnt += (c > 0u) ? 1u : 0u; mine = (j == x) ? c : mine; }
        if (sum == G) break;
        __builtin_amdgcn_s_sleep(1);
        if ((++sp & 255u) == 0u) { if (xb_ld(&bar[XB_TMO])) break; if (sp > XB_SPIN_CAP) { atomicAdd(&bar[XB_TMO], 1u); break; } }
    }
    nloc = mine > 0u ? mine : 1u; nx = cnt > 0u ? cnt : 1u;
}

__device__ __forceinline__ void xcd_barrier(const XcdBarrier& b) {
    asm volatile("s_waitcnt vmcnt(0)" ::: "memory");
    __syncthreads();
    if (threadIdx.x == 0) {
        unsigned* bar = b.bar;
        __builtin_amdgcn_s_waitcnt(0);
        unsigned nloc = b.st[0], nx = b.st[1];
        if (nloc == 0u) { xcd_barrier_complete(bar, b.x, nloc, nx); b.st[0] = nloc; b.st[1] = nx; }
        const unsigned old = xb_add(&bar[XB_XSUB(b.x)], 1u);
        const unsigned gen = old / nloc;
        if (old + 1u == (gen + 1u) * nloc) {
            __builtin_amdgcn_fence(__ATOMIC_RELEASE, "agent");
            asm volatile("s_waitcnt vmcnt(0)" ::: "memory");
            const unsigned og = xb_add(&bar[XB_TOP], 1u);
            const unsigned tg = og / nx;
            if (og + 1u == (tg + 1u) * nx) xb_add(&bar[XB_TOPGEN], 1u);
            else XB_SPIN(xb_ld(&bar[XB_TOPGEN]) == tg, bar);
            __builtin_amdgcn_fence(__ATOMIC_ACQUIRE, "agent");
            xb_add(&bar[XB_XGEN(b.x)], 1u);
            asm volatile("s_waitcnt vmcnt(0)" ::: "memory");
        } else {
            XB_SPIN(xb_ld(&bar[XB_XGEN(b.x)]) == gen, bar);
            __builtin_amdgcn_fence(__ATOMIC_ACQUIRE, "agent");
            asm volatile("s_waitcnt vmcnt(0)" ::: "memory");
        }
    }
    __syncthreads();
}

constexpr int NWAVES = 8;
constexpr int D = 1024, TP = 16384, TS = 512, T = TP + TS, FF = 2816, NH = 8, KVR = 256, ROPE = 64, QRANK = 512, NQ = 1536, HD = 192;
constexpr int SEQ = 8192, DB = 128, DS = 4, PAGE = 128, NPG = 64, CKVW = 320;
constexpr int NCK = DB * SEQ;
constexpr float EPS = 1e-6f;
constexpr float QSCALE = 0.07216878364870322f * 1.4426950408889634f;
constexpr size_t OUT_Y = 0, OUT_CSP = 17301504, OUT_CSS = 17305600, OUT_LATP = 17567744, OUT_KPEP = 21762048, OUT_LATS = 22810624, OUT_KPES = 22941696, OUT_TOTAL = 22974464;
constexpr size_t MiB = 1u << 20;
constexpr size_t WS_CTL = 0, CTL_BYTES = 4 * MiB;
constexpr size_t WS_WGU0 = 4 * MiB, WS_WGU1 = 15 * MiB, WS_WGU2 = 26 * MiB, WS_WGU3 = 38 * MiB;
constexpr size_t WS_WDN0 = 49 * MiB, WS_WDN1 = 55 * MiB, WS_WDN2 = 61 * MiB, WS_WDN3 = 67 * MiB;
constexpr size_t WS_WCI = 73 * MiB, WS_WCO = 79 * MiB, WS_WDQ = 81 * MiB, WS_WUQ = 82 * MiB, WS_WO = 84 * MiB, WS_WUKV = 86 * MiB;
constexpr size_t WS_ROPE = 88 * MiB;
constexpr size_t WS_XB = 92 * MiB, WS_HB = 126 * MiB, WS_BB = 218 * MiB, WS_UB = 252 * MiB, WS_ZB = 286 * MiB, WS_CKV = 320 * MiB;
constexpr size_t WS_LATB = 342 * MiB, WS_KPEB = 352 * MiB, WS_KN = 356 * MiB, WS_VB = 390 * MiB, WS_CQB = 424 * MiB, WS_QB = 442 * MiB;
constexpr size_t WS_OB = 493 * MiB, WS_RPT = 527 * MiB, WS_RTS = 529 * MiB, WS_QS = 530 * MiB, WS_PO = 534 * MiB, WS_PML = 543 * MiB;
constexpr size_t WS_CLB = 544 * MiB, WS_CKB = 1056 * MiB, WS_RP = 1184 * MiB, WS_SLAB = 1248 * MiB;
constexpr size_t WS_CL8 = 1272 * MiB, WS_SC2 = 1528 * MiB, WS_W8 = 1532 * MiB, WS_T2 = 1533 * MiB;
constexpr size_t WS_A8 = 1534 * MiB, WS_SA = 1552 * MiB, WS_W8GU0 = 1553 * MiB, WS_W8GU_STRIDE = 6 * MiB, WS_TGU = 1577 * MiB, WS_WDKV = 1578 * MiB, WS_END = 1580 * MiB;
constexpr int SPLITK = 11;
constexpr int CW_BAR = 4096;
constexpr int F_SSQX = 16384, F_SSQLAT = F_SSQX + 6 * T, F_SSQKPE = F_SSQX + 7 * T, F_SSQCQ = F_SSQX + 8 * T, F_SSQQ = F_SSQX + 9 * T;
static_assert((size_t)(F_SSQQ + 16 * T) * 4 <= CTL_BYTES, "ctl");
constexpr int RING_OFF = 0, RING_BYTES = 131072, MISC_OFF = 131072, QS_OFF = 131584, QS_STRIDE = 656, SCR_OFF = QS_OFF + 32 * QS_STRIDE, LDS_BYTES = 155648;
static_assert(SCR_OFF + 8 * 256 <= LDS_BYTES, "lds");

typedef unsigned short bf16_t;
typedef unsigned u32x2 __attribute__((ext_vector_type(2)));
typedef float f32x2 __attribute__((ext_vector_type(2)));
typedef __bf16 bf16x2_t __attribute__((ext_vector_type(2)));
__device__ __forceinline__ unsigned cvt_pk_bf16(float lo, float hi) { f32x2 v = {lo, hi}; bf16x2_t b = __builtin_convertvector(v, bf16x2_t); return __builtin_bit_cast(unsigned, b); }
__device__ __forceinline__ float bf2f(unsigned short h) { return __builtin_bit_cast(float, (unsigned)h << 16); }
__device__ __forceinline__ float bflo(unsigned w) { return __builtin_bit_cast(float, w << 16); }
__device__ __forceinline__ float bfhi(unsigned w) { return __builtin_bit_cast(float, w & 0xffff0000u); }
__device__ __forceinline__ v4u pack8f(const float* v) { v4u o; o.x = cvt_pk_bf16(v[0], v[1]); o.y = cvt_pk_bf16(v[2], v[3]); o.z = cvt_pk_bf16(v[4], v[5]); o.w = cvt_pk_bf16(v[6], v[7]); return o; }
__device__ __forceinline__ void unpack8f(v4u w, float* v) { v[0] = bflo(w.x); v[1] = bfhi(w.x); v[2] = bflo(w.y); v[3] = bfhi(w.y); v[4] = bflo(w.z); v[5] = bfhi(w.z); v[6] = bflo(w.w); v[7] = bfhi(w.w); }
__device__ __forceinline__ float fq_sum(float s) { s += __shfl_xor(s, 16); s += __shfl_xor(s, 32); return s; }
__device__ __forceinline__ float wave_sum(float v) {
#pragma unroll
    for (int o = 1; o < 64; o <<= 1) v += __shfl_xor(v, o);
    return v;
}
__device__ __forceinline__ float rsq(float x) { return 1.0f / sqrtf(x); }
__device__ __forceinline__ void atomic_addf(float* p, float v) { unsafeAtomicAdd(p, v); }

namespace epi {
using pg8::Unit; using pg8::f32x4; using pg8::BM; using pg8::HALF;
typedef f32x4 Acc[2][2][4][2];

struct Swiglu {
    static constexpr bool PERM = true, AFTER_DRAIN = false;
    bf16_t* HB; const float* ssq; float* ckv; float* ssq_lat; float* ssq_kpe; int ngu;
    __device__ __forceinline__ void operator()(const f32x4 (&acc)[2][2][4][2], const Unit& u, int wr, int wc, int fr, int fq) const {
        float sq8[2][4];
#pragma unroll
        for (int ai = 0; ai < 2; ++ai)
#pragma unroll
            for (int m = 0; m < 4; ++m) sq8[ai][m] = ssq[u.pm * BM + ai * HALF + wr * 64 + m * 16 + fr];
#pragma unroll
        for (int ai = 0; ai < 2; ++ai)
#pragma unroll
            for (int m = 0; m < 4; ++m) {
                const int row = u.pm * BM + ai * HALF + wr * 64 + m * 16 + fr;
                const float rs = rsq(sq8[ai][m] * (1.0f / D) + EPS);
                if (u.pn < ngu) {
                    float h[8];
#pragma unroll
                    for (int n = 0; n < 2; ++n)
#pragma unroll
                        for (int j = 0; j < 4; ++j) { const float g = acc[ai][0][m][n][j] * rs, up = acc[ai][1][m][n][j] * rs;
                            const float sg = g * __builtin_amdgcn_rcpf(1.0f + __builtin_amdgcn_exp2f(-1.4426950408889634f * g)); h[4 * n + j] = sg * up; }
                    *(v4u*)(HB + (size_t)row * FF + 128 * u.pn + 32 * wc + 8 * fq) = pack8f(h);
                } else if (u.pn == ngu) {
                    float ss = 0.f;
#pragma unroll
                    for (int bj = 0; bj < 2; ++bj)
#pragma unroll
                        for (int n = 0; n < 2; ++n) { const f32x4 v = acc[ai][bj][m][n] * rs; ss += (v[0] * v[0] + v[1] * v[1]) + (v[2] * v[2] + v[3] * v[3]);
                            *(f32x4*)(ckv + (size_t)row * CKVW + 128 * bj + 32 * wc + 8 * fq + 4 * n) = v; }
                    ss = fq_sum(ss); if (fq == 0) atomic_addf(ssq_lat + row, ss);
                } else {
                    if (wc < 2) { float ss = 0.f;
#pragma unroll
                        for (int n = 0; n < 2; ++n) { const f32x4 v = acc[ai][0][m][n] * rs; ss += (v[0] * v[0] + v[1] * v[1]) + (v[2] * v[2] + v[3] * v[3]);
                            *(f32x4*)(ckv + (size_t)row * CKVW + 256 + 32 * wc + 8 * fq + 4 * n) = v; }
                        ss = fq_sum(ss); if (fq == 0) atomic_addf(ssq_kpe + row, ss); }
                }
            }
    }
};
struct Swiglu8 {
    static constexpr bool PERM = true, AFTER_DRAIN = false;
    bf16_t* HB; const float* ssq; const float* sa; const float* tsc;
    __device__ __forceinline__ void operator()(const f32x4 (&acc)[2][2][4][2], const Unit& u, int wr, int wc, int fr, int fq) const {
        typedef int i32x4 __attribute__((ext_vector_type(4)));
        int fq_ = fq, fr_ = fr; asm volatile("" : "+v"(fq_), "+v"(fr_));
        float f8[2][4], s8[2][4]; f32x4 tg[2], tu[2];
#pragma unroll
        for (int ai = 0; ai < 2; ++ai)
#pragma unroll
            for (int m = 0; m < 4; ++m) { const int row = u.pm * BM + ai * HALF + wr * 64 + m * 16 + fr_; f8[ai][m] = ssq[row]; s8[ai][m] = sa[row]; }
#pragma unroll
        for (int n = 0; n < 2; ++n) { tg[n] = *(const f32x4*)(tsc + 256 * u.pn + 32 * wc + 8 * fq_ + 4 * n); tu[n] = *(const f32x4*)(tsc + 256 * u.pn + 128 + 32 * wc + 8 * fq_ + 4 * n); }
#pragma unroll
        for (int ai = 0; ai < 2; ++ai)
#pragma unroll
            for (int m = 0; m < 4; ++m) {
                const int row = u.pm * BM + ai * HALF + wr * 64 + m * 16 + fr;
                const float rs = rsq(f8[ai][m] * (1.0f / D) + EPS) * s8[ai][m];
                float h[8];
#pragma unroll
                for (int n = 0; n < 2; ++n) { const i32x4 ig = __builtin_bit_cast(i32x4, acc[ai][0][m][n]), iu = __builtin_bit_cast(i32x4, acc[ai][1][m][n]);
#pragma unroll
                    for (int j = 0; j < 4; ++j) { const float g = (float)ig[j] * (rs * tg[n][j]), up = (float)iu[j] * (rs * tu[n][j]);
                        const float sg = g * __builtin_amdgcn_rcpf(1.0f + __builtin_amdgcn_exp2f(-1.4426950408889634f * g)); h[4 * n + j] = sg * up; } }
                *(v4u*)(HB + (size_t)row * FF + 128 * u.pn + 32 * wc + 8 * fq) = pack8f(h);
            }
    }
};
struct Dkv {
    static constexpr bool PERM = true, AFTER_DRAIN = false;
    const float* ssq; float* ckv; float* ssq_lat; float* ssq_kpe;
    __device__ __forceinline__ void operator()(const f32x4 (&acc)[2][2][4][2], const Unit& u, int wr, int wc, int fr, int fq) const {
        float sq8[2][4];
#pragma unroll
        for (int ai = 0; ai < 2; ++ai)
#pragma unroll
            for (int m = 0; m < 4; ++m) sq8[ai][m] = ssq[u.pm * BM + ai * HALF + wr * 64 + m * 16 + fr];
#pragma unroll
        for (int ai = 0; ai < 2; ++ai)
#pragma unroll
            for (int m = 0; m < 4; ++m) {
                const int row = u.pm * BM + ai * HALF + wr * 64 + m * 16 + fr;
                const float rs = rsq(sq8[ai][m] * (1.0f / D) + EPS);
                if (u.pn == 0) {
                    float ss = 0.f;
#pragma unroll
                    for (int bj = 0; bj < 2; ++bj)
#pragma unroll
                        for (int n = 0; n < 2; ++n) { const f32x4 v = acc[ai][bj][m][n] * rs; ss += (v[0] * v[0] + v[1] * v[1]) + (v[2] * v[2] + v[3] * v[3]);
                            *(f32x4*)(ckv + (size_t)row * CKVW + 128 * bj + 32 * wc + 8 * fq + 4 * n) = v; }
                    ss = fq_sum(ss); if (fq == 0) atomic_addf(ssq_lat + row, ss);
                } else if (wc < 2) { float ss = 0.f;
#pragma unroll
                    for (int n = 0; n < 2; ++n) { const f32x4 v = acc[ai][0][m][n] * rs; ss += (v[0] * v[0] + v[1] * v[1]) + (v[2] * v[2] + v[3] * v[3]);
                        *(f32x4*)(ckv + (size_t)row * CKVW + 256 + 32 * wc + 8 * fq + 4 * n) = v; }
                    ss = fq_sum(ss); if (fq == 0) atomic_addf(ssq_kpe + row, ss); }
            }
    }
};
template <bool FINAL>
struct ResidT {
    static constexpr bool PERM = true, AFTER_DRAIN = false;
    bf16_t* XB; float* P; float alpha;
    __device__ __forceinline__ void operator()(const f32x4 (&acc)[2][2][4][2], const Unit& u, int wr, int wc, int fr, int fq) const {
        v4u xv[2][4][2];
#pragma unroll
        for (int ai = 0; ai < 2; ++ai)
#pragma unroll
            for (int m = 0; m < 4; ++m) { const bf16_t* xp = XB + (size_t)(u.pm * BM + ai * HALF + wr * 64 + m * 16 + fr) * D + 256 * u.pn + 32 * wc + 8 * fq;
#pragma unroll
                for (int bj = 0; bj < 2; ++bj) xv[ai][m][bj] = *(const v4u*)(xp + 128 * bj); }
#pragma unroll
        for (int ai = 0; ai < 2; ++ai)
#pragma unroll
            for (int m = 0; m < 4; ++m) { const int row = u.pm * BM + ai * HALF + wr * 64 + m * 16 + fr;
                const size_t off = (size_t)row * D + 256 * u.pn + 32 * wc + 8 * fq; float ss = 0.f;
#pragma unroll
                for (int bj = 0; bj < 2; ++bj) { const v4u xw = xv[ai][m][bj];
                    const f32x4 v0 = (f32x4){bflo(xw.x), bfhi(xw.x), bflo(xw.y), bfhi(xw.y)} + acc[ai][bj][m][0] * alpha, v1 = (f32x4){bflo(xw.z), bfhi(xw.z), bflo(xw.w), bfhi(xw.w)} + acc[ai][bj][m][1] * alpha;
                    if constexpr (FINAL) { float* yp = P + off + 128 * bj; *(f32x4*)yp = v0; *(f32x4*)(yp + 4) = v1; }
                    else { ss += (v0[0] * v0[0] + v0[1] * v0[1]) + (v0[2] * v0[2] + v0[3] * v0[3]) + (v1[0] * v1[0] + v1[1] * v1[1]) + (v1[2] * v1[2] + v1[3] * v1[3]);
                        v4u w; w.x = cvt_pk_bf16(v0[0], v0[1]); w.y = cvt_pk_bf16(v0[2], v0[3]); w.z = cvt_pk_bf16(v1[0], v1[1]); w.w = cvt_pk_bf16(v1[2], v1[3]); *(v4u*)(XB + off + 128 * bj) = w; } }
                if constexpr (!FINAL) { ss = fq_sum(ss); if (fq == 0) atomic_addf(P + row, ss); } }
    }
};
using Resid = ResidT<false>;
using ResidY = ResidT<true>;
struct ConvIn {
    static constexpr bool PERM = true, AFTER_DRAIN = false;
    bf16_t* BB; bf16_t* UB; const float* ssq; float* csp; float* css;
    __device__ __forceinline__ void operator()(const f32x4 (&acc)[2][2][4][2], const Unit& u, int wr, int wc, int fr, int fq) const {
        float sq8[2][4];
#pragma unroll
        for (int ai = 0; ai < 2; ++ai)
#pragma unroll
            for (int m = 0; m < 4; ++m) sq8[ai][m] = ssq[u.pm * BM + ai * HALF + wr * 64 + m * 16 + fr];
#pragma unroll
        for (int ai = 0; ai < 2; ++ai)
#pragma unroll
            for (int m = 0; m < 4; ++m) {
                const int row = u.pm * BM + ai * HALF + wr * 64 + m * 16 + fr;
                const float rs = rsq(sq8[ai][m] * (1.0f / D) + EPS);
                if (u.pn < 4) {
#pragma unroll
                    for (int bj = 0; bj < 2; ++bj) { const f32x4 v0 = acc[ai][bj][m][0] * rs, v1 = acc[ai][bj][m][1] * rs;
                        v4u w; w.x = cvt_pk_bf16(v0[0], v0[1]); w.y = cvt_pk_bf16(v0[2], v0[3]); w.z = cvt_pk_bf16(v1[0], v1[1]); w.w = cvt_pk_bf16(v1[2], v1[3]);
                        *(v4u*)(BB + (size_t)row * D + 256 * u.pn + 128 * bj + 32 * wc + 8 * fq) = w; }
                } else {
                    const int ch0 = 128 * (u.pn - 4) + 32 * wc + 8 * fq;
                    const f32x4 u0 = (acc[ai][0][m][0] * rs) * (acc[ai][1][m][0] * rs), u1 = (acc[ai][0][m][1] * rs) * (acc[ai][1][m][1] * rs);
                    v4u w; w.x = cvt_pk_bf16(u0[0], u0[1]); w.y = cvt_pk_bf16(u0[2], u0[3]); w.z = cvt_pk_bf16(u1[0], u1[1]); w.w = cvt_pk_bf16(u1[2], u1[3]);
                    *(v4u*)(UB + (size_t)row * D + ch0) = w;
                    float* dst = nullptr;
                    if (row < TP) { const int t = row & (SEQ - 1); if (t >= SEQ - 2) dst = csp + (size_t)((row >> 13) * 2 + (t - (SEQ - 2))) * D + ch0; }
                    else { const int rs_ = row - TP, i = rs_ & 3; if (i >= 2) dst = css + (size_t)((rs_ >> 2) * 2 + (i - 2)) * D + ch0; }
                    if (dst) { *(f32x4*)dst = u0; *(f32x4*)(dst + 4) = u1; }
                }
            }
    }
};
struct Dq {
    static constexpr bool PERM = true, AFTER_DRAIN = false;
    bf16_t* CQB; const float* ssq; float* ssq_out;
    __device__ __forceinline__ void operator()(const f32x4 (&acc)[2][2][4][2], const Unit& u, int wr, int wc, int fr, int fq) const {
        float sq8[2][4];
#pragma unroll
        for (int ai = 0; ai < 2; ++ai)
#pragma unroll
            for (int m = 0; m < 4; ++m) sq8[ai][m] = ssq[u.pm * BM + ai * HALF + wr * 64 + m * 16 + fr];
#pragma unroll
        for (int ai = 0; ai < 2; ++ai)
#pragma unroll
            for (int m = 0; m < 4; ++m) {
                const int row = u.pm * BM + ai * HALF + wr * 64 + m * 16 + fr;
                const float rs = rsq(sq8[ai][m] * (1.0f / D) + EPS);
                float ss = 0.f;
#pragma unroll
                for (int bj = 0; bj < 2; ++bj) { const f32x4 v0 = acc[ai][bj][m][0] * rs, v1 = acc[ai][bj][m][1] * rs;
                    ss += (v0[0] * v0[0] + v0[1] * v0[1]) + (v0[2] * v0[2] + v0[3] * v0[3]) + (v1[0] * v1[0] + v1[1] * v1[1]) + (v1[2] * v1[2] + v1[3] * v1[3]);
                    v4u w; w.x = cvt_pk_bf16(v0[0], v0[1]); w.y = cvt_pk_bf16(v0[2], v0[3]); w.z = cvt_pk_bf16(v1[0], v1[1]); w.w = cvt_pk_bf16(v1[2], v1[3]);
                    *(v4u*)(CQB + (size_t)row * QRANK + 256 * u.pn + 128 * bj + 32 * wc + 8 * fq) = w; }
                ss = fq_sum(ss); if (fq == 0) atomic_addf(ssq_out + row, ss);
            }
    }
};
struct Uq {
    static constexpr bool PERM = true, AFTER_DRAIN = false;
    bf16_t* QB; const float* ssq; float* ssq_q;
    __device__ __forceinline__ void operator()(const f32x4 (&acc)[2][2][4][2], const Unit& u, int wr, int wc, int fr, int fq) const {
        float sq8[2][4];
#pragma unroll
        for (int ai = 0; ai < 2; ++ai)
#pragma unroll
            for (int m = 0; m < 4; ++m) sq8[ai][m] = ssq[u.pm * BM + ai * HALF + wr * 64 + m * 16 + fr];
#pragma unroll
        for (int ai = 0; ai < 2; ++ai)
#pragma unroll
            for (int m = 0; m < 4; ++m) {
                const int row = u.pm * BM + ai * HALF + wr * 64 + m * 16 + fr;
                const float rs = rsq(sq8[ai][m] * (1.0f / QRANK) + EPS);
#pragma unroll
                for (int bj = 0; bj < 2; ++bj) { const f32x4 v0 = acc[ai][bj][m][0] * rs, v1 = acc[ai][bj][m][1] * rs;
                    float ss = (v0[0] * v0[0] + v0[1] * v0[1]) + (v0[2] * v0[2] + v0[3] * v0[3]) + (v1[0] * v1[0] + v1[1] * v1[1]) + (v1[2] * v1[2] + v1[3] * v1[3]);
                    const int cb = 256 * u.pn + 128 * bj + 32 * wc;
                    const int hh = cb / HD, seg = 2 * hh + ((cb - hh * HD) >= 128 ? 1 : 0);
                    v4u w; w.x = cvt_pk_bf16(v0[0], v0[1]); w.y = cvt_pk_bf16(v0[2], v0[3]); w.z = cvt_pk_bf16(v1[0], v1[1]); w.w = cvt_pk_bf16(v1[2], v1[3]);
                    *(v4u*)(QB + (size_t)row * NQ + cb + 8 * fq) = w;
                    ss = fq_sum(ss); if (fq == 0) atomic_addf(ssq_q + (size_t)seg * T + row, ss); }
            }
    }
};
struct Kv {
    static constexpr bool PERM = true, AFTER_DRAIN = false;
    bf16_t* KU; bf16_t* VB; float* RP; size_t nrows;
    __device__ __forceinline__ void operator()(const f32x4 (&acc)[2][2][4][2], const Unit& u, int wr, int wc, int fr, int fq) const {
#pragma unroll
        for (int ai = 0; ai < 2; ++ai)
#pragma unroll
            for (int m = 0; m < 4; ++m) {
                const unsigned row = (unsigned)(u.pm * BM + ai * HALF + wr * 64 + m * 16 + fr);
                if (u.pn < 4) {
                    const int head = 2 * u.pn + (wc >> 1);
                    float ss = 0.f;
#pragma unroll
                    for (int bj = 0; bj < 2; ++bj) { const f32x4 v0 = acc[ai][bj][m][0], v1 = acc[ai][bj][m][1];
                        ss += (v0[0] * v0[0] + v0[1] * v0[1]) + (v0[2] * v0[2] + v0[3] * v0[3]) + (v1[0] * v1[0] + v1[1] * v1[1]) + (v1[2] * v1[2] + v1[3] * v1[3]);
                        if (KU) { v4u w; w.x = cvt_pk_bf16(v0[0], v0[1]); w.y = cvt_pk_bf16(v0[2], v0[3]); w.z = cvt_pk_bf16(v1[0], v1[1]); w.w = cvt_pk_bf16(v1[2], v1[3]);
                            *(v4u*)(KU + (size_t)(row * D + 128 * head + 64 * (wc & 1) + 32 * bj + 8 * fq)) = w; } }
                    ss = fq_sum(ss); if (fq == 0) RP[(size_t)((unsigned)(2 * head + (wc & 1)) * (unsigned)nrows + row)] = ss;
                } else if (VB) {
#pragma unroll
                    for (int bj = 0; bj < 2; ++bj) { const f32x4 v0 = acc[ai][bj][m][0], v1 = acc[ai][bj][m][1];
                        v4u w; w.x = cvt_pk_bf16(v0[0], v0[1]); w.y = cvt_pk_bf16(v0[2], v0[3]); w.z = cvt_pk_bf16(v1[0], v1[1]); w.w = cvt_pk_bf16(v1[2], v1[3]);
                        *(v4u*)(VB + (size_t)(row * D + 256 * (u.pn - 4) + 128 * bj + 32 * wc + 8 * fq)) = w; }
                }
            }
    }
};
struct Kv8 {
    static constexpr bool PERM = true, AFTER_DRAIN = false;
    float* RP; const float* sc2; const LAS float* t2; size_t nrows;
    __device__ __forceinline__ void operator()(const f32x4 (&acc)[2][2][4][2], const Unit& u, int wr, int wc, int fr, int fq) const {
        typedef int i32x4 __attribute__((ext_vector_type(4)));
        const int head = 2 * u.pn + (wc >> 1);
        int fq_ = fq; asm volatile("" : "+v"(fq_));
        float ss[2][4];
#pragma unroll
        for (int ai = 0; ai < 2; ++ai)
#pragma unroll
            for (int m = 0; m < 4; ++m) ss[ai][m] = 0.f;
#pragma unroll
        for (int bj = 0; bj < 2; ++bj)
#pragma unroll
            for (int n = 0; n < 2; ++n) { const f32x4 tv = *(const LAS f32x4*)(t2 + 256 * u.pn + 128 * bj + 32 * wc + 8 * fq_ + 4 * n);
#pragma unroll
                for (int ai = 0; ai < 2; ++ai)
#pragma unroll
                    for (int m = 0; m < 4; ++m) { const i32x4 vi = __builtin_bit_cast(i32x4, acc[ai][bj][m][n]);
#pragma unroll
                        for (int j = 0; j < 4; ++j) { const float f = (float)vi[j]; ss[ai][m] += f * f * tv[j]; } } }
#pragma unroll
        for (int ai = 0; ai < 2; ++ai)
#pragma unroll
            for (int m = 0; m < 4; ++m) {
                const unsigned row = (unsigned)(u.pm * BM + ai * HALF + wr * 64 + m * 16 + fr);
                const float s_ = fq_sum(ss[ai][m]); if (fq == 0) RP[(size_t)((unsigned)(2 * head + (wc & 1)) * (unsigned)nrows + row)] = s_;
            }
    }
};
struct Slab {
    static constexpr bool PERM = true, AFTER_DRAIN = false;
    float* slab;
    __device__ __forceinline__ void operator()(const f32x4 (&acc)[2][2][4][2], const Unit& u, int wr, int wc, int fr, int fq) const {
        float* base = slab + (size_t)(u.ko >> 9) * TS * D;
#pragma unroll
        for (int ai = 0; ai < 2; ++ai)
#pragma unroll
            for (int m = 0; m < 4; ++m) { float* p = base + (size_t)(u.pm * BM + ai * HALF + wr * 64 + m * 16 + fr) * D + 256 * u.pn + 32 * wc + 8 * fq;
#pragma unroll
                for (int bj = 0; bj < 2; ++bj) { *(f32x4*)(p + 128 * bj) = acc[ai][bj][m][0]; *(f32x4*)(p + 128 * bj + 4) = acc[ai][bj][m][1]; } }
    }
};
}

struct Ctx {
    LAS unsigned char* lds;
    int tid, lane, wave, vcu, G;
};
struct PrepD { const float* W; const float* gain; bf16_t* WT; int K, N, drow0, k0, n0; };
__device__ __forceinline__ void prep_load(const PrepD& d, f32x4 (&v)[8], float (&gk)[8], int lane) {
    if (!d.W) return;
    const int r = lane >> 3, c4 = lane & 7;
#pragma unroll
    for (int i = 0; i < 8; ++i) { v[i] = *(const f32x4*)(d.W + (size_t)(d.k0 + 8 * i + r) * d.N + d.n0 + 4 * c4); gk[i] = d.gain ? d.gain[d.k0 + 8 * i + r] : 1.0f; }
}
__device__ __forceinline__ void prep_finish(const PrepD& d, const f32x4 (&v)[8], const float (&gk)[8], LAS float* scr, int lane) {
    if (!d.W) { const v4u z = {0u, 0u, 0u, 0u};
#pragma unroll
        for (int j = 0; j < 2; ++j) *(v4u*)(d.WT + 8 * (lane + 64 * j)) = z;
        return; }
    { const int r = lane >> 3, c4 = lane & 7;
#pragma unroll
      for (int i = 0; i < 8; ++i) { LAS float* sp = scr + (8 * i + r) * 33 + 4 * c4; sp[0] = v[i].x * gk[i]; sp[1] = v[i].y * gk[i]; sp[2] = v[i].z * gk[i]; sp[3] = v[i].w * gk[i]; } }
    LDS_WAIT(); asm volatile("" ::: "memory");
    const int c = lane & 7;
#pragma unroll
    for (int j = 0; j < 4; ++j) { const int n = (lane >> 3) + 8 * j; const LAS float* s = scr + (8 * c) * 33 + n;
        v4u o; o.x = cvt_pk_bf16(s[0 * 33], s[1 * 33]); o.y = cvt_pk_bf16(s[2 * 33], s[3 * 33]); o.z = cvt_pk_bf16(s[4 * 33], s[5 * 33]); o.w = cvt_pk_bf16(s[6 * 33], s[7 * 33]);
        *(v4u*)(d.WT + (size_t)(d.drow0 + n) * d.K + d.k0 + 8 * c) = o; }
    LDS_WAIT(); asm volatile("" ::: "memory");
}
__device__ __forceinline__ int gu_map(int nb) { const int up = nb >= 88 ? 1 : 0, hb = nb - 88 * up; return 256 * (hb >> 2) + 128 * up + 32 * (hb & 3); }
__device__ __forceinline__ int ci_map(int nb) { if (nb < 32) return 32 * nb; const int hh = nb >= 64 ? 1 : 0, cb = nb - 32 - 32 * hh; return 256 * (4 + (cb >> 2)) + 128 * hh + 32 * (cb & 3); }
__device__ __forceinline__ int uk_map(int nb) { const int h = nb >> 2, dq = nb & 3; return 256 * (h >> 1) + 128 * (dq & 1) + 32 * (2 * (h & 1) + (dq >> 1)); }
__device__ __forceinline__ int uk_row(int h, int d) { return 256 * (h >> 1) + 128 * ((d >> 5) & 1) + 32 * (2 * (h & 1) + (d >> 6)) + (d & 31); }

struct Ptrs {
    const float* in[29]; float* out; unsigned char* ws;
};
typedef const __attribute__((address_space(4))) Ptrs CPtrs;

__device__ __forceinline__ void phase_prologue(const Ctx& C, CPtrs& P) {
    unsigned char* ws = P.ws;
    LAS float* scr = (LAS float*)(C.lds + RING_OFF + C.wave * 16384);
    const int lane = C.lane;
    const int gw = C.vcu * NWAVES + C.wave, NGW = C.G * NWAVES;
    constexpr int I_GU = 16 * 176, I_DKV = 16 * 10, I_DN = 44 * 32, I_CI = 16 * 96, I_SQ = 16 * 32, I_DQ = 16 * 16, I_UQ = 8 * 48, I_UKV = 4 * 32, I_Z = 192;
    constexpr int NITEMS = I_DKV + 4 * I_DN + I_CI + I_SQ + I_DQ + I_UQ + I_SQ + 2 * I_UKV + I_Z;
    auto decode = [&](int it) -> PrepD {
        int r = it;
        if (r < I_DKV) { const int kb = r / 10, nb = r % 10; return PrepD{P.in[23], P.in[22], (bf16_t*)(ws + WS_WDKV), D, CKVW, 32 * nb, 64 * (kb), 32 * (nb)}; } r -= I_DKV;
        if (r < 4 * I_DN) { const int mi = r / I_DN; r -= mi * I_DN; const int kb = r / 32, nb = r % 32;
            const float* W = (mi & 1 ? P.in[12] : P.in[8]) + (size_t)(mi >> 1) * FF * D;
            bf16_t* dst = (bf16_t*)(ws + (mi == 0 ? WS_WDN0 : mi == 1 ? WS_WDN1 : mi == 2 ? WS_WDN2 : WS_WDN3));
            return PrepD{W, nullptr, dst, FF, D, 32 * nb, 64 * (kb), 32 * (nb)}; } r -= 4 * I_DN;
        if (r < I_CI) { const int kb = r / 96, nb = r % 96; return PrepD{P.in[13], P.in[9], (bf16_t*)(ws + WS_WCI), D, 3 * D, ci_map(nb), 64 * (kb), 32 * (nb)}; } r -= I_CI;
        if (r < I_SQ) { const int kb = r / 32, nb = r % 32; return PrepD{P.in[15], nullptr, (bf16_t*)(ws + WS_WCO), D, D, 32 * nb, 64 * (kb), 32 * (nb)}; } r -= I_SQ;
        if (r < I_DQ) { const int kb = r / 16, nb = r % 16; return PrepD{P.in[16], P.in[9] + D, (bf16_t*)(ws + WS_WDQ), D, QRANK, 32 * nb, 64 * (kb), 32 * (nb)}; } r -= I_DQ;
        if (r < I_UQ) { const int kb = r / 48, nb = r % 48; return PrepD{P.in[18], P.in[17], (bf16_t*)(ws + WS_WUQ), QRANK, NQ, 32 * nb, 64 * (kb), 32 * (nb)}; } r -= I_UQ;
        if (r < I_SQ) { const int kb = r / 32, nb = r % 32; return PrepD{P.in[21], nullptr, (bf16_t*)(ws + WS_WO), D, D, 32 * nb, 64 * (kb), 32 * (nb)}; } r -= I_SQ;
        if (r < I_UKV) { const int kb = r / 32, nb = r % 32; return PrepD{P.in[26], nullptr, (bf16_t*)(ws + WS_WUKV), KVR, D, uk_map(nb), 64 * (kb), 32 * (nb)}; } r -= I_UKV;
        if (r < I_UKV) { const int kb = r / 32, nb = r % 32; return PrepD{P.in[27], nullptr, (bf16_t*)(ws + WS_WUKV), KVR, D, 1024 + 32 * nb, 64 * (kb), 32 * (nb)}; } r -= I_UKV;
        return PrepD{nullptr, nullptr, (bf16_t*)(ws + WS_WDKV) + (size_t)(320 + r) * D, 0, 0, 0, 0, 0};
    };
    if (gw < NITEMS) {
        PrepD cur = decode(gw); f32x4 v[8]; float gk[8]; prep_load(cur, v, gk, lane);
        for (int it = gw; it < NITEMS; it += NGW) {
            PrepD nxt = cur; f32x4 vn[8]; float gn[8];
            if (it + NGW < NITEMS) { nxt = decode(it + NGW); prep_load(nxt, vn, gn, lane); }
            prep_finish(cur, v, gk, scr, lane);
            cur = nxt;
#pragma unroll
            for (int i = 0; i < 8; ++i) { v[i] = vn[i]; gk[i] = gn[i]; }
        }
    }
    {
        f32x2* tab = (f32x2*)(ws + WS_ROPE);
        for (int e = gw * 64 + lane; e < (SEQ + DS) * 32; e += NGW * 64) {
            const int pos = e >> 5, j = e & 31;
            double f = 1.0; for (int i = 0; i < j; ++i) f *= 0.74989420933245582730;
            const double ang = (double)pos * f;
            const double k = __builtin_rint(ang * 0.15915494309189533577);
            double r = __builtin_fma(-k, 6.283185307179586232, ang); r = __builtin_fma(-k, 2.4492935982947064e-16, r);
            const double r2 = r * r; double ts = 1.0, tc = 1.0, ss = 1.0, cs = 1.0;
#pragma unroll
            for (int q = 1; q <= 14; ++q) { tc *= -r2 / (double)((2 * q - 1) * (2 * q)); cs += tc; ts *= -r2 / (double)((2 * q) * (2 * q + 1)); ss += ts; }
            tab[e] = (f32x2){(float)cs, (float)(ss * r)};
        }
    }
    {
        bf16_t* XB = (bf16_t*)(ws + WS_XB); float* ssq = (float*)(ws + WS_CTL) + F_SSQX; unsigned char* A8 = ws + WS_A8; float* SA = (float*)(ws + WS_SA);
        for (int row0 = gw; row0 < T; row0 += 2 * NGW) {
            f32x4 v[2][4]; float s[2]; const int nr = row0 + NGW < T ? 2 : 1;
#pragma unroll
            for (int q = 0; q < 2; ++q) { const int row = row0 + (q < nr ? q * NGW : 0); const float* src = row < TP ? P.in[0] + (size_t)row * D : P.in[1] + (size_t)(row - TP) * D;
#pragma unroll
                for (int j = 0; j < 4; ++j) v[q][j] = *((const f32x4*)src + lane + 64 * j); }
#pragma unroll
            for (int q = 0; q < 2; ++q) { s[q] = 0.f;
#pragma unroll
                for (int j = 0; j < 4; ++j) s[q] += (v[q][j].x * v[q][j].x + v[q][j].y * v[q][j].y) + (v[q][j].z * v[q][j].z + v[q][j].w * v[q][j].w);
                s[q] = wave_sum(s[q]); }
#pragma unroll
            for (int q = 0; q < 2; ++q) if (q < nr) { const int row = row0 + q * NGW;
#pragma unroll
                for (int j = 0; j < 4; ++j) {
                    u32x2 w; w.x = cvt_pk_bf16(v[q][j].x, v[q][j].y); w.y = cvt_pk_bf16(v[q][j].z, v[q][j].w); *((u32x2*)(XB + (size_t)row * D) + lane + 64 * j) = w; }
                if (lane == 0) ssq[row] = s[q];
                float am = 0.f;
#pragma unroll
                for (int j = 0; j < 4; ++j) am = fmaxf(am, fmaxf(fmaxf(fabsf(v[q][j].x), fabsf(v[q][j].y)), fmaxf(fabsf(v[q][j].z), fabsf(v[q][j].w))));
#pragma unroll
                for (int o = 1; o < 64; o <<= 1) am = fmaxf(am, __shfl_xor(am, o));
                const float inv = am > 0.f ? 127.0f / am : 0.f;
#pragma unroll
                for (int j = 0; j < 4; ++j) { const int q0 = __float2int_rn(v[q][j].x * inv), q1 = __float2int_rn(v[q][j].y * inv), q2 = __float2int_rn(v[q][j].z * inv), q3 = __float2int_rn(v[q][j].w * inv);
                    *(unsigned*)(A8 + (size_t)row * D + 4 * (lane + 64 * j)) = (unsigned)(q0 & 255) | ((unsigned)(q1 & 255) << 8) | ((unsigned)(q2 & 255) << 16) | ((unsigned)q3 << 24); }
                if (lane == 0) SA[row] = am * (1.0f / 127.0f); }
        }
    }
}

#ifndef SA_INT8_COPY_ONLY
#define SA_INT8_COPY_ONLY 1
#endif
__device__ __forceinline__ void phase_cacheconv(const Ctx& C, CPtrs& P, int cw, int nconv) {
    unsigned char* ws = P.ws; const int lane = C.lane;
    const int* pt = (const int*)P.in[5]; bf16_t* CLB = (bf16_t*)(ws + WS_CLB); unsigned char* CL8 = ws + WS_CL8; float* SC2 = (float*)(ws + WS_SC2);
    for (int pg = cw * NWAVES + C.wave; pg < DB * NPG; pg += nconv * NWAVES) {
        const int phys = pt[pg];
        const float* sl = P.in[2] + (size_t)phys * PAGE * KVR; bf16_t* dl = CLB + (size_t)pg * PAGE * KVR;
        for (int i0 = 0; i0 < 64; i0 += 8) {
            f32x4 a[8], c[8];
#pragma unroll
            for (int j = 0; j < 8; ++j) { a[j] = *((const f32x4*)sl + 2 * (lane + 64 * (i0 + j))); c[j] = *((const f32x4*)sl + 2 * (lane + 64 * (i0 + j)) + 1); }
#pragma unroll
            for (int j = 0; j < 8; ++j) {
#if !SA_INT8_COPY_ONLY
                { v4u w; w.x = cvt_pk_bf16(a[j].x, a[j].y); w.y = cvt_pk_bf16(a[j].z, a[j].w); w.z = cvt_pk_bf16(c[j].x, c[j].y); w.w = cvt_pk_bf16(c[j].z, c[j].w); *((v4u*)dl + lane + 64 * (i0 + j)) = w; }
#endif
                float am = fmaxf(fmaxf(fmaxf(fabsf(a[j].x), fabsf(a[j].y)), fmaxf(fabsf(a[j].z), fabsf(a[j].w))), fmaxf(fmaxf(fabsf(c[j].x), fabsf(c[j].y)), fmaxf(fabsf(c[j].z), fabsf(c[j].w))));
#pragma unroll
                for (int o = 1; o < 32; o <<= 1) am = fmaxf(am, __shfl_xor(am, o));
                const float inv = am > 0.f ? 127.0f / am : 0.f;
                const int q0 = __float2int_rn(a[j].x * inv), q1 = __float2int_rn(a[j].y * inv), q2 = __float2int_rn(a[j].z * inv), q3 = __float2int_rn(a[j].w * inv);
                const int q4 = __float2int_rn(c[j].x * inv), q5 = __float2int_rn(c[j].y * inv), q6 = __float2int_rn(c[j].z * inv), q7 = __float2int_rn(c[j].w * inv);
                u32x2 qw; qw.x = (unsigned)(q0 & 255) | ((unsigned)(q1 & 255) << 8) | ((unsigned)(q2 & 255) << 16) | ((unsigned)q3 << 24);
                qw.y = (unsigned)(q4 & 255) | ((unsigned)(q5 & 255) << 8) | ((unsigned)(q6 & 255) << 16) | ((unsigned)q7 << 24);
                const size_t row = (size_t)pg * PAGE + 2 * (i0 + j) + (lane >> 5);
                *(u32x2*)(CL8 + row * KVR + 8 * (lane & 31)) = qw;
                if ((lane & 31) == 0) { const float sc = am * (1.0f / 127.0f); SC2[row] = sc * sc; } }
        }
    }
}

__device__ __forceinline__ void phase_w8(const Ctx& C, CPtrs& P) {
    unsigned char* ws = P.ws; const float* wuk = P.in[26]; unsigned char* W8 = ws + WS_W8; float* T2 = (float*)(ws + WS_T2); const int lane = C.lane;
    for (int r = C.vcu * NWAVES + C.wave; r < D; r += C.G * NWAVES) {
        const int pn = r >> 8, bj = (r >> 7) & 1, wc = (r >> 5) & 3, h = 2 * pn + (wc >> 1), d = 64 * (wc & 1) + 32 * bj + (r & 31), col = 128 * h + d;
        float x[4]; float am = 0.f;
#pragma unroll
        for (int e = 0; e < 4; ++e) { x[e] = wuk[(size_t)(4 * lane + e) * D + col]; am = fmaxf(am, fabsf(x[e])); }
#pragma unroll
        for (int o = 1; o < 64; o <<= 1) am = fmaxf(am, __shfl_xor(am, o));
        const float inv = am > 0.f ? 127.0f / am : 0.f;
        const int q0 = __float2int_rn(x[0] * inv), q1 = __float2int_rn(x[1] * inv), q2 = __float2int_rn(x[2] * inv), q3 = __float2int_rn(x[3] * inv);
        *(unsigned*)(W8 + (size_t)r * KVR + 4 * lane) = (unsigned)(q0 & 255) | ((unsigned)(q1 & 255) << 8) | ((unsigned)(q2 & 255) << 16) | ((unsigned)q3 << 24);
        if (lane == 0) { const float sc = am * (1.0f / 127.0f); T2[r] = sc * sc; }
    }
}

__device__ __forceinline__ void phase_quant(const Ctx& C, CPtrs& P, const float* slab = nullptr, int ns = 0, float* ssq_out = nullptr) {
    unsigned char* ws = P.ws; bf16_t* XB = (bf16_t*)(ws + WS_XB); unsigned char* A8 = ws + WS_A8; float* SA = (float*)(ws + WS_SA);
    const int gw = C.vcu * NWAVES + C.wave, NGW = C.G * NWAVES, lane = C.lane;
    if (slab) {
        for (int r = gw; r < TS; r += NGW) { const size_t row = (size_t)TP + r; f32x4 v[4]; float ss = 0.f, am = 0.f;
#pragma unroll
            for (int j = 0; j < 4; ++j) { const u32x2 xw = *((const u32x2*)(XB + row * D) + lane + 64 * j); f32x4 a = {bflo(xw.x), bfhi(xw.x), bflo(xw.y), bfhi(xw.y)};
                for (int c = 0; c < ns; ++c) a += *((const f32x4*)(slab + ((size_t)c * TS + r) * D) + lane + 64 * j);
                v[j] = a; ss += (a.x * a.x + a.y * a.y) + (a.z * a.z + a.w * a.w); am = fmaxf(am, fmaxf(fmaxf(fabsf(a.x), fabsf(a.y)), fmaxf(fabsf(a.z), fabsf(a.w)))); }
            ss = wave_sum(ss);
#pragma unroll
            for (int o = 1; o < 64; o <<= 1) am = fmaxf(am, __shfl_xor(am, o));
            const float inv = am > 0.f ? 127.0f / am : 0.f;
#pragma unroll
            for (int j = 0; j < 4; ++j) { u32x2 w; w.x = cvt_pk_bf16(v[j].x, v[j].y); w.y = cvt_pk_bf16(v[j].z, v[j].w); *((u32x2*)(XB + row * D) + lane + 64 * j) = w;
                const int q0 = __float2int_rn(v[j].x * inv), q1 = __float2int_rn(v[j].y * inv), q2 = __float2int_rn(v[j].z * inv), q3 = __float2int_rn(v[j].w * inv);
                *(unsigned*)(A8 + row * D + 4 * (lane + 64 * j)) = (unsigned)(q0 & 255) | ((unsigned)(q1 & 255) << 8) | ((unsigned)(q2 & 255) << 16) | ((unsigned)q3 << 24); }
            if (lane == 0) { ssq_out[row] = ss; SA[row] = am * (1.0f / 127.0f); } }
    }
    const int TQ = slab ? TP : T;
    constexpr int RPS = 4;
    for (int row0 = gw; row0 < TQ; row0 += RPS * NGW) {
        v4u w[RPS][2];
#pragma unroll
        for (int q = 0; q < RPS; ++q) { const int rq = row0 + q * NGW, row = rq < TQ ? rq : row0; w[q][0] = *((const v4u*)(XB + (size_t)row * D) + 2 * lane); w[q][1] = *((const v4u*)(XB + (size_t)row * D) + 2 * lane + 1); }
#pragma unroll
        for (int q = 0; q < RPS; ++q) if (row0 + q * NGW < TQ) { const int row = row0 + q * NGW; float x[16]; unpack8f(w[q][0], x); unpack8f(w[q][1], x + 8);
            float am = 0.f;
#pragma unroll
            for (int e = 0; e < 16; ++e) am = fmaxf(am, fabsf(x[e]));
#pragma unroll
            for (int o = 1; o < 64; o <<= 1) am = fmaxf(am, __shfl_xor(am, o));
            const float inv = am > 0.f ? 127.0f / am : 0.f; v4u o4; unsigned ww[4];
#pragma unroll
            for (int g = 0; g < 4; ++g) { const int q0 = __float2int_rn(x[4 * g] * inv), q1 = __float2int_rn(x[4 * g + 1] * inv), q2 = __float2int_rn(x[4 * g + 2] * inv), q3 = __float2int_rn(x[4 * g + 3] * inv);
                ww[g] = (unsigned)(q0 & 255) | ((unsigned)(q1 & 255) << 8) | ((unsigned)(q2 & 255) << 16) | ((unsigned)q3 << 24); }
            o4.x = ww[0]; o4.y = ww[1]; o4.z = ww[2]; o4.w = ww[3];
            *((v4u*)(A8 + (size_t)row * D) + lane) = o4;
            if (lane == 0) SA[row] = am * (1.0f / 127.0f); }
    }
}
__device__ __forceinline__ void phase_w8gu(const Ctx& C, CPtrs& P) {
    unsigned char* ws = P.ws; const int lane = C.lane, r = lane >> 3, c4 = lane & 7;
    LAS float* scr = (LAS float*)(C.lds + RING_OFF + C.wave * 16384);
    for (int item = C.vcu * NWAVES + C.wave; item < 4 * 176; item += C.G * NWAVES) {
        const int mi = item / 176, nb = item % 176, n0 = 32 * nb, N = 2 * FF;
        const float* W = (mi & 1 ? P.in[11] : P.in[7]) + (size_t)(mi >> 1) * D * N; const float* g = (mi & 1 ? P.in[10] : P.in[6]) + (mi >> 1) * D;
        unsigned char* W8 = ws + WS_W8GU0 + (size_t)mi * WS_W8GU_STRIDE; float* TS = (float*)(ws + WS_TGU) + mi * N;
        const int drow0 = gu_map(nb);
        float am[4] = {0.f, 0.f, 0.f, 0.f};
#pragma unroll 16
        for (int kb = 0; kb < D / 8; ++kb) { const int k = 8 * kb + r; const f32x4 v = *(const f32x4*)(W + (size_t)k * N + n0 + 4 * c4); const float gk = g[k];
            am[0] = fmaxf(am[0], fabsf(v.x * gk)); am[1] = fmaxf(am[1], fabsf(v.y * gk)); am[2] = fmaxf(am[2], fabsf(v.z * gk)); am[3] = fmaxf(am[3], fabsf(v.w * gk)); }
        float inv[4];
#pragma unroll
        for (int j = 0; j < 4; ++j) { float a = am[j]; a = fmaxf(a, __shfl_xor(a, 8)); a = fmaxf(a, __shfl_xor(a, 16)); a = fmaxf(a, __shfl_xor(a, 32)); inv[j] = a > 0.f ? 127.0f / a : 0.f; am[j] = a; }
        if (r == 0) *(f32x4*)(TS + drow0 + 4 * c4) = (f32x4){am[0] * (1.0f / 127.0f), am[1] * (1.0f / 127.0f), am[2] * (1.0f / 127.0f), am[3] * (1.0f / 127.0f)};
        for (int k0 = 0; k0 < D; k0 += 64) {
            f32x4 v[8]; float gk[8];
#pragma unroll
            for (int i = 0; i < 8; ++i) { v[i] = *(const f32x4*)(W + (size_t)(k0 + 8 * i + r) * N + n0 + 4 * c4); gk[i] = g[k0 + 8 * i + r]; }
#pragma unroll
            for (int i = 0; i < 8; ++i) { LAS float* sp = scr + (8 * i + r) * 33 + 4 * c4;
                sp[0] = __builtin_rintf(v[i].x * gk[i] * inv[0]); sp[1] = __builtin_rintf(v[i].y * gk[i] * inv[1]); sp[2] = __builtin_rintf(v[i].z * gk[i] * inv[2]); sp[3] = __builtin_rintf(v[i].w * gk[i] * inv[3]); }
            LDS_WAIT(); asm volatile("" ::: "memory");
            const int c = lane & 7;
#pragma unroll
            for (int j = 0; j < 4; ++j) { const int n = (lane >> 3) + 8 * j; const LAS float* s = scr + (8 * c) * 33 + n;
                const int q0 = (int)s[0 * 33], q1 = (int)s[1 * 33], q2 = (int)s[2 * 33], q3 = (int)s[3 * 33], q4 = (int)s[4 * 33], q5 = (int)s[5 * 33], q6 = (int)s[6 * 33], q7 = (int)s[7 * 33];
                u32x2 o; o.x = (unsigned)(q0 & 255) | ((unsigned)(q1 & 255) << 8) | ((unsigned)(q2 & 255) << 16) | ((unsigned)q3 << 24);
                o.y = (unsigned)(q4 & 255) | ((unsigned)(q5 & 255) << 8) | ((unsigned)(q6 & 255) << 16) | ((unsigned)q7 << 24);
                *(u32x2*)(W8 + (size_t)(drow0 + n) * D + k0 + 8 * c) = o; }
            LDS_WAIT(); asm volatile("" ::: "memory");
        }
    }
}

__device__ __forceinline__ void phase_conv(const Ctx& C, CPtrs& P) {
    unsigned char* ws = P.ws; const bf16_t* BB = (const bf16_t*)(ws + WS_BB); const bf16_t* UB = (const bf16_t*)(ws + WS_UB); bf16_t* ZB = (bf16_t*)(ws + WS_ZB);
    const float* cw = P.in[14]; const float* st = P.in[4];
    const int gw = C.vcu * NWAVES + C.wave, NGW = C.G * NWAVES, lane = C.lane;
    for (int row = gw; row < T; row += NGW) {
        int have1, have2; const float* s1 = nullptr; const float* s2 = nullptr;
        if (row < TP) { const int t = row & (SEQ - 1); have1 = t >= 1; have2 = t >= 2; }
        else { const int r = row - TP, i = r & 3, b = r >> 2; have1 = i >= 1; have2 = i >= 2;
            if (!have1) s1 = st + (size_t)(b * 2 + 1) * D; if (!have2) s2 = st + (size_t)(b * 2 + i) * D; }
        v4u rb[2], r0[2], r1[2], r2[2];
#pragma unroll
        for (int j = 0; j < 2; ++j) { const int ch = 8 * lane + 512 * j; rb[j] = *(const v4u*)(BB + (size_t)row * D + ch); r0[j] = *(const v4u*)(UB + (size_t)row * D + ch);
            r1[j] = have1 ? *(const v4u*)(UB + (size_t)(row - 1) * D + ch) : (v4u){0u, 0u, 0u, 0u}; r2[j] = have2 ? *(const v4u*)(UB + (size_t)(row - 2) * D + ch) : (v4u){0u, 0u, 0u, 0u}; }
#pragma unroll
        for (int j = 0; j < 2; ++j) {
            const int ch = 8 * lane + 512 * j;
            float b8[8], u0[8], u1[8], u2[8], z[8];
            unpack8f(rb[j], b8); unpack8f(r0[j], u0); unpack8f(r1[j], u1); unpack8f(r2[j], u2);
            if (!have1 && s1) { const f32x4 a = *(const f32x4*)(s1 + ch), b = *(const f32x4*)(s1 + ch + 4); u1[0] = a.x; u1[1] = a.y; u1[2] = a.z; u1[3] = a.w; u1[4] = b.x; u1[5] = b.y; u1[6] = b.z; u1[7] = b.w; }
            if (!have2 && s2) { const f32x4 a = *(const f32x4*)(s2 + ch), b = *(const f32x4*)(s2 + ch + 4); u2[0] = a.x; u2[1] = a.y; u2[2] = a.z; u2[3] = a.w; u2[4] = b.x; u2[5] = b.y; u2[6] = b.z; u2[7] = b.w; }
#pragma unroll
            for (int e = 0; e < 8; ++e) z[e] = b8[e] * (cw[ch + e] * u2[e] + cw[D + ch + e] * u1[e] + cw[2 * D + ch + e] * u0[e]);
            *(v4u*)(ZB + (size_t)row * D + ch) = pack8f(z);
        }
    }
}

__device__ __forceinline__ void phase_kvfin(const Ctx& C, CPtrs& P) {
    unsigned char* ws = P.ws; const float* ckv = (const float*)(ws + WS_CKV); const float* ctl = (const float*)(ws + WS_CTL);
    bf16_t* LATB = (bf16_t*)(ws + WS_LATB); bf16_t* KPEB = (bf16_t*)(ws + WS_KPEB); const f32x2* tab = (const f32x2*)(ws + WS_ROPE);
    int lane = C.lane; asm volatile("" : "+v"(lane));
    const int gw = C.vcu * NWAVES + C.wave, NGW = C.G * NWAVES;
    const f32x4 gl = *((const f32x4*)P.in[24] + lane); const float gk = P.in[25][lane];
    for (int row0 = gw; row0 < T; row0 += 2 * NGW) {
        const int nr = row0 + NGW < T ? 2 : 1;
        float sl_[2], sk_[2], xk[2]; f32x4 vl[2]; f32x2 cs[2]; int rowq[2], posq[2];
#pragma unroll
        for (int q = 0; q < 2; ++q) { const int row = row0 + (q < nr ? q * NGW : 0); rowq[q] = row; posq[q] = row < TP ? (row & (SEQ - 1)) : SEQ + ((row - TP) & 3);
            sl_[q] = ctl[F_SSQLAT + row]; sk_[q] = ctl[F_SSQKPE + row]; vl[q] = *((const f32x4*)(ckv + (size_t)row * CKVW) + lane); xk[q] = ckv[(size_t)row * CKVW + KVR + lane]; cs[q] = tab[posq[q] * 32 + (lane & 31)]; }
#pragma unroll
        for (int q = 0; q < 2; ++q) if (q < nr) { const int row = rowq[q];
            const float rl = rsq(sl_[q] * (1.0f / KVR) + EPS), rk = rsq(sk_[q] * (1.0f / ROPE) + EPS);
            const f32x4 v = vl[q] * rl * gl;
            float* ol = row < TP ? P.out + OUT_LATP + (size_t)row * KVR : P.out + OUT_LATS + (size_t)(row - TP) * KVR;
            *((f32x4*)ol + lane) = v;
            u32x2 w; w.x = cvt_pk_bf16(v.x, v.y); w.y = cvt_pk_bf16(v.z, v.w); *((u32x2*)(LATB + (size_t)row * KVR) + lane) = w;
            const float xn = xk[q] * rk * gk, pr = __shfl_xor(xn, 32);
            const float o = lane < 32 ? xn * cs[q].x - pr * cs[q].y : xn * cs[q].x + pr * cs[q].y;
            float* ok = row < TP ? P.out + OUT_KPEP + (size_t)row * ROPE : P.out + OUT_KPES + (size_t)(row - TP) * ROPE;
            ok[lane] = o;
            const float on = __shfl_xor(o, 1);
            if ((lane & 1) == 0) *(unsigned*)(KPEB + (size_t)row * ROPE + lane) = cvt_pk_bf16(o, on); }
    }
}

__device__ __forceinline__ void phase_qkfin(const Ctx& C, CPtrs& P) {
    unsigned char* ws = P.ws; const float* ctl = (const float*)(ws + WS_CTL); bf16_t* QB = (bf16_t*)(ws + WS_QB); bf16_t* KN = (bf16_t*)(ws + WS_KN);
    const float* RPT = (const float*)(ws + WS_RPT); const f32x2* tab = (const f32x2*)(ws + WS_ROPE);
    const float* gqn = P.in[19]; const float* gqp = P.in[20]; const float* gkn = P.in[28];
    int lane = C.lane; asm volatile("" : "+v"(lane));
    const int gw = C.vcu * NWAVES + C.wave, NGW = C.G * NWAVES;
    for (int row = gw; row < TP; row += NGW) {
        const int pos = row & (SEQ - 1);
        const float* sq = ctl + F_SSQQ + row;
        bf16_t* pq[2]; bf16_t* pk[2]; v4u vq[2], vk[2]; float rq[2], rk[2];
#pragma unroll
        for (int it = 0; it < 2; ++it) { const int h = 4 * it + (lane >> 4), c = lane & 15; pq[it] = QB + (size_t)row * NQ + HD * h + 8 * c; vq[it] = *(const v4u*)pq[it]; rq[it] = sq[(size_t)(2 * h) * T];
            const int ci = lane + 64 * it, hk = ci >> 4, ck = ci & 15; pk[it] = KN + (size_t)row * D + 128 * hk + 8 * ck; vk[it] = *(const v4u*)pk[it];
            rk[it] = RPT[(size_t)(2 * hk) * T + row] + RPT[(size_t)(2 * hk + 1) * T + row]; }
        bf16_t* pr = QB + (size_t)row * NQ + HD * (lane >> 3) + 128 + 8 * (lane & 7); const v4u vr = *(const v4u*)pr; const float rr = sq[(size_t)(2 * (lane >> 3) + 1) * T];
#pragma unroll
        for (int it = 0; it < 2; ++it) { const int c = lane & 15; const float rs = rsq(rq[it] * (1.0f / 128) + EPS) * QSCALE; float x[8]; unpack8f(vq[it], x);
#pragma unroll
            for (int e = 0; e < 8; ++e) x[e] = x[e] * rs * gqn[8 * c + e];
            *(v4u*)pq[it] = pack8f(x); }
        { const int c = lane & 7; const float rs = rsq(rr * (1.0f / 64) + EPS); float x[8], y[8]; unpack8f(vr, x);
#pragma unroll
            for (int e = 0; e < 8; ++e) x[e] = x[e] * rs * gqp[8 * c + e];
#pragma unroll
            for (int e = 0; e < 8; ++e) { const float prt = __shfl_xor(x[e], 4); const f32x2 cs = tab[pos * 32 + ((8 * c + e) & 31)];
                y[e] = (c < 4 ? x[e] * cs.x - prt * cs.y : x[e] * cs.x + prt * cs.y) * QSCALE; }
            *(v4u*)pr = pack8f(y); }
#pragma unroll
        for (int jj = 0; jj < 2; ++jj) { const int c = (lane + 64 * jj) & 15; const float rs = rsq(rk[jj] * (1.0f / 128) + EPS); float x[8]; unpack8f(vk[jj], x);
#pragma unroll
            for (int e = 0; e < 8; ++e) x[e] = x[e] * rs * gkn[8 * c + e];
            *(v4u*)pk[jj] = pack8f(x); }
    }
    { float* RTS = (float*)(ws + WS_RTS);
      for (int i = C.vcu * (NWAVES * 64) + C.tid; i < TS * NH; i += C.G * (NWAVES * 64)) { const int rsi = i >> 3, h = i & 7; const size_t rw = (size_t)TP + rsi;
          RTS[i] = rsq((RPT[(size_t)(2 * h) * T + rw] + RPT[(size_t)(2 * h + 1) * T + rw]) * (1.0f / 128) + EPS); } }
    {
        LAS float* A = (LAS float*)(C.lds + RING_OFF + C.wave * 1024);
        const bf16_t* WUK = (const bf16_t*)(ws + WS_WUKV); bf16_t* QS = (bf16_t*)(ws + WS_QS);
        for (int item = gw; item < TS * NH; item += NGW) {
            const int rsi = item >> 3, h = item & 7, row = TP + rsi;
            const float* sq = ctl + F_SSQQ + row;
            { const unsigned w = *(const unsigned*)(QB + (size_t)row * NQ + HD * h + 2 * lane); const float rs = rsq(sq[(size_t)(2 * h) * T] * (1.0f / 128) + EPS);
              A[2 * lane] = bflo(w) * rs * gqn[2 * lane] * gkn[2 * lane]; A[2 * lane + 1] = bfhi(w) * rs * gqn[2 * lane + 1] * gkn[2 * lane + 1]; }
            { const float x = bf2f(QB[(size_t)row * NQ + HD * h + 128 + lane]) * rsq(sq[(size_t)(2 * h + 1) * T] * (1.0f / 64) + EPS) * gqp[lane], pr = __shfl_xor(x, 32);
              const f32x2 cs = tab[(SEQ + (rsi & 3)) * 32 + (lane & 31)];
              const float o = (lane < 32 ? x * cs.x - pr * cs.y : x * cs.x + pr * cs.y) * QSCALE, on = __shfl_xor(o, 1);
              if ((lane & 1) == 0) *(unsigned*)(QS + (size_t)item * 320 + 256 + lane) = cvt_pk_bf16(o, on); }
            LDS_WAIT(); asm volatile("" ::: "memory");
            float acc[4] = {0.f, 0.f, 0.f, 0.f};
#pragma unroll 32
            for (int d = 0; d < 128; ++d) { const u32x2 w = *(const u32x2*)(WUK + (size_t)uk_row(h, d) * KVR + 4 * lane); const float ad = A[d];
                acc[0] += bflo(w.x) * ad; acc[1] += bfhi(w.x) * ad; acc[2] += bflo(w.y) * ad; acc[3] += bfhi(w.y) * ad; }
            u32x2 o; o.x = cvt_pk_bf16(acc[0] * QSCALE, acc[1] * QSCALE); o.y = cvt_pk_bf16(acc[2] * QSCALE, acc[3] * QSCALE);
            *(u32x2*)(QS + (size_t)item * 320 + 4 * lane) = o;
            LDS_WAIT(); asm volatile("" ::: "memory");
        }
    }
}

__device__ __forceinline__ void phase_scomb(const Ctx& C, CPtrs& P) {
    unsigned char* ws = P.ws; const float* PO = (const float*)(ws + WS_PO); const float* PML = (const float*)(ws + WS_PML); bf16_t* OB = (bf16_t*)(ws + WS_OB);
    const float* wuv = P.in[27];
    const int gw = C.vcu * NWAVES + C.wave, NGW = C.G * NWAVES, lane = C.lane;
    LAS float* OL = (LAS float*)(C.lds + RING_OFF + C.wave * 1024);
    for (int item = gw; item < TS * NH; item += NGW) {
        const int rsi = item >> 3, h = item & 7, b = rsi >> 2, q = rsi & 3, rho = q * 8 + h;
        const size_t i0 = (size_t)(b * 2 + 0) * 32 + rho, i1 = (size_t)(b * 2 + 1) * 32 + rho;
        const float m0 = PML[i0 * 2], l0 = PML[i0 * 2 + 1], m1 = PML[i1 * 2], l1 = PML[i1 * 2 + 1];
        const float mm = fmaxf(m0, m1), f0 = __builtin_amdgcn_exp2f(m0 - mm), f1 = __builtin_amdgcn_exp2f(m1 - mm), inv = 1.0f / (l0 * f0 + l1 * f1);
        { const f32x4 a = *((const f32x4*)(PO + i0 * 256) + lane), c = *((const f32x4*)(PO + i1 * 256) + lane); *((LAS f32x4*)OL + lane) = (a * f0 + c * f1) * inv; }
        LDS_WAIT(); asm volatile("" ::: "memory");
        float a0 = 0.f, a1 = 0.f; const float* wp = wuv + 128 * h + 2 * lane;
#pragma unroll 32
        for (int n = 0; n < KVR; ++n) { const f32x2 w = *(const f32x2*)(wp + (size_t)n * D); const float on = OL[n]; a0 += on * w.x; a1 += on * w.y; }
        *(unsigned*)(OB + (size_t)(TP + rsi) * D + 128 * h + 2 * lane) = cvt_pk_bf16(a0, a1);
        LDS_WAIT(); asm volatile("" ::: "memory");
    }
}

namespace att {
typedef short bf16x8 __attribute__((ext_vector_type(8)));
typedef short s16x4 __attribute__((ext_vector_type(4)));
typedef float f32x16 __attribute__((ext_vector_type(16)));
typedef float f32x4 __attribute__((ext_vector_type(4)));
typedef unsigned u32x4 __attribute__((ext_vector_type(4)));
constexpr float THR = 11.5f;
#define SBAR() __builtin_amdgcn_sched_barrier(0)
__device__ __forceinline__ int crow(int r, int hi) { return (r & 3) + 8 * (r >> 2) + 4 * hi; }
__device__ __forceinline__ unsigned cvtpk(float lo, float hi) { unsigned r; asm volatile("v_cvt_pk_bf16_f32 %0, %1, %2" : "=v"(r) : "v"(lo), "v"(hi)); return r; }
__device__ __forceinline__ float xmax32(float v) { auto rr = __builtin_amdgcn_permlane32_swap(__float_as_uint(v), __float_as_uint(v), false, false); return fmaxf(__uint_as_float(rr[0]), __uint_as_float(rr[1])); }
__device__ __forceinline__ float xsum32(float v) { auto rr = __builtin_amdgcn_permlane32_swap(__float_as_uint(v), __float_as_uint(v), false, false); return __uint_as_float(rr[0]) + __uint_as_float(rr[1]); }
#define PK4(P, B_, OUT) do { unsigned a0 = cvtpk(P[B_+0], P[B_+1]), a1 = cvtpk(P[B_+2], P[B_+3]);                          \
        unsigned b0 = cvtpk(P[B_+4], P[B_+5]), b1 = cvtpk(P[B_+6], P[B_+7]);                                             \
        auto r0 = __builtin_amdgcn_permlane32_swap(a0, b0, false, false); auto r1 = __builtin_amdgcn_permlane32_swap(a1, b1, false, false); \
        u32x4 w = {r0[0], r1[0], r0[1], r1[1]}; OUT = *reinterpret_cast<bf16x8*>(&w); } while (0)

namespace pa {
constexpr int KVBLK = 64, QBLK = 32, QB = 256;
constexpr int SHM_V = 16384, SHM_K = 16384, SHM_R = 8192;
constexpr int OFF_V = 0, OFF_K = 2 * SHM_V, OFF_R = OFF_K + 2 * SHM_K, OFF_WS = OFF_R + 2 * SHM_R;
#define KSWZ(row, colB) ((row) * 256 + ((colB) ^ (((row) & 7) << 4)))
__device__ __forceinline__ int v_st(int k, int c) { const int kk = (k & ~0xC) | ((k & 4) << 1) | ((k & 8) >> 1); return ((kk >> 3) * 4 + (c >> 5)) * 512 + ((kk & 7) * 32 + (c & 31)) * 2; }
__device__ __forceinline__ int v_rd_base(int lane) { return ((lane & 3) << 3) | (((lane >> 2) & 3) << 6) | (((lane >> 4) & 1) << 5) | (((lane >> 5) & 1) << 8); }
constexpr int v_rd_off(int d0, int ks, int half) { return d0 * 512 + ks * 4096 + half * 2048; }
__device__ __forceinline__ void mask_tile(f32x16& p0, f32x16& p1, int dq) {
    const float NEG = -__builtin_inff();
#pragma unroll
    for (int r = 0; r < 16; ++r) { const int c = (r & 3) + 8 * (r >> 2); if (dq - c < 0) p0[r] = NEG; if (dq - c - 32 < 0) p1[r] = NEG; }
}
__device__ __forceinline__ void softmax_tile(f32x16& p0, f32x16& p1, float& m_reg, float& l_reg, float& alpha, bf16x8& pa0, bf16x8& pa1, bf16x8& pa2, bf16x8& pa3) {
    float pmax = p0[0];
#pragma unroll
    for (int r = 1; r < 16; ++r) pmax = fmaxf(pmax, p0[r]);
#pragma unroll
    for (int r = 0; r < 16; ++r) pmax = fmaxf(pmax, p1[r]);
    pmax = xmax32(pmax);
    float mn;
    if (__builtin_expect(__all((pmax - m_reg) <= THR), 1)) { mn = m_reg; alpha = 1.f; }
    else { mn = fmaxf(m_reg, pmax); alpha = __builtin_amdgcn_exp2f(m_reg - mn); m_reg = mn; }
#pragma unroll
    for (int r = 0; r < 16; ++r) { p0[r] = __builtin_amdgcn_exp2f(p0[r] - mn); p1[r] = __builtin_amdgcn_exp2f(p1[r] - mn); }
    float ps = 0.f;
#pragma unroll
    for (int r = 0; r < 16; ++r) ps += p0[r];
#pragma unroll
    for (int r = 0; r < 16; ++r) ps += p1[r];
    ps = xsum32(ps);
    l_reg = l_reg * alpha + ps;
    PK4(p0, 0, pa0); PK4(p0, 8, pa1); PK4(p1, 0, pa2); PK4(p1, 8, pa3);
}
template <int KB>
__device__ __forceinline__ void qkt(f32x16& p0, f32x16& p1, const char* lds, int r32, int hi, const bf16x8* qr) {
    p0 = f32x16{}; p1 = f32x16{};
    const char* kb[4];
#pragma unroll
    for (int dd = 0; dd < 4; ++dd) kb[dd] = lds + OFF_K + KB * SHM_K + KSWZ(r32, (dd * 16 + hi * 8) * 2);
#pragma unroll
    for (int d0 = 0; d0 < 8; ++d0) { const char* a = kb[d0 & 3] + (d0 >> 2) * 128;
        const bf16x8 b0 = *reinterpret_cast<const bf16x8*>(a), b1 = *reinterpret_cast<const bf16x8*>(a + 32 * 256);
        p0 = __builtin_amdgcn_mfma_f32_32x32x16_bf16(b0, qr[d0], p0, 0, 0, 0);
        p1 = __builtin_amdgcn_mfma_f32_32x32x16_bf16(b1, qr[d0], p1, 0, 0, 0); }
    const int sw = (r32 >> 1) & 7; const char* rb = lds + OFF_R + KB * SHM_R + r32 * 128;
#pragma unroll
    for (int s = 0; s < 4; ++s) { const char* a = rb + (((2 * s + hi) ^ sw) << 4);
        const bf16x8 b0 = *reinterpret_cast<const bf16x8*>(a), b1 = *reinterpret_cast<const bf16x8*>(a + 32 * 128);
        p0 = __builtin_amdgcn_mfma_f32_32x32x16_bf16(b0, qr[8 + s], p0, 0, 0, 0);
        p1 = __builtin_amdgcn_mfma_f32_32x32x16_bf16(b1, qr[8 + s], p1, 0, 0, 0); }
}
template <int VB>
__device__ __forceinline__ void pv_tile(f32x16* o, int vb0, bf16x8 pa0, bf16x8 pa1, bf16x8 pa2, bf16x8 pa3) {
#define TRRD(dst, off) asm volatile("ds_read_b64_tr_b16 %0, %1 offset:%2" : "=&v"(dst) : "v"(vb0), "i"(off) : "memory")
#define PV_KS(ks, PA) do { s16x4 l0, l1, l2, l3, h0, h1, h2, h3; constexpr int b_ = OFF_V + VB * SHM_V + v_rd_off(0, ks, 0);   \
        TRRD(l0, b_); TRRD(h0, b_ + 2048); TRRD(l1, b_ + 512); TRRD(h1, b_ + 512 + 2048); TRRD(l2, b_ + 1024); TRRD(h2, b_ + 1024 + 2048); TRRD(l3, b_ + 1536); TRRD(h3, b_ + 1536 + 2048); \
        asm volatile("s_waitcnt lgkmcnt(0)" ::: "memory"); SBAR();   \
        o[0] = __builtin_amdgcn_mfma_f32_32x32x16_bf16(PA, (bf16x8){l0[0], l0[1], l0[2], l0[3], h0[0], h0[1], h0[2], h0[3]}, o[0], 0, 0, 0);   \
        o[1] = __builtin_amdgcn_mfma_f32_32x32x16_bf16(PA, (bf16x8){l1[0], l1[1], l1[2], l1[3], h1[0], h1[1], h1[2], h1[3]}, o[1], 0, 0, 0);   \
        o[2] = __builtin_amdgcn_mfma_f32_32x32x16_bf16(PA, (bf16x8){l2[0], l2[1], l2[2], l2[3], h2[0], h2[1], h2[2], h2[3]}, o[2], 0, 0, 0);   \
        o[3] = __builtin_amdgcn_mfma_f32_32x32x16_bf16(PA, (bf16x8){l3[0], l3[1], l3[2], l3[3], h3[0], h3[1], h3[2], h3[3]}, o[3], 0, 0, 0); } while (0)
    PV_KS(0, pa0); PV_KS(1, pa1); PV_KS(2, pa2); PV_KS(3, pa3);
#undef PV_KS
#undef TRRD
}
__device__ __forceinline__ void unit(int b, int h, int qb, const bf16_t* __restrict__ QF, const bf16_t* __restrict__ KN, const bf16_t* __restrict__ KPE, const bf16_t* __restrict__ VBg, bf16_t* OB, char* lds) {
    const int tid = threadIdx.x, wid = __builtin_amdgcn_readfirstlane(tid >> 6), lane = tid & 63, r32 = lane & 31, hi = lane >> 5;
    const size_t rowb = (size_t)b * SEQ; const int q0 = qb * QB, qlo = q0 + wid * QBLK, qm = qlo + r32 - 4 * hi;
    const int NT = (q0 + QB) / KVBLK;
    float* wsf = (float*)(lds + OFF_WS) + wid * 64; float* li_l = wsf; float* al_l = wsf + 32;
    bf16x8 qr[12];
    { const bf16_t* qp = QF + (rowb + qlo + r32) * NQ + HD * h + hi * 8;
#pragma unroll
      for (int d0 = 0; d0 < 12; ++d0) qr[d0] = *reinterpret_cast<const bf16x8*>(qp + d0 * 16); }
    const int sr = tid >> 4, sc = (tid & 15) * 8, rr = tid >> 3, rc = tid & 7;
    const int kws = KSWZ(sr, sc * 2), vst0 = v_st(sr, sc), vst1 = v_st(32 + sr, sc), rws = rr * 128 + ((rc ^ ((rr >> 1) & 7)) << 4);
    const bf16_t* Kg = KN + (rowb + sr) * D + 128 * h + sc; const bf16_t* Vg = VBg + (rowb + sr) * D + 128 * h + sc; const bf16_t* Rg = KPE + (rowb + rr) * ROPE + rc * 8;
    bf16x8 st_k0, st_k1, st_v0, st_v1, st_r;
#define SLOAD(t) do { const size_t ko = (size_t)(t) * KVBLK * D; st_k0 = *reinterpret_cast<const bf16x8*>(Kg + ko); st_k1 = *reinterpret_cast<const bf16x8*>(Kg + ko + 32 * D); \
        st_v0 = *reinterpret_cast<const bf16x8*>(Vg + ko); st_v1 = *reinterpret_cast<const bf16x8*>(Vg + ko + 32 * D); st_r = *reinterpret_cast<const bf16x8*>(Rg + (size_t)(t) * KVBLK * ROPE); } while (0)
#define SWRITE(bf) do { *(bf16x8*)(lds + OFF_K + (bf) * SHM_K + kws) = st_k0; *(bf16x8*)(lds + OFF_K + (bf) * SHM_K + kws + 32 * 256) = st_k1; \
        *(bf16x8*)(lds + OFF_V + (bf) * SHM_V + vst0) = st_v0; *(bf16x8*)(lds + OFF_V + (bf) * SHM_V + vst1) = st_v1; *(bf16x8*)(lds + OFF_R + (bf) * SHM_R + rws) = st_r; } while (0)
    const int vb0 = (int)(uintptr_t)lds + v_rd_base(lane);
    float m_reg = -1e30f, l_reg = 0.f, alpha; f32x16 o[4] = {}; f32x16 p0, p1; bf16x8 pa0, pa1, pa2, pa3;
    SLOAD(0); SWRITE(0); __syncthreads();
#define STEP(t, CB) do { if ((t) + 1 < NT) SLOAD((t) + 1); SBAR();                                                            \
        qkt<CB>(p0, p1, lds, r32, hi, qr);                                                                                    \
        if (KVBLK * (t) + KVBLK - 1 > qlo) mask_tile(p0, p1, qm - KVBLK * (t));                                               \
        softmax_tile(p0, p1, m_reg, l_reg, alpha, pa0, pa1, pa2, pa3);                                                        \
        if (__any(alpha < 1.f)) { if (hi == 0) al_l[r32] = alpha; asm volatile("s_waitcnt lgkmcnt(0)" ::: "memory");         \
            _Pragma("unroll") for (int d_ = 0; d_ < 4; ++d_) _Pragma("unroll") for (int r = 0; r < 16; ++r) o[d_][r] *= al_l[crow(r, hi)]; } \
        SBAR(); pv_tile<CB>(o, vb0, pa0, pa1, pa2, pa3);                                                                      \
        if ((t) + 1 < NT) SWRITE(1 - (CB));                                                                                   \
        __syncthreads(); } while (0)
    for (int t = 0; t < NT; t += 2) { STEP(t, 0); STEP(t + 1, 1); }
#undef STEP
#undef SLOAD
#undef SWRITE
    if (hi == 0) li_l[r32] = l_reg; asm volatile("s_waitcnt lgkmcnt(0)" ::: "memory");
    float rli[16];
#pragma unroll
    for (int r = 0; r < 16; ++r) rli[r] = __builtin_amdgcn_rcpf(li_l[crow(r, hi)]);
    bf16_t* Ow = OB + (rowb + qlo) * D + 128 * h;
#pragma unroll
    for (int r = 0; r < 16; ++r) { const int orow = crow(r, hi);
#pragma unroll
        for (int d0 = 0; d0 < 4; ++d0) { const float v = o[d0][r] * rli[r]; const float vn = __shfl_xor(v, 1);
            if ((r32 & 1) == 0) *(unsigned*)(Ow + (size_t)orow * D + d0 * 32 + r32) = cvtpk(v, vn); } }
    __syncthreads();
}
constexpr int R3_V = 0, R3_K = 3 * SHM_V, R3_R = R3_K + 3 * SHM_K, R3_WS = R3_R + 3 * SHM_R;
__device__ __forceinline__ void qkt_rt(f32x16& p0, f32x16& p1, const char* lds, int kofs, int rofs, int r32, int hi, const bf16x8* qr) {
    p0 = f32x16{}; p1 = f32x16{};
    const char* kb[4];
#pragma unroll
    for (int dd = 0; dd < 4; ++dd) kb[dd] = lds + R3_K + kofs + KSWZ(r32, (dd * 16 + hi * 8) * 2);
#pragma unroll
    for (int d0 = 0; d0 < 8; ++d0) { const char* a = kb[d0 & 3] + (d0 >> 2) * 128;
        const bf16x8 b0 = *reinterpret_cast<const bf16x8*>(a), b1 = *reinterpret_cast<const bf16x8*>(a + 32 * 256);
        p0 = __builtin_amdgcn_mfma_f32_32x32x16_bf16(b0, qr[d0], p0, 0, 0, 0);
        p1 = __builtin_amdgcn_mfma_f32_32x32x16_bf16(b1, qr[d0], p1, 0, 0, 0); }
    const int sw = (r32 >> 1) & 7; const char* rb = lds + R3_R + rofs + r32 * 128;
#pragma unroll
    for (int s = 0; s < 4; ++s) { const char* a = rb + (((2 * s + hi) ^ sw) << 4);
        const bf16x8 b0 = *reinterpret_cast<const bf16x8*>(a), b1 = *reinterpret_cast<const bf16x8*>(a + 32 * 128);
        p0 = __builtin_amdgcn_mfma_f32_32x32x16_bf16(b0, qr[8 + s], p0, 0, 0, 0);
        p1 = __builtin_amdgcn_mfma_f32_32x32x16_bf16(b1, qr[8 + s], p1, 0, 0, 0); }
}
__device__ __forceinline__ void pv_rt(f32x16* o, int vb, bf16x8 pa0, bf16x8 pa1, bf16x8 pa2, bf16x8 pa3) {
#define TRRD(dst, off) asm volatile("ds_read_b64_tr_b16 %0, %1 offset:%2" : "=&v"(dst) : "v"(vb), "i"(off) : "memory")
#define PV_KS(ks, PA) do { s16x4 l0, l1, l2, l3, h0, h1, h2, h3; constexpr int b_ = R3_V + v_rd_off(0, ks, 0);   \
        TRRD(l0, b_); TRRD(h0, b_ + 2048); TRRD(l1, b_ + 512); TRRD(h1, b_ + 512 + 2048); TRRD(l2, b_ + 1024); TRRD(h2, b_ + 1024 + 2048); TRRD(l3, b_ + 1536); TRRD(h3, b_ + 1536 + 2048); \
        asm volatile("s_waitcnt lgkmcnt(0)" ::: "memory"); SBAR();   \
        o[0] = __builtin_amdgcn_mfma_f32_32x32x16_bf16(PA, (bf16x8){l0[0], l0[1], l0[2], l0[3], h0[0], h0[1], h0[2], h0[3]}, o[0], 0, 0, 0);   \
        o[1] = __builtin_amdgcn_mfma_f32_32x32x16_bf16(PA, (bf16x8){l1[0], l1[1], l1[2], l1[3], h1[0], h1[1], h1[2], h1[3]}, o[1], 0, 0, 0);   \
        o[2] = __builtin_amdgcn_mfma_f32_32x32x16_bf16(PA, (bf16x8){l2[0], l2[1], l2[2], l2[3], h2[0], h2[1], h2[2], h2[3]}, o[2], 0, 0, 0);   \
        o[3] = __builtin_amdgcn_mfma_f32_32x32x16_bf16(PA, (bf16x8){l3[0], l3[1], l3[2], l3[3], h3[0], h3[1], h3[2], h3[3]}, o[3], 0, 0, 0); } while (0)
    PV_KS(0, pa0); PV_KS(1, pa1); PV_KS(2, pa2); PV_KS(3, pa3);
#undef PV_KS
#undef TRRD
}
#ifndef PA_PF
#define PA_PF 5
#endif
__device__ __forceinline__ void qkt_pf(f32x16& p0, f32x16& p1, const char* lds, int kofs, int rofs, int r32, int hi, const bf16x8* qr) {
    p0 = f32x16{}; p1 = f32x16{};
    const char* kb[4];
#pragma unroll
    for (int dd = 0; dd < 4; ++dd) kb[dd] = lds + R3_K + kofs + KSWZ(r32, (dd * 16 + hi * 8) * 2);
    const int sw = (r32 >> 1) & 7; const char* rb = lds + R3_R + rofs + r32 * 128;
    bf16x8 f0[12], f1[12];
#define QK_LD(d) do { if ((d) < 8) { const char* a = kb[(d) & 3] + ((d) >> 2) * 128; f0[d] = *reinterpret_cast<const bf16x8*>(a); f1[d] = *reinterpret_cast<const bf16x8*>(a + 32 * 256); } \
                      else { const char* a = rb + (((2 * ((d) - 8) + hi) ^ sw) << 4); f0[d] = *reinterpret_cast<const bf16x8*>(a); f1[d] = *reinterpret_cast<const bf16x8*>(a + 32 * 128); } } while (0)
#pragma unroll
    for (int d = 0; d < PA_PF; ++d) QK_LD(d);
#pragma unroll
    for (int d = 0; d < 12; ++d) {
        if (d + PA_PF < 12) QK_LD(d + PA_PF);
        SBAR();
        p0 = __builtin_amdgcn_mfma_f32_32x32x16_bf16(f0[d], qr[d], p0, 0, 0, 0);
        p1 = __builtin_amdgcn_mfma_f32_32x32x16_bf16(f1[d], qr[d], p1, 0, 0, 0);
        SBAR(); }
#undef QK_LD
}
#define TRRD(dst, off) asm volatile("ds_read_b64_tr_b16 %0, %1 offset:%2" : "=&v"(dst) : "v"(vb_), "i"(off) : "memory")
#define PV_RD(ks, S) do { constexpr int b_ = R3_V + v_rd_off(0, ks, 0);   \
        TRRD(S[0], b_); TRRD(S[4], b_ + 2048); TRRD(S[1], b_ + 512); TRRD(S[5], b_ + 512 + 2048); TRRD(S[2], b_ + 1024); TRRD(S[6], b_ + 1024 + 2048); TRRD(S[3], b_ + 1536); TRRD(S[7], b_ + 1536 + 2048); } while (0)
#define PV_MM(PA, S) do { \
        o[0] = __builtin_amdgcn_mfma_f32_32x32x16_bf16(PA, (bf16x8){S[0][0], S[0][1], S[0][2], S[0][3], S[4][0], S[4][1], S[4][2], S[4][3]}, o[0], 0, 0, 0);   \
        o[1] = __builtin_amdgcn_mfma_f32_32x32x16_bf16(PA, (bf16x8){S[1][0], S[1][1], S[1][2], S[1][3], S[5][0], S[5][1], S[5][2], S[5][3]}, o[1], 0, 0, 0);   \
        o[2] = __builtin_amdgcn_mfma_f32_32x32x16_bf16(PA, (bf16x8){S[2][0], S[2][1], S[2][2], S[2][3], S[6][0], S[6][1], S[6][2], S[6][3]}, o[2], 0, 0, 0);   \
        o[3] = __builtin_amdgcn_mfma_f32_32x32x16_bf16(PA, (bf16x8){S[3][0], S[3][1], S[3][2], S[3][3], S[7][0], S[7][1], S[7][2], S[7][3]}, o[3], 0, 0, 0); } while (0)
#define PV_EARLY(VA, VB_) do { PV_RD(0, VA); PV_RD(1, VB_); } while (0)
#define PV_REST(VA, VB_) do {                                                                     \
    asm volatile("s_waitcnt lgkmcnt(8)" ::: "memory"); SBAR(); PV_MM(pa0, VA); SBAR();            \
    PV_RD(2, VA);                                                                                 \
    asm volatile("s_waitcnt lgkmcnt(8)" ::: "memory"); SBAR(); PV_MM(pa1, VB_); SBAR();           \
    PV_RD(3, VB_);                                                                                \
    asm volatile("s_waitcnt lgkmcnt(8)" ::: "memory"); SBAR(); PV_MM(pa2, VA); SBAR();            \
    asm volatile("s_waitcnt lgkmcnt(0)" ::: "memory"); SBAR(); PV_MM(pa3, VB_); } while (0)
#ifndef PA_QK
#define PA_QK qkt_pf
#endif
__device__ __forceinline__ void unit_dma(int b, int h, int qb, const bf16_t* __restrict__ QF, const bf16_t* __restrict__ KN, const bf16_t* __restrict__ KPE, const bf16_t* __restrict__ VBg, bf16_t* OB, char* lds, LAS unsigned char* ldsu) {
    const int tid = threadIdx.x, wid = __builtin_amdgcn_readfirstlane(tid >> 6), lane = tid & 63, r32 = lane & 31, hi = lane >> 5;
    const size_t rowb = (size_t)b * SEQ; const int q0 = qb * QB, qlo = q0 + wid * QBLK, qm = qlo + r32 - 4 * hi;
    const int NT = (q0 + QB) / KVBLK;
    float* wsf = (float*)(lds + R3_WS) + wid * 64; float* li_l = wsf; float* al_l = wsf + 32;
    bf16x8 qr[12];
    { const bf16_t* qp = QF + (rowb + qlo + r32) * NQ + HD * h + hi * 8;
#pragma unroll
      for (int d0 = 0; d0 < 12; ++d0) qr[d0] = *reinterpret_cast<const bf16x8*>(qp + d0 * 16); }
    const char* Kb = (const char*)(KN + rowb * D + 128 * h); const char* Vb = (const char*)(VBg + rowb * D + 128 * h); const char* Rb = (const char*)(KPE + rowb * ROPE);
    unsigned kof[2], vof[2], rof;
#pragma unroll
    for (int pi = 0; pi < 2; ++pi) { const int p = 2 * wid + pi, rw = 4 * pi + (lane >> 4);
        kof[pi] = (unsigned)((4 * p + (lane >> 4)) * (D * 2) + 16 * ((lane & 15) ^ (rw & 7)));
        const int kk = 8 * (p >> 1) + ((lane & 31) >> 2), key = (kk & ~0xC) | ((kk & 4) << 1) | ((kk & 8) >> 1), col = 32 * (2 * (p & 1) + (lane >> 5)) + 8 * (lane & 3);
        vof[pi] = (unsigned)(key * (D * 2) + col * 2); }
    { const int row = 8 * wid + (lane >> 3); rof = (unsigned)(row * (ROPE * 2) + 16 * ((lane & 7) ^ ((row >> 1) & 7))); }
#define DMA_TILE(t, ks_, vs_, rs_) do { const size_t kb_ = (size_t)(t) * KVBLK * (D * 2);                                                                \
        _Pragma("unroll") for (int pi = 0; pi < 2; ++pi) { const int p = 2 * wid + pi;                                                                 \
            __builtin_amdgcn_global_load_lds((const unsigned*)(Kb + kb_ + kof[pi]), (LAS unsigned*)(ldsu + R3_K + (ks_) + p * 1024), 16, 0, 0);        \
            __builtin_amdgcn_global_load_lds((const unsigned*)(Vb + kb_ + vof[pi]), (LAS unsigned*)(ldsu + R3_V + (vs_) + p * 1024), 16, 0, 0); }      \
        __builtin_amdgcn_global_load_lds((const unsigned*)(Rb + (size_t)(t) * KVBLK * (ROPE * 2) + rof), (LAS unsigned*)(ldsu + R3_R + (rs_) + wid * 1024), 16, 0, 0); } while (0)
    const int vb0 = (int)(uintptr_t)lds + v_rd_base(lane);
    float m_reg = -1e30f, l_reg = 0.f, alpha; f32x16 o[4] = {}; f32x16 p0, p1; bf16x8 pa0, pa1, pa2, pa3;
    DMA_TILE(0, 0, 0, 0); DMA_TILE(1, SHM_K, SHM_V, SHM_R);
    asm volatile("s_waitcnt vmcnt(5)" ::: "memory"); __builtin_amdgcn_s_barrier(); asm volatile("" ::: "memory");
    int s_cur = 0, s_nxt = 1, s_nn = 2;
    for (int t = 0; t < NT; ++t) {
        int kofs = s_cur * SHM_K, rofs = s_cur * SHM_R, vofs = s_cur * SHM_V; asm volatile("" : "+v"(kofs), "+v"(rofs), "+v"(vofs));
        if (t + 2 < NT) DMA_TILE(t + 2, s_nn * SHM_K, s_nn * SHM_V, s_nn * SHM_R);
        PA_QK(p0, p1, lds, kofs, rofs, r32, hi, qr);
        s16x4 VA[8], VB_[8]; const int vb_ = vb0 + vofs; SBAR(); PV_EARLY(VA, VB_); SBAR();
        if (KVBLK * t + KVBLK - 1 > qlo) mask_tile(p0, p1, qm - KVBLK * t);
        softmax_tile(p0, p1, m_reg, l_reg, alpha, pa0, pa1, pa2, pa3);
        if (__any(alpha < 1.f)) { if (hi == 0) al_l[r32] = alpha; asm volatile("s_waitcnt lgkmcnt(0)" ::: "memory");
#pragma unroll
            for (int d_ = 0; d_ < 4; ++d_)
#pragma unroll
                for (int r = 0; r < 16; ++r) o[d_][r] *= al_l[crow(r, hi)]; }
        SBAR(); PV_REST(VA, VB_);
        if (t + 2 < NT) asm volatile("s_waitcnt vmcnt(5) lgkmcnt(0)" ::: "memory"); else asm volatile("s_waitcnt vmcnt(0) lgkmcnt(0)" ::: "memory");
        __builtin_amdgcn_s_barrier(); asm volatile("" ::: "memory");
        const int tmp = s_cur; s_cur = s_nxt; s_nxt = s_nn; s_nn = tmp;
    }
#undef DMA_TILE
    if (hi == 0) li_l[r32] = l_reg; asm volatile("s_waitcnt lgkmcnt(0)" ::: "memory");
    float rli[16];
#pragma unroll
    for (int r = 0; r < 16; ++r) rli[r] = __builtin_amdgcn_rcpf(li_l[crow(r, hi)]);
    bf16_t* Ow = OB + (rowb + qlo) * D + 128 * h;
#pragma unroll
    for (int r = 0; r < 16; ++r) { const int orow = crow(r, hi);
#pragma unroll
        for (int d0 = 0; d0 < 4; ++d0) { const float v = o[d0][r] * rli[r]; const float vn = __shfl_xor(v, 1);
            if ((r32 & 1) == 0) *(unsigned*)(Ow + (size_t)orow * D + d0 * 32 + r32) = cvtpk(v, vn); } }
    asm volatile("s_waitcnt vmcnt(0) lgkmcnt(0)" ::: "memory"); __builtin_amdgcn_s_barrier(); asm volatile("" ::: "memory");
}
}

namespace sa {
constexpr int TILE = 16384;
struct Src { const bf16_t* CLB; const float* CKF; const int* PT; const float* RP; const bf16_t* LATB; const bf16_t* KPEB; const float* RTS; const unsigned char* CL8; const float* SC2; };
#ifndef SA_INT8
#define SA_INT8 1
#endif
__device__ __forceinline__ int offa(int row, int ch) { return 2048 * (row >> 3) + 512 * (ch >> 2) + 64 * (row & 7) + 16 * ((ch & 3) ^ ((row >> 2) & 3)); }
__device__ __forceinline__ v4u widen8(u32x2 w) {
    const unsigned x0 = w.x ^ 0x80808080u, x1 = w.y ^ 0x80808080u; v4u o;
    o.x = cvt_pk_bf16((float)(x0 & 255u), (float)((x0 >> 8) & 255u)); o.y = cvt_pk_bf16((float)((x0 >> 16) & 255u), (float)(x0 >> 24));
    o.z = cvt_pk_bf16((float)(x1 & 255u), (float)((x1 >> 8) & 255u)); o.w = cvt_pk_bf16((float)((x1 >> 16) & 255u), (float)(x1 >> 24)); return o;
}
template <bool TAIL, bool Q8 = false>
__device__ __forceinline__ void tile(const Src& S, int b, int k0, LAS unsigned char* ldsu, char* lds, int wid, int lane, f32x16 (&o)[8], float& m_reg, float& l_reg, float* al_l, int tbase, float& lb, float cb) {
    asm volatile("" : "+v"(lane));
    const int r32 = lane & 31, hi = lane >> 5, h = r32 & 7;
    LAS unsigned char* tl = ldsu + tbase + wid * TILE; const char* tg = lds + tbase + wid * TILE;
    asm volatile("s_waitcnt lgkmcnt(0)" ::: "memory");
    {
        const int rlo = (lane >> 2) & 7, chh = lane >> 5, x4 = (lane >> 4) & 1;
        if constexpr (TAIL) {
            const char* ub = (const char*)(S.LATB + (size_t)(TP + 4 * b) * KVR);
#pragma unroll
            for (int P = 0; P < 16; ++P) { const int img = P >> 3, pp = P & 7, row = 8 * (pp >> 1) + rlo, ch = 8 * (pp & 1) + 4 * chh + ((lane & 3) ^ (2 * ((pp >> 1) & 1) + x4));
                const unsigned lo = (unsigned)((row < 3 ? row : 3) * (KVR * 2) + (128 * img + 8 * ch) * 2);
                __builtin_amdgcn_global_load_lds((const unsigned*)(ub + lo), (LAS unsigned*)(tl + P * 1024), 16, 0, 0); }
        } else if constexpr (Q8) {
            const char* ub = (const char*)S.CL8 + ((size_t)b * SEQ + k0) * KVR + 16 * lane;
#pragma unroll
            for (int P = 0; P < 8; ++P) __builtin_amdgcn_global_load_lds((const unsigned*)(ub + P * 1024), (LAS unsigned*)(tl + 8192 + P * 1024), 16, 0, 0);
        } else {
            const char* ub = (const char*)(S.CLB + ((size_t)b * SEQ + k0) * KVR);
            const unsigned loA = (unsigned)(rlo * 512 + 64 * chh + 16 * ((lane & 3) ^ x4)), loB = (unsigned)(rlo * 512 + 64 * chh + 16 * ((lane & 3) ^ (2 + x4)));
#pragma unroll
            for (int P = 0; P < 16; ++P) { const int img = P >> 3, pp = P & 7; const unsigned cst = (unsigned)((8 * (pp >> 1)) * 512 + 256 * img + 128 * (pp & 1));
                __builtin_amdgcn_global_load_lds((const unsigned*)(ub + cst + (((pp >> 1) & 1) ? loB : loA)), (LAS unsigned*)(tl + P * 1024), 16, 0, 0); }
        }
    }
    bf16x8 kp[4]; float rf[16];
    {
        if constexpr (TAIL) { const bf16_t* kr = S.KPEB + (size_t)(TP + 4 * b + (r32 < 3 ? r32 : 3)) * ROPE;
#pragma unroll
            for (int s = 0; s < 4; ++s) kp[s] = *reinterpret_cast<const bf16x8*>(kr + 16 * s + 8 * hi);
        } else {
            const int phys = S.PT[b * NPG + (k0 >> 7)];
            const float* kr = S.CKF + ((size_t)phys * PAGE + (k0 & (PAGE - 1)) + r32) * ROPE + 8 * hi;
#pragma unroll
            for (int s = 0; s < 4; ++s) { const f32x4 x0 = *(const f32x4*)(kr + 16 * s), x1 = *(const f32x4*)(kr + 16 * s + 4);
                u32x4 w = {cvt_pk_bf16(x0[0], x0[1]), cvt_pk_bf16(x0[2], x0[3]), cvt_pk_bf16(x1[0], x1[1]), cvt_pk_bf16(x1[2], x1[3])}; kp[s] = *reinterpret_cast<bf16x8*>(&w); }
        }
        if constexpr (TAIL) {
#pragma unroll
            for (int r = 0; r < 16; ++r) { const int j = crow(r, hi), jc = j < 3 ? j : 3; rf[r] = S.RTS[(4 * b + jc) * 8 + h]; }
        } else {
            const float* r0 = S.RP + (size_t)(2 * h) * NCK + (size_t)b * SEQ + k0 + 4 * hi;
#pragma unroll
            for (int j = 0; j < 4; ++j) { const f32x4 a = *(const f32x4*)(r0 + 8 * j) + *(const f32x4*)(r0 + NCK + 8 * j);
#pragma unroll
                for (int e = 0; e < 4; ++e) rf[4 * j + e] = a[e]; }
            if constexpr (Q8) {
                const float* s0 = S.SC2 + (size_t)b * SEQ + k0 + 4 * hi;
#pragma unroll
                for (int j = 0; j < 4; ++j) { f32x4 sv = *(const f32x4*)(s0 + 8 * j);
#pragma unroll
                    for (int e = 0; e < 4; ++e) { const float s2 = sv[e]; sv[e] = sqrtf(s2); rf[4 * j + e] = rsq(rf[4 * j + e] * s2 * (1.0f / 128) + EPS) * sv[e]; }
                    if (r32 == 0) *(f32x4*)(al_l + 32 + 8 * j + 4 * hi) = sv; }
            }
        }
    }
    asm volatile("s_waitcnt vmcnt(0)" ::: "memory");
    if constexpr (Q8 && !TAIL) {
        const int c8 = lane & 15, r0 = lane >> 4; const char* st = tg + 8192;
#pragma unroll
        for (int i = 0; i < 8; ++i) { const int row = r0 + 4 * i; *(v4u*)(const_cast<char*>(tg) + offa(row, c8)) = widen8(*(const u32x2*)(st + row * 256 + 8 * c8)); }
        u32x2 wb[8];
#pragma unroll
        for (int i = 0; i < 8; ++i) wb[i] = *(const u32x2*)(st + (r0 + 4 * i) * 256 + 128 + 8 * c8);
        asm volatile("s_waitcnt lgkmcnt(0)" ::: "memory");
#pragma unroll
        for (int i = 0; i < 8; ++i) *(v4u*)(const_cast<char*>(tg) + 8192 + offa(r0 + 4 * i, c8)) = widen8(wb[i]);
        asm volatile("s_waitcnt lgkmcnt(0)" ::: "memory");
    }
    f32x16 p = {}, pn = {};
    {
        const int x = (r32 >> 2) & 3; const char* kbase = tg + 2048 * (r32 >> 3) + 64 * (r32 & 7);
        const char* kE = kbase + 16 * (hi ^ x); const char* kO = kbase + 16 * ((2 + hi) ^ x);
        const char* qb = lds + QS_OFF + r32 * QS_STRIDE + hi * 16;
#pragma unroll
        for (int s = 0; s < 4; ++s) p = __builtin_amdgcn_mfma_f32_32x32x16_bf16(kp[s], *reinterpret_cast<const bf16x8*>(qb + (16 + s) * 32), p, 0, 0, 0);
#pragma unroll
        for (int s = 0; s < 16; ++s) { const int img = s >> 3, ss = s & 7; const char* a = ((ss & 1) ? kO : kE) + 8192 * img + 512 * (ss >> 1);
            pn = __builtin_amdgcn_mfma_f32_32x32x16_bf16(*reinterpret_cast<const bf16x8*>(a), *reinterpret_cast<const bf16x8*>(qb + s * 32), pn, 0, 0, 0); }
    }
#pragma unroll
    for (int r = 0; r < 16; ++r) p[r] = (Q8 && !TAIL) ? (pn[r] - cb) * rf[r] + p[r] : pn[r] * (TAIL ? rf[r] : rsq(rf[r] * (1.0f / 128) + EPS)) + p[r];
    if constexpr (TAIL) { const int q = r32 >> 3;
#pragma unroll
        for (int r = 0; r < 16; ++r) if (crow(r, hi) > q) p[r] = -__builtin_inff(); }
    float pmax = p[0];
#pragma unroll
    for (int r = 1; r < 16; ++r) pmax = fmaxf(pmax, p[r]);
    pmax = xmax32(pmax);
    float mn, alpha;
    if (__builtin_expect(__all((pmax - m_reg) <= THR), 1)) { mn = m_reg; alpha = 1.f; }
    else { mn = fmaxf(m_reg, pmax); alpha = __builtin_amdgcn_exp2f(m_reg - mn); m_reg = mn; }
    float ps = 0.f;
#pragma unroll
    for (int r = 0; r < 16; ++r) { p[r] = __builtin_amdgcn_exp2f(p[r] - mn); ps += p[r]; }
    ps = xsum32(ps); l_reg = l_reg * alpha + ps;
    if constexpr (Q8 && !TAIL) {
#pragma unroll
        for (int j = 0; j < 4; ++j) { const f32x4 sv = *(const f32x4*)(al_l + 32 + 8 * j + 4 * hi);
#pragma unroll
            for (int e = 0; e < 4; ++e) p[4 * j + e] *= sv[e]; }
    }
    bf16x8 pa0, pa1; PK4(p, 0, pa0); PK4(p, 8, pa1);
    if constexpr (Q8) {
        float bs = 0.f;
        if constexpr (!TAIL) { const u32x4 w0 = *reinterpret_cast<const u32x4*>(&pa0), w1 = *reinterpret_cast<const u32x4*>(&pa1);
#pragma unroll
            for (int e = 0; e < 4; ++e) bs += (bflo(w0[e]) + bfhi(w0[e])) + (bflo(w1[e]) + bfhi(w1[e]));
            bs = xsum32(bs); }
        lb = lb * alpha + bs;
    }
    if (__any(alpha < 1.f)) { if (hi == 0) al_l[r32] = alpha; asm volatile("s_waitcnt lgkmcnt(0)" ::: "memory");
#pragma unroll
        for (int c = 0; c < 8; ++c)
#pragma unroll
            for (int r = 0; r < 16; ++r) o[c][r] *= al_l[crow(r, hi)]; }
    {
        const int hh = lane >> 5, blk = (lane >> 4) & 1, q4 = (lane & 15) >> 2, pp = lane & 3;
        const int tb = (int)(uintptr_t)tg + 2048 * hh + 64 * q4 + 8 * (pp & 1);
        const int t0 = tb + 16 * ((2 * blk + (pp >> 1)) ^ (2 * hh)), t1 = tb + 256 + 16 * ((2 * blk + (pp >> 1)) ^ (2 * hh + 1));
#define TR0(dst, off) asm volatile("ds_read_b64_tr_b16 %0, %1 offset:%2" : "=&v"(dst) : "v"(t0), "i"(off) : "memory")
#define TR1(dst, off) asm volatile("ds_read_b64_tr_b16 %0, %1 offset:%2" : "=&v"(dst) : "v"(t1), "i"(off) : "memory")
#define PVC(c) do { s16x4 a0, a1, b0, b1; constexpr int f_ = 8192 * ((c) >> 2) + 512 * ((c) & 3);                               \
        TR0(a0, f_); TR1(a1, f_); TR0(b0, f_ + 4096); TR1(b1, f_ + 4096);                                                        \
        asm volatile("s_waitcnt lgkmcnt(0)" ::: "memory"); SBAR();                                                                \
        o[c] = __builtin_amdgcn_mfma_f32_32x32x16_bf16(pa0, (bf16x8){a0[0], a0[1], a0[2], a0[3], a1[0], a1[1], a1[2], a1[3]}, o[c], 0, 0, 0); \
        o[c] = __builtin_amdgcn_mfma_f32_32x32x16_bf16(pa1, (bf16x8){b0[0], b0[1], b0[2], b0[3], b1[0], b1[1], b1[2], b1[3]}, o[c], 0, 0, 0); } while (0)
        PVC(0); PVC(1); PVC(2); PVC(3); PVC(4); PVC(5); PVC(6); PVC(7);
#undef PVC
#undef TR0
#undef TR1
    }
}
__device__ __forceinline__ void unit(const Src& S, const bf16_t* QS, float* PO, float* PML, int b, int s, LAS unsigned char* ldsu, char* lds) {
    int tid = threadIdx.x; asm volatile("" : "+v"(tid));
    const int wid = __builtin_amdgcn_readfirstlane(tid >> 6), lane = tid & 63, r32 = lane & 31, hi = lane >> 5;
    for (int c = tid; c < 32 * 40; c += 512) { const int rho = c / 40, ch = c % 40; *(v4u*)(lds + QS_OFF + rho * QS_STRIDE + ch * 16) = *(const v4u*)(QS + ((size_t)b * 32 + rho) * 320 + ch * 8); }
    __syncthreads();
    float* al_l = (float*)(lds + SCR_OFF) + wid * 64;
    float m_reg = -1e30f, l_reg = 0.f, lb = 0.f, cb = 0.f; f32x16 o[8] = {};
    if (SA_INT8) { const char* qrow = lds + QS_OFF + r32 * QS_STRIDE;
#pragma unroll 8
        for (int ch = 0; ch < 32; ++ch) { const v4u q = *(const v4u*)(qrow + 16 * ch); cb += (bflo(q.x) + bfhi(q.x)) + (bflo(q.y) + bfhi(q.y)) + (bflo(q.z) + bfhi(q.z)) + (bflo(q.w) + bfhi(q.w)); }
        cb *= 128.0f; }
    const int kbase = (8 * s + wid) * 512;
    for (int i = 0; i < 16; ++i) tile<false, SA_INT8 != 0>(S, b, kbase + 32 * i, ldsu, lds, wid, lane, o, m_reg, l_reg, al_l, 0, lb, cb);
    if (s == 1 && wid == 7) tile<true, SA_INT8 != 0>(S, b, 0, ldsu, lds, wid, lane, o, m_reg, l_reg, al_l, 0, lb, cb);
    asm volatile("s_waitcnt lgkmcnt(0)" ::: "memory");
    if (SA_INT8) {
        if (hi == 0) al_l[r32] = lb; asm volatile("s_waitcnt lgkmcnt(0)" ::: "memory");
#pragma unroll
        for (int r = 0; r < 16; ++r) { const float corr = 128.0f * al_l[crow(r, hi)];
#pragma unroll
            for (int c = 0; c < 8; ++c) o[c][r] -= corr; }
        asm volatile("s_waitcnt lgkmcnt(0)" ::: "memory");
    }
    __syncthreads();
    float* ST = (float*)(lds + 32768);
    float* OL = (float*)lds;
    if (hi == 0) { ST[(wid * 32 + r32) * 2] = m_reg; ST[(wid * 32 + r32) * 2 + 1] = l_reg; }
    __syncthreads();
    float sc[16];
#pragma unroll
    for (int r = 0; r < 16; ++r) { const int row = crow(r, hi); float M = ST[row * 2];
#pragma unroll
        for (int w = 1; w < 8; ++w) M = fmaxf(M, ST[(w * 32 + row) * 2]);
        sc[r] = __builtin_amdgcn_exp2f(ST[(wid * 32 + row) * 2] - M); }
    for (int w = 0; w < 8; ++w) {
        if (wid == w) {
#pragma unroll
            for (int c = 0; c < 8; ++c)
#pragma unroll
                for (int r = 0; r < 16; ++r) { float* d = OL + crow(r, hi) * 256 + 32 * c + r32; const float v = o[c][r] * sc[r]; *d = (w == 0) ? v : *d + v; }
        }
        __syncthreads();
    }
    if (tid < 32) { float M = ST[tid * 2];
        for (int w = 1; w < 8; ++w) M = fmaxf(M, ST[(w * 32 + tid) * 2]);
        float L = 0.f; for (int w = 0; w < 8; ++w) L += ST[(w * 32 + tid) * 2 + 1] * __builtin_amdgcn_exp2f(ST[(w * 32 + tid) * 2] - M);
        PML[((size_t)(b * 2 + s) * 32 + tid) * 2] = M; PML[((size_t)(b * 2 + s) * 32 + tid) * 2 + 1] = L; }
    for (int c = tid; c < 32 * 64; c += 512) *((f32x4*)(PO + (size_t)(b * 2 + s) * 32 * 256) + c) = *((const f32x4*)OL + c);
    __syncthreads();
}
}

__device__ __forceinline__ void grp_barrier(volatile LAS unsigned* cnt, unsigned& epoch, unsigned nw, int lane) {
    asm volatile("s_waitcnt vmcnt(0) lgkmcnt(0)" ::: "memory");
    epoch += nw;
    if (lane == 0) __hip_atomic_fetch_add((LAS unsigned*)cnt, 1u, __ATOMIC_RELAXED, __HIP_MEMORY_SCOPE_WORKGROUP);
    while ((int)(*cnt - epoch) < 0) __builtin_amdgcn_s_sleep(0);
    asm volatile("" ::: "memory");
}
namespace pa4 {
using namespace pa;
constexpr int QB4 = 128, OFF_WS4 = SCR_OFF + 1024;
__device__ __forceinline__ void unit(int b, int h, int qb, const bf16_t* __restrict__ QF, const bf16_t* __restrict__ KN, const bf16_t* __restrict__ KPE, const bf16_t* __restrict__ VBg, bf16_t* OB,
                                     char* lds, LAS unsigned char* ldsu, volatile LAS unsigned* cnt, unsigned& epoch) {
    const int tid = threadIdx.x, wid = __builtin_amdgcn_readfirstlane(tid >> 6), lane = tid & 63, r32 = lane & 31, hi = lane >> 5;
    const size_t rowb = (size_t)b * SEQ; const int q0 = qb * QB4, qlo = q0 + wid * QBLK, qm = qlo + r32 - 4 * hi;
    const int NT = (q0 + QB4) / KVBLK;
    float* wsf = (float*)(lds + OFF_WS4) + wid * 64; float* li_l = wsf; float* al_l = wsf + 32;
    bf16x8 qr[12];
    { const bf16_t* qp = QF + (rowb + qlo + r32) * NQ + HD * h + hi * 8;
#pragma unroll
      for (int d0 = 0; d0 < 12; ++d0) qr[d0] = *reinterpret_cast<const bf16x8*>(qp + d0 * 16); }
    const char* Kb = (const char*)(KN + rowb * D + 128 * h); const char* Vb = (const char*)(VBg + rowb * D + 128 * h); const char* Rb = (const char*)(KPE + rowb * ROPE);
    unsigned kof[2], vof[4], rof[2];
#pragma unroll
    for (int e = 0; e < 2; ++e) { const int rw = 4 * e + (lane >> 4); kof[e] = (unsigned)((lane >> 4) * (D * 2) + 16 * ((lane & 15) ^ (rw & 7))); }
#pragma unroll
    for (int pi = 0; pi < 4; ++pi) { const int p = 4 * wid + pi, kk = 8 * (p >> 1) + ((lane & 31) >> 2), key = (kk & ~0xC) | ((kk & 4) << 1) | ((kk & 8) >> 1), col = 32 * (2 * (p & 1) + (lane >> 5)) + 8 * (lane & 3);
        vof[pi] = (unsigned)(key * (D * 2) + col * 2); }
#pragma unroll
    for (int pi = 0; pi < 2; ++pi) { const int p = 2 * wid + pi, row = 8 * p + (lane >> 3); rof[pi] = (unsigned)(row * (ROPE * 2) + 16 * ((lane & 7) ^ ((row >> 1) & 7))); }
#define DMA_TILE(t, bf) do { const size_t kb_ = (size_t)(t) * KVBLK * (D * 2);                                                                          \
        _Pragma("unroll") for (int pi = 0; pi < 4; ++pi) { const int p = 4 * wid + pi;                                                                 \
            __builtin_amdgcn_global_load_lds((const unsigned*)(Kb + kb_ + (size_t)(4 * p) * (D * 2) + kof[pi & 1]), (LAS unsigned*)(ldsu + OFF_K + (bf) * SHM_K + p * 1024), 16, 0, 0); \
            __builtin_amdgcn_global_load_lds((const unsigned*)(Vb + kb_ + vof[pi]), (LAS unsigned*)(ldsu + OFF_V + (bf) * SHM_V + p * 1024), 16, 0, 0); }  \
        _Pragma("unroll") for (int pi = 0; pi < 2; ++pi) { const int p = 2 * wid + pi;                                                                 \
            __builtin_amdgcn_global_load_lds((const unsigned*)(Rb + (size_t)(t) * KVBLK * (ROPE * 2) + rof[pi]), (LAS unsigned*)(ldsu + OFF_R + (bf) * SHM_R + p * 1024), 16, 0, 0); } } while (0)
    const int vb0 = (int)(uintptr_t)lds + v_rd_base(lane);
    float m_reg = -1e30f, l_reg = 0.f, alpha; f32x16 o[4] = {}; f32x16 p0, p1; bf16x8 pa0, pa1, pa2, pa3;
    DMA_TILE(0, 0); grp_barrier(cnt, epoch, 4u, lane);
#define STEP4(t, CB) do { if ((t) + 1 < NT) DMA_TILE((t) + 1, 1 - (CB));                                                      \
        qkt<CB>(p0, p1, lds, r32, hi, qr);                                                                                    \
        if (KVBLK * (t) + KVBLK - 1 > qlo) mask_tile(p0, p1, qm - KVBLK * (t));                                               \
        softmax_tile(p0, p1, m_reg, l_reg, alpha, pa0, pa1, pa2, pa3);                                                        \
        if (__any(alpha < 1.f)) { if (hi == 0) al_l[r32] = alpha; asm volatile("s_waitcnt lgkmcnt(0)" ::: "memory");         \
            _Pragma("unroll") for (int d_ = 0; d_ < 4; ++d_) _Pragma("unroll") for (int r = 0; r < 16; ++r) o[d_][r] *= al_l[crow(r, hi)]; } \
        pv_tile<CB>(o, vb0, pa0, pa1, pa2, pa3);                                                                      \
        grp_barrier(cnt, epoch, 4u, lane); } while (0)
    for (int t = 0; t < NT; t += 2) { STEP4(t, 0); STEP4(t + 1, 1); }
#undef STEP4
#undef DMA_TILE
    if (hi == 0) li_l[r32] = l_reg; asm volatile("s_waitcnt lgkmcnt(0)" ::: "memory");
    float rli[16];
#pragma unroll
    for (int r = 0; r < 16; ++r) rli[r] = __builtin_amdgcn_rcpf(li_l[crow(r, hi)]);
    bf16_t* Ow = OB + (rowb + qlo) * D + 128 * h;
#pragma unroll
    for (int r = 0; r < 16; ++r) { const int orow = crow(r, hi);
#pragma unroll
        for (int d0 = 0; d0 < 4; ++d0) { const float v = o[d0][r] * rli[r]; const float vn = __shfl_xor(v, 1);
            if ((r32 & 1) == 0) *(unsigned*)(Ow + (size_t)orow * D + d0 * 32 + r32) = cvtpk(v, vn); } }
    asm volatile("s_waitcnt lgkmcnt(0)" ::: "memory");
}
}
namespace sa3 {
using namespace sa;
constexpr int TB = 81920;
__device__ __forceinline__ void unit(const Src& S, const bf16_t* QS, float* PO, float* PML, int b, int s, LAS unsigned char* ldsu, char* lds, volatile LAS unsigned* cnt, unsigned& epoch) {
    const int tid = threadIdx.x - 256, j = __builtin_amdgcn_readfirstlane(tid >> 6), lane = tid & 63, r32 = lane & 31, hi = lane >> 5;
    for (int c = tid; c < 32 * 40; c += 192) { const int rho = c / 40, ch = c % 40; *(v4u*)(lds + QS_OFF + rho * QS_STRIDE + ch * 16) = *(const v4u*)(QS + ((size_t)b * 32 + rho) * 320 + ch * 8); }
    grp_barrier(cnt, epoch, 3u, lane);
    float* al_l = (float*)(lds + SCR_OFF) + j * 64;
    float m_reg = -1e30f, l_reg = 0.f; f32x16 o[8] = {};
    for (int i = j; i < 128; i += 3) { float lb_ = 0.f; tile<false>(S, b, s * 4096 + 32 * i, ldsu, lds, j, lane, o, m_reg, l_reg, al_l, TB, lb_, 0.f); }
    if (s == 1 && j == 2) { float lb_ = 0.f; tile<true>(S, b, 0, ldsu, lds, j, lane, o, m_reg, l_reg, al_l, TB, lb_, 0.f); }
    grp_barrier(cnt, epoch, 3u, lane);
    float* OL = (float*)(lds + TB);
    float* ST = (float*)(lds + TB + 32768);
    if (hi == 0) { ST[(j * 32 + r32) * 2] = m_reg; ST[(j * 32 + r32) * 2 + 1] = l_reg; }
    grp_barrier(cnt, epoch, 3u, lane);
    float sc[16];
#pragma unroll
    for (int r = 0; r < 16; ++r) { const int row = crow(r, hi); const float M = fmaxf(fmaxf(ST[row * 2], ST[(32 + row) * 2]), ST[(64 + row) * 2]);
        sc[r] = __builtin_amdgcn_exp2f(ST[(j * 32 + row) * 2] - M); }
    for (int w = 0; w < 3; ++w) {
        if (j == w) {
#pragma unroll
            for (int c = 0; c < 8; ++c)
#pragma unroll
                for (int r = 0; r < 16; ++r) { float* d = OL + crow(r, hi) * 256 + 32 * c + r32; const float v = o[c][r] * sc[r]; *d = (w == 0) ? v : *d + v; }
        }
        grp_barrier(cnt, epoch, 3u, lane);
    }
    if (tid < 32) { const float M = fmaxf(fmaxf(ST[tid * 2], ST[(32 + tid) * 2]), ST[(64 + tid) * 2]);
        float L = 0.f; for (int w = 0; w < 3; ++w) L += ST[(w * 32 + tid) * 2 + 1] * __builtin_amdgcn_exp2f(ST[(w * 32 + tid) * 2] - M);
        PML[((size_t)(b * 2 + s) * 32 + tid) * 2] = M; PML[((size_t)(b * 2 + s) * 32 + tid) * 2 + 1] = L; }
    for (int c = tid; c < 32 * 64; c += 192) *((f32x4*)(PO + (size_t)(b * 2 + s) * 32 * 256) + c) = *((const f32x4*)OL + c);
    grp_barrier(cnt, epoch, 3u, lane);
}
}
#undef SBAR
#undef PK4
}

#ifndef MK_SPLIT
#define MK_SPLIT 0
#endif
struct RangeOrder {
    int g0, n;
    __device__ __forceinline__ bool next(int i, pg8::Unit& u) const { if (i >= n) return false; const int g = g0 + i; u.pm = g >> 2; u.pn = g & 3; u.ko = 0; return true; }
    __device__ __forceinline__ void a_ready(const pg8::Unit&) const {}
    __device__ __forceinline__ void done(const pg8::Unit&) const {}
};
struct SplitOrder {
    int j, ns;
    __device__ __forceinline__ bool next(int i, pg8::Unit& u) const { if (i > 0 || j >= 8 * ns) return false; const int t = j / ns; u.pm = t >> 2; u.pn = t & 3; u.ko = (j % ns) * 512; return true; }
    __device__ __forceinline__ void a_ready(const pg8::Unit&) const {}
    __device__ __forceinline__ void done(const pg8::Unit&) const {}
};
constexpr int NSLOT = 11, R_UNITS = (NCK / 256) * 4;
constexpr int FILL_REM[NSLOT] = {172, 8, 24, 32, 172, 8, 48, 8, 132, 16, 140};
constexpr int FILL_PER[NSLOT] = {3, 17, 4, 1, 3, 17, 0, 17, 4, 0, 2};
constexpr int fill_start(int s) { int a = 0; for (int j = 0; j < s; ++j) a += (256 - FILL_REM[j]) * FILL_PER[j]; return a; }
static_assert(fill_start(NSLOT) <= R_UNITS, "filler");
#ifndef R_SP2
#define R_SP2 PG8_SP2
#endif
constexpr int NPHASE = 20;
struct Args { Ptrs P; int ph_lo, ph_hi; };
typedef const __attribute__((address_space(4))) Args CArgs;
__global__ void __launch_bounds__(NWAVES * 64, 2) fwd(Args args) {
    extern __shared__ __attribute__((aligned(16))) unsigned char lds[];
    Ctx C0; C0.lds = (LAS unsigned char*)lds; C0.tid = threadIdx.x; C0.lane = C0.tid & 63; C0.wave = __builtin_amdgcn_readfirstlane(C0.tid >> 6);
    C0.G = gridDim.x; { const int bx = blockIdx.x; C0.vcu = (C0.G % 8 == 0) ? (bx % 8) * (C0.G / 8) + bx / 8 : bx; }
    const Ctx& C = C0;
    volatile LAS unsigned* MISC = (volatile LAS unsigned*)(C.lds + MISC_OFF);
    if (C.tid < 32) MISC[C.tid] = 0u;
    __syncthreads();
    XcdBarrier bar; bar.bar = (unsigned*)(args.P.ws + WS_CTL) + CW_BAR; bar.x = 0; bar.st = nullptr;
    if (!MK_SPLIT) bar = xcd_barrier_post((unsigned*)(args.P.ws + WS_CTL) + CW_BAR, MISC + 8);
    const int lo = args.ph_lo, hi = args.ph_hi;
#ifndef PHASE_MASK
#define PHASE_MASK 0xFFFFFFFFu
#endif
#define IN(k) (((PHASE_MASK >> (k)) & 1u) && lo <= (k) && (k) < hi)
#define SEAM(k) do { if ((k) == 13 ? (IN(12) && IN(14)) : (IN(k) && IN((k) + 1))) { TP_A(5); xcd_barrier(bar); TP_B(5); TP_B(40 + PGRP(k)); TP_A(40 + PGRP((k) + 1)); } } while (0)
#define PH_BEGIN Ctx Cp_ = C0; { int t_ = threadIdx.x; asm volatile("" : "+v"(t_)); Cp_.tid = t_; Cp_.lane = t_ & 63; } const Ctx& C = Cp_;   \
        CArgs* ka_ = (CArgs*)__builtin_amdgcn_kernarg_segment_ptr(); asm volatile("" : "+s"(ka_)); CPtrs& P = ka_->P; unsigned char* ws = P.ws; float* ctl = (float*)(ws + WS_CTL); \
        bf16_t* XB = (bf16_t*)(ws + WS_XB); bf16_t* HB = (bf16_t*)(ws + WS_HB); float* X = P.out + OUT_Y; float* ssqx = ctl + F_SSQX; (void)XB; (void)HB; (void)X; (void)ssqx; (void)ctl;
    LAS unsigned char* ring = C.lds + RING_OFF;
    const int bx = (int)blockIdx.x;
#define GEMM(EPI, Aptr, Bptr, M_, N_, K_, Eobj) do { int k_ = (K_); asm volatile("" : "+s"(k_));   \
        pg8::Gemm g{(const bf16_t*)(Aptr), (const bf16_t*)(Bptr), (M_), (N_), k_, k_}; pg8::StaticOrder S; S.init((M_), (N_), C.G, bx); \
        pg8::gemm_phase<EPI, pg8::StaticOrder, PG8_ALIGN, PG8_SP2>(ring, g, S, Eobj); } while (0)

#define GEMM8(EPI, Aptr, Bptr, M_, N_, Eobj) do { int k_ = D / 2; asm volatile("" : "+s"(k_));   \
        pg8::Gemm g{(const bf16_t*)(Aptr), (const bf16_t*)(Bptr), (M_), (N_), k_, k_}; pg8::StaticOrder S; S.init((M_), (N_), C.G, bx); \
        pg8::gemm_phase<EPI, pg8::StaticOrder, PG8_ALIGN, PG8_SP2, true>(ring, g, S, Eobj); } while (0)
#define SA_PTR ((const float*)(ws + WS_SA))
#define TGU_PTR(i) ((const float*)(ws + WS_TGU) + (i) * 2 * FF)
#define W8GU_PTR(i) (ws + WS_W8GU0 + (size_t)(i) * WS_W8GU_STRIDE)
#define STAGE_T2() do { __syncthreads(); for (int i_ = C.tid; i_ < D / 4; i_ += NWAVES * 64) *((LAS f32x4*)(C.lds + QS_OFF) + i_) = *((const f32x4*)(ws + WS_T2) + i_); __syncthreads(); } while (0)
#define FILL(s) do { if (C.G == 256) { RangeOrder S; S.n = bx >= FILL_REM[s] ? FILL_PER[s] : 0; S.g0 = fill_start(s) + (bx - FILL_REM[s]) * FILL_PER[s]; \
        int k_ = KVR / 2; asm volatile("" : "+s"(k_)); pg8::Gemm g{(const bf16_t*)(ws + WS_CL8), (const bf16_t*)(ws + WS_W8), NCK, D, k_, k_}; STAGE_T2(); epi::Kv8 E_{(float*)(ws + WS_RP), (const float*)(ws + WS_SC2), (const LAS float*)(C.lds + QS_OFF), (size_t)NCK}; \
        pg8::gemm_phase<epi::Kv8, RangeOrder, PG8_ALIGN, R_SP2, true>(ring, g, S, E_); } } while (0)

#ifndef TPROBE
#define TPROBE 0
#endif
#ifdef PROBE_PHASE
#define PGRP(k) ((k) == PROBE_PHASE ? 7 : 0)
#else
#define PGRP(k) ((k) == 0 ? 1 : ((k) == 12 || (k) == 13) ? 2 : (k) == 14 ? 3 : ((k) == 4 || (k) == 15) ? 4 : 0)
#endif
    unsigned long long tp0_ = 0, tp1_ = 0, tpacc_ = 0;
#define TP_A(k) do { if (TPROBE == (k)) { __syncthreads(); tp0_ = __builtin_amdgcn_s_memrealtime(); } } while (0)
#define TP_B(k) do { if (TPROBE == (k)) { __syncthreads(); tp1_ = __builtin_amdgcn_s_memrealtime(); tpacc_ += tp1_ - tp0_; } } while (0)
#ifndef DUP_SEL
#define DUP_SEL 0
#endif
    if (IN(0)) { PH_BEGIN phase_cacheconv(C, P, C.vcu, C.G); phase_w8(C, P); phase_w8gu(C, P); phase_prologue(C, P); if (DUP_SEL == 1) { __syncthreads(); phase_prologue(C, P); } } SEAM(0);
    if (IN(1)) { PH_BEGIN epi::Swiglu8 E{HB, ssqx + 0 * T, SA_PTR, TGU_PTR(0)}; TP_A(3); GEMM8(epi::Swiglu8, ws + WS_A8, W8GU_PTR(0), T, 2 * FF, E); TP_B(3); TP_A(4); FILL(0); TP_B(4); } SEAM(1);
    if (IN(2)) { PH_BEGIN epi::Resid E{XB, ssqx + 1 * T, 0.5f}; TP_A(2); GEMM(epi::Resid, HB, ws + WS_WDN0, T, D, FF, E); TP_B(2); TP_A(1); FILL(1); TP_B(1); } SEAM(2);
    if (IN(3)) { PH_BEGIN epi::ConvIn E{(bf16_t*)(ws + WS_BB), (bf16_t*)(ws + WS_UB), ssqx + 1 * T, P.out + OUT_CSP, P.out + OUT_CSS}; GEMM(epi::ConvIn, XB, ws + WS_WCI, T, 3 * D, D, E); FILL(2); } SEAM(3);
    if (IN(4)) { PH_BEGIN TP_A(8); phase_conv(C, P); TP_B(8); } SEAM(4);
    if (IN(5)) { PH_BEGIN epi::Resid E{XB, ssqx + 2 * T, 1.0f};
        if (C.G == 256) {
            GEMM(epi::Resid, ws + WS_ZB, ws + WS_WCO, TP, D, D, E);
            { int k_ = 256; asm volatile("" : "+s"(k_)); pg8::Gemm g{(const bf16_t*)(ws + WS_ZB) + (size_t)TP * D, (const bf16_t*)(ws + WS_WCO), TS, D, k_, D}; SplitOrder S{bx, 4}; epi::Slab E_{(float*)(ws + WS_SLAB)};
              pg8::gemm_phase<epi::Slab, SplitOrder, PG8_ALIGN, PG8_SP2>(ring, g, S, E_); }
        } else { GEMM(epi::Resid, ws + WS_ZB, ws + WS_WCO, T, D, D, E); }
        FILL(3); } SEAM(5);
    if (IN(6)) { PH_BEGIN if (C.G == 256) phase_quant(C, P, (const float*)(ws + WS_SLAB), 4, ssqx + 2 * T); else phase_quant(C, P); xcd_barrier(bar); epi::Swiglu8 E{HB, ssqx + 2 * T, SA_PTR, TGU_PTR(1)}; GEMM8(epi::Swiglu8, ws + WS_A8, W8GU_PTR(1), T, 2 * FF, E); FILL(4); } SEAM(6);
    if (IN(7)) { PH_BEGIN epi::Resid E{XB, ssqx + 3 * T, 0.5f}; GEMM(epi::Resid, HB, ws + WS_WDN1, T, D, FF, E); FILL(5); } SEAM(7);
    if (IN(8)) { PH_BEGIN phase_quant(C, P); xcd_barrier(bar); { epi::Swiglu8 E{HB, ssqx + 3 * T, SA_PTR, TGU_PTR(2)}; GEMM8(epi::Swiglu8, ws + WS_A8, W8GU_PTR(2), T, 2 * FF, E); }
        { epi::Dkv E{ssqx + 3 * T, (float*)(ws + WS_CKV), ctl + F_SSQLAT, ctl + F_SSQKPE}; int k_ = D; asm volatile("" : "+s"(k_)); pg8::Gemm g{(const bf16_t*)XB, (const bf16_t*)(ws + WS_WDKV), T, 512, k_, k_};
          pg8::StaticOrder S; S.init(T, 512, C.G, (bx + 84) % C.G); pg8::gemm_phase<epi::Dkv, pg8::StaticOrder, PG8_ALIGN, PG8_SP2>(ring, g, S, E); } } SEAM(8);
    if (IN(9)) { PH_BEGIN epi::Resid E{XB, ssqx + 4 * T, 0.5f}; GEMM(epi::Resid, HB, ws + WS_WDN2, T, D, FF, E); FILL(7); TP_A(8); phase_kvfin(C, P); TP_B(8); } SEAM(9);
    if (IN(10)) { PH_BEGIN { epi::Dq E{(bf16_t*)(ws + WS_CQB), ssqx + 4 * T, ctl + F_SSQCQ}; GEMM(epi::Dq, XB, ws + WS_WDQ, T, QRANK, D, E); } FILL(8);
                  { epi::Kv E{(bf16_t*)(ws + WS_KN), (bf16_t*)(ws + WS_VB), (float*)(ws + WS_RPT), (size_t)T}; GEMM(epi::Kv, ws + WS_LATB, ws + WS_WUKV, T, 2 * D, KVR, E); } FILL(9); } SEAM(10);
    if (IN(11)) { PH_BEGIN epi::Uq E{(bf16_t*)(ws + WS_QB), ctl + F_SSQCQ, ctl + F_SSQQ}; TP_A(13); GEMM(epi::Uq, ws + WS_CQB, ws + WS_WUQ, T, NQ, QRANK, E); TP_B(13); TP_A(14); FILL(10); TP_B(14); } SEAM(11);
    if (IN(12)) { PH_BEGIN const int r0_ = (C.G == 256) ? fill_start(NSLOT) : 0, base_ = (R_UNITS - r0_) / C.G, ext_ = (R_UNITS - r0_) % C.G;
        RangeOrder S; S.g0 = r0_ + bx * base_ + (bx < ext_ ? bx : ext_); S.n = base_ + (bx < ext_ ? 1 : 0);
        int k_ = KVR / 2; asm volatile("" : "+s"(k_)); pg8::Gemm g{(const bf16_t*)(ws + WS_CL8), (const bf16_t*)(ws + WS_W8), NCK, D, k_, k_}; STAGE_T2(); epi::Kv8 E_{(float*)(ws + WS_RP), (const float*)(ws + WS_SC2), (const LAS float*)(C.lds + QS_OFF), (size_t)NCK};
        pg8::gemm_phase<epi::Kv8, RangeOrder, PG8_ALIGN, R_SP2, true>(ring, g, S, E_);
        phase_qkfin(C, P); }
    SEAM(13);
    if (IN(14)) { PH_BEGIN
        const bf16_t* QF = (const bf16_t*)(ws + WS_QB); const bf16_t* KN = (const bf16_t*)(ws + WS_KN); const bf16_t* KPE = (const bf16_t*)(ws + WS_KPEB);
        const bf16_t* VBp = (const bf16_t*)(ws + WS_VB); bf16_t* OB = (bf16_t*)(ws + WS_OB);
#ifndef ATT_SEL
#define ATT_SEL 3
#endif
        att::sa::Src S{(const bf16_t*)(ws + WS_CLB), P.in[3], (const int*)P.in[5], (const float*)(ws + WS_RP), (const bf16_t*)(ws + WS_LATB), KPE, (const float*)(ws + WS_RTS), ws + WS_CL8, (const float*)(ws + WS_SC2)};
#ifndef ATT_OVERLAP
#define ATT_OVERLAP 0
#endif
        if (ATT_OVERLAP && C.G == 256) {
            volatile LAS unsigned* gcnt = (volatile LAS unsigned*)(C.lds + MISC_OFF) + 16;
            if (C.wave < 4) { unsigned ep = 0u; const int bh = C.vcu >> 4, s = C.vcu & 15;
                att::pa4::unit(bh >> 3, bh & 7, 63 - 2 * s, QF, KN, KPE, VBp, OB, (char*)lds, C.lds, gcnt, ep);
                att::pa4::unit(bh >> 3, bh & 7, 62 - 2 * s, QF, KN, KPE, VBp, OB, (char*)lds, C.lds, gcnt, ep);
                att::pa4::unit(bh >> 3, bh & 7, 2 * s + 1, QF, KN, KPE, VBp, OB, (char*)lds, C.lds, gcnt, ep);
                att::pa4::unit(bh >> 3, bh & 7, 2 * s, QF, KN, KPE, VBp, OB, (char*)lds, C.lds, gcnt, ep);
            } else if (C.wave < 7) { unsigned ep = 0u;
                att::sa3::unit(S, (const bf16_t*)(ws + WS_QS), (float*)(ws + WS_PO), (float*)(ws + WS_PML), C.vcu >> 1, C.vcu & 1, C.lds, (char*)lds, gcnt + 1, ep); }
        } else {
#define RUN_SA() do { for (int v = C.vcu; v < 2 * DB; v += C.G) att::sa::unit(S, (const bf16_t*)(ws + WS_QS), (float*)(ws + WS_PO), (float*)(ws + WS_PML), v >> 1, v & 1, C.lds, (char*)lds); } while (0)
#ifndef PA_UNIT
#define PA_UNIT unit_dma
#endif
#define RUN_PA() do { for (int v = C.vcu; v < 256; v += C.G) { const int bh = v >> 4, s = v & 15; \
            att::pa::PA_UNIT(bh >> 3, bh & 7, s, QF, KN, KPE, VBp, OB, (char*)lds, C.lds); att::pa::PA_UNIT(bh >> 3, bh & 7, 31 - s, QF, KN, KPE, VBp, OB, (char*)lds, C.lds); } } while (0)
        RUN_PA(); RUN_SA();
#undef RUN_SA
#undef RUN_PA
        }
    } SEAM(14);
    if (IN(15)) { PH_BEGIN TP_A(7); phase_scomb(C, P); TP_B(7); } SEAM(15);
    if (IN(16)) { PH_BEGIN epi::Resid E{XB, ssqx + 5 * T, 1.0f};
        if (C.G == 256) {
            GEMM(epi::Resid, ws + WS_OB, ws + WS_WO, TP, D, D, E);
            { int k_ = 256; asm volatile("" : "+s"(k_)); pg8::Gemm g{(const bf16_t*)(ws + WS_OB) + (size_t)TP * D, (const bf16_t*)(ws + WS_WO), TS, D, k_, D}; SplitOrder S{bx, 4}; epi::Slab E_{(float*)(ws + WS_SLAB)};
              pg8::gemm_phase<epi::Slab, SplitOrder, PG8_ALIGN, PG8_SP2>(ring, g, S, E_); }
        } else { GEMM(epi::Resid, ws + WS_OB, ws + WS_WO, T, D, D, E); } } SEAM(16);
    if (IN(17)) { PH_BEGIN if (C.G == 256) phase_quant(C, P, (const float*)(ws + WS_SLAB), 4, ssqx + 5 * T); else phase_quant(C, P); xcd_barrier(bar); epi::Swiglu8 E{HB, ssqx + 5 * T, SA_PTR, TGU_PTR(3)}; GEMM8(epi::Swiglu8, ws + WS_A8, W8GU_PTR(3), T, 2 * FF, E); } SEAM(17);
    if (IN(18)) { PH_BEGIN
        if (C.G == 256) {
            { epi::ResidY E{XB, X, 0.5f}; GEMM(epi::ResidY, HB, ws + WS_WDN3, TP, D, FF, E); }
            { int k_ = 256; asm volatile("" : "+s"(k_)); pg8::Gemm g{(const bf16_t*)HB + (size_t)TP * FF, (const bf16_t*)(ws + WS_WDN3), TS, D, k_, FF}; SplitOrder S{bx, SPLITK}; epi::Slab E_{(float*)(ws + WS_SLAB)};
              pg8::gemm_phase<epi::Slab, SplitOrder, PG8_ALIGN, PG8_SP2>(ring, g, S, E_); }
        } else { epi::ResidY E{XB, X, 0.5f}; GEMM(epi::ResidY, HB, ws + WS_WDN3, T, D, FF, E); } } SEAM(18);
    if (IN(19)) { PH_BEGIN
        if (C.G == 256) { const float* slab = (const float*)(ws + WS_SLAB);
            for (int i = C.vcu * (NWAVES * 64) + C.tid; i < TS * D / 4; i += C.G * (NWAVES * 64)) { f32x4 s = *((const f32x4*)slab + i);
#pragma unroll
                for (int c = 1; c < SPLITK; ++c) s += *((const f32x4*)(slab + (size_t)c * TS * D) + i);
                const u32x2 xw = *((const u32x2*)(XB + (size_t)TP * D) + i); *((f32x4*)(X + (size_t)TP * D) + i) = (f32x4){bflo(xw.x), bfhi(xw.x), bflo(xw.y), bfhi(xw.y)} + s * 0.5f; } } }
#ifdef XBAR_PROBE
    for (int i_ = 0; i_ < XBAR_PROBE; ++i_) xcd_barrier(bar);
#endif
#ifndef PROBE_BLOCK
#define PROBE_BLOCK 255
#endif
    if (TPROBE && blockIdx.x == PROBE_BLOCK && C.wave == 0) { const unsigned long long te = __builtin_amdgcn_s_memrealtime(), span = tpacc_ * 32ull;
        while (__builtin_amdgcn_s_memrealtime() - te < span) __builtin_amdgcn_s_sleep(8); }
#undef IN
#undef SEAM
#undef GEMM
}

extern "C" void kernel_launch(void* const* d_in, const int* in_sizes, int n_in, void* d_out, int out_size, void* d_ws, size_t ws_size, hipStream_t stream) {
    static int grid = 0;
    if (grid == 0) {
        if (n_in != 29 || out_size != (int)OUT_TOTAL || ws_size < WS_END) { fprintf(stderr, "kernel_launch: unexpected shapes (n_in %d, out %d, ws %zu); nothing launched\n", n_in, out_size, ws_size); grid = -1; return; }
        int dev = 0, cus = 0, per_cu = 0;
        if (hipGetDevice(&dev) != hipSuccess || hipDeviceGetAttribute(&cus, hipDeviceAttributeMultiprocessorCount, dev) != hipSuccess) { grid = -1; return; }
        if (hipFuncSetAttribute((const void*)fwd, hipFuncAttributeMaxDynamicSharedMemorySize, LDS_BYTES) != hipSuccess) { fprintf(stderr, "kernel_launch: hipFuncSetAttribute failed\n"); grid = -1; return; }
        if (hipOccupancyMaxActiveBlocksPerMultiprocessor(&per_cu, (const void*)fwd, NWAVES * 64, LDS_BYTES) != hipSuccess || per_cu < 1)
            fprintf(stderr, "kernel_launch: note: occupancy query reports %d workgroups per CU\n", per_cu);
        (void)hipGetLastError();
        grid = cus;
    }
    if (grid < 0) return;
    if (hipMemsetAsync((char*)d_ws + WS_CTL, 0, CTL_BYTES, stream) != hipSuccess) { fprintf(stderr, "kernel_launch: memset failed\n"); return; }
    Args a{};
    for (int i = 0; i < 29; ++i) a.P.in[i] = (const float*)d_in[i];
    a.P.out = (float*)d_out; a.P.ws = (unsigned char*)d_ws;
#if MK_SPLIT
    for (int ph = 0; ph < NPHASE; ++ph) { a.ph_lo = ph; a.ph_hi = ph + 1; hipLaunchKernelGGL(fwd, dim3(grid), dim3(NWAVES * 64), LDS_BYTES, stream, a); }
#else
    a.ph_lo = 0; a.ph_hi = NPHASE;
    hipLaunchKernelGGL(fwd, dim3(grid), dim3(NWAVES * 64), LDS_BYTES, stream, a);
#endif
    const hipError_t le = hipPeekAtLastError();
    if (le != hipSuccess) fprintf(stderr, "kernel_launch: launch failed: %s\n", hipGetErrorName(le));
}
```

```cpp
#include <hip/hip_runtime.h>
#include <cstdio>
#include <cstdint>
namespace pg8 {
#define PG8_LAS __attribute__((address_space(3)))
typedef unsigned short bf16_t;
typedef short bf16x8 __attribute__((ext_vector_type(8)));
typedef float f32x4 __attribute__((ext_vector_type(4)));
typedef unsigned u32x4 __attribute__((ext_vector_type(4)));
constexpr int BM = 256, BK = 64, HALF = 128, HTB = HALF * BK * 2  , STAGE_BYTES = 8 * HTB, NXCD = 8, WGM = 8;

__host__ __device__ __forceinline__ int lds_byte(int r, int c) { const int st = (r >> 4) * 2 + (c >> 5), rr = r & 15, cc = c & 31, ob = rr * 64 + cc * 2; return st * 1024 + (ob ^ (((ob >> 9) & 1) << 5)); }
__host__ __device__ __forceinline__ void stage_rc(int b, int& R, int& C) { const int st = b / 1024, sb = b % 1024, swz = sb ^ (((sb >> 9) & 1) << 5); R = (st >> 1) * 16 + swz / 64; C = (st & 1) * 32 + (swz % 64) / 2; }
__host__ __device__ __forceinline__ int perm32(int rho) { const int n = rho >> 4, i = rho & 15; return 8 * (i >> 2) + 4 * n + (i & 3); }

struct Unit { int pm, pn; int ko; };
struct Gemm { const bf16_t* A; const bf16_t* Bt; int M, N, K; int ld; };

struct StaticOrder {
    int nM, nN, nwg, G, c;
    __host__ __device__ void init(int M, int N, int G_, int c_) { nM = M / BM; nN = N / BM; nwg = nM * nN; G = G_; c = c_; }
    __host__ __device__ bool next(int i, Unit& u) const {
        const long L = (long)i * G + c; if (L >= nwg) return false;
        int wgid = (int)L; { const int q = nwg / NXCD, r = nwg % NXCD, xcd = wgid % NXCD, off = wgid / NXCD; wgid = (xcd < r ? xcd * (q + 1) : r * (q + 1) + (xcd - r) * q) + off; }
        const int nig = WGM * nN, gid = wgid / nig, fm = gid * WGM, gsz = (nM - fm) < WGM ? (nM - fm) : WGM;
        u.pm = fm + ((wgid % nig) % gsz); u.pn = (wgid % nig) / gsz; u.ko = 0; return true;
    }
    __device__ __forceinline__ void a_ready(const Unit&) const {}
    __device__ __forceinline__ void done(const Unit&) const {}
};

__device__ __forceinline__ unsigned cvt_pk_bf16(float lo, float hi) { unsigned r; asm volatile("v_cvt_pk_bf16_f32 %0, %1, %2" : "=v"(r) : "v"(lo), "v"(hi)); return r; }
typedef float f32x2 __attribute__((ext_vector_type(2)));
typedef int i32x4 __attribute__((ext_vector_type(4)));
template <bool I8> __device__ __forceinline__ f32x4 mma16(bf16x8 b, bf16x8 a, f32x4 c) {
    if constexpr (I8) return __builtin_bit_cast(f32x4, __builtin_amdgcn_mfma_i32_16x16x64_i8(__builtin_bit_cast(i32x4, b), __builtin_bit_cast(i32x4, a), __builtin_bit_cast(i32x4, c), 0, 0, 0));
    else return __builtin_amdgcn_mfma_f32_16x16x32_bf16(b, a, c, 0, 0, 0);
}
template <class Epi, class Sched, bool ALIGN_EPI = false, bool SP2 = false, bool I8 = false>
__device__ __forceinline__ void gemm_phase(PG8_LAS unsigned char* lds, const Gemm g, const Sched& S, const Epi& E) {
    int tid_ = threadIdx.x; asm volatile("" : "+v"(tid_));
    const int tid = tid_, wid = __builtin_amdgcn_readfirstlane(tid >> 6), lane = tid & 63, wr = wid >> 2, wc = wid & 3, fr = lane & 15, fq = lane >> 4;
    const int K = g.K, nt = K / BK;
    unsigned voffA[2], voffB[2];
#pragma unroll
    for (int i = 0; i < 2; ++i) { int R, C; stage_rc(tid * 16 + i * 8192, R, C); const int Rb = Epi::PERM ? ((R & ~31) + perm32(R & 31)) : R;
        voffA[i] = (unsigned)(R * g.ld + C) * 2u; voffB[i] = (unsigned)(Rb * g.ld + C) * 2u; }
    const size_t kstep = (size_t)(BK * 2);
    const size_t hstep = (size_t)HALF * g.ld * 2;
    const size_t tstep = 2 * hstep;
    const unsigned ldsw = (unsigned)wid * 1024u;
    const int aoff = lds_byte(wr * 64 + fr, fq * 8), boff = lds_byte(wc * 32 + fr, fq * 8);
#define PG8_SA(b, h) (((b) * 2 + (h)) * HTB)
#define PG8_SB(b, h) ((4 + (b) * 2 + (h)) * HTB)
#define PG8_STAGE(bufoff, gbase, voff) do { _Pragma("unroll") for (int _i = 0; _i < 2; ++_i) \
        __builtin_amdgcn_global_load_lds((const unsigned*)((const char*)(gbase) + (voff)[_i]), (PG8_LAS unsigned*)(lds + (bufoff) + ldsw + _i * 8192), 16, 0, 0); } while (0)
#define PG8_LDA(dst, b, h) do { _Pragma("unroll") for (int m = 0; m < 4; ++m) _Pragma("unroll") for (int k = 0; k < 2; ++k) dst[m][k] = *(const PG8_LAS bf16x8*)(lds + PG8_SA(b, h) + aoff + m * 2048 + k * 1024); } while (0)
#define PG8_LDB(dst, b, h) do { _Pragma("unroll") for (int n = 0; n < 2; ++n) _Pragma("unroll") for (int k = 0; k < 2; ++k) dst[n][k] = *(const PG8_LAS bf16x8*)(lds + PG8_SB(b, h) + boff + n * 2048 + k * 1024); } while (0)
#define PG8_MMA(ai, bj, At, Bt) do { __builtin_amdgcn_s_setprio(1); _Pragma("unroll") for (int m = 0; m < 4; ++m) _Pragma("unroll") for (int n = 0; n < 2; ++n) _Pragma("unroll") for (int k = 0; k < 2; ++k) \
        acc[ai][bj][m][n] = mma16<I8>(Bt[n][k], At[m][k], acc[ai][bj][m][n]); __builtin_amdgcn_s_setprio(0); } while (0)
#define PG8_WAIT_V(n) asm volatile("s_waitcnt vmcnt(" #n ")" ::: "memory")
#define PG8_WAIT_L(n) asm volatile("s_waitcnt lgkmcnt(" #n ")" ::: "memory")
#define PG8_BAR __builtin_amdgcn_s_barrier()
#define PG8_SCHED __builtin_amdgcn_sched_barrier(0)
    Unit cur, nxt; int ui = 0;
    if (!S.next(0, cur)) return;
    f32x4 acc[2][2][4][2];
#pragma unroll
    for (int a = 0; a < 2; ++a)
#pragma unroll
        for (int b = 0; b < 2; ++b)
#pragma unroll
            for (int m = 0; m < 4; ++m)
#pragma unroll
                for (int n = 0; n < 2; ++n) acc[a][b][m][n] = (f32x4){0.f, 0.f, 0.f, 0.f};
    bf16x8 At[4][2], B0[2][2], B1[2][2];
    const char* cA = (const char*)g.A + (size_t)cur.pm * tstep + cur.ko; const char* cB = (const char*)g.Bt + (size_t)cur.pn * tstep + cur.ko;
    S.a_ready(cur);
    if constexpr (SP2) {
        PG8_STAGE(PG8_SB(0, 0), cB, voffB); PG8_STAGE(PG8_SB(0, 1), cB + hstep, voffB); PG8_STAGE(PG8_SA(0, 0), cA, voffA); PG8_STAGE(PG8_SA(0, 1), cA + hstep, voffA);
        if (wr == 1) PG8_BAR;
        PG8_WAIT_V(2); PG8_BAR;
        PG8_STAGE(PG8_SB(1, 0), cB + kstep, voffB); PG8_STAGE(PG8_SA(1, 0), cA + kstep, voffA); PG8_STAGE(PG8_SB(1, 1), cB + hstep + kstep, voffB);
        PG8_WAIT_V(6); PG8_BAR;
    } else {
        PG8_STAGE(PG8_SB(0, 0), cB, voffB); PG8_STAGE(PG8_SA(0, 0), cA, voffA); PG8_STAGE(PG8_SB(0, 1), cB + hstep, voffB); PG8_STAGE(PG8_SA(0, 1), cA + hstep, voffA);
        if (wr == 1) PG8_BAR;
        PG8_WAIT_V(4); PG8_BAR;
        PG8_STAGE(PG8_SB(1, 0), cB + kstep, voffB); PG8_STAGE(PG8_SA(1, 0), cA + kstep, voffA); PG8_STAGE(PG8_SB(1, 1), cB + hstep + kstep, voffB);
        PG8_WAIT_V(6); PG8_BAR;
    }
    for (;;) {
        const bool has_next = S.next(ui + 1, nxt);
        const char* nA = has_next ? (const char*)g.A + (size_t)nxt.pm * tstep + nxt.ko : cA; const char* nB = has_next ? (const char*)g.Bt + (size_t)nxt.pn * tstep + nxt.ko : cB;
        for (int t = 0; t < nt; t += 2) {
            const bool last = (t == nt - 2);
            const char* a1 = cA + (size_t)(t + 1) * kstep;
            const char* a2 = last ? nA : cA + (size_t)(t + 2) * kstep; const char* b2 = last ? nB : cB + (size_t)(t + 2) * kstep;
            const char* a3 = a2 + kstep; const char* b3 = b2 + kstep;
            if (last && has_next) S.a_ready(nxt);
            if constexpr (SP2) {
            PG8_LDB(B0, 0, 0); PG8_LDB(B1, 0, 1); PG8_SCHED; PG8_LDA(At, 0, 0); PG8_STAGE(PG8_SA(1, 1), a1 + hstep, voffA);
            PG8_WAIT_V(8); PG8_WAIT_L(0); PG8_BAR; PG8_MMA(0, 0, At, B0); PG8_MMA(0, 1, At, B1); PG8_BAR; PG8_SCHED;
            PG8_LDA(At, 0, 1); PG8_STAGE(PG8_SB(0, 0), b2, voffB); PG8_STAGE(PG8_SB(0, 1), b2 + hstep, voffB); PG8_STAGE(PG8_SA(0, 0), a2, voffA);
            PG8_WAIT_V(8); PG8_WAIT_L(0); PG8_BAR; PG8_MMA(1, 0, At, B0); PG8_MMA(1, 1, At, B1); PG8_BAR; PG8_SCHED;
            PG8_LDB(B0, 1, 0); PG8_LDB(B1, 1, 1); PG8_SCHED; PG8_LDA(At, 1, 0); PG8_STAGE(PG8_SA(0, 1), a2 + hstep, voffA);
            PG8_WAIT_V(8); PG8_WAIT_L(0); PG8_BAR; PG8_MMA(0, 0, At, B0); PG8_MMA(0, 1, At, B1); PG8_BAR; PG8_SCHED;
            PG8_LDA(At, 1, 1); PG8_STAGE(PG8_SB(1, 0), b3, voffB); PG8_STAGE(PG8_SB(1, 1), b3 + hstep, voffB); PG8_STAGE(PG8_SA(1, 0), a3, voffA);
            PG8_WAIT_V(8); PG8_WAIT_L(0); PG8_BAR; PG8_MMA(1, 0, At, B0); PG8_MMA(1, 1, At, B1); PG8_BAR; PG8_SCHED;
            } else {
            PG8_LDB(B0, 0, 0); PG8_SCHED; PG8_LDA(At, 0, 0); PG8_STAGE(PG8_SA(1, 1), a1 + hstep, voffA);
            PG8_WAIT_L(8); PG8_BAR; PG8_WAIT_L(0); PG8_MMA(0, 0, At, B0); PG8_BAR; PG8_SCHED;
            PG8_LDB(B1, 0, 1); PG8_STAGE(PG8_SB(0, 0), b2, voffB);
            PG8_BAR; PG8_WAIT_L(0); PG8_MMA(0, 1, At, B1); PG8_BAR;
            PG8_LDA(At, 0, 1); PG8_STAGE(PG8_SA(0, 0), a2, voffA);
            PG8_BAR; PG8_WAIT_L(0); PG8_MMA(1, 0, At, B0); PG8_BAR; PG8_SCHED;
            PG8_STAGE(PG8_SB(0, 1), b2 + hstep, voffB);
            PG8_WAIT_V(6); PG8_BAR; PG8_MMA(1, 1, At, B1); PG8_BAR;
            PG8_LDB(B0, 1, 0); PG8_SCHED; PG8_LDA(At, 1, 0); PG8_STAGE(PG8_SA(0, 1), a2 + hstep, voffA);
            PG8_WAIT_L(8); PG8_BAR; PG8_WAIT_L(0); PG8_MMA(0, 0, At, B0); PG8_BAR; PG8_SCHED;
            PG8_LDB(B1, 1, 1); PG8_STAGE(PG8_SB(1, 0), b3, voffB);
            PG8_BAR; PG8_WAIT_L(0); PG8_MMA(0, 1, At, B1); PG8_BAR;
            PG8_LDA(At, 1, 1); PG8_STAGE(PG8_SA(1, 0), a3, voffA);
            PG8_BAR; PG8_WAIT_L(0); PG8_MMA(1, 0, At, B0); PG8_BAR; PG8_SCHED;
            PG8_STAGE(PG8_SB(1, 1), b3 + hstep, voffB);
            PG8_WAIT_V(6); PG8_BAR; PG8_MMA(1, 1, At, B1); PG8_BAR;
            }
        }
        if constexpr (ALIGN_EPI) { if (wr == 0) PG8_BAR; }
        if constexpr (!Epi::AFTER_DRAIN) { E(acc, cur, wr, wc, fr, fq); S.done(cur); }
        if (!has_next) break;
#pragma unroll
        for (int a = 0; a < 2; ++a)
#pragma unroll
            for (int b = 0; b < 2; ++b)
#pragma unroll
                for (int m = 0; m < 4; ++m)
#pragma unroll
                    for (int n = 0; n < 2; ++n) acc[a][b][m][n] = (f32x4){0.f, 0.f, 0.f, 0.f};
        cur = nxt; cA = nA; cB = nB; ++ui;
        if constexpr (ALIGN_EPI) { if (wr == 1) PG8_BAR; }
    }
    PG8_WAIT_V(0);
    if constexpr (!ALIGN_EPI) { if (wr == 0) PG8_BAR; }
    PG8_BAR;
    if constexpr (Epi::AFTER_DRAIN) { E.fused(acc, cur, wr, wc, fr, fq, lds, wid, lane); S.done(cur); }
#undef PG8_SA
#undef PG8_SB
#undef PG8_STAGE
#undef PG8_LDA
#undef PG8_LDB
#undef PG8_MMA
#undef PG8_WAIT_V
#undef PG8_WAIT_L
#undef PG8_BAR
#undef PG8_SCHED
}
}
#define PG8_SP2 true
#define PG8_ALIGN true
#define GAS __attribute__((address_space(1)))
#define LAS __attribute__((address_space(3)))
typedef unsigned short bf16;
typedef unsigned v4u __attribute__((ext_vector_type(4)));
typedef float f32x4 __attribute__((ext_vector_type(4)));
typedef short bf16x8 __attribute__((ext_vector_type(8)));
typedef GAS unsigned gu32;
typedef GAS unsigned long long gu64;
#define RLX_AGENT __ATOMIC_RELAXED, __HIP_MEMORY_SCOPE_AGENT
#define LDS_WAIT() asm volatile("s_waitcnt lgkmcnt(0)" ::: "memory")
#define VM_WAIT() asm volatile("s_waitcnt vmcnt(0)" ::: "memory")
__device__ __forceinline__ unsigned long long rt() { return __builtin_amdgcn_s_memrealtime(); }
__device__ __forceinline__ unsigned f2bf(float f) { unsigned u = __builtin_bit_cast(unsigned, f); return (u + 0x7fffu + ((u >> 16) & 1u)) >> 16; }
__device__ __forceinline__ unsigned pk2(float lo, float hi) { return f2bf(lo) | (f2bf(hi) << 16); }
#define XB_TMO      128
#define XB_XCNT(j)  (256  + 64 * (j))
#define XB_XSUB(j)  (1280 + 64 * (j))
#define XB_XGEN(j)  (2304 + 64 * (j))
#define XB_TOP      3328
#define XB_TOPGEN   3392
#define XCD_BAR_WORDS 3456
#define XB_SPIN_CAP (1u << 18)

__device__ __forceinline__ unsigned xb_ld(unsigned* p)              { return __hip_atomic_load(p, __ATOMIC_RELAXED, __HIP_MEMORY_SCOPE_AGENT); }
__device__ __forceinline__ unsigned xb_add(unsigned* p, unsigned v) { return __hip_atomic_fetch_add(p, v, __ATOMIC_RELAXED, __HIP_MEMORY_SCOPE_AGENT); }
__device__ __forceinline__ unsigned xb_xcc_id() { return (unsigned)__builtin_amdgcn_s_getreg((3 << 11) | 20) & 0xFu; }
#define XB_SPIN(cond, bar) do { unsigned _sp = 0; while (cond) { __builtin_amdgcn_s_sleep(1); \
    if ((++_sp & 255u) == 0u) { if (xb_ld(&(bar)[XB_TMO])) break; if (_sp > XB_SPIN_CAP) { atomicAdd(&(bar)[XB_TMO], 1u); break; } } } } while (0)

struct XcdBarrier {
    unsigned* bar; unsigned x;
    volatile LAS unsigned* st;
};

__device__ __forceinline__ XcdBarrier xcd_barrier_post(unsigned* bar, volatile LAS unsigned* st) {
    XcdBarrier b; b.bar = bar; b.x = xb_xcc_id(); b.st = st;
    if (threadIdx.x == 0) (void)xb_add(&bar[XB_XCNT(b.x)], 1u);
    return b;
}
__device__ __forceinline__ void xcd_barrier_complete(unsigned* bar, unsigned x, unsigned& nloc, unsigned& nx) {
    const unsigned G = gridDim.x * gridDim.y * gridDim.z;
    unsigned sum, cnt, mine, sp = 0u;
    for (;;) {
        sum = 0u; cnt = 0u; mine = 0u;
#pragma unroll
        for (unsigned j = 0; j < 16; ++j) { const unsigned c = xb_ld(&bar[XB_XCNT(j)]); sum += c; cnt += (c > 0u) ? 1u : 0u; mine = (j == x) ? c : mine; }
        if (sum == G) break;
        __builtin_amdgcn_s_sleep(1);
        if ((++sp & 255u) == 0u) { if (xb_ld(&bar[XB_TMO])) break; if (sp > XB_SPIN_CAP) { atomicAdd(&bar[XB_TMO], 1u); break; } }
    }
    nloc = mine > 0u ? mine : 1u; nx = cnt > 0u ? cnt : 1u;
}

__device__ __forceinline__ void xcd_barrier(const XcdBarrier& b) {
    asm volatile("s_waitcnt vmcnt(0)" ::: "memory");
    __syncthreads();
    if (threadIdx.x == 0) {
        unsigned* bar = b.bar;
        __builtin_amdgcn_s_waitcnt(0);
        unsigned nloc = b.st[0], nx = b.st[1];
        if (nloc == 0u) { xcd_barrier_complete(bar, b.x, nloc, nx); b.st[0] = nloc; b.st[1] = nx; }
        const unsigned old = xb_add(&bar[XB_XSUB(b.x)], 1u);
        const unsigned gen = old / nloc;
        if (old + 1u == (gen + 1u) * nloc) {
            __builtin_amdgcn_fence(__ATOMIC_RELEASE, "agent");
            asm volatile("s_waitcnt vmcnt(0)" ::: "memory");
            const unsigned og = xb_add(&bar[XB_TOP], 1u);
            const unsigned tg = og / nx;
            if (og + 1u == (tg + 1u) * nx) xb_add(&bar[XB_TOPGEN], 1u);
            else XB_SPIN(xb_ld(&bar[XB_TOPGEN]) == tg, bar);
            __builtin_amdgcn_fence(__ATOMIC_ACQUIRE, "agent");
            xb_add(&bar[XB_XGEN(b.x)], 1u);
            asm volatile("s_waitcnt vmcnt(0)" ::: "memory");
        } else {
            XB_SPIN(xb_ld(&bar[XB_XGEN(b.x)]) == gen, bar);
            __builtin_amdgcn_fence(__ATOMIC_ACQUIRE, "agent");
            asm volatile("s_waitcnt vmcnt(0)" ::: "memory");
        }
    }
    __syncthreads();
}

constexpr int NWAVES = 8;
constexpr int D = 1024, TP = 16384, TS = 512, T = TP + TS, FF = 2816, NH = 8, KVR = 256, ROPE = 64, QRANK = 512, NQ = 1536, HD = 192;
constexpr int SEQ = 8192, DB = 128, DS = 4, PAGE = 128, NPG = 64, CKVW = 320;
constexpr int NCK = DB * SEQ;
constexpr float EPS = 1e-6f;
constexpr float QSCALE = 0.07216878364870322f * 1.4426950408889634f;
constexpr size_t OUT_Y = 0, OUT_CSP = 17301504, OUT_CSS = 17305600, OUT_LATP = 17567744, OUT_KPEP = 21762048, OUT_LATS = 22810624, OUT_KPES = 22941696, OUT_TOTAL = 22974464;
constexpr size_t MiB = 1u << 20;
constexpr size_t WS_CTL = 0, CTL_BYTES = 4 * MiB;
constexpr size_t WS_WGU0 = 4 * MiB, WS_WGU1 = 15 * MiB, WS_WGU2 = 26 * MiB, WS_WGU3 = 38 * MiB;
constexpr size_t WS_WDN0 = 49 * MiB, WS_WDN1 = 55 * MiB, WS_WDN2 = 61 * MiB, WS_WDN3 = 67 * MiB;
constexpr size_t WS_WCI = 73 * MiB, WS_WCO = 79 * MiB, WS_WDQ = 81 * MiB, WS_WUQ = 82 * MiB, WS_WO = 84 * MiB, WS_WUKV = 86 * MiB;
constexpr size_t WS_ROPE = 88 * MiB;
constexpr size_t WS_XB = 92 * MiB, WS_HB = 126 * MiB, WS_BB = 218 * MiB, WS_UB = 252 * MiB, WS_ZB = 286 * MiB, WS_CKV = 320 * MiB;
constexpr size_t WS_LATB = 342 * MiB, WS_KPEB = 352 * MiB, WS_KN = 356 * MiB, WS_VB = 390 * MiB, WS_CQB = 424 * MiB, WS_QB = 442 * MiB;
constexpr size_t WS_OB = 493 * MiB, WS_RPT = 527 * MiB, WS_RTS = 529 * MiB, WS_QS = 530 * MiB, WS_PO = 534 * MiB, WS_PML = 543 * MiB;
constexpr size_t WS_CLB = 544 * MiB, WS_CKB = 1056 * MiB, WS_RP = 1184 * MiB, WS_SLAB = 1248 * MiB;
constexpr size_t WS_CL8 = 1272 * MiB, WS_SC2 = 1528 * MiB, WS_W8 = 1532 * MiB, WS_T2 = 1533 * MiB;
constexpr size_t WS_A8 = 1534 * MiB, WS_SA = 1552 * MiB, WS_W8GU0 = 1553 * MiB, WS_W8GU_STRIDE = 6 * MiB, WS_TGU = 1577 * MiB, WS_WDKV = 1578 * MiB, WS_END = 1580 * MiB;
constexpr int SPLITK = 11;
constexpr int CW_BAR = 4096, CW_SLC = 8192;
constexpr int F_SSQX = 16384, F_SSQLAT = F_SSQX + 6 * T, F_SSQKPE = F_SSQX + 7 * T, F_SSQCQ = F_SSQX + 8 * T, F_SSQQ = F_SSQX + 9 * T;
static_assert((size_t)(F_SSQQ + 16 * T) * 4 <= CTL_BYTES, "ctl");
constexpr int RING_OFF = 0, RING_BYTES = 131072, MISC_OFF = 131072, QS_OFF = 131584, QS_STRIDE = 656, SCR_OFF = QS_OFF + 32 * QS_STRIDE, LDS_BYTES = 155648;
static_assert(SCR_OFF + 8 * 256 <= LDS_BYTES, "lds");

typedef unsigned short bf16_t;
typedef unsigned u32x2 __attribute__((ext_vector_type(2)));
typedef float f32x2 __attribute__((ext_vector_type(2)));
typedef __bf16 bf16x2_t __attribute__((ext_vector_type(2)));
__device__ __forceinline__ unsigned cvt_pk_bf16(float lo, float hi) { f32x2 v = {lo, hi}; bf16x2_t b = __builtin_convertvector(v, bf16x2_t); return __builtin_bit_cast(unsigned, b); }
__device__ __forceinline__ float bf2f(unsigned short h) { return __builtin_bit_cast(float, (unsigned)h << 16); }
__device__ __forceinline__ float bflo(unsigned w) { return __builtin_bit_cast(float, w << 16); }
__device__ __forceinline__ float bfhi(unsigned w) { return __builtin_bit_cast(float, w & 0xffff0000u); }
__device__ __forceinline__ v4u pack8f(const float* v) { v4u o; o.x = cvt_pk_bf16(v[0], v[1]); o.y = cvt_pk_bf16(v[2], v[3]); o.z = cvt_pk_bf16(v[4], v[5]); o.w = cvt_pk_bf16(v[6], v[7]); return o; }
__device__ __forceinline__ void unpack8f(v4u w, float* v) { v[0] = bflo(w.x); v[1] = bfhi(w.x); v[2] = bflo(w.y); v[3] = bfhi(w.y); v[4] = bflo(w.z); v[5] = bfhi(w.z); v[6] = bflo(w.w); v[7] = bfhi(w.w); }
__device__ __forceinline__ float fq_sum(float s) { s += __shfl_xor(s, 16); s += __shfl_xor(s, 32); return s; }
__device__ __forceinline__ float wave_sum(float v) {
#pragma unroll
    for (int o = 1; o < 64; o <<= 1) v += __shfl_xor(v, o);
    return v;
}
__device__ __forceinline__ float rsq(float x) { return 1.0f / sqrtf(x); }
__device__ __forceinline__ void atomic_addf(float* p, float v) { unsafeAtomicAdd(p, v); }

namespace epi {
using pg8::Unit; using pg8::f32x4; using pg8::BM; using pg8::HALF;
typedef f32x4 Acc[2][2][4][2];

struct Swiglu {
    static constexpr bool PERM = true, AFTER_DRAIN = false;
    bf16_t* HB; const float* ssq; float* ckv; float* ssq_lat; float* ssq_kpe; int ngu;
    __device__ __forceinline__ void operator()(const f32x4 (&acc)[2][2][4][2], const Unit& u, int wr, int wc, int fr, int fq) const {
        float sq8[2][4];
#pragma unroll
        for (int ai = 0; ai < 2; ++ai)
#pragma unroll
            for (int m = 0; m < 4; ++m) sq8[ai][m] = ssq[u.pm * BM + ai * HALF + wr * 64 + m * 16 + fr];
#pragma unroll
        for (int ai = 0; ai < 2; ++ai)
#pragma unroll
            for (int m = 0; m < 4; ++m) {
                const int row = u.pm * BM + ai * HALF + wr * 64 + m * 16 + fr;
                const float rs = rsq(sq8[ai][m] * (1.0f / D) + EPS);
                if (u.pn < ngu) {
                    float h[8];
#pragma unroll
                    for (int n = 0; n < 2; ++n)
#pragma unroll
                        for (int j = 0; j < 4; ++j) { const float g = acc[ai][0][m][n][j] * rs, up = acc[ai][1][m][n][j] * rs;
                            const float sg = g * __builtin_amdgcn_rcpf(1.0f + __builtin_amdgcn_exp2f(-1.4426950408889634f * g)); h[4 * n + j] = sg * up; }
                    *(v4u*)(HB + (size_t)row * FF + 128 * u.pn + 32 * wc + 8 * fq) = pack8f(h);
                } else if (u.pn == ngu) {
                    float ss = 0.f;
#pragma unroll
                    for (int bj = 0; bj < 2; ++bj)
#pragma unroll
                        for (int n = 0; n < 2; ++n) { const f32x4 v = acc[ai][bj][m][n] * rs; ss += (v[0] * v[0] + v[1] * v[1]) + (v[2] * v[2] + v[3] * v[3]);
                            *(f32x4*)(ckv + (size_t)row * CKVW + 128 * bj + 32 * wc + 8 * fq + 4 * n) = v; }
                    ss = fq_sum(ss); if (fq == 0) atomic_addf(ssq_lat + row, ss);
                } else {
                    if (wc < 2) { float ss = 0.f;
#pragma unroll
                        for (int n = 0; n < 2; ++n) { const f32x4 v = acc[ai][0][m][n] * rs; ss += (v[0] * v[0] + v[1] * v[1]) + (v[2] * v[2] + v[3] * v[3]);
                            *(f32x4*)(ckv + (size_t)row * CKVW + 256 + 32 * wc + 8 * fq + 4 * n) = v; }
                        ss = fq_sum(ss); if (fq == 0) atomic_addf(ssq_kpe + row, ss); }
                }
            }
    }
};
struct Swiglu8 {
    static constexpr bool PERM = true, AFTER_DRAIN = false;
    bf16_t* HB; const float* ssq; const float* sa; const float* tsc;
    __device__ __forceinline__ void operator()(const f32x4 (&acc)[2][2][4][2], const Unit& u, int wr, int wc, int fr, int fq) const {
        typedef int i32x4 __attribute__((ext_vector_type(4)));
        int fq_ = fq, fr_ = fr; asm volatile("" : "+v"(fq_), "+v"(fr_));
        float f8[2][4], s8[2][4]; f32x4 tg[2], tu[2];
#pragma unroll
        for (int ai = 0; ai < 2; ++ai)
#pragma unroll
            for (int m = 0; m < 4; ++m) { const int row = u.pm * BM + ai * HALF + wr * 64 + m * 16 + fr_; f8[ai][m] = ssq[row]; s8[ai][m] = sa[row]; }
#pragma unroll
        for (int n = 0; n < 2; ++n) { tg[n] = *(const f32x4*)(tsc + 256 * u.pn + 32 * wc + 8 * fq_ + 4 * n); tu[n] = *(const f32x4*)(tsc + 256 * u.pn + 128 + 32 * wc + 8 * fq_ + 4 * n); }
#pragma unroll
        for (int ai = 0; ai < 2; ++ai)
#pragma unroll
            for (int m = 0; m < 4; ++m) {
                const int row = u.pm * BM + ai * HALF + wr * 64 + m * 16 + fr;
                const float rs = rsq(f8[ai][m] * (1.0f / D) + EPS) * s8[ai][m];
                float h[8];
#pragma unroll
                for (int n = 0; n < 2; ++n) { const i32x4 ig = __builtin_bit_cast(i32x4, acc[ai][0][m][n]), iu = __builtin_bit_cast(i32x4, acc[ai][1][m][n]);
#pragma unroll
                    for (int j = 0; j < 4; ++j) { const float g = (float)ig[j] * (rs * tg[n][j]), up = (float)iu[j] * (rs * tu[n][j]);
                        const float sg = g * __builtin_amdgcn_rcpf(1.0f + __builtin_amdgcn_exp2f(-1.4426950408889634f * g)); h[4 * n + j] = sg * up; } }
                *(v4u*)(HB + (size_t)row * FF + 128 * u.pn + 32 * wc + 8 * fq) = pack8f(h);
            }
    }
};
struct Dkv {
    static constexpr bool PERM = true, AFTER_DRAIN = false;
    const float* ssq; float* ckv; float* ssq_lat; float* ssq_kpe;
    __device__ __forceinline__ void operator()(const f32x4 (&acc)[2][2][4][2], const Unit& u, int wr, int wc, int fr, int fq) const {
        float sq8[2][4];
#pragma unroll
        for (int ai = 0; ai < 2; ++ai)
#pragma unroll
            for (int m = 0; m < 4; ++m) sq8[ai][m] = ssq[u.pm * BM + ai * HALF + wr * 64 + m * 16 + fr];
#pragma unroll
        for (int ai = 0; ai < 2; ++ai)
#pragma unroll
            for (int m = 0; m < 4; ++m) {
                const int row = u.pm * BM + ai * HALF + wr * 64 + m * 16 + fr;
                const float rs = rsq(sq8[ai][m] * (1.0f / D) + EPS);
                if (u.pn == 0) {
                    float ss = 0.f;
#pragma unroll
                    for (int bj = 0; bj < 2; ++bj)
#pragma unroll
                        for (int n = 0; n < 2; ++n) { const f32x4 v = acc[ai][bj][m][n] * rs; ss += (v[0] * v[0] + v[1] * v[1]) + (v[2] * v[2] + v[3] * v[3]);
                            *(f32x4*)(ckv + (size_t)row * CKVW + 128 * bj + 32 * wc + 8 * fq + 4 * n) = v; }
                    ss = fq_sum(ss); if (fq == 0) atomic_addf(ssq_lat + row, ss);
                } else if (wc < 2) { float ss = 0.f;
#pragma unroll
                    for (int n = 0; n < 2; ++n) { const f32x4 v = acc[ai][0][m][n] * rs; ss += (v[0] * v[0] + v[1] * v[1]) + (v[2] * v[2] + v[3] * v[3]);
                        *(f32x4*)(ckv + (size_t)row * CKVW + 256 + 32 * wc + 8 * fq + 4 * n) = v; }
                    ss = fq_sum(ss); if (fq == 0) atomic_addf(ssq_kpe + row, ss); }
            }
    }
};
template <bool FINAL>
struct ResidT {
    static constexpr bool PERM = true, AFTER_DRAIN = false;
    bf16_t* XB; float* P; float alpha;
    __device__ __forceinline__ void operator()(const f32x4 (&acc)[2][2][4][2], const Unit& u, int wr, int wc, int fr, int fq) const {
        v4u xv[2][4][2];
#pragma unroll
        for (int ai = 0; ai < 2; ++ai)
#pragma unroll
            for (int m = 0; m < 4; ++m) { const bf16_t* xp = XB + (size_t)(u.pm * BM + ai * HALF + wr * 64 + m * 16 + fr) * D + 256 * u.pn + 32 * wc + 8 * fq;
#pragma unroll
                for (int bj = 0; bj < 2; ++bj) xv[ai][m][bj] = *(const v4u*)(xp + 128 * bj); }
#pragma unroll
        for (int ai = 0; ai < 2; ++ai)
#pragma unroll
            for (int m = 0; m < 4; ++m) { const int row = u.pm * BM + ai * HALF + wr * 64 + m * 16 + fr;
                const size_t off = (size_t)row * D + 256 * u.pn + 32 * wc + 8 * fq; float ss = 0.f;
#pragma unroll
                for (int bj = 0; bj < 2; ++bj) { const v4u xw = xv[ai][m][bj];
                    const f32x4 v0 = (f32x4){bflo(xw.x), bfhi(xw.x), bflo(xw.y), bfhi(xw.y)} + acc[ai][bj][m][0] * alpha, v1 = (f32x4){bflo(xw.z), bfhi(xw.z), bflo(xw.w), bfhi(xw.w)} + acc[ai][bj][m][1] * alpha;
                    if constexpr (FINAL) { float* yp = P + off + 128 * bj; *(f32x4*)yp = v0; *(f32x4*)(yp + 4) = v1; }
                    else { ss += (v0[0] * v0[0] + v0[1] * v0[1]) + (v0[2] * v0[2] + v0[3] * v0[3]) + (v1[0] * v1[0] + v1[1] * v1[1]) + (v1[2] * v1[2] + v1[3] * v1[3]);
                        v4u w; w.x = cvt_pk_bf16(v0[0], v0[1]); w.y = cvt_pk_bf16(v0[2], v0[3]); w.z = cvt_pk_bf16(v1[0], v1[1]); w.w = cvt_pk_bf16(v1[2], v1[3]); *(v4u*)(XB + off + 128 * bj) = w; } }
                if constexpr (!FINAL) { ss = fq_sum(ss); if (fq == 0) atomic_addf(P + row, ss); } }
    }
};
using Resid = ResidT<false>;
using ResidY = ResidT<true>;
struct ConvIn {
    static constexpr bool PERM = true, AFTER_DRAIN = false;
    bf16_t* BB; bf16_t* UB; const float* ssq; float* csp; float* css;
    __device__ __forceinline__ void operator()(const f32x4 (&acc)[2][2][4][2], const Unit& u, int wr, int wc, int fr, int fq) const {
        float sq8[2][4];
#pragma unroll
        for (int ai = 0; ai < 2; ++ai)
#pragma unroll
            for (int m = 0; m < 4; ++m) sq8[ai][m] = ssq[u.pm * BM + ai * HALF + wr * 64 + m * 16 + fr];
#pragma unroll
        for (int ai = 0; ai < 2; ++ai)
#pragma unroll
            for (int m = 0; m < 4; ++m) {
                const int row = u.pm * BM + ai * HALF + wr * 64 + m * 16 + fr;
                const float rs = rsq(sq8[ai][m] * (1.0f / D) + EPS);
                if (u.pn < 4) {
#pragma unroll
                    for (int bj = 0; bj < 2; ++bj) { const f32x4 v0 = acc[ai][bj][m][0] * rs, v1 = acc[ai][bj][m][1] * rs;
                        v4u w; w.x = cvt_pk_bf16(v0[0], v0[1]); w.y = cvt_pk_bf16(v0[2], v0[3]); w.z = cvt_pk_bf16(v1[0], v1[1]); w.w = cvt_pk_bf16(v1[2], v1[3]);
                        *(v4u*)(BB + (size_t)row * D + 256 * u.pn + 128 * bj + 32 * wc + 8 * fq) = w; }
                } else {
                    const int ch0 = 128 * (u.pn - 4) + 32 * wc + 8 * fq;
                    const f32x4 u0 = (acc[ai][0][m][0] * rs) * (acc[ai][1][m][0] * rs), u1 = (acc[ai][0][m][1] * rs) * (acc[ai][1][m][1] * rs);
                    v4u w; w.x = cvt_pk_bf16(u0[0], u0[1]); w.y = cvt_pk_bf16(u0[2], u0[3]); w.z = cvt_pk_bf16(u1[0], u1[1]); w.w = cvt_pk_bf16(u1[2], u1[3]);
                    *(v4u*)(UB + (size_t)row * D + ch0) = w;
                    float* dst = nullptr;
                    if (row < TP) { const int t = row & (SEQ - 1); if (t >= SEQ - 2) dst = csp + (size_t)((row >> 13) * 2 + (t - (SEQ - 2))) * D + ch0; }
                    else { const int rs_ = row - TP, i = rs_ & 3; if (i >= 2) dst = css + (size_t)((rs_ >> 2) * 2 + (i - 2)) * D + ch0; }
                    if (dst) { *(f32x4*)dst = u0; *(f32x4*)(dst + 4) = u1; }
                }
            }
    }
};
struct Dq {
    static constexpr bool PERM = true, AFTER_DRAIN = false;
    bf16_t* CQB; const float* ssq; float* ssq_out;
    __device__ __forceinline__ void operator()(const f32x4 (&acc)[2][2][4][2], const Unit& u, int wr, int wc, int fr, int fq) const {
        float sq8[2][4];
#pragma unroll
        for (int ai = 0; ai < 2; ++ai)
#pragma unroll
            for (int m = 0; m < 4; ++m) sq8[ai][m] = ssq[u.pm * BM + ai * HALF + wr * 64 + m * 16 + fr];
#pragma unroll
        for (int ai = 0; ai < 2; ++ai)
#pragma unroll
            for (int m = 0; m < 4; ++m) {
                const int row = u.pm * BM + ai * HALF + wr * 64 + m * 16 + fr;
                const float rs = rsq(sq8[ai][m] * (1.0f / D) + EPS);
                float ss = 0.f;
#pragma unroll
                for (int bj = 0; bj < 2; ++bj) { const f32x4 v0 = acc[ai][bj][m][0] * rs, v1 = acc[ai][bj][m][1] * rs;
                    ss += (v0[0] * v0[0] + v0[1] * v0[1]) + (v0[2] * v0[2] + v0[3] * v0[3]) + (v1[0] * v1[0] + v1[1] * v1[1]) + (v1[2] * v1[2] + v1[3] * v1[3]);
                    v4u w; w.x = cvt_pk_bf16(v0[0], v0[1]); w.y = cvt_pk_bf16(v0[2], v0[3]); w.z = cvt_pk_bf16(v1[0], v1[1]); w.w = cvt_pk_bf16(v1[2], v1[3]);
                    *(v4u*)(CQB + (size_t)row * QRANK + 256 * u.pn + 128 * bj + 32 * wc + 8 * fq) = w; }
                ss = fq_sum(ss); if (fq == 0) atomic_addf(ssq_out + row, ss);
            }
    }
};
struct Uq {
    static constexpr bool PERM = true, AFTER_DRAIN = false;
    bf16_t* QB; const float* ssq; float* ssq_q;
    __device__ __forceinline__ void operator()(const f32x4 (&acc)[2][2][4][2], const Unit& u, int wr, int wc, int fr, int fq) const {
        float sq8[2][4];
#pragma unroll
        for (int ai = 0; ai < 2; ++ai)
#pragma unroll
            for (int m = 0; m < 4; ++m) sq8[ai][m] = ssq[u.pm * BM + ai * HALF + wr * 64 + m * 16 + fr];
#pragma unroll
        for (int ai = 0; ai < 2; ++ai)
#pragma unroll
            for (int m = 0; m < 4; ++m) {
                const int row = u.pm * BM + ai * HALF + wr * 64 + m * 16 + fr;
                const float rs = rsq(sq8[ai][m] * (1.0f / QRANK) + EPS);
#pragma unroll
                for (int bj = 0; bj < 2; ++bj) { const f32x4 v0 = acc[ai][bj][m][0] * rs, v1 = acc[ai][bj][m][1] * rs;
                    float ss = (v0[0] * v0[0] + v0[1] * v0[1]) + (v0[2] * v0[2] + v0[3] * v0[3]) + (v1[0] * v1[0] + v1[1] * v1[1]) + (v1[2] * v1[2] + v1[3] * v1[3]);
                    const int cb = 256 * u.pn + 128 * bj + 32 * wc;
                    const int hh = cb / HD, seg = 2 * hh + ((cb - hh * HD) >= 128 ? 1 : 0);
                    v4u w; w.x = cvt_pk_bf16(v0[0], v0[1]); w.y = cvt_pk_bf16(v0[2], v0[3]); w.z = cvt_pk_bf16(v1[0], v1[1]); w.w = cvt_pk_bf16(v1[2], v1[3]);
                    *(v4u*)(QB + (size_t)row * NQ + cb + 8 * fq) = w;
                    ss = fq_sum(ss); if (fq == 0) atomic_addf(ssq_q + (size_t)seg * T + row, ss); }
            }
    }
};
struct Kv {
    static constexpr bool PERM = true, AFTER_DRAIN = false;
    bf16_t* KU; bf16_t* VB; float* RP; size_t nrows;
    __device__ __forceinline__ void operator()(const f32x4 (&acc)[2][2][4][2], const Unit& u, int wr, int wc, int fr, int fq) const {
#pragma unroll
        for (int ai = 0; ai < 2; ++ai)
#pragma unroll
            for (int m = 0; m < 4; ++m) {
                const unsigned row = (unsigned)(u.pm * BM + ai * HALF + wr * 64 + m * 16 + fr);
                if (u.pn < 4) {
                    const int head = 2 * u.pn + (wc >> 1);
                    float ss = 0.f;
#pragma unroll
                    for (int bj = 0; bj < 2; ++bj) { const f32x4 v0 = acc[ai][bj][m][0], v1 = acc[ai][bj][m][1];
                        ss += (v0[0] * v0[0] + v0[1] * v0[1]) + (v0[2] * v0[2] + v0[3] * v0[3]) + (v1[0] * v1[0] + v1[1] * v1[1]) + (v1[2] * v1[2] + v1[3] * v1[3]);
                        if (KU) { v4u w; w.x = cvt_pk_bf16(v0[0], v0[1]); w.y = cvt_pk_bf16(v0[2], v0[3]); w.z = cvt_pk_bf16(v1[0], v1[1]); w.w = cvt_pk_bf16(v1[2], v1[3]);
                            *(v4u*)(KU + (size_t)(row * D + 128 * head + 64 * (wc & 1) + 32 * bj + 8 * fq)) = w; } }
                    ss = fq_sum(ss); if (fq == 0) RP[(size_t)((unsigned)(2 * head + (wc & 1)) * (unsigned)nrows + row)] = ss;
                } else if (VB) {
#pragma unroll
                    for (int bj = 0; bj < 2; ++bj) { const f32x4 v0 = acc[ai][bj][m][0], v1 = acc[ai][bj][m][1];
                        v4u w; w.x = cvt_pk_bf16(v0[0], v0[1]); w.y = cvt_pk_bf16(v0[2], v0[3]); w.z = cvt_pk_bf16(v1[0], v1[1]); w.w = cvt_pk_bf16(v1[2], v1[3]);
                        *(v4u*)(VB + (size_t)(row * D + 256 * (u.pn - 4) + 128 * bj + 32 * wc + 8 * fq)) = w; }
                }
            }
    }
};
struct Kv8 {
    static constexpr bool PERM = true, AFTER_DRAIN = false;
    float* RP; const float* sc2; const LAS float* t2; size_t nrows;
    __device__ __forceinline__ void operator()(const f32x4 (&acc)[2][2][4][2], const Unit& u, int wr, int wc, int fr, int fq) const {
        typedef int i32x4 __attribute__((ext_vector_type(4)));
        const int head = 2 * u.pn + (wc >> 1);
        int fq_ = fq; asm volatile("" : "+v"(fq_));
        float ss[2][4];
#pragma unroll
        for (int ai = 0; ai < 2; ++ai)
#pragma unroll
            for (int m = 0; m < 4; ++m) ss[ai][m] = 0.f;
#pragma unroll
        for (int bj = 0; bj < 2; ++bj)
#pragma unroll
            for (int n = 0; n < 2; ++n) { const f32x4 tv = *(const LAS f32x4*)(t2 + 256 * u.pn + 128 * bj + 32 * wc + 8 * fq_ + 4 * n);
#pragma unroll
                for (int ai = 0; ai < 2; ++ai)
#pragma unroll
                    for (int m = 0; m < 4; ++m) { const i32x4 vi = __builtin_bit_cast(i32x4, acc[ai][bj][m][n]);
#pragma unroll
                        for (int j = 0; j < 4; ++j) { const float f = (float)vi[j]; ss[ai][m] += f * f * tv[j]; } } }
#pragma unroll
        for (int ai = 0; ai < 2; ++ai)
#pragma unroll
            for (int m = 0; m < 4; ++m) {
                const unsigned row = (unsigned)(u.pm * BM + ai * HALF + wr * 64 + m * 16 + fr);
                const float s_ = fq_sum(ss[ai][m]); if (fq == 0) RP[(size_t)((unsigned)(2 * head + (wc & 1)) * (unsigned)nrows + row)] = s_;
            }
    }
};
struct Slab {
    static constexpr bool PERM = true, AFTER_DRAIN = false;
    float* slab;
    __device__ __forceinline__ void operator()(const f32x4 (&acc)[2][2][4][2], const Unit& u, int wr, int wc, int fr, int fq) const {
        float* base = slab + (size_t)(u.ko >> 9) * TS * D;
#pragma unroll
        for (int ai = 0; ai < 2; ++ai)
#pragma unroll
            for (int m = 0; m < 4; ++m) { float* p = base + (size_t)(u.pm * BM + ai * HALF + wr * 64 + m * 16 + fr) * D + 256 * u.pn + 32 * wc + 8 * fq;
#pragma unroll
                for (int bj = 0; bj < 2; ++bj) { *(f32x4*)(p + 128 * bj) = acc[ai][bj][m][0]; *(f32x4*)(p + 128 * bj + 4) = acc[ai][bj][m][1]; } }
    }
};
}

struct Ctx {
    LAS unsigned char* lds;
    int tid, lane, wave, vcu, G;
};
struct PrepD { const float* W; const float* gain; bf16_t* WT; int K, N, drow0, k0, n0; };
__device__ __forceinline__ void prep_load(const PrepD& d, f32x4 (&v)[8], float (&gk)[8], int lane) {
    if (!d.W) return;
    const int r = lane >> 3, c4 = lane & 7;
#pragma unroll
    for (int i = 0; i < 8; ++i) { v[i] = *(const f32x4*)(d.W + (size_t)(d.k0 + 8 * i + r) * d.N + d.n0 + 4 * c4); gk[i] = d.gain ? d.gain[d.k0 + 8 * i + r] : 1.0f; }
}
__device__ __forceinline__ void prep_finish(const PrepD& d, const f32x4 (&v)[8], const float (&gk)[8], LAS float* scr, int lane) {
    if (!d.W) { const v4u z = {0u, 0u, 0u, 0u};
#pragma unroll
        for (int j = 0; j < 2; ++j) *(v4u*)(d.WT + 8 * (lane + 64 * j)) = z;
        return; }
    { const int r = lane >> 3, c4 = lane & 7;
#pragma unroll
      for (int i = 0; i < 8; ++i) { LAS float* sp = scr + (8 * i + r) * 33 + 4 * c4; sp[0] = v[i].x * gk[i]; sp[1] = v[i].y * gk[i]; sp[2] = v[i].z * gk[i]; sp[3] = v[i].w * gk[i]; } }
    LDS_WAIT(); asm volatile("" ::: "memory");
    const int c = lane & 7;
#pragma unroll
    for (int j = 0; j < 4; ++j) { const int n = (lane >> 3) + 8 * j; const LAS float* s = scr + (8 * c) * 33 + n;
        v4u o; o.x = cvt_pk_bf16(s[0 * 33], s[1 * 33]); o.y = cvt_pk_bf16(s[2 * 33], s[3 * 33]); o.z = cvt_pk_bf16(s[4 * 33], s[5 * 33]); o.w = cvt_pk_bf16(s[6 * 33], s[7 * 33]);
        *(v4u*)(d.WT + (size_t)(d.drow0 + n) * d.K + d.k0 + 8 * c) = o; }
    LDS_WAIT(); asm volatile("" ::: "memory");
}
__device__ __forceinline__ int gu_map(int nb) { const int up = nb >= 88 ? 1 : 0, hb = nb - 88 * up; return 256 * (hb >> 2) + 128 * up + 32 * (hb & 3); }
__device__ __forceinline__ int ci_map(int nb) { if (nb < 32) return 32 * nb; const int hh = nb >= 64 ? 1 : 0, cb = nb - 32 - 32 * hh; return 256 * (4 + (cb >> 2)) + 128 * hh + 32 * (cb & 3); }
__device__ __forceinline__ int uk_map(int nb) { const int h = nb >> 2, dq = nb & 3; return 256 * (h >> 1) + 128 * (dq & 1) + 32 * (2 * (h & 1) + (dq >> 1)); }
__device__ __forceinline__ int uk_row(int h, int d) { return 256 * (h >> 1) + 128 * ((d >> 5) & 1) + 32 * (2 * (h & 1) + (d >> 6)) + (d & 31); }

struct Ptrs {
    const float* in[29]; float* out; unsigned char* ws;
};
typedef const __attribute__((address_space(4))) Ptrs CPtrs;

__device__ __forceinline__ void phase_prologue(const Ctx& C, CPtrs& P) {
    unsigned char* ws = P.ws;
    LAS float* scr = (LAS float*)(C.lds + RING_OFF + C.wave * 16384);
    const int lane = C.lane;
    const int gw = C.vcu * NWAVES + C.wave, NGW = C.G * NWAVES;
    constexpr int I_GU = 16 * 176, I_DKV = 16 * 10, I_DN = 44 * 32, I_CI = 16 * 96, I_SQ = 16 * 32, I_DQ = 16 * 16, I_UQ = 8 * 48, I_UKV = 4 * 32, I_Z = 192;
    constexpr int NITEMS = I_DKV + 4 * I_DN + I_CI + I_SQ + I_DQ + I_UQ + I_SQ + 2 * I_UKV + I_Z;
    auto decode = [&](int it) -> PrepD {
        int r = it;
        if (r < I_DKV) { const int kb = r / 10, nb = r % 10; return PrepD{P.in[23], P.in[22], (bf16_t*)(ws + WS_WDKV), D, CKVW, 32 * nb, 64 * (kb), 32 * (nb)}; } r -= I_DKV;
        if (r < 4 * I_DN) { const int mi = r / I_DN; r -= mi * I_DN; const int kb = r / 32, nb = r % 32;
            const float* W = (mi & 1 ? P.in[12] : P.in[8]) + (size_t)(mi >> 1) * FF * D;
            bf16_t* dst = (bf16_t*)(ws + (mi == 0 ? WS_WDN0 : mi == 1 ? WS_WDN1 : mi == 2 ? WS_WDN2 : WS_WDN3));
            return PrepD{W, nullptr, dst, FF, D, 32 * nb, 64 * (kb), 32 * (nb)}; } r -= 4 * I_DN;
        if (r < I_CI) { const int kb = r / 96, nb = r % 96; return PrepD{P.in[13], P.in[9], (bf16_t*)(ws + WS_WCI), D, 3 * D, ci_map(nb), 64 * (kb), 32 * (nb)}; } r -= I_CI;
        if (r < I_SQ) { const int kb = r / 32, nb = r % 32; return PrepD{P.in[15], nullptr, (bf16_t*)(ws + WS_WCO), D, D, 32 * nb, 64 * (kb), 32 * (nb)}; } r -= I_SQ;
        if (r < I_DQ) { const int kb = r / 16, nb = r % 16; return PrepD{P.in[16], P.in[9] + D, (bf16_t*)(ws + WS_WDQ), D, QRANK, 32 * nb, 64 * (kb), 32 * (nb)}; } r -= I_DQ;
        if (r < I_UQ) { const int kb = r / 48, nb = r % 48; return PrepD{P.in[18], P.in[17], (bf16_t*)(ws + WS_WUQ), QRANK, NQ, 32 * nb, 64 * (kb), 32 * (nb)}; } r -= I_UQ;
        if (r < I_SQ) { const int kb = r / 32, nb = r % 32; return PrepD{P.in[21], nullptr, (bf16_t*)(ws + WS_WO), D, D, 32 * nb, 64 * (kb), 32 * (nb)}; } r -= I_SQ;
        if (r < I_UKV) { const int kb = r / 32, nb = r % 32; return PrepD{P.in[26], nullptr, (bf16_t*)(ws + WS_WUKV), KVR, D, uk_map(nb), 64 * (kb), 32 * (nb)}; } r -= I_UKV;
        if (r < I_UKV) { const int kb = r / 32, nb = r % 32; return PrepD{P.in[27], nullptr, (bf16_t*)(ws + WS_WUKV), KVR, D, 1024 + 32 * nb, 64 * (kb), 32 * (nb)}; } r -= I_UKV;
        return PrepD{nullptr, nullptr, (bf16_t*)(ws + WS_WDKV) + (size_t)(320 + r) * D, 0, 0, 0, 0, 0};
    };
    if (gw < NITEMS) {
        PrepD cur = decode(gw); f32x4 v[8]; float gk[8]; prep_load(cur, v, gk, lane);
        for (int it = gw; it < NITEMS; it += NGW) {
            PrepD nxt = cur; f32x4 vn[8]; float gn[8];
            if (it + NGW < NITEMS) { nxt = decode(it + NGW); prep_load(nxt, vn, gn, lane); }
            prep_finish(cur, v, gk, scr, lane);
            cur = nxt;
#pragma unroll
            for (int i = 0; i < 8; ++i) { v[i] = vn[i]; gk[i] = gn[i]; }
        }
    }
    {
        f32x2* tab = (f32x2*)(ws + WS_ROPE);
        for (int e = gw * 64 + lane; e < (SEQ + DS) * 32; e += NGW * 64) {
            const int pos = e >> 5, j = e & 31;
            double f = 1.0; for (int i = 0; i < j; ++i) f *= 0.74989420933245582730;
            const double ang = (double)pos * f;
            const double k = __builtin_rint(ang * 0.15915494309189533577);
            double r = __builtin_fma(-k, 6.283185307179586232, ang); r = __builtin_fma(-k, 2.4492935982947064e-16, r);
            const double r2 = r * r; double ts = 1.0, tc = 1.0, ss = 1.0, cs = 1.0;
#pragma unroll
            for (int q = 1; q <= 14; ++q) { tc *= -r2 / (double)((2 * q - 1) * (2 * q)); cs += tc; ts *= -r2 / (double)((2 * q) * (2 * q + 1)); ss += ts; }
            tab[e] = (f32x2){(float)cs, (float)(ss * r)};
        }
    }
    {
        bf16_t* XB = (bf16_t*)(ws + WS_XB); float* ssq = (float*)(ws + WS_CTL) + F_SSQX; unsigned char* A8 = ws + WS_A8; float* SA = (float*)(ws + WS_SA);
        for (int row0 = gw; row0 < T; row0 += 2 * NGW) {
            f32x4 v[2][4]; float s[2]; const int nr = row0 + NGW < T ? 2 : 1;
#pragma unroll
            for (int q = 0; q < 2; ++q) { const int row = row0 + (q < nr ? q * NGW : 0); const float* src = row < TP ? P.in[0] + (size_t)row * D : P.in[1] + (size_t)(row - TP) * D;
#pragma unroll
                for (int j = 0; j < 4; ++j) v[q][j] = *((const f32x4*)src + lane + 64 * j); }
#pragma unroll
            for (int q = 0; q < 2; ++q) { s[q] = 0.f;
#pragma unroll
                for (int j = 0; j < 4; ++j) s[q] += (v[q][j].x * v[q][j].x + v[q][j].y * v[q][j].y) + (v[q][j].z * v[q][j].z + v[q][j].w * v[q][j].w);
                s[q] = wave_sum(s[q]); }
#pragma unroll
            for (int q = 0; q < 2; ++q) if (q < nr) { const int row = row0 + q * NGW;
#pragma unroll
                for (int j = 0; j < 4; ++j) {
                    u32x2 w; w.x = cvt_pk_bf16(v[q][j].x, v[q][j].y); w.y = cvt_pk_bf16(v[q][j].z, v[q][j].w); *((u32x2*)(XB + (size_t)row * D) + lane + 64 * j) = w; }
                if (lane == 0) ssq[row] = s[q];
                float am = 0.f;
#pragma unroll
                for (int j = 0; j < 4; ++j) am = fmaxf(am, fmaxf(fmaxf(fabsf(v[q][j].x), fabsf(v[q][j].y)), fmaxf(fabsf(v[q][j].z), fabsf(v[q][j].w))));
#pragma unroll
                for (int o = 1; o < 64; o <<= 1) am = fmaxf(am, __shfl_xor(am, o));
                const float inv = am > 0.f ? 127.0f / am : 0.f;
#pragma unroll
                for (int j = 0; j < 4; ++j) { const int q0 = __float2int_rn(v[q][j].x * inv), q1 = __float2int_rn(v[q][j].y * inv), q2 = __float2int_rn(v[q][j].z * inv), q3 = __float2int_rn(v[q][j].w * inv);
                    *(unsigned*)(A8 + (size_t)row * D + 4 * (lane + 64 * j)) = (unsigned)(q0 & 255) | ((unsigned)(q1 & 255) << 8) | ((unsigned)(q2 & 255) << 16) | ((unsigned)q3 << 24); }
                if (lane == 0) SA[row] = am * (1.0f / 127.0f); }
        }
    }
}

#ifndef SA_INT8_COPY_ONLY
#define SA_INT8_COPY_ONLY 1
#endif
__device__ __forceinline__ void phase_cacheconv(const Ctx& C, CPtrs& P, int cw, int nconv) {
    unsigned char* ws = P.ws; const int lane = C.lane;
    const int* pt = (const int*)P.in[5]; bf16_t* CLB = (bf16_t*)(ws + WS_CLB); unsigned char* CL8 = ws + WS_CL8; float* SC2 = (float*)(ws + WS_SC2);
    for (int pg = cw * NWAVES + C.wave; pg < DB * NPG; pg += nconv * NWAVES) {
        const int phys = pt[pg];
        const float* sl = P.in[2] + (size_t)phys * PAGE * KVR; bf16_t* dl = CLB + (size_t)pg * PAGE * KVR;
        for (int i0 = 0; i0 < 64; i0 += 8) {
            f32x4 a[8], c[8];
#pragma unroll
            for (int j = 0; j < 8; ++j) { a[j] = *((const f32x4*)sl + 2 * (lane + 64 * (i0 + j))); c[j] = *((const f32x4*)sl + 2 * (lane + 64 * (i0 + j)) + 1); }
#pragma unroll
            for (int j = 0; j < 8; ++j) {
#if !SA_INT8_COPY_ONLY
                { v4u w; w.x = cvt_pk_bf16(a[j].x, a[j].y); w.y = cvt_pk_bf16(a[j].z, a[j].w); w.z = cvt_pk_bf16(c[j].x, c[j].y); w.w = cvt_pk_bf16(c[j].z, c[j].w); *((v4u*)dl + lane + 64 * (i0 + j)) = w; }
#endif
                float am = fmaxf(fmaxf(fmaxf(fabsf(a[j].x), fabsf(a[j].y)), fmaxf(fabsf(a[j].z), fabsf(a[j].w))), fmaxf(fmaxf(fabsf(c[j].x), fabsf(c[j].y)), fmaxf(fabsf(c[j].z), fabsf(c[j].w))));
#pragma unroll
                for (int o = 1; o < 32; o <<= 1) am = fmaxf(am, __shfl_xor(am, o));
                const float inv = am > 0.f ? 127.0f / am : 0.f;
                const int q0 = __float2int_rn(a[j].x * inv), q1 = __float2int_rn(a[j].y * inv), q2 = __float2int_rn(a[j].z * inv), q3 = __float2int_rn(a[j].w * inv);
                const int q4 = __float2int_rn(c[j].x * inv), q5 = __float2int_rn(c[j].y * inv), q6 = __float2int_rn(c[j].z * inv), q7 = __float2int_rn(c[j].w * inv);
                u32x2 qw; qw.x = (unsigned)(q0 & 255) | ((unsigned)(q1 & 255) << 8) | ((unsigned)(q2 & 255) << 16) | ((unsigned)q3 << 24);
                qw.y = (unsigned)(q4 & 255) | ((unsigned)(q5 & 255) << 8) | ((unsigned)(q6 & 255) << 16) | ((unsigned)q7 << 24);
                const size_t row = (size_t)pg * PAGE + 2 * (i0 + j) + (lane >> 5);
                *(u32x2*)(CL8 + row * KVR + 8 * (lane & 31)) = qw;
                if ((lane & 31) == 0) { const float sc = am * (1.0f / 127.0f); SC2[row] = sc * sc; } }
        }
    }
}

__device__ __forceinline__ void phase_w8(const Ctx& C, CPtrs& P) {
    unsigned char* ws = P.ws; const float* wuk = P.in[26]; unsigned char* W8 = ws + WS_W8; float* T2 = (float*)(ws + WS_T2); const int lane = C.lane;
    for (int r = C.vcu * NWAVES + C.wave; r < D; r += C.G * NWAVES) {
        const int pn = r >> 8, bj = (r >> 7) & 1, wc = (r >> 5) & 3, h = 2 * pn + (wc >> 1), d = 64 * (wc & 1) + 32 * bj + (r & 31), col = 128 * h + d;
        float x[4]; float am = 0.f;
#pragma unroll
        for (int e = 0; e < 4; ++e) { x[e] = wuk[(size_t)(4 * lane + e) * D + col]; am = fmaxf(am, fabsf(x[e])); }
#pragma unroll
        for (int o = 1; o < 64; o <<= 1) am = fmaxf(am, __shfl_xor(am, o));
        const float inv = am > 0.f ? 127.0f / am : 0.f;
        const int q0 = __float2int_rn(x[0] * inv), q1 = __float2int_rn(x[1] * inv), q2 = __float2int_rn(x[2] * inv), q3 = __float2int_rn(x[3] * inv);
        *(unsigned*)(W8 + (size_t)r * KVR + 4 * lane) = (unsigned)(q0 & 255) | ((unsigned)(q1 & 255) << 8) | ((unsigned)(q2 & 255) << 16) | ((unsigned)q3 << 24);
        if (lane == 0) { const float sc = am * (1.0f / 127.0f); T2[r] = sc * sc; }
    }
}

__device__ __forceinline__ void phase_quant(const Ctx& C, CPtrs& P, const float* slab = nullptr, int ns = 0, float* ssq_out = nullptr) {
    unsigned char* ws = P.ws; bf16_t* XB = (bf16_t*)(ws + WS_XB); unsigned char* A8 = ws + WS_A8; float* SA = (float*)(ws + WS_SA);
    const int gw = C.vcu * NWAVES + C.wave, NGW = C.G * NWAVES, lane = C.lane;
    if (slab) {
        for (int r = gw; r < TS; r += NGW) { const size_t row = (size_t)TP + r; f32x4 v[4]; float ss = 0.f, am = 0.f;
#pragma unroll
            for (int j = 0; j < 4; ++j) { const u32x2 xw = *((const u32x2*)(XB + row * D) + lane + 64 * j); f32x4 a = {bflo(xw.x), bfhi(xw.x), bflo(xw.y), bfhi(xw.y)};
                for (int c = 0; c < ns; ++c) a += *((const f32x4*)(slab + ((size_t)c * TS + r) * D) + lane + 64 * j);
                v[j] = a; ss += (a.x * a.x + a.y * a.y) + (a.z * a.z + a.w * a.w); am = fmaxf(am, fmaxf(fmaxf(fabsf(a.x), fabsf(a.y)), fmaxf(fabsf(a.z), fabsf(a.w)))); }
            ss = wave_sum(ss);
#pragma unroll
            for (int o = 1; o < 64; o <<= 1) am = fmaxf(am, __shfl_xor(am, o));
            const float inv = am > 0.f ? 127.0f / am : 0.f;
#pragma unroll
            for (int j = 0; j < 4; ++j) { u32x2 w; w.x = cvt_pk_bf16(v[j].x, v[j].y); w.y = cvt_pk_bf16(v[j].z, v[j].w); *((u32x2*)(XB + row * D) + lane + 64 * j) = w;
                const int q0 = __float2int_rn(v[j].x * inv), q1 = __float2int_rn(v[j].y * inv), q2 = __float2int_rn(v[j].z * inv), q3 = __float2int_rn(v[j].w * inv);
                *(unsigned*)(A8 + row * D + 4 * (lane + 64 * j)) = (unsigned)(q0 & 255) | ((unsigned)(q1 & 255) << 8) | ((unsigned)(q2 & 255) << 16) | ((unsigned)q3 << 24); }
            if (lane == 0) { ssq_out[row] = ss; SA[row] = am * (1.0f / 127.0f); } }
    }
    const int TQ = slab ? TP : T;
    constexpr int RPS = 4;
    for (int row0 = gw; row0 < TQ; row0 += RPS * NGW) {
        v4u w[RPS][2];
#pragma unroll
        for (int q = 0; q < RPS; ++q) { const int rq = row0 + q * NGW, row = rq < TQ ? rq : row0; w[q][0] = *((const v4u*)(XB + (size_t)row * D) + 2 * lane); w[q][1] = *((const v4u*)(XB + (size_t)row * D) + 2 * lane + 1); }
#pragma unroll
        for (int q = 0; q < RPS; ++q) if (row0 + q * NGW < TQ) { const int row = row0 + q * NGW; float x[16]; unpack8f(w[q][0], x); unpack8f(w[q][1], x + 8);
            float am = 0.f;
#pragma unroll
            for (int e = 0; e < 16; ++e) am = fmaxf(am, fabsf(x[e]));
#pragma unroll
            for (int o = 1; o < 64; o <<= 1) am = fmaxf(am, __shfl_xor(am, o));
            const float inv = am > 0.f ? 127.0f / am : 0.f; v4u o4; unsigned ww[4];
#pragma unroll
            for (int g = 0; g < 4; ++g) { const int q0 = __float2int_rn(x[4 * g] * inv), q1 = __float2int_rn(x[4 * g + 1] * inv), q2 = __float2int_rn(x[4 * g + 2] * inv), q3 = __float2int_rn(x[4 * g + 3] * inv);
                ww[g] = (unsigned)(q0 & 255) | ((unsigned)(q1 & 255) << 8) | ((unsigned)(q2 & 255) << 16) | ((unsigned)q3 << 24); }
            o4.x = ww[0]; o4.y = ww[1]; o4.z = ww[2]; o4.w = ww[3];
            *((v4u*)(A8 + (size_t)row * D) + lane) = o4;
            if (lane == 0) SA[row] = am * (1.0f / 127.0f); }
    }
}
__device__ __forceinline__ void phase_w8gu(const Ctx& C, CPtrs& P) {
    unsigned char* ws = P.ws; const int lane = C.lane, r = lane >> 3, c4 = lane & 7;
    LAS float* scr = (LAS float*)(C.lds + RING_OFF + C.wave * 16384);
    for (int item = C.vcu * NWAVES + C.wave; item < 4 * 176; item += C.G * NWAVES) {
        const int mi = item / 176, nb = item % 176, n0 = 32 * nb, N = 2 * FF;
        const float* W = (mi & 1 ? P.in[11] : P.in[7]) + (size_t)(mi >> 1) * D * N; const float* g = (mi & 1 ? P.in[10] : P.in[6]) + (mi >> 1) * D;
        unsigned char* W8 = ws + WS_W8GU0 + (size_t)mi * WS_W8GU_STRIDE; float* TS = (float*)(ws + WS_TGU) + mi * N;
        const int drow0 = gu_map(nb);
        float am[4] = {0.f, 0.f, 0.f, 0.f};
#pragma unroll 16
        for (int kb = 0; kb < D / 8; ++kb) { const int k = 8 * kb + r; const f32x4 v = *(const f32x4*)(W + (size_t)k * N + n0 + 4 * c4); const float gk = g[k];
            am[0] = fmaxf(am[0], fabsf(v.x * gk)); am[1] = fmaxf(am[1], fabsf(v.y * gk)); am[2] = fmaxf(am[2], fabsf(v.z * gk)); am[3] = fmaxf(am[3], fabsf(v.w * gk)); }
        float inv[4];
#pragma unroll
        for (int j = 0; j < 4; ++j) { float a = am[j]; a = fmaxf(a, __shfl_xor(a, 8)); a = fmaxf(a, __shfl_xor(a, 16)); a = fmaxf(a, __shfl_xor(a, 32)); inv[j] = a > 0.f ? 127.0f / a : 0.f; am[j] = a; }
        if (r == 0) *(f32x4*)(TS + drow0 + 4 * c4) = (f32x4){am[0] * (1.0f / 127.0f), am[1] * (1.0f / 127.0f), am[2] * (1.0f / 127.0f), am[3] * (1.0f / 127.0f)};
        for (int k0 = 0; k0 < D; k0 += 64) {
            f32x4 v[8]; float gk[8];
#pragma unroll
            for (int i = 0; i < 8; ++i) { v[i] = *(const f32x4*)(W + (size_t)(k0 + 8 * i + r) * N + n0 + 4 * c4); gk[i] = g[k0 + 8 * i + r]; }
#pragma unroll
            for (int i = 0; i < 8; ++i) { LAS float* sp = scr + (8 * i + r) * 33 + 4 * c4;
                sp[0] = __builtin_rintf(v[i].x * gk[i] * inv[0]); sp[1] = __builtin_rintf(v[i].y * gk[i] * inv[1]); sp[2] = __builtin_rintf(v[i].z * gk[i] * inv[2]); sp[3] = __builtin_rintf(v[i].w * gk[i] * inv[3]); }
            LDS_WAIT(); asm volatile("" ::: "memory");
            const int c = lane & 7;
#pragma unroll
            for (int j = 0; j < 4; ++j) { const int n = (lane >> 3) + 8 * j; const LAS float* s = scr + (8 * c) * 33 + n;
                const int q0 = (int)s[0 * 33], q1 = (int)s[1 * 33], q2 = (int)s[2 * 33], q3 = (int)s[3 * 33], q4 = (int)s[4 * 33], q5 = (int)s[5 * 33], q6 = (int)s[6 * 33], q7 = (int)s[7 * 33];
                u32x2 o; o.x = (unsigned)(q0 & 255) | ((unsigned)(q1 & 255) << 8) | ((unsigned)(q2 & 255) << 16) | ((unsigned)q3 << 24);
                o.y = (unsigned)(q4 & 255) | ((unsigned)(q5 & 255) << 8) | ((unsigned)(q6 & 255) << 16) | ((unsigned)q7 << 24);
                *(u32x2*)(W8 + (size_t)(drow0 + n) * D + k0 + 8 * c) = o; }
            LDS_WAIT(); asm volatile("" ::: "memory");
        }
    }
}

__device__ __forceinline__ void phase_conv(const Ctx& C, CPtrs& P) {
    unsigned char* ws = P.ws; const bf16_t* BB = (const bf16_t*)(ws + WS_BB); const bf16_t* UB = (const bf16_t*)(ws + WS_UB); bf16_t* ZB = (bf16_t*)(ws + WS_ZB);
    const float* cw = P.in[14]; const float* st = P.in[4];
    const int gw = C.vcu * NWAVES + C.wave, NGW = C.G * NWAVES, lane = C.lane;
    for (int row = gw; row < T; row += NGW) {
        int have1, have2; const float* s1 = nullptr; const float* s2 = nullptr;
        if (row < TP) { const int t = row & (SEQ - 1); have1 = t >= 1; have2 = t >= 2; }
        else { const int r = row - TP, i = r & 3, b = r >> 2; have1 = i >= 1; have2 = i >= 2;
            if (!have1) s1 = st + (size_t)(b * 2 + 1) * D; if (!have2) s2 = st + (size_t)(b * 2 + i) * D; }
        v4u rb[2], r0[2], r1[2], r2[2];
#pragma unroll
        for (int j = 0; j < 2; ++j) { const int ch = 8 * lane + 512 * j; rb[j] = *(const v4u*)(BB + (size_t)row * D + ch); r0[j] = *(const v4u*)(UB + (size_t)row * D + ch);
            r1[j] = have1 ? *(const v4u*)(UB + (size_t)(row - 1) * D + ch) : (v4u){0u, 0u, 0u, 0u}; r2[j] = have2 ? *(const v4u*)(UB + (size_t)(row - 2) * D + ch) : (v4u){0u, 0u, 0u, 0u}; }
#pragma unroll
        for (int j = 0; j < 2; ++j) {
            const int ch = 8 * lane + 512 * j;
            float b8[8], u0[8], u1[8], u2[8], z[8];
            unpack8f(rb[j], b8); unpack8f(r0[j], u0); unpack8f(r1[j], u1); unpack8f(r2[j], u2);
            if (!have1 && s1) { const f32x4 a = *(const f32x4*)(s1 + ch), b = *(const f32x4*)(s1 + ch + 4); u1[0] = a.x; u1[1] = a.y; u1[2] = a.z; u1[3] = a.w; u1[4] = b.x; u1[5] = b.y; u1[6] = b.z; u1[7] = b.w; }
            if (!have2 && s2) { const f32x4 a = *(const f32x4*)(s2 + ch), b = *(const f32x4*)(s2 + ch + 4); u2[0] = a.x; u2[1] = a.y; u2[2] = a.z; u2[3] = a.w; u2[4] = b.x; u2[5] = b.y; u2[6] = b.z; u2[7] = b.w; }
#pragma unroll
            for (int e = 0; e < 8; ++e) z[e] = b8[e] * (cw[ch + e] * u2[e] + cw[D + ch + e] * u1[e] + cw[2 * D + ch + e] * u0[e]);
            *(v4u*)(ZB + (size_t)row * D + ch) = pack8f(z);
        }
    }
}

__device__ __forceinline__ void phase_kvfin(const Ctx& C, CPtrs& P) {
    unsigned char* ws = P.ws; const float* ckv = (const float*)(ws + WS_CKV); const float* ctl = (const float*)(ws + WS_CTL);
    bf16_t* LATB = (bf16_t*)(ws + WS_LATB); bf16_t* KPEB = (bf16_t*)(ws + WS_KPEB); const f32x2* tab = (const f32x2*)(ws + WS_ROPE);
    int lane = C.lane; asm volatile("" : "+v"(lane));
    const int gw = C.vcu * NWAVES + C.wave, NGW = C.G * NWAVES;
    const f32x4 gl = *((const f32x4*)P.in[24] + lane); const float gk = P.in[25][lane];
    for (int row0 = gw; row0 < T; row0 += 2 * NGW) {
        const int nr = row0 + NGW < T ? 2 : 1;
        float sl_[2], sk_[2], xk[2]; f32x4 vl[2]; f32x2 cs[2]; int rowq[2], posq[2];
#pragma unroll
        for (int q = 0; q < 2; ++q) { const int row = row0 + (q < nr ? q * NGW : 0); rowq[q] = row; posq[q] = row < TP ? (row & (SEQ - 1)) : SEQ + ((row - TP) & 3);
            sl_[q] = ctl[F_SSQLAT + row]; sk_[q] = ctl[F_SSQKPE + row]; vl[q] = *((const f32x4*)(ckv + (size_t)row * CKVW) + lane); xk[q] = ckv[(size_t)row * CKVW + KVR + lane]; cs[q] = tab[posq[q] * 32 + (lane & 31)]; }
#pragma unroll
        for (int q = 0; q < 2; ++q) if (q < nr) { const int row = rowq[q];
            const float rl = rsq(sl_[q] * (1.0f / KVR) + EPS), rk = rsq(sk_[q] * (1.0f / ROPE) + EPS);
            const f32x4 v = vl[q] * rl * gl;
            float* ol = row < TP ? P.out + OUT_LATP + (size_t)row * KVR : P.out + OUT_LATS + (size_t)(row - TP) * KVR;
            *((f32x4*)ol + lane) = v;
            u32x2 w; w.x = cvt_pk_bf16(v.x, v.y); w.y = cvt_pk_bf16(v.z, v.w); *((u32x2*)(LATB + (size_t)row * KVR) + lane) = w;
            const float xn = xk[q] * rk * gk, pr = __shfl_xor(xn, 32);
            const float o = lane < 32 ? xn * cs[q].x - pr * cs[q].y : xn * cs[q].x + pr * cs[q].y;
            float* ok = row < TP ? P.out + OUT_KPEP + (size_t)row * ROPE : P.out + OUT_KPES + (size_t)(row - TP) * ROPE;
            ok[lane] = o;
            const float on = __shfl_xor(o, 1);
            if ((lane & 1) == 0) *(unsigned*)(KPEB + (size_t)row * ROPE + lane) = cvt_pk_bf16(o, on); }
    }
}

__device__ __forceinline__ void phase_qkfin(const Ctx& C, CPtrs& P) {
    unsigned char* ws = P.ws; const float* ctl = (const float*)(ws + WS_CTL); bf16_t* QB = (bf16_t*)(ws + WS_QB); bf16_t* KN = (bf16_t*)(ws + WS_KN);
    const float* RPT = (const float*)(ws + WS_RPT); const f32x2* tab = (const f32x2*)(ws + WS_ROPE);
    const float* gqn = P.in[19]; const float* gqp = P.in[20]; const float* gkn = P.in[28];
    int lane = C.lane; asm volatile("" : "+v"(lane));
    const int gw = C.vcu * NWAVES + C.wave, NGW = C.G * NWAVES;
    for (int row = gw; row < TP; row += NGW) {
        const int pos = row & (SEQ - 1);
        const float* sq = ctl + F_SSQQ + row;
        bf16_t* pq[2]; bf16_t* pk[2]; v4u vq[2], vk[2]; float rq[2], rk[2];
#pragma unroll
        for (int it = 0; it < 2; ++it) { const int h = 4 * it + (lane >> 4), c = lane & 15; pq[it] = QB + (size_t)row * NQ + HD * h + 8 * c; vq[it] = *(const v4u*)pq[it]; rq[it] = sq[(size_t)(2 * h) * T];
            const int ci = lane + 64 * it, hk = ci >> 4, ck = ci & 15; pk[it] = KN + (size_t)row * D + 128 * hk + 8 * ck; vk[it] = *(const v4u*)pk[it];
            rk[it] = RPT[(size_t)(2 * hk) * T + row] + RPT[(size_t)(2 * hk + 1) * T + row]; }
        bf16_t* pr = QB + (size_t)row * NQ + HD * (lane >> 3) + 128 + 8 * (lane & 7); const v4u vr = *(const v4u*)pr; const float rr = sq[(size_t)(2 * (lane >> 3) + 1) * T];
#pragma unroll
        for (int it = 0; it < 2; ++it) { const int c = lane & 15; const float rs = rsq(rq[it] * (1.0f / 128) + EPS) * QSCALE; float x[8]; unpack8f(vq[it], x);
#pragma unroll
            for (int e = 0; e < 8; ++e) x[e] = x[e] * rs * gqn[8 * c + e];
            *(v4u*)pq[it] = pack8f(x); }
        { const int c = lane & 7; const float rs = rsq(rr * (1.0f / 64) + EPS); float x[8], y[8]; unpack8f(vr, x);
#pragma unroll
            for (int e = 0; e < 8; ++e) x[e] = x[e] * rs * gqp[8 * c + e];
#pragma unroll
            for (int e = 0; e < 8; ++e) { const float prt = __shfl_xor(x[e], 4); const f32x2 cs = tab[pos * 32 + ((8 * c + e) & 31)];
                y[e] = (c < 4 ? x[e] * cs.x - prt * cs.y : x[e] * cs.x + prt * cs.y) * QSCALE; }
            *(v4u*)pr = pack8f(y); }
#pragma unroll
        for (int jj = 0; jj < 2; ++jj) { const int c = (lane + 64 * jj) & 15; const float rs = rsq(rk[jj] * (1.0f / 128) + EPS); float x[8]; unpack8f(vk[jj], x);
#pragma unroll
            for (int e = 0; e < 8; ++e) x[e] = x[e] * rs * gkn[8 * c + e];
            *(v4u*)pk[jj] = pack8f(x); }
    }
    { float* RTS = (float*)(ws + WS_RTS);
      for (int i = C.vcu * (NWAVES * 64) + C.tid; i < TS * NH; i += C.G * (NWAVES * 64)) { const int rsi = i >> 3, h = i & 7; const size_t rw = (size_t)TP + rsi;
          RTS[i] = rsq((RPT[(size_t)(2 * h) * T + rw] + RPT[(size_t)(2 * h + 1) * T + rw]) * (1.0f / 128) + EPS); } }
    {
        LAS float* A = (LAS float*)(C.lds + RING_OFF + C.wave * 1024);
        const bf16_t* WUK = (const bf16_t*)(ws + WS_WUKV); bf16_t* QS = (bf16_t*)(ws + WS_QS);
        for (int item = gw; item < TS * NH; item += NGW) {
            const int rsi = item >> 3, h = item & 7, row = TP + rsi;
            const float* sq = ctl + F_SSQQ + row;
            { const unsigned w = *(const unsigned*)(QB + (size_t)row * NQ + HD * h + 2 * lane); const float rs = rsq(sq[(size_t)(2 * h) * T] * (1.0f / 128) + EPS);
              A[2 * lane] = bflo(w) * rs * gqn[2 * lane] * gkn[2 * lane]; A[2 * lane + 1] = bfhi(w) * rs * gqn[2 * lane + 1] * gkn[2 * lane + 1]; }
            { const float x = bf2f(QB[(size_t)row * NQ + HD * h + 128 + lane]) * rsq(sq[(size_t)(2 * h + 1) * T] * (1.0f / 64) + EPS) * gqp[lane], pr = __shfl_xor(x, 32);
              const f32x2 cs = tab[(SEQ + (rsi & 3)) * 32 + (lane & 31)];
              const float o = (lane < 32 ? x * cs.x - pr * cs.y : x * cs.x + pr * cs.y) * QSCALE, on = __shfl_xor(o, 1);
              if ((lane & 1) == 0) *(unsigned*)(QS + (size_t)item * 320 + 256 + lane) = cvt_pk_bf16(o, on); }
            LDS_WAIT(); asm volatile("" ::: "memory");
            float acc[4] = {0.f, 0.f, 0.f, 0.f};
#pragma unroll 32
            for (int d = 0; d < 128; ++d) { const u32x2 w = *(const u32x2*)(WUK + (size_t)uk_row(h, d) * KVR + 4 * lane); const float ad = A[d];
                acc[0] += bflo(w.x) * ad; acc[1] += bfhi(w.x) * ad; acc[2] += bflo(w.y) * ad; acc[3] += bfhi(w.y) * ad; }
            u32x2 o; o.x = cvt_pk_bf16(acc[0] * QSCALE, acc[1] * QSCALE); o.y = cvt_pk_bf16(acc[2] * QSCALE, acc[3] * QSCALE);
            *(u32x2*)(QS + (size_t)item * 320 + 4 * lane) = o;
            LDS_WAIT(); asm volatile("" ::: "memory");
        }
    }
}

__device__ __forceinline__ void phase_scomb(const Ctx& C, CPtrs& P) {
    unsigned char* ws = P.ws; const float* PO = (const float*)(ws + WS_PO); const float* PML = (const float*)(ws + WS_PML); bf16_t* OB = (bf16_t*)(ws + WS_OB);
    const float* wuv = P.in[27];
    const int gw = C.vcu * NWAVES + C.wave, NGW = C.G * NWAVES, lane = C.lane;
    LAS float* OL = (LAS float*)(C.lds + RING_OFF + C.wave * 1024);
    for (int item = gw; item < TS * NH; item += NGW) {
        const int rsi = item >> 3, h = item & 7, b = rsi >> 2, q = rsi & 3, rho = q * 8 + h;
        const size_t i0 = (size_t)(b * 2 + 0) * 32 + rho, i1 = (size_t)(b * 2 + 1) * 32 + rho;
        const float m0 = PML[i0 * 2], l0 = PML[i0 * 2 + 1], m1 = PML[i1 * 2], l1 = PML[i1 * 2 + 1];
        const float mm = fmaxf(m0, m1), f0 = __builtin_amdgcn_exp2f(m0 - mm), f1 = __builtin_amdgcn_exp2f(m1 - mm), inv = 1.0f / (l0 * f0 + l1 * f1);
        { const f32x4 a = *((const f32x4*)(PO + i0 * 256) + lane), c = *((const f32x4*)(PO + i1 * 256) + lane); *((LAS f32x4*)OL + lane) = (a * f0 + c * f1) * inv; }
        LDS_WAIT(); asm volatile("" ::: "memory");
        float a0 = 0.f, a1 = 0.f; const float* wp = wuv + 128 * h + 2 * lane;
#pragma unroll 32
        for (int n = 0; n < KVR; ++n) { const f32x2 w = *(const f32x2*)(wp + (size_t)n * D); const float on = OL[n]; a0 += on * w.x; a1 += on * w.y; }
        *(unsigned*)(OB + (size_t)(TP + rsi) * D + 128 * h + 2 * lane) = cvt_pk_bf16(a0, a1);
        LDS_WAIT(); asm volatile("" ::: "memory");
    }
}

namespace att {
typedef short bf16x8 __attribute__((ext_vector_type(8)));
typedef short s16x4 __attribute__((ext_vector_type(4)));
typedef float f32x16 __attribute__((ext_vector_type(16)));
typedef float f32x4 __attribute__((ext_vector_type(4)));
typedef unsigned u32x4 __attribute__((ext_vector_type(4)));
constexpr float THR = 11.5f;
#define SBAR() __builtin_amdgcn_sched_barrier(0)
__device__ __forceinline__ int crow(int r, int hi) { return (r & 3) + 8 * (r >> 2) + 4 * hi; }
__device__ __forceinline__ unsigned cvtpk(float lo, float hi) { unsigned r; asm volatile("v_cvt_pk_bf16_f32 %0, %1, %2" : "=v"(r) : "v"(lo), "v"(hi)); return r; }
__device__ __forceinline__ float xmax32(float v) { auto rr = __builtin_amdgcn_permlane32_swap(__float_as_uint(v), __float_as_uint(v), false, false); return fmaxf(__uint_as_float(rr[0]), __uint_as_float(rr[1])); }
__device__ __forceinline__ float xsum32(float v) { auto rr = __builtin_amdgcn_permlane32_swap(__float_as_uint(v), __float_as_uint(v), false, false); return __uint_as_float(rr[0]) + __uint_as_float(rr[1]); }
#define PK4(P, B_, OUT) do { unsigned a0 = cvtpk(P[B_+0], P[B_+1]), a1 = cvtpk(P[B_+2], P[B_+3]);                          \
        unsigned b0 = cvtpk(P[B_+4], P[B_+5]), b1 = cvtpk(P[B_+6], P[B_+7]);                                             \
        auto r0 = __builtin_amdgcn_permlane32_swap(a0, b0, false, false); auto r1 = __builtin_amdgcn_permlane32_swap(a1, b1, false, false); \
        u32x4 w = {r0[0], r1[0], r0[1], r1[1]}; OUT = *reinterpret_cast<bf16x8*>(&w); } while (0)

namespace pa {
constexpr int KVBLK = 64, QBLK = 32, QB = 256;
constexpr int SHM_V = 16384, SHM_K = 16384, SHM_R = 8192;
constexpr int OFF_V = 0, OFF_K = 2 * SHM_V, OFF_R = OFF_K + 2 * SHM_K, OFF_WS = OFF_R + 2 * SHM_R;
#define KSWZ(row, colB) ((row) * 256 + ((colB) ^ (((row) & 7) << 4)))
__device__ __forceinline__ int v_st(int k, int c) { const int kk = (k & ~0xC) | ((k & 4) << 1) | ((k & 8) >> 1); return ((kk >> 3) * 4 + (c >> 5)) * 512 + ((kk & 7) * 32 + (c & 31)) * 2; }
__device__ __forceinline__ int v_rd_base(int lane) { return ((lane & 3) << 3) | (((lane >> 2) & 3) << 6) | (((lane >> 4) & 1) << 5) | (((lane >> 5) & 1) << 8); }
constexpr int v_rd_off(int d0, int ks, int half) { return d0 * 512 + ks * 4096 + half * 2048; }
__device__ __forceinline__ void mask_tile(f32x16& p0, f32x16& p1, int dq) {
    const float NEG = -__builtin_inff();
#pragma unroll
    for (int r = 0; r < 16; ++r) { const int c = (r & 3) + 8 * (r >> 2); if (dq - c < 0) p0[r] = NEG; if (dq - c - 32 < 0) p1[r] = NEG; }
}
__device__ __forceinline__ void softmax_tile(f32x16& p0, f32x16& p1, float& m_reg, float& l_reg, float& alpha, bf16x8& pa0, bf16x8& pa1, bf16x8& pa2, bf16x8& pa3) {
    float pmax = p0[0];
#pragma unroll
    for (int r = 1; r < 16; ++r) pmax = fmaxf(pmax, p0[r]);
#pragma unroll
    for (int r = 0; r < 16; ++r) pmax = fmaxf(pmax, p1[r]);
    pmax = xmax32(pmax);
    float mn;
    if (__builtin_expect(__all((pmax - m_reg) <= THR), 1)) { mn = m_reg; alpha = 1.f; }
    else { mn = fmaxf(m_reg, pmax); alpha = __builtin_amdgcn_exp2f(m_reg - mn); m_reg = mn; }
#pragma unroll
    for (int r = 0; r < 16; ++r) { p0[r] = __builtin_amdgcn_exp2f(p0[r] - mn); p1[r] = __builtin_amdgcn_exp2f(p1[r] - mn); }
    float ps = 0.f;
#pragma unroll
    for (int r = 0; r < 16; ++r) ps += p0[r];
#pragma unroll
    for (int r = 0; r < 16; ++r) ps += p1[r];
    ps = xsum32(ps);
    l_reg = l_reg * alpha + ps;
    PK4(p0, 0, pa0); PK4(p0, 8, pa1); PK4(p1, 0, pa2); PK4(p1, 8, pa3);
}
template <int KB>
__device__ __forceinline__ void qkt(f32x16& p0, f32x16& p1, const char* lds, int r32, int hi, const bf16x8* qr) {
    p0 = f32x16{}; p1 = f32x16{};
    const char* kb[4];
#pragma unroll
    for (int dd = 0; dd < 4; ++dd) kb[dd] = lds + OFF_K + KB * SHM_K + KSWZ(r32, (dd * 16 + hi * 8) * 2);
#pragma unroll
    for (int d0 = 0; d0 < 8; ++d0) { const char* a = kb[d0 & 3] + (d0 >> 2) * 128;
        const bf16x8 b0 = *reinterpret_cast<const bf16x8*>(a), b1 = *reinterpret_cast<const bf16x8*>(a + 32 * 256);
        p0 = __builtin_amdgcn_mfma_f32_32x32x16_bf16(b0, qr[d0], p0, 0, 0, 0);
        p1 = __builtin_amdgcn_mfma_f32_32x32x16_bf16(b1, qr[d0], p1, 0, 0, 0); }
    const int sw = (r32 >> 1) & 7; const char* rb = lds + OFF_R + KB * SHM_R + r32 * 128;
#pragma unroll
    for (int s = 0; s < 4; ++s) { const char* a = rb + (((2 * s + hi) ^ sw) << 4);
        const bf16x8 b0 = *reinterpret_cast<const bf16x8*>(a), b1 = *reinterpret_cast<const bf16x8*>(a + 32 * 128);
        p0 = __builtin_amdgcn_mfma_f32_32x32x16_bf16(b0, qr[8 + s], p0, 0, 0, 0);
        p1 = __builtin_amdgcn_mfma_f32_32x32x16_bf16(b1, qr[8 + s], p1, 0, 0, 0); }
}
template <int VB>
__device__ __forceinline__ void pv_tile(f32x16* o, int vb0, bf16x8 pa0, bf16x8 pa1, bf16x8 pa2, bf16x8 pa3) {
#define TRRD(dst, off) asm volatile("ds_read_b64_tr_b16 %0, %1 offset:%2" : "=&v"(dst) : "v"(vb0), "i"(off) : "memory")
#define PV_KS(ks, PA) do { s16x4 l0, l1, l2, l3, h0, h1, h2, h3; constexpr int b_ = OFF_V + VB * SHM_V + v_rd_off(0, ks, 0);   \
        TRRD(l0, b_); TRRD(h0, b_ + 2048); TRRD(l1, b_ + 512); TRRD(h1, b_ + 512 + 2048); TRRD(l2, b_ + 1024); TRRD(h2, b_ + 1024 + 2048); TRRD(l3, b_ + 1536); TRRD(h3, b_ + 1536 + 2048); \
        asm volatile("s_waitcnt lgkmcnt(0)" ::: "memory"); SBAR();   \
        o[0] = __builtin_amdgcn_mfma_f32_32x32x16_bf16(PA, (bf16x8){l0[0], l0[1], l0[2], l0[3], h0[0], h0[1], h0[2], h0[3]}, o[0], 0, 0, 0);   \
        o[1] = __builtin_amdgcn_mfma_f32_32x32x16_bf16(PA, (bf16x8){l1[0], l1[1], l1[2], l1[3], h1[0], h1[1], h1[2], h1[3]}, o[1], 0, 0, 0);   \
        o[2] = __builtin_amdgcn_mfma_f32_32x32x16_bf16(PA, (bf16x8){l2[0], l2[1], l2[2], l2[3], h2[0], h2[1], h2[2], h2[3]}, o[2], 0, 0, 0);   \
        o[3] = __builtin_amdgcn_mfma_f32_32x32x16_bf16(PA, (bf16x8){l3[0], l3[1], l3[2], l3[3], h3[0], h3[1], h3[2], h3[3]}, o[3], 0, 0, 0); } while (0)
    PV_KS(0, pa0); PV_KS(1, pa1); PV_KS(2, pa2); PV_KS(3, pa3);
#undef PV_KS
#undef TRRD
}
__device__ __forceinline__ void unit(int b, int h, int qb, const bf16_t* __restrict__ QF, const bf16_t* __restrict__ KN, const bf16_t* __restrict__ KPE, const bf16_t* __restrict__ VBg, bf16_t* OB, char* lds) {
    const int tid = threadIdx.x, wid = __builtin_amdgcn_readfirstlane(tid >> 6), lane = tid & 63, r32 = lane & 31, hi = lane >> 5;
    const size_t rowb = (size_t)b * SEQ; const int q0 = qb * QB, qlo = q0 + wid * QBLK, qm = qlo + r32 - 4 * hi;
    const int NT = (q0 + QB) / KVBLK;
    float* wsf = (float*)(lds + OFF_WS) + wid * 64; float* li_l = wsf; float* al_l = wsf + 32;
    bf16x8 qr[12];
    { const bf16_t* qp = QF + (rowb + qlo + r32) * NQ + HD * h + hi * 8;
#pragma unroll
      for (int d0 = 0; d0 < 12; ++d0) qr[d0] = *reinterpret_cast<const bf16x8*>(qp + d0 * 16); }
    const int sr = tid >> 4, sc = (tid & 15) * 8, rr = tid >> 3, rc = tid & 7;
    const int kws = KSWZ(sr, sc * 2), vst0 = v_st(sr, sc), vst1 = v_st(32 + sr, sc), rws = rr * 128 + ((rc ^ ((rr >> 1) & 7)) << 4);
    const bf16_t* Kg = KN + (rowb + sr) * D + 128 * h + sc; const bf16_t* Vg = VBg + (rowb + sr) * D + 128 * h + sc; const bf16_t* Rg = KPE + (rowb + rr) * ROPE + rc * 8;
    bf16x8 st_k0, st_k1, st_v0, st_v1, st_r;
#define SLOAD(t) do { const size_t ko = (size_t)(t) * KVBLK * D; st_k0 = *reinterpret_cast<const bf16x8*>(Kg + ko); st_k1 = *reinterpret_cast<const bf16x8*>(Kg + ko + 32 * D); \
        st_v0 = *reinterpret_cast<const bf16x8*>(Vg + ko); st_v1 = *reinterpret_cast<const bf16x8*>(Vg + ko + 32 * D); st_r = *reinterpret_cast<const bf16x8*>(Rg + (size_t)(t) * KVBLK * ROPE); } while (0)
#define SWRITE(bf) do { *(bf16x8*)(lds + OFF_K + (bf) * SHM_K + kws) = st_k0; *(bf16x8*)(lds + OFF_K + (bf) * SHM_K + kws + 32 * 256) = st_k1; \
        *(bf16x8*)(lds + OFF_V + (bf) * SHM_V + vst0) = st_v0; *(bf16x8*)(lds + OFF_V + (bf) * SHM_V + vst1) = st_v1; *(bf16x8*)(lds + OFF_R + (bf) * SHM_R + rws) = st_r; } while (0)
    const int vb0 = (int)(uintptr_t)lds + v_rd_base(lane);
    float m_reg = -1e30f, l_reg = 0.f, alpha; f32x16 o[4] = {}; f32x16 p0, p1; bf16x8 pa0, pa1, pa2, pa3;
    SLOAD(0); SWRITE(0); __syncthreads();
#define STEP(t, CB) do { if ((t) + 1 < NT) SLOAD((t) + 1); SBAR();                                                            \
        qkt<CB>(p0, p1, lds, r32, hi, qr);                                                                                    \
        if (KVBLK * (t) + KVBLK - 1 > qlo) mask_tile(p0, p1, qm - KVBLK * (t));                                               \
        softmax_tile(p0, p1, m_reg, l_reg, alpha, pa0, pa1, pa2, pa3);                                                        \
        if (__any(alpha < 1.f)) { if (hi == 0) al_l[r32] = alpha; asm volatile("s_waitcnt lgkmcnt(0)" ::: "memory");         \
            _Pragma("unroll") for (int d_ = 0; d_ < 4; ++d_) _Pragma("unroll") for (int r = 0; r < 16; ++r) o[d_][r] *= al_l[crow(r, hi)]; } \
        SBAR(); pv_tile<CB>(o, vb0, pa0, pa1, pa2, pa3);                                                                      \
        if ((t) + 1 < NT) SWRITE(1 - (CB));                                                                                   \
        __syncthreads(); } while (0)
    for (int t = 0; t < NT; t += 2) { STEP(t, 0); STEP(t + 1, 1); }
#undef STEP
#undef SLOAD
#undef SWRITE
    if (hi == 0) li_l[r32] = l_reg; asm volatile("s_waitcnt lgkmcnt(0)" ::: "memory");
    float rli[16];
#pragma unroll
    for (int r = 0; r < 16; ++r) rli[r] = __builtin_amdgcn_rcpf(li_l[crow(r, hi)]);
    bf16_t* Ow = OB + (rowb + qlo) * D + 128 * h;
#pragma unroll
    for (int r = 0; r < 16; ++r) { const int orow = crow(r, hi);
#pragma unroll
        for (int d0 = 0; d0 < 4; ++d0) { const float v = o[d0][r] * rli[r]; const float vn = __shfl_xor(v, 1);
            if ((r32 & 1) == 0) *(unsigned*)(Ow + (size_t)orow * D + d0 * 32 + r32) = cvtpk(v, vn); } }
    __syncthreads();
}
constexpr int S4_R2 = 131584, S4_WS = S4_R2 + SHM_R;
static_assert(S4_WS + 2048 <= 155648, "lds");
constexpr int R3_V = 0, R3_K = 3 * SHM_V, R3_R = R3_K + 3 * SHM_K, R3_WS = R3_R + 3 * SHM_R;
__device__ __forceinline__ void qkt_rt(f32x16& p0, f32x16& p1, const char* lds, int kofs, int rofs, int r32, int hi, const bf16x8* qr) {
    p0 = f32x16{}; p1 = f32x16{};
    const char* kb[4];
#pragma unroll
    for (int dd = 0; dd < 4; ++dd) kb[dd] = lds + R3_K + kofs + KSWZ(r32, (dd * 16 + hi * 8) * 2);
#pragma unroll
    for (int d0 = 0; d0 < 8; ++d0) { const char* a = kb[d0 & 3] + (d0 >> 2) * 128;
        const bf16x8 b0 = *reinterpret_cast<const bf16x8*>(a), b1 = *reinterpret_cast<const bf16x8*>(a + 32 * 256);
        p0 = __builtin_amdgcn_mfma_f32_32x32x16_bf16(b0, qr[d0], p0, 0, 0, 0);
        p1 = __builtin_amdgcn_mfma_f32_32x32x16_bf16(b1, qr[d0], p1, 0, 0, 0); }
    const int sw = (r32 >> 1) & 7; const char* rb = lds + R3_R + rofs + r32 * 128;
#pragma unroll
    for (int s = 0; s < 4; ++s) { const char* a = rb + (((2 * s + hi) ^ sw) << 4);
        const bf16x8 b0 = *reinterpret_cast<const bf16x8*>(a), b1 = *reinterpret_cast<const bf16x8*>(a + 32 * 128);
        p0 = __builtin_amdgcn_mfma_f32_32x32x16_bf16(b0, qr[8 + s], p0, 0, 0, 0);
        p1 = __builtin_amdgcn_mfma_f32_32x32x16_bf16(b1, qr[8 + s], p1, 0, 0, 0); }
}
__device__ __forceinline__ void pv_rt(f32x16* o, int vb, bf16x8 pa0, bf16x8 pa1, bf16x8 pa2, bf16x8 pa3) {
#define TRRD(dst, off) asm volatile("ds_read_b64_tr_b16 %0, %1 offset:%2" : "=&v"(dst) : "v"(vb), "i"(off) : "memory")
#define PV_KS(ks, PA) do { s16x4 l0, l1, l2, l3, h0, h1, h2, h3; constexpr int b_ = R3_V + v_rd_off(0, ks, 0);   \
        TRRD(l0, b_); TRRD(h0, b_ + 2048); TRRD(l1, b_ + 512); TRRD(h1, b_ + 512 + 2048); TRRD(l2, b_ + 1024); TRRD(h2, b_ + 1024 + 2048); TRRD(l3, b_ + 1536); TRRD(h3, b_ + 1536 + 2048); \
        asm volatile("s_waitcnt lgkmcnt(0)" ::: "memory"); SBAR();   \
        o[0] = __builtin_amdgcn_mfma_f32_32x32x16_bf16(PA, (bf16x8){l0[0], l0[1], l0[2], l0[3], h0[0], h0[1], h0[2], h0[3]}, o[0], 0, 0, 0);   \
        o[1] = __builtin_amdgcn_mfma_f32_32x32x16_bf16(PA, (bf16x8){l1[0], l1[1], l1[2], l1[3], h1[0], h1[1], h1[2], h1[3]}, o[1], 0, 0, 0);   \
        o[2] = __builtin_amdgcn_mfma_f32_32x32x16_bf16(PA, (bf16x8){l2[0], l2[1], l2[2], l2[3], h2[0], h2[1], h2[2], h2[3]}, o[2], 0, 0, 0);   \
        o[3] = __builtin_amdgcn_mfma_f32_32x32x16_bf16(PA, (bf16x8){l3[0], l3[1], l3[2], l3[3], h3[0], h3[1], h3[2], h3[3]}, o[3], 0, 0, 0); } while (0)
    PV_KS(0, pa0); PV_KS(1, pa1); PV_KS(2, pa2); PV_KS(3, pa3);
#undef PV_KS
#undef TRRD
}
#ifndef PA_PF
#define PA_PF 5
#endif
__device__ __forceinline__ void qkt_pf(f32x16& p0, f32x16& p1, const char* lds, int kofs, int rofs, int r32, int hi, const bf16x8* qr) {
    p0 = f32x16{}; p1 = f32x16{};
    const char* kb[4];
#pragma unroll
    for (int dd = 0; dd < 4; ++dd) kb[dd] = lds + R3_K + kofs + KSWZ(r32, (dd * 16 + hi * 8) * 2);
    const int sw = (r32 >> 1) & 7; const char* rb = lds + R3_R + rofs + r32 * 128;
    bf16x8 f0[12], f1[12];
#define QK_LD(d) do { if ((d) < 8) { const char* a = kb[(d) & 3] + ((d) >> 2) * 128; f0[d] = *reinterpret_cast<const bf16x8*>(a); f1[d] = *reinterpret_cast<const bf16x8*>(a + 32 * 256); } \
                      else { const char* a = rb + (((2 * ((d) - 8) + hi) ^ sw) << 4); f0[d] = *reinterpret_cast<const bf16x8*>(a); f1[d] = *reinterpret_cast<const bf16x8*>(a + 32 * 128); } } while (0)
#pragma unroll
    for (int d = 0; d < PA_PF; ++d) QK_LD(d);
#pragma unroll
    for (int d = 0; d < 12; ++d) {
        if (d + PA_PF < 12) QK_LD(d + PA_PF);
        SBAR();
        p0 = __builtin_amdgcn_mfma_f32_32x32x16_bf16(f0[d], qr[d], p0, 0, 0, 0);
        p1 = __builtin_amdgcn_mfma_f32_32x32x16_bf16(f1[d], qr[d], p1, 0, 0, 0);
        SBAR(); }
#undef QK_LD
}
#define TRRD(dst, off) asm volatile("ds_read_b64_tr_b16 %0, %1 offset:%2" : "=&v"(dst) : "v"(vb_), "i"(off) : "memory")
#define PV_RD(ks, S) do { constexpr int b_ = R3_V + v_rd_off(0, ks, 0);   \
        TRRD(S[0], b_); TRRD(S[4], b_ + 2048); TRRD(S[1], b_ + 512); TRRD(S[5], b_ + 512 + 2048); TRRD(S[2], b_ + 1024); TRRD(S[6], b_ + 1024 + 2048); TRRD(S[3], b_ + 1536); TRRD(S[7], b_ + 1536 + 2048); } while (0)
#define PV_MM(PA, S) do { \
        o[0] = __builtin_amdgcn_mfma_f32_32x32x16_bf16(PA, (bf16x8){S[0][0], S[0][1], S[0][2], S[0][3], S[4][0], S[4][1], S[4][2], S[4][3]}, o[0], 0, 0, 0);   \
        o[1] = __builtin_amdgcn_mfma_f32_32x32x16_bf16(PA, (bf16x8){S[1][0], S[1][1], S[1][2], S[1][3], S[5][0], S[5][1], S[5][2], S[5][3]}, o[1], 0, 0, 0);   \
        o[2] = __builtin_amdgcn_mfma_f32_32x32x16_bf16(PA, (bf16x8){S[2][0], S[2][1], S[2][2], S[2][3], S[6][0], S[6][1], S[6][2], S[6][3]}, o[2], 0, 0, 0);   \
        o[3] = __builtin_amdgcn_mfma_f32_32x32x16_bf16(PA, (bf16x8){S[3][0], S[3][1], S[3][2], S[3][3], S[7][0], S[7][1], S[7][2], S[7][3]}, o[3], 0, 0, 0); } while (0)
#define PV_EARLY(VA, VB_) do { PV_RD(0, VA); PV_RD(1, VB_); } while (0)
#define PV_REST(VA, VB_) do {                                                                     \
    asm volatile("s_waitcnt lgkmcnt(8)" ::: "memory"); SBAR(); PV_MM(pa0, VA); SBAR();            \
    PV_RD(2, VA);                                                                                 \
    asm volatile("s_waitcnt lgkmcnt(8)" ::: "memory"); SBAR(); PV_MM(pa1, VB_); SBAR();           \
    PV_RD(3, VB_);                                                                                \
    asm volatile("s_waitcnt lgkmcnt(8)" ::: "memory"); SBAR(); PV_MM(pa2, VA); SBAR();            \
    asm volatile("s_waitcnt lgkmcnt(0)" ::: "memory"); SBAR(); PV_MM(pa3, VB_); } while (0)
#ifndef PA_QK
#define PA_QK qkt_pf
#endif
__device__ __forceinline__ void unit_dma(int b, int h, int qb, const bf16_t* __restrict__ QF, const bf16_t* __restrict__ KN, const bf16_t* __restrict__ KPE, const bf16_t* __restrict__ VBg, bf16_t* OB, char* lds, LAS unsigned char* ldsu) {
    const int tid = threadIdx.x, wid = __builtin_amdgcn_readfirstlane(tid >> 6), lane = tid & 63, r32 = lane & 31, hi = lane >> 5;
    const size_t rowb = (size_t)b * SEQ; const int q0 = qb * QB, qlo = q0 + wid * QBLK, qm = qlo + r32 - 4 * hi;
    const int NT = (q0 + QB) / KVBLK;
    float* wsf = (float*)(lds + R3_WS) + wid * 64; float* li_l = wsf; float* al_l = wsf + 32;
    bf16x8 qr[12];
    { const bf16_t* qp = QF + (rowb + qlo + r32) * NQ + HD * h + hi * 8;
#pragma unroll
      for (int d0 = 0; d0 < 12; ++d0) qr[d0] = *reinterpret_cast<const bf16x8*>(qp + d0 * 16); }
    const char* Kb = (const char*)(KN + rowb * D + 128 * h); const char* Vb = (const char*)(VBg + rowb * D + 128 * h); const char* Rb = (const char*)(KPE + rowb * ROPE);
    unsigned kof[2], vof[2], rof;
#pragma unroll
    for (int pi = 0; pi < 2; ++pi) { const int p = 2 * wid + pi, rw = 4 * pi + (lane >> 4);
        kof[pi] = (unsigned)((4 * p + (lane >> 4)) * (D * 2) + 16 * ((lane & 15) ^ (rw & 7)));
        const int kk = 8 * (p >> 1) + ((lane & 31) >> 2), key = (kk & ~0xC) | ((kk & 4) << 1) | ((kk & 8) >> 1), col = 32 * (2 * (p & 1) + (lane >> 5)) + 8 * (lane & 3);
        vof[pi] = (unsigned)(key * (D * 2) + col * 2); }
    { const int row = 8 * wid + (lane >> 3); rof = (unsigned)(row * (ROPE * 2) + 16 * ((lane & 7) ^ ((row >> 1) & 7))); }
#define DMA_TILE(t, ks_, vs_, rs_) do { const size_t kb_ = (size_t)(t) * KVBLK * (D * 2);                                                                \
        _Pragma("unroll") for (int pi = 0; pi < 2; ++pi) { const int p = 2 * wid + pi;                                                                 \
            __builtin_amdgcn_global_load_lds((const unsigned*)(Kb + kb_ + kof[pi]), (LAS unsigned*)(ldsu + R3_K + (ks_) + p * 1024), 16, 0, 0);        \
            __builtin_amdgcn_global_load_lds((const unsigned*)(Vb + kb_ + vof[pi]), (LAS unsigned*)(ldsu + R3_V + (vs_) + p * 1024), 16, 0, 0); }      \
        __builtin_amdgcn_global_load_lds((const unsigned*)(Rb + (size_t)(t) * KVBLK * (ROPE * 2) + rof), (LAS unsigned*)(ldsu + R3_R + (rs_) + wid * 1024), 16, 0, 0); } while (0)
    const int vb0 = (int)(uintptr_t)lds + v_rd_base(lane);
    float m_reg = -1e30f, l_reg = 0.f, alpha; f32x16 o[4] = {}; f32x16 p0, p1; bf16x8 pa0, pa1, pa2, pa3;
    DMA_TILE(0, 0, 0, 0); DMA_TILE(1, SHM_K, SHM_V, SHM_R);
    asm volatile("s_waitcnt vmcnt(5)" ::: "memory"); __builtin_amdgcn_s_barrier(); asm volatile("" ::: "memory");
    int s_cur = 0, s_nxt = 1, s_nn = 2;
    for (int t = 0; t < NT; ++t) {
        int kofs = s_cur * SHM_K, rofs = s_cur * SHM_R, vofs = s_cur * SHM_V; asm volatile("" : "+v"(kofs), "+v"(rofs), "+v"(vofs));
        if (t + 2 < NT) DMA_TILE(t + 2, s_nn * SHM_K, s_nn * SHM_V, s_nn * SHM_R);
        PA_QK(p0, p1, lds, kofs, rofs, r32, hi, qr);
        s16x4 VA[8], VB_[8]; const int vb_ = vb0 + vofs; SBAR(); PV_EARLY(VA, VB_); SBAR();
        if (KVBLK * t + KVBLK - 1 > qlo) mask_tile(p0, p1, qm - KVBLK * t);
        softmax_tile(p0, p1, m_reg, l_reg, alpha, pa0, pa1, pa2, pa3);
        if (__any(alpha < 1.f)) { if (hi == 0) al_l[r32] = alpha; asm volatile("s_waitcnt lgkmcnt(0)" ::: "memory");
#pragma unroll
            for (int d_ = 0; d_ < 4; ++d_)
#pragma unroll
                for (int r = 0; r < 16; ++r) o[d_][r] *= al_l[crow(r, hi)]; }
        SBAR(); PV_REST(VA, VB_);
        if (t + 2 < NT) asm volatile("s_waitcnt vmcnt(5) lgkmcnt(0)" ::: "memory"); else asm volatile("s_waitcnt vmcnt(0) lgkmcnt(0)" ::: "memory");
        __builtin_amdgcn_s_barrier(); asm volatile("" ::: "memory");
        const int tmp = s_cur; s_cur = s_nxt; s_nxt = s_nn; s_nn = tmp;
    }
#undef DMA_TILE
    if (hi == 0) li_l[r32] = l_reg; asm volatile("s_waitcnt lgkmcnt(0)" ::: "memory");
    float rli[16];
#pragma unroll
    for (int r = 0; r < 16; ++r) rli[r] = __builtin_amdgcn_rcpf(li_l[crow(r, hi)]);
    bf16_t* Ow = OB + (rowb + qlo) * D + 128 * h;
#pragma unroll
    for (int r = 0; r < 16; ++r) { const int orow = crow(r, hi);
#pragma unroll
        for (int d0 = 0; d0 < 4; ++d0) { const float v = o[d0][r] * rli[r]; const float vn = __shfl_xor(v, 1);
            if ((r32 & 1) == 0) *(unsigned*)(Ow + (size_t)orow * D + d0 * 32 + r32) = cvtpk(v, vn); } }
    asm volatile("s_waitcnt vmcnt(0) lgkmcnt(0)" ::: "memory"); __builtin_amdgcn_s_barrier(); asm volatile("" ::: "memory");
}
__device__ __forceinline__ void unit_stg(int b, int h, int qb, const bf16_t* __restrict__ QF, const bf16_t* __restrict__ KN, const bf16_t* __restrict__ KPE, const bf16_t* __restrict__ VBg, bf16_t* OB, char* lds, LAS unsigned char* ldsu) {
    int tid = threadIdx.x; asm volatile("" : "+v"(tid));
    const int wid = __builtin_amdgcn_readfirstlane(tid >> 6), lane = tid & 63, r32 = lane & 31, hi = lane >> 5;
    const size_t rowb = (size_t)b * SEQ; const int q0 = qb * QB, qlo = q0 + wid * QBLK, qm = qlo + r32 - 4 * hi;
    const int NT = (q0 + QB) / KVBLK;
    float* wsf = (float*)(lds + S4_WS) + wid * 64; float* li_l = wsf; float* al_l = wsf + 32;
    bf16x8 qr[12];
    { const bf16_t* qp = QF + (rowb + qlo + r32) * NQ + HD * h + hi * 8;
#pragma unroll
      for (int d0 = 0; d0 < 12; ++d0) qr[d0] = *reinterpret_cast<const bf16x8*>(qp + d0 * 16); }
    const char* Kb = (const char*)(KN + rowb * D + 128 * h); const char* Vb = (const char*)(VBg + rowb * D + 128 * h); const char* Rb = (const char*)(KPE + rowb * ROPE);
    unsigned kof[2], vof[2], rof;
#pragma unroll
    for (int pi = 0; pi < 2; ++pi) { const int p = 2 * wid + pi, rw = 4 * pi + (lane >> 4);
        kof[pi] = (unsigned)((4 * p + (lane >> 4)) * (D * 2) + 16 * ((lane & 15) ^ (rw & 7)));
        const int kk = 8 * (p >> 1) + ((lane & 31) >> 2), key = (kk & ~0xC) | ((kk & 4) << 1) | ((kk & 8) >> 1), col = 32 * (2 * (p & 1) + (lane >> 5)) + 8 * (lane & 3);
        vof[pi] = (unsigned)(key * (D * 2) + col * 2); }
    { const int row = 8 * wid + (lane >> 3); rof = (unsigned)(row * (ROPE * 2) + 16 * ((lane & 7) ^ ((row >> 1) & 7))); }
#define DMA_TILE(t, ks_, vs_, rs_) do { const size_t kb_ = (size_t)(t) * KVBLK * (D * 2);                                                                \
        _Pragma("unroll") for (int pi = 0; pi < 2; ++pi) { const int p = 2 * wid + pi;                                                                 \
            __builtin_amdgcn_global_load_lds((const unsigned*)(Kb + kb_ + kof[pi]), (LAS unsigned*)(ldsu + R3_K + (ks_) + p * 1024), 16, 0, 0);        \
            __builtin_amdgcn_global_load_lds((const unsigned*)(Vb + kb_ + vof[pi]), (LAS unsigned*)(ldsu + R3_V + (vs_) + p * 1024), 16, 0, 0); }      \
        __builtin_amdgcn_global_load_lds((const unsigned*)(Rb + (size_t)(t) * KVBLK * (ROPE * 2) + rof), (LAS unsigned*)(ldsu + R3_R + (rs_) + wid * 1024), 16, 0, 0); } while (0)
    const int vb0 = (int)(uintptr_t)lds + v_rd_base(lane);
    float m_reg = -1e30f, l_reg = 0.f, alpha; f32x16 o[4] = {}; f32x16 p0, p1; bf16x8 pa0, pa1, pa2, pa3;
#define S4_KOFS(sl_) (16384 + (sl_) * SHM_K)
#define S4_ROFS(sl_) ((sl_) == 0 ? 16384 : (sl_) == 1 ? 24576 : (S4_R2 - R3_R))
    const bool grpB = wid >= 4;
    DMA_TILE(0, S4_KOFS(0), 0, S4_ROFS(0)); DMA_TILE(1, S4_KOFS(1), SHM_V, S4_ROFS(1));
    asm volatile("s_waitcnt vmcnt(5)" ::: "memory"); __builtin_amdgcn_s_barrier(); asm volatile("" ::: "memory");
    int s_cur = 0, s_nxt = 1, s_nn = 2;
#define STG_WAIT(t) do { if ((t) + 2 < NT) asm volatile("s_waitcnt vmcnt(5) lgkmcnt(0)" ::: "memory"); else asm volatile("s_waitcnt vmcnt(0) lgkmcnt(0)" ::: "memory");   \
        __builtin_amdgcn_s_barrier(); asm volatile("" ::: "memory"); { const int tmp = s_cur; s_cur = s_nxt; s_nxt = s_nn; s_nn = tmp; } } while (0)
#define STG_RESCALE() do { if (__any(alpha < 1.f)) { if (hi == 0) al_l[r32] = alpha; asm volatile("s_waitcnt lgkmcnt(0)" ::: "memory");                    \
            _Pragma("unroll") for (int d_ = 0; d_ < 4; ++d_) _Pragma("unroll") for (int r = 0; r < 16; ++r) o[d_][r] *= al_l[crow(r, hi)]; } } while (0)
    if (!grpB) {
        for (int t = 0; t < NT; ++t) {
            int kofs = S4_KOFS(s_cur), rofs = S4_ROFS(s_cur), vofs = (t & 3) * SHM_V; asm volatile("" : "+v"(kofs), "+v"(rofs), "+v"(vofs));
            if (t + 2 < NT) DMA_TILE(t + 2, S4_KOFS(s_nn), ((t + 2) & 3) * SHM_V, S4_ROFS(s_nn));
            PA_QK(p0, p1, lds, kofs, rofs, r32, hi, qr);
            s16x4 VA[8], VB_[8]; const int vb_ = vb0 + vofs; SBAR(); PV_EARLY(VA, VB_); SBAR();
            if (KVBLK * t + KVBLK - 1 > qlo) mask_tile(p0, p1, qm - KVBLK * t);
            softmax_tile(p0, p1, m_reg, l_reg, alpha, pa0, pa1, pa2, pa3);
            STG_RESCALE();
            SBAR(); PV_REST(VA, VB_);
            STG_WAIT(t);
        }
    } else {
        for (int t = 0; t < NT; ++t) {
            int kofs = S4_KOFS(s_cur), rofs = S4_ROFS(s_cur), vofs = ((t + 3) & 3) * SHM_V; asm volatile("" : "+v"(kofs), "+v"(rofs), "+v"(vofs));
            if (t + 2 < NT) DMA_TILE(t + 2, S4_KOFS(s_nn), ((t + 2) & 3) * SHM_V, S4_ROFS(s_nn));
            if (t > 0) { s16x4 VA[8], VB_[8]; const int vb_ = vb0 + vofs; SBAR(); PV_EARLY(VA, VB_); SBAR(); PV_REST(VA, VB_); SBAR(); }
            PA_QK(p0, p1, lds, kofs, rofs, r32, hi, qr);
            if (KVBLK * t + KVBLK - 1 > qlo) mask_tile(p0, p1, qm - KVBLK * t);
            softmax_tile(p0, p1, m_reg, l_reg, alpha, pa0, pa1, pa2, pa3);
            STG_RESCALE();
            STG_WAIT(t);
        }
        { const int vofs = ((NT + 3) & 3) * SHM_V; s16x4 VA[8], VB_[8]; const int vb_ = vb0 + vofs; SBAR(); PV_EARLY(VA, VB_); SBAR(); PV_REST(VA, VB_); SBAR(); }
    }
#undef STG_WAIT
#undef STG_RESCALE
#undef S4_KOFS
#undef S4_ROFS
#undef DMA_TILE
    if (hi == 0) li_l[r32] = l_reg; asm volatile("s_waitcnt lgkmcnt(0)" ::: "memory");
    float rli[16];
#pragma unroll
    for (int r = 0; r < 16; ++r) rli[r] = __builtin_amdgcn_rcpf(li_l[crow(r, hi)]);
    bf16_t* Ow = OB + (rowb + qlo) * D + 128 * h;
#pragma unroll
    for (int r = 0; r < 16; ++r) { const int orow = crow(r, hi);
#pragma unroll
        for (int d0 = 0; d0 < 4; ++d0) { const float v = o[d0][r] * rli[r]; const float vn = __shfl_xor(v, 1);
            if ((r32 & 1) == 0) *(unsigned*)(Ow + (size_t)orow * D + d0 * 32 + r32) = cvtpk(v, vn); } }
    asm volatile("s_waitcnt vmcnt(0) lgkmcnt(0)" ::: "memory"); __builtin_amdgcn_s_barrier(); asm volatile("" ::: "memory");
}
}

namespace sa {
constexpr int TILE = 16384;
struct Src { const bf16_t* CLB; const float* CKF; const int* PT; const float* RP; const bf16_t* LATB; const bf16_t* KPEB; const float* RTS; const unsigned char* CL8; const float* SC2; };
#ifndef SA_INT8
#define SA_INT8 1
#endif
__device__ __forceinline__ int offa(int row, int ch) { return 2048 * (row >> 3) + 512 * (ch >> 2) + 64 * (row & 7) + 16 * ((ch & 3) ^ ((row >> 2) & 3)); }
__device__ __forceinline__ v4u widen8(u32x2 w) {
    const unsigned x0 = w.x ^ 0x80808080u, x1 = w.y ^ 0x80808080u; v4u o;
    o.x = cvt_pk_bf16((float)(x0 & 255u), (float)((x0 >> 8) & 255u)); o.y = cvt_pk_bf16((float)((x0 >> 16) & 255u), (float)(x0 >> 24));
    o.z = cvt_pk_bf16((float)(x1 & 255u), (float)((x1 >> 8) & 255u)); o.w = cvt_pk_bf16((float)((x1 >> 16) & 255u), (float)(x1 >> 24)); return o;
}
template <bool TAIL, bool Q8 = false>
__device__ __forceinline__ void tile(const Src& S, int b, int k0, LAS unsigned char* ldsu, char* lds, int wid, int lane, f32x16 (&o)[8], float& m_reg, float& l_reg, float* al_l, int tbase, float& lb, float cb) {
    asm volatile("" : "+v"(lane));
    const int r32 = lane & 31, hi = lane >> 5, h = r32 & 7;
    LAS unsigned char* tl = ldsu + tbase + wid * TILE; const char* tg = lds + tbase + wid * TILE;
    asm volatile("s_waitcnt lgkmcnt(0)" ::: "memory");
    {
        const int rlo = (lane >> 2) & 7, chh = lane >> 5, x4 = (lane >> 4) & 1;
        if constexpr (TAIL) {
            const char* ub = (const char*)(S.LATB + (size_t)(TP + 4 * b) * KVR);
#pragma unroll
            for (int P = 0; P < 16; ++P) { const int img = P >> 3, pp = P & 7, row = 8 * (pp >> 1) + rlo, ch = 8 * (pp & 1) + 4 * chh + ((lane & 3) ^ (2 * ((pp >> 1) & 1) + x4));
                const unsigned lo = (unsigned)((row < 3 ? row : 3) * (KVR * 2) + (128 * img + 8 * ch) * 2);
                __builtin_amdgcn_global_load_lds((const unsigned*)(ub + lo), (LAS unsigned*)(tl + P * 1024), 16, 0, 0); }
        } else if constexpr (Q8) {
            const char* ub = (const char*)S.CL8 + ((size_t)b * SEQ + k0) * KVR + 16 * lane;
#pragma unroll
            for (int P = 0; P < 8; ++P) __builtin_amdgcn_global_load_lds((const unsigned*)(ub + P * 1024), (LAS unsigned*)(tl + 8192 + P * 1024), 16, 0, 0);
        } else {
            const char* ub = (const char*)(S.CLB + ((size_t)b * SEQ + k0) * KVR);
            const unsigned loA = (unsigned)(rlo * 512 + 64 * chh + 16 * ((lane & 3) ^ x4)), loB = (unsigned)(rlo * 512 + 64 * chh + 16 * ((lane & 3) ^ (2 + x4)));
#pragma unroll
            for (int P = 0; P < 16; ++P) { const int img = P >> 3, pp = P & 7; const unsigned cst = (unsigned)((8 * (pp >> 1)) * 512 + 256 * img + 128 * (pp & 1));
                __builtin_amdgcn_global_load_lds((const unsigned*)(ub + cst + (((pp >> 1) & 1) ? loB : loA)), (LAS unsigned*)(tl + P * 1024), 16, 0, 0); }
        }
    }
    bf16x8 kp[4]; float rf[16];
    {
        if constexpr (TAIL) { const bf16_t* kr = S.KPEB + (size_t)(TP + 4 * b + (r32 < 3 ? r32 : 3)) * ROPE;
#pragma unroll
            for (int s = 0; s < 4; ++s) kp[s] = *reinterpret_cast<const bf16x8*>(kr + 16 * s + 8 * hi);
        } else {
            const int phys = S.PT[b * NPG + (k0 >> 7)];
            const float* kr = S.CKF + ((size_t)phys * PAGE + (k0 & (PAGE - 1)) + r32) * ROPE + 8 * hi;
#pragma unroll
            for (int s = 0; s < 4; ++s) { const f32x4 x0 = *(const f32x4*)(kr + 16 * s), x1 = *(const f32x4*)(kr + 16 * s + 4);
                u32x4 w = {cvt_pk_bf16(x0[0], x0[1]), cvt_pk_bf16(x0[2], x0[3]), cvt_pk_bf16(x1[0], x1[1]), cvt_pk_bf16(x1[2], x1[3])}; kp[s] = *reinterpret_cast<bf16x8*>(&w); }
        }
        if constexpr (TAIL) {
#pragma unroll
            for (int r = 0; r < 16; ++r) { const int j = crow(r, hi), jc = j < 3 ? j : 3; rf[r] = S.RTS[(4 * b + jc) * 8 + h]; }
        } else {
            const float* r0 = S.RP + (size_t)(2 * h) * NCK + (size_t)b * SEQ + k0 + 4 * hi;
#pragma unroll
            for (int j = 0; j < 4; ++j) { const f32x4 a = *(const f32x4*)(r0 + 8 * j) + *(const f32x4*)(r0 + NCK + 8 * j);
#pragma unroll
                for (int e = 0; e < 4; ++e) rf[4 * j + e] = a[e]; }
            if constexpr (Q8) {
                const float* s0 = S.SC2 + (size_t)b * SEQ + k0 + 4 * hi;
#pragma unroll
                for (int j = 0; j < 4; ++j) { f32x4 sv = *(const f32x4*)(s0 + 8 * j);
#pragma unroll
                    for (int e = 0; e < 4; ++e) { const float s2 = sv[e]; sv[e] = sqrtf(s2); rf[4 * j + e] = rsq(rf[4 * j + e] * s2 * (1.0f / 128) + EPS) * sv[e]; }
                    if (r32 == 0) *(f32x4*)(al_l + 32 + 8 * j + 4 * hi) = sv; }
            }
        }
    }
    asm volatile("s_waitcnt vmcnt(0)" ::: "memory");
    if constexpr (Q8 && !TAIL) {
        const int c8 = lane & 15, r0 = lane >> 4; const char* st = tg + 8192;
#pragma unroll
        for (int i = 0; i < 8; ++i) { const int row = r0 + 4 * i; *(v4u*)(const_cast<char*>(tg) + offa(row, c8)) = widen8(*(const u32x2*)(st + row * 256 + 8 * c8)); }
        u32x2 wb[8];
#pragma unroll
        for (int i = 0; i < 8; ++i) wb[i] = *(const u32x2*)(st + (r0 + 4 * i) * 256 + 128 + 8 * c8);
        asm volatile("s_waitcnt lgkmcnt(0)" ::: "memory");
#pragma unroll
        for (int i = 0; i < 8; ++i) *(v4u*)(const_cast<char*>(tg) + 8192 + offa(r0 + 4 * i, c8)) = widen8(wb[i]);
        asm volatile("s_waitcnt lgkmcnt(0)" ::: "memory");
    }
    f32x16 p = {}, pn = {};
    {
        const int x = (r32 >> 2) & 3; const char* kbase = tg + 2048 * (r32 >> 3) + 64 * (r32 & 7);
        const char* kE = kbase + 16 * (hi ^ x); const char* kO = kbase + 16 * ((2 + hi) ^ x);
        const char* qb = lds + QS_OFF + r32 * QS_STRIDE + hi * 16;
#pragma unroll
        for (int s = 0; s < 4; ++s) p = __builtin_amdgcn_mfma_f32_32x32x16_bf16(kp[s], *reinterpret_cast<const bf16x8*>(qb + (16 + s) * 32), p, 0, 0, 0);
#pragma unroll
        for (int s = 0; s < 16; ++s) { const int img = s >> 3, ss = s & 7; const char* a = ((ss & 1) ? kO : kE) + 8192 * img + 512 * (ss >> 1);
            pn = __builtin_amdgcn_mfma_f32_32x32x16_bf16(*reinterpret_cast<const bf16x8*>(a), *reinterpret_cast<const bf16x8*>(qb + s * 32), pn, 0, 0, 0); }
    }
#pragma unroll
    for (int r = 0; r < 16; ++r) p[r] = (Q8 && !TAIL) ? (pn[r] - cb) * rf[r] + p[r] : pn[r] * (TAIL ? rf[r] : rsq(rf[r] * (1.0f / 128) + EPS)) + p[r];
    if constexpr (TAIL) { const int q = r32 >> 3;
#pragma unroll
        for (int r = 0; r < 16; ++r) if (crow(r, hi) > q) p[r] = -__builtin_inff(); }
    float pmax = p[0];
#pragma unroll
    for (int r = 1; r < 16; ++r) pmax = fmaxf(pmax, p[r]);
    pmax = xmax32(pmax);
    float mn, alpha;
    if (__builtin_expect(__all((pmax - m_reg) <= THR), 1)) { mn = m_reg; alpha = 1.f; }
    else { mn = fmaxf(m_reg, pmax); alpha = __builtin_amdgcn_exp2f(m_reg - mn); m_reg = mn; }
    float ps = 0.f;
#pragma unroll
    for (int r = 0; r < 16; ++r) { p[r] = __builtin_amdgcn_exp2f(p[r] - mn); ps += p[r]; }
    ps = xsum32(ps); l_reg = l_reg * alpha + ps;
    if constexpr (Q8 && !TAIL) {
#pragma unroll
        for (int j = 0; j < 4; ++j) { const f32x4 sv = *(const f32x4*)(al_l + 32 + 8 * j + 4 * hi);
#pragma unroll
            for (int e = 0; e < 4; ++e) p[4 * j + e] *= sv[e]; }
    }
    bf16x8 pa0, pa1; PK4(p, 0, pa0); PK4(p, 8, pa1);
    if constexpr (Q8) {
        float bs = 0.f;
        if constexpr (!TAIL) { const u32x4 w0 = *reinterpret_cast<const u32x4*>(&pa0), w1 = *reinterpret_cast<const u32x4*>(&pa1);
#pragma unroll
            for (int e = 0; e < 4; ++e) bs += (bflo(w0[e]) + bfhi(w0[e])) + (bflo(w1[e]) + bfhi(w1[e]));
            bs = xsum32(bs); }
        lb = lb * alpha + bs;
    }
    if (__any(alpha < 1.f)) { if (hi == 0) al_l[r32] = alpha; asm volatile("s_waitcnt lgkmcnt(0)" ::: "memory");
#pragma unroll
        for (int c = 0; c < 8; ++c)
#pragma unroll
            for (int r = 0; r < 16; ++r) o[c][r] *= al_l[crow(r, hi)]; }
    {
        const int hh = lane >> 5, blk = (lane >> 4) & 1, q4 = (lane & 15) >> 2, pp = lane & 3;
        const int tb = (int)(uintptr_t)tg + 2048 * hh + 64 * q4 + 8 * (pp & 1);
        const int t0 = tb + 16 * ((2 * blk + (pp >> 1)) ^ (2 * hh)), t1 = tb + 256 + 16 * ((2 * blk + (pp >> 1)) ^ (2 * hh + 1));
#define TR0(dst, off) asm volatile("ds_read_b64_tr_b16 %0, %1 offset:%2" : "=&v"(dst) : "v"(t0), "i"(off) : "memory")
#define TR1(dst, off) asm volatile("ds_read_b64_tr_b16 %0, %1 offset:%2" : "=&v"(dst) : "v"(t1), "i"(off) : "memory")
#define PVC(c) do { s16x4 a0, a1, b0, b1; constexpr int f_ = 8192 * ((c) >> 2) + 512 * ((c) & 3);                               \
        TR0(a0, f_); TR1(a1, f_); TR0(b0, f_ + 4096); TR1(b1, f_ + 4096);                                                        \
        asm volatile("s_waitcnt lgkmcnt(0)" ::: "memory"); SBAR();                                                                \
        o[c] = __builtin_amdgcn_mfma_f32_32x32x16_bf16(pa0, (bf16x8){a0[0], a0[1], a0[2], a0[3], a1[0], a1[1], a1[2], a1[3]}, o[c], 0, 0, 0); \
        o[c] = __builtin_amdgcn_mfma_f32_32x32x16_bf16(pa1, (bf16x8){b0[0], b0[1], b0[2], b0[3], b1[0], b1[1], b1[2], b1[3]}, o[c], 0, 0, 0); } while (0)
        PVC(0); PVC(1); PVC(2); PVC(3); PVC(4); PVC(5); PVC(6); PVC(7);
#undef PVC
#undef TR0
#undef TR1
    }
}
__device__ __forceinline__ void unit(const Src& S, const bf16_t* QS, float* PO, float* PML, int b, int s, LAS unsigned char* ldsu, char* lds) {
    int tid = threadIdx.x; asm volatile("" : "+v"(tid));
    const int wid = __builtin_amdgcn_readfirstlane(tid >> 6), lane = tid & 63, r32 = lane & 31, hi = lane >> 5;
    for (int c = tid; c < 32 * 40; c += 512) { const int rho = c / 40, ch = c % 40; *(v4u*)(lds + QS_OFF + rho * QS_STRIDE + ch * 16) = *(const v4u*)(QS + ((size_t)b * 32 + rho) * 320 + ch * 8); }
    __syncthreads();
    float* al_l = (float*)(lds + SCR_OFF) + wid * 64;
    float m_reg = -1e30f, l_reg = 0.f, lb = 0.f, cb = 0.f; f32x16 o[8] = {};
    if (SA_INT8) { const char* qrow = lds + QS_OFF + r32 * QS_STRIDE;
#pragma unroll 8
        for (int ch = 0; ch < 32; ++ch) { const v4u q = *(const v4u*)(qrow + 16 * ch); cb += (bflo(q.x) + bfhi(q.x)) + (bflo(q.y) + bfhi(q.y)) + (bflo(q.z) + bfhi(q.z)) + (bflo(q.w) + bfhi(q.w)); }
        cb *= 128.0f; }
    const int kbase = (8 * s + wid) * 512;
    for (int i = 0; i < 16; ++i) tile<false, SA_INT8 != 0>(S, b, kbase + 32 * i, ldsu, lds, wid, lane, o, m_reg, l_reg, al_l, 0, lb, cb);
    if (s == 1 && wid == 7) tile<true, SA_INT8 != 0>(S, b, 0, ldsu, lds, wid, lane, o, m_reg, l_reg, al_l, 0, lb, cb);
    asm volatile("s_waitcnt lgkmcnt(0)" ::: "memory");
    if (SA_INT8) {
        if (hi == 0) al_l[r32] = lb; asm volatile("s_waitcnt lgkmcnt(0)" ::: "memory");
#pragma unroll
        for (int r = 0; r < 16; ++r) { const float corr = 128.0f * al_l[crow(r, hi)];
#pragma unroll
            for (int c = 0; c < 8; ++c) o[c][r] -= corr; }
        asm volatile("s_waitcnt lgkmcnt(0)" ::: "memory");
    }
    __syncthreads();
    float* ST = (float*)(lds + 32768);
    float* OL = (float*)lds;
    if (hi == 0) { ST[(wid * 32 + r32) * 2] = m_reg; ST[(wid * 32 + r32) * 2 + 1] = l_reg; }
    __syncthreads();
    float sc[16];
#pragma unroll
    for (int r = 0; r < 16; ++r) { const int row = crow(r, hi); float M = ST[row * 2];
#pragma unroll
        for (int w = 1; w < 8; ++w) M = fmaxf(M, ST[(w * 32 + row) * 2]);
        sc[r] = __builtin_amdgcn_exp2f(ST[(wid * 32 + row) * 2] - M); }
    for (int w = 0; w < 8; ++w) {
        if (wid == w) {
#pragma unroll
            for (int c = 0; c < 8; ++c)
#pragma unroll
                for (int r = 0; r < 16; ++r) { float* d = OL + crow(r, hi) * 256 + 32 * c + r32; const float v = o[c][r] * sc[r]; *d = (w == 0) ? v : *d + v; }
        }
        __syncthreads();
    }
    if (tid < 32) { float M = ST[tid * 2];
        for (int w = 1; w < 8; ++w) M = fmaxf(M, ST[(w * 32 + tid) * 2]);
        float L = 0.f; for (int w = 0; w < 8; ++w) L += ST[(w * 32 + tid) * 2 + 1] * __builtin_amdgcn_exp2f(ST[(w * 32 + tid) * 2] - M);
        PML[((size_t)(b * 2 + s) * 32 + tid) * 2] = M; PML[((size_t)(b * 2 + s) * 32 + tid) * 2 + 1] = L; }
    for (int c = tid; c < 32 * 64; c += 512) *((f32x4*)(PO + (size_t)(b * 2 + s) * 32 * 256) + c) = *((const f32x4*)OL + c);
    __syncthreads();
}
}

__device__ __forceinline__ void grp_barrier(volatile LAS unsigned* cnt, unsigned& epoch, unsigned nw, int lane) {
    asm volatile("s_waitcnt vmcnt(0) lgkmcnt(0)" ::: "memory");
    epoch += nw;
    if (lane == 0) __hip_atomic_fetch_add((LAS unsigned*)cnt, 1u, __ATOMIC_RELAXED, __HIP_MEMORY_SCOPE_WORKGROUP);
    while ((int)(*cnt - epoch) < 0) __builtin_amdgcn_s_sleep(0);
    asm volatile("" ::: "memory");
}
namespace pa4 {
using namespace pa;
constexpr int QB4 = 128, OFF_WS4 = SCR_OFF + 1024;
__device__ __forceinline__ void unit(int b, int h, int qb, const bf16_t* __restrict__ QF, const bf16_t* __restrict__ KN, const bf16_t* __restrict__ KPE, const bf16_t* __restrict__ VBg, bf16_t* OB,
                                     char* lds, LAS unsigned char* ldsu, volatile LAS unsigned* cnt, unsigned& epoch) {
    const int tid = threadIdx.x, wid = __builtin_amdgcn_readfirstlane(tid >> 6), lane = tid & 63, r32 = lane & 31, hi = lane >> 5;
    const size_t rowb = (size_t)b * SEQ; const int q0 = qb * QB4, qlo = q0 + wid * QBLK, qm = qlo + r32 - 4 * hi;
    const int NT = (q0 + QB4) / KVBLK;
    float* wsf = (float*)(lds + OFF_WS4) + wid * 64; float* li_l = wsf; float* al_l = wsf + 32;
    bf16x8 qr[12];
    { const bf16_t* qp = QF + (rowb + qlo + r32) * NQ + HD * h + hi * 8;
#pragma unroll
      for (int d0 = 0; d0 < 12; ++d0) qr[d0] = *reinterpret_cast<const bf16x8*>(qp + d0 * 16); }
    const char* Kb = (const char*)(KN + rowb * D + 128 * h); const char* Vb = (const char*)(VBg + rowb * D + 128 * h); const char* Rb = (const char*)(KPE + rowb * ROPE);
    unsigned kof[2], vof[4], rof[2];
#pragma unroll
    for (int e = 0; e < 2; ++e) { const int rw = 4 * e + (lane >> 4); kof[e] = (unsigned)((lane >> 4) * (D * 2) + 16 * ((lane & 15) ^ (rw & 7))); }
#pragma unroll
    for (int pi = 0; pi < 4; ++pi) { const int p = 4 * wid + pi, kk = 8 * (p >> 1) + ((lane & 31) >> 2), key = (kk & ~0xC) | ((kk & 4) << 1) | ((kk & 8) >> 1), col = 32 * (2 * (p & 1) + (lane >> 5)) + 8 * (lane & 3);
        vof[pi] = (unsigned)(key * (D * 2) + col * 2); }
#pragma unroll
    for (int pi = 0; pi < 2; ++pi) { const int p = 2 * wid + pi, row = 8 * p + (lane >> 3); rof[pi] = (unsigned)(row * (ROPE * 2) + 16 * ((lane & 7) ^ ((row >> 1) & 7))); }
#define DMA_TILE(t, bf) do { const size_t kb_ = (size_t)(t) * KVBLK * (D * 2);                                                                          \
        _Pragma("unroll") for (int pi = 0; pi < 4; ++pi) { const int p = 4 * wid + pi;                                                                 \
            __builtin_amdgcn_global_load_lds((const unsigned*)(Kb + kb_ + (size_t)(4 * p) * (D * 2) + kof[pi & 1]), (LAS unsigned*)(ldsu + OFF_K + (bf) * SHM_K + p * 1024), 16, 0, 0); \
            __builtin_amdgcn_global_load_lds((const unsigned*)(Vb + kb_ + vof[pi]), (LAS unsigned*)(ldsu + OFF_V + (bf) * SHM_V + p * 1024), 16, 0, 0); }  \
        _Pragma("unroll") for (int pi = 0; pi < 2; ++pi) { const int p = 2 * wid + pi;                                                                 \
            __builtin_amdgcn_global_load_lds((const unsigned*)(Rb + (size_t)(t) * KVBLK * (ROPE * 2) + rof[pi]), (LAS unsigned*)(ldsu + OFF_R + (bf) * SHM_R + p * 1024), 16, 0, 0); } } while (0)
    const int vb0 = (int)(uintptr_t)lds + v_rd_base(lane);
    float m_reg = -1e30f, l_reg = 0.f, alpha; f32x16 o[4] = {}; f32x16 p0, p1; bf16x8 pa0, pa1, pa2, pa3;
    DMA_TILE(0, 0); grp_barrier(cnt, epoch, 4u, lane);
#define STEP4(t, CB) do { if ((t) + 1 < NT) DMA_TILE((t) + 1, 1 - (CB));                                                      \
        qkt<CB>(p0, p1, lds, r32, hi, qr);                                                                                    \
        if (KVBLK * (t) + KVBLK - 1 > qlo) mask_tile(p0, p1, qm - KVBLK * (t));                                               \
        softmax_tile(p0, p1, m_reg, l_reg, alpha, pa0, pa1, pa2, pa3);                                                        \
        if (__any(alpha < 1.f)) { if (hi == 0) al_l[r32] = alpha; asm volatile("s_waitcnt lgkmcnt(0)" ::: "memory");         \
            _Pragma("unroll") for (int d_ = 0; d_ < 4; ++d_) _Pragma("unroll") for (int r = 0; r < 16; ++r) o[d_][r] *= al_l[crow(r, hi)]; } \
        pv_tile<CB>(o, vb0, pa0, pa1, pa2, pa3);                                                                      \
        grp_barrier(cnt, epoch, 4u, lane); } while (0)
    for (int t = 0; t < NT; t += 2) { STEP4(t, 0); STEP4(t + 1, 1); }
#undef STEP4
#undef DMA_TILE
    if (hi == 0) li_l[r32] = l_reg; asm volatile("s_waitcnt lgkmcnt(0)" ::: "memory");
    float rli[16];
#pragma unroll
    for (int r = 0; r < 16; ++r) rli[r] = __builtin_amdgcn_rcpf(li_l[crow(r, hi)]);
    bf16_t* Ow = OB + (rowb + qlo) * D + 128 * h;
#pragma unroll
    for (int r = 0; r < 16; ++r) { const int orow = crow(r, hi);
#pragma unroll
        for (int d0 = 0; d0 < 4; ++d0) { const float v = o[d0][r] * rli[r]; const float vn = __shfl_xor(v, 1);
            if ((r32 & 1) == 0) *(unsigned*)(Ow + (size_t)orow * D + d0 * 32 + r32) = cvtpk(v, vn); } }
    asm volatile("s_waitcnt lgkmcnt(0)" ::: "memory");
}
}
namespace sa3 {
using namespace sa;
constexpr int TB = 81920;
__device__ __forceinline__ void unit(const Src& S, const bf16_t* QS, float* PO, float* PML, int b, int s, LAS unsigned char* ldsu, char* lds, volatile LAS unsigned* cnt, unsigned& epoch) {
    const int tid = threadIdx.x - 256, j = __builtin_amdgcn_readfirstlane(tid >> 6), lane = tid & 63, r32 = lane & 31, hi = lane >> 5;
    for (int c = tid; c < 32 * 40; c += 192) { const int rho = c / 40, ch = c % 40; *(v4u*)(lds + QS_OFF + rho * QS_STRIDE + ch * 16) = *(const v4u*)(QS + ((size_t)b * 32 + rho) * 320 + ch * 8); }
    grp_barrier(cnt, epoch, 3u, lane);
    float* al_l = (float*)(lds + SCR_OFF) + j * 64;
    float m_reg = -1e30f, l_reg = 0.f; f32x16 o[8] = {};
    for (int i = j; i < 128; i += 3) { float lb_ = 0.f; tile<false>(S, b, s * 4096 + 32 * i, ldsu, lds, j, lane, o, m_reg, l_reg, al_l, TB, lb_, 0.f); }
    if (s == 1 && j == 2) { float lb_ = 0.f; tile<true>(S, b, 0, ldsu, lds, j, lane, o, m_reg, l_reg, al_l, TB, lb_, 0.f); }
    grp_barrier(cnt, epoch, 3u, lane);
    float* OL = (float*)(lds + TB);
    float* ST = (float*)(lds + TB + 32768);
    if (hi == 0) { ST[(j * 32 + r32) * 2] = m_reg; ST[(j * 32 + r32) * 2 + 1] = l_reg; }
    grp_barrier(cnt, epoch, 3u, lane);
    float sc[16];
#pragma unroll
    for (int r = 0; r < 16; ++r) { const int row = crow(r, hi); const float M = fmaxf(fmaxf(ST[row * 2], ST[(32 + row) * 2]), ST[(64 + row) * 2]);
        sc[r] = __builtin_amdgcn_exp2f(ST[(j * 32 + row) * 2] - M); }
    for (int w = 0; w < 3; ++w) {
        if (j == w) {
#pragma unroll
            for (int c = 0; c < 8; ++c)
#pragma unroll
                for (int r = 0; r < 16; ++r) { float* d = OL + crow(r, hi) * 256 + 32 * c + r32; const float v = o[c][r] * sc[r]; *d = (w == 0) ? v : *d + v; }
        }
        grp_barrier(cnt, epoch, 3u, lane);
    }
    if (tid < 32) { const float M = fmaxf(fmaxf(ST[tid * 2], ST[(32 + tid) * 2]), ST[(64 + tid) * 2]);
        float L = 0.f; for (int w = 0; w < 3; ++w) L += ST[(w * 32 + tid) * 2 + 1] * __builtin_amdgcn_exp2f(ST[(w * 32 + tid) * 2] - M);
        PML[((size_t)(b * 2 + s) * 32 + tid) * 2] = M; PML[((size_t)(b * 2 + s) * 32 + tid) * 2 + 1] = L; }
    for (int c = tid; c < 32 * 64; c += 192) *((f32x4*)(PO + (size_t)(b * 2 + s) * 32 * 256) + c) = *((const f32x4*)OL + c);
    grp_barrier(cnt, epoch, 3u, lane);
}
}
#undef SBAR
#undef PK4
}

#ifndef MK_SPLIT
#define MK_SPLIT 0
#endif
struct RangeOrder {
    int g0, n;
    __device__ __forceinline__ bool next(int i, pg8::Unit& u) const { if (i >= n) return false; const int g = g0 + i; u.pm = g >> 2; u.pn = g & 3; u.ko = 0; return true; }
    __device__ __forceinline__ void a_ready(const pg8::Unit&) const {}
    __device__ __forceinline__ void done(const pg8::Unit&) const {}
};
struct SplitOrder {
    int j, ns;
    __device__ __forceinline__ bool next(int i, pg8::Unit& u) const { if (i > 0 || j >= 8 * ns) return false; const int t = j / ns; u.pm = t >> 2; u.pn = t & 3; u.ko = (j % ns) * 512; return true; }
    __device__ __forceinline__ void a_ready(const pg8::Unit&) const {}
    __device__ __forceinline__ void done(const pg8::Unit&) const {}
};
constexpr int NSLOT = 11, R_UNITS = (NCK / 256) * 4;
constexpr int FILL_REM[NSLOT] = {172, 8, 24, 32, 172, 8, 48, 8, 132, 16, 140};
constexpr int FILL_PER[NSLOT] = {3, 17, 4, 1, 3, 17, 0, 17, 4, 0, 2};
constexpr int fill_start(int s) { int a = 0; for (int j = 0; j < s; ++j) a += (256 - FILL_REM[j]) * FILL_PER[j]; return a; }
static_assert(fill_start(NSLOT) <= R_UNITS, "filler");
#ifndef R_SP2
#define R_SP2 PG8_SP2
#endif
constexpr int NPHASE = 20;
struct Args { Ptrs P; int ph_lo, ph_hi; };
typedef const __attribute__((address_space(4))) Args CArgs;
__global__ void __launch_bounds__(NWAVES * 64, 2) fwd(Args args) {
    extern __shared__ __attribute__((aligned(16))) unsigned char lds[];
    Ctx C0; C0.lds = (LAS unsigned char*)lds; C0.tid = threadIdx.x; C0.lane = C0.tid & 63; C0.wave = __builtin_amdgcn_readfirstlane(C0.tid >> 6);
    C0.G = gridDim.x; { const int bx = blockIdx.x; C0.vcu = (C0.G % 8 == 0) ? (bx % 8) * (C0.G / 8) + bx / 8 : bx; }
    const Ctx& C = C0;
    volatile LAS unsigned* MISC = (volatile LAS unsigned*)(C.lds + MISC_OFF);
    if (C.tid < 32) MISC[C.tid] = 0u;
    __syncthreads();
    XcdBarrier bar; bar.bar = (unsigned*)(args.P.ws + WS_CTL) + CW_BAR; bar.x = 0; bar.st = nullptr;
    if (!MK_SPLIT) bar = xcd_barrier_post((unsigned*)(args.P.ws + WS_CTL) + CW_BAR, MISC + 8);
    const int lo = args.ph_lo, hi = args.ph_hi;
#ifndef PHASE_MASK
#define PHASE_MASK 0xFFFFFFFFu
#endif
#define IN(k) (((PHASE_MASK >> (k)) & 1u) && lo <= (k) && (k) < hi)
#define SEAM(k) do { if ((k) == 13 ? (IN(12) && IN(14)) : (IN(k) && IN((k) + 1))) { TP_A(5); xcd_barrier(bar); TP_B(5); TP_B(40 + PGRP(k)); TP_A(40 + PGRP((k) + 1)); } } while (0)
#define PH_BEGIN Ctx Cp_ = C0; { int t_ = threadIdx.x; asm volatile("" : "+v"(t_)); Cp_.tid = t_; Cp_.lane = t_ & 63; } const Ctx& C = Cp_;   \
        CArgs* ka_ = (CArgs*)__builtin_amdgcn_kernarg_segment_ptr(); asm volatile("" : "+s"(ka_)); CPtrs& P = ka_->P; unsigned char* ws = P.ws; float* ctl = (float*)(ws + WS_CTL); \
        bf16_t* XB = (bf16_t*)(ws + WS_XB); bf16_t* HB = (bf16_t*)(ws + WS_HB); float* X = P.out + OUT_Y; float* ssqx = ctl + F_SSQX; (void)XB; (void)HB; (void)X; (void)ssqx; (void)ctl;
    LAS unsigned char* ring = C.lds + RING_OFF;
    const int bx = (int)blockIdx.x;
#define GEMM(EPI, Aptr, Bptr, M_, N_, K_, Eobj) do { int k_ = (K_); asm volatile("" : "+s"(k_));   \
        pg8::Gemm g{(const bf16_t*)(Aptr), (const bf16_t*)(Bptr), (M_), (N_), k_, k_}; pg8::StaticOrder S; S.init((M_), (N_), C.G, bx); \
        pg8::gemm_phase<EPI, pg8::StaticOrder, PG8_ALIGN, PG8_SP2>(ring, g, S, Eobj); } while (0)

#define GEMM8(EPI, Aptr, Bptr, M_, N_, Eobj) do { int k_ = D / 2; asm volatile("" : "+s"(k_));   \
        pg8::Gemm g{(const bf16_t*)(Aptr), (const bf16_t*)(Bptr), (M_), (N_), k_, k_}; pg8::StaticOrder S; S.init((M_), (N_), C.G, bx); \
        pg8::gemm_phase<EPI, pg8::StaticOrder, PG8_ALIGN, PG8_SP2, true>(ring, g, S, Eobj); } while (0)
#define SA_PTR ((const float*)(ws + WS_SA))
#define TGU_PTR(i) ((const float*)(ws + WS_TGU) + (i) * 2 * FF)
#define W8GU_PTR(i) (ws + WS_W8GU0 + (size_t)(i) * WS_W8GU_STRIDE)
#define STAGE_T2() do { __syncthreads(); for (int i_ = C.tid; i_ < D / 4; i_ += NWAVES * 64) *((LAS f32x4*)(C.lds + QS_OFF) + i_) = *((const f32x4*)(ws + WS_T2) + i_); __syncthreads(); } while (0)
#define FILL(s) do { if (C.G == 256) { RangeOrder S; S.n = bx >= FILL_REM[s] ? FILL_PER[s] : 0; S.g0 = fill_start(s) + (bx - FILL_REM[s]) * FILL_PER[s]; \
        int k_ = KVR / 2; asm volatile("" : "+s"(k_)); pg8::Gemm g{(const bf16_t*)(ws + WS_CL8), (const bf16_t*)(ws + WS_W8), NCK, D, k_, k_}; STAGE_T2(); epi::Kv8 E_{(float*)(ws + WS_RP), (const float*)(ws + WS_SC2), (const LAS float*)(C.lds + QS_OFF), (size_t)NCK}; \
        pg8::gemm_phase<epi::Kv8, RangeOrder, PG8_ALIGN, R_SP2, true>(ring, g, S, E_); } } while (0)

#ifndef TPROBE
#define TPROBE 0
#endif
#ifdef PROBE_PHASE
#define PGRP(k) ((k) == PROBE_PHASE ? 7 : 0)
#else
#define PGRP(k) ((k) == 0 ? 1 : ((k) == 12 || (k) == 13) ? 2 : (k) == 14 ? 3 : ((k) == 4 || (k) == 15) ? 4 : 0)
#endif
    unsigned long long tp0_ = 0, tp1_ = 0, tpacc_ = 0;
#define TP_A(k) do { if (TPROBE == (k)) { __syncthreads(); tp0_ = __builtin_amdgcn_s_memrealtime(); } } while (0)
#define TP_B(k) do { if (TPROBE == (k)) { __syncthreads(); tp1_ = __builtin_amdgcn_s_memrealtime(); tpacc_ += tp1_ - tp0_; } } while (0)
#ifndef DUP_SEL
#define DUP_SEL 0
#endif
    if (IN(0)) { PH_BEGIN phase_cacheconv(C, P, C.vcu, C.G); phase_w8(C, P); phase_w8gu(C, P); phase_prologue(C, P); if (DUP_SEL == 1) { __syncthreads(); phase_prologue(C, P); } } SEAM(0);
    if (IN(1)) { PH_BEGIN epi::Swiglu8 E{HB, ssqx + 0 * T, SA_PTR, TGU_PTR(0)}; TP_A(3); GEMM8(epi::Swiglu8, ws + WS_A8, W8GU_PTR(0), T, 2 * FF, E); TP_B(3); TP_A(4); FILL(0); TP_B(4); } SEAM(1);
    if (IN(2)) { PH_BEGIN epi::Resid E{XB, ssqx + 1 * T, 0.5f}; TP_A(2); GEMM(epi::Resid, HB, ws + WS_WDN0, T, D, FF, E); TP_B(2); TP_A(1); FILL(1); TP_B(1); } SEAM(2);
    if (IN(3)) { PH_BEGIN epi::ConvIn E{(bf16_t*)(ws + WS_BB), (bf16_t*)(ws + WS_UB), ssqx + 1 * T, P.out + OUT_CSP, P.out + OUT_CSS}; GEMM(epi::ConvIn, XB, ws + WS_WCI, T, 3 * D, D, E); FILL(2); } SEAM(3);
    if (IN(4)) { PH_BEGIN TP_A(8); phase_conv(C, P); TP_B(8); } SEAM(4);
    if (IN(5)) { PH_BEGIN epi::Resid E{XB, ssqx + 2 * T, 1.0f};
        if (C.G == 256) {
            GEMM(epi::Resid, ws + WS_ZB, ws + WS_WCO, TP, D, D, E);
            { int k_ = 256; asm volatile("" : "+s"(k_)); pg8::Gemm g{(const bf16_t*)(ws + WS_ZB) + (size_t)TP * D, (const bf16_t*)(ws + WS_WCO), TS, D, k_, D}; SplitOrder S{bx, 4}; epi::Slab E_{(float*)(ws + WS_SLAB)};
              pg8::gemm_phase<epi::Slab, SplitOrder, PG8_ALIGN, PG8_SP2>(ring, g, S, E_); }
        } else { GEMM(epi::Resid, ws + WS_ZB, ws + WS_WCO, T, D, D, E); }
        FILL(3); } SEAM(5);
    if (IN(6)) { PH_BEGIN if (C.G == 256) phase_quant(C, P, (const float*)(ws + WS_SLAB), 4, ssqx + 2 * T); else phase_quant(C, P); xcd_barrier(bar); epi::Swiglu8 E{HB, ssqx + 2 * T, SA_PTR, TGU_PTR(1)}; GEMM8(epi::Swiglu8, ws + WS_A8, W8GU_PTR(1), T, 2 * FF, E); FILL(4); } SEAM(6);
    if (IN(7)) { PH_BEGIN epi::Resid E{XB, ssqx + 3 * T, 0.5f}; GEMM(epi::Resid, HB, ws + WS_WDN1, T, D, FF, E); FILL(5); } SEAM(7);
    if (IN(8)) { PH_BEGIN phase_quant(C, P); xcd_barrier(bar); { epi::Swiglu8 E{HB, ssqx + 3 * T, SA_PTR, TGU_PTR(2)}; GEMM8(epi::Swiglu8, ws + WS_A8, W8GU_PTR(2), T, 2 * FF, E); }
        { epi::Dkv E{ssqx + 3 * T, (float*)(ws + WS_CKV), ctl + F_SSQLAT, ctl + F_SSQKPE}; int k_ = D; asm volatile("" : "+s"(k_)); pg8::Gemm g{(const bf16_t*)XB, (const bf16_t*)(ws + WS_WDKV), T, 512, k_, k_};
          pg8::StaticOrder S; S.init(T, 512, C.G, (bx + 84) % C.G); pg8::gemm_phase<epi::Dkv, pg8::StaticOrder, PG8_ALIGN, PG8_SP2>(ring, g, S, E); } } SEAM(8);
    if (IN(9)) { PH_BEGIN epi::Resid E{XB, ssqx + 4 * T, 0.5f}; GEMM(epi::Resid, HB, ws + WS_WDN2, T, D, FF, E); FILL(7); TP_A(8); phase_kvfin(C, P); TP_B(8); } SEAM(9);
    if (IN(10)) { PH_BEGIN { epi::Dq E{(bf16_t*)(ws + WS_CQB), ssqx + 4 * T, ctl + F_SSQCQ}; GEMM(epi::Dq, XB, ws + WS_WDQ, T, QRANK, D, E); } FILL(8);
                  { epi::Kv E{(bf16_t*)(ws + WS_KN), (bf16_t*)(ws + WS_VB), (float*)(ws + WS_RPT), (size_t)T}; GEMM(epi::Kv, ws + WS_LATB, ws + WS_WUKV, T, 2 * D, KVR, E); } FILL(9); } SEAM(10);
    if (IN(11)) { PH_BEGIN epi::Uq E{(bf16_t*)(ws + WS_QB), ctl + F_SSQCQ, ctl + F_SSQQ}; TP_A(13); GEMM(epi::Uq, ws + WS_CQB, ws + WS_WUQ, T, NQ, QRANK, E); TP_B(13); TP_A(14); FILL(10); TP_B(14); } SEAM(11);
    if (IN(12)) { PH_BEGIN const int r0_ = (C.G == 256) ? fill_start(NSLOT) : 0, base_ = (R_UNITS - r0_) / C.G, ext_ = (R_UNITS - r0_) % C.G;
        RangeOrder S; S.g0 = r0_ + bx * base_ + (bx < ext_ ? bx : ext_); S.n = base_ + (bx < ext_ ? 1 : 0);
        int k_ = KVR / 2; asm volatile("" : "+s"(k_)); pg8::Gemm g{(const bf16_t*)(ws + WS_CL8), (const bf16_t*)(ws + WS_W8), NCK, D, k_, k_}; STAGE_T2(); epi::Kv8 E_{(float*)(ws + WS_RP), (const float*)(ws + WS_SC2), (const LAS float*)(C.lds + QS_OFF), (size_t)NCK};
        pg8::gemm_phase<epi::Kv8, RangeOrder, PG8_ALIGN, R_SP2, true>(ring, g, S, E_);
        phase_qkfin(C, P); }
    SEAM(13);
    if (IN(14)) { PH_BEGIN
        const bf16_t* QF = (const bf16_t*)(ws + WS_QB); const bf16_t* KN = (const bf16_t*)(ws + WS_KN); const bf16_t* KPE = (const bf16_t*)(ws + WS_KPEB);
        const bf16_t* VBp = (const bf16_t*)(ws + WS_VB); bf16_t* OB = (bf16_t*)(ws + WS_OB);
#ifndef ATT_SEL
#define ATT_SEL 3
#endif
        att::sa::Src S{(const bf16_t*)(ws + WS_CLB), P.in[3], (const int*)P.in[5], (const float*)(ws + WS_RP), (const bf16_t*)(ws + WS_LATB), KPE, (const float*)(ws + WS_RTS), ws + WS_CL8, (const float*)(ws + WS_SC2)};
#ifndef ATT_OVERLAP
#define ATT_OVERLAP 0
#endif
        if (ATT_OVERLAP && C.G == 256) {
            volatile LAS unsigned* gcnt = (volatile LAS unsigned*)(C.lds + MISC_OFF) + 16;
            if (C.wave < 4) { unsigned ep = 0u; const int bh = C.vcu >> 4, s = C.vcu & 15;
                att::pa4::unit(bh >> 3, bh & 7, 63 - 2 * s, QF, KN, KPE, VBp, OB, (char*)lds, C.lds, gcnt, ep);
                att::pa4::unit(bh >> 3, bh & 7, 62 - 2 * s, QF, KN, KPE, VBp, OB, (char*)lds, C.lds, gcnt, ep);
                att::pa4::unit(bh >> 3, bh & 7, 2 * s + 1, QF, KN, KPE, VBp, OB, (char*)lds, C.lds, gcnt, ep);
                att::pa4::unit(bh >> 3, bh & 7, 2 * s, QF, KN, KPE, VBp, OB, (char*)lds, C.lds, gcnt, ep);
            } else if (C.wave < 7) { unsigned ep = 0u;
                att::sa3::unit(S, (const bf16_t*)(ws + WS_QS), (float*)(ws + WS_PO), (float*)(ws + WS_PML), C.vcu >> 1, C.vcu & 1, C.lds, (char*)lds, gcnt + 1, ep); }
        } else {
#define RUN_SA() do { for (int v = C.vcu; v < 2 * DB; v += C.G) att::sa::unit(S, (const bf16_t*)(ws + WS_QS), (float*)(ws + WS_PO), (float*)(ws + WS_PML), v >> 1, v & 1, C.lds, (char*)lds); } while (0)
#ifndef PA_UNIT
#define PA_UNIT unit_dma
#endif
#define RUN_PA() do { for (int v = C.vcu; v < 256; v += C.G) { const int bh = v >> 4, s = v & 15; \
            att::pa::PA_UNIT(bh >> 3, bh & 7, s, QF, KN, KPE, VBp, OB, (char*)lds, C.lds); att::pa::PA_UNIT(bh >> 3, bh & 7, 31 - s, QF, KN, KPE, VBp, OB, (char*)lds, C.lds); } } while (0)
        RUN_PA(); RUN_SA();
#undef RUN_SA
#undef RUN_PA
        }
    } SEAM(14);
    if (IN(15)) { PH_BEGIN TP_A(7); phase_scomb(C, P); TP_B(7); } SEAM(15);
    if (IN(16)) { PH_BEGIN epi::Resid E{XB, ssqx + 5 * T, 1.0f};
        if (C.G == 256) {
            GEMM(epi::Resid, ws + WS_OB, ws + WS_WO, TP, D, D, E);
            { int k_ = 256; asm volatile("" : "+s"(k_)); pg8::Gemm g{(const bf16_t*)(ws + WS_OB) + (size_t)TP * D, (const bf16_t*)(ws + WS_WO), TS, D, k_, D}; SplitOrder S{bx, 4}; epi::Slab E_{(float*)(ws + WS_SLAB)};
              pg8::gemm_phase<epi::Slab, SplitOrder, PG8_ALIGN, PG8_SP2>(ring, g, S, E_); }
        } else { GEMM(epi::Resid, ws + WS_OB, ws + WS_WO, T, D, D, E); } } SEAM(16);
    if (IN(17)) { PH_BEGIN if (C.G == 256) phase_quant(C, P, (const float*)(ws + WS_SLAB), 4, ssqx + 5 * T); else phase_quant(C, P); xcd_barrier(bar); epi::Swiglu8 E{HB, ssqx + 5 * T, SA_PTR, TGU_PTR(3)}; GEMM8(epi::Swiglu8, ws + WS_A8, W8GU_PTR(3), T, 2 * FF, E); } SEAM(17);
    if (IN(18)) { PH_BEGIN
        if (C.G == 256) { unsigned* cnt = (unsigned*)(ws + WS_CTL) + CW_SLC;
            { int k_ = 256; asm volatile("" : "+s"(k_)); pg8::Gemm g{(const bf16_t*)HB + (size_t)TP * FF, (const bf16_t*)(ws + WS_WDN3), TS, D, k_, FF}; SplitOrder S{bx, SPLITK}; epi::Slab E_{(float*)(ws + WS_SLAB)};
              pg8::gemm_phase<epi::Slab, SplitOrder, PG8_ALIGN, PG8_SP2>(ring, g, S, E_); }
            if (bx < 8 * SPLITK) { asm volatile("s_waitcnt vmcnt(0)" ::: "memory"); __syncthreads();
                if (threadIdx.x == 0) { __builtin_amdgcn_fence(__ATOMIC_RELEASE, "agent"); asm volatile("s_waitcnt vmcnt(0)" ::: "memory"); (void)xb_add(cnt, 1u); } }
            { epi::ResidY E{XB, X, 0.5f}; GEMM(epi::ResidY, HB, ws + WS_WDN3, TP, D, FF, E); }
            if (bx >= 8 * SPLITK) {
                if (threadIdx.x == 0) { XB_SPIN(xb_ld(cnt) < (unsigned)(8 * SPLITK), bar.bar); __builtin_amdgcn_fence(__ATOMIC_ACQUIRE, "agent"); asm volatile("s_waitcnt vmcnt(0)" ::: "memory"); }
                __syncthreads();
                const float* slab = (const float*)(ws + WS_SLAB);
                for (int i = (bx - 8 * SPLITK) * (NWAVES * 64) + C.tid; i < TS * D / 4; i += (256 - 8 * SPLITK) * (NWAVES * 64)) { f32x4 s = *((const f32x4*)slab + i);
#pragma unroll
                    for (int c = 1; c < SPLITK; ++c) s += *((const f32x4*)(slab + (size_t)c * TS * D) + i);
                    const u32x2 xw = *((const u32x2*)(XB + (size_t)TP * D) + i); *((f32x4*)(X + (size_t)TP * D) + i) = (f32x4){bflo(xw.x), bfhi(xw.x), bflo(xw.y), bfhi(xw.y)} + s * 0.5f; } }
        } else { epi::ResidY E{XB, X, 0.5f}; GEMM(epi::ResidY, HB, ws + WS_WDN3, T, D, FF, E); } }
#ifdef XBAR_PROBE
    for (int i_ = 0; i_ < XBAR_PROBE; ++i_) xcd_barrier(bar);
#endif
#ifndef PROBE_BLOCK
#define PROBE_BLOCK 255
#endif
    if (TPROBE && blockIdx.x == PROBE_BLOCK && C.wave == 0) { const unsigned long long te = __builtin_amdgcn_s_memrealtime(), span = tpacc_ * 32ull;
        while (__builtin_amdgcn_s_memrealtime() - te < span) __builtin_amdgcn_s_sleep(8); }
#undef IN
#undef SEAM
#undef GEMM
}

extern "C" void kernel_launch(void* const* d_in, const int* in_sizes, int n_in, void* d_out, int out_size, void* d_ws, size_t ws_size, hipStream_t stream) {
    static int grid = 0;
    if (grid == 0) {
        if (n_in != 29 || out_size != (int)OUT_TOTAL || ws_size < WS_END) { fprintf(stderr, "kernel_launch: unexpected shapes (n_in %d, out %d, ws %zu); nothing launched\n", n_in, out_size, ws_size); grid = -1; return; }
        int dev = 0, cus = 0, per_cu = 0;
        if (hipGetDevice(&dev) != hipSuccess || hipDeviceGetAttribute(&cus, hipDeviceAttributeMultiprocessorCount, dev) != hipSuccess) { grid = -1; return; }
        if (hipFuncSetAttribute((const void*)fwd, hipFuncAttributeMaxDynamicSharedMemorySize, LDS_BYTES) != hipSuccess) { fprintf(stderr, "kernel_launch: hipFuncSetAttribute failed\n"); grid = -1; return; }
        if (hipOccupancyMaxActiveBlocksPerMultiprocessor(&per_cu, (const void*)fwd, NWAVES * 64, LDS_BYTES) != hipSuccess || per_cu < 1)
            fprintf(stderr, "kernel_launch: note: occupancy query reports %d workgroups per CU\n", per_cu);
        (void)hipGetLastError();
        grid = cus;
    }
    if (grid < 0) return;
    if (hipMemsetAsync((char*)d_ws + WS_CTL, 0, CTL_BYTES, stream) != hipSuccess) { fprintf(stderr, "kernel_launch: memset failed\n"); return; }
    Args a{};
    for (int i = 0; i < 29; ++i) a.P.in[i] = (const float*)d_in[i];
    a.P.out = (float*)d_out; a.P.ws = (unsigned char*)d_ws;
#if MK_SPLIT
    for (int ph = 0; ph < NPHASE; ++ph) { a.ph_lo = ph; a.ph_hi = ph + 1; hipLaunchKernelGGL(fwd, dim3(grid), dim3(NWAVES * 64), LDS_BYTES, stream, a); }
#else
    a.ph_lo = 0; a.ph_hi = NPHASE;
    hipLaunchKernelGGL(fwd, dim3(grid), dim3(NWAVES * 64), LDS_BYTES, stream, a);
#endif
    const hipError_t le = hipPeekAtLastError();
    if (le != hipSuccess) fprintf(stderr, "kernel_launch: launch failed: %s\n", hipGetErrorName(le));
}
```

```cpp
#include <hip/hip_runtime.h>
#include <cstdio>
#include <cstdint>
namespace pg8 {
#define PG8_LAS __attribute__((address_space(3)))
typedef unsigned short bf16_t;
typedef short bf16x8 __attribute__((ext_vector_type(8)));
typedef float f32x4 __attribute__((ext_vector_type(4)));
typedef unsigned u32x4 __attribute__((ext_vector_type(4)));
constexpr int BM = 256, BK = 64, HALF = 128, HTB = HALF * BK * 2  , STAGE_BYTES = 8 * HTB, NXCD = 8, WGM = 8;

__host__ __device__ __forceinline__ int lds_byte(int r, int c) { const int st = (r >> 4) * 2 + (c >> 5), rr = r & 15, cc = c & 31, ob = rr * 64 + cc * 2; return st * 1024 + (ob ^ (((ob >> 9) & 1) << 5)); }
__host__ __device__ __forceinline__ void stage_rc(int b, int& R, int& C) { const int st = b / 1024, sb = b % 1024, swz = sb ^ (((sb >> 9) & 1) << 5); R = (st >> 1) * 16 + swz / 64; C = (st & 1) * 32 + (swz % 64) / 2; }
__host__ __device__ __forceinline__ int perm32(int rho) { const int n = rho >> 4, i = rho & 15; return 8 * (i >> 2) + 4 * n + (i & 3); }

struct Unit { int pm, pn; int ko; };
struct Gemm { const bf16_t* A; const bf16_t* Bt; int M, N, K; int ld; };

struct StaticOrder {
    int nM, nN, nwg, G, c;
    __host__ __device__ void init(int M, int N, int G_, int c_) { nM = M / BM; nN = N / BM; nwg = nM * nN; G = G_; c = c_; }
    __host__ __device__ bool next(int i, Unit& u) const {
        const long L = (long)i * G + c; if (L >= nwg) return false;
        int wgid = (int)L; { const int q = nwg / NXCD, r = nwg % NXCD, xcd = wgid % NXCD, off = wgid / NXCD; wgid = (xcd < r ? xcd * (q + 1) : r * (q + 1) + (xcd - r) * q) + off; }
        const int nig = WGM * nN, gid = wgid / nig, fm = gid * WGM, gsz = (nM - fm) < WGM ? (nM - fm) : WGM;
        u.pm = fm + ((wgid % nig) % gsz); u.pn = (wgid % nig) / gsz; u.ko = 0; return true;
    }
    __device__ __forceinline__ void a_ready(const Unit&) const {}
    __device__ __forceinline__ void done(const Unit&) const {}
};

__device__ __forceinline__ unsigned cvt_pk_bf16(float lo, float hi) { unsigned r; asm volatile("v_cvt_pk_bf16_f32 %0, %1, %2" : "=v"(r) : "v"(lo), "v"(hi)); return r; }
typedef float f32x2 __attribute__((ext_vector_type(2)));
typedef int i32x4 __attribute__((ext_vector_type(4)));
template <bool I8> __device__ __forceinline__ f32x4 mma16(bf16x8 b, bf16x8 a, f32x4 c) {
    if constexpr (I8) return __builtin_bit_cast(f32x4, __builtin_amdgcn_mfma_i32_16x16x64_i8(__builtin_bit_cast(i32x4, b), __builtin_bit_cast(i32x4, a), __builtin_bit_cast(i32x4, c), 0, 0, 0));
    else return __builtin_amdgcn_mfma_f32_16x16x32_bf16(b, a, c, 0, 0, 0);
}
template <class Epi, class Sched, bool ALIGN_EPI = false, bool SP2 = false, bool I8 = false>
__device__ __forceinline__ void gemm_phase(PG8_LAS unsigned char* lds, const Gemm g, const Sched& S, const Epi& E) {
    int tid_ = threadIdx.x; asm volatile("" : "+v"(tid_));
    const int tid = tid_, wid = __builtin_amdgcn_readfirstlane(tid >> 6), lane = tid & 63, wr = wid >> 2, wc = wid & 3, fr = lane & 15, fq = lane >> 4;
    const int K = g.K, nt = K / BK;
    unsigned voffA[2], voffB[2];
#pragma unroll
    for (int i = 0; i < 2; ++i) { int R, C; stage_rc(tid * 16 + i * 8192, R, C); const int Rb = Epi::PERM ? ((R & ~31) + perm32(R & 31)) : R;
        voffA[i] = (unsigned)(R * g.ld + C) * 2u; voffB[i] = (unsigned)(Rb * g.ld + C) * 2u; }
    const size_t kstep = (size_t)(BK * 2);
    const size_t hstep = (size_t)HALF * g.ld * 2;
    const size_t tstep = 2 * hstep;
    const unsigned ldsw = (unsigned)wid * 1024u;
    const int aoff = lds_byte(wr * 64 + fr, fq * 8), boff = lds_byte(wc * 32 + fr, fq * 8);
#define PG8_SA(b, h) (((b) * 2 + (h)) * HTB)
#define PG8_SB(b, h) ((4 + (b) * 2 + (h)) * HTB)
#define PG8_STAGE(bufoff, gbase, voff) do { _Pragma("unroll") for (int _i = 0; _i < 2; ++_i) \
        __builtin_amdgcn_global_load_lds((const unsigned*)((const char*)(gbase) + (voff)[_i]), (PG8_LAS unsigned*)(lds + (bufoff) + ldsw + _i * 8192), 16, 0, 0); } while (0)
#define PG8_LDA(dst, b, h) do { _Pragma("unroll") for (int m = 0; m < 4; ++m) _Pragma("unroll") for (int k = 0; k < 2; ++k) dst[m][k] = *(const PG8_LAS bf16x8*)(lds + PG8_SA(b, h) + aoff + m * 2048 + k * 1024); } while (0)
#define PG8_LDB(dst, b, h) do { _Pragma("unroll") for (int n = 0; n < 2; ++n) _Pragma("unroll") for (int k = 0; k < 2; ++k) dst[n][k] = *(const PG8_LAS bf16x8*)(lds + PG8_SB(b, h) + boff + n * 2048 + k * 1024); } while (0)
#define PG8_MMA(ai, bj, At, Bt) do { __builtin_amdgcn_s_setprio(1); _Pragma("unroll") for (int m = 0; m < 4; ++m) _Pragma("unroll") for (int n = 0; n < 2; ++n) _Pragma("unroll") for (int k = 0; k < 2; ++k) \
        acc[ai][bj][m][n] = mma16<I8>(Bt[n][k], At[m][k], acc[ai][bj][m][n]); __builtin_amdgcn_s_setprio(0); } while (0)
#define PG8_WAIT_V(n) asm volatile("s_waitcnt vmcnt(" #n ")" ::: "memory")
#define PG8_WAIT_L(n) asm volatile("s_waitcnt lgkmcnt(" #n ")" ::: "memory")
#define PG8_BAR __builtin_amdgcn_s_barrier()
#define PG8_SCHED __builtin_amdgcn_sched_barrier(0)
    Unit cur, nxt; int ui = 0;
    if (!S.next(0, cur)) return;
    f32x4 acc[2][2][4][2];
#pragma unroll
    for (int a = 0; a < 2; ++a)
#pragma unroll
        for (int b = 0; b < 2; ++b)
#pragma unroll
            for (int m = 0; m < 4; ++m)
#pragma unroll
                for (int n = 0; n < 2; ++n) acc[a][b][m][n] = (f32x4){0.f, 0.f, 0.f, 0.f};
    bf16x8 At[4][2], B0[2][2], B1[2][2];
    const char* cA = (const char*)g.A + (size_t)cur.pm * tstep + cur.ko; const char* cB = (const char*)g.Bt + (size_t)cur.pn * tstep + cur.ko;
    S.a_ready(cur);
    if constexpr (SP2) {
        PG8_STAGE(PG8_SB(0, 0), cB, voffB); PG8_STAGE(PG8_SB(0, 1), cB + hstep, voffB); PG8_STAGE(PG8_SA(0, 0), cA, voffA); PG8_STAGE(PG8_SA(0, 1), cA + hstep, voffA);
        if (wr == 1) PG8_BAR;
        PG8_WAIT_V(2); PG8_BAR;
        PG8_STAGE(PG8_SB(1, 0), cB + kstep, voffB); PG8_STAGE(PG8_SA(1, 0), cA + kstep, voffA); PG8_STAGE(PG8_SB(1, 1), cB + hstep + kstep, voffB);
        PG8_WAIT_V(6); PG8_BAR;
    } else {
        PG8_STAGE(PG8_SB(0, 0), cB, voffB); PG8_STAGE(PG8_SA(0, 0), cA, voffA); PG8_STAGE(PG8_SB(0, 1), cB + hstep, voffB); PG8_STAGE(PG8_SA(0, 1), cA + hstep, voffA);
        if (wr == 1) PG8_BAR;
        PG8_WAIT_V(4); PG8_BAR;
        PG8_STAGE(PG8_SB(1, 0), cB + kstep, voffB); PG8_STAGE(PG8_SA(1, 0), cA + kstep, voffA); PG8_STAGE(PG8_SB(1, 1), cB + hstep + kstep, voffB);
        PG8_WAIT_V(6); PG8_BAR;
    }
    for (;;) {
        const bool has_next = S.next(ui + 1, nxt);
        const char* nA = has_next ? (const char*)g.A + (size_t)nxt.pm * tstep + nxt.ko : cA; const char* nB = has_next ? (const char*)g.Bt + (size_t)nxt.pn * tstep + nxt.ko : cB;
        for (int t = 0; t < nt; t += 2) {
            const bool last = (t == nt - 2);
            const char* a1 = cA + (size_t)(t + 1) * kstep;
            const char* a2 = last ? nA : cA + (size_t)(t + 2) * kstep; const char* b2 = last ? nB : cB + (size_t)(t + 2) * kstep;
            const char* a3 = a2 + kstep; const char* b3 = b2 + kstep;
            if (last && has_next) S.a_ready(nxt);
            if constexpr (SP2) {
            PG8_LDB(B0, 0, 0); PG8_LDB(B1, 0, 1); PG8_SCHED; PG8_LDA(At, 0, 0); PG8_STAGE(PG8_SA(1, 1), a1 + hstep, voffA);
            PG8_WAIT_V(8); PG8_WAIT_L(0); PG8_BAR; PG8_MMA(0, 0, At, B0); PG8_MMA(0, 1, At, B1); PG8_BAR; PG8_SCHED;
            PG8_LDA(At, 0, 1); PG8_STAGE(PG8_SB(0, 0), b2, voffB); PG8_STAGE(PG8_SB(0, 1), b2 + hstep, voffB); PG8_STAGE(PG8_SA(0, 0), a2, voffA);
            PG8_WAIT_V(8); PG8_WAIT_L(0); PG8_BAR; PG8_MMA(1, 0, At, B0); PG8_MMA(1, 1, At, B1); PG8_BAR; PG8_SCHED;
            PG8_LDB(B0, 1, 0); PG8_LDB(B1, 1, 1); PG8_SCHED; PG8_LDA(At, 1, 0); PG8_STAGE(PG8_SA(0, 1), a2 + hstep, voffA);
            PG8_WAIT_V(8); PG8_WAIT_L(0); PG8_BAR; PG8_MMA(0, 0, At, B0); PG8_MMA(0, 1, At, B1); PG8_BAR; PG8_SCHED;
            PG8_LDA(At, 1, 1); PG8_STAGE(PG8_SB(1, 0), b3, voffB); PG8_STAGE(PG8_SB(1, 1), b3 + hstep, voffB); PG8_STAGE(PG8_SA(1, 0), a3, voffA);
            PG8_WAIT_V(8); PG8_WAIT_L(0); PG8_BAR; PG8_MMA(1, 0, At, B0); PG8_MMA(1, 1, At, B1); PG8_BAR; PG8_SCHED;
            } else {
            PG8_LDB(B0, 0, 0); PG8_SCHED; PG8_LDA(At, 0, 0); PG8_STAGE(PG8_SA(1, 1), a1 + hstep, voffA);
            PG8_WAIT_L(8); PG8_BAR; PG8_WAIT_L(0); PG8_MMA(0, 0, At, B0); PG8_BAR; PG8_SCHED;
            PG8_LDB(B1, 0, 1); PG8_STAGE(PG8_SB(0, 0), b2, voffB);
            PG8_BAR; PG8_WAIT_L(0); PG8_MMA(0, 1, At, B1); PG8_BAR;
            PG8_LDA(At, 0, 1); PG8_STAGE(PG8_SA(0, 0), a2, voffA);
            PG8_BAR; PG8_WAIT_L(0); PG8_MMA(1, 0, At, B0); PG8_BAR; PG8_SCHED;
            PG8_STAGE(PG8_SB(0, 1), b2 + hstep, voffB);
            PG8_WAIT_V(6); PG8_BAR; PG8_MMA(1, 1, At, B1); PG8_BAR;
            PG8_LDB(B0, 1, 0); PG8_SCHED; PG8_LDA(At, 1, 0); PG8_STAGE(PG8_SA(0, 1), a2 + hstep, voffA);
            PG8_WAIT_L(8); PG8_BAR; PG8_WAIT_L(0); PG8_MMA(0, 0, At, B0); PG8_BAR; PG8_SCHED;
            PG8_LDB(B1, 1, 1); PG8_STAGE(PG8_SB(1, 0), b3, voffB);
            PG8_BAR; PG8_WAIT_L(0); PG8_MMA(0, 1, At, B1); PG8_BAR;
            PG8_LDA(At, 1, 1); PG8_STAGE(PG8_SA(1, 0), a3, voffA);
            PG8_BAR; PG8_WAIT_L(0); PG8_MMA(1, 0, At, B0); PG8_BAR; PG8_SCHED;
            PG8_STAGE(PG8_SB(1, 1), b3 + hstep, voffB);
            PG8_WAIT_V(6); PG8_BAR; PG8_MMA(1, 1, At, B1); PG8_BAR;
            }
        }
        if constexpr (ALIGN_EPI) { if (wr == 0) PG8_BAR; }
        if constexpr (!Epi::AFTER_DRAIN) { E(acc, cur, wr, wc, fr, fq); S.done(cur); }
        if (!has_next) break;
#pragma unroll
        for (int a = 0; a < 2; ++a)
#pragma unroll
            for (int b = 0; b < 2; ++b)
#pragma unroll
                for (int m = 0; m < 4; ++m)
#pragma unroll
                    for (int n = 0; n < 2; ++n) acc[a][b][m][n] = (f32x4){0.f, 0.f, 0.f, 0.f};
        cur = nxt; cA = nA; cB = nB; ++ui;
        if constexpr (ALIGN_EPI) { if (wr == 1) PG8_BAR; }
    }
    PG8_WAIT_V(0);
    if constexpr (!ALIGN_EPI) { if (wr == 0) PG8_BAR; }
    PG8_BAR;
    if constexpr (Epi::AFTER_DRAIN) { E.fused(acc, cur, wr, wc, fr, fq, lds, wid, lane); S.done(cur); }
#undef PG8_SA
#undef PG8_SB
#undef PG8_STAGE
#undef PG8_LDA
#undef PG8_LDB
#undef PG8_MMA
#undef PG8_WAIT_V
#undef PG8_WAIT_L
#undef PG8_BAR
#undef PG8_SCHED
}
}
#define PG8_SP2 true
#define PG8_ALIGN true
#define GAS __attribute__((address_space(1)))
#define LAS __attribute__((address_space(3)))
typedef unsigned short bf16;
typedef unsigned v4u __attribute__((ext_vector_type(4)));
typedef float f32x4 __attribute__((ext_vector_type(4)));
typedef short bf16x8 __attribute__((ext_vector_type(8)));
typedef GAS unsigned gu32;
typedef GAS unsigned long long gu64;
#define RLX_AGENT __ATOMIC_RELAXED, __HIP_MEMORY_SCOPE_AGENT
#define LDS_WAIT() asm volatile("s_waitcnt lgkmcnt(0)" ::: "memory")
#define VM_WAIT() asm volatile("s_waitcnt vmcnt(0)" ::: "memory")
__device__ __forceinline__ unsigned long long rt() { return __builtin_amdgcn_s_memrealtime(); }
__device__ __forceinline__ unsigned f2bf(float f) { unsigned u = __builtin_bit_cast(unsigned, f); return (u + 0x7fffu + ((u >> 16) & 1u)) >> 16; }
__device__ __forceinline__ unsigned pk2(float lo, float hi) { return f2bf(lo) | (f2bf(hi) << 16); }
#define XB_TMO      128
#define XB_XCNT(j)  (256  + 64 * (j))
#define XB_XSUB(j)  (1280 + 64 * (j))
#define XB_XGEN(j)  (2304 + 64 * (j))
#define XB_TOP      3328
#define XB_TOPGEN   3392
#define XCD_BAR_WORDS 3456
#define XB_SPIN_CAP (1u << 18)

__device__ __forceinline__ unsigned xb_ld(unsigned* p)              { return __hip_atomic_load(p, __ATOMIC_RELAXED, __HIP_MEMORY_SCOPE_AGENT); }
__device__ __forceinline__ unsigned xb_add(unsigned* p, unsigned v) { return __hip_atomic_fetch_add(p, v, __ATOMIC_RELAXED, __HIP_MEMORY_SCOPE_AGENT); }
__device__ __forceinline__ unsigned xb_xcc_id() { return (unsigned)__builtin_amdgcn_s_getreg((3 << 11) | 20) & 0xFu; }
#define XB_SPIN(cond, bar) do { unsigned _sp = 0; while (cond) { __builtin_amdgcn_s_sleep(1); \
    if ((++_sp & 255u) == 0u) { if (xb_ld(&(bar)[XB_TMO])) break; if (_sp > XB_SPIN_CAP) { atomicAdd(&(bar)[XB_TMO], 1u); break; } } } } while (0)

struct XcdBarrier {
    unsigned* bar; unsigned x;
    volatile LAS unsigned* st;
};

__device__ __forceinline__ XcdBarrier xcd_barrier_post(unsigned* bar, volatile LAS unsigned* st) {
    XcdBarrier b; b.bar = bar; b.x = xb_xcc_id(); b.st = st;
    if (threadIdx.x == 0) (void)xb_add(&bar[XB_XCNT(b.x)], 1u);
    return b;
}
__device__ __forceinline__ void xcd_barrier_complete(unsigned* bar, unsigned x, unsigned& nloc, unsigned& nx) {
    const unsigned G = gridDim.x * gridDim.y * gridDim.z;
    unsigned sum, cnt, mine, sp = 0u;
    for (;;) {
        sum = 0u; cnt = 0u; mine = 0u;
#pragma unroll
        for (unsigned j = 0; j < 16; ++j) { const unsigned c = xb_ld(&bar[XB_XCNT(j)]); sum += c; cnt += (c > 0u) ? 1u : 0u; mine = (j == x) ? c : mine; }
        if (sum == G) break;
        __builtin_amdgcn_s_sleep(1);
        if ((++sp & 255u) == 0u) { if (xb_ld(&bar[XB_TMO])) break; if (sp > XB_SPIN_CAP) { atomicAdd(&bar[XB_TMO], 1u); break; } }
    }
    nloc = mine > 0u ? mine : 1u; nx = cnt > 0u ? cnt : 1u;
}

__device__ __forceinline__ void xcd_barrier(const XcdBarrier& b) {
    asm volatile("s_waitcnt vmcnt(0)" ::: "memory");
    __syncthreads();
    if (threadIdx.x == 0) {
        unsigned* bar = b.bar;
        __builtin_amdgcn_s_waitcnt(0);
        unsigned nloc = b.st[0], nx = b.st[1];
        if (nloc == 0u) { xcd_barrier_complete(bar, b.x, nloc, nx); b.st[0] = nloc; b.st[1] = nx; }
        const unsigned old = xb_add(&bar[XB_XSUB(b.x)], 1u);
        const unsigned gen = old / nloc;
        if (old + 1u == (gen + 1u) * nloc) {
            __builtin_amdgcn_fence(__ATOMIC_RELEASE, "agent");
            asm volatile("s_waitcnt vmcnt(0)" ::: "memory");
            const unsigned og = xb_add(&bar[XB_TOP], 1u);
            const unsigned tg = og / nx;
            if (og + 1u == (tg + 1u) * nx) xb_add(&bar[XB_TOPGEN], 1u);
            else XB_SPIN(xb_ld(&bar[XB_TOPGEN]) == tg, bar);
            __builtin_amdgcn_fence(__ATOMIC_ACQUIRE, "agent");
            xb_add(&bar[XB_XGEN(b.x)], 1u);
            asm volatile("s_waitcnt vmcnt(0)" ::: "memory");
        } else {
            XB_SPIN(xb_ld(&bar[XB_XGEN(b.x)]) == gen, bar);
            __builtin_amdgcn_fence(__ATOMIC_ACQUIRE, "agent");
            asm volatile("s_waitcnt vmcnt(0)" ::: "memory");
        }
    }
    __syncthreads();
}

constexpr int NWAVES = 8;
constexpr int D = 1024, TP = 16384, TS = 512, T = TP + TS, FF = 2816, NH = 8, KVR = 256, ROPE = 64, QRANK = 512, NQ = 1536, HD = 192;
constexpr int SEQ = 8192, DB = 128, DS = 4, PAGE = 128, NPG = 64, CKVW = 320;
constexpr int NCK = DB * SEQ;
constexpr float EPS = 1e-6f;
constexpr float QSCALE = 0.07216878364870322f * 1.4426950408889634f;
constexpr size_t OUT_Y = 0, OUT_CSP = 17301504, OUT_CSS = 17305600, OUT_LATP = 17567744, OUT_KPEP = 21762048, OUT_LATS = 22810624, OUT_KPES = 22941696, OUT_TOTAL = 22974464;
constexpr size_t MiB = 1u << 20;
constexpr size_t WS_CTL = 0, CTL_BYTES = 4 * MiB;
constexpr size_t WS_WGU0 = 4 * MiB, WS_WGU1 = 15 * MiB, WS_WGU2 = 26 * MiB, WS_WGU3 = 38 * MiB;
constexpr size_t WS_WDN0 = 49 * MiB, WS_WDN1 = 55 * MiB, WS_WDN2 = 61 * MiB, WS_WDN3 = 67 * MiB;
constexpr size_t WS_WCI = 73 * MiB, WS_WCO = 79 * MiB, WS_WDQ = 81 * MiB, WS_WUQ = 82 * MiB, WS_WO = 84 * MiB, WS_WUKV = 86 * MiB;
constexpr size_t WS_ROPE = 88 * MiB;
constexpr size_t WS_XB = 92 * MiB, WS_HB = 126 * MiB, WS_BB = 218 * MiB, WS_UB = 252 * MiB, WS_ZB = 286 * MiB, WS_CKV = 320 * MiB;
constexpr size_t WS_LATB = 342 * MiB, WS_KPEB = 352 * MiB, WS_KN = 356 * MiB, WS_VB = 390 * MiB, WS_CQB = 424 * MiB, WS_QB = 442 * MiB;
constexpr size_t WS_OB = 493 * MiB, WS_RPT = 527 * MiB, WS_RTS = 529 * MiB, WS_QS = 530 * MiB, WS_PO = 534 * MiB, WS_PML = 543 * MiB;
constexpr size_t WS_CLB = 544 * MiB, WS_CKB = 1056 * MiB, WS_RP = 1184 * MiB, WS_SLAB = 1248 * MiB;
constexpr size_t WS_CL8 = 1272 * MiB, WS_SC2 = 1528 * MiB, WS_W8 = 1532 * MiB, WS_T2 = 1533 * MiB;
constexpr size_t WS_A8 = 1534 * MiB, WS_SA = 1552 * MiB, WS_W8GU0 = 1553 * MiB, WS_W8GU_STRIDE = 6 * MiB, WS_TGU = 1577 * MiB, WS_WDKV = 1578 * MiB, WS_END = 1580 * MiB;
constexpr int SPLITK = 11;
constexpr int CW_BAR = 4096, CW_SLC = 8192, CW_SC = 8256;
constexpr int F_SSQX = 16384, F_SSQLAT = F_SSQX + 6 * T, F_SSQKPE = F_SSQX + 7 * T, F_SSQCQ = F_SSQX + 8 * T, F_SSQQ = F_SSQX + 9 * T;
static_assert((size_t)(F_SSQQ + 16 * T) * 4 <= CTL_BYTES, "ctl");
constexpr int RING_OFF = 0, RING_BYTES = 131072, MISC_OFF = 131072, QS_OFF = 131584, QS_STRIDE = 656, SCR_OFF = QS_OFF + 32 * QS_STRIDE, LDS_BYTES = 155648;
static_assert(SCR_OFF + 8 * 256 <= LDS_BYTES, "lds");

typedef unsigned short bf16_t;
typedef unsigned u32x2 __attribute__((ext_vector_type(2)));
typedef float f32x2 __attribute__((ext_vector_type(2)));
typedef __bf16 bf16x2_t __attribute__((ext_vector_type(2)));
__device__ __forceinline__ unsigned cvt_pk_bf16(float lo, float hi) { f32x2 v = {lo, hi}; bf16x2_t b = __builtin_convertvector(v, bf16x2_t); return __builtin_bit_cast(unsigned, b); }
__device__ __forceinline__ float bf2f(unsigned short h) { return __builtin_bit_cast(float, (unsigned)h << 16); }
__device__ __forceinline__ float bflo(unsigned w) { return __builtin_bit_cast(float, w << 16); }
__device__ __forceinline__ float bfhi(unsigned w) { return __builtin_bit_cast(float, w & 0xffff0000u); }
__device__ __forceinline__ v4u pack8f(const float* v) { v4u o; o.x = cvt_pk_bf16(v[0], v[1]); o.y = cvt_pk_bf16(v[2], v[3]); o.z = cvt_pk_bf16(v[4], v[5]); o.w = cvt_pk_bf16(v[6], v[7]); return o; }
__device__ __forceinline__ void unpack8f(v4u w, float* v) { v[0] = bflo(w.x); v[1] = bfhi(w.x); v[2] = bflo(w.y); v[3] = bfhi(w.y); v[4] = bflo(w.z); v[5] = bfhi(w.z); v[6] = bflo(w.w); v[7] = bfhi(w.w); }
__device__ __forceinline__ float fq_sum(float s) { s += __shfl_xor(s, 16); s += __shfl_xor(s, 32); return s; }
__device__ __forceinline__ float wave_sum(float v) {
#pragma unroll
    for (int o = 1; o < 64; o <<= 1) v += __shfl_xor(v, o);
    return v;
}
__device__ __forceinline__ float rsq(float x) { return 1.0f / sqrtf(x); }
__device__ __forceinline__ void atomic_addf(float* p, float v) { unsafeAtomicAdd(p, v); }

namespace epi {
using pg8::Unit; using pg8::f32x4; using pg8::BM; using pg8::HALF;
typedef f32x4 Acc[2][2][4][2];

struct Swiglu {
    static constexpr bool PERM = true, AFTER_DRAIN = false;
    bf16_t* HB; const float* ssq; float* ckv; float* ssq_lat; float* ssq_kpe; int ngu;
    __device__ __forceinline__ void operator()(const f32x4 (&acc)[2][2][4][2], const Unit& u, int wr, int wc, int fr, int fq) const {
        float sq8[2][4];
#pragma unroll
        for (int ai = 0; ai < 2; ++ai)
#pragma unroll
            for (int m = 0; m < 4; ++m) sq8[ai][m] = ssq[u.pm * BM + ai * HALF + wr * 64 + m * 16 + fr];
#pragma unroll
        for (int ai = 0; ai < 2; ++ai)
#pragma unroll
            for (int m = 0; m < 4; ++m) {
                const int row = u.pm * BM + ai * HALF + wr * 64 + m * 16 + fr;
                const float rs = rsq(sq8[ai][m] * (1.0f / D) + EPS);
                if (u.pn < ngu) {
                    float h[8];
#pragma unroll
                    for (int n = 0; n < 2; ++n)
#pragma unroll
                        for (int j = 0; j < 4; ++j) { const float g = acc[ai][0][m][n][j] * rs, up = acc[ai][1][m][n][j] * rs;
                            const float sg = g * __builtin_amdgcn_rcpf(1.0f + __builtin_amdgcn_exp2f(-1.4426950408889634f * g)); h[4 * n + j] = sg * up; }
                    *(v4u*)(HB + (size_t)row * FF + 128 * u.pn + 32 * wc + 8 * fq) = pack8f(h);
                } else if (u.pn == ngu) {
                    float ss = 0.f;
#pragma unroll
                    for (int bj = 0; bj < 2; ++bj)
#pragma unroll
                        for (int n = 0; n < 2; ++n) { const f32x4 v = acc[ai][bj][m][n] * rs; ss += (v[0] * v[0] + v[1] * v[1]) + (v[2] * v[2] + v[3] * v[3]);
                            *(f32x4*)(ckv + (size_t)row * CKVW + 128 * bj + 32 * wc + 8 * fq + 4 * n) = v; }
                    ss = fq_sum(ss); if (fq == 0) atomic_addf(ssq_lat + row, ss);
                } else {
                    if (wc < 2) { float ss = 0.f;
#pragma unroll
                        for (int n = 0; n < 2; ++n) { const f32x4 v = acc[ai][0][m][n] * rs; ss += (v[0] * v[0] + v[1] * v[1]) + (v[2] * v[2] + v[3] * v[3]);
                            *(f32x4*)(ckv + (size_t)row * CKVW + 256 + 32 * wc + 8 * fq + 4 * n) = v; }
                        ss = fq_sum(ss); if (fq == 0) atomic_addf(ssq_kpe + row, ss); }
                }
            }
    }
};
struct Swiglu8 {
    static constexpr bool PERM = true, AFTER_DRAIN = false;
    bf16_t* HB; const float* ssq; const float* sa; const float* tsc;
    __device__ __forceinline__ void operator()(const f32x4 (&acc)[2][2][4][2], const Unit& u, int wr, int wc, int fr, int fq) const {
        typedef int i32x4 __attribute__((ext_vector_type(4)));
        int fq_ = fq, fr_ = fr; asm volatile("" : "+v"(fq_), "+v"(fr_));
        float f8[2][4], s8[2][4]; f32x4 tg[2], tu[2];
#pragma unroll
        for (int ai = 0; ai < 2; ++ai)
#pragma unroll
            for (int m = 0; m < 4; ++m) { const int row = u.pm * BM + ai * HALF + wr * 64 + m * 16 + fr_; f8[ai][m] = ssq[row]; s8[ai][m] = sa[row]; }
#pragma unroll
        for (int n = 0; n < 2; ++n) { tg[n] = *(const f32x4*)(tsc + 256 * u.pn + 32 * wc + 8 * fq_ + 4 * n); tu[n] = *(const f32x4*)(tsc + 256 * u.pn + 128 + 32 * wc + 8 * fq_ + 4 * n); }
#pragma unroll
        for (int ai = 0; ai < 2; ++ai)
#pragma unroll
            for (int m = 0; m < 4; ++m) {
                const int row = u.pm * BM + ai * HALF + wr * 64 + m * 16 + fr;
                const float rs = rsq(f8[ai][m] * (1.0f / D) + EPS) * s8[ai][m];
                float h[8];
#pragma unroll
                for (int n = 0; n < 2; ++n) { const i32x4 ig = __builtin_bit_cast(i32x4, acc[ai][0][m][n]), iu = __builtin_bit_cast(i32x4, acc[ai][1][m][n]);
#pragma unroll
                    for (int j = 0; j < 4; ++j) { const float g = (float)ig[j] * (rs * tg[n][j]), up = (float)iu[j] * (rs * tu[n][j]);
                        const float sg = g * __builtin_amdgcn_rcpf(1.0f + __builtin_amdgcn_exp2f(-1.4426950408889634f * g)); h[4 * n + j] = sg * up; } }
                *(v4u*)(HB + (size_t)row * FF + 128 * u.pn + 32 * wc + 8 * fq) = pack8f(h);
            }
    }
};
struct Dkv {
    static constexpr bool PERM = true, AFTER_DRAIN = false;
    const float* ssq; float* ckv; float* ssq_lat; float* ssq_kpe;
    __device__ __forceinline__ void operator()(const f32x4 (&acc)[2][2][4][2], const Unit& u, int wr, int wc, int fr, int fq) const {
        float sq8[2][4];
#pragma unroll
        for (int ai = 0; ai < 2; ++ai)
#pragma unroll
            for (int m = 0; m < 4; ++m) sq8[ai][m] = ssq[u.pm * BM + ai * HALF + wr * 64 + m * 16 + fr];
#pragma unroll
        for (int ai = 0; ai < 2; ++ai)
#pragma unroll
            for (int m = 0; m < 4; ++m) {
                const int row = u.pm * BM + ai * HALF + wr * 64 + m * 16 + fr;
                const float rs = rsq(sq8[ai][m] * (1.0f / D) + EPS);
                if (u.pn == 0) {
                    float ss = 0.f;
#pragma unroll
                    for (int bj = 0; bj < 2; ++bj)
#pragma unroll
                        for (int n = 0; n < 2; ++n) { const f32x4 v = acc[ai][bj][m][n] * rs; ss += (v[0] * v[0] + v[1] * v[1]) + (v[2] * v[2] + v[3] * v[3]);
                            *(f32x4*)(ckv + (size_t)row * CKVW + 128 * bj + 32 * wc + 8 * fq + 4 * n) = v; }
                    ss = fq_sum(ss); if (fq == 0) atomic_addf(ssq_lat + row, ss);
                } else if (wc < 2) { float ss = 0.f;
#pragma unroll
                    for (int n = 0; n < 2; ++n) { const f32x4 v = acc[ai][0][m][n] * rs; ss += (v[0] * v[0] + v[1] * v[1]) + (v[2] * v[2] + v[3] * v[3]);
                        *(f32x4*)(ckv + (size_t)row * CKVW + 256 + 32 * wc + 8 * fq + 4 * n) = v; }
                    ss = fq_sum(ss); if (fq == 0) atomic_addf(ssq_kpe + row, ss); }
            }
    }
};
template <bool FINAL>
struct ResidT {
    static constexpr bool PERM = true, AFTER_DRAIN = false;
    bf16_t* XB; float* P; float alpha;
    __device__ __forceinline__ void operator()(const f32x4 (&acc)[2][2][4][2], const Unit& u, int wr, int wc, int fr, int fq) const {
        v4u xv[2][4][2];
#pragma unroll
        for (int ai = 0; ai < 2; ++ai)
#pragma unroll
            for (int m = 0; m < 4; ++m) { const bf16_t* xp = XB + (size_t)(u.pm * BM + ai * HALF + wr * 64 + m * 16 + fr) * D + 256 * u.pn + 32 * wc + 8 * fq;
#pragma unroll
                for (int bj = 0; bj < 2; ++bj) xv[ai][m][bj] = *(const v4u*)(xp + 128 * bj); }
#pragma unroll
        for (int ai = 0; ai < 2; ++ai)
#pragma unroll
            for (int m = 0; m < 4; ++m) { const int row = u.pm * BM + ai * HALF + wr * 64 + m * 16 + fr;
                const size_t off = (size_t)row * D + 256 * u.pn + 32 * wc + 8 * fq; float ss = 0.f;
#pragma unroll
                for (int bj = 0; bj < 2; ++bj) { const v4u xw = xv[ai][m][bj];
                    const f32x4 v0 = (f32x4){bflo(xw.x), bfhi(xw.x), bflo(xw.y), bfhi(xw.y)} + acc[ai][bj][m][0] * alpha, v1 = (f32x4){bflo(xw.z), bfhi(xw.z), bflo(xw.w), bfhi(xw.w)} + acc[ai][bj][m][1] * alpha;
                    if constexpr (FINAL) { float* yp = P + off + 128 * bj; *(f32x4*)yp = v0; *(f32x4*)(yp + 4) = v1; }
                    else { ss += (v0[0] * v0[0] + v0[1] * v0[1]) + (v0[2] * v0[2] + v0[3] * v0[3]) + (v1[0] * v1[0] + v1[1] * v1[1]) + (v1[2] * v1[2] + v1[3] * v1[3]);
                        v4u w; w.x = cvt_pk_bf16(v0[0], v0[1]); w.y = cvt_pk_bf16(v0[2], v0[3]); w.z = cvt_pk_bf16(v1[0], v1[1]); w.w = cvt_pk_bf16(v1[2], v1[3]); *(v4u*)(XB + off + 128 * bj) = w; } }
                if constexpr (!FINAL) { ss = fq_sum(ss); if (fq == 0) atomic_addf(P + row, ss); } }
    }
};
using Resid = ResidT<false>;
using ResidY = ResidT<true>;
struct ConvIn {
    static constexpr bool PERM = true, AFTER_DRAIN = false;
    bf16_t* BB; bf16_t* UB; const float* ssq; float* csp; float* css;
    __device__ __forceinline__ void operator()(const f32x4 (&acc)[2][2][4][2], const Unit& u, int wr, int wc, int fr, int fq) const {
        float sq8[2][4];
#pragma unroll
        for (int ai = 0; ai < 2; ++ai)
#pragma unroll
            for (int m = 0; m < 4; ++m) sq8[ai][m] = ssq[u.pm * BM + ai * HALF + wr * 64 + m * 16 + fr];
#pragma unroll
        for (int ai = 0; ai < 2; ++ai)
#pragma unroll
            for (int m = 0; m < 4; ++m) {
                const int row = u.pm * BM + ai * HALF + wr * 64 + m * 16 + fr;
                const float rs = rsq(sq8[ai][m] * (1.0f / D) + EPS);
                if (u.pn < 4) {
#pragma unroll
                    for (int bj = 0; bj < 2; ++bj) { const f32x4 v0 = acc[ai][bj][m][0] * rs, v1 = acc[ai][bj][m][1] * rs;
                        v4u w; w.x = cvt_pk_bf16(v0[0], v0[1]); w.y = cvt_pk_bf16(v0[2], v0[3]); w.z = cvt_pk_bf16(v1[0], v1[1]); w.w = cvt_pk_bf16(v1[2], v1[3]);
                        *(v4u*)(BB + (size_t)row * D + 256 * u.pn + 128 * bj + 32 * wc + 8 * fq) = w; }
                } else {
                    const int ch0 = 128 * (u.pn - 4) + 32 * wc + 8 * fq;
                    const f32x4 u0 = (acc[ai][0][m][0] * rs) * (acc[ai][1][m][0] * rs), u1 = (acc[ai][0][m][1] * rs) * (acc[ai][1][m][1] * rs);
                    v4u w; w.x = cvt_pk_bf16(u0[0], u0[1]); w.y = cvt_pk_bf16(u0[2], u0[3]); w.z = cvt_pk_bf16(u1[0], u1[1]); w.w = cvt_pk_bf16(u1[2], u1[3]);
                    *(v4u*)(UB + (size_t)row * D + ch0) = w;
                    float* dst = nullptr;
                    if (row < TP) { const int t = row & (SEQ - 1); if (t >= SEQ - 2) dst = csp + (size_t)((row >> 13) * 2 + (t - (SEQ - 2))) * D + ch0; }
                    else { const int rs_ = row - TP, i = rs_ & 3; if (i >= 2) dst = css + (size_t)((rs_ >> 2) * 2 + (i - 2)) * D + ch0; }
                    if (dst) { *(f32x4*)dst = u0; *(f32x4*)(dst + 4) = u1; }
                }
            }
    }
};
struct Dq {
    static constexpr bool PERM = true, AFTER_DRAIN = false;
    bf16_t* CQB; const float* ssq; float* ssq_out;
    __device__ __forceinline__ void operator()(const f32x4 (&acc)[2][2][4][2], const Unit& u, int wr, int wc, int fr, int fq) const {
        float sq8[2][4];
#pragma unroll
        for (int ai = 0; ai < 2; ++ai)
#pragma unroll
            for (int m = 0; m < 4; ++m) sq8[ai][m] = ssq[u.pm * BM + ai * HALF + wr * 64 + m * 16 + fr];
#pragma unroll
        for (int ai = 0; ai < 2; ++ai)
#pragma unroll
            for (int m = 0; m < 4; ++m) {
                const int row = u.pm * BM + ai * HALF + wr * 64 + m * 16 + fr;
                const float rs = rsq(sq8[ai][m] * (1.0f / D) + EPS);
                float ss = 0.f;
#pragma unroll
                for (int bj = 0; bj < 2; ++bj) { const f32x4 v0 = acc[ai][bj][m][0] * rs, v1 = acc[ai][bj][m][1] * rs;
                    ss += (v0[0] * v0[0] + v0[1] * v0[1]) + (v0[2] * v0[2] + v0[3] * v0[3]) + (v1[0] * v1[0] + v1[1] * v1[1]) + (v1[2] * v1[2] + v1[3] * v1[3]);
                    v4u w; w.x = cvt_pk_bf16(v0[0], v0[1]); w.y = cvt_pk_bf16(v0[2], v0[3]); w.z = cvt_pk_bf16(v1[0], v1[1]); w.w = cvt_pk_bf16(v1[2], v1[3]);
                    *(v4u*)(CQB + (size_t)row * QRANK + 256 * u.pn + 128 * bj + 32 * wc + 8 * fq) = w; }
                ss = fq_sum(ss); if (fq == 0) atomic_addf(ssq_out + row, ss);
            }
    }
};
struct Uq {
    static constexpr bool PERM = true, AFTER_DRAIN = false;
    bf16_t* QB; const float* ssq; float* ssq_q;
    __device__ __forceinline__ void operator()(const f32x4 (&acc)[2][2][4][2], const Unit& u, int wr, int wc, int fr, int fq) const {
        float sq8[2][4];
#pragma unroll
        for (int ai = 0; ai < 2; ++ai)
#pragma unroll
            for (int m = 0; m < 4; ++m) sq8[ai][m] = ssq[u.pm * BM + ai * HALF + wr * 64 + m * 16 + fr];
#pragma unroll
        for (int ai = 0; ai < 2; ++ai)
#pragma unroll
            for (int m = 0; m < 4; ++m) {
                const int row = u.pm * BM + ai * HALF + wr * 64 + m * 16 + fr;
                const float rs = rsq(sq8[ai][m] * (1.0f / QRANK) + EPS);
#pragma unroll
                for (int bj = 0; bj < 2; ++bj) { const f32x4 v0 = acc[ai][bj][m][0] * rs, v1 = acc[ai][bj][m][1] * rs;
                    float ss = (v0[0] * v0[0] + v0[1] * v0[1]) + (v0[2] * v0[2] + v0[3] * v0[3]) + (v1[0] * v1[0] + v1[1] * v1[1]) + (v1[2] * v1[2] + v1[3] * v1[3]);
                    const int cb = 256 * u.pn + 128 * bj + 32 * wc;
                    const int hh = cb / HD, seg = 2 * hh + ((cb - hh * HD) >= 128 ? 1 : 0);
                    v4u w; w.x = cvt_pk_bf16(v0[0], v0[1]); w.y = cvt_pk_bf16(v0[2], v0[3]); w.z = cvt_pk_bf16(v1[0], v1[1]); w.w = cvt_pk_bf16(v1[2], v1[3]);
                    *(v4u*)(QB + (size_t)row * NQ + cb + 8 * fq) = w;
                    ss = fq_sum(ss); if (fq == 0) atomic_addf(ssq_q + (size_t)seg * T + row, ss); }
            }
    }
};
struct Kv {
    static constexpr bool PERM = true, AFTER_DRAIN = false;
    bf16_t* KU; bf16_t* VB; float* RP; size_t nrows;
    __device__ __forceinline__ void operator()(const f32x4 (&acc)[2][2][4][2], const Unit& u, int wr, int wc, int fr, int fq) const {
#pragma unroll
        for (int ai = 0; ai < 2; ++ai)
#pragma unroll
            for (int m = 0; m < 4; ++m) {
                const unsigned row = (unsigned)(u.pm * BM + ai * HALF + wr * 64 + m * 16 + fr);
                if (u.pn < 4) {
                    const int head = 2 * u.pn + (wc >> 1);
                    float ss = 0.f;
#pragma unroll
                    for (int bj = 0; bj < 2; ++bj) { const f32x4 v0 = acc[ai][bj][m][0], v1 = acc[ai][bj][m][1];
                        ss += (v0[0] * v0[0] + v0[1] * v0[1]) + (v0[2] * v0[2] + v0[3] * v0[3]) + (v1[0] * v1[0] + v1[1] * v1[1]) + (v1[2] * v1[2] + v1[3] * v1[3]);
                        if (KU) { v4u w; w.x = cvt_pk_bf16(v0[0], v0[1]); w.y = cvt_pk_bf16(v0[2], v0[3]); w.z = cvt_pk_bf16(v1[0], v1[1]); w.w = cvt_pk_bf16(v1[2], v1[3]);
                            *(v4u*)(KU + (size_t)(row * D + 128 * head + 64 * (wc & 1) + 32 * bj + 8 * fq)) = w; } }
                    ss = fq_sum(ss); if (fq == 0) RP[(size_t)((unsigned)(2 * head + (wc & 1)) * (unsigned)nrows + row)] = ss;
                } else if (VB) {
#pragma unroll
                    for (int bj = 0; bj < 2; ++bj) { const f32x4 v0 = acc[ai][bj][m][0], v1 = acc[ai][bj][m][1];
                        v4u w; w.x = cvt_pk_bf16(v0[0], v0[1]); w.y = cvt_pk_bf16(v0[2], v0[3]); w.z = cvt_pk_bf16(v1[0], v1[1]); w.w = cvt_pk_bf16(v1[2], v1[3]);
                        *(v4u*)(VB + (size_t)(row * D + 256 * (u.pn - 4) + 128 * bj + 32 * wc + 8 * fq)) = w; }
                }
            }
    }
};
struct Kv8 {
    static constexpr bool PERM = true, AFTER_DRAIN = false;
    float* RP; const float* sc2; const LAS float* t2; size_t nrows;
    __device__ __forceinline__ void operator()(const f32x4 (&acc)[2][2][4][2], const Unit& u, int wr, int wc, int fr, int fq) const {
        typedef int i32x4 __attribute__((ext_vector_type(4)));
        const int head = 2 * u.pn + (wc >> 1);
        int fq_ = fq; asm volatile("" : "+v"(fq_));
        float ss[2][4];
#pragma unroll
        for (int ai = 0; ai < 2; ++ai)
#pragma unroll
            for (int m = 0; m < 4; ++m) ss[ai][m] = 0.f;
#pragma unroll
        for (int bj = 0; bj < 2; ++bj)
#pragma unroll
            for (int n = 0; n < 2; ++n) { const f32x4 tv = *(const LAS f32x4*)(t2 + 256 * u.pn + 128 * bj + 32 * wc + 8 * fq_ + 4 * n);
#pragma unroll
                for (int ai = 0; ai < 2; ++ai)
#pragma unroll
                    for (int m = 0; m < 4; ++m) { const i32x4 vi = __builtin_bit_cast(i32x4, acc[ai][bj][m][n]);
#pragma unroll
                        for (int j = 0; j < 4; ++j) { const float f = (float)vi[j]; ss[ai][m] += f * f * tv[j]; } } }
#pragma unroll
        for (int ai = 0; ai < 2; ++ai)
#pragma unroll
            for (int m = 0; m < 4; ++m) {
                const unsigned row = (unsigned)(u.pm * BM + ai * HALF + wr * 64 + m * 16 + fr);
                const float s_ = fq_sum(ss[ai][m]); if (fq == 0) RP[(size_t)((unsigned)(2 * head + (wc & 1)) * (unsigned)nrows + row)] = s_;
            }
    }
};
struct Slab {
    static constexpr bool PERM = true, AFTER_DRAIN = false;
    float* slab;
    __device__ __forceinline__ void operator()(const f32x4 (&acc)[2][2][4][2], const Unit& u, int wr, int wc, int fr, int fq) const {
        float* base = slab + (size_t)(u.ko >> 9) * TS * D;
#pragma unroll
        for (int ai = 0; ai < 2; ++ai)
#pragma unroll
            for (int m = 0; m < 4; ++m) { float* p = base + (size_t)(u.pm * BM + ai * HALF + wr * 64 + m * 16 + fr) * D + 256 * u.pn + 32 * wc + 8 * fq;
#pragma unroll
                for (int bj = 0; bj < 2; ++bj) { *(f32x4*)(p + 128 * bj) = acc[ai][bj][m][0]; *(f32x4*)(p + 128 * bj + 4) = acc[ai][bj][m][1]; } }
    }
};
}

struct Ctx {
    LAS unsigned char* lds;
    int tid, lane, wave, vcu, G;
};
struct PrepD { const float* W; const float* gain; bf16_t* WT; int K, N, drow0, k0, n0; };
__device__ __forceinline__ void prep_load(const PrepD& d, f32x4 (&v)[8], float (&gk)[8], int lane) {
    if (!d.W) return;
    const int r = lane >> 3, c4 = lane & 7;
#pragma unroll
    for (int i = 0; i < 8; ++i) { v[i] = *(const f32x4*)(d.W + (size_t)(d.k0 + 8 * i + r) * d.N + d.n0 + 4 * c4); gk[i] = d.gain ? d.gain[d.k0 + 8 * i + r] : 1.0f; }
}
__device__ __forceinline__ void prep_finish(const PrepD& d, const f32x4 (&v)[8], const float (&gk)[8], LAS float* scr, int lane) {
    if (!d.W) { const v4u z = {0u, 0u, 0u, 0u};
#pragma unroll
        for (int j = 0; j < 2; ++j) *(v4u*)(d.WT + 8 * (lane + 64 * j)) = z;
        return; }
    { const int r = lane >> 3, c4 = lane & 7;
#pragma unroll
      for (int i = 0; i < 8; ++i) { LAS float* sp = scr + (8 * i + r) * 33 + 4 * c4; sp[0] = v[i].x * gk[i]; sp[1] = v[i].y * gk[i]; sp[2] = v[i].z * gk[i]; sp[3] = v[i].w * gk[i]; } }
    LDS_WAIT(); asm volatile("" ::: "memory");
    const int c = lane & 7;
#pragma unroll
    for (int j = 0; j < 4; ++j) { const int n = (lane >> 3) + 8 * j; const LAS float* s = scr + (8 * c) * 33 + n;
        v4u o; o.x = cvt_pk_bf16(s[0 * 33], s[1 * 33]); o.y = cvt_pk_bf16(s[2 * 33], s[3 * 33]); o.z = cvt_pk_bf16(s[4 * 33], s[5 * 33]); o.w = cvt_pk_bf16(s[6 * 33], s[7 * 33]);
        *(v4u*)(d.WT + (size_t)(d.drow0 + n) * d.K + d.k0 + 8 * c) = o; }
    LDS_WAIT(); asm volatile("" ::: "memory");
}
__device__ __forceinline__ int gu_map(int nb) { const int up = nb >= 88 ? 1 : 0, hb = nb - 88 * up; return 256 * (hb >> 2) + 128 * up + 32 * (hb & 3); }
__device__ __forceinline__ int ci_map(int nb) { if (nb < 32) return 32 * nb; const int hh = nb >= 64 ? 1 : 0, cb = nb - 32 - 32 * hh; return 256 * (4 + (cb >> 2)) + 128 * hh + 32 * (cb & 3); }
__device__ __forceinline__ int uk_map(int nb) { const int h = nb >> 2, dq = nb & 3; return 256 * (h >> 1) + 128 * (dq & 1) + 32 * (2 * (h & 1) + (dq >> 1)); }
__device__ __forceinline__ int uk_row(int h, int d) { return 256 * (h >> 1) + 128 * ((d >> 5) & 1) + 32 * (2 * (h & 1) + (d >> 6)) + (d & 31); }

struct Ptrs {
    const float* in[29]; float* out; unsigned char* ws;
};
typedef const __attribute__((address_space(4))) Ptrs CPtrs;

__device__ __forceinline__ void phase_prologue(const Ctx& C, CPtrs& P) {
    unsigned char* ws = P.ws;
    LAS float* scr = (LAS float*)(C.lds + RING_OFF + C.wave * 16384);
    const int lane = C.lane;
    const int gw = C.vcu * NWAVES + C.wave, NGW = C.G * NWAVES;
    constexpr int I_GU = 16 * 176, I_DKV = 16 * 10, I_DN = 44 * 32, I_CI = 16 * 96, I_SQ = 16 * 32, I_DQ = 16 * 16, I_UQ = 8 * 48, I_UKV = 4 * 32, I_Z = 192;
    constexpr int NITEMS = I_DKV + 4 * I_DN + I_CI + I_SQ + I_DQ + I_UQ + I_SQ + 2 * I_UKV + I_Z;
    auto decode = [&](int it) -> PrepD {
        int r = it;
        if (r < I_DKV) { const int kb = r / 10, nb = r % 10; return PrepD{P.in[23], P.in[22], (bf16_t*)(ws + WS_WDKV), D, CKVW, 32 * nb, 64 * (kb), 32 * (nb)}; } r -= I_DKV;
        if (r < 4 * I_DN) { const int mi = r / I_DN; r -= mi * I_DN; const int kb = r / 32, nb = r % 32;
            const float* W = (mi & 1 ? P.in[12] : P.in[8]) + (size_t)(mi >> 1) * FF * D;
            bf16_t* dst = (bf16_t*)(ws + (mi == 0 ? WS_WDN0 : mi == 1 ? WS_WDN1 : mi == 2 ? WS_WDN2 : WS_WDN3));
            return PrepD{W, nullptr, dst, FF, D, 32 * nb, 64 * (kb), 32 * (nb)}; } r -= 4 * I_DN;
        if (r < I_CI) { const int kb = r / 96, nb = r % 96; return PrepD{P.in[13], P.in[9], (bf16_t*)(ws + WS_WCI), D, 3 * D, ci_map(nb), 64 * (kb), 32 * (nb)}; } r -= I_CI;
        if (r < I_SQ) { const int kb = r / 32, nb = r % 32; return PrepD{P.in[15], nullptr, (bf16_t*)(ws + WS_WCO), D, D, 32 * nb, 64 * (kb), 32 * (nb)}; } r -= I_SQ;
        if (r < I_DQ) { const int kb = r / 16, nb = r % 16; return PrepD{P.in[16], P.in[9] + D, (bf16_t*)(ws + WS_WDQ), D, QRANK, 32 * nb, 64 * (kb), 32 * (nb)}; } r -= I_DQ;
        if (r < I_UQ) { const int kb = r / 48, nb = r % 48; return PrepD{P.in[18], P.in[17], (bf16_t*)(ws + WS_WUQ), QRANK, NQ, 32 * nb, 64 * (kb), 32 * (nb)}; } r -= I_UQ;
        if (r < I_SQ) { const int kb = r / 32, nb = r % 32; return PrepD{P.in[21], nullptr, (bf16_t*)(ws + WS_WO), D, D, 32 * nb, 64 * (kb), 32 * (nb)}; } r -= I_SQ;
        if (r < I_UKV) { const int kb = r / 32, nb = r % 32; return PrepD{P.in[26], nullptr, (bf16_t*)(ws + WS_WUKV), KVR, D, uk_map(nb), 64 * (kb), 32 * (nb)}; } r -= I_UKV;
        if (r < I_UKV) { const int kb = r / 32, nb = r % 32; return PrepD{P.in[27], nullptr, (bf16_t*)(ws + WS_WUKV), KVR, D, 1024 + 32 * nb, 64 * (kb), 32 * (nb)}; } r -= I_UKV;
        return PrepD{nullptr, nullptr, (bf16_t*)(ws + WS_WDKV) + (size_t)(320 + r) * D, 0, 0, 0, 0, 0};
    };
    if (gw < NITEMS) {
        PrepD cur = decode(gw); f32x4 v[8]; float gk[8]; prep_load(cur, v, gk, lane);
        for (int it = gw; it < NITEMS; it += NGW) {
            PrepD nxt = cur; f32x4 vn[8]; float gn[8];
            if (it + NGW < NITEMS) { nxt = decode(it + NGW); prep_load(nxt, vn, gn, lane); }
            prep_finish(cur, v, gk, scr, lane);
            cur = nxt;
#pragma unroll
            for (int i = 0; i < 8; ++i) { v[i] = vn[i]; gk[i] = gn[i]; }
        }
    }
    {
        f32x2* tab = (f32x2*)(ws + WS_ROPE);
        for (int e = gw * 64 + lane; e < (SEQ + DS) * 32; e += NGW * 64) {
            const int pos = e >> 5, j = e & 31;
            double f = 1.0; for (int i = 0; i < j; ++i) f *= 0.74989420933245582730;
            const double ang = (double)pos * f;
            const double k = __builtin_rint(ang * 0.15915494309189533577);
            double r = __builtin_fma(-k, 6.283185307179586232, ang); r = __builtin_fma(-k, 2.4492935982947064e-16, r);
            const double r2 = r * r; double ts = 1.0, tc = 1.0, ss = 1.0, cs = 1.0;
#pragma unroll
            for (int q = 1; q <= 14; ++q) { tc *= -r2 / (double)((2 * q - 1) * (2 * q)); cs += tc; ts *= -r2 / (double)((2 * q) * (2 * q + 1)); ss += ts; }
            tab[e] = (f32x2){(float)cs, (float)(ss * r)};
        }
    }
    {
        bf16_t* XB = (bf16_t*)(ws + WS_XB); float* ssq = (float*)(ws + WS_CTL) + F_SSQX; unsigned char* A8 = ws + WS_A8; float* SA = (float*)(ws + WS_SA);
        for (int row0 = gw; row0 < T; row0 += 2 * NGW) {
            f32x4 v[2][4]; float s[2]; const int nr = row0 + NGW < T ? 2 : 1;
#pragma unroll
            for (int q = 0; q < 2; ++q) { const int row = row0 + (q < nr ? q * NGW : 0); const float* src = row < TP ? P.in[0] + (size_t)row * D : P.in[1] + (size_t)(row - TP) * D;
#pragma unroll
                for (int j = 0; j < 4; ++j) v[q][j] = *((const f32x4*)src + lane + 64 * j); }
#pragma unroll
            for (int q = 0; q < 2; ++q) { s[q] = 0.f;
#pragma unroll
                for (int j = 0; j < 4; ++j) s[q] += (v[q][j].x * v[q][j].x + v[q][j].y * v[q][j].y) + (v[q][j].z * v[q][j].z + v[q][j].w * v[q][j].w);
                s[q] = wave_sum(s[q]); }
#pragma unroll
            for (int q = 0; q < 2; ++q) if (q < nr) { const int row = row0 + q * NGW;
#pragma unroll
                for (int j = 0; j < 4; ++j) {
                    u32x2 w; w.x = cvt_pk_bf16(v[q][j].x, v[q][j].y); w.y = cvt_pk_bf16(v[q][j].z, v[q][j].w); *((u32x2*)(XB + (size_t)row * D) + lane + 64 * j) = w; }
                if (lane == 0) ssq[row] = s[q];
                float am = 0.f;
#pragma unroll
                for (int j = 0; j < 4; ++j) am = fmaxf(am, fmaxf(fmaxf(fabsf(v[q][j].x), fabsf(v[q][j].y)), fmaxf(fabsf(v[q][j].z), fabsf(v[q][j].w))));
#pragma unroll
                for (int o = 1; o < 64; o <<= 1) am = fmaxf(am, __shfl_xor(am, o));
                const float inv = am > 0.f ? 127.0f / am : 0.f;
#pragma unroll
                for (int j = 0; j < 4; ++j) { const int q0 = __float2int_rn(v[q][j].x * inv), q1 = __float2int_rn(v[q][j].y * inv), q2 = __float2int_rn(v[q][j].z * inv), q3 = __float2int_rn(v[q][j].w * inv);
                    *(unsigned*)(A8 + (size_t)row * D + 4 * (lane + 64 * j)) = (unsigned)(q0 & 255) | ((unsigned)(q1 & 255) << 8) | ((unsigned)(q2 & 255) << 16) | ((unsigned)q3 << 24); }
                if (lane == 0) SA[row] = am * (1.0f / 127.0f); }
        }
    }
}

#ifndef SA_INT8_COPY_ONLY
#define SA_INT8_COPY_ONLY 1
#endif
__device__ __forceinline__ void phase_cacheconv(const Ctx& C, CPtrs& P, int cw, int nconv) {
    unsigned char* ws = P.ws; const int lane = C.lane;
    const int* pt = (const int*)P.in[5]; bf16_t* CLB = (bf16_t*)(ws + WS_CLB); unsigned char* CL8 = ws + WS_CL8; float* SC2 = (float*)(ws + WS_SC2);
    for (int pg = cw * NWAVES + C.wave; pg < DB * NPG; pg += nconv * NWAVES) {
        const int phys = pt[pg];
        const float* sl = P.in[2] + (size_t)phys * PAGE * KVR; bf16_t* dl = CLB + (size_t)pg * PAGE * KVR;
        for (int i0 = 0; i0 < 64; i0 += 8) {
            f32x4 a[8], c[8];
#pragma unroll
            for (int j = 0; j < 8; ++j) { a[j] = *((const f32x4*)sl + 2 * (lane + 64 * (i0 + j))); c[j] = *((const f32x4*)sl + 2 * (lane + 64 * (i0 + j)) + 1); }
#pragma unroll
            for (int j = 0; j < 8; ++j) {
#if !SA_INT8_COPY_ONLY
                { v4u w; w.x = cvt_pk_bf16(a[j].x, a[j].y); w.y = cvt_pk_bf16(a[j].z, a[j].w); w.z = cvt_pk_bf16(c[j].x, c[j].y); w.w = cvt_pk_bf16(c[j].z, c[j].w); *((v4u*)dl + lane + 64 * (i0 + j)) = w; }
#endif
                float am = fmaxf(fmaxf(fmaxf(fabsf(a[j].x), fabsf(a[j].y)), fmaxf(fabsf(a[j].z), fabsf(a[j].w))), fmaxf(fmaxf(fabsf(c[j].x), fabsf(c[j].y)), fmaxf(fabsf(c[j].z), fabsf(c[j].w))));
#pragma unroll
                for (int o = 1; o < 32; o <<= 1) am = fmaxf(am, __shfl_xor(am, o));
                const float inv = am > 0.f ? 127.0f / am : 0.f;
                const int q0 = __float2int_rn(a[j].x * inv), q1 = __float2int_rn(a[j].y * inv), q2 = __float2int_rn(a[j].z * inv), q3 = __float2int_rn(a[j].w * inv);
                const int q4 = __float2int_rn(c[j].x * inv), q5 = __float2int_rn(c[j].y * inv), q6 = __float2int_rn(c[j].z * inv), q7 = __float2int_rn(c[j].w * inv);
                u32x2 qw; qw.x = (unsigned)(q0 & 255) | ((unsigned)(q1 & 255) << 8) | ((unsigned)(q2 & 255) << 16) | ((unsigned)q3 << 24);
                qw.y = (unsigned)(q4 & 255) | ((unsigned)(q5 & 255) << 8) | ((unsigned)(q6 & 255) << 16) | ((unsigned)q7 << 24);
                const size_t row = (size_t)pg * PAGE + 2 * (i0 + j) + (lane >> 5);
                *(u32x2*)(CL8 + row * KVR + 8 * (lane & 31)) = qw;
                if ((lane & 31) == 0) { const float sc = am * (1.0f / 127.0f); SC2[row] = sc * sc; } }
        }
    }
}

__device__ __forceinline__ void phase_w8(const Ctx& C, CPtrs& P) {
    unsigned char* ws = P.ws; const float* wuk = P.in[26]; unsigned char* W8 = ws + WS_W8; float* T2 = (float*)(ws + WS_T2); const int lane = C.lane;
    for (int r = C.vcu * NWAVES + C.wave; r < D; r += C.G * NWAVES) {
        const int pn = r >> 8, bj = (r >> 7) & 1, wc = (r >> 5) & 3, h = 2 * pn + (wc >> 1), d = 64 * (wc & 1) + 32 * bj + (r & 31), col = 128 * h + d;
        float x[4]; float am = 0.f;
#pragma unroll
        for (int e = 0; e < 4; ++e) { x[e] = wuk[(size_t)(4 * lane + e) * D + col]; am = fmaxf(am, fabsf(x[e])); }
#pragma unroll
        for (int o = 1; o < 64; o <<= 1) am = fmaxf(am, __shfl_xor(am, o));
        const float inv = am > 0.f ? 127.0f / am : 0.f;
        const int q0 = __float2int_rn(x[0] * inv), q1 = __float2int_rn(x[1] * inv), q2 = __float2int_rn(x[2] * inv), q3 = __float2int_rn(x[3] * inv);
        *(unsigned*)(W8 + (size_t)r * KVR + 4 * lane) = (unsigned)(q0 & 255) | ((unsigned)(q1 & 255) << 8) | ((unsigned)(q2 & 255) << 16) | ((unsigned)q3 << 24);
        if (lane == 0) { const float sc = am * (1.0f / 127.0f); T2[r] = sc * sc; }
    }
}

__device__ __forceinline__ void phase_quant(const Ctx& C, CPtrs& P, const float* slab = nullptr, int ns = 0, float* ssq_out = nullptr) {
    unsigned char* ws = P.ws; bf16_t* XB = (bf16_t*)(ws + WS_XB); unsigned char* A8 = ws + WS_A8; float* SA = (float*)(ws + WS_SA);
    const int gw = C.vcu * NWAVES + C.wave, NGW = C.G * NWAVES, lane = C.lane;
    if (slab) {
        for (int r = gw; r < TS; r += NGW) { const size_t row = (size_t)TP + r; f32x4 v[4]; float ss = 0.f, am = 0.f;
#pragma unroll
            for (int j = 0; j < 4; ++j) { const u32x2 xw = *((const u32x2*)(XB + row * D) + lane + 64 * j); f32x4 a = {bflo(xw.x), bfhi(xw.x), bflo(xw.y), bfhi(xw.y)};
                for (int c = 0; c < ns; ++c) a += *((const f32x4*)(slab + ((size_t)c * TS + r) * D) + lane + 64 * j);
                v[j] = a; ss += (a.x * a.x + a.y * a.y) + (a.z * a.z + a.w * a.w); am = fmaxf(am, fmaxf(fmaxf(fabsf(a.x), fabsf(a.y)), fmaxf(fabsf(a.z), fabsf(a.w)))); }
            ss = wave_sum(ss);
#pragma unroll
            for (int o = 1; o < 64; o <<= 1) am = fmaxf(am, __shfl_xor(am, o));
            const float inv = am > 0.f ? 127.0f / am : 0.f;
#pragma unroll
            for (int j = 0; j < 4; ++j) { u32x2 w; w.x = cvt_pk_bf16(v[j].x, v[j].y); w.y = cvt_pk_bf16(v[j].z, v[j].w); *((u32x2*)(XB + row * D) + lane + 64 * j) = w;
                const int q0 = __float2int_rn(v[j].x * inv), q1 = __float2int_rn(v[j].y * inv), q2 = __float2int_rn(v[j].z * inv), q3 = __float2int_rn(v[j].w * inv);
                *(unsigned*)(A8 + row * D + 4 * (lane + 64 * j)) = (unsigned)(q0 & 255) | ((unsigned)(q1 & 255) << 8) | ((unsigned)(q2 & 255) << 16) | ((unsigned)q3 << 24); }
            if (lane == 0) { ssq_out[row] = ss; SA[row] = am * (1.0f / 127.0f); } }
    }
    const int TQ = slab ? TP : T;
    constexpr int RPS = 4;
    for (int row0 = gw; row0 < TQ; row0 += RPS * NGW) {
        v4u w[RPS][2];
#pragma unroll
        for (int q = 0; q < RPS; ++q) { const int rq = row0 + q * NGW, row = rq < TQ ? rq : row0; w[q][0] = *((const v4u*)(XB + (size_t)row * D) + 2 * lane); w[q][1] = *((const v4u*)(XB + (size_t)row * D) + 2 * lane + 1); }
#pragma unroll
        for (int q = 0; q < RPS; ++q) if (row0 + q * NGW < TQ) { const int row = row0 + q * NGW; float x[16]; unpack8f(w[q][0], x); unpack8f(w[q][1], x + 8);
            float am = 0.f;
#pragma unroll
            for (int e = 0; e < 16; ++e) am = fmaxf(am, fabsf(x[e]));
#pragma unroll
            for (int o = 1; o < 64; o <<= 1) am = fmaxf(am, __shfl_xor(am, o));
            const float inv = am > 0.f ? 127.0f / am : 0.f; v4u o4; unsigned ww[4];
#pragma unroll
            for (int g = 0; g < 4; ++g) { const int q0 = __float2int_rn(x[4 * g] * inv), q1 = __float2int_rn(x[4 * g + 1] * inv), q2 = __float2int_rn(x[4 * g + 2] * inv), q3 = __float2int_rn(x[4 * g + 3] * inv);
                ww[g] = (unsigned)(q0 & 255) | ((unsigned)(q1 & 255) << 8) | ((unsigned)(q2 & 255) << 16) | ((unsigned)q3 << 24); }
            o4.x = ww[0]; o4.y = ww[1]; o4.z = ww[2]; o4.w = ww[3];
            *((v4u*)(A8 + (size_t)row * D) + lane) = o4;
            if (lane == 0) SA[row] = am * (1.0f / 127.0f); }
    }
}
__device__ __forceinline__ void phase_w8gu(const Ctx& C, CPtrs& P) {
    unsigned char* ws = P.ws; const int lane = C.lane, r = lane >> 3, c4 = lane & 7;
    LAS float* scr = (LAS float*)(C.lds + RING_OFF + C.wave * 16384);
    for (int item = C.vcu * NWAVES + C.wave; item < 4 * 176; item += C.G * NWAVES) {
        const int mi = item / 176, nb = item % 176, n0 = 32 * nb, N = 2 * FF;
        const float* W = (mi & 1 ? P.in[11] : P.in[7]) + (size_t)(mi >> 1) * D * N; const float* g = (mi & 1 ? P.in[10] : P.in[6]) + (mi >> 1) * D;
        unsigned char* W8 = ws + WS_W8GU0 + (size_t)mi * WS_W8GU_STRIDE; float* TS = (float*)(ws + WS_TGU) + mi * N;
        const int drow0 = gu_map(nb);
        float am[4] = {0.f, 0.f, 0.f, 0.f};
#pragma unroll 16
        for (int kb = 0; kb < D / 8; ++kb) { const int k = 8 * kb + r; const f32x4 v = *(const f32x4*)(W + (size_t)k * N + n0 + 4 * c4); const float gk = g[k];
            am[0] = fmaxf(am[0], fabsf(v.x * gk)); am[1] = fmaxf(am[1], fabsf(v.y * gk)); am[2] = fmaxf(am[2], fabsf(v.z * gk)); am[3] = fmaxf(am[3], fabsf(v.w * gk)); }
        float inv[4];
#pragma unroll
        for (int j = 0; j < 4; ++j) { float a = am[j]; a = fmaxf(a, __shfl_xor(a, 8)); a = fmaxf(a, __shfl_xor(a, 16)); a = fmaxf(a, __shfl_xor(a, 32)); inv[j] = a > 0.f ? 127.0f / a : 0.f; am[j] = a; }
        if (r == 0) *(f32x4*)(TS + drow0 + 4 * c4) = (f32x4){am[0] * (1.0f / 127.0f), am[1] * (1.0f / 127.0f), am[2] * (1.0f / 127.0f), am[3] * (1.0f / 127.0f)};
        for (int k0 = 0; k0 < D; k0 += 64) {
            f32x4 v[8]; float gk[8];
#pragma unroll
            for (int i = 0; i < 8; ++i) { v[i] = *(const f32x4*)(W + (size_t)(k0 + 8 * i + r) * N + n0 + 4 * c4); gk[i] = g[k0 + 8 * i + r]; }
#pragma unroll
            for (int i = 0; i < 8; ++i) { LAS float* sp = scr + (8 * i + r) * 33 + 4 * c4;
                sp[0] = __builtin_rintf(v[i].x * gk[i] * inv[0]); sp[1] = __builtin_rintf(v[i].y * gk[i] * inv[1]); sp[2] = __builtin_rintf(v[i].z * gk[i] * inv[2]); sp[3] = __builtin_rintf(v[i].w * gk[i] * inv[3]); }
            LDS_WAIT(); asm volatile("" ::: "memory");
            const int c = lane & 7;
#pragma unroll
            for (int j = 0; j < 4; ++j) { const int n = (lane >> 3) + 8 * j; const LAS float* s = scr + (8 * c) * 33 + n;
                const int q0 = (int)s[0 * 33], q1 = (int)s[1 * 33], q2 = (int)s[2 * 33], q3 = (int)s[3 * 33], q4 = (int)s[4 * 33], q5 = (int)s[5 * 33], q6 = (int)s[6 * 33], q7 = (int)s[7 * 33];
                u32x2 o; o.x = (unsigned)(q0 & 255) | ((unsigned)(q1 & 255) << 8) | ((unsigned)(q2 & 255) << 16) | ((unsigned)q3 << 24);
                o.y = (unsigned)(q4 & 255) | ((unsigned)(q5 & 255) << 8) | ((unsigned)(q6 & 255) << 16) | ((unsigned)q7 << 24);
                *(u32x2*)(W8 + (size_t)(drow0 + n) * D + k0 + 8 * c) = o; }
            LDS_WAIT(); asm volatile("" ::: "memory");
        }
    }
}

__device__ __forceinline__ void phase_w8gu2(const Ctx& C, CPtrs& P) {
    unsigned char* ws = P.ws; const int lane = C.lane, r = lane >> 3, c4 = lane & 7, w = C.wave;
    LAS float* S = (LAS float*)(C.lds + RING_OFF); LAS float* AM = (LAS float*)(C.lds + QS_OFF);
    __syncthreads();
    for (int item = C.vcu; item < 4 * 176; item += C.G) {
        const int mi = item / 176, nb = item % 176, n0 = 32 * nb, N = 2 * FF;
        const float* W = (mi & 1 ? P.in[11] : P.in[7]) + (size_t)(mi >> 1) * D * N; const float* g = (mi & 1 ? P.in[10] : P.in[6]) + (mi >> 1) * D;
        unsigned char* W8 = ws + WS_W8GU0 + (size_t)mi * WS_W8GU_STRIDE; float* TS = (float*)(ws + WS_TGU) + mi * N;
        const int drow0 = gu_map(nb);
        float am[4] = {0.f, 0.f, 0.f, 0.f};
#pragma unroll
        for (int hb = 0; hb < 2; ++hb) {
            f32x4 v[8]; float gk[8];
#pragma unroll
            for (int i = 0; i < 8; ++i) { const int k = 128 * w + 64 * hb + 8 * i + r; v[i] = *(const f32x4*)(W + (size_t)k * N + n0 + 4 * c4); gk[i] = g[k]; }
#pragma unroll
            for (int i = 0; i < 8; ++i) { const int k = 128 * w + 64 * hb + 8 * i + r, sw = k & 31; LAS float* sp = S + k * 32;
                const float x0 = v[i].x * gk[i], x1 = v[i].y * gk[i], x2 = v[i].z * gk[i], x3 = v[i].w * gk[i];
                am[0] = fmaxf(am[0], fabsf(x0)); am[1] = fmaxf(am[1], fabsf(x1)); am[2] = fmaxf(am[2], fabsf(x2)); am[3] = fmaxf(am[3], fabsf(x3));
                sp[(4 * c4 + 0) ^ sw] = x0; sp[(4 * c4 + 1) ^ sw] = x1; sp[(4 * c4 + 2) ^ sw] = x2; sp[(4 * c4 + 3) ^ sw] = x3; }
        }
#pragma unroll
        for (int j = 0; j < 4; ++j) { float a = am[j]; a = fmaxf(a, __shfl_xor(a, 8)); a = fmaxf(a, __shfl_xor(a, 16)); a = fmaxf(a, __shfl_xor(a, 32)); am[j] = a; }
        if (r == 0) { AM[w * 32 + 4 * c4 + 0] = am[0]; AM[w * 32 + 4 * c4 + 1] = am[1]; AM[w * 32 + 4 * c4 + 2] = am[2]; AM[w * 32 + 4 * c4 + 3] = am[3]; }
        __syncthreads();
        const int n = lane & 31, k0 = 128 * w + 64 * (lane >> 5);
        float a = 0.f;
#pragma unroll
        for (int ww = 0; ww < 8; ++ww) a = fmaxf(a, AM[ww * 32 + n]);
        const float inv = a > 0.f ? 127.0f / a : 0.f;
        if (w == 0 && lane < 32) TS[drow0 + lane] = a * (1.0f / 127.0f);
#pragma unroll
        for (int q = 0; q < 4; ++q) { unsigned o[4];
#pragma unroll
            for (int d = 0; d < 4; ++d) { unsigned wd = 0u;
#pragma unroll
                for (int e = 0; e < 4; ++e) { const int k = k0 + 16 * q + 4 * d + e; const int qi = (int)__builtin_rintf(S[k * 32 + (n ^ (k & 31))] * inv); wd |= (unsigned)(qi & 255) << (8 * e); }
                o[d] = wd; }
            v4u ov; ov.x = o[0]; ov.y = o[1]; ov.z = o[2]; ov.w = o[3]; *(v4u*)(W8 + (size_t)(drow0 + n) * D + k0 + 16 * q) = ov; }
        __syncthreads();
    }
}

__device__ __forceinline__ void phase_conv(const Ctx& C, CPtrs& P) {
    unsigned char* ws = P.ws; const bf16_t* BB = (const bf16_t*)(ws + WS_BB); const bf16_t* UB = (const bf16_t*)(ws + WS_UB); bf16_t* ZB = (bf16_t*)(ws + WS_ZB);
    const float* cw = P.in[14]; const float* st = P.in[4];
    const int gw = C.vcu * NWAVES + C.wave, NGW = C.G * NWAVES, lane = C.lane;
    for (int row = gw; row < T; row += NGW) {
        int have1, have2; const float* s1 = nullptr; const float* s2 = nullptr;
        if (row < TP) { const int t = row & (SEQ - 1); have1 = t >= 1; have2 = t >= 2; }
        else { const int r = row - TP, i = r & 3, b = r >> 2; have1 = i >= 1; have2 = i >= 2;
            if (!have1) s1 = st + (size_t)(b * 2 + 1) * D; if (!have2) s2 = st + (size_t)(b * 2 + i) * D; }
        v4u rb[2], r0[2], r1[2], r2[2];
#pragma unroll
        for (int j = 0; j < 2; ++j) { const int ch = 8 * lane + 512 * j; rb[j] = *(const v4u*)(BB + (size_t)row * D + ch); r0[j] = *(const v4u*)(UB + (size_t)row * D + ch);
            r1[j] = have1 ? *(const v4u*)(UB + (size_t)(row - 1) * D + ch) : (v4u){0u, 0u, 0u, 0u}; r2[j] = have2 ? *(const v4u*)(UB + (size_t)(row - 2) * D + ch) : (v4u){0u, 0u, 0u, 0u}; }
#pragma unroll
        for (int j = 0; j < 2; ++j) {
            const int ch = 8 * lane + 512 * j;
            float b8[8], u0[8], u1[8], u2[8], z[8];
            unpack8f(rb[j], b8); unpack8f(r0[j], u0); unpack8f(r1[j], u1); unpack8f(r2[j], u2);
            if (!have1 && s1) { const f32x4 a = *(const f32x4*)(s1 + ch), b = *(const f32x4*)(s1 + ch + 4); u1[0] = a.x; u1[1] = a.y; u1[2] = a.z; u1[3] = a.w; u1[4] = b.x; u1[5] = b.y; u1[6] = b.z; u1[7] = b.w; }
            if (!have2 && s2) { const f32x4 a = *(const f32x4*)(s2 + ch), b = *(const f32x4*)(s2 + ch + 4); u2[0] = a.x; u2[1] = a.y; u2[2] = a.z; u2[3] = a.w; u2[4] = b.x; u2[5] = b.y; u2[6] = b.z; u2[7] = b.w; }
#pragma unroll
            for (int e = 0; e < 8; ++e) z[e] = b8[e] * (cw[ch + e] * u2[e] + cw[D + ch + e] * u1[e] + cw[2 * D + ch + e] * u0[e]);
            *(v4u*)(ZB + (size_t)row * D + ch) = pack8f(z);
        }
    }
}

__device__ __forceinline__ void phase_kvfin(const Ctx& C, CPtrs& P) {
    unsigned char* ws = P.ws; const float* ckv = (const float*)(ws + WS_CKV); const float* ctl = (const float*)(ws + WS_CTL);
    bf16_t* LATB = (bf16_t*)(ws + WS_LATB); bf16_t* KPEB = (bf16_t*)(ws + WS_KPEB); const f32x2* tab = (const f32x2*)(ws + WS_ROPE);
    int lane = C.lane; asm volatile("" : "+v"(lane));
    const int gw = C.vcu * NWAVES + C.wave, NGW = C.G * NWAVES;
    const f32x4 gl = *((const f32x4*)P.in[24] + lane); const float gk = P.in[25][lane];
    for (int row0 = gw; row0 < T; row0 += 2 * NGW) {
        const int nr = row0 + NGW < T ? 2 : 1;
        float sl_[2], sk_[2], xk[2]; f32x4 vl[2]; f32x2 cs[2]; int rowq[2], posq[2];
#pragma unroll
        for (int q = 0; q < 2; ++q) { const int row = row0 + (q < nr ? q * NGW : 0); rowq[q] = row; posq[q] = row < TP ? (row & (SEQ - 1)) : SEQ + ((row - TP) & 3);
            sl_[q] = ctl[F_SSQLAT + row]; sk_[q] = ctl[F_SSQKPE + row]; vl[q] = *((const f32x4*)(ckv + (size_t)row * CKVW) + lane); xk[q] = ckv[(size_t)row * CKVW + KVR + lane]; cs[q] = tab[posq[q] * 32 + (lane & 31)]; }
#pragma unroll
        for (int q = 0; q < 2; ++q) if (q < nr) { const int row = rowq[q];
            const float rl = rsq(sl_[q] * (1.0f / KVR) + EPS), rk = rsq(sk_[q] * (1.0f / ROPE) + EPS);
            const f32x4 v = vl[q] * rl * gl;
            float* ol = row < TP ? P.out + OUT_LATP + (size_t)row * KVR : P.out + OUT_LATS + (size_t)(row - TP) * KVR;
            *((f32x4*)ol + lane) = v;
            u32x2 w; w.x = cvt_pk_bf16(v.x, v.y); w.y = cvt_pk_bf16(v.z, v.w); *((u32x2*)(LATB + (size_t)row * KVR) + lane) = w;
            const float xn = xk[q] * rk * gk, pr = __shfl_xor(xn, 32);
            const float o = lane < 32 ? xn * cs[q].x - pr * cs[q].y : xn * cs[q].x + pr * cs[q].y;
            float* ok = row < TP ? P.out + OUT_KPEP + (size_t)row * ROPE : P.out + OUT_KPES + (size_t)(row - TP) * ROPE;
            ok[lane] = o;
            const float on = __shfl_xor(o, 1);
            if ((lane & 1) == 0) *(unsigned*)(KPEB + (size_t)row * ROPE + lane) = cvt_pk_bf16(o, on); }
    }
}

__device__ __forceinline__ void phase_qkfin(const Ctx& C, CPtrs& P) {
    unsigned char* ws = P.ws; const float* ctl = (const float*)(ws + WS_CTL); bf16_t* QB = (bf16_t*)(ws + WS_QB); bf16_t* KN = (bf16_t*)(ws + WS_KN);
    const float* RPT = (const float*)(ws + WS_RPT); const f32x2* tab = (const f32x2*)(ws + WS_ROPE);
    const float* gqn = P.in[19]; const float* gqp = P.in[20]; const float* gkn = P.in[28];
    int lane = C.lane; asm volatile("" : "+v"(lane));
    const int gw = C.vcu * NWAVES + C.wave, NGW = C.G * NWAVES;
    for (int row = gw; row < TP; row += NGW) {
        const int pos = row & (SEQ - 1);
        const float* sq = ctl + F_SSQQ + row;
        bf16_t* pq[2]; bf16_t* pk[2]; v4u vq[2], vk[2]; float rq[2], rk[2];
#pragma unroll
        for (int it = 0; it < 2; ++it) { const int h = 4 * it + (lane >> 4), c = lane & 15; pq[it] = QB + (size_t)row * NQ + HD * h + 8 * c; vq[it] = *(const v4u*)pq[it]; rq[it] = sq[(size_t)(2 * h) * T];
            const int ci = lane + 64 * it, hk = ci >> 4, ck = ci & 15; pk[it] = KN + (size_t)row * D + 128 * hk + 8 * ck; vk[it] = *(const v4u*)pk[it];
            rk[it] = RPT[(size_t)(2 * hk) * T + row] + RPT[(size_t)(2 * hk + 1) * T + row]; }
        bf16_t* pr = QB + (size_t)row * NQ + HD * (lane >> 3) + 128 + 8 * (lane & 7); const v4u vr = *(const v4u*)pr; const float rr = sq[(size_t)(2 * (lane >> 3) + 1) * T];
#pragma unroll
        for (int it = 0; it < 2; ++it) { const int c = lane & 15; const float rs = rsq(rq[it] * (1.0f / 128) + EPS) * QSCALE; float x[8]; unpack8f(vq[it], x);
#pragma unroll
            for (int e = 0; e < 8; ++e) x[e] = x[e] * rs * gqn[8 * c + e];
            *(v4u*)pq[it] = pack8f(x); }
        { const int c = lane & 7; const float rs = rsq(rr * (1.0f / 64) + EPS); float x[8], y[8]; unpack8f(vr, x);
#pragma unroll
            for (int e = 0; e < 8; ++e) x[e] = x[e] * rs * gqp[8 * c + e];
#pragma unroll
            for (int e = 0; e < 8; ++e) { const float prt = __shfl_xor(x[e], 4); const f32x2 cs = tab[pos * 32 + ((8 * c + e) & 31)];
                y[e] = (c < 4 ? x[e] * cs.x - prt * cs.y : x[e] * cs.x + prt * cs.y) * QSCALE; }
            *(v4u*)pr = pack8f(y); }
#pragma unroll
        for (int jj = 0; jj < 2; ++jj) { const int c = (lane + 64 * jj) & 15; const float rs = rsq(rk[jj] * (1.0f / 128) + EPS); float x[8]; unpack8f(vk[jj], x);
#pragma unroll
            for (int e = 0; e < 8; ++e) x[e] = x[e] * rs * gkn[8 * c + e];
            *(v4u*)pk[jj] = pack8f(x); }
    }
    { float* RTS = (float*)(ws + WS_RTS);
      for (int i = C.vcu * (NWAVES * 64) + C.tid; i < TS * NH; i += C.G * (NWAVES * 64)) { const int rsi = i >> 3, h = i & 7; const size_t rw = (size_t)TP + rsi;
          RTS[i] = rsq((RPT[(size_t)(2 * h) * T + rw] + RPT[(size_t)(2 * h + 1) * T + rw]) * (1.0f / 128) + EPS); } }
    {
        LAS float* A = (LAS float*)(C.lds + RING_OFF + C.wave * 1024);
        const bf16_t* WUK = (const bf16_t*)(ws + WS_WUKV); bf16_t* QS = (bf16_t*)(ws + WS_QS);
        for (int item = gw; item < TS * NH; item += NGW) {
            const int rsi = item >> 3, h = item & 7, row = TP + rsi;
            const float* sq = ctl + F_SSQQ + row;
            { const unsigned w = *(const unsigned*)(QB + (size_t)row * NQ + HD * h + 2 * lane); const float rs = rsq(sq[(size_t)(2 * h) * T] * (1.0f / 128) + EPS);
              A[2 * lane] = bflo(w) * rs * gqn[2 * lane] * gkn[2 * lane]; A[2 * lane + 1] = bfhi(w) * rs * gqn[2 * lane + 1] * gkn[2 * lane + 1]; }
            { const float x = bf2f(QB[(size_t)row * NQ + HD * h + 128 + lane]) * rsq(sq[(size_t)(2 * h + 1) * T] * (1.0f / 64) + EPS) * gqp[lane], pr = __shfl_xor(x, 32);
              const f32x2 cs = tab[(SEQ + (rsi & 3)) * 32 + (lane & 31)];
              const float o = (lane < 32 ? x * cs.x - pr * cs.y : x * cs.x + pr * cs.y) * QSCALE, on = __shfl_xor(o, 1);
              if ((lane & 1) == 0) *(unsigned*)(QS + (size_t)item * 320 + 256 + lane) = cvt_pk_bf16(o, on); }
            LDS_WAIT(); asm volatile("" ::: "memory");
            float acc[4] = {0.f, 0.f, 0.f, 0.f};
#pragma unroll 32
            for (int d = 0; d < 128; ++d) { const u32x2 w = *(const u32x2*)(WUK + (size_t)uk_row(h, d) * KVR + 4 * lane); const float ad = A[d];
                acc[0] += bflo(w.x) * ad; acc[1] += bfhi(w.x) * ad; acc[2] += bflo(w.y) * ad; acc[3] += bfhi(w.y) * ad; }
            u32x2 o; o.x = cvt_pk_bf16(acc[0] * QSCALE, acc[1] * QSCALE); o.y = cvt_pk_bf16(acc[2] * QSCALE, acc[3] * QSCALE);
            *(u32x2*)(QS + (size_t)item * 320 + 4 * lane) = o;
            LDS_WAIT(); asm volatile("" ::: "memory");
        }
    }
}

__device__ __forceinline__ void phase_scomb(const Ctx& C, CPtrs& P) {
    unsigned char* ws = P.ws; const float* PO = (const float*)(ws + WS_PO); const float* PML = (const float*)(ws + WS_PML); bf16_t* OB = (bf16_t*)(ws + WS_OB);
    const float* wuv = P.in[27];
    const int gw = C.vcu * NWAVES + C.wave, NGW = C.G * NWAVES, lane = C.lane;
    LAS float* OL = (LAS float*)(C.lds + RING_OFF + C.wave * 1024);
    for (int item = gw; item < TS * NH; item += NGW) {
        const int rsi = item >> 3, h = item & 7, b = rsi >> 2, q = rsi & 3, rho = q * 8 + h;
        const size_t i0 = (size_t)(b * 2 + 0) * 32 + rho, i1 = (size_t)(b * 2 + 1) * 32 + rho;
        const float m0 = PML[i0 * 2], l0 = PML[i0 * 2 + 1], m1 = PML[i1 * 2], l1 = PML[i1 * 2 + 1];
        const float mm = fmaxf(m0, m1), f0 = __builtin_amdgcn_exp2f(m0 - mm), f1 = __builtin_amdgcn_exp2f(m1 - mm), inv = 1.0f / (l0 * f0 + l1 * f1);
        { const f32x4 a = *((const f32x4*)(PO + i0 * 256) + lane), c = *((const f32x4*)(PO + i1 * 256) + lane); *((LAS f32x4*)OL + lane) = (a * f0 + c * f1) * inv; }
        LDS_WAIT(); asm volatile("" ::: "memory");
        float a0 = 0.f, a1 = 0.f; const float* wp = wuv + 128 * h + 2 * lane;
#pragma unroll 32
        for (int n = 0; n < KVR; ++n) { const f32x2 w = *(const f32x2*)(wp + (size_t)n * D); const float on = OL[n]; a0 += on * w.x; a1 += on * w.y; }
        *(unsigned*)(OB + (size_t)(TP + rsi) * D + 128 * h + 2 * lane) = cvt_pk_bf16(a0, a1);
        LDS_WAIT(); asm volatile("" ::: "memory");
    }
}

namespace att {
typedef short bf16x8 __attribute__((ext_vector_type(8)));
typedef short s16x4 __attribute__((ext_vector_type(4)));
typedef float f32x16 __attribute__((ext_vector_type(16)));
typedef float f32x4 __attribute__((ext_vector_type(4)));
typedef unsigned u32x4 __attribute__((ext_vector_type(4)));
constexpr float THR = 11.5f;
#define SBAR() __builtin_amdgcn_sched_barrier(0)
__device__ __forceinline__ int crow(int r, int hi) { return (r & 3) + 8 * (r >> 2) + 4 * hi; }
__device__ __forceinline__ unsigned cvtpk(float lo, float hi) { unsigned r; asm volatile("v_cvt_pk_bf16_f32 %0, %1, %2" : "=v"(r) : "v"(lo), "v"(hi)); return r; }
__device__ __forceinline__ float xmax32(float v) { auto rr = __builtin_amdgcn_permlane32_swap(__float_as_uint(v), __float_as_uint(v), false, false); return fmaxf(__uint_as_float(rr[0]), __uint_as_float(rr[1])); }
__device__ __forceinline__ float xsum32(float v) { auto rr = __builtin_amdgcn_permlane32_swap(__float_as_uint(v), __float_as_uint(v), false, false); return __uint_as_float(rr[0]) + __uint_as_float(rr[1]); }
#define PK4(P, B_, OUT) do { unsigned a0 = cvtpk(P[B_+0], P[B_+1]), a1 = cvtpk(P[B_+2], P[B_+3]);                          \
        unsigned b0 = cvtpk(P[B_+4], P[B_+5]), b1 = cvtpk(P[B_+6], P[B_+7]);                                             \
        auto r0 = __builtin_amdgcn_permlane32_swap(a0, b0, false, false); auto r1 = __builtin_amdgcn_permlane32_swap(a1, b1, false, false); \
        u32x4 w = {r0[0], r1[0], r0[1], r1[1]}; OUT = *reinterpret_cast<bf16x8*>(&w); } while (0)

namespace pa {
constexpr int KVBLK = 64, QBLK = 32, QB = 256;
constexpr int SHM_V = 16384, SHM_K = 16384, SHM_R = 8192;
constexpr int OFF_V = 0, OFF_K = 2 * SHM_V, OFF_R = OFF_K + 2 * SHM_K, OFF_WS = OFF_R + 2 * SHM_R;
#define KSWZ(row, colB) ((row) * 256 + ((colB) ^ (((row) & 7) << 4)))
__device__ __forceinline__ int v_st(int k, int c) { const int kk = (k & ~0xC) | ((k & 4) << 1) | ((k & 8) >> 1); return ((kk >> 3) * 4 + (c >> 5)) * 512 + ((kk & 7) * 32 + (c & 31)) * 2; }
__device__ __forceinline__ int v_rd_base(int lane) { return ((lane & 3) << 3) | (((lane >> 2) & 3) << 6) | (((lane >> 4) & 1) << 5) | (((lane >> 5) & 1) << 8); }
constexpr int v_rd_off(int d0, int ks, int half) { return d0 * 512 + ks * 4096 + half * 2048; }
__device__ __forceinline__ void mask_tile(f32x16& p0, f32x16& p1, int dq) {
    const float NEG = -__builtin_inff();
#pragma unroll
    for (int r = 0; r < 16; ++r) { const int c = (r & 3) + 8 * (r >> 2); if (dq - c < 0) p0[r] = NEG; if (dq - c - 32 < 0) p1[r] = NEG; }
}
__device__ __forceinline__ void softmax_tile(f32x16& p0, f32x16& p1, float& m_reg, float& l_reg, float& alpha, bf16x8& pa0, bf16x8& pa1, bf16x8& pa2, bf16x8& pa3) {
    float pmax = p0[0];
#pragma unroll
    for (int r = 1; r < 16; ++r) pmax = fmaxf(pmax, p0[r]);
#pragma unroll
    for (int r = 0; r < 16; ++r) pmax = fmaxf(pmax, p1[r]);
    pmax = xmax32(pmax);
    float mn;
    if (__builtin_expect(__all((pmax - m_reg) <= THR), 1)) { mn = m_reg; alpha = 1.f; }
    else { mn = fmaxf(m_reg, pmax); alpha = __builtin_amdgcn_exp2f(m_reg - mn); m_reg = mn; }
#pragma unroll
    for (int r = 0; r < 16; ++r) { p0[r] = __builtin_amdgcn_exp2f(p0[r] - mn); p1[r] = __builtin_amdgcn_exp2f(p1[r] - mn); }
    float ps = 0.f;
#pragma unroll
    for (int r = 0; r < 16; ++r) ps += p0[r];
#pragma unroll
    for (int r = 0; r < 16; ++r) ps += p1[r];
    ps = xsum32(ps);
    l_reg = l_reg * alpha + ps;
    PK4(p0, 0, pa0); PK4(p0, 8, pa1); PK4(p1, 0, pa2); PK4(p1, 8, pa3);
}
template <int KB>
__device__ __forceinline__ void qkt(f32x16& p0, f32x16& p1, const char* lds, int r32, int hi, const bf16x8* qr) {
    p0 = f32x16{}; p1 = f32x16{};
    const char* kb[4];
#pragma unroll
    for (int dd = 0; dd < 4; ++dd) kb[dd] = lds + OFF_K + KB * SHM_K + KSWZ(r32, (dd * 16 + hi * 8) * 2);
#pragma unroll
    for (int d0 = 0; d0 < 8; ++d0) { const char* a = kb[d0 & 3] + (d0 >> 2) * 128;
        const bf16x8 b0 = *reinterpret_cast<const bf16x8*>(a), b1 = *reinterpret_cast<const bf16x8*>(a + 32 * 256);
        p0 = __builtin_amdgcn_mfma_f32_32x32x16_bf16(b0, qr[d0], p0, 0, 0, 0);
        p1 = __builtin_amdgcn_mfma_f32_32x32x16_bf16(b1, qr[d0], p1, 0, 0, 0); }
    const int sw = (r32 >> 1) & 7; const char* rb = lds + OFF_R + KB * SHM_R + r32 * 128;
#pragma unroll
    for (int s = 0; s < 4; ++s) { const char* a = rb + (((2 * s + hi) ^ sw) << 4);
        const bf16x8 b0 = *reinterpret_cast<const bf16x8*>(a), b1 = *reinterpret_cast<const bf16x8*>(a + 32 * 128);
        p0 = __builtin_amdgcn_mfma_f32_32x32x16_bf16(b0, qr[8 + s], p0, 0, 0, 0);
        p1 = __builtin_amdgcn_mfma_f32_32x32x16_bf16(b1, qr[8 + s], p1, 0, 0, 0); }
}
template <int VB>
__device__ __forceinline__ void pv_tile(f32x16* o, int vb0, bf16x8 pa0, bf16x8 pa1, bf16x8 pa2, bf16x8 pa3) {
#define TRRD(dst, off) asm volatile("ds_read_b64_tr_b16 %0, %1 offset:%2" : "=&v"(dst) : "v"(vb0), "i"(off) : "memory")
#define PV_KS(ks, PA) do { s16x4 l0, l1, l2, l3, h0, h1, h2, h3; constexpr int b_ = OFF_V + VB * SHM_V + v_rd_off(0, ks, 0);   \
        TRRD(l0, b_); TRRD(h0, b_ + 2048); TRRD(l1, b_ + 512); TRRD(h1, b_ + 512 + 2048); TRRD(l2, b_ + 1024); TRRD(h2, b_ + 1024 + 2048); TRRD(l3, b_ + 1536); TRRD(h3, b_ + 1536 + 2048); \
        asm volatile("s_waitcnt lgkmcnt(0)" ::: "memory"); SBAR();   \
        o[0] = __builtin_amdgcn_mfma_f32_32x32x16_bf16(PA, (bf16x8){l0[0], l0[1], l0[2], l0[3], h0[0], h0[1], h0[2], h0[3]}, o[0], 0, 0, 0);   \
        o[1] = __builtin_amdgcn_mfma_f32_32x32x16_bf16(PA, (bf16x8){l1[0], l1[1], l1[2], l1[3], h1[0], h1[1], h1[2], h1[3]}, o[1], 0, 0, 0);   \
        o[2] = __builtin_amdgcn_mfma_f32_32x32x16_bf16(PA, (bf16x8){l2[0], l2[1], l2[2], l2[3], h2[0], h2[1], h2[2], h2[3]}, o[2], 0, 0, 0);   \
        o[3] = __builtin_amdgcn_mfma_f32_32x32x16_bf16(PA, (bf16x8){l3[0], l3[1], l3[2], l3[3], h3[0], h3[1], h3[2], h3[3]}, o[3], 0, 0, 0); } while (0)
    PV_KS(0, pa0); PV_KS(1, pa1); PV_KS(2, pa2); PV_KS(3, pa3);
#undef PV_KS
#undef TRRD
}
__device__ __forceinline__ void unit(int b, int h, int qb, const bf16_t* __restrict__ QF, const bf16_t* __restrict__ KN, const bf16_t* __restrict__ KPE, const bf16_t* __restrict__ VBg, bf16_t* OB, char* lds) {
    const int tid = threadIdx.x, wid = __builtin_amdgcn_readfirstlane(tid >> 6), lane = tid & 63, r32 = lane & 31, hi = lane >> 5;
    const size_t rowb = (size_t)b * SEQ; const int q0 = qb * QB, qlo = q0 + wid * QBLK, qm = qlo + r32 - 4 * hi;
    const int NT = (q0 + QB) / KVBLK;
    float* wsf = (float*)(lds + OFF_WS) + wid * 64; float* li_l = wsf; float* al_l = wsf + 32;
    bf16x8 qr[12];
    { const bf16_t* qp = QF + (rowb + qlo + r32) * NQ + HD * h + hi * 8;
#pragma unroll
      for (int d0 = 0; d0 < 12; ++d0) qr[d0] = *reinterpret_cast<const bf16x8*>(qp + d0 * 16); }
    const int sr = tid >> 4, sc = (tid & 15) * 8, rr = tid >> 3, rc = tid & 7;
    const int kws = KSWZ(sr, sc * 2), vst0 = v_st(sr, sc), vst1 = v_st(32 + sr, sc), rws = rr * 128 + ((rc ^ ((rr >> 1) & 7)) << 4);
    const bf16_t* Kg = KN + (rowb + sr) * D + 128 * h + sc; const bf16_t* Vg = VBg + (rowb + sr) * D + 128 * h + sc; const bf16_t* Rg = KPE + (rowb + rr) * ROPE + rc * 8;
    bf16x8 st_k0, st_k1, st_v0, st_v1, st_r;
#define SLOAD(t) do { const size_t ko = (size_t)(t) * KVBLK * D; st_k0 = *reinterpret_cast<const bf16x8*>(Kg + ko); st_k1 = *reinterpret_cast<const bf16x8*>(Kg + ko + 32 * D); \
        st_v0 = *reinterpret_cast<const bf16x8*>(Vg + ko); st_v1 = *reinterpret_cast<const bf16x8*>(Vg + ko + 32 * D); st_r = *reinterpret_cast<const bf16x8*>(Rg + (size_t)(t) * KVBLK * ROPE); } while (0)
#define SWRITE(bf) do { *(bf16x8*)(lds + OFF_K + (bf) * SHM_K + kws) = st_k0; *(bf16x8*)(lds + OFF_K + (bf) * SHM_K + kws + 32 * 256) = st_k1; \
        *(bf16x8*)(lds + OFF_V + (bf) * SHM_V + vst0) = st_v0; *(bf16x8*)(lds + OFF_V + (bf) * SHM_V + vst1) = st_v1; *(bf16x8*)(lds + OFF_R + (bf) * SHM_R + rws) = st_r; } while (0)
    const int vb0 = (int)(uintptr_t)lds + v_rd_base(lane);
    float m_reg = -1e30f, l_reg = 0.f, alpha; f32x16 o[4] = {}; f32x16 p0, p1; bf16x8 pa0, pa1, pa2, pa3;
    SLOAD(0); SWRITE(0); __syncthreads();
#define STEP(t, CB) do { if ((t) + 1 < NT) SLOAD((t) + 1); SBAR();                                                            \
        qkt<CB>(p0, p1, lds, r32, hi, qr);                                                                                    \
        if (KVBLK * (t) + KVBLK - 1 > qlo) mask_tile(p0, p1, qm - KVBLK * (t));                                               \
        softmax_tile(p0, p1, m_reg, l_reg, alpha, pa0, pa1, pa2, pa3);                                                        \
        if (__any(alpha < 1.f)) { if (hi == 0) al_l[r32] = alpha; asm volatile("s_waitcnt lgkmcnt(0)" ::: "memory");         \
            _Pragma("unroll") for (int d_ = 0; d_ < 4; ++d_) _Pragma("unroll") for (int r = 0; r < 16; ++r) o[d_][r] *= al_l[crow(r, hi)]; } \
        SBAR(); pv_tile<CB>(o, vb0, pa0, pa1, pa2, pa3);                                                                      \
        if ((t) + 1 < NT) SWRITE(1 - (CB));                                                                                   \
        __syncthreads(); } while (0)
    for (int t = 0; t < NT; t += 2) { STEP(t, 0); STEP(t + 1, 1); }
#undef STEP
#undef SLOAD
#undef SWRITE
    if (hi == 0) li_l[r32] = l_reg; asm volatile("s_waitcnt lgkmcnt(0)" ::: "memory");
    float rli[16];
#pragma unroll
    for (int r = 0; r < 16; ++r) rli[r] = __builtin_amdgcn_rcpf(li_l[crow(r, hi)]);
    bf16_t* Ow = OB + (rowb + qlo) * D + 128 * h;
#pragma unroll
    for (int r = 0; r < 16; ++r) { const int orow = crow(r, hi);
#pragma unroll
        for (int d0 = 0; d0 < 4; ++d0) { const float v = o[d0][r] * rli[r]; const float vn = __shfl_xor(v, 1);
            if ((r32 & 1) == 0) *(unsigned*)(Ow + (size_t)orow * D + d0 * 32 + r32) = cvtpk(v, vn); } }
    __syncthreads();
}
constexpr int S4_R2 = 131584, S4_WS = S4_R2 + SHM_R;
static_assert(S4_WS + 2048 <= 155648, "lds");
constexpr int R3_V = 0, R3_K = 3 * SHM_V, R3_R = R3_K + 3 * SHM_K, R3_WS = R3_R + 3 * SHM_R;
__device__ __forceinline__ void qkt_rt(f32x16& p0, f32x16& p1, const char* lds, int kofs, int rofs, int r32, int hi, const bf16x8* qr) {
    p0 = f32x16{}; p1 = f32x16{};
    const char* kb[4];
#pragma unroll
    for (int dd = 0; dd < 4; ++dd) kb[dd] = lds + R3_K + kofs + KSWZ(r32, (dd * 16 + hi * 8) * 2);
#pragma unroll
    for (int d0 = 0; d0 < 8; ++d0) { const char* a = kb[d0 & 3] + (d0 >> 2) * 128;
        const bf16x8 b0 = *reinterpret_cast<const bf16x8*>(a), b1 = *reinterpret_cast<const bf16x8*>(a + 32 * 256);
        p0 = __builtin_amdgcn_mfma_f32_32x32x16_bf16(b0, qr[d0], p0, 0, 0, 0);
        p1 = __builtin_amdgcn_mfma_f32_32x32x16_bf16(b1, qr[d0], p1, 0, 0, 0); }
    const int sw = (r32 >> 1) & 7; const char* rb = lds + R3_R + rofs + r32 * 128;
#pragma unroll
    for (int s = 0; s < 4; ++s) { const char* a = rb + (((2 * s + hi) ^ sw) << 4);
        const bf16x8 b0 = *reinterpret_cast<const bf16x8*>(a), b1 = *reinterpret_cast<const bf16x8*>(a + 32 * 128);
        p0 = __builtin_amdgcn_mfma_f32_32x32x16_bf16(b0, qr[8 + s], p0, 0, 0, 0);
        p1 = __builtin_amdgcn_mfma_f32_32x32x16_bf16(b1, qr[8 + s], p1, 0, 0, 0); }
}
__device__ __forceinline__ void pv_rt(f32x16* o, int vb, bf16x8 pa0, bf16x8 pa1, bf16x8 pa2, bf16x8 pa3) {
#define TRRD(dst, off) asm volatile("ds_read_b64_tr_b16 %0, %1 offset:%2" : "=&v"(dst) : "v"(vb), "i"(off) : "memory")
#define PV_KS(ks, PA) do { s16x4 l0, l1, l2, l3, h0, h1, h2, h3; constexpr int b_ = R3_V + v_rd_off(0, ks, 0);   \
        TRRD(l0, b_); TRRD(h0, b_ + 2048); TRRD(l1, b_ + 512); TRRD(h1, b_ + 512 + 2048); TRRD(l2, b_ + 1024); TRRD(h2, b_ + 1024 + 2048); TRRD(l3, b_ + 1536); TRRD(h3, b_ + 1536 + 2048); \
        asm volatile("s_waitcnt lgkmcnt(0)" ::: "memory"); SBAR();   \
        o[0] = __builtin_amdgcn_mfma_f32_32x32x16_bf16(PA, (bf16x8){l0[0], l0[1], l0[2], l0[3], h0[0], h0[1], h0[2], h0[3]}, o[0], 0, 0, 0);   \
        o[1] = __builtin_amdgcn_mfma_f32_32x32x16_bf16(PA, (bf16x8){l1[0], l1[1], l1[2], l1[3], h1[0], h1[1], h1[2], h1[3]}, o[1], 0, 0, 0);   \
        o[2] = __builtin_amdgcn_mfma_f32_32x32x16_bf16(PA, (bf16x8){l2[0], l2[1], l2[2], l2[3], h2[0], h2[1], h2[2], h2[3]}, o[2], 0, 0, 0);   \
        o[3] = __builtin_amdgcn_mfma_f32_32x32x16_bf16(PA, (bf16x8){l3[0], l3[1], l3[2], l3[3], h3[0], h3[1], h3[2], h3[3]}, o[3], 0, 0, 0); } while (0)
    PV_KS(0, pa0); PV_KS(1, pa1); PV_KS(2, pa2); PV_KS(3, pa3);
#undef PV_KS
#undef TRRD
}
#ifndef PA_PF
#define PA_PF 5
#endif
__device__ __forceinline__ void qkt_pf(f32x16& p0, f32x16& p1, const char* lds, int kofs, int rofs, int r32, int hi, const bf16x8* qr) {
    p0 = f32x16{}; p1 = f32x16{};
    const char* kb[4];
#pragma unroll
    for (int dd = 0; dd < 4; ++dd) kb[dd] = lds + R3_K + kofs + KSWZ(r32, (dd * 16 + hi * 8) * 2);
    const int sw = (r32 >> 1) & 7; const char* rb = lds + R3_R + rofs + r32 * 128;
    bf16x8 f0[12], f1[12];
#define QK_LD(d) do { if ((d) < 8) { const char* a = kb[(d) & 3] + ((d) >> 2) * 128; f0[d] = *reinterpret_cast<const bf16x8*>(a); f1[d] = *reinterpret_cast<const bf16x8*>(a + 32 * 256); } \
                      else { const char* a = rb + (((2 * ((d) - 8) + hi) ^ sw) << 4); f0[d] = *reinterpret_cast<const bf16x8*>(a); f1[d] = *reinterpret_cast<const bf16x8*>(a + 32 * 128); } } while (0)
#pragma unroll
    for (int d = 0; d < PA_PF; ++d) QK_LD(d);
#pragma unroll
    for (int d = 0; d < 12; ++d) {
        if (d + PA_PF < 12) QK_LD(d + PA_PF);
        SBAR();
        p0 = __builtin_amdgcn_mfma_f32_32x32x16_bf16(f0[d], qr[d], p0, 0, 0, 0);
        p1 = __builtin_amdgcn_mfma_f32_32x32x16_bf16(f1[d], qr[d], p1, 0, 0, 0);
        SBAR(); }
#undef QK_LD
}
#define TRRD(dst, off) asm volatile("ds_read_b64_tr_b16 %0, %1 offset:%2" : "=&v"(dst) : "v"(vb_), "i"(off) : "memory")
#define PV_RD(ks, S) do { constexpr int b_ = R3_V + v_rd_off(0, ks, 0);   \
        TRRD(S[0], b_); TRRD(S[4], b_ + 2048); TRRD(S[1], b_ + 512); TRRD(S[5], b_ + 512 + 2048); TRRD(S[2], b_ + 1024); TRRD(S[6], b_ + 1024 + 2048); TRRD(S[3], b_ + 1536); TRRD(S[7], b_ + 1536 + 2048); } while (0)
#define PV_MM(PA, S) do { \
        o[0] = __builtin_amdgcn_mfma_f32_32x32x16_bf16(PA, (bf16x8){S[0][0], S[0][1], S[0][2], S[0][3], S[4][0], S[4][1], S[4][2], S[4][3]}, o[0], 0, 0, 0);   \
        o[1] = __builtin_amdgcn_mfma_f32_32x32x16_bf16(PA, (bf16x8){S[1][0], S[1][1], S[1][2], S[1][3], S[5][0], S[5][1], S[5][2], S[5][3]}, o[1], 0, 0, 0);   \
        o[2] = __builtin_amdgcn_mfma_f32_32x32x16_bf16(PA, (bf16x8){S[2][0], S[2][1], S[2][2], S[2][3], S[6][0], S[6][1], S[6][2], S[6][3]}, o[2], 0, 0, 0);   \
        o[3] = __builtin_amdgcn_mfma_f32_32x32x16_bf16(PA, (bf16x8){S[3][0], S[3][1], S[3][2], S[3][3], S[7][0], S[7][1], S[7][2], S[7][3]}, o[3], 0, 0, 0); } while (0)
#define PV_EARLY(VA, VB_) do { PV_RD(0, VA); PV_RD(1, VB_); } while (0)
#define PV_REST(VA, VB_) do {                                                                     \
    asm volatile("s_waitcnt lgkmcnt(8)" ::: "memory"); SBAR(); PV_MM(pa0, VA); SBAR();            \
    PV_RD(2, VA);                                                                                 \
    asm volatile("s_waitcnt lgkmcnt(8)" ::: "memory"); SBAR(); PV_MM(pa1, VB_); SBAR();           \
    PV_RD(3, VB_);                                                                                \
    asm volatile("s_waitcnt lgkmcnt(8)" ::: "memory"); SBAR(); PV_MM(pa2, VA); SBAR();            \
    asm volatile("s_waitcnt lgkmcnt(0)" ::: "memory"); SBAR(); PV_MM(pa3, VB_); } while (0)
#ifndef PA_QK
#define PA_QK qkt_pf
#endif
__device__ __forceinline__ void unit_dma(int b, int h, int qb, const bf16_t* __restrict__ QF, const bf16_t* __restrict__ KN, const bf16_t* __restrict__ KPE, const bf16_t* __restrict__ VBg, bf16_t* OB, char* lds, LAS unsigned char* ldsu) {
    const int tid = threadIdx.x, wid = __builtin_amdgcn_readfirstlane(tid >> 6), lane = tid & 63, r32 = lane & 31, hi = lane >> 5;
    const size_t rowb = (size_t)b * SEQ; const int q0 = qb * QB, qlo = q0 + wid * QBLK, qm = qlo + r32 - 4 * hi;
    const int NT = (q0 + QB) / KVBLK;
    float* wsf = (float*)(lds + R3_WS) + wid * 64; float* li_l = wsf; float* al_l = wsf + 32;
    bf16x8 qr[12];
    { const bf16_t* qp = QF + (rowb + qlo + r32) * NQ + HD * h + hi * 8;
#pragma unroll
      for (int d0 = 0; d0 < 12; ++d0) qr[d0] = *reinterpret_cast<const bf16x8*>(qp + d0 * 16); }
    const char* Kb = (const char*)(KN + rowb * D + 128 * h); const char* Vb = (const char*)(VBg + rowb * D + 128 * h); const char* Rb = (const char*)(KPE + rowb * ROPE);
    unsigned kof[2], vof[2], rof;
#pragma unroll
    for (int pi = 0; pi < 2; ++pi) { const int p = 2 * wid + pi, rw = 4 * pi + (lane >> 4);
        kof[pi] = (unsigned)((4 * p + (lane >> 4)) * (D * 2) + 16 * ((lane & 15) ^ (rw & 7)));
        const int kk = 8 * (p >> 1) + ((lane & 31) >> 2), key = (kk & ~0xC) | ((kk & 4) << 1) | ((kk & 8) >> 1), col = 32 * (2 * (p & 1) + (lane >> 5)) + 8 * (lane & 3);
        vof[pi] = (unsigned)(key * (D * 2) + col * 2); }
    { const int row = 8 * wid + (lane >> 3); rof = (unsigned)(row * (ROPE * 2) + 16 * ((lane & 7) ^ ((row >> 1) & 7))); }
#define DMA_TILE(t, ks_, vs_, rs_) do { const size_t kb_ = (size_t)(t) * KVBLK * (D * 2);                                                                \
        _Pragma("unroll") for (int pi = 0; pi < 2; ++pi) { const int p = 2 * wid + pi;                                                                 \
            __builtin_amdgcn_global_load_lds((const unsigned*)(Kb + kb_ + kof[pi]), (LAS unsigned*)(ldsu + R3_K + (ks_) + p * 1024), 16, 0, 0);        \
            __builtin_amdgcn_global_load_lds((const unsigned*)(Vb + kb_ + vof[pi]), (LAS unsigned*)(ldsu + R3_V + (vs_) + p * 1024), 16, 0, 0); }      \
        __builtin_amdgcn_global_load_lds((const unsigned*)(Rb + (size_t)(t) * KVBLK * (ROPE * 2) + rof), (LAS unsigned*)(ldsu + R3_R + (rs_) + wid * 1024), 16, 0, 0); } while (0)
    const int vb0 = (int)(uintptr_t)lds + v_rd_base(lane);
    float m_reg = -1e30f, l_reg = 0.f, alpha; f32x16 o[4] = {}; f32x16 p0, p1; bf16x8 pa0, pa1, pa2, pa3;
    DMA_TILE(0, 0, 0, 0); DMA_TILE(1, SHM_K, SHM_V, SHM_R);
    asm volatile("s_waitcnt vmcnt(5)" ::: "memory"); __builtin_amdgcn_s_barrier(); asm volatile("" ::: "memory");
    int s_cur = 0, s_nxt = 1, s_nn = 2;
    for (int t = 0; t < NT; ++t) {
        int kofs = s_cur * SHM_K, rofs = s_cur * SHM_R, vofs = s_cur * SHM_V; asm volatile("" : "+v"(kofs), "+v"(rofs), "+v"(vofs));
        if (t + 2 < NT) DMA_TILE(t + 2, s_nn * SHM_K, s_nn * SHM_V, s_nn * SHM_R);
        PA_QK(p0, p1, lds, kofs, rofs, r32, hi, qr);
        s16x4 VA[8], VB_[8]; const int vb_ = vb0 + vofs; SBAR(); PV_EARLY(VA, VB_); SBAR();
        if (KVBLK * t + KVBLK - 1 > qlo) mask_tile(p0, p1, qm - KVBLK * t);
        softmax_tile(p0, p1, m_reg, l_reg, alpha, pa0, pa1, pa2, pa3);
        if (__any(alpha < 1.f)) { if (hi == 0) al_l[r32] = alpha; asm volatile("s_waitcnt lgkmcnt(0)" ::: "memory");
#pragma unroll
            for (int d_ = 0; d_ < 4; ++d_)
#pragma unroll
                for (int r = 0; r < 16; ++r) o[d_][r] *= al_l[crow(r, hi)]; }
        SBAR(); PV_REST(VA, VB_);
        if (t + 2 < NT) asm volatile("s_waitcnt vmcnt(5) lgkmcnt(0)" ::: "memory"); else asm volatile("s_waitcnt vmcnt(0) lgkmcnt(0)" ::: "memory");
        __builtin_amdgcn_s_barrier(); asm volatile("" ::: "memory");
        const int tmp = s_cur; s_cur = s_nxt; s_nxt = s_nn; s_nn = tmp;
    }
#undef DMA_TILE
    if (hi == 0) li_l[r32] = l_reg; asm volatile("s_waitcnt lgkmcnt(0)" ::: "memory");
    float rli[16];
#pragma unroll
    for (int r = 0; r < 16; ++r) rli[r] = __builtin_amdgcn_rcpf(li_l[crow(r, hi)]);
    bf16_t* Ow = OB + (rowb + qlo) * D + 128 * h;
#pragma unroll
    for (int r = 0; r < 16; ++r) { const int orow = crow(r, hi);
#pragma unroll
        for (int d0 = 0; d0 < 4; ++d0) { const float v = o[d0][r] * rli[r]; const float vn = __shfl_xor(v, 1);
            if ((r32 & 1) == 0) *(unsigned*)(Ow + (size_t)orow * D + d0 * 32 + r32) = cvtpk(v, vn); } }
    asm volatile("s_waitcnt vmcnt(0) lgkmcnt(0)" ::: "memory"); __builtin_amdgcn_s_barrier(); asm volatile("" ::: "memory");
}
__device__ __forceinline__ void unit_stg(int b, int h, int qb, const bf16_t* __restrict__ QF, const bf16_t* __restrict__ KN, const bf16_t* __restrict__ KPE, const bf16_t* __restrict__ VBg, bf16_t* OB, char* lds, LAS unsigned char* ldsu) {
    int tid = threadIdx.x; asm volatile("" : "+v"(tid));
    const int wid = __builtin_amdgcn_readfirstlane(tid >> 6), lane = tid & 63, r32 = lane & 31, hi = lane >> 5;
    const size_t rowb = (size_t)b * SEQ; const int q0 = qb * QB, qlo = q0 + wid * QBLK, qm = qlo + r32 - 4 * hi;
    const int NT = (q0 + QB) / KVBLK;
    float* wsf = (float*)(lds + S4_WS) + wid * 64; float* li_l = wsf; float* al_l = wsf + 32;
    bf16x8 qr[12];
    { const bf16_t* qp = QF + (rowb + qlo + r32) * NQ + HD * h + hi * 8;
#pragma unroll
      for (int d0 = 0; d0 < 12; ++d0) qr[d0] = *reinterpret_cast<const bf16x8*>(qp + d0 * 16); }
    const char* Kb = (const char*)(KN + rowb * D + 128 * h); const char* Vb = (const char*)(VBg + rowb * D + 128 * h); const char* Rb = (const char*)(KPE + rowb * ROPE);
    unsigned kof[2], vof[2], rof;
#pragma unroll
    for (int pi = 0; pi < 2; ++pi) { const int p = 2 * wid + pi, rw = 4 * pi + (lane >> 4);
        kof[pi] = (unsigned)((4 * p + (lane >> 4)) * (D * 2) + 16 * ((lane & 15) ^ (rw & 7)));
        const int kk = 8 * (p >> 1) + ((lane & 31) >> 2), key = (kk & ~0xC) | ((kk & 4) << 1) | ((kk & 8) >> 1), col = 32 * (2 * (p & 1) + (lane >> 5)) + 8 * (lane & 3);
        vof[pi] = (unsigned)(key * (D * 2) + col * 2); }
    { const int row = 8 * wid + (lane >> 3); rof = (unsigned)(row * (ROPE * 2) + 16 * ((lane & 7) ^ ((row >> 1) & 7))); }
#define DMA_TILE(t, ks_, vs_, rs_) do { const size_t kb_ = (size_t)(t) * KVBLK * (D * 2);                                                                \
        _Pragma("unroll") for (int pi = 0; pi < 2; ++pi) { const int p = 2 * wid + pi;                                                                 \
            __builtin_amdgcn_global_load_lds((const unsigned*)(Kb + kb_ + kof[pi]), (LAS unsigned*)(ldsu + R3_K + (ks_) + p * 1024), 16, 0, 0);        \
            __builtin_amdgcn_global_load_lds((const unsigned*)(Vb + kb_ + vof[pi]), (LAS unsigned*)(ldsu + R3_V + (vs_) + p * 1024), 16, 0, 0); }      \
        __builtin_amdgcn_global_load_lds((const unsigned*)(Rb + (size_t)(t) * KVBLK * (ROPE * 2) + rof), (LAS unsigned*)(ldsu + R3_R + (rs_) + wid * 1024), 16, 0, 0); } while (0)
    const int vb0 = (int)(uintptr_t)lds + v_rd_base(lane);
    float m_reg = -1e30f, l_reg = 0.f, alpha; f32x16 o[4] = {}; f32x16 p0, p1; bf16x8 pa0, pa1, pa2, pa3;
#define S4_KOFS(sl_) (16384 + (sl_) * SHM_K)
#define S4_ROFS(sl_) ((sl_) == 0 ? 16384 : (sl_) == 1 ? 24576 : (S4_R2 - R3_R))
    const bool grpB = wid >= 4;
    DMA_TILE(0, S4_KOFS(0), 0, S4_ROFS(0)); DMA_TILE(1, S4_KOFS(1), SHM_V, S4_ROFS(1));
    asm volatile("s_waitcnt vmcnt(5)" ::: "memory"); __builtin_amdgcn_s_barrier(); asm volatile("" ::: "memory");
    int s_cur = 0, s_nxt = 1, s_nn = 2;
#define STG_WAIT(t) do { if ((t) + 2 < NT) asm volatile("s_waitcnt vmcnt(5) lgkmcnt(0)" ::: "memory"); else asm volatile("s_waitcnt vmcnt(0) lgkmcnt(0)" ::: "memory");   \
        __builtin_amdgcn_s_barrier(); asm volatile("" ::: "memory"); { const int tmp = s_cur; s_cur = s_nxt; s_nxt = s_nn; s_nn = tmp; } } while (0)
#define STG_RESCALE() do { if (__any(alpha < 1.f)) { if (hi == 0) al_l[r32] = alpha; asm volatile("s_waitcnt lgkmcnt(0)" ::: "memory");                    \
            _Pragma("unroll") for (int d_ = 0; d_ < 4; ++d_) _Pragma("unroll") for (int r = 0; r < 16; ++r) o[d_][r] *= al_l[crow(r, hi)]; } } while (0)
    if (!grpB) {
        for (int t = 0; t < NT; ++t) {
            int kofs = S4_KOFS(s_cur), rofs = S4_ROFS(s_cur), vofs = (t & 3) * SHM_V; asm volatile("" : "+v"(kofs), "+v"(rofs), "+v"(vofs));
            if (t + 2 < NT) DMA_TILE(t + 2, S4_KOFS(s_nn), ((t + 2) & 3) * SHM_V, S4_ROFS(s_nn));
            PA_QK(p0, p1, lds, kofs, rofs, r32, hi, qr);
            s16x4 VA[8], VB_[8]; const int vb_ = vb0 + vofs; SBAR(); PV_EARLY(VA, VB_); SBAR();
            if (KVBLK * t + KVBLK - 1 > qlo) mask_tile(p0, p1, qm - KVBLK * t);
            softmax_tile(p0, p1, m_reg, l_reg, alpha, pa0, pa1, pa2, pa3);
            STG_RESCALE();
            SBAR(); PV_REST(VA, VB_);
            STG_WAIT(t);
        }
    } else {
        for (int t = 0; t < NT; ++t) {
            int kofs = S4_KOFS(s_cur), rofs = S4_ROFS(s_cur), vofs = ((t + 3) & 3) * SHM_V; asm volatile("" : "+v"(kofs), "+v"(rofs), "+v"(vofs));
            if (t + 2 < NT) DMA_TILE(t + 2, S4_KOFS(s_nn), ((t + 2) & 3) * SHM_V, S4_ROFS(s_nn));
            if (t > 0) { s16x4 VA[8], VB_[8]; const int vb_ = vb0 + vofs; SBAR(); PV_EARLY(VA, VB_); SBAR(); PV_REST(VA, VB_); SBAR(); }
            PA_QK(p0, p1, lds, kofs, rofs, r32, hi, qr);
            if (KVBLK * t + KVBLK - 1 > qlo) mask_tile(p0, p1, qm - KVBLK * t);
            softmax_tile(p0, p1, m_reg, l_reg, alpha, pa0, pa1, pa2, pa3);
            STG_RESCALE();
            STG_WAIT(t);
        }
        { const int vofs = ((NT + 3) & 3) * SHM_V; s16x4 VA[8], VB_[8]; const int vb_ = vb0 + vofs; SBAR(); PV_EARLY(VA, VB_); SBAR(); PV_REST(VA, VB_); SBAR(); }
    }
#undef STG_WAIT
#undef STG_RESCALE
#undef S4_KOFS
#undef S4_ROFS
#undef DMA_TILE
    if (hi == 0) li_l[r32] = l_reg; asm volatile("s_waitcnt lgkmcnt(0)" ::: "memory");
    float rli[16];
#pragma unroll
    for (int r = 0; r < 16; ++r) rli[r] = __builtin_amdgcn_rcpf(li_l[crow(r, hi)]);
    bf16_t* Ow = OB + (rowb + qlo) * D + 128 * h;
#pragma unroll
    for (int r = 0; r < 16; ++r) { const int orow = crow(r, hi);
#pragma unroll
        for (int d0 = 0; d0 < 4; ++d0) { const float v = o[d0][r] * rli[r]; const float vn = __shfl_xor(v, 1);
            if ((r32 & 1) == 0) *(unsigned*)(Ow + (size_t)orow * D + d0 * 32 + r32) = cvtpk(v, vn); } }
    asm volatile("s_waitcnt vmcnt(0) lgkmcnt(0)" ::: "memory"); __builtin_amdgcn_s_barrier(); asm volatile("" ::: "memory");
}
}

namespace sa {
constexpr int TILE = 16384;
struct Src { const bf16_t* CLB; const float* CKF; const int* PT; const float* RP; const bf16_t* LATB; const bf16_t* KPEB; const float* RTS; const unsigned char* CL8; const float* SC2; };
#ifndef SA_INT8
#define SA_INT8 1
#endif
__device__ __forceinline__ int offa(int row, int ch) { return 2048 * (row >> 3) + 512 * (ch >> 2) + 64 * (row & 7) + 16 * ((ch & 3) ^ ((row >> 2) & 3)); }
__device__ __forceinline__ v4u widen8(u32x2 w) {
    const unsigned x0 = w.x ^ 0x80808080u, x1 = w.y ^ 0x80808080u; v4u o;
    o.x = cvt_pk_bf16((float)(x0 & 255u), (float)((x0 >> 8) & 255u)); o.y = cvt_pk_bf16((float)((x0 >> 16) & 255u), (float)(x0 >> 24));
    o.z = cvt_pk_bf16((float)(x1 & 255u), (float)((x1 >> 8) & 255u)); o.w = cvt_pk_bf16((float)((x1 >> 16) & 255u), (float)(x1 >> 24)); return o;
}
template <bool TAIL, bool Q8 = false>
__device__ __forceinline__ void tile(const Src& S, int b, int k0, LAS unsigned char* ldsu, char* lds, int wid, int lane, f32x16 (&o)[8], float& m_reg, float& l_reg, float* al_l, int tbase, float& lb, float cb) {
    asm volatile("" : "+v"(lane));
    const int r32 = lane & 31, hi = lane >> 5, h = r32 & 7;
    LAS unsigned char* tl = ldsu + tbase + wid * TILE; const char* tg = lds + tbase + wid * TILE;
    asm volatile("s_waitcnt lgkmcnt(0)" ::: "memory");
    {
        const int rlo = (lane >> 2) & 7, chh = lane >> 5, x4 = (lane >> 4) & 1;
        if constexpr (TAIL) {
            const char* ub = (const char*)(S.LATB + (size_t)(TP + 4 * b) * KVR);
#pragma unroll
            for (int P = 0; P < 16; ++P) { const int img = P >> 3, pp = P & 7, row = 8 * (pp >> 1) + rlo, ch = 8 * (pp & 1) + 4 * chh + ((lane & 3) ^ (2 * ((pp >> 1) & 1) + x4));
                const unsigned lo = (unsigned)((row < 3 ? row : 3) * (KVR * 2) + (128 * img + 8 * ch) * 2);
                __builtin_amdgcn_global_load_lds((const unsigned*)(ub + lo), (LAS unsigned*)(tl + P * 1024), 16, 0, 0); }
        } else if constexpr (Q8) {
            const char* ub = (const char*)S.CL8 + ((size_t)b * SEQ + k0) * KVR + 16 * lane;
#pragma unroll
            for (int P = 0; P < 8; ++P) __builtin_amdgcn_global_load_lds((const unsigned*)(ub + P * 1024), (LAS unsigned*)(tl + 8192 + P * 1024), 16, 0, 0);
        } else {
            const char* ub = (const char*)(S.CLB + ((size_t)b * SEQ + k0) * KVR);
            const unsigned loA = (unsigned)(rlo * 512 + 64 * chh + 16 * ((lane & 3) ^ x4)), loB = (unsigned)(rlo * 512 + 64 * chh + 16 * ((lane & 3) ^ (2 + x4)));
#pragma unroll
            for (int P = 0; P < 16; ++P) { const int img = P >> 3, pp = P & 7; const unsigned cst = (unsigned)((8 * (pp >> 1)) * 512 + 256 * img + 128 * (pp & 1));
                __builtin_amdgcn_global_load_lds((const unsigned*)(ub + cst + (((pp >> 1) & 1) ? loB : loA)), (LAS unsigned*)(tl + P * 1024), 16, 0, 0); }
        }
    }
    bf16x8 kp[4]; float rf[16];
    {
        if constexpr (TAIL) { const bf16_t* kr = S.KPEB + (size_t)(TP + 4 * b + (r32 < 3 ? r32 : 3)) * ROPE;
#pragma unroll
            for (int s = 0; s < 4; ++s) kp[s] = *reinterpret_cast<const bf16x8*>(kr + 16 * s + 8 * hi);
        } else {
            const int phys = S.PT[b * NPG + (k0 >> 7)];
            const float* kr = S.CKF + ((size_t)phys * PAGE + (k0 & (PAGE - 1)) + r32) * ROPE + 8 * hi;
#pragma unroll
            for (int s = 0; s < 4; ++s) { const f32x4 x0 = *(const f32x4*)(kr + 16 * s), x1 = *(const f32x4*)(kr + 16 * s + 4);
                u32x4 w = {cvt_pk_bf16(x0[0], x0[1]), cvt_pk_bf16(x0[2], x0[3]), cvt_pk_bf16(x1[0], x1[1]), cvt_pk_bf16(x1[2], x1[3])}; kp[s] = *reinterpret_cast<bf16x8*>(&w); }
        }
        if constexpr (TAIL) {
#pragma unroll
            for (int r = 0; r < 16; ++r) { const int j = crow(r, hi), jc = j < 3 ? j : 3; rf[r] = S.RTS[(4 * b + jc) * 8 + h]; }
        } else {
            const float* r0 = S.RP + (size_t)(2 * h) * NCK + (size_t)b * SEQ + k0 + 4 * hi;
#pragma unroll
            for (int j = 0; j < 4; ++j) { const f32x4 a = *(const f32x4*)(r0 + 8 * j) + *(const f32x4*)(r0 + NCK + 8 * j);
#pragma unroll
                for (int e = 0; e < 4; ++e) rf[4 * j + e] = a[e]; }
            if constexpr (Q8) {
                const float* s0 = S.SC2 + (size_t)b * SEQ + k0 + 4 * hi;
#pragma unroll
                for (int j = 0; j < 4; ++j) { f32x4 sv = *(const f32x4*)(s0 + 8 * j);
#pragma unroll
                    for (int e = 0; e < 4; ++e) { const float s2 = sv[e]; sv[e] = sqrtf(s2); rf[4 * j + e] = rsq(rf[4 * j + e] * s2 * (1.0f / 128) + EPS) * sv[e]; }
                    if (r32 == 0) *(f32x4*)(al_l + 32 + 8 * j + 4 * hi) = sv; }
            }
        }
    }
    asm volatile("s_waitcnt vmcnt(0)" ::: "memory");
    if constexpr (Q8 && !TAIL) {
        const int c8 = lane & 15, r0 = lane >> 4; const char* st = tg + 8192;
#pragma unroll
        for (int i = 0; i < 8; ++i) { const int row = r0 + 4 * i; *(v4u*)(const_cast<char*>(tg) + offa(row, c8)) = widen8(*(const u32x2*)(st + row * 256 + 8 * c8)); }
        u32x2 wb[8];
#pragma unroll
        for (int i = 0; i < 8; ++i) wb[i] = *(const u32x2*)(st + (r0 + 4 * i) * 256 + 128 + 8 * c8);
        asm volatile("s_waitcnt lgkmcnt(0)" ::: "memory");
#pragma unroll
        for (int i = 0; i < 8; ++i) *(v4u*)(const_cast<char*>(tg) + 8192 + offa(r0 + 4 * i, c8)) = widen8(wb[i]);
        asm volatile("s_waitcnt lgkmcnt(0)" ::: "memory");
    }
    f32x16 p = {}, pn = {};
    {
        const int x = (r32 >> 2) & 3; const char* kbase = tg + 2048 * (r32 >> 3) + 64 * (r32 & 7);
        const char* kE = kbase + 16 * (hi ^ x); const char* kO = kbase + 16 * ((2 + hi) ^ x);
        const char* qb = lds + QS_OFF + r32 * QS_STRIDE + hi * 16;
#pragma unroll
        for (int s = 0; s < 4; ++s) p = __builtin_amdgcn_mfma_f32_32x32x16_bf16(kp[s], *reinterpret_cast<const bf16x8*>(qb + (16 + s) * 32), p, 0, 0, 0);
#pragma unroll
        for (int s = 0; s < 16; ++s) { const int img = s >> 3, ss = s & 7; const char* a = ((ss & 1) ? kO : kE) + 8192 * img + 512 * (ss >> 1);
            pn = __builtin_amdgcn_mfma_f32_32x32x16_bf16(*reinterpret_cast<const bf16x8*>(a), *reinterpret_cast<const bf16x8*>(qb + s * 32), pn, 0, 0, 0); }
    }
#pragma unroll
    for (int r = 0; r < 16; ++r) p[r] = (Q8 && !TAIL) ? (pn[r] - cb) * rf[r] + p[r] : pn[r] * (TAIL ? rf[r] : rsq(rf[r] * (1.0f / 128) + EPS)) + p[r];
    if constexpr (TAIL) { const int q = r32 >> 3;
#pragma unroll
        for (int r = 0; r < 16; ++r) if (crow(r, hi) > q) p[r] = -__builtin_inff(); }
    float pmax = p[0];
#pragma unroll
    for (int r = 1; r < 16; ++r) pmax = fmaxf(pmax, p[r]);
    pmax = xmax32(pmax);
    float mn, alpha;
    if (__builtin_expect(__all((pmax - m_reg) <= THR), 1)) { mn = m_reg; alpha = 1.f; }
    else { mn = fmaxf(m_reg, pmax); alpha = __builtin_amdgcn_exp2f(m_reg - mn); m_reg = mn; }
    float ps = 0.f;
#pragma unroll
    for (int r = 0; r < 16; ++r) { p[r] = __builtin_amdgcn_exp2f(p[r] - mn); ps += p[r]; }
    ps = xsum32(ps); l_reg = l_reg * alpha + ps;
    if constexpr (Q8 && !TAIL) {
#pragma unroll
        for (int j = 0; j < 4; ++j) { const f32x4 sv = *(const f32x4*)(al_l + 32 + 8 * j + 4 * hi);
#pragma unroll
            for (int e = 0; e < 4; ++e) p[4 * j + e] *= sv[e]; }
    }
    bf16x8 pa0, pa1; PK4(p, 0, pa0); PK4(p, 8, pa1);
    if constexpr (Q8) {
        float bs = 0.f;
        if constexpr (!TAIL) { const u32x4 w0 = *reinterpret_cast<const u32x4*>(&pa0), w1 = *reinterpret_cast<const u32x4*>(&pa1);
#pragma unroll
            for (int e = 0; e < 4; ++e) bs += (bflo(w0[e]) + bfhi(w0[e])) + (bflo(w1[e]) + bfhi(w1[e]));
            bs = xsum32(bs); }
        lb = lb * alpha + bs;
    }
    if (__any(alpha < 1.f)) { if (hi == 0) al_l[r32] = alpha; asm volatile("s_waitcnt lgkmcnt(0)" ::: "memory");
#pragma unroll
        for (int c = 0; c < 8; ++c)
#pragma unroll
            for (int r = 0; r < 16; ++r) o[c][r] *= al_l[crow(r, hi)]; }
    {
        const int hh = lane >> 5, blk = (lane >> 4) & 1, q4 = (lane & 15) >> 2, pp = lane & 3;
        const int tb = (int)(uintptr_t)tg + 2048 * hh + 64 * q4 + 8 * (pp & 1);
        const int t0 = tb + 16 * ((2 * blk + (pp >> 1)) ^ (2 * hh)), t1 = tb + 256 + 16 * ((2 * blk + (pp >> 1)) ^ (2 * hh + 1));
#define TR0(dst, off) asm volatile("ds_read_b64_tr_b16 %0, %1 offset:%2" : "=&v"(dst) : "v"(t0), "i"(off) : "memory")
#define TR1(dst, off) asm volatile("ds_read_b64_tr_b16 %0, %1 offset:%2" : "=&v"(dst) : "v"(t1), "i"(off) : "memory")
#define PVC(c) do { s16x4 a0, a1, b0, b1; constexpr int f_ = 8192 * ((c) >> 2) + 512 * ((c) & 3);                               \
        TR0(a0, f_); TR1(a1, f_); TR0(b0, f_ + 4096); TR1(b1, f_ + 4096);                                                        \
        asm volatile("s_waitcnt lgkmcnt(0)" ::: "memory"); SBAR();                                                                \
        o[c] = __builtin_amdgcn_mfma_f32_32x32x16_bf16(pa0, (bf16x8){a0[0], a0[1], a0[2], a0[3], a1[0], a1[1], a1[2], a1[3]}, o[c], 0, 0, 0); \
        o[c] = __builtin_amdgcn_mfma_f32_32x32x16_bf16(pa1, (bf16x8){b0[0], b0[1], b0[2], b0[3], b1[0], b1[1], b1[2], b1[3]}, o[c], 0, 0, 0); } while (0)
        PVC(0); PVC(1); PVC(2); PVC(3); PVC(4); PVC(5); PVC(6); PVC(7);
#undef PVC
#undef TR0
#undef TR1
    }
}
__device__ __forceinline__ void unit(const Src& S, const bf16_t* QS, float* PO, float* PML, int b, int s, LAS unsigned char* ldsu, char* lds) {
    int tid = threadIdx.x; asm volatile("" : "+v"(tid));
    const int wid = __builtin_amdgcn_readfirstlane(tid >> 6), lane = tid & 63, r32 = lane & 31, hi = lane >> 5;
    for (int c = tid; c < 32 * 40; c += 512) { const int rho = c / 40, ch = c % 40; *(v4u*)(lds + QS_OFF + rho * QS_STRIDE + ch * 16) = *(const v4u*)(QS + ((size_t)b * 32 + rho) * 320 + ch * 8); }
    __syncthreads();
    float* al_l = (float*)(lds + SCR_OFF) + wid * 64;
    float m_reg = -1e30f, l_reg = 0.f, lb = 0.f, cb = 0.f; f32x16 o[8] = {};
    if (SA_INT8) { const char* qrow = lds + QS_OFF + r32 * QS_STRIDE;
#pragma unroll 8
        for (int ch = 0; ch < 32; ++ch) { const v4u q = *(const v4u*)(qrow + 16 * ch); cb += (bflo(q.x) + bfhi(q.x)) + (bflo(q.y) + bfhi(q.y)) + (bflo(q.z) + bfhi(q.z)) + (bflo(q.w) + bfhi(q.w)); }
        cb *= 128.0f; }
    const int kbase = (8 * s + wid) * 512;
    for (int i = 0; i < 16; ++i) tile<false, SA_INT8 != 0>(S, b, kbase + 32 * i, ldsu, lds, wid, lane, o, m_reg, l_reg, al_l, 0, lb, cb);
    if (s == 1 && wid == 7) tile<true, SA_INT8 != 0>(S, b, 0, ldsu, lds, wid, lane, o, m_reg, l_reg, al_l, 0, lb, cb);
    asm volatile("s_waitcnt lgkmcnt(0)" ::: "memory");
    if (SA_INT8) {
        if (hi == 0) al_l[r32] = lb; asm volatile("s_waitcnt lgkmcnt(0)" ::: "memory");
#pragma unroll
        for (int r = 0; r < 16; ++r) { const float corr = 128.0f * al_l[crow(r, hi)];
#pragma unroll
            for (int c = 0; c < 8; ++c) o[c][r] -= corr; }
        asm volatile("s_waitcnt lgkmcnt(0)" ::: "memory");
    }
    __syncthreads();
    float* ST = (float*)(lds + 32768);
    float* OL = (float*)lds;
    if (hi == 0) { ST[(wid * 32 + r32) * 2] = m_reg; ST[(wid * 32 + r32) * 2 + 1] = l_reg; }
    __syncthreads();
    float sc[16];
#pragma unroll
    for (int r = 0; r < 16; ++r) { const int row = crow(r, hi); float M = ST[row * 2];
#pragma unroll
        for (int w = 1; w < 8; ++w) M = fmaxf(M, ST[(w * 32 + row) * 2]);
        sc[r] = __builtin_amdgcn_exp2f(ST[(wid * 32 + row) * 2] - M); }
    for (int w = 0; w < 8; ++w) {
        if (wid == w) {
#pragma unroll
            for (int c = 0; c < 8; ++c)
#pragma unroll
                for (int r = 0; r < 16; ++r) { float* d = OL + crow(r, hi) * 256 + 32 * c + r32; const float v = o[c][r] * sc[r]; *d = (w == 0) ? v : *d + v; }
        }
        __syncthreads();
    }
    if (tid < 32) { float M = ST[tid * 2];
        for (int w = 1; w < 8; ++w) M = fmaxf(M, ST[(w * 32 + tid) * 2]);
        float L = 0.f; for (int w = 0; w < 8; ++w) L += ST[(w * 32 + tid) * 2 + 1] * __builtin_amdgcn_exp2f(ST[(w * 32 + tid) * 2] - M);
        PML[((size_t)(b * 2 + s) * 32 + tid) * 2] = M; PML[((size_t)(b * 2 + s) * 32 + tid) * 2 + 1] = L; }
    for (int c = tid; c < 32 * 64; c += 512) *((f32x4*)(PO + (size_t)(b * 2 + s) * 32 * 256) + c) = *((const f32x4*)OL + c);
    __syncthreads();
}
}

__device__ __forceinline__ void grp_barrier(volatile LAS unsigned* cnt, unsigned& epoch, unsigned nw, int lane) {
    asm volatile("s_waitcnt vmcnt(0) lgkmcnt(0)" ::: "memory");
    epoch += nw;
    if (lane == 0) __hip_atomic_fetch_add((LAS unsigned*)cnt, 1u, __ATOMIC_RELAXED, __HIP_MEMORY_SCOPE_WORKGROUP);
    while ((int)(*cnt - epoch) < 0) __builtin_amdgcn_s_sleep(0);
    asm volatile("" ::: "memory");
}
namespace pa4 {
using namespace pa;
constexpr int QB4 = 128, OFF_WS4 = SCR_OFF + 1024;
__device__ __forceinline__ void unit(int b, int h, int qb, const bf16_t* __restrict__ QF, const bf16_t* __restrict__ KN, const bf16_t* __restrict__ KPE, const bf16_t* __restrict__ VBg, bf16_t* OB,
                                     char* lds, LAS unsigned char* ldsu, volatile LAS unsigned* cnt, unsigned& epoch) {
    const int tid = threadIdx.x, wid = __builtin_amdgcn_readfirstlane(tid >> 6), lane = tid & 63, r32 = lane & 31, hi = lane >> 5;
    const size_t rowb = (size_t)b * SEQ; const int q0 = qb * QB4, qlo = q0 + wid * QBLK, qm = qlo + r32 - 4 * hi;
    const int NT = (q0 + QB4) / KVBLK;
    float* wsf = (float*)(lds + OFF_WS4) + wid * 64; float* li_l = wsf; float* al_l = wsf + 32;
    bf16x8 qr[12];
    { const bf16_t* qp = QF + (rowb + qlo + r32) * NQ + HD * h + hi * 8;
#pragma unroll
      for (int d0 = 0; d0 < 12; ++d0) qr[d0] = *reinterpret_cast<const bf16x8*>(qp + d0 * 16); }
    const char* Kb = (const char*)(KN + rowb * D + 128 * h); const char* Vb = (const char*)(VBg + rowb * D + 128 * h); const char* Rb = (const char*)(KPE + rowb * ROPE);
    unsigned kof[2], vof[4], rof[2];
#pragma unroll
    for (int e = 0; e < 2; ++e) { const int rw = 4 * e + (lane >> 4); kof[e] = (unsigned)((lane >> 4) * (D * 2) + 16 * ((lane & 15) ^ (rw & 7))); }
#pragma unroll
    for (int pi = 0; pi < 4; ++pi) { const int p = 4 * wid + pi, kk = 8 * (p >> 1) + ((lane & 31) >> 2), key = (kk & ~0xC) | ((kk & 4) << 1) | ((kk & 8) >> 1), col = 32 * (2 * (p & 1) + (lane >> 5)) + 8 * (lane & 3);
        vof[pi] = (unsigned)(key * (D * 2) + col * 2); }
#pragma unroll
    for (int pi = 0; pi < 2; ++pi) { const int p = 2 * wid + pi, row = 8 * p + (lane >> 3); rof[pi] = (unsigned)(row * (ROPE * 2) + 16 * ((lane & 7) ^ ((row >> 1) & 7))); }
#define DMA_TILE(t, bf) do { const size_t kb_ = (size_t)(t) * KVBLK * (D * 2);                                                                          \
        _Pragma("unroll") for (int pi = 0; pi < 4; ++pi) { const int p = 4 * wid + pi;                                                                 \
            __builtin_amdgcn_global_load_lds((const unsigned*)(Kb + kb_ + (size_t)(4 * p) * (D * 2) + kof[pi & 1]), (LAS unsigned*)(ldsu + OFF_K + (bf) * SHM_K + p * 1024), 16, 0, 0); \
            __builtin_amdgcn_global_load_lds((const unsigned*)(Vb + kb_ + vof[pi]), (LAS unsigned*)(ldsu + OFF_V + (bf) * SHM_V + p * 1024), 16, 0, 0); }  \
        _Pragma("unroll") for (int pi = 0; pi < 2; ++pi) { const int p = 2 * wid + pi;                                                                 \
            __builtin_amdgcn_global_load_lds((const unsigned*)(Rb + (size_t)(t) * KVBLK * (ROPE * 2) + rof[pi]), (LAS unsigned*)(ldsu + OFF_R + (bf) * SHM_R + p * 1024), 16, 0, 0); } } while (0)
    const int vb0 = (int)(uintptr_t)lds + v_rd_base(lane);
    float m_reg = -1e30f, l_reg = 0.f, alpha; f32x16 o[4] = {}; f32x16 p0, p1; bf16x8 pa0, pa1, pa2, pa3;
    DMA_TILE(0, 0); grp_barrier(cnt, epoch, 4u, lane);
#define STEP4(t, CB) do { if ((t) + 1 < NT) DMA_TILE((t) + 1, 1 - (CB));                                                      \
        qkt<CB>(p0, p1, lds, r32, hi, qr);                                                                                    \
        if (KVBLK * (t) + KVBLK - 1 > qlo) mask_tile(p0, p1, qm - KVBLK * (t));                                               \
        softmax_tile(p0, p1, m_reg, l_reg, alpha, pa0, pa1, pa2, pa3);                                                        \
        if (__any(alpha < 1.f)) { if (hi == 0) al_l[r32] = alpha; asm volatile("s_waitcnt lgkmcnt(0)" ::: "memory");         \
            _Pragma("unroll") for (int d_ = 0; d_ < 4; ++d_) _Pragma("unroll") for (int r = 0; r < 16; ++r) o[d_][r] *= al_l[crow(r, hi)]; } \
        pv_tile<CB>(o, vb0, pa0, pa1, pa2, pa3);                                                                      \
        grp_barrier(cnt, epoch, 4u, lane); } while (0)
    for (int t = 0; t < NT; t += 2) { STEP4(t, 0); STEP4(t + 1, 1); }
#undef STEP4
#undef DMA_TILE
    if (hi == 0) li_l[r32] = l_reg; asm volatile("s_waitcnt lgkmcnt(0)" ::: "memory");
    float rli[16];
#pragma unroll
    for (int r = 0; r < 16; ++r) rli[r] = __builtin_amdgcn_rcpf(li_l[crow(r, hi)]);
    bf16_t* Ow = OB + (rowb + qlo) * D + 128 * h;
#pragma unroll
    for (int r = 0; r < 16; ++r) { const int orow = crow(r, hi);
#pragma unroll
        for (int d0 = 0; d0 < 4; ++d0) { const float v = o[d0][r] * rli[r]; const float vn = __shfl_xor(v, 1);
            if ((r32 & 1) == 0) *(unsigned*)(Ow + (size_t)orow * D + d0 * 32 + r32) = cvtpk(v, vn); } }
    asm volatile("s_waitcnt lgkmcnt(0)" ::: "memory");
}
}
namespace sa3 {
using namespace sa;
constexpr int TB = 81920;
__device__ __forceinline__ void unit(const Src& S, const bf16_t* QS, float* PO, float* PML, int b, int s, LAS unsigned char* ldsu, char* lds, volatile LAS unsigned* cnt, unsigned& epoch) {
    const int tid = threadIdx.x - 256, j = __builtin_amdgcn_readfirstlane(tid >> 6), lane = tid & 63, r32 = lane & 31, hi = lane >> 5;
    for (int c = tid; c < 32 * 40; c += 192) { const int rho = c / 40, ch = c % 40; *(v4u*)(lds + QS_OFF + rho * QS_STRIDE + ch * 16) = *(const v4u*)(QS + ((size_t)b * 32 + rho) * 320 + ch * 8); }
    grp_barrier(cnt, epoch, 3u, lane);
    float* al_l = (float*)(lds + SCR_OFF) + j * 64;
    float m_reg = -1e30f, l_reg = 0.f; f32x16 o[8] = {};
    for (int i = j; i < 128; i += 3) { float lb_ = 0.f; tile<false>(S, b, s * 4096 + 32 * i, ldsu, lds, j, lane, o, m_reg, l_reg, al_l, TB, lb_, 0.f); }
    if (s == 1 && j == 2) { float lb_ = 0.f; tile<true>(S, b, 0, ldsu, lds, j, lane, o, m_reg, l_reg, al_l, TB, lb_, 0.f); }
    grp_barrier(cnt, epoch, 3u, lane);
    float* OL = (float*)(lds + TB);
    float* ST = (float*)(lds + TB + 32768);
    if (hi == 0) { ST[(j * 32 + r32) * 2] = m_reg; ST[(j * 32 + r32) * 2 + 1] = l_reg; }
    grp_barrier(cnt, epoch, 3u, lane);
    float sc[16];
#pragma unroll
    for (int r = 0; r < 16; ++r) { const int row = crow(r, hi); const float M = fmaxf(fmaxf(ST[row * 2], ST[(32 + row) * 2]), ST[(64 + row) * 2]);
        sc[r] = __builtin_amdgcn_exp2f(ST[(j * 32 + row) * 2] - M); }
    for (int w = 0; w < 3; ++w) {
        if (j == w) {
#pragma unroll
            for (int c = 0; c < 8; ++c)
#pragma unroll
                for (int r = 0; r < 16; ++r) { float* d = OL + crow(r, hi) * 256 + 32 * c + r32; const float v = o[c][r] * sc[r]; *d = (w == 0) ? v : *d + v; }
        }
        grp_barrier(cnt, epoch, 3u, lane);
    }
    if (tid < 32) { const float M = fmaxf(fmaxf(ST[tid * 2], ST[(32 + tid) * 2]), ST[(64 + tid) * 2]);
        float L = 0.f; for (int w = 0; w < 3; ++w) L += ST[(w * 32 + tid) * 2 + 1] * __builtin_amdgcn_exp2f(ST[(w * 32 + tid) * 2] - M);
        PML[((size_t)(b * 2 + s) * 32 + tid) * 2] = M; PML[((size_t)(b * 2 + s) * 32 + tid) * 2 + 1] = L; }
    for (int c = tid; c < 32 * 64; c += 192) *((f32x4*)(PO + (size_t)(b * 2 + s) * 32 * 256) + c) = *((const f32x4*)OL + c);
    grp_barrier(cnt, epoch, 3u, lane);
}
}
#undef SBAR
#undef PK4
}

#ifndef MK_SPLIT
#define MK_SPLIT 0
#endif
struct RangeOrder {
    int g0, n;
    __device__ __forceinline__ bool next(int i, pg8::Unit& u) const { if (i >= n) return false; const int g = g0 + i; u.pm = g >> 2; u.pn = g & 3; u.ko = 0; return true; }
    __device__ __forceinline__ void a_ready(const pg8::Unit&) const {}
    __device__ __forceinline__ void done(const pg8::Unit&) const {}
};
struct SplitOrder {
    int j, ns;
    __device__ __forceinline__ bool next(int i, pg8::Unit& u) const { if (i > 0 || j >= 8 * ns) return false; const int t = j / ns; u.pm = t >> 2; u.pn = t & 3; u.ko = (j % ns) * 512; return true; }
    __device__ __forceinline__ void a_ready(const pg8::Unit&) const {}
    __device__ __forceinline__ void done(const pg8::Unit&) const {}
};
constexpr int NSLOT = 11, R_UNITS = (NCK / 256) * 4;
constexpr int FILL_REM[NSLOT] = {172, 8, 24, 32, 172, 8, 48, 8, 132, 16, 140};
constexpr int FILL_PER[NSLOT] = {3, 17, 4, 1, 3, 17, 0, 17, 4, 0, 2};
constexpr int fill_start(int s) { int a = 0; for (int j = 0; j < s; ++j) a += (256 - FILL_REM[j]) * FILL_PER[j]; return a; }
static_assert(fill_start(NSLOT) <= R_UNITS, "filler");
#ifndef R_SP2
#define R_SP2 PG8_SP2
#endif
constexpr int NPHASE = 20;
struct Args { Ptrs P; int ph_lo, ph_hi; };
typedef const __attribute__((address_space(4))) Args CArgs;
__global__ void __launch_bounds__(NWAVES * 64, 2) fwd(Args args) {
    extern __shared__ __attribute__((aligned(16))) unsigned char lds[];
    Ctx C0; C0.lds = (LAS unsigned char*)lds; C0.tid = threadIdx.x; C0.lane = C0.tid & 63; C0.wave = __builtin_amdgcn_readfirstlane(C0.tid >> 6);
    C0.G = gridDim.x; { const int bx = blockIdx.x; C0.vcu = (C0.G % 8 == 0) ? (bx % 8) * (C0.G / 8) + bx / 8 : bx; }
    const Ctx& C = C0;
    volatile LAS unsigned* MISC = (volatile LAS unsigned*)(C.lds + MISC_OFF);
    if (C.tid < 32) MISC[C.tid] = 0u;
    __syncthreads();
    XcdBarrier bar; bar.bar = (unsigned*)(args.P.ws + WS_CTL) + CW_BAR; bar.x = 0; bar.st = nullptr;
    if (!MK_SPLIT) bar = xcd_barrier_post((unsigned*)(args.P.ws + WS_CTL) + CW_BAR, MISC + 8);
    const int lo = args.ph_lo, hi = args.ph_hi;
#ifndef PHASE_MASK
#define PHASE_MASK 0xFFFFFFFFu
#endif
#define IN(k) (((PHASE_MASK >> (k)) & 1u) && lo <= (k) && (k) < hi)
#define SEAM(k) do { if ((k) == 13 ? (IN(12) && IN(14)) : (IN(k) && IN((k) + 1))) { TP_A(5); xcd_barrier(bar); TP_B(5); TP_B(40 + PGRP(k)); TP_A(40 + PGRP((k) + 1)); } } while (0)
#define PH_BEGIN Ctx Cp_ = C0; { int t_ = threadIdx.x; asm volatile("" : "+v"(t_)); Cp_.tid = t_; Cp_.lane = t_ & 63; } const Ctx& C = Cp_;   \
        CArgs* ka_ = (CArgs*)__builtin_amdgcn_kernarg_segment_ptr(); asm volatile("" : "+s"(ka_)); CPtrs& P = ka_->P; unsigned char* ws = P.ws; float* ctl = (float*)(ws + WS_CTL); \
        bf16_t* XB = (bf16_t*)(ws + WS_XB); bf16_t* HB = (bf16_t*)(ws + WS_HB); float* X = P.out + OUT_Y; float* ssqx = ctl + F_SSQX; (void)XB; (void)HB; (void)X; (void)ssqx; (void)ctl;
    LAS unsigned char* ring = C.lds + RING_OFF;
    const int bx = (int)blockIdx.x;
#define GEMM(EPI, Aptr, Bptr, M_, N_, K_, Eobj) do { int k_ = (K_); asm volatile("" : "+s"(k_));   \
        pg8::Gemm g{(const bf16_t*)(Aptr), (const bf16_t*)(Bptr), (M_), (N_), k_, k_}; pg8::StaticOrder S; S.init((M_), (N_), C.G, bx); \
        pg8::gemm_phase<EPI, pg8::StaticOrder, PG8_ALIGN, PG8_SP2>(ring, g, S, Eobj); } while (0)

#define GEMM8(EPI, Aptr, Bptr, M_, N_, Eobj) do { int k_ = D / 2; asm volatile("" : "+s"(k_));   \
        pg8::Gemm g{(const bf16_t*)(Aptr), (const bf16_t*)(Bptr), (M_), (N_), k_, k_}; pg8::StaticOrder S; S.init((M_), (N_), C.G, bx); \
        pg8::gemm_phase<EPI, pg8::StaticOrder, PG8_ALIGN, PG8_SP2, true>(ring, g, S, Eobj); } while (0)
#define SA_PTR ((const float*)(ws + WS_SA))
#define TGU_PTR(i) ((const float*)(ws + WS_TGU) + (i) * 2 * FF)
#define W8GU_PTR(i) (ws + WS_W8GU0 + (size_t)(i) * WS_W8GU_STRIDE)
#define STAGE_T2() do { __syncthreads(); for (int i_ = C.tid; i_ < D / 4; i_ += NWAVES * 64) *((LAS f32x4*)(C.lds + QS_OFF) + i_) = *((const f32x4*)(ws + WS_T2) + i_); __syncthreads(); } while (0)
#define FILL(s) do { if (C.G == 256) { RangeOrder S; S.n = bx >= FILL_REM[s] ? FILL_PER[s] : 0; S.g0 = fill_start(s) + (bx - FILL_REM[s]) * FILL_PER[s]; \
        int k_ = KVR / 2; asm volatile("" : "+s"(k_)); pg8::Gemm g{(const bf16_t*)(ws + WS_CL8), (const bf16_t*)(ws + WS_W8), NCK, D, k_, k_}; STAGE_T2(); epi::Kv8 E_{(float*)(ws + WS_RP), (const float*)(ws + WS_SC2), (const LAS float*)(C.lds + QS_OFF), (size_t)NCK}; \
        pg8::gemm_phase<epi::Kv8, RangeOrder, PG8_ALIGN, R_SP2, true>(ring, g, S, E_); } } while (0)

#ifndef TPROBE
#define TPROBE 0
#endif
#ifdef PROBE_PHASE
#define PGRP(k) ((k) == PROBE_PHASE ? 7 : 0)
#else
#define PGRP(k) ((k) == 0 ? 1 : ((k) == 12 || (k) == 13) ? 2 : (k) == 14 ? 3 : ((k) == 4 || (k) == 15) ? 4 : 0)
#endif
    unsigned long long tp0_ = 0, tp1_ = 0, tpacc_ = 0;
#define TP_A(k) do { if (TPROBE == (k)) { __syncthreads(); tp0_ = __builtin_amdgcn_s_memrealtime(); } } while (0)
#define TP_B(k) do { if (TPROBE == (k)) { __syncthreads(); tp1_ = __builtin_amdgcn_s_memrealtime(); tpacc_ += tp1_ - tp0_; } } while (0)
#ifndef W8GU_FN
#define W8GU_FN phase_w8gu2
#endif
#ifndef DUP_SEL
#define DUP_SEL 0
#endif
    if (IN(0)) { PH_BEGIN phase_cacheconv(C, P, C.vcu, C.G); phase_w8(C, P); W8GU_FN(C, P); phase_prologue(C, P); if (DUP_SEL == 1) { __syncthreads(); phase_prologue(C, P); } } SEAM(0);
    if (IN(1)) { PH_BEGIN epi::Swiglu8 E{HB, ssqx + 0 * T, SA_PTR, TGU_PTR(0)}; TP_A(3); GEMM8(epi::Swiglu8, ws + WS_A8, W8GU_PTR(0), T, 2 * FF, E); TP_B(3); TP_A(4); FILL(0); TP_B(4); } SEAM(1);
    if (IN(2)) { PH_BEGIN epi::Resid E{XB, ssqx + 1 * T, 0.5f}; TP_A(2); GEMM(epi::Resid, HB, ws + WS_WDN0, T, D, FF, E); TP_B(2); TP_A(1); FILL(1); TP_B(1); } SEAM(2);
    if (IN(3)) { PH_BEGIN epi::ConvIn E{(bf16_t*)(ws + WS_BB), (bf16_t*)(ws + WS_UB), ssqx + 1 * T, P.out + OUT_CSP, P.out + OUT_CSS}; GEMM(epi::ConvIn, XB, ws + WS_WCI, T, 3 * D, D, E); FILL(2); } SEAM(3);
    if (IN(4)) { PH_BEGIN TP_A(8); phase_conv(C, P); TP_B(8); } SEAM(4);
    if (IN(5)) { PH_BEGIN epi::Resid E{XB, ssqx + 2 * T, 1.0f};
        if (C.G == 256) {
            GEMM(epi::Resid, ws + WS_ZB, ws + WS_WCO, TP, D, D, E);
            { int k_ = 256; asm volatile("" : "+s"(k_)); pg8::Gemm g{(const bf16_t*)(ws + WS_ZB) + (size_t)TP * D, (const bf16_t*)(ws + WS_WCO), TS, D, k_, D}; SplitOrder S{bx, 4}; epi::Slab E_{(float*)(ws + WS_SLAB)};
              pg8::gemm_phase<epi::Slab, SplitOrder, PG8_ALIGN, PG8_SP2>(ring, g, S, E_); }
        } else { GEMM(epi::Resid, ws + WS_ZB, ws + WS_WCO, T, D, D, E); }
        FILL(3); } SEAM(5);
    if (IN(6)) { PH_BEGIN if (C.G == 256) phase_quant(C, P, (const float*)(ws + WS_SLAB), 4, ssqx + 2 * T); else phase_quant(C, P); xcd_barrier(bar); epi::Swiglu8 E{HB, ssqx + 2 * T, SA_PTR, TGU_PTR(1)}; GEMM8(epi::Swiglu8, ws + WS_A8, W8GU_PTR(1), T, 2 * FF, E); FILL(4); } SEAM(6);
    if (IN(7)) { PH_BEGIN epi::Resid E{XB, ssqx + 3 * T, 0.5f}; GEMM(epi::Resid, HB, ws + WS_WDN1, T, D, FF, E); FILL(5); } SEAM(7);
    if (IN(8)) { PH_BEGIN phase_quant(C, P); xcd_barrier(bar); { epi::Swiglu8 E{HB, ssqx + 3 * T, SA_PTR, TGU_PTR(2)}; GEMM8(epi::Swiglu8, ws + WS_A8, W8GU_PTR(2), T, 2 * FF, E); }
        { epi::Dkv E{ssqx + 3 * T, (float*)(ws + WS_CKV), ctl + F_SSQLAT, ctl + F_SSQKPE}; int k_ = D; asm volatile("" : "+s"(k_)); pg8::Gemm g{(const bf16_t*)XB, (const bf16_t*)(ws + WS_WDKV), T, 512, k_, k_};
          pg8::StaticOrder S; S.init(T, 512, C.G, (bx + 84) % C.G); pg8::gemm_phase<epi::Dkv, pg8::StaticOrder, PG8_ALIGN, PG8_SP2>(ring, g, S, E); } } SEAM(8);
    if (IN(9)) { PH_BEGIN epi::Resid E{XB, ssqx + 4 * T, 0.5f}; GEMM(epi::Resid, HB, ws + WS_WDN2, T, D, FF, E); FILL(7); TP_A(8); phase_kvfin(C, P); TP_B(8); } SEAM(9);
    if (IN(10)) { PH_BEGIN { epi::Dq E{(bf16_t*)(ws + WS_CQB), ssqx + 4 * T, ctl + F_SSQCQ}; GEMM(epi::Dq, XB, ws + WS_WDQ, T, QRANK, D, E); } FILL(8);
                  { epi::Kv E{(bf16_t*)(ws + WS_KN), (bf16_t*)(ws + WS_VB), (float*)(ws + WS_RPT), (size_t)T}; GEMM(epi::Kv, ws + WS_LATB, ws + WS_WUKV, T, 2 * D, KVR, E); } FILL(9); } SEAM(10);
    if (IN(11)) { PH_BEGIN epi::Uq E{(bf16_t*)(ws + WS_QB), ctl + F_SSQCQ, ctl + F_SSQQ}; TP_A(13); GEMM(epi::Uq, ws + WS_CQB, ws + WS_WUQ, T, NQ, QRANK, E); TP_B(13); TP_A(14); FILL(10); TP_B(14); } SEAM(11);
    if (IN(12)) { PH_BEGIN const int r0_ = (C.G == 256) ? fill_start(NSLOT) : 0, base_ = (R_UNITS - r0_) / C.G, ext_ = (R_UNITS - r0_) % C.G;
        RangeOrder S; S.g0 = r0_ + bx * base_ + (bx < ext_ ? bx : ext_); S.n = base_ + (bx < ext_ ? 1 : 0);
        int k_ = KVR / 2; asm volatile("" : "+s"(k_)); pg8::Gemm g{(const bf16_t*)(ws + WS_CL8), (const bf16_t*)(ws + WS_W8), NCK, D, k_, k_}; STAGE_T2(); epi::Kv8 E_{(float*)(ws + WS_RP), (const float*)(ws + WS_SC2), (const LAS float*)(C.lds + QS_OFF), (size_t)NCK};
        pg8::gemm_phase<epi::Kv8, RangeOrder, PG8_ALIGN, R_SP2, true>(ring, g, S, E_);
        phase_qkfin(C, P); }
    SEAM(13);
    if (IN(14)) { PH_BEGIN
        const bf16_t* QF = (const bf16_t*)(ws + WS_QB); const bf16_t* KN = (const bf16_t*)(ws + WS_KN); const bf16_t* KPE = (const bf16_t*)(ws + WS_KPEB);
        const bf16_t* VBp = (const bf16_t*)(ws + WS_VB); bf16_t* OB = (bf16_t*)(ws + WS_OB);
#ifndef ATT_SEL
#define ATT_SEL 3
#endif
        att::sa::Src S{(const bf16_t*)(ws + WS_CLB), P.in[3], (const int*)P.in[5], (const float*)(ws + WS_RP), (const bf16_t*)(ws + WS_LATB), KPE, (const float*)(ws + WS_RTS), ws + WS_CL8, (const float*)(ws + WS_SC2)};
#ifndef ATT_OVERLAP
#define ATT_OVERLAP 0
#endif
        if (ATT_OVERLAP && C.G == 256) {
            volatile LAS unsigned* gcnt = (volatile LAS unsigned*)(C.lds + MISC_OFF) + 16;
            if (C.wave < 4) { unsigned ep = 0u; const int bh = C.vcu >> 4, s = C.vcu & 15;
                att::pa4::unit(bh >> 3, bh & 7, 63 - 2 * s, QF, KN, KPE, VBp, OB, (char*)lds, C.lds, gcnt, ep);
                att::pa4::unit(bh >> 3, bh & 7, 62 - 2 * s, QF, KN, KPE, VBp, OB, (char*)lds, C.lds, gcnt, ep);
                att::pa4::unit(bh >> 3, bh & 7, 2 * s + 1, QF, KN, KPE, VBp, OB, (char*)lds, C.lds, gcnt, ep);
                att::pa4::unit(bh >> 3, bh & 7, 2 * s, QF, KN, KPE, VBp, OB, (char*)lds, C.lds, gcnt, ep);
            } else if (C.wave < 7) { unsigned ep = 0u;
                att::sa3::unit(S, (const bf16_t*)(ws + WS_QS), (float*)(ws + WS_PO), (float*)(ws + WS_PML), C.vcu >> 1, C.vcu & 1, C.lds, (char*)lds, gcnt + 1, ep); }
        } else {
#define RUN_SA() do { for (int v = C.vcu; v < 2 * DB; v += C.G) att::sa::unit(S, (const bf16_t*)(ws + WS_QS), (float*)(ws + WS_PO), (float*)(ws + WS_PML), v >> 1, v & 1, C.lds, (char*)lds); } while (0)
#ifndef PA_UNIT
#define PA_UNIT unit_dma
#endif
#define RUN_PA() do { for (int v = C.vcu; v < 256; v += C.G) { const int bh = v >> 4, s = v & 15; \
            att::pa::PA_UNIT(bh >> 3, bh & 7, s, QF, KN, KPE, VBp, OB, (char*)lds, C.lds); att::pa::PA_UNIT(bh >> 3, bh & 7, 31 - s, QF, KN, KPE, VBp, OB, (char*)lds, C.lds); } } while (0)
        RUN_PA(); RUN_SA();
#undef RUN_SA
#undef RUN_PA
        }
    } SEAM(14);
    if (IN(15)) { PH_BEGIN TP_A(7); phase_scomb(C, P); TP_B(7); } SEAM(15);
    if (IN(16)) { PH_BEGIN epi::Resid E{XB, ssqx + 5 * T, 1.0f};
        if (C.G == 256) {
            GEMM(epi::Resid, ws + WS_OB, ws + WS_WO, TP, D, D, E);
            { int k_ = 256; asm volatile("" : "+s"(k_)); pg8::Gemm g{(const bf16_t*)(ws + WS_OB) + (size_t)TP * D, (const bf16_t*)(ws + WS_WO), TS, D, k_, D}; SplitOrder S{bx, 4}; epi::Slab E_{(float*)(ws + WS_SLAB)};
              pg8::gemm_phase<epi::Slab, SplitOrder, PG8_ALIGN, PG8_SP2>(ring, g, S, E_); }
        } else { GEMM(epi::Resid, ws + WS_OB, ws + WS_WO, T, D, D, E); } } SEAM(16);
    if (IN(17)) { PH_BEGIN if (C.G == 256) phase_quant(C, P, (const float*)(ws + WS_SLAB), 4, ssqx + 5 * T); else phase_quant(C, P); xcd_barrier(bar); epi::Swiglu8 E{HB, ssqx + 5 * T, SA_PTR, TGU_PTR(3)}; GEMM8(epi::Swiglu8, ws + WS_A8, W8GU_PTR(3), T, 2 * FF, E); } SEAM(17);
    if (IN(18)) { PH_BEGIN
        if (C.G == 256) { unsigned* cnt = (unsigned*)(ws + WS_CTL) + CW_SLC;
            { int k_ = 256; asm volatile("" : "+s"(k_)); pg8::Gemm g{(const bf16_t*)HB + (size_t)TP * FF, (const bf16_t*)(ws + WS_WDN3), TS, D, k_, FF}; SplitOrder S{bx, SPLITK}; epi::Slab E_{(float*)(ws + WS_SLAB)};
              pg8::gemm_phase<epi::Slab, SplitOrder, PG8_ALIGN, PG8_SP2>(ring, g, S, E_); }
            if (bx < 8 * SPLITK) { asm volatile("s_waitcnt vmcnt(0)" ::: "memory"); __syncthreads();
                if (threadIdx.x == 0) { __builtin_amdgcn_fence(__ATOMIC_RELEASE, "agent"); asm volatile("s_waitcnt vmcnt(0)" ::: "memory"); (void)xb_add(cnt, 1u); } }
            { epi::ResidY E{XB, X, 0.5f}; GEMM(epi::ResidY, HB, ws + WS_WDN3, TP, D, FF, E); }
            if (bx >= 8 * SPLITK) {
                if (threadIdx.x == 0) { XB_SPIN(xb_ld(cnt) < (unsigned)(8 * SPLITK), bar.bar); __builtin_amdgcn_fence(__ATOMIC_ACQUIRE, "agent"); asm volatile("s_waitcnt vmcnt(0)" ::: "memory"); }
                __syncthreads();
                const float* slab = (const float*)(ws + WS_SLAB);
                for (int i = (bx - 8 * SPLITK) * (NWAVES * 64) + C.tid; i < TS * D / 4; i += (256 - 8 * SPLITK) * (NWAVES * 64)) { f32x4 s = *((const f32x4*)slab + i);
#pragma unroll
                    for (int c = 1; c < SPLITK; ++c) s += *((const f32x4*)(slab + (size_t)c * TS * D) + i);
                    const u32x2 xw = *((const u32x2*)(XB + (size_t)TP * D) + i); *((f32x4*)(X + (size_t)TP * D) + i) = (f32x4){bflo(xw.x), bfhi(xw.x), bflo(xw.y), bfhi(xw.y)} + s * 0.5f; } }
        } else { epi::ResidY E{XB, X, 0.5f}; GEMM(epi::ResidY, HB, ws + WS_WDN3, T, D, FF, E); } }
#ifdef XBAR_PROBE
    for (int i_ = 0; i_ < XBAR_PROBE; ++i_) xcd_barrier(bar);
#endif
#ifndef PROBE_BLOCK
#define PROBE_BLOCK 255
#endif
    if (TPROBE && blockIdx.x == PROBE_BLOCK && C.wave == 0) { const unsigned long long te = __builtin_amdgcn_s_memrealtime(), span = tpacc_ * 32ull;
        while (__builtin_amdgcn_s_memrealtime() - te < span) __builtin_amdgcn_s_sleep(8); }
#undef IN
#undef SEAM
#undef GEMM
}

extern "C" void kernel_launch(void* const* d_in, const int* in_sizes, int n_in, void* d_out, int out_size, void* d_ws, size_t ws_size, hipStream_t stream) {
    static int grid = 0;
    if (grid == 0) {
        if (n_in != 29 || out_size != (int)OUT_TOTAL || ws_size < WS_END) { fprintf(stderr, "kernel_launch: unexpected shapes (n_in %d, out %d, ws %zu); nothing launched\n", n_in, out_size, ws_size); grid = -1; return; }
        int dev = 0, cus = 0, per_cu = 0;
        if (hipGetDevice(&dev) != hipSuccess || hipDeviceGetAttribute(&cus, hipDeviceAttributeMultiprocessorCount, dev) != hipSuccess) { grid = -1; return; }
        if (hipFuncSetAttribute((const void*)fwd, hipFuncAttributeMaxDynamicSharedMemorySize, LDS_BYTES) != hipSuccess) { fprintf(stderr, "kernel_launch: hipFuncSetAttribute failed\n"); grid = -1; return; }
        if (hipOccupancyMaxActiveBlocksPerMultiprocessor(&per_cu, (const void*)fwd, NWAVES * 64, LDS_BYTES) != hipSuccess || per_cu < 1)
            fprintf(stderr, "kernel_launch: note: occupancy query reports %d workgroups per CU\n", per_cu);
        (void)hipGetLastError();
        grid = cus;
    }
    if (grid < 0) return;
    if (hipMemsetAsync((char*)d_ws + WS_CTL, 0, CTL_BYTES, stream) != hipSuccess) { fprintf(stderr, "kernel_launch: memset failed\n"); return; }
    Args a{};
    for (int i = 0; i < 29; ++i) a.P.in[i] = (const float*)d_in[i];
    a.P.out = (float*)d_out; a.P.ws = (unsigned char*)d_ws;
#if MK_SPLIT
    for (int ph = 0; ph < NPHASE; ++ph) { a.ph_lo = ph; a.ph_hi = ph + 1; hipLaunchKernelGGL(fwd, dim3(grid), dim3(NWAVES * 64), LDS_BYTES, stream, a); }
#else
    a.ph_lo = 0; a.ph_hi = NPHASE;
    hipLaunchKernelGGL(fwd, dim3(grid), dim3(NWAVES * 64), LDS_BYTES, stream, a);
#endif
    const hipError_t le = hipPeekAtLastError();
    if (le != hipSuccess) fprintf(stderr, "kernel_launch: launch failed: %s\n", hipGetErrorName(le));
}
```

```cpp
#include <hip/hip_runtime.h>
#include <cstdio>
#include <cstdint>
namespace pg8 {
#define PG8_LAS __attribute__((address_space(3)))
typedef unsigned short bf16_t;
typedef short bf16x8 __attribute__((ext_vector_type(8)));
typedef float f32x4 __attribute__((ext_vector_type(4)));
typedef unsigned u32x4 __attribute__((ext_vector_type(4)));
constexpr int BM = 256, BK = 64, HALF = 128, HTB = HALF * BK * 2  , STAGE_BYTES = 8 * HTB, NXCD = 8, WGM = 8;

__host__ __device__ __forceinline__ int lds_byte(int r, int c) { const int st = (r >> 4) * 2 + (c >> 5), rr = r & 15, cc = c & 31, ob = rr * 64 + cc * 2; return st * 1024 + (ob ^ (((ob >> 9) & 1) << 5)); }
__host__ __device__ __forceinline__ void stage_rc(int b, int& R, int& C) { const int st = b / 1024, sb = b % 1024, swz = sb ^ (((sb >> 9) & 1) << 5); R = (st >> 1) * 16 + swz / 64; C = (st & 1) * 32 + (swz % 64) / 2; }
__host__ __device__ __forceinline__ int perm32(int rho) { const int n = rho >> 4, i = rho & 15; return 8 * (i >> 2) + 4 * n + (i & 3); }

struct Unit { int pm, pn; int ko; };
struct Gemm { const bf16_t* A; const bf16_t* Bt; int M, N, K; int ld; };

struct StaticOrder {
    int nM, nN, nwg, G, c;
    __host__ __device__ void init(int M, int N, int G_, int c_) { nM = M / BM; nN = N / BM; nwg = nM * nN; G = G_; c = c_; }
    __host__ __device__ bool next(int i, Unit& u) const {
        const long L = (long)i * G + c; if (L >= nwg) return false;
        int wgid = (int)L; { const int q = nwg / NXCD, r = nwg % NXCD, xcd = wgid % NXCD, off = wgid / NXCD; wgid = (xcd < r ? xcd * (q + 1) : r * (q + 1) + (xcd - r) * q) + off; }
        const int nig = WGM * nN, gid = wgid / nig, fm = gid * WGM, gsz = (nM - fm) < WGM ? (nM - fm) : WGM;
        u.pm = fm + ((wgid % nig) % gsz); u.pn = (wgid % nig) / gsz; u.ko = 0; return true;
    }
    __device__ __forceinline__ void a_ready(const Unit&) const {}
    __device__ __forceinline__ void done(const Unit&) const {}
};

__device__ __forceinline__ unsigned cvt_pk_bf16(float lo, float hi) { unsigned r; asm volatile("v_cvt_pk_bf16_f32 %0, %1, %2" : "=v"(r) : "v"(lo), "v"(hi)); return r; }
typedef float f32x2 __attribute__((ext_vector_type(2)));
typedef int i32x4 __attribute__((ext_vector_type(4)));
template <bool I8> __device__ __forceinline__ f32x4 mma16(bf16x8 b, bf16x8 a, f32x4 c) {
    if constexpr (I8) return __builtin_bit_cast(f32x4, __builtin_amdgcn_mfma_i32_16x16x64_i8(__builtin_bit_cast(i32x4, b), __builtin_bit_cast(i32x4, a), __builtin_bit_cast(i32x4, c), 0, 0, 0));
    else return __builtin_amdgcn_mfma_f32_16x16x32_bf16(b, a, c, 0, 0, 0);
}
template <class Epi, class Sched, bool ALIGN_EPI = false, bool SP2 = false, bool I8 = false>
__device__ __forceinline__ void gemm_phase(PG8_LAS unsigned char* lds, const Gemm g, const Sched& S, const Epi& E) {
    int tid_ = threadIdx.x; asm volatile("" : "+v"(tid_));
    const int tid = tid_, wid = __builtin_amdgcn_readfirstlane(tid >> 6), lane = tid & 63, wr = wid >> 2, wc = wid & 3, fr = lane & 15, fq = lane >> 4;
    const int K = g.K, nt = K / BK;
    unsigned voffA[2], voffB[2];
#pragma unroll
    for (int i = 0; i < 2; ++i) { int R, C; stage_rc(tid * 16 + i * 8192, R, C); const int Rb = Epi::PERM ? ((R & ~31) + perm32(R & 31)) : R;
        voffA[i] = (unsigned)(R * g.ld + C) * 2u; voffB[i] = (unsigned)(Rb * g.ld + C) * 2u; }
    const size_t kstep = (size_t)(BK * 2);
    const size_t hstep = (size_t)HALF * g.ld * 2;
    const size_t tstep = 2 * hstep;
    const unsigned ldsw = (unsigned)wid * 1024u;
    const int aoff = lds_byte(wr * 64 + fr, fq * 8), boff = lds_byte(wc * 32 + fr, fq * 8);
#define PG8_SA(b, h) (((b) * 2 + (h)) * HTB)
#define PG8_SB(b, h) ((4 + (b) * 2 + (h)) * HTB)
#define PG8_STAGE(bufoff, gbase, voff) do { _Pragma("unroll") for (int _i = 0; _i < 2; ++_i) \
        __builtin_amdgcn_global_load_lds((const unsigned*)((const char*)(gbase) + (voff)[_i]), (PG8_LAS unsigned*)(lds + (bufoff) + ldsw + _i * 8192), 16, 0, 0); } while (0)
#define PG8_LDA(dst, b, h) do { _Pragma("unroll") for (int m = 0; m < 4; ++m) _Pragma("unroll") for (int k = 0; k < 2; ++k) dst[m][k] = *(const PG8_LAS bf16x8*)(lds + PG8_SA(b, h) + aoff + m * 2048 + k * 1024); } while (0)
#define PG8_LDB(dst, b, h) do { _Pragma("unroll") for (int n = 0; n < 2; ++n) _Pragma("unroll") for (int k = 0; k < 2; ++k) dst[n][k] = *(const PG8_LAS bf16x8*)(lds + PG8_SB(b, h) + boff + n * 2048 + k * 1024); } while (0)
#define PG8_MMA(ai, bj, At, Bt) do { __builtin_amdgcn_s_setprio(1); _Pragma("unroll") for (int m = 0; m < 4; ++m) _Pragma("unroll") for (int n = 0; n < 2; ++n) _Pragma("unroll") for (int k = 0; k < 2; ++k) \
        acc[ai][bj][m][n] = mma16<I8>(Bt[n][k], At[m][k], acc[ai][bj][m][n]); __builtin_amdgcn_s_setprio(0); } while (0)
#define PG8_WAIT_V(n) asm volatile("s_waitcnt vmcnt(" #n ")" ::: "memory")
#define PG8_WAIT_L(n) asm volatile("s_waitcnt lgkmcnt(" #n ")" ::: "memory")
#define PG8_BAR __builtin_amdgcn_s_barrier()
#define PG8_SCHED __builtin_amdgcn_sched_barrier(0)
    Unit cur, nxt; int ui = 0;
    if (!S.next(0, cur)) return;
    f32x4 acc[2][2][4][2];
#pragma unroll
    for (int a = 0; a < 2; ++a)
#pragma unroll
        for (int b = 0; b < 2; ++b)
#pragma unroll
            for (int m = 0; m < 4; ++m)
#pragma unroll
                for (int n = 0; n < 2; ++n) acc[a][b][m][n] = (f32x4){0.f, 0.f, 0.f, 0.f};
    bf16x8 At[4][2], B0[2][2], B1[2][2];
    const char* cA = (const char*)g.A + (size_t)cur.pm * tstep + cur.ko; const char* cB = (const char*)g.Bt + (size_t)cur.pn * tstep + cur.ko;
    S.a_ready(cur);
    if constexpr (SP2) {
        PG8_STAGE(PG8_SB(0, 0), cB, voffB); PG8_STAGE(PG8_SB(0, 1), cB + hstep, voffB); PG8_STAGE(PG8_SA(0, 0), cA, voffA); PG8_STAGE(PG8_SA(0, 1), cA + hstep, voffA);
        if (wr == 1) PG8_BAR;
        PG8_WAIT_V(2); PG8_BAR;
        PG8_STAGE(PG8_SB(1, 0), cB + kstep, voffB); PG8_STAGE(PG8_SA(1, 0), cA + kstep, voffA); PG8_STAGE(PG8_SB(1, 1), cB + hstep + kstep, voffB);
        PG8_WAIT_V(6); PG8_BAR;
    } else {
        PG8_STAGE(PG8_SB(0, 0), cB, voffB); PG8_STAGE(PG8_SA(0, 0), cA, voffA); PG8_STAGE(PG8_SB(0, 1), cB + hstep, voffB); PG8_STAGE(PG8_SA(0, 1), cA + hstep, voffA);
        if (wr == 1) PG8_BAR;
        PG8_WAIT_V(4); PG8_BAR;
        PG8_STAGE(PG8_SB(1, 0), cB + kstep, voffB); PG8_STAGE(PG8_SA(1, 0), cA + kstep, voffA); PG8_STAGE(PG8_SB(1, 1), cB + hstep + kstep, voffB);
        PG8_WAIT_V(6); PG8_BAR;
    }
    for (;;) {
        const bool has_next = S.next(ui + 1, nxt);
        const char* nA = has_next ? (const char*)g.A + (size_t)nxt.pm * tstep + nxt.ko : cA; const char* nB = has_next ? (const char*)g.Bt + (size_t)nxt.pn * tstep + nxt.ko : cB;
        for (int t = 0; t < nt; t += 2) {
            const bool last = (t == nt - 2);
            const char* a1 = cA + (size_t)(t + 1) * kstep;
            const char* a2 = last ? nA : cA + (size_t)(t + 2) * kstep; const char* b2 = last ? nB : cB + (size_t)(t + 2) * kstep;
            const char* a3 = a2 + kstep; const char* b3 = b2 + kstep;
            if (last && has_next) S.a_ready(nxt);
            if constexpr (SP2) {
            PG8_LDB(B0, 0, 0); PG8_LDB(B1, 0, 1); PG8_SCHED; PG8_LDA(At, 0, 0); PG8_STAGE(PG8_SA(1, 1), a1 + hstep, voffA);
            PG8_WAIT_V(8); PG8_WAIT_L(0); PG8_BAR; PG8_MMA(0, 0, At, B0); PG8_MMA(0, 1, At, B1); PG8_BAR; PG8_SCHED;
            PG8_LDA(At, 0, 1); PG8_STAGE(PG8_SB(0, 0), b2, voffB); PG8_STAGE(PG8_SB(0, 1), b2 + hstep, voffB); PG8_STAGE(PG8_SA(0, 0), a2, voffA);
            PG8_WAIT_V(8); PG8_WAIT_L(0); PG8_BAR; PG8_MMA(1, 0, At, B0); PG8_MMA(1, 1, At, B1); PG8_BAR; PG8_SCHED;
            PG8_LDB(B0, 1, 0); PG8_LDB(B1, 1, 1); PG8_SCHED; PG8_LDA(At, 1, 0); PG8_STAGE(PG8_SA(0, 1), a2 + hstep, voffA);
            PG8_WAIT_V(8); PG8_WAIT_L(0); PG8_BAR; PG8_MMA(0, 0, At, B0); PG8_MMA(0, 1, At, B1); PG8_BAR; PG8_SCHED;
            PG8_LDA(At, 1, 1); PG8_STAGE(PG8_SB(1, 0), b3, voffB); PG8_STAGE(PG8_SB(1, 1), b3 + hstep, voffB); PG8_STAGE(PG8_SA(1, 0), a3, voffA);
            PG8_WAIT_V(8); PG8_WAIT_L(0); PG8_BAR; PG8_MMA(1, 0, At, B0); PG8_MMA(1, 1, At, B1); PG8_BAR; PG8_SCHED;
            } else {
            PG8_LDB(B0, 0, 0); PG8_SCHED; PG8_LDA(At, 0, 0); PG8_STAGE(PG8_SA(1, 1), a1 + hstep, voffA);
            PG8_WAIT_L(8); PG8_BAR; PG8_WAIT_L(0); PG8_MMA(0, 0, At, B0); PG8_BAR; PG8_SCHED;
            PG8_LDB(B1, 0, 1); PG8_STAGE(PG8_SB(0, 0), b2, voffB);
            PG8_BAR; PG8_WAIT_L(0); PG8_MMA(0, 1, At, B1); PG8_BAR;
            PG8_LDA(At, 0, 1); PG8_STAGE(PG8_SA(0, 0), a2, voffA);
            PG8_BAR; PG8_WAIT_L(0); PG8_MMA(1, 0, At, B0); PG8_BAR; PG8_SCHED;
            PG8_STAGE(PG8_SB(0, 1), b2 + hstep, voffB);
            PG8_WAIT_V(6); PG8_BAR; PG8_MMA(1, 1, At, B1); PG8_BAR;
            PG8_LDB(B0, 1, 0); PG8_SCHED; PG8_LDA(At, 1, 0); PG8_STAGE(PG8_SA(0, 1), a2 + hstep, voffA);
            PG8_WAIT_L(8); PG8_BAR; PG8_WAIT_L(0); PG8_MMA(0, 0, At, B0); PG8_BAR; PG8_SCHED;
            PG8_LDB(B1, 1, 1); PG8_STAGE(PG8_SB(1, 0), b3, voffB);
            PG8_BAR; PG8_WAIT_L(0); PG8_MMA(0, 1, At, B1); PG8_BAR;
            PG8_LDA(At, 1, 1); PG8_STAGE(PG8_SA(1, 0), a3, voffA);
            PG8_BAR; PG8_WAIT_L(0); PG8_MMA(1, 0, At, B0); PG8_BAR; PG8_SCHED;
            PG8_STAGE(PG8_SB(1, 1), b3 + hstep, voffB);
            PG8_WAIT_V(6); PG8_BAR; PG8_MMA(1, 1, At, B1); PG8_BAR;
            }
        }
        if constexpr (ALIGN_EPI) { if (wr == 0) PG8_BAR; }
        if constexpr (!Epi::AFTER_DRAIN) { E(acc, cur, wr, wc, fr, fq); S.done(cur); }
        if (!has_next) break;
#pragma unroll
        for (int a = 0; a < 2; ++a)
#pragma unroll
            for (int b = 0; b < 2; ++b)
#pragma unroll
                for (int m = 0; m < 4; ++m)
#pragma unroll
                    for (int n = 0; n < 2; ++n) acc[a][b][m][n] = (f32x4){0.f, 0.f, 0.f, 0.f};
        cur = nxt; cA = nA; cB = nB; ++ui;
        if constexpr (ALIGN_EPI) { if (wr == 1) PG8_BAR; }
    }
    PG8_WAIT_V(0);
    if constexpr (!ALIGN_EPI) { if (wr == 0) PG8_BAR; }
    PG8_BAR;
    if constexpr (Epi::AFTER_DRAIN) { E.fused(acc, cur, wr, wc, fr, fq, lds, wid, lane); S.done(cur); }
#undef PG8_SA
#undef PG8_SB
#undef PG8_STAGE
#undef PG8_LDA
#undef PG8_LDB
#undef PG8_MMA
#undef PG8_WAIT_V
#undef PG8_WAIT_L
#undef PG8_BAR
#undef PG8_SCHED
}
}
#define PG8_SP2 true
#define PG8_ALIGN true
#define GAS __attribute__((address_space(1)))
#define LAS __attribute__((address_space(3)))
typedef unsigned short bf16;
typedef unsigned v4u __attribute__((ext_vector_type(4)));
typedef float f32x4 __attribute__((ext_vector_type(4)));
typedef short bf16x8 __attribute__((ext_vector_type(8)));
typedef GAS unsigned gu32;
typedef GAS unsigned long long gu64;
#define RLX_AGENT __ATOMIC_RELAXED, __HIP_MEMORY_SCOPE_AGENT
#define LDS_WAIT() asm volatile("s_waitcnt lgkmcnt(0)" ::: "memory")
#define VM_WAIT() asm volatile("s_waitcnt vmcnt(0)" ::: "memory")
__device__ __forceinline__ unsigned long long rt() { return __builtin_amdgcn_s_memrealtime(); }
__device__ __forceinline__ unsigned f2bf(float f) { unsigned u = __builtin_bit_cast(unsigned, f); return (u + 0x7fffu + ((u >> 16) & 1u)) >> 16; }
__device__ __forceinline__ unsigned pk2(float lo, float hi) { return f2bf(lo) | (f2bf(hi) << 16); }
#define XB_TMO      128
#define XB_XCNT(j)  (256  + 64 * (j))
#define XB_XSUB(j)  (1280 + 64 * (j))
#define XB_XGEN(j)  (2304 + 64 * (j))
#define XB_TOP      3328
#define XB_TOPGEN   3392
#define XCD_BAR_WORDS 3456
#define XB_SPIN_CAP (1u << 18)

__device__ __forceinline__ unsigned xb_ld(unsigned* p)              { return __hip_atomic_load(p, __ATOMIC_RELAXED, __HIP_MEMORY_SCOPE_AGENT); }
__device__ __forceinline__ unsigned xb_add(unsigned* p, unsigned v) { return __hip_atomic_fetch_add(p, v, __ATOMIC_RELAXED, __HIP_MEMORY_SCOPE_AGENT); }
__device__ __forceinline__ unsigned xb_xcc_id() { return (unsigned)__builtin_amdgcn_s_getreg((3 << 11) | 20) & 0xFu; }
#define XB_SPIN(cond, bar) do { unsigned _sp = 0; while (cond) { __builtin_amdgcn_s_sleep(1); \
    if ((++_sp & 255u) == 0u) { if (xb_ld(&(bar)[XB_TMO])) break; if (_sp > XB_SPIN_CAP) { atomicAdd(&(bar)[XB_TMO], 1u); break; } } } } while (0)

struct XcdBarrier {
    unsigned* bar; unsigned x;
    volatile LAS unsigned* st;
};

__device__ __forceinline__ XcdBarrier xcd_barrier_post(unsigned* bar, volatile LAS unsigned* st) {
    XcdBarrier b; b.bar = bar; b.x = xb_xcc_id(); b.st = st;
    if (threadIdx.x == 0) (void)xb_add(&bar[XB_XCNT(b.x)], 1u);
    return b;
}
__device__ __forceinline__ void xcd_barrier_complete(unsigned* bar, unsigned x, unsigned& nloc, unsigned& nx) {
    const unsigned G = gridDim.x * gridDim.y * gridDim.z;
    unsigned sum, cnt, mine, sp = 0u;
    for (;;) {
        sum = 0u; cnt = 0u; mine = 0u;
#pragma unroll
        for (unsigned j = 0; j < 16; ++j) { const unsigned c = xb_ld(&bar[XB_XCNT(j)]); sum += c; cnt += (c > 0u) ? 1u : 0u; mine = (j == x) ? c : mine; }
        if (sum == G) break;
        __builtin_amdgcn_s_sleep(1);
        if ((++sp & 255u) == 0u) { if (xb_ld(&bar[XB_TMO])) break; if (sp > XB_SPIN_CAP) { atomicAdd(&bar[XB_TMO], 1u); break; } }
    }
    nloc = mine > 0u ? mine : 1u; nx = cnt > 0u ? cnt : 1u;
}

__device__ __forceinline__ void xcd_barrier(const XcdBarrier& b) {
    asm volatile("s_waitcnt vmcnt(0)" ::: "memory");
    __syncthreads();
    if (threadIdx.x == 0) {
        unsigned* bar = b.bar;
        __builtin_amdgcn_s_waitcnt(0);
        unsigned nloc = b.st[0], nx = b.st[1];
        if (nloc == 0u) { xcd_barrier_complete(bar, b.x, nloc, nx); b.st[0] = nloc; b.st[1] = nx; }
        const unsigned old = xb_add(&bar[XB_XSUB(b.x)], 1u);
        const unsigned gen = old / nloc;
        if (old + 1u == (gen + 1u) * nloc) {
            __builtin_amdgcn_fence(__ATOMIC_RELEASE, "agent");
            asm volatile("s_waitcnt vmcnt(0)" ::: "memory");
            const unsigned og = xb_add(&bar[XB_TOP], 1u);
            const unsigned tg = og / nx;
            if (og + 1u == (tg + 1u) * nx) xb_add(&bar[XB_TOPGEN], 1u);
            else XB_SPIN(xb_ld(&bar[XB_TOPGEN]) == tg, bar);
            __builtin_amdgcn_fence(__ATOMIC_ACQUIRE, "agent");
            xb_add(&bar[XB_XGEN(b.x)], 1u);
            asm volatile("s_waitcnt vmcnt(0)" ::: "memory");
        } else {
            XB_SPIN(xb_ld(&bar[XB_XGEN(b.x)]) == gen, bar);
            __builtin_amdgcn_fence(__ATOMIC_ACQUIRE, "agent");
            asm volatile("s_waitcnt vmcnt(0)" ::: "memory");
        }
    }
    __syncthreads();
}

constexpr int NWAVES = 8;
constexpr int D = 1024, TP = 16384, TS = 512, T = TP + TS, FF = 2816, NH = 8, KVR = 256, ROPE = 64, QRANK = 512, NQ = 1536, HD = 192;
constexpr int SEQ = 8192, DB = 128, DS = 4, PAGE = 128, NPG = 64, CKVW = 320;
constexpr int NCK = DB * SEQ;
constexpr float EPS = 1e-6f;
constexpr float QSCALE = 0.07216878364870322f * 1.4426950408889634f;
constexpr size_t OUT_Y = 0, OUT_CSP = 17301504, OUT_CSS = 17305600, OUT_LATP = 17567744, OUT_KPEP = 21762048, OUT_LATS = 22810624, OUT_KPES = 22941696, OUT_TOTAL = 22974464;
constexpr size_t MiB = 1u << 20;
constexpr size_t WS_CTL = 0, CTL_BYTES = 4 * MiB;
constexpr size_t WS_WGU0 = 4 * MiB, WS_WGU1 = 15 * MiB, WS_WGU2 = 26 * MiB, WS_WGU3 = 38 * MiB;
constexpr size_t WS_WDN0 = 49 * MiB, WS_WDN1 = 55 * MiB, WS_WDN2 = 61 * MiB, WS_WDN3 = 67 * MiB;
constexpr size_t WS_WCI = 73 * MiB, WS_WCO = 79 * MiB, WS_WDQ = 81 * MiB, WS_WUQ = 82 * MiB, WS_WO = 84 * MiB, WS_WUKV = 86 * MiB;
constexpr size_t WS_ROPE = 88 * MiB;
constexpr size_t WS_XB = 92 * MiB, WS_HB = 126 * MiB, WS_BB = 218 * MiB, WS_UB = 252 * MiB, WS_ZB = 286 * MiB, WS_CKV = 320 * MiB;
constexpr size_t WS_LATB = 342 * MiB, WS_KPEB = 352 * MiB, WS_KN = 356 * MiB, WS_VB = 390 * MiB, WS_CQB = 424 * MiB, WS_QB = 442 * MiB;
constexpr size_t WS_OB = 493 * MiB, WS_RPT = 527 * MiB, WS_RTS = 529 * MiB, WS_QS = 530 * MiB, WS_PO = 534 * MiB, WS_PML = 543 * MiB;
constexpr size_t WS_CLB = 544 * MiB, WS_CKB = 1056 * MiB, WS_RP = 1184 * MiB, WS_SLAB = 1248 * MiB;
constexpr size_t WS_CL8 = 1272 * MiB, WS_SC2 = 1528 * MiB, WS_W8 = 1532 * MiB, WS_T2 = 1533 * MiB;
constexpr size_t WS_A8 = 1534 * MiB, WS_SA = 1552 * MiB, WS_W8GU0 = 1553 * MiB, WS_W8GU_STRIDE = 6 * MiB, WS_TGU = 1577 * MiB, WS_WDKV = 1578 * MiB, WS_END = 1580 * MiB;
constexpr int SPLITK = 11;
constexpr int CW_BAR = 4096, CW_SLC = 8192, CW_SC = 8256;
constexpr int F_SSQX = 16384, F_SSQLAT = F_SSQX + 6 * T, F_SSQKPE = F_SSQX + 7 * T, F_SSQCQ = F_SSQX + 8 * T, F_SSQQ = F_SSQX + 9 * T;
static_assert((size_t)(F_SSQQ + 16 * T) * 4 <= CTL_BYTES, "ctl");
constexpr int RING_OFF = 0, RING_BYTES = 131072, MISC_OFF = 131072, QS_OFF = 131584, QS_STRIDE = 656, SCR_OFF = QS_OFF + 32 * QS_STRIDE, LDS_BYTES = 155648;
static_assert(SCR_OFF + 8 * 256 <= LDS_BYTES, "lds");

typedef unsigned short bf16_t;
typedef unsigned u32x2 __attribute__((ext_vector_type(2)));
typedef float f32x2 __attribute__((ext_vector_type(2)));
typedef __bf16 bf16x2_t __attribute__((ext_vector_type(2)));
__device__ __forceinline__ unsigned cvt_pk_bf16(float lo, float hi) { f32x2 v = {lo, hi}; bf16x2_t b = __builtin_convertvector(v, bf16x2_t); return __builtin_bit_cast(unsigned, b); }
__device__ __forceinline__ float bf2f(unsigned short h) { return __builtin_bit_cast(float, (unsigned)h << 16); }
__device__ __forceinline__ float bflo(unsigned w) { return __builtin_bit_cast(float, w << 16); }
__device__ __forceinline__ float bfhi(unsigned w) { return __builtin_bit_cast(float, w & 0xffff0000u); }
__device__ __forceinline__ v4u pack8f(const float* v) { v4u o; o.x = cvt_pk_bf16(v[0], v[1]); o.y = cvt_pk_bf16(v[2], v[3]); o.z = cvt_pk_bf16(v[4], v[5]); o.w = cvt_pk_bf16(v[6], v[7]); return o; }
__device__ __forceinline__ void unpack8f(v4u w, float* v) { v[0] = bflo(w.x); v[1] = bfhi(w.x); v[2] = bflo(w.y); v[3] = bfhi(w.y); v[4] = bflo(w.z); v[5] = bfhi(w.z); v[6] = bflo(w.w); v[7] = bfhi(w.w); }
__device__ __forceinline__ float fq_sum(float s) { s += __shfl_xor(s, 16); s += __shfl_xor(s, 32); return s; }
__device__ __forceinline__ float wave_sum(float v) {
#pragma unroll
    for (int o = 1; o < 64; o <<= 1) v += __shfl_xor(v, o);
    return v;
}
__device__ __forceinline__ float rsq(float x) { return 1.0f / sqrtf(x); }
__device__ __forceinline__ void atomic_addf(float* p, float v) { unsafeAtomicAdd(p, v); }

namespace epi {
using pg8::Unit; using pg8::f32x4; using pg8::BM; using pg8::HALF;
typedef f32x4 Acc[2][2][4][2];

struct Swiglu {
    static constexpr bool PERM = true, AFTER_DRAIN = false;
    bf16_t* HB; const float* ssq; float* ckv; float* ssq_lat; float* ssq_kpe; int ngu;
    __device__ __forceinline__ void operator()(const f32x4 (&acc)[2][2][4][2], const Unit& u, int wr, int wc, int fr, int fq) const {
        float sq8[2][4];
#pragma unroll
        for (int ai = 0; ai < 2; ++ai)
#pragma unroll
            for (int m = 0; m < 4; ++m) sq8[ai][m] = ssq[u.pm * BM + ai * HALF + wr * 64 + m * 16 + fr];
#pragma unroll
        for (int ai = 0; ai < 2; ++ai)
#pragma unroll
            for (int m = 0; m < 4; ++m) {
                const int row = u.pm * BM + ai * HALF + wr * 64 + m * 16 + fr;
                const float rs = rsq(sq8[ai][m] * (1.0f / D) + EPS);
                if (u.pn < ngu) {
                    float h[8];
#pragma unroll
                    for (int n = 0; n < 2; ++n)
#pragma unroll
                        for (int j = 0; j < 4; ++j) { const float g = acc[ai][0][m][n][j] * rs, up = acc[ai][1][m][n][j] * rs;
                            const float sg = g * __builtin_amdgcn_rcpf(1.0f + __builtin_amdgcn_exp2f(-1.4426950408889634f * g)); h[4 * n + j] = sg * up; }
                    *(v4u*)(HB + (size_t)row * FF + 128 * u.pn + 32 * wc + 8 * fq) = pack8f(h);
                } else if (u.pn == ngu) {
                    float ss = 0.f;
#pragma unroll
                    for (int bj = 0; bj < 2; ++bj)
#pragma unroll
                        for (int n = 0; n < 2; ++n) { const f32x4 v = acc[ai][bj][m][n] * rs; ss += (v[0] * v[0] + v[1] * v[1]) + (v[2] * v[2] + v[3] * v[3]);
                            *(f32x4*)(ckv + (size_t)row * CKVW + 128 * bj + 32 * wc + 8 * fq + 4 * n) = v; }
                    ss = fq_sum(ss); if (fq == 0) atomic_addf(ssq_lat + row, ss);
                } else {
                    if (wc < 2) { float ss = 0.f;
#pragma unroll
                        for (int n = 0; n < 2; ++n) { const f32x4 v = acc[ai][0][m][n] * rs; ss += (v[0] * v[0] + v[1] * v[1]) + (v[2] * v[2] + v[3] * v[3]);
                            *(f32x4*)(ckv + (size_t)row * CKVW + 256 + 32 * wc + 8 * fq + 4 * n) = v; }
                        ss = fq_sum(ss); if (fq == 0) atomic_addf(ssq_kpe + row, ss); }
                }
            }
    }
};
struct Swiglu8 {
    static constexpr bool PERM = true, AFTER_DRAIN = false;
    bf16_t* HB; const float* ssq; const float* sa; const float* tsc;
    __device__ __forceinline__ void operator()(const f32x4 (&acc)[2][2][4][2], const Unit& u, int wr, int wc, int fr, int fq) const {
        typedef int i32x4 __attribute__((ext_vector_type(4)));
        int fq_ = fq, fr_ = fr; asm volatile("" : "+v"(fq_), "+v"(fr_));
        float f8[2][4], s8[2][4]; f32x4 tg[2], tu[2];
#pragma unroll
        for (int ai = 0; ai < 2; ++ai)
#pragma unroll
            for (int m = 0; m < 4; ++m) { const int row = u.pm * BM + ai * HALF + wr * 64 + m * 16 + fr_; f8[ai][m] = ssq[row]; s8[ai][m] = sa[row]; }
#pragma unroll
        for (int n = 0; n < 2; ++n) { tg[n] = *(const f32x4*)(tsc + 256 * u.pn + 32 * wc + 8 * fq_ + 4 * n); tu[n] = *(const f32x4*)(tsc + 256 * u.pn + 128 + 32 * wc + 8 * fq_ + 4 * n); }
#pragma unroll
        for (int ai = 0; ai < 2; ++ai)
#pragma unroll
            for (int m = 0; m < 4; ++m) {
                const int row = u.pm * BM + ai * HALF + wr * 64 + m * 16 + fr;
                const float rs = rsq(f8[ai][m] * (1.0f / D) + EPS) * s8[ai][m];
                float h[8];
#pragma unroll
                for (int n = 0; n < 2; ++n) { const i32x4 ig = __builtin_bit_cast(i32x4, acc[ai][0][m][n]), iu = __builtin_bit_cast(i32x4, acc[ai][1][m][n]);
#pragma unroll
                    for (int j = 0; j < 4; ++j) { const float g = (float)ig[j] * (rs * tg[n][j]), up = (float)iu[j] * (rs * tu[n][j]);
                        const float sg = g * __builtin_amdgcn_rcpf(1.0f + __builtin_amdgcn_exp2f(-1.4426950408889634f * g)); h[4 * n + j] = sg * up; } }
                *(v4u*)(HB + (size_t)row * FF + 128 * u.pn + 32 * wc + 8 * fq) = pack8f(h);
            }
    }
};
struct Dkv {
    static constexpr bool PERM = true, AFTER_DRAIN = false;
    const float* ssq; float* ckv; float* ssq_lat; float* ssq_kpe;
    __device__ __forceinline__ void operator()(const f32x4 (&acc)[2][2][4][2], const Unit& u, int wr, int wc, int fr, int fq) const {
        float sq8[2][4];
#pragma unroll
        for (int ai = 0; ai < 2; ++ai)
#pragma unroll
            for (int m = 0; m < 4; ++m) sq8[ai][m] = ssq[u.pm * BM + ai * HALF + wr * 64 + m * 16 + fr];
#pragma unroll
        for (int ai = 0; ai < 2; ++ai)
#pragma unroll
            for (int m = 0; m < 4; ++m) {
                const int row = u.pm * BM + ai * HALF + wr * 64 + m * 16 + fr;
                const float rs = rsq(sq8[ai][m] * (1.0f / D) + EPS);
                if (u.pn == 0) {
                    float ss = 0.f;
#pragma unroll
                    for (int bj = 0; bj < 2; ++bj)
#pragma unroll
                        for (int n = 0; n < 2; ++n) { const f32x4 v = acc[ai][bj][m][n] * rs; ss += (v[0] * v[0] + v[1] * v[1]) + (v[2] * v[2] + v[3] * v[3]);
                            *(f32x4*)(ckv + (size_t)row * CKVW + 128 * bj + 32 * wc + 8 * fq + 4 * n) = v; }
                    ss = fq_sum(ss); if (fq == 0) atomic_addf(ssq_lat + row, ss);
                } else if (wc < 2) { float ss = 0.f;
#pragma unroll
                    for (int n = 0; n < 2; ++n) { const f32x4 v = acc[ai][0][m][n] * rs; ss += (v[0] * v[0] + v[1] * v[1]) + (v[2] * v[2] + v[3] * v[3]);
                        *(f32x4*)(ckv + (size_t)row * CKVW + 256 + 32 * wc + 8 * fq + 4 * n) = v; }
                    ss = fq_sum(ss); if (fq == 0) atomic_addf(ssq_kpe + row, ss); }
            }
    }
};
template <bool FINAL>
struct ResidT {
    static constexpr bool PERM = true, AFTER_DRAIN = false;
    bf16_t* XB; float* P; float alpha;
    __device__ __forceinline__ void operator()(const f32x4 (&acc)[2][2][4][2], const Unit& u, int wr, int wc, int fr, int fq) const {
        v4u xv[2][4][2];
#pragma unroll
        for (int ai = 0; ai < 2; ++ai)
#pragma unroll
            for (int m = 0; m < 4; ++m) { const bf16_t* xp = XB + (size_t)(u.pm * BM + ai * HALF + wr * 64 + m * 16 + fr) * D + 256 * u.pn + 32 * wc + 8 * fq;
#pragma unroll
                for (int bj = 0; bj < 2; ++bj) xv[ai][m][bj] = *(const v4u*)(xp + 128 * bj); }
#pragma unroll
        for (int ai = 0; ai < 2; ++ai)
#pragma unroll
            for (int m = 0; m < 4; ++m) { const int row = u.pm * BM + ai * HALF + wr * 64 + m * 16 + fr;
                const size_t off = (size_t)row * D + 256 * u.pn + 32 * wc + 8 * fq; float ss = 0.f;
#pragma unroll
                for (int bj = 0; bj < 2; ++bj) { const v4u xw = xv[ai][m][bj];
                    const f32x4 v0 = (f32x4){bflo(xw.x), bfhi(xw.x), bflo(xw.y), bfhi(xw.y)} + acc[ai][bj][m][0] * alpha, v1 = (f32x4){bflo(xw.z), bfhi(xw.z), bflo(xw.w), bfhi(xw.w)} + acc[ai][bj][m][1] * alpha;
                    if constexpr (FINAL) { float* yp = P + off + 128 * bj; *(f32x4*)yp = v0; *(f32x4*)(yp + 4) = v1; }
                    else { ss += (v0[0] * v0[0] + v0[1] * v0[1]) + (v0[2] * v0[2] + v0[3] * v0[3]) + (v1[0] * v1[0] + v1[1] * v1[1]) + (v1[2] * v1[2] + v1[3] * v1[3]);
                        v4u w; w.x = cvt_pk_bf16(v0[0], v0[1]); w.y = cvt_pk_bf16(v0[2], v0[3]); w.z = cvt_pk_bf16(v1[0], v1[1]); w.w = cvt_pk_bf16(v1[2], v1[3]); *(v4u*)(XB + off + 128 * bj) = w; } }
                if constexpr (!FINAL) { ss = fq_sum(ss); if (fq == 0) atomic_addf(P + row, ss); } }
    }
};
using Resid = ResidT<false>;
using ResidY = ResidT<true>;
struct ConvIn {
    static constexpr bool PERM = true, AFTER_DRAIN = false;
    bf16_t* BB; bf16_t* UB; const float* ssq; float* csp; float* css;
    __device__ __forceinline__ void operator()(const f32x4 (&acc)[2][2][4][2], const Unit& u, int wr, int wc, int fr, int fq) const {
        float sq8[2][4];
#pragma unroll
        for (int ai = 0; ai < 2; ++ai)
#pragma unroll
            for (int m = 0; m < 4; ++m) sq8[ai][m] = ssq[u.pm * BM + ai * HALF + wr * 64 + m * 16 + fr];
#pragma unroll
        for (int ai = 0; ai < 2; ++ai)
#pragma unroll
            for (int m = 0; m < 4; ++m) {
                const int row = u.pm * BM + ai * HALF + wr * 64 + m * 16 + fr;
                const float rs = rsq(sq8[ai][m] * (1.0f / D) + EPS);
                if (u.pn < 4) {
#pragma unroll
                    for (int bj = 0; bj < 2; ++bj) { const f32x4 v0 = acc[ai][bj][m][0] * rs, v1 = acc[ai][bj][m][1] * rs;
                        v4u w; w.x = cvt_pk_bf16(v0[0], v0[1]); w.y = cvt_pk_bf16(v0[2], v0[3]); w.z = cvt_pk_bf16(v1[0], v1[1]); w.w = cvt_pk_bf16(v1[2], v1[3]);
                        *(v4u*)(BB + (size_t)row * D + 256 * u.pn + 128 * bj + 32 * wc + 8 * fq) = w; }
                } else {
                    const int ch0 = 128 * (u.pn - 4) + 32 * wc + 8 * fq;
                    const f32x4 u0 = (acc[ai][0][m][0] * rs) * (acc[ai][1][m][0] * rs), u1 = (acc[ai][0][m][1] * rs) * (acc[ai][1][m][1] * rs);
                    v4u w; w.x = cvt_pk_bf16(u0[0], u0[1]); w.y = cvt_pk_bf16(u0[2], u0[3]); w.z = cvt_pk_bf16(u1[0], u1[1]); w.w = cvt_pk_bf16(u1[2], u1[3]);
                    *(v4u*)(UB + (size_t)row * D + ch0) = w;
                    float* dst = nullptr;
                    if (row < TP) { const int t = row & (SEQ - 1); if (t >= SEQ - 2) dst = csp + (size_t)((row >> 13) * 2 + (t - (SEQ - 2))) * D + ch0; }
                    else { const int rs_ = row - TP, i = rs_ & 3; if (i >= 2) dst = css + (size_t)((rs_ >> 2) * 2 + (i - 2)) * D + ch0; }
                    if (dst) { *(f32x4*)dst = u0; *(f32x4*)(dst + 4) = u1; }
                }
            }
    }
};
struct Dq {
    static constexpr bool PERM = true, AFTER_DRAIN = false;
    bf16_t* CQB; const float* ssq; float* ssq_out;
    __device__ __forceinline__ void operator()(const f32x4 (&acc)[2][2][4][2], const Unit& u, int wr, int wc, int fr, int fq) const {
        float sq8[2][4];
#pragma unroll
        for (int ai = 0; ai < 2; ++ai)
#pragma unroll
            for (int m = 0; m < 4; ++m) sq8[ai][m] = ssq[u.pm * BM + ai * HALF + wr * 64 + m * 16 + fr];
#pragma unroll
        for (int ai = 0; ai < 2; ++ai)
#pragma unroll
            for (int m = 0; m < 4; ++m) {
                const int row = u.pm * BM + ai * HALF + wr * 64 + m * 16 + fr;
                const float rs = rsq(sq8[ai][m] * (1.0f / D) + EPS);
                float ss = 0.f;
#pragma unroll
                for (int bj = 0; bj < 2; ++bj) { const f32x4 v0 = acc[ai][bj][m][0] * rs, v1 = acc[ai][bj][m][1] * rs;
                    ss += (v0[0] * v0[0] + v0[1] * v0[1]) + (v0[2] * v0[2] + v0[3] * v0[3]) + (v1[0] * v1[0] + v1[1] * v1[1]) + (v1[2] * v1[2] + v1[3] * v1[3]);
                    v4u w; w.x = cvt_pk_bf16(v0[0], v0[1]); w.y = cvt_pk_bf16(v0[2], v0[3]); w.z = cvt_pk_bf16(v1[0], v1[1]); w.w = cvt_pk_bf16(v1[2], v1[3]);
                    *(v4u*)(CQB + (size_t)row * QRANK + 256 * u.pn + 128 * bj + 32 * wc + 8 * fq) = w; }
                ss = fq_sum(ss); if (fq == 0) atomic_addf(ssq_out + row, ss);
            }
    }
};
struct Uq {
    static constexpr bool PERM = true, AFTER_DRAIN = false;
    bf16_t* QB; const float* ssq; float* ssq_q;
    __device__ __forceinline__ void operator()(const f32x4 (&acc)[2][2][4][2], const Unit& u, int wr, int wc, int fr, int fq) const {
        float sq8[2][4];
#pragma unroll
        for (int ai = 0; ai < 2; ++ai)
#pragma unroll
            for (int m = 0; m < 4; ++m) sq8[ai][m] = ssq[u.pm * BM + ai * HALF + wr * 64 + m * 16 + fr];
#pragma unroll
        for (int ai = 0; ai < 2; ++ai)
#pragma unroll
            for (int m = 0; m < 4; ++m) {
                const int row = u.pm * BM + ai * HALF + wr * 64 + m * 16 + fr;
                const float rs = rsq(sq8[ai][m] * (1.0f / QRANK) + EPS);
#pragma unroll
                for (int bj = 0; bj < 2; ++bj) { const f32x4 v0 = acc[ai][bj][m][0] * rs, v1 = acc[ai][bj][m][1] * rs;
                    float ss = (v0[0] * v0[0] + v0[1] * v0[1]) + (v0[2] * v0[2] + v0[3] * v0[3]) + (v1[0] * v1[0] + v1[1] * v1[1]) + (v1[2] * v1[2] + v1[3] * v1[3]);
                    const int cb = 256 * u.pn + 128 * bj + 32 * wc;
                    const int hh = cb / HD, seg = 2 * hh + ((cb - hh * HD) >= 128 ? 1 : 0);
                    v4u w; w.x = cvt_pk_bf16(v0[0], v0[1]); w.y = cvt_pk_bf16(v0[2], v0[3]); w.z = cvt_pk_bf16(v1[0], v1[1]); w.w = cvt_pk_bf16(v1[2], v1[3]);
                    *(v4u*)(QB + (size_t)row * NQ + cb + 8 * fq) = w;
                    ss = fq_sum(ss); if (fq == 0) atomic_addf(ssq_q + (size_t)seg * T + row, ss); }
            }
    }
};
struct Kv {
    static constexpr bool PERM = true, AFTER_DRAIN = false;
    bf16_t* KU; bf16_t* VB; float* RP; size_t nrows;
    __device__ __forceinline__ void operator()(const f32x4 (&acc)[2][2][4][2], const Unit& u, int wr, int wc, int fr, int fq) const {
#pragma unroll
        for (int ai = 0; ai < 2; ++ai)
#pragma unroll
            for (int m = 0; m < 4; ++m) {
                const unsigned row = (unsigned)(u.pm * BM + ai * HALF + wr * 64 + m * 16 + fr);
                if (u.pn < 4) {
                    const int head = 2 * u.pn + (wc >> 1);
                    float ss = 0.f;
#pragma unroll
                    for (int bj = 0; bj < 2; ++bj) { const f32x4 v0 = acc[ai][bj][m][0], v1 = acc[ai][bj][m][1];
                        ss += (v0[0] * v0[0] + v0[1] * v0[1]) + (v0[2] * v0[2] + v0[3] * v0[3]) + (v1[0] * v1[0] + v1[1] * v1[1]) + (v1[2] * v1[2] + v1[3] * v1[3]);
                        if (KU) { v4u w; w.x = cvt_pk_bf16(v0[0], v0[1]); w.y = cvt_pk_bf16(v0[2], v0[3]); w.z = cvt_pk_bf16(v1[0], v1[1]); w.w = cvt_pk_bf16(v1[2], v1[3]);
                            *(v4u*)(KU + (size_t)(row * D + 128 * head + 64 * (wc & 1) + 32 * bj + 8 * fq)) = w; } }
                    ss = fq_sum(ss); if (fq == 0) RP[(size_t)((unsigned)(2 * head + (wc & 1)) * (unsigned)nrows + row)] = ss;
                } else if (VB) {
#pragma unroll
                    for (int bj = 0; bj < 2; ++bj) { const f32x4 v0 = acc[ai][bj][m][0], v1 = acc[ai][bj][m][1];
                        v4u w; w.x = cvt_pk_bf16(v0[0], v0[1]); w.y = cvt_pk_bf16(v0[2], v0[3]); w.z = cvt_pk_bf16(v1[0], v1[1]); w.w = cvt_pk_bf16(v1[2], v1[3]);
                        *(v4u*)(VB + (size_t)(row * D + 256 * (u.pn - 4) + 128 * bj + 32 * wc + 8 * fq)) = w; }
                }
            }
    }
};
struct Kv8 {
    static constexpr bool PERM = true, AFTER_DRAIN = false;
    float* RP; const float* sc2; const LAS float* t2; size_t nrows;
    __device__ __forceinline__ void operator()(const f32x4 (&acc)[2][2][4][2], const Unit& u, int wr, int wc, int fr, int fq) const {
        typedef int i32x4 __attribute__((ext_vector_type(4)));
        const int head = 2 * u.pn + (wc >> 1);
        int fq_ = fq; asm volatile("" : "+v"(fq_));
        float ss[2][4];
#pragma unroll
        for (int ai = 0; ai < 2; ++ai)
#pragma unroll
            for (int m = 0; m < 4; ++m) ss[ai][m] = 0.f;
#pragma unroll
        for (int bj = 0; bj < 2; ++bj)
#pragma unroll
            for (int n = 0; n < 2; ++n) { const f32x4 tv = *(const LAS f32x4*)(t2 + 256 * u.pn + 128 * bj + 32 * wc + 8 * fq_ + 4 * n);
#pragma unroll
                for (int ai = 0; ai < 2; ++ai)
#pragma unroll
                    for (int m = 0; m < 4; ++m) { const i32x4 vi = __builtin_bit_cast(i32x4, acc[ai][bj][m][n]);
#pragma unroll
                        for (int j = 0; j < 4; ++j) { const float f = (float)vi[j]; ss[ai][m] += f * f * tv[j]; } } }
#pragma unroll
        for (int ai = 0; ai < 2; ++ai)
#pragma unroll
            for (int m = 0; m < 4; ++m) {
                const unsigned row = (unsigned)(u.pm * BM + ai * HALF + wr * 64 + m * 16 + fr);
                const float s_ = fq_sum(ss[ai][m]); if (fq == 0) RP[(size_t)((unsigned)(2 * head + (wc & 1)) * (unsigned)nrows + row)] = s_;
            }
    }
};
struct Slab {
    static constexpr bool PERM = true, AFTER_DRAIN = false;
    float* slab;
    __device__ __forceinline__ void operator()(const f32x4 (&acc)[2][2][4][2], const Unit& u, int wr, int wc, int fr, int fq) const {
        float* base = slab + (size_t)(u.ko >> 9) * TS * D;
#pragma unroll
        for (int ai = 0; ai < 2; ++ai)
#pragma unroll
            for (int m = 0; m < 4; ++m) { float* p = base + (size_t)(u.pm * BM + ai * HALF + wr * 64 + m * 16 + fr) * D + 256 * u.pn + 32 * wc + 8 * fq;
#pragma unroll
                for (int bj = 0; bj < 2; ++bj) { *(f32x4*)(p + 128 * bj) = acc[ai][bj][m][0]; *(f32x4*)(p + 128 * bj + 4) = acc[ai][bj][m][1]; } }
    }
};
}

struct Ctx {
    LAS unsigned char* lds;
    int tid, lane, wave, vcu, G;
};
struct PrepD { const float* W; const float* gain; bf16_t* WT; int K, N, drow0, k0, n0; };
__device__ __forceinline__ void prep_load(const PrepD& d, f32x4 (&v)[8], float (&gk)[8], int lane) {
    if (!d.W) return;
    const int r = lane >> 3, c4 = lane & 7;
#pragma unroll
    for (int i = 0; i < 8; ++i) { v[i] = *(const f32x4*)(d.W + (size_t)(d.k0 + 8 * i + r) * d.N + d.n0 + 4 * c4); gk[i] = d.gain ? d.gain[d.k0 + 8 * i + r] : 1.0f; }
}
__device__ __forceinline__ void prep_finish(const PrepD& d, const f32x4 (&v)[8], const float (&gk)[8], LAS float* scr, int lane) {
    if (!d.W) { const v4u z = {0u, 0u, 0u, 0u};
#pragma unroll
        for (int j = 0; j < 2; ++j) *(v4u*)(d.WT + 8 * (lane + 64 * j)) = z;
        return; }
    { const int r = lane >> 3, c4 = lane & 7;
#pragma unroll
      for (int i = 0; i < 8; ++i) { LAS float* sp = scr + (8 * i + r) * 33 + 4 * c4; sp[0] = v[i].x * gk[i]; sp[1] = v[i].y * gk[i]; sp[2] = v[i].z * gk[i]; sp[3] = v[i].w * gk[i]; } }
    LDS_WAIT(); asm volatile("" ::: "memory");
    const int c = lane & 7;
#pragma unroll
    for (int j = 0; j < 4; ++j) { const int n = (lane >> 3) + 8 * j; const LAS float* s = scr + (8 * c) * 33 + n;
        v4u o; o.x = cvt_pk_bf16(s[0 * 33], s[1 * 33]); o.y = cvt_pk_bf16(s[2 * 33], s[3 * 33]); o.z = cvt_pk_bf16(s[4 * 33], s[5 * 33]); o.w = cvt_pk_bf16(s[6 * 33], s[7 * 33]);
        *(v4u*)(d.WT + (size_t)(d.drow0 + n) * d.K + d.k0 + 8 * c) = o; }
    LDS_WAIT(); asm volatile("" ::: "memory");
}
__device__ __forceinline__ int gu_map(int nb) { const int up = nb >= 88 ? 1 : 0, hb = nb - 88 * up; return 256 * (hb >> 2) + 128 * up + 32 * (hb & 3); }
__device__ __forceinline__ int ci_map(int nb) { if (nb < 32) return 32 * nb; const int hh = nb >= 64 ? 1 : 0, cb = nb - 32 - 32 * hh; return 256 * (4 + (cb >> 2)) + 128 * hh + 32 * (cb & 3); }
__device__ __forceinline__ int uk_map(int nb) { const int h = nb >> 2, dq = nb & 3; return 256 * (h >> 1) + 128 * (dq & 1) + 32 * (2 * (h & 1) + (dq >> 1)); }
__device__ __forceinline__ int uk_row(int h, int d) { return 256 * (h >> 1) + 128 * ((d >> 5) & 1) + 32 * (2 * (h & 1) + (d >> 6)) + (d & 31); }

struct Ptrs {
    const float* in[29]; float* out; unsigned char* ws;
};
typedef const __attribute__((address_space(4))) Ptrs CPtrs;

__device__ __forceinline__ void phase_prologue(const Ctx& C, CPtrs& P) {
    unsigned char* ws = P.ws;
    LAS float* scr = (LAS float*)(C.lds + RING_OFF + C.wave * 16384);
    const int lane = C.lane;
    const int gw = C.vcu * NWAVES + C.wave, NGW = C.G * NWAVES;
    constexpr int I_GU = 16 * 176, I_DKV = 16 * 10, I_DN = 44 * 32, I_CI = 16 * 96, I_SQ = 16 * 32, I_DQ = 16 * 16, I_UQ = 8 * 48, I_UKV = 4 * 32, I_Z = 192;
    constexpr int NITEMS = I_DKV + 4 * I_DN + I_CI + I_SQ + I_DQ + I_UQ + I_SQ + 2 * I_UKV + I_Z;
    auto decode = [&](int it) -> PrepD {
        int r = it;
        if (r < I_DKV) { const int kb = r / 10, nb = r % 10; return PrepD{P.in[23], P.in[22], (bf16_t*)(ws + WS_WDKV), D, CKVW, 32 * nb, 64 * (kb), 32 * (nb)}; } r -= I_DKV;
        if (r < 4 * I_DN) { const int mi = r / I_DN; r -= mi * I_DN; const int kb = r / 32, nb = r % 32;
            const float* W = (mi & 1 ? P.in[12] : P.in[8]) + (size_t)(mi >> 1) * FF * D;
            bf16_t* dst = (bf16_t*)(ws + (mi == 0 ? WS_WDN0 : mi == 1 ? WS_WDN1 : mi == 2 ? WS_WDN2 : WS_WDN3));
            return PrepD{W, nullptr, dst, FF, D, 32 * nb, 64 * (kb), 32 * (nb)}; } r -= 4 * I_DN;
        if (r < I_CI) { const int kb = r / 96, nb = r % 96; return PrepD{P.in[13], P.in[9], (bf16_t*)(ws + WS_WCI), D, 3 * D, ci_map(nb), 64 * (kb), 32 * (nb)}; } r -= I_CI;
        if (r < I_SQ) { const int kb = r / 32, nb = r % 32; return PrepD{P.in[15], nullptr, (bf16_t*)(ws + WS_WCO), D, D, 32 * nb, 64 * (kb), 32 * (nb)}; } r -= I_SQ;
        if (r < I_DQ) { const int kb = r / 16, nb = r % 16; return PrepD{P.in[16], P.in[9] + D, (bf16_t*)(ws + WS_WDQ), D, QRANK, 32 * nb, 64 * (kb), 32 * (nb)}; } r -= I_DQ;
        if (r < I_UQ) { const int kb = r / 48, nb = r % 48; return PrepD{P.in[18], P.in[17], (bf16_t*)(ws + WS_WUQ), QRANK, NQ, 32 * nb, 64 * (kb), 32 * (nb)}; } r -= I_UQ;
        if (r < I_SQ) { const int kb = r / 32, nb = r % 32; return PrepD{P.in[21], nullptr, (bf16_t*)(ws + WS_WO), D, D, 32 * nb, 64 * (kb), 32 * (nb)}; } r -= I_SQ;
        if (r < I_UKV) { const int kb = r / 32, nb = r % 32; return PrepD{P.in[26], nullptr, (bf16_t*)(ws + WS_WUKV), KVR, D, uk_map(nb), 64 * (kb), 32 * (nb)}; } r -= I_UKV;
        if (r < I_UKV) { const int kb = r / 32, nb = r % 32; return PrepD{P.in[27], nullptr, (bf16_t*)(ws + WS_WUKV), KVR, D, 1024 + 32 * nb, 64 * (kb), 32 * (nb)}; } r -= I_UKV;
        return PrepD{nullptr, nullptr, (bf16_t*)(ws + WS_WDKV) + (size_t)(320 + r) * D, 0, 0, 0, 0, 0};
    };
    if (gw < NITEMS) {
        PrepD cur = decode(gw); f32x4 v[8]; float gk[8]; prep_load(cur, v, gk, lane);
        for (int it = gw; it < NITEMS; it += NGW) {
            PrepD nxt = cur; f32x4 vn[8]; float gn[8];
            if (it + NGW < NITEMS) { nxt = decode(it + NGW); prep_load(nxt, vn, gn, lane); }
            prep_finish(cur, v, gk, scr, lane);
            cur = nxt;
#pragma unroll
            for (int i = 0; i < 8; ++i) { v[i] = vn[i]; gk[i] = gn[i]; }
        }
    }
    {
        f32x2* tab = (f32x2*)(ws + WS_ROPE);
        for (int e = gw * 64 + lane; e < (SEQ + DS) * 32; e += NGW * 64) {
            const int pos = e >> 5, j = e & 31;
            double f = 1.0; for (int i = 0; i < j; ++i) f *= 0.74989420933245582730;
            const double ang = (double)pos * f;
            const double k = __builtin_rint(ang * 0.15915494309189533577);
            double r = __builtin_fma(-k, 6.283185307179586232, ang); r = __builtin_fma(-k, 2.4492935982947064e-16, r);
            const double r2 = r * r; double ts = 1.0, tc = 1.0, ss = 1.0, cs = 1.0;
#pragma unroll
            for (int q = 1; q <= 14; ++q) { tc *= -r2 / (double)((2 * q - 1) * (2 * q)); cs += tc; ts *= -r2 / (double)((2 * q) * (2 * q + 1)); ss += ts; }
            tab[e] = (f32x2){(float)cs, (float)(ss * r)};
        }
    }
    {
        bf16_t* XB = (bf16_t*)(ws + WS_XB); float* ssq = (float*)(ws + WS_CTL) + F_SSQX; unsigned char* A8 = ws + WS_A8; float* SA = (float*)(ws + WS_SA);
        for (int row0 = gw; row0 < T; row0 += 2 * NGW) {
            f32x4 v[2][4]; float s[2]; const int nr = row0 + NGW < T ? 2 : 1;
#pragma unroll
            for (int q = 0; q < 2; ++q) { const int row = row0 + (q < nr ? q * NGW : 0); const float* src = row < TP ? P.in[0] + (size_t)row * D : P.in[1] + (size_t)(row - TP) * D;
#pragma unroll
                for (int j = 0; j < 4; ++j) v[q][j] = *((const f32x4*)src + lane + 64 * j); }
#pragma unroll
            for (int q = 0; q < 2; ++q) { s[q] = 0.f;
#pragma unroll
                for (int j = 0; j < 4; ++j) s[q] += (v[q][j].x * v[q][j].x + v[q][j].y * v[q][j].y) + (v[q][j].z * v[q][j].z + v[q][j].w * v[q][j].w);
                s[q] = wave_sum(s[q]); }
#pragma unroll
            for (int q = 0; q < 2; ++q) if (q < nr) { const int row = row0 + q * NGW;
#pragma unroll
                for (int j = 0; j < 4; ++j) {
                    u32x2 w; w.x = cvt_pk_bf16(v[q][j].x, v[q][j].y); w.y = cvt_pk_bf16(v[q][j].z, v[q][j].w); *((u32x2*)(XB + (size_t)row * D) + lane + 64 * j) = w; }
                if (lane == 0) ssq[row] = s[q];
                float am = 0.f;
#pragma unroll
                for (int j = 0; j < 4; ++j) am = fmaxf(am, fmaxf(fmaxf(fabsf(v[q][j].x), fabsf(v[q][j].y)), fmaxf(fabsf(v[q][j].z), fabsf(v[q][j].w))));
#pragma unroll
                for (int o = 1; o < 64; o <<= 1) am = fmaxf(am, __shfl_xor(am, o));
                const float inv = am > 0.f ? 127.0f / am : 0.f;
#pragma unroll
                for (int j = 0; j < 4; ++j) { const int q0 = __float2int_rn(v[q][j].x * inv), q1 = __float2int_rn(v[q][j].y * inv), q2 = __float2int_rn(v[q][j].z * inv), q3 = __float2int_rn(v[q][j].w * inv);
                    *(unsigned*)(A8 + (size_t)row * D + 4 * (lane + 64 * j)) = (unsigned)(q0 & 255) | ((unsigned)(q1 & 255) << 8) | ((unsigned)(q2 & 255) << 16) | ((unsigned)q3 << 24); }
                if (lane == 0) SA[row] = am * (1.0f / 127.0f); }
        }
    }
}

#ifndef SA_INT8_COPY_ONLY
#define SA_INT8_COPY_ONLY 1
#endif
__device__ __forceinline__ void phase_cacheconv(const Ctx& C, CPtrs& P, int cw, int nconv) {
    unsigned char* ws = P.ws; const int lane = C.lane;
    const int* pt = (const int*)P.in[5]; bf16_t* CLB = (bf16_t*)(ws + WS_CLB); unsigned char* CL8 = ws + WS_CL8; float* SC2 = (float*)(ws + WS_SC2);
    for (int pg = cw * NWAVES + C.wave; pg < DB * NPG; pg += nconv * NWAVES) {
        const int phys = pt[pg];
        const float* sl = P.in[2] + (size_t)phys * PAGE * KVR; bf16_t* dl = CLB + (size_t)pg * PAGE * KVR;
        for (int i0 = 0; i0 < 64; i0 += 8) {
            f32x4 a[8], c[8];
#pragma unroll
            for (int j = 0; j < 8; ++j) { a[j] = *((const f32x4*)sl + 2 * (lane + 64 * (i0 + j))); c[j] = *((const f32x4*)sl + 2 * (lane + 64 * (i0 + j)) + 1); }
#pragma unroll
            for (int j = 0; j < 8; ++j) {
#if !SA_INT8_COPY_ONLY
                { v4u w; w.x = cvt_pk_bf16(a[j].x, a[j].y); w.y = cvt_pk_bf16(a[j].z, a[j].w); w.z = cvt_pk_bf16(c[j].x, c[j].y); w.w = cvt_pk_bf16(c[j].z, c[j].w); *((v4u*)dl + lane + 64 * (i0 + j)) = w; }
#endif
                float am = fmaxf(fmaxf(fmaxf(fabsf(a[j].x), fabsf(a[j].y)), fmaxf(fabsf(a[j].z), fabsf(a[j].w))), fmaxf(fmaxf(fabsf(c[j].x), fabsf(c[j].y)), fmaxf(fabsf(c[j].z), fabsf(c[j].w))));
#pragma unroll
                for (int o = 1; o < 32; o <<= 1) am = fmaxf(am, __shfl_xor(am, o));
                const float inv = am > 0.f ? 127.0f / am : 0.f;
                const int q0 = __float2int_rn(a[j].x * inv), q1 = __float2int_rn(a[j].y * inv), q2 = __float2int_rn(a[j].z * inv), q3 = __float2int_rn(a[j].w * inv);
                const int q4 = __float2int_rn(c[j].x * inv), q5 = __float2int_rn(c[j].y * inv), q6 = __float2int_rn(c[j].z * inv), q7 = __float2int_rn(c[j].w * inv);
                u32x2 qw; qw.x = (unsigned)(q0 & 255) | ((unsigned)(q1 & 255) << 8) | ((unsigned)(q2 & 255) << 16) | ((unsigned)q3 << 24);
                qw.y = (unsigned)(q4 & 255) | ((unsigned)(q5 & 255) << 8) | ((unsigned)(q6 & 255) << 16) | ((unsigned)q7 << 24);
                const size_t row = (size_t)pg * PAGE + 2 * (i0 + j) + (lane >> 5);
                *(u32x2*)(CL8 + row * KVR + 8 * (lane & 31)) = qw;
                if ((lane & 31) == 0) { const float sc = am * (1.0f / 127.0f); SC2[row] = sc * sc; } }
        }
    }
}

__device__ __forceinline__ void phase_w8(const Ctx& C, CPtrs& P) {
    unsigned char* ws = P.ws; const float* wuk = P.in[26]; unsigned char* W8 = ws + WS_W8; float* T2 = (float*)(ws + WS_T2); const int lane = C.lane;
    for (int r = C.vcu * NWAVES + C.wave; r < D; r += C.G * NWAVES) {
        const int pn = r >> 8, bj = (r >> 7) & 1, wc = (r >> 5) & 3, h = 2 * pn + (wc >> 1), d = 64 * (wc & 1) + 32 * bj + (r & 31), col = 128 * h + d;
        float x[4]; float am = 0.f;
#pragma unroll
        for (int e = 0; e < 4; ++e) { x[e] = wuk[(size_t)(4 * lane + e) * D + col]; am = fmaxf(am, fabsf(x[e])); }
#pragma unroll
        for (int o = 1; o < 64; o <<= 1) am = fmaxf(am, __shfl_xor(am, o));
        const float inv = am > 0.f ? 127.0f / am : 0.f;
        const int q0 = __float2int_rn(x[0] * inv), q1 = __float2int_rn(x[1] * inv), q2 = __float2int_rn(x[2] * inv), q3 = __float2int_rn(x[3] * inv);
        *(unsigned*)(W8 + (size_t)r * KVR + 4 * lane) = (unsigned)(q0 & 255) | ((unsigned)(q1 & 255) << 8) | ((unsigned)(q2 & 255) << 16) | ((unsigned)q3 << 24);
        if (lane == 0) { const float sc = am * (1.0f / 127.0f); T2[r] = sc * sc; }
    }
}

__device__ __forceinline__ void phase_quant(const Ctx& C, CPtrs& P, const float* slab = nullptr, int ns = 0, float* ssq_out = nullptr) {
    unsigned char* ws = P.ws; bf16_t* XB = (bf16_t*)(ws + WS_XB); unsigned char* A8 = ws + WS_A8; float* SA = (float*)(ws + WS_SA);
    const int gw = C.vcu * NWAVES + C.wave, NGW = C.G * NWAVES, lane = C.lane;
    if (slab) {
        for (int r = gw; r < TS; r += NGW) { const size_t row = (size_t)TP + r; f32x4 v[4]; float ss = 0.f, am = 0.f;
#pragma unroll
            for (int j = 0; j < 4; ++j) { const u32x2 xw = *((const u32x2*)(XB + row * D) + lane + 64 * j); f32x4 a = {bflo(xw.x), bfhi(xw.x), bflo(xw.y), bfhi(xw.y)};
                for (int c = 0; c < ns; ++c) a += *((const f32x4*)(slab + ((size_t)c * TS + r) * D) + lane + 64 * j);
                v[j] = a; ss += (a.x * a.x + a.y * a.y) + (a.z * a.z + a.w * a.w); am = fmaxf(am, fmaxf(fmaxf(fabsf(a.x), fabsf(a.y)), fmaxf(fabsf(a.z), fabsf(a.w)))); }
            ss = wave_sum(ss);
#pragma unroll
            for (int o = 1; o < 64; o <<= 1) am = fmaxf(am, __shfl_xor(am, o));
            const float inv = am > 0.f ? 127.0f / am : 0.f;
#pragma unroll
            for (int j = 0; j < 4; ++j) { u32x2 w; w.x = cvt_pk_bf16(v[j].x, v[j].y); w.y = cvt_pk_bf16(v[j].z, v[j].w); *((u32x2*)(XB + row * D) + lane + 64 * j) = w;
                const int q0 = __float2int_rn(v[j].x * inv), q1 = __float2int_rn(v[j].y * inv), q2 = __float2int_rn(v[j].z * inv), q3 = __float2int_rn(v[j].w * inv);
                *(unsigned*)(A8 + row * D + 4 * (lane + 64 * j)) = (unsigned)(q0 & 255) | ((unsigned)(q1 & 255) << 8) | ((unsigned)(q2 & 255) << 16) | ((unsigned)q3 << 24); }
            if (lane == 0) { ssq_out[row] = ss; SA[row] = am * (1.0f / 127.0f); } }
    }
    const int TQ = slab ? TP : T;
    constexpr int RPS = 4;
    for (int row0 = gw; row0 < TQ; row0 += RPS * NGW) {
        v4u w[RPS][2];
#pragma unroll
        for (int q = 0; q < RPS; ++q) { const int rq = row0 + q * NGW, row = rq < TQ ? rq : row0; w[q][0] = *((const v4u*)(XB + (size_t)row * D) + 2 * lane); w[q][1] = *((const v4u*)(XB + (size_t)row * D) + 2 * lane + 1); }
#pragma unroll
        for (int q = 0; q < RPS; ++q) if (row0 + q * NGW < TQ) { const int row = row0 + q * NGW; float x[16]; unpack8f(w[q][0], x); unpack8f(w[q][1], x + 8);
            float am = 0.f;
#pragma unroll
            for (int e = 0; e < 16; ++e) am = fmaxf(am, fabsf(x[e]));
#pragma unroll
            for (int o = 1; o < 64; o <<= 1) am = fmaxf(am, __shfl_xor(am, o));
            const float inv = am > 0.f ? 127.0f / am : 0.f; v4u o4; unsigned ww[4];
#pragma unroll
            for (int g = 0; g < 4; ++g) { const int q0 = __float2int_rn(x[4 * g] * inv), q1 = __float2int_rn(x[4 * g + 1] * inv), q2 = __float2int_rn(x[4 * g + 2] * inv), q3 = __float2int_rn(x[4 * g + 3] * inv);
                ww[g] = (unsigned)(q0 & 255) | ((unsigned)(q1 & 255) << 8) | ((unsigned)(q2 & 255) << 16) | ((unsigned)q3 << 24); }
            o4.x = ww[0]; o4.y = ww[1]; o4.z = ww[2]; o4.w = ww[3];
            *((v4u*)(A8 + (size_t)row * D) + lane) = o4;
            if (lane == 0) SA[row] = am * (1.0f / 127.0f); }
    }
}
__device__ __forceinline__ void phase_w8gu(const Ctx& C, CPtrs& P) {
    unsigned char* ws = P.ws; const int lane = C.lane, r = lane >> 3, c4 = lane & 7;
    LAS float* scr = (LAS float*)(C.lds + RING_OFF + C.wave * 16384);
    for (int item = C.vcu * NWAVES + C.wave; item < 4 * 176; item += C.G * NWAVES) {
        const int mi = item / 176, nb = item % 176, n0 = 32 * nb, N = 2 * FF;
        const float* W = (mi & 1 ? P.in[11] : P.in[7]) + (size_t)(mi >> 1) * D * N; const float* g = (mi & 1 ? P.in[10] : P.in[6]) + (mi >> 1) * D;
        unsigned char* W8 = ws + WS_W8GU0 + (size_t)mi * WS_W8GU_STRIDE; float* TS = (float*)(ws + WS_TGU) + mi * N;
        const int drow0 = gu_map(nb);
        float am[4] = {0.f, 0.f, 0.f, 0.f};
#pragma unroll 16
        for (int kb = 0; kb < D / 8; ++kb) { const int k = 8 * kb + r; const f32x4 v = *(const f32x4*)(W + (size_t)k * N + n0 + 4 * c4); const float gk = g[k];
            am[0] = fmaxf(am[0], fabsf(v.x * gk)); am[1] = fmaxf(am[1], fabsf(v.y * gk)); am[2] = fmaxf(am[2], fabsf(v.z * gk)); am[3] = fmaxf(am[3], fabsf(v.w * gk)); }
        float inv[4];
#pragma unroll
        for (int j = 0; j < 4; ++j) { float a = am[j]; a = fmaxf(a, __shfl_xor(a, 8)); a = fmaxf(a, __shfl_xor(a, 16)); a = fmaxf(a, __shfl_xor(a, 32)); inv[j] = a > 0.f ? 127.0f / a : 0.f; am[j] = a; }
        if (r == 0) *(f32x4*)(TS + drow0 + 4 * c4) = (f32x4){am[0] * (1.0f / 127.0f), am[1] * (1.0f / 127.0f), am[2] * (1.0f / 127.0f), am[3] * (1.0f / 127.0f)};
        for (int k0 = 0; k0 < D; k0 += 64) {
            f32x4 v[8]; float gk[8];
#pragma unroll
            for (int i = 0; i < 8; ++i) { v[i] = *(const f32x4*)(W + (size_t)(k0 + 8 * i + r) * N + n0 + 4 * c4); gk[i] = g[k0 + 8 * i + r]; }
#pragma unroll
            for (int i = 0; i < 8; ++i) { LAS float* sp = scr + (8 * i + r) * 33 + 4 * c4;
                sp[0] = __builtin_rintf(v[i].x * gk[i] * inv[0]); sp[1] = __builtin_rintf(v[i].y * gk[i] * inv[1]); sp[2] = __builtin_rintf(v[i].z * gk[i] * inv[2]); sp[3] = __builtin_rintf(v[i].w * gk[i] * inv[3]); }
            LDS_WAIT(); asm volatile("" ::: "memory");
            const int c = lane & 7;
#pragma unroll
            for (int j = 0; j < 4; ++j) { const int n = (lane >> 3) + 8 * j; const LAS float* s = scr + (8 * c) * 33 + n;
                const int q0 = (int)s[0 * 33], q1 = (int)s[1 * 33], q2 = (int)s[2 * 33], q3 = (int)s[3 * 33], q4 = (int)s[4 * 33], q5 = (int)s[5 * 33], q6 = (int)s[6 * 33], q7 = (int)s[7 * 33];
                u32x2 o; o.x = (unsigned)(q0 & 255) | ((unsigned)(q1 & 255) << 8) | ((unsigned)(q2 & 255) << 16) | ((unsigned)q3 << 24);
                o.y = (unsigned)(q4 & 255) | ((unsigned)(q5 & 255) << 8) | ((unsigned)(q6 & 255) << 16) | ((unsigned)q7 << 24);
                *(u32x2*)(W8 + (size_t)(drow0 + n) * D + k0 + 8 * c) = o; }
            LDS_WAIT(); asm volatile("" ::: "memory");
        }
    }
}

__device__ __forceinline__ void phase_w8gu2(const Ctx& C, CPtrs& P) {
    unsigned char* ws = P.ws; const int lane = C.lane, r = lane >> 3, c4 = lane & 7, w = C.wave;
    LAS float* S = (LAS float*)(C.lds + RING_OFF); LAS float* AM = (LAS float*)(C.lds + QS_OFF);
    __syncthreads();
    for (int item = C.vcu; item < 4 * 176; item += C.G) {
        const int mi = item / 176, nb = item % 176, n0 = 32 * nb, N = 2 * FF;
        const float* W = (mi & 1 ? P.in[11] : P.in[7]) + (size_t)(mi >> 1) * D * N; const float* g = (mi & 1 ? P.in[10] : P.in[6]) + (mi >> 1) * D;
        unsigned char* W8 = ws + WS_W8GU0 + (size_t)mi * WS_W8GU_STRIDE; float* TS = (float*)(ws + WS_TGU) + mi * N;
        const int drow0 = gu_map(nb);
        float am[4] = {0.f, 0.f, 0.f, 0.f};
#pragma unroll
        for (int hb = 0; hb < 2; ++hb) {
            f32x4 v[8]; float gk[8];
#pragma unroll
            for (int i = 0; i < 8; ++i) { const int k = 128 * w + 64 * hb + 8 * i + r; v[i] = *(const f32x4*)(W + (size_t)k * N + n0 + 4 * c4); gk[i] = g[k]; }
#pragma unroll
            for (int i = 0; i < 8; ++i) { const int k = 128 * w + 64 * hb + 8 * i + r, sw = k & 31; LAS float* sp = S + k * 32;
                const float x0 = v[i].x * gk[i], x1 = v[i].y * gk[i], x2 = v[i].z * gk[i], x3 = v[i].w * gk[i];
                am[0] = fmaxf(am[0], fabsf(x0)); am[1] = fmaxf(am[1], fabsf(x1)); am[2] = fmaxf(am[2], fabsf(x2)); am[3] = fmaxf(am[3], fabsf(x3));
                sp[(4 * c4 + 0) ^ sw] = x0; sp[(4 * c4 + 1) ^ sw] = x1; sp[(4 * c4 + 2) ^ sw] = x2; sp[(4 * c4 + 3) ^ sw] = x3; }
        }
#pragma unroll
        for (int j = 0; j < 4; ++j) { float a = am[j]; a = fmaxf(a, __shfl_xor(a, 8)); a = fmaxf(a, __shfl_xor(a, 16)); a = fmaxf(a, __shfl_xor(a, 32)); am[j] = a; }
        if (r == 0) { AM[w * 32 + 4 * c4 + 0] = am[0]; AM[w * 32 + 4 * c4 + 1] = am[1]; AM[w * 32 + 4 * c4 + 2] = am[2]; AM[w * 32 + 4 * c4 + 3] = am[3]; }
        __syncthreads();
        const int n = lane & 31, k0 = 128 * w + 64 * (lane >> 5);
        float a = 0.f;
#pragma unroll
        for (int ww = 0; ww < 8; ++ww) a = fmaxf(a, AM[ww * 32 + n]);
        const float inv = a > 0.f ? 127.0f / a : 0.f;
        if (w == 0 && lane < 32) TS[drow0 + lane] = a * (1.0f / 127.0f);
#pragma unroll
        for (int q = 0; q < 4; ++q) { unsigned o[4];
#pragma unroll
            for (int d = 0; d < 4; ++d) { unsigned wd = 0u;
#pragma unroll
                for (int e = 0; e < 4; ++e) { const int k = k0 + 16 * q + 4 * d + e; const int qi = (int)__builtin_rintf(S[k * 32 + (n ^ (k & 31))] * inv); wd |= (unsigned)(qi & 255) << (8 * e); }
                o[d] = wd; }
            v4u ov; ov.x = o[0]; ov.y = o[1]; ov.z = o[2]; ov.w = o[3]; *(v4u*)(W8 + (size_t)(drow0 + n) * D + k0 + 16 * q) = ov; }
        __syncthreads();
    }
}

__device__ __forceinline__ void phase_conv(const Ctx& C, CPtrs& P) {
    unsigned char* ws = P.ws; const bf16_t* BB = (const bf16_t*)(ws + WS_BB); const bf16_t* UB = (const bf16_t*)(ws + WS_UB); bf16_t* ZB = (bf16_t*)(ws + WS_ZB);
    const float* cw = P.in[14]; const float* st = P.in[4];
    const int gw = C.vcu * NWAVES + C.wave, NGW = C.G * NWAVES, lane = C.lane;
    for (int row = gw; row < T; row += NGW) {
        int have1, have2; const float* s1 = nullptr; const float* s2 = nullptr;
        if (row < TP) { const int t = row & (SEQ - 1); have1 = t >= 1; have2 = t >= 2; }
        else { const int r = row - TP, i = r & 3, b = r >> 2; have1 = i >= 1; have2 = i >= 2;
            if (!have1) s1 = st + (size_t)(b * 2 + 1) * D; if (!have2) s2 = st + (size_t)(b * 2 + i) * D; }
        v4u rb[2], r0[2], r1[2], r2[2];
#pragma unroll
        for (int j = 0; j < 2; ++j) { const int ch = 8 * lane + 512 * j; rb[j] = *(const v4u*)(BB + (size_t)row * D + ch); r0[j] = *(const v4u*)(UB + (size_t)row * D + ch);
            r1[j] = have1 ? *(const v4u*)(UB + (size_t)(row - 1) * D + ch) : (v4u){0u, 0u, 0u, 0u}; r2[j] = have2 ? *(const v4u*)(UB + (size_t)(row - 2) * D + ch) : (v4u){0u, 0u, 0u, 0u}; }
#pragma unroll
        for (int j = 0; j < 2; ++j) {
            const int ch = 8 * lane + 512 * j;
            float b8[8], u0[8], u1[8], u2[8], z[8];
            unpack8f(rb[j], b8); unpack8f(r0[j], u0); unpack8f(r1[j], u1); unpack8f(r2[j], u2);
            if (!have1 && s1) { const f32x4 a = *(const f32x4*)(s1 + ch), b = *(const f32x4*)(s1 + ch + 4); u1[0] = a.x; u1[1] = a.y; u1[2] = a.z; u1[3] = a.w; u1[4] = b.x; u1[5] = b.y; u1[6] = b.z; u1[7] = b.w; }
            if (!have2 && s2) { const f32x4 a = *(const f32x4*)(s2 + ch), b = *(const f32x4*)(s2 + ch + 4); u2[0] = a.x; u2[1] = a.y; u2[2] = a.z; u2[3] = a.w; u2[4] = b.x; u2[5] = b.y; u2[6] = b.z; u2[7] = b.w; }
#pragma unroll
            for (int e = 0; e < 8; ++e) z[e] = b8[e] * (cw[ch + e] * u2[e] + cw[D + ch + e] * u1[e] + cw[2 * D + ch + e] * u0[e]);
            *(v4u*)(ZB + (size_t)row * D + ch) = pack8f(z);
        }
    }
}

__device__ __forceinline__ void phase_kvfin(const Ctx& C, CPtrs& P) {
    unsigned char* ws = P.ws; const float* ckv = (const float*)(ws + WS_CKV); const float* ctl = (const float*)(ws + WS_CTL);
    bf16_t* LATB = (bf16_t*)(ws + WS_LATB); bf16_t* KPEB = (bf16_t*)(ws + WS_KPEB); const f32x2* tab = (const f32x2*)(ws + WS_ROPE);
    int lane = C.lane; asm volatile("" : "+v"(lane));
    const int gw = C.vcu * NWAVES + C.wave, NGW = C.G * NWAVES;
    const f32x4 gl = *((const f32x4*)P.in[24] + lane); const float gk = P.in[25][lane];
    for (int row0 = gw; row0 < T; row0 += 2 * NGW) {
        const int nr = row0 + NGW < T ? 2 : 1;
        float sl_[2], sk_[2], xk[2]; f32x4 vl[2]; f32x2 cs[2]; int rowq[2], posq[2];
#pragma unroll
        for (int q = 0; q < 2; ++q) { const int row = row0 + (q < nr ? q * NGW : 0); rowq[q] = row; posq[q] = row < TP ? (row & (SEQ - 1)) : SEQ + ((row - TP) & 3);
            sl_[q] = ctl[F_SSQLAT + row]; sk_[q] = ctl[F_SSQKPE + row]; vl[q] = *((const f32x4*)(ckv + (size_t)row * CKVW) + lane); xk[q] = ckv[(size_t)row * CKVW + KVR + lane]; cs[q] = tab[posq[q] * 32 + (lane & 31)]; }
#pragma unroll
        for (int q = 0; q < 2; ++q) if (q < nr) { const int row = rowq[q];
            const float rl = rsq(sl_[q] * (1.0f / KVR) + EPS), rk = rsq(sk_[q] * (1.0f / ROPE) + EPS);
            const f32x4 v = vl[q] * rl * gl;
            float* ol = row < TP ? P.out + OUT_LATP + (size_t)row * KVR : P.out + OUT_LATS + (size_t)(row - TP) * KVR;
            *((f32x4*)ol + lane) = v;
            u32x2 w; w.x = cvt_pk_bf16(v.x, v.y); w.y = cvt_pk_bf16(v.z, v.w); *((u32x2*)(LATB + (size_t)row * KVR) + lane) = w;
            const float xn = xk[q] * rk * gk, pr = __shfl_xor(xn, 32);
            const float o = lane < 32 ? xn * cs[q].x - pr * cs[q].y : xn * cs[q].x + pr * cs[q].y;
            float* ok = row < TP ? P.out + OUT_KPEP + (size_t)row * ROPE : P.out + OUT_KPES + (size_t)(row - TP) * ROPE;
            ok[lane] = o;
            const float on = __shfl_xor(o, 1);
            if ((lane & 1) == 0) *(unsigned*)(KPEB + (size_t)row * ROPE + lane) = cvt_pk_bf16(o, on); }
    }
}

__device__ __forceinline__ void phase_qkfin(const Ctx& C, CPtrs& P) {
    unsigned char* ws = P.ws; const float* ctl = (const float*)(ws + WS_CTL); bf16_t* QB = (bf16_t*)(ws + WS_QB); bf16_t* KN = (bf16_t*)(ws + WS_KN);
    const float* RPT = (const float*)(ws + WS_RPT); const f32x2* tab = (const f32x2*)(ws + WS_ROPE);
    const float* gqn = P.in[19]; const float* gqp = P.in[20]; const float* gkn = P.in[28];
    int lane = C.lane; asm volatile("" : "+v"(lane));
    const int gw = C.vcu * NWAVES + C.wave, NGW = C.G * NWAVES;
    for (int row = gw; row < TP; row += NGW) {
        const int pos = row & (SEQ - 1);
        const float* sq = ctl + F_SSQQ + row;
        bf16_t* pq[2]; bf16_t* pk[2]; v4u vq[2], vk[2]; float rq[2], rk[2];
#pragma unroll
        for (int it = 0; it < 2; ++it) { const int h = 4 * it + (lane >> 4), c = lane & 15; pq[it] = QB + (size_t)row * NQ + HD * h + 8 * c; vq[it] = *(const v4u*)pq[it]; rq[it] = sq[(size_t)(2 * h) * T];
            const int ci = lane + 64 * it, hk = ci >> 4, ck = ci & 15; pk[it] = KN + (size_t)row * D + 128 * hk + 8 * ck; vk[it] = *(const v4u*)pk[it];
            rk[it] = RPT[(size_t)(2 * hk) * T + row] + RPT[(size_t)(2 * hk + 1) * T + row]; }
        bf16_t* pr = QB + (size_t)row * NQ + HD * (lane >> 3) + 128 + 8 * (lane & 7); const v4u vr = *(const v4u*)pr; const float rr = sq[(size_t)(2 * (lane >> 3) + 1) * T];
#pragma unroll
        for (int it = 0; it < 2; ++it) { const int c = lane & 15; const float rs = rsq(rq[it] * (1.0f / 128) + EPS) * QSCALE; float x[8]; unpack8f(vq[it], x);
#pragma unroll
            for (int e = 0; e < 8; ++e) x[e] = x[e] * rs * gqn[8 * c + e];
            *(v4u*)pq[it] = pack8f(x); }
        { const int c = lane & 7; const float rs = rsq(rr * (1.0f / 64) + EPS); float x[8], y[8]; unpack8f(vr, x);
#pragma unroll
            for (int e = 0; e < 8; ++e) x[e] = x[e] * rs * gqp[8 * c + e];
#pragma unroll
            for (int e = 0; e < 8; ++e) { const float prt = __shfl_xor(x[e], 4); const f32x2 cs = tab[pos * 32 + ((8 * c + e) & 31)];
                y[e] = (c < 4 ? x[e] * cs.x - prt * cs.y : x[e] * cs.x + prt * cs.y) * QSCALE; }
            *(v4u*)pr = pack8f(y); }
#pragma unroll
        for (int jj = 0; jj < 2; ++jj) { const int c = (lane + 64 * jj) & 15; const float rs = rsq(rk[jj] * (1.0f / 128) + EPS); float x[8]; unpack8f(vk[jj], x);
#pragma unroll
            for (int e = 0; e < 8; ++e) x[e] = x[e] * rs * gkn[8 * c + e];
            *(v4u*)pk[jj] = pack8f(x); }
    }
    { float* RTS = (float*)(ws + WS_RTS);
      for (int i = C.vcu * (NWAVES * 64) + C.tid; i < TS * NH; i += C.G * (NWAVES * 64)) { const int rsi = i >> 3, h = i & 7; const size_t rw = (size_t)TP + rsi;
          RTS[i] = rsq((RPT[(size_t)(2 * h) * T + rw] + RPT[(size_t)(2 * h + 1) * T + rw]) * (1.0f / 128) + EPS); } }
    {
        LAS float* A = (LAS float*)(C.lds + RING_OFF + C.wave * 1024);
        const bf16_t* WUK = (const bf16_t*)(ws + WS_WUKV); bf16_t* QS = (bf16_t*)(ws + WS_QS);
        for (int item = gw; item < TS * NH; item += NGW) {
            const int rsi = item >> 3, h = item & 7, row = TP + rsi;
            const float* sq = ctl + F_SSQQ + row;
            { const unsigned w = *(const unsigned*)(QB + (size_t)row * NQ + HD * h + 2 * lane); const float rs = rsq(sq[(size_t)(2 * h) * T] * (1.0f / 128) + EPS);
              A[2 * lane] = bflo(w) * rs * gqn[2 * lane] * gkn[2 * lane]; A[2 * lane + 1] = bfhi(w) * rs * gqn[2 * lane + 1] * gkn[2 * lane + 1]; }
            { const float x = bf2f(QB[(size_t)row * NQ + HD * h + 128 + lane]) * rsq(sq[(size_t)(2 * h + 1) * T] * (1.0f / 64) + EPS) * gqp[lane], pr = __shfl_xor(x, 32);
              const f32x2 cs = tab[(SEQ + (rsi & 3)) * 32 + (lane & 31)];
              const float o = (lane < 32 ? x * cs.x - pr * cs.y : x * cs.x + pr * cs.y) * QSCALE, on = __shfl_xor(o, 1);
              if ((lane & 1) == 0) *(unsigned*)(QS + (size_t)item * 320 + 256 + lane) = cvt_pk_bf16(o, on); }
            LDS_WAIT(); asm volatile("" ::: "memory");
            float acc[4] = {0.f, 0.f, 0.f, 0.f};
#pragma unroll 32
            for (int d = 0; d < 128; ++d) { const u32x2 w = *(const u32x2*)(WUK + (size_t)uk_row(h, d) * KVR + 4 * lane); const float ad = A[d];
                acc[0] += bflo(w.x) * ad; acc[1] += bfhi(w.x) * ad; acc[2] += bflo(w.y) * ad; acc[3] += bfhi(w.y) * ad; }
            u32x2 o; o.x = cvt_pk_bf16(acc[0] * QSCALE, acc[1] * QSCALE); o.y = cvt_pk_bf16(acc[2] * QSCALE, acc[3] * QSCALE);
            *(u32x2*)(QS + (size_t)item * 320 + 4 * lane) = o;
            LDS_WAIT(); asm volatile("" ::: "memory");
        }
    }
}

__device__ __forceinline__ void phase_scomb(const Ctx& C, CPtrs& P) {
    unsigned char* ws = P.ws; const float* PO = (const float*)(ws + WS_PO); const float* PML = (const float*)(ws + WS_PML); bf16_t* OB = (bf16_t*)(ws + WS_OB);
    const float* wuv = P.in[27];
    const int gw = C.vcu * NWAVES + C.wave, NGW = C.G * NWAVES, lane = C.lane;
    LAS float* OL = (LAS float*)(C.lds + RING_OFF + C.wave * 1024);
    for (int item = gw; item < TS * NH; item += NGW) {
        const int rsi = item >> 3, h = item & 7, b = rsi >> 2, q = rsi & 3, rho = q * 8 + h;
        const size_t i0 = (size_t)(b * 2 + 0) * 32 + rho, i1 = (size_t)(b * 2 + 1) * 32 + rho;
        const float m0 = PML[i0 * 2], l0 = PML[i0 * 2 + 1], m1 = PML[i1 * 2], l1 = PML[i1 * 2 + 1];
        const float mm = fmaxf(m0, m1), f0 = __builtin_amdgcn_exp2f(m0 - mm), f1 = __builtin_amdgcn_exp2f(m1 - mm), inv = 1.0f / (l0 * f0 + l1 * f1);
        { const f32x4 a = *((const f32x4*)(PO + i0 * 256) + lane), c = *((const f32x4*)(PO + i1 * 256) + lane); *((LAS f32x4*)OL + lane) = (a * f0 + c * f1) * inv; }
        LDS_WAIT(); asm volatile("" ::: "memory");
        float a0 = 0.f, a1 = 0.f; const float* wp = wuv + 128 * h + 2 * lane;
#pragma unroll 32
        for (int n = 0; n < KVR; ++n) { const f32x2 w = *(const f32x2*)(wp + (size_t)n * D); const float on = OL[n]; a0 += on * w.x; a1 += on * w.y; }
        *(unsigned*)(OB + (size_t)(TP + rsi) * D + 128 * h + 2 * lane) = cvt_pk_bf16(a0, a1);
        LDS_WAIT(); asm volatile("" ::: "memory");
    }
}

namespace att {
typedef short bf16x8 __attribute__((ext_vector_type(8)));
typedef short s16x4 __attribute__((ext_vector_type(4)));
typedef float f32x16 __attribute__((ext_vector_type(16)));
typedef float f32x4 __attribute__((ext_vector_type(4)));
typedef unsigned u32x4 __attribute__((ext_vector_type(4)));
constexpr float THR = 11.5f;
#define SBAR() __builtin_amdgcn_sched_barrier(0)
__device__ __forceinline__ int crow(int r, int hi) { return (r & 3) + 8 * (r >> 2) + 4 * hi; }
__device__ __forceinline__ unsigned cvtpk(float lo, float hi) { unsigned r; asm volatile("v_cvt_pk_bf16_f32 %0, %1, %2" : "=v"(r) : "v"(lo), "v"(hi)); return r; }
__device__ __forceinline__ float xmax32(float v) { auto rr = __builtin_amdgcn_permlane32_swap(__float_as_uint(v), __float_as_uint(v), false, false); return fmaxf(__uint_as_float(rr[0]), __uint_as_float(rr[1])); }
__device__ __forceinline__ float xsum32(float v) { auto rr = __builtin_amdgcn_permlane32_swap(__float_as_uint(v), __float_as_uint(v), false, false); return __uint_as_float(rr[0]) + __uint_as_float(rr[1]); }
#define PK4(P, B_, OUT) do { unsigned a0 = cvtpk(P[B_+0], P[B_+1]), a1 = cvtpk(P[B_+2], P[B_+3]);                          \
        unsigned b0 = cvtpk(P[B_+4], P[B_+5]), b1 = cvtpk(P[B_+6], P[B_+7]);                                             \
        auto r0 = __builtin_amdgcn_permlane32_swap(a0, b0, false, false); auto r1 = __builtin_amdgcn_permlane32_swap(a1, b1, false, false); \
        u32x4 w = {r0[0], r1[0], r0[1], r1[1]}; OUT = *reinterpret_cast<bf16x8*>(&w); } while (0)

namespace pa {
constexpr int KVBLK = 64, QBLK = 32, QB = 256;
constexpr int SHM_V = 16384, SHM_K = 16384, SHM_R = 8192;
constexpr int OFF_V = 0, OFF_K = 2 * SHM_V, OFF_R = OFF_K + 2 * SHM_K, OFF_WS = OFF_R + 2 * SHM_R;
#define KSWZ(row, colB) ((row) * 256 + ((colB) ^ (((row) & 7) << 4)))
__device__ __forceinline__ int v_st(int k, int c) { const int kk = (k & ~0xC) | ((k & 4) << 1) | ((k & 8) >> 1); return ((kk >> 3) * 4 + (c >> 5)) * 512 + ((kk & 7) * 32 + (c & 31)) * 2; }
__device__ __forceinline__ int v_rd_base(int lane) { return ((lane & 3) << 3) | (((lane >> 2) & 3) << 6) | (((lane >> 4) & 1) << 5) | (((lane >> 5) & 1) << 8); }
constexpr int v_rd_off(int d0, int ks, int half) { return d0 * 512 + ks * 4096 + half * 2048; }
__device__ __forceinline__ void mask_tile(f32x16& p0, f32x16& p1, int dq) {
    const float NEG = -__builtin_inff();
#pragma unroll
    for (int r = 0; r < 16; ++r) { const int c = (r & 3) + 8 * (r >> 2); if (dq - c < 0) p0[r] = NEG; if (dq - c - 32 < 0) p1[r] = NEG; }
}
__device__ __forceinline__ void softmax_tile(f32x16& p0, f32x16& p1, float& m_reg, float& l_reg, float& alpha, bf16x8& pa0, bf16x8& pa1, bf16x8& pa2, bf16x8& pa3) {
    float pmax = p0[0];
#pragma unroll
    for (int r = 1; r < 16; ++r) pmax = fmaxf(pmax, p0[r]);
#pragma unroll
    for (int r = 0; r < 16; ++r) pmax = fmaxf(pmax, p1[r]);
    pmax = xmax32(pmax);
    float mn;
    if (__builtin_expect(__all((pmax - m_reg) <= THR), 1)) { mn = m_reg; alpha = 1.f; }
    else { mn = fmaxf(m_reg, pmax); alpha = __builtin_amdgcn_exp2f(m_reg - mn); m_reg = mn; }
#pragma unroll
    for (int r = 0; r < 16; ++r) { p0[r] = __builtin_amdgcn_exp2f(p0[r] - mn); p1[r] = __builtin_amdgcn_exp2f(p1[r] - mn); }
    float ps = 0.f;
#pragma unroll
    for (int r = 0; r < 16; ++r) ps += p0[r];
#pragma unroll
    for (int r = 0; r < 16; ++r) ps += p1[r];
    ps = xsum32(ps);
    l_reg = l_reg * alpha + ps;
    PK4(p0, 0, pa0); PK4(p0, 8, pa1); PK4(p1, 0, pa2); PK4(p1, 8, pa3);
}
template <int KB>
__device__ __forceinline__ void qkt(f32x16& p0, f32x16& p1, const char* lds, int r32, int hi, const bf16x8* qr) {
    p0 = f32x16{}; p1 = f32x16{};
    const char* kb[4];
#pragma unroll
    for (int dd = 0; dd < 4; ++dd) kb[dd] = lds + OFF_K + KB * SHM_K + KSWZ(r32, (dd * 16 + hi * 8) * 2);
#pragma unroll
    for (int d0 = 0; d0 < 8; ++d0) { const char* a = kb[d0 & 3] + (d0 >> 2) * 128;
        const bf16x8 b0 = *reinterpret_cast<const bf16x8*>(a), b1 = *reinterpret_cast<const bf16x8*>(a + 32 * 256);
        p0 = __builtin_amdgcn_mfma_f32_32x32x16_bf16(b0, qr[d0], p0, 0, 0, 0);
        p1 = __builtin_amdgcn_mfma_f32_32x32x16_bf16(b1, qr[d0], p1, 0, 0, 0); }
    const int sw = (r32 >> 1) & 7; const char* rb = lds + OFF_R + KB * SHM_R + r32 * 128;
#pragma unroll
    for (int s = 0; s < 4; ++s) { const char* a = rb + (((2 * s + hi) ^ sw) << 4);
        const bf16x8 b0 = *reinterpret_cast<const bf16x8*>(a), b1 = *reinterpret_cast<const bf16x8*>(a + 32 * 128);
        p0 = __builtin_amdgcn_mfma_f32_32x32x16_bf16(b0, qr[8 + s], p0, 0, 0, 0);
        p1 = __builtin_amdgcn_mfma_f32_32x32x16_bf16(b1, qr[8 + s], p1, 0, 0, 0); }
}
template <int VB>
__device__ __forceinline__ void pv_tile(f32x16* o, int vb0, bf16x8 pa0, bf16x8 pa1, bf16x8 pa2, bf16x8 pa3) {
#define TRRD(dst, off) asm volatile("ds_read_b64_tr_b16 %0, %1 offset:%2" : "=&v"(dst) : "v"(vb0), "i"(off) : "memory")
#define PV_KS(ks, PA) do { s16x4 l0, l1, l2, l3, h0, h1, h2, h3; constexpr int b_ = OFF_V + VB * SHM_V + v_rd_off(0, ks, 0);   \
        TRRD(l0, b_); TRRD(h0, b_ + 2048); TRRD(l1, b_ + 512); TRRD(h1, b_ + 512 + 2048); TRRD(l2, b_ + 1024); TRRD(h2, b_ + 1024 + 2048); TRRD(l3, b_ + 1536); TRRD(h3, b_ + 1536 + 2048); \
        asm volatile("s_waitcnt lgkmcnt(0)" ::: "memory"); SBAR();   \
        o[0] = __builtin_amdgcn_mfma_f32_32x32x16_bf16(PA, (bf16x8){l0[0], l0[1], l0[2], l0[3], h0[0], h0[1], h0[2], h0[3]}, o[0], 0, 0, 0);   \
        o[1] = __builtin_amdgcn_mfma_f32_32x32x16_bf16(PA, (bf16x8){l1[0], l1[1], l1[2], l1[3], h1[0], h1[1], h1[2], h1[3]}, o[1], 0, 0, 0);   \
        o[2] = __builtin_amdgcn_mfma_f32_32x32x16_bf16(PA, (bf16x8){l2[0], l2[1], l2[2], l2[3], h2[0], h2[1], h2[2], h2[3]}, o[2], 0, 0, 0);   \
        o[3] = __builtin_amdgcn_mfma_f32_32x32x16_bf16(PA, (bf16x8){l3[0], l3[1], l3[2], l3[3], h3[0], h3[1], h3[2], h3[3]}, o[3], 0, 0, 0); } while (0)
    PV_KS(0, pa0); PV_KS(1, pa1); PV_KS(2, pa2); PV_KS(3, pa3);
#undef PV_KS
#undef TRRD
}
__device__ __forceinline__ void unit(int b, int h, int qb, const bf16_t* __restrict__ QF, const bf16_t* __restrict__ KN, const bf16_t* __restrict__ KPE, const bf16_t* __restrict__ VBg, bf16_t* OB, char* lds) {
    const int tid = threadIdx.x, wid = __builtin_amdgcn_readfirstlane(tid >> 6), lane = tid & 63, r32 = lane & 31, hi = lane >> 5;
    const size_t rowb = (size_t)b * SEQ; const int q0 = qb * QB, qlo = q0 + wid * QBLK, qm = qlo + r32 - 4 * hi;
    const int NT = (q0 + QB) / KVBLK;
    float* wsf = (float*)(lds + OFF_WS) + wid * 64; float* li_l = wsf; float* al_l = wsf + 32;
    bf16x8 qr[12];
    { const bf16_t* qp = QF + (rowb + qlo + r32) * NQ + HD * h + hi * 8;
#pragma unroll
      for (int d0 = 0; d0 < 12; ++d0) qr[d0] = *reinterpret_cast<const bf16x8*>(qp + d0 * 16); }
    const int sr = tid >> 4, sc = (tid & 15) * 8, rr = tid >> 3, rc = tid & 7;
    const int kws = KSWZ(sr, sc * 2), vst0 = v_st(sr, sc), vst1 = v_st(32 + sr, sc), rws = rr * 128 + ((rc ^ ((rr >> 1) & 7)) << 4);
    const bf16_t* Kg = KN + (rowb + sr) * D + 128 * h + sc; const bf16_t* Vg = VBg + (rowb + sr) * D + 128 * h + sc; const bf16_t* Rg = KPE + (rowb + rr) * ROPE + rc * 8;
    bf16x8 st_k0, st_k1, st_v0, st_v1, st_r;
#define SLOAD(t) do { const size_t ko = (size_t)(t) * KVBLK * D; st_k0 = *reinterpret_cast<const bf16x8*>(Kg + ko); st_k1 = *reinterpret_cast<const bf16x8*>(Kg + ko + 32 * D); \
        st_v0 = *reinterpret_cast<const bf16x8*>(Vg + ko); st_v1 = *reinterpret_cast<const bf16x8*>(Vg + ko + 32 * D); st_r = *reinterpret_cast<const bf16x8*>(Rg + (size_t)(t) * KVBLK * ROPE); } while (0)
#define SWRITE(bf) do { *(bf16x8*)(lds + OFF_K + (bf) * SHM_K + kws) = st_k0; *(bf16x8*)(lds + OFF_K + (bf) * SHM_K + kws + 32 * 256) = st_k1; \
        *(bf16x8*)(lds + OFF_V + (bf) * SHM_V + vst0) = st_v0; *(bf16x8*)(lds + OFF_V + (bf) * SHM_V + vst1) = st_v1; *(bf16x8*)(lds + OFF_R + (bf) * SHM_R + rws) = st_r; } while (0)
    const int vb0 = (int)(uintptr_t)lds + v_rd_base(lane);
    float m_reg = -1e30f, l_reg = 0.f, alpha; f32x16 o[4] = {}; f32x16 p0, p1; bf16x8 pa0, pa1, pa2, pa3;
    SLOAD(0); SWRITE(0); __syncthreads();
#define STEP(t, CB) do { if ((t) + 1 < NT) SLOAD((t) + 1); SBAR();                                                            \
        qkt<CB>(p0, p1, lds, r32, hi, qr);                                                                                    \
        if (KVBLK * (t) + KVBLK - 1 > qlo) mask_tile(p0, p1, qm - KVBLK * (t));                                               \
        softmax_tile(p0, p1, m_reg, l_reg, alpha, pa0, pa1, pa2, pa3);                                                        \
        if (__any(alpha < 1.f)) { if (hi == 0) al_l[r32] = alpha; asm volatile("s_waitcnt lgkmcnt(0)" ::: "memory");         \
            _Pragma("unroll") for (int d_ = 0; d_ < 4; ++d_) _Pragma("unroll") for (int r = 0; r < 16; ++r) o[d_][r] *= al_l[crow(r, hi)]; } \
        SBAR(); pv_tile<CB>(o, vb0, pa0, pa1, pa2, pa3);                                                                      \
        if ((t) + 1 < NT) SWRITE(1 - (CB));                                                                                   \
        __syncthreads(); } while (0)
    for (int t = 0; t < NT; t += 2) { STEP(t, 0); STEP(t + 1, 1); }
#undef STEP
#undef SLOAD
#undef SWRITE
    if (hi == 0) li_l[r32] = l_reg; asm volatile("s_waitcnt lgkmcnt(0)" ::: "memory");
    float rli[16];
#pragma unroll
    for (int r = 0; r < 16; ++r) rli[r] = __builtin_amdgcn_rcpf(li_l[crow(r, hi)]);
    bf16_t* Ow = OB + (rowb + qlo) * D + 128 * h;
#pragma unroll
    for (int r = 0; r < 16; ++r) { const int orow = crow(r, hi);
#pragma unroll
        for (int d0 = 0; d0 < 4; ++d0) { const float v = o[d0][r] * rli[r]; const float vn = __shfl_xor(v, 1);
            if ((r32 & 1) == 0) *(unsigned*)(Ow + (size_t)orow * D + d0 * 32 + r32) = cvtpk(v, vn); } }
    __syncthreads();
}
constexpr int S4_R2 = 131584, S4_WS = S4_R2 + SHM_R;
static_assert(S4_WS + 2048 <= 155648, "lds");
constexpr int R3_V = 0, R3_K = 3 * SHM_V, R3_R = R3_K + 3 * SHM_K, R3_WS = R3_R + 3 * SHM_R;
__device__ __forceinline__ void qkt_rt(f32x16& p0, f32x16& p1, const char* lds, int kofs, int rofs, int r32, int hi, const bf16x8* qr) {
    p0 = f32x16{}; p1 = f32x16{};
    const char* kb[4];
#pragma unroll
    for (int dd = 0; dd < 4; ++dd) kb[dd] = lds + R3_K + kofs + KSWZ(r32, (dd * 16 + hi * 8) * 2);
#pragma unroll
    for (int d0 = 0; d0 < 8; ++d0) { const char* a = kb[d0 & 3] + (d0 >> 2) * 128;
        const bf16x8 b0 = *reinterpret_cast<const bf16x8*>(a), b1 = *reinterpret_cast<const bf16x8*>(a + 32 * 256);
        p0 = __builtin_amdgcn_mfma_f32_32x32x16_bf16(b0, qr[d0], p0, 0, 0, 0);
        p1 = __builtin_amdgcn_mfma_f32_32x32x16_bf16(b1, qr[d0], p1, 0, 0, 0); }
    const int sw = (r32 >> 1) & 7; const char* rb = lds + R3_R + rofs + r32 * 128;
#pragma unroll
    for (int s = 0; s < 4; ++s) { const char* a = rb + (((2 * s + hi) ^ sw) << 4);
        const bf16x8 b0 = *reinterpret_cast<const bf16x8*>(a), b1 = *reinterpret_cast<const bf16x8*>(a + 32 * 128);
        p0 = __builtin_amdgcn_mfma_f32_32x32x16_bf16(b0, qr[8 + s], p0, 0, 0, 0);
        p1 = __builtin_amdgcn_mfma_f32_32x32x16_bf16(b1, qr[8 + s], p1, 0, 0, 0); }
}
__device__ __forceinline__ void pv_rt(f32x16* o, int vb, bf16x8 pa0, bf16x8 pa1, bf16x8 pa2, bf16x8 pa3) {
#define TRRD(dst, off) asm volatile("ds_read_b64_tr_b16 %0, %1 offset:%2" : "=&v"(dst) : "v"(vb), "i"(off) : "memory")
#define PV_KS(ks, PA) do { s16x4 l0, l1, l2, l3, h0, h1, h2, h3; constexpr int b_ = R3_V + v_rd_off(0, ks, 0);   \
        TRRD(l0, b_); TRRD(h0, b_ + 2048); TRRD(l1, b_ + 512); TRRD(h1, b_ + 512 + 2048); TRRD(l2, b_ + 1024); TRRD(h2, b_ + 1024 + 2048); TRRD(l3, b_ + 1536); TRRD(h3, b_ + 1536 + 2048); \
        asm volatile("s_waitcnt lgkmcnt(0)" ::: "memory"); SBAR();   \
        o[0] = __builtin_amdgcn_mfma_f32_32x32x16_bf16(PA, (bf16x8){l0[0], l0[1], l0[2], l0[3], h0[0], h0[1], h0[2], h0[3]}, o[0], 0, 0, 0);   \
        o[1] = __builtin_amdgcn_mfma_f32_32x32x16_bf16(PA, (bf16x8){l1[0], l1[1], l1[2], l1[3], h1[0], h1[1], h1[2], h1[3]}, o[1], 0, 0, 0);   \
        o[2] = __builtin_amdgcn_mfma_f32_32x32x16_bf16(PA, (bf16x8){l2[0], l2[1], l2[2], l2[3], h2[0], h2[1], h2[2], h2[3]}, o[2], 0, 0, 0);   \
        o[3] = __builtin_amdgcn_mfma_f32_32x32x16_bf16(PA, (bf16x8){l3[0], l3[1], l3[2], l3[3], h3[0], h3[1], h3[2], h3[3]}, o[3], 0, 0, 0); } while (0)
    PV_KS(0, pa0); PV_KS(1, pa1); PV_KS(2, pa2); PV_KS(3, pa3);
#undef PV_KS
#undef TRRD
}
#ifndef PA_PF
#define PA_PF 5
#endif
__device__ __forceinline__ void qkt_pf(f32x16& p0, f32x16& p1, const char* lds, int kofs, int rofs, int r32, int hi, const bf16x8* qr) {
    p0 = f32x16{}; p1 = f32x16{};
    const char* kb[4];
#pragma unroll
    for (int dd = 0; dd < 4; ++dd) kb[dd] = lds + R3_K + kofs + KSWZ(r32, (dd * 16 + hi * 8) * 2);
    const int sw = (r32 >> 1) & 7; const char* rb = lds + R3_R + rofs + r32 * 128;
    bf16x8 f0[12], f1[12];
#define QK_LD(d) do { if ((d) < 8) { const char* a = kb[(d) & 3] + ((d) >> 2) * 128; f0[d] = *reinterpret_cast<const bf16x8*>(a); f1[d] = *reinterpret_cast<const bf16x8*>(a + 32 * 256); } \
                      else { const char* a = rb + (((2 * ((d) - 8) + hi) ^ sw) << 4); f0[d] = *reinterpret_cast<const bf16x8*>(a); f1[d] = *reinterpret_cast<const bf16x8*>(a + 32 * 128); } } while (0)
#pragma unroll
    for (int d = 0; d < PA_PF; ++d) QK_LD(d);
#pragma unroll
    for (int d = 0; d < 12; ++d) {
        if (d + PA_PF < 12) QK_LD(d + PA_PF);
        SBAR();
        p0 = __builtin_amdgcn_mfma_f32_32x32x16_bf16(f0[d], qr[d], p0, 0, 0, 0);
        p1 = __builtin_amdgcn_mfma_f32_32x32x16_bf16(f1[d], qr[d], p1, 0, 0, 0);
        SBAR(); }
#undef QK_LD
}
#define TRRD(dst, off) asm volatile("ds_read_b64_tr_b16 %0, %1 offset:%2" : "=&v"(dst) : "v"(vb_), "i"(off) : "memory")
#define PV_RD(ks, S) do { constexpr int b_ = R3_V + v_rd_off(0, ks, 0);   \
        TRRD(S[0], b_); TRRD(S[4], b_ + 2048); TRRD(S[1], b_ + 512); TRRD(S[5], b_ + 512 + 2048); TRRD(S[2], b_ + 1024); TRRD(S[6], b_ + 1024 + 2048); TRRD(S[3], b_ + 1536); TRRD(S[7], b_ + 1536 + 2048); } while (0)
#define PV_MM(PA, S) do { \
        o[0] = __builtin_amdgcn_mfma_f32_32x32x16_bf16(PA, (bf16x8){S[0][0], S[0][1], S[0][2], S[0][3], S[4][0], S[4][1], S[4][2], S[4][3]}, o[0], 0, 0, 0);   \
        o[1] = __builtin_amdgcn_mfma_f32_32x32x16_bf16(PA, (bf16x8){S[1][0], S[1][1], S[1][2], S[1][3], S[5][0], S[5][1], S[5][2], S[5][3]}, o[1], 0, 0, 0);   \
        o[2] = __builtin_amdgcn_mfma_f32_32x32x16_bf16(PA, (bf16x8){S[2][0], S[2][1], S[2][2], S[2][3], S[6][0], S[6][1], S[6][2], S[6][3]}, o[2], 0, 0, 0);   \
        o[3] = __builtin_amdgcn_mfma_f32_32x32x16_bf16(PA, (bf16x8){S[3][0], S[3][1], S[3][2], S[3][3], S[7][0], S[7][1], S[7][2], S[7][3]}, o[3], 0, 0, 0); } while (0)
#define PV_EARLY(VA, VB_) do { PV_RD(0, VA); PV_RD(1, VB_); } while (0)
#define PV_REST(VA, VB_) do {                                                                     \
    asm volatile("s_waitcnt lgkmcnt(8)" ::: "memory"); SBAR(); PV_MM(pa0, VA); SBAR();            \
    PV_RD(2, VA);                                                                                 \
    asm volatile("s_waitcnt lgkmcnt(8)" ::: "memory"); SBAR(); PV_MM(pa1, VB_); SBAR();           \
    PV_RD(3, VB_);                                                                                \
    asm volatile("s_waitcnt lgkmcnt(8)" ::: "memory"); SBAR(); PV_MM(pa2, VA); SBAR();            \
    asm volatile("s_waitcnt lgkmcnt(0)" ::: "memory"); SBAR(); PV_MM(pa3, VB_); } while (0)
#ifndef PA_QK
#define PA_QK qkt_pf
#endif
template <bool REV>
__device__ __forceinline__ void unit_dma(int b, int h, int qb, const bf16_t* __restrict__ QF, const bf16_t* __restrict__ KN, const bf16_t* __restrict__ KPE, const bf16_t* __restrict__ VBg, bf16_t* OB, char* lds, LAS unsigned char* ldsu) {
    const int tid = threadIdx.x, wid = __builtin_amdgcn_readfirstlane(tid >> 6), lane = tid & 63, r32 = lane & 31, hi = lane >> 5;
    const size_t rowb = (size_t)b * SEQ; const int q0 = qb * QB, qlo = q0 + wid * QBLK, qm = qlo + r32 - 4 * hi;
    const int NT = (q0 + QB) / KVBLK;
    float* wsf = (float*)(lds + R3_WS) + wid * 64; float* li_l = wsf; float* al_l = wsf + 32;
    bf16x8 qr[12];
    { const bf16_t* qp = QF + (rowb + qlo + r32) * NQ + HD * h + hi * 8;
#pragma unroll
      for (int d0 = 0; d0 < 12; ++d0) qr[d0] = *reinterpret_cast<const bf16x8*>(qp + d0 * 16); }
    const char* Kb = (const char*)(KN + rowb * D + 128 * h); const char* Vb = (const char*)(VBg + rowb * D + 128 * h); const char* Rb = (const char*)(KPE + rowb * ROPE);
    unsigned kof[2], vof[2], rof;
#pragma unroll
    for (int pi = 0; pi < 2; ++pi) { const int p = 2 * wid + pi, rw = 4 * pi + (lane >> 4);
        kof[pi] = (unsigned)((4 * p + (lane >> 4)) * (D * 2) + 16 * ((lane & 15) ^ (rw & 7)));
        const int kk = 8 * (p >> 1) + ((lane & 31) >> 2), key = (kk & ~0xC) | ((kk & 4) << 1) | ((kk & 8) >> 1), col = 32 * (2 * (p & 1) + (lane >> 5)) + 8 * (lane & 3);
        vof[pi] = (unsigned)(key * (D * 2) + col * 2); }
    { const int row = 8 * wid + (lane >> 3); rof = (unsigned)(row * (ROPE * 2) + 16 * ((lane & 7) ^ ((row >> 1) & 7))); }
#define DMA_TILE(t, ks_, vs_, rs_) do { const size_t kb_ = (size_t)(t) * KVBLK * (D * 2);                                                                \
        _Pragma("unroll") for (int pi = 0; pi < 2; ++pi) { const int p = 2 * wid + pi;                                                                 \
            __builtin_amdgcn_global_load_lds((const unsigned*)(Kb + kb_ + kof[pi]), (LAS unsigned*)(ldsu + R3_K + (ks_) + p * 1024), 16, 0, 0);        \
            __builtin_amdgcn_global_load_lds((const unsigned*)(Vb + kb_ + vof[pi]), (LAS unsigned*)(ldsu + R3_V + (vs_) + p * 1024), 16, 0, 0); }      \
        __builtin_amdgcn_global_load_lds((const unsigned*)(Rb + (size_t)(t) * KVBLK * (ROPE * 2) + rof), (LAS unsigned*)(ldsu + R3_R + (rs_) + wid * 1024), 16, 0, 0); } while (0)
    const int vb0 = (int)(uintptr_t)lds + v_rd_base(lane);
    float m_reg = -1e30f, l_reg = 0.f, alpha; f32x16 o[4] = {}; f32x16 p0, p1; bf16x8 pa0, pa1, pa2, pa3;
#define TID_(i) (REV ? NT - 1 - (i) : (i))
    DMA_TILE(TID_(0), 0, 0, 0); DMA_TILE(TID_(1), SHM_K, SHM_V, SHM_R);
    asm volatile("s_waitcnt vmcnt(5)" ::: "memory"); __builtin_amdgcn_s_barrier(); asm volatile("" ::: "memory");
    int s_cur = 0, s_nxt = 1, s_nn = 2;
    for (int t = 0; t < NT; ++t) {
        int kofs = s_cur * SHM_K, rofs = s_cur * SHM_R, vofs = s_cur * SHM_V; asm volatile("" : "+v"(kofs), "+v"(rofs), "+v"(vofs));
        if (t + 2 < NT) DMA_TILE(TID_(t + 2), s_nn * SHM_K, s_nn * SHM_V, s_nn * SHM_R);
        PA_QK(p0, p1, lds, kofs, rofs, r32, hi, qr);
        s16x4 VA[8], VB_[8]; const int vb_ = vb0 + vofs; SBAR(); PV_EARLY(VA, VB_); SBAR();
        { const int tq = TID_(t); if (KVBLK * tq + KVBLK - 1 > qlo) mask_tile(p0, p1, qm - KVBLK * tq); }
        softmax_tile(p0, p1, m_reg, l_reg, alpha, pa0, pa1, pa2, pa3);
        if (__any(alpha < 1.f)) { if (hi == 0) al_l[r32] = alpha; asm volatile("s_waitcnt lgkmcnt(0)" ::: "memory");
#pragma unroll
            for (int d_ = 0; d_ < 4; ++d_)
#pragma unroll
                for (int r = 0; r < 16; ++r) o[d_][r] *= al_l[crow(r, hi)]; }
        SBAR(); PV_REST(VA, VB_);
        if (t + 2 < NT) asm volatile("s_waitcnt vmcnt(5) lgkmcnt(0)" ::: "memory"); else asm volatile("s_waitcnt vmcnt(0) lgkmcnt(0)" ::: "memory");
        __builtin_amdgcn_s_barrier(); asm volatile("" ::: "memory");
        const int tmp = s_cur; s_cur = s_nxt; s_nxt = s_nn; s_nn = tmp;
    }
#undef DMA_TILE
#undef TID_
    if (hi == 0) li_l[r32] = l_reg; asm volatile("s_waitcnt lgkmcnt(0)" ::: "memory");
    float rli[16];
#pragma unroll
    for (int r = 0; r < 16; ++r) rli[r] = __builtin_amdgcn_rcpf(li_l[crow(r, hi)]);
    bf16_t* Ow = OB + (rowb + qlo) * D + 128 * h;
#pragma unroll
    for (int r = 0; r < 16; ++r) { const int orow = crow(r, hi);
#pragma unroll
        for (int d0 = 0; d0 < 4; ++d0) { const float v = o[d0][r] * rli[r]; const float vn = __shfl_xor(v, 1);
            if ((r32 & 1) == 0) *(unsigned*)(Ow + (size_t)orow * D + d0 * 32 + r32) = cvtpk(v, vn); } }
    asm volatile("s_waitcnt vmcnt(0) lgkmcnt(0)" ::: "memory"); __builtin_amdgcn_s_barrier(); asm volatile("" ::: "memory");
}
__device__ __forceinline__ void unit_stg(int b, int h, int qb, const bf16_t* __restrict__ QF, const bf16_t* __restrict__ KN, const bf16_t* __restrict__ KPE, const bf16_t* __restrict__ VBg, bf16_t* OB, char* lds, LAS unsigned char* ldsu) {
    int tid = threadIdx.x; asm volatile("" : "+v"(tid));
    const int wid = __builtin_amdgcn_readfirstlane(tid >> 6), lane = tid & 63, r32 = lane & 31, hi = lane >> 5;
    const size_t rowb = (size_t)b * SEQ; const int q0 = qb * QB, qlo = q0 + wid * QBLK, qm = qlo + r32 - 4 * hi;
    const int NT = (q0 + QB) / KVBLK;
    float* wsf = (float*)(lds + S4_WS) + wid * 64; float* li_l = wsf; float* al_l = wsf + 32;
    bf16x8 qr[12];
    { const bf16_t* qp = QF + (rowb + qlo + r32) * NQ + HD * h + hi * 8;
#pragma unroll
      for (int d0 = 0; d0 < 12; ++d0) qr[d0] = *reinterpret_cast<const bf16x8*>(qp + d0 * 16); }
    const char* Kb = (const char*)(KN + rowb * D + 128 * h); const char* Vb = (const char*)(VBg + rowb * D + 128 * h); const char* Rb = (const char*)(KPE + rowb * ROPE);
    unsigned kof[2], vof[2], rof;
#pragma unroll
    for (int pi = 0; pi < 2; ++pi) { const int p = 2 * wid + pi, rw = 4 * pi + (lane >> 4);
        kof[pi] = (unsigned)((4 * p + (lane >> 4)) * (D * 2) + 16 * ((lane & 15) ^ (rw & 7)));
        const int kk = 8 * (p >> 1) + ((lane & 31) >> 2), key = (kk & ~0xC) | ((kk & 4) << 1) | ((kk & 8) >> 1), col = 32 * (2 * (p & 1) + (lane >> 5)) + 8 * (lane & 3);
        vof[pi] = (unsigned)(key * (D * 2) + col * 2); }
    { const int row = 8 * wid + (lane >> 3); rof = (unsigned)(row * (ROPE * 2) + 16 * ((lane & 7) ^ ((row >> 1) & 7))); }
#define DMA_TILE(t, ks_, vs_, rs_) do { const size_t kb_ = (size_t)(t) * KVBLK * (D * 2);                                                                \
        _Pragma("unroll") for (int pi = 0; pi < 2; ++pi) { const int p = 2 * wid + pi;                                                                 \
            __builtin_amdgcn_global_load_lds((const unsigned*)(Kb + kb_ + kof[pi]), (LAS unsigned*)(ldsu + R3_K + (ks_) + p * 1024), 16, 0, 0);        \
            __builtin_amdgcn_global_load_lds((const unsigned*)(Vb + kb_ + vof[pi]), (LAS unsigned*)(ldsu + R3_V + (vs_) + p * 1024), 16, 0, 0); }      \
        __builtin_amdgcn_global_load_lds((const unsigned*)(Rb + (size_t)(t) * KVBLK * (ROPE * 2) + rof), (LAS unsigned*)(ldsu + R3_R + (rs_) + wid * 1024), 16, 0, 0); } while (0)
    const int vb0 = (int)(uintptr_t)lds + v_rd_base(lane);
    float m_reg = -1e30f, l_reg = 0.f, alpha; f32x16 o[4] = {}; f32x16 p0, p1; bf16x8 pa0, pa1, pa2, pa3;
#define S4_KOFS(sl_) (16384 + (sl_) * SHM_K)
#define S4_ROFS(sl_) ((sl_) == 0 ? 16384 : (sl_) == 1 ? 24576 : (S4_R2 - R3_R))
    const bool grpB = wid >= 4;
    DMA_TILE(0, S4_KOFS(0), 0, S4_ROFS(0)); DMA_TILE(1, S4_KOFS(1), SHM_V, S4_ROFS(1));
    asm volatile("s_waitcnt vmcnt(5)" ::: "memory"); __builtin_amdgcn_s_barrier(); asm volatile("" ::: "memory");
    int s_cur = 0, s_nxt = 1, s_nn = 2;
#define STG_WAIT(t) do { if ((t) + 2 < NT) asm volatile("s_waitcnt vmcnt(5) lgkmcnt(0)" ::: "memory"); else asm volatile("s_waitcnt vmcnt(0) lgkmcnt(0)" ::: "memory");   \
        __builtin_amdgcn_s_barrier(); asm volatile("" ::: "memory"); { const int tmp = s_cur; s_cur = s_nxt; s_nxt = s_nn; s_nn = tmp; } } while (0)
#define STG_RESCALE() do { if (__any(alpha < 1.f)) { if (hi == 0) al_l[r32] = alpha; asm volatile("s_waitcnt lgkmcnt(0)" ::: "memory");                    \
            _Pragma("unroll") for (int d_ = 0; d_ < 4; ++d_) _Pragma("unroll") for (int r = 0; r < 16; ++r) o[d_][r] *= al_l[crow(r, hi)]; } } while (0)
    if (!grpB) {
        for (int t = 0; t < NT; ++t) {
            int kofs = S4_KOFS(s_cur), rofs = S4_ROFS(s_cur), vofs = (t & 3) * SHM_V; asm volatile("" : "+v"(kofs), "+v"(rofs), "+v"(vofs));
            if (t + 2 < NT) DMA_TILE(t + 2, S4_KOFS(s_nn), ((t + 2) & 3) * SHM_V, S4_ROFS(s_nn));
            PA_QK(p0, p1, lds, kofs, rofs, r32, hi, qr);
            s16x4 VA[8], VB_[8]; const int vb_ = vb0 + vofs; SBAR(); PV_EARLY(VA, VB_); SBAR();
            if (KVBLK * t + KVBLK - 1 > qlo) mask_tile(p0, p1, qm - KVBLK * t);
            softmax_tile(p0, p1, m_reg, l_reg, alpha, pa0, pa1, pa2, pa3);
            STG_RESCALE();
            SBAR(); PV_REST(VA, VB_);
            STG_WAIT(t);
        }
    } else {
        for (int t = 0; t < NT; ++t) {
            int kofs = S4_KOFS(s_cur), rofs = S4_ROFS(s_cur), vofs = ((t + 3) & 3) * SHM_V; asm volatile("" : "+v"(kofs), "+v"(rofs), "+v"(vofs));
            if (t + 2 < NT) DMA_TILE(t + 2, S4_KOFS(s_nn), ((t + 2) & 3) * SHM_V, S4_ROFS(s_nn));
            if (t > 0) { s16x4 VA[8], VB_[8]; const int vb_ = vb0 + vofs; SBAR(); PV_EARLY(VA, VB_); SBAR(); PV_REST(VA, VB_); SBAR(); }
            PA_QK(p0, p1, lds, kofs, rofs, r32, hi, qr);
            if (KVBLK * t + KVBLK - 1 > qlo) mask_tile(p0, p1, qm - KVBLK * t);
            softmax_tile(p0, p1, m_reg, l_reg, alpha, pa0, pa1, pa2, pa3);
            STG_RESCALE();
            STG_WAIT(t);
        }
        { const int vofs = ((NT + 3) & 3) * SHM_V; s16x4 VA[8], VB_[8]; const int vb_ = vb0 + vofs; SBAR(); PV_EARLY(VA, VB_); SBAR(); PV_REST(VA, VB_); SBAR(); }
    }
#undef STG_WAIT
#undef STG_RESCALE
#undef S4_KOFS
#undef S4_ROFS
#undef DMA_TILE
    if (hi == 0) li_l[r32] = l_reg; asm volatile("s_waitcnt lgkmcnt(0)" ::: "memory");
    float rli[16];
#pragma unroll
    for (int r = 0; r < 16; ++r) rli[r] = __builtin_amdgcn_rcpf(li_l[crow(r, hi)]);
    bf16_t* Ow = OB + (rowb + qlo) * D + 128 * h;
#pragma unroll
    for (int r = 0; r < 16; ++r) { const int orow = crow(r, hi);
#pragma unroll
        for (int d0 = 0; d0 < 4; ++d0) { const float v = o[d0][r] * rli[r]; const float vn = __shfl_xor(v, 1);
            if ((r32 & 1) == 0) *(unsigned*)(Ow + (size_t)orow * D + d0 * 32 + r32) = cvtpk(v, vn); } }
    asm volatile("s_waitcnt vmcnt(0) lgkmcnt(0)" ::: "memory"); __builtin_amdgcn_s_barrier(); asm volatile("" ::: "memory");
}
}

namespace sa {
constexpr int TILE = 16384;
struct Src { const bf16_t* CLB; const float* CKF; const int* PT; const float* RP; const bf16_t* LATB; const bf16_t* KPEB; const float* RTS; const unsigned char* CL8; const float* SC2; };
#ifndef SA_INT8
#define SA_INT8 1
#endif
__device__ __forceinline__ int offa(int row, int ch) { return 2048 * (row >> 3) + 512 * (ch >> 2) + 64 * (row & 7) + 16 * ((ch & 3) ^ ((row >> 2) & 3)); }
__device__ __forceinline__ v4u widen8(u32x2 w) {
    const unsigned x0 = w.x ^ 0x80808080u, x1 = w.y ^ 0x80808080u; v4u o;
    o.x = cvt_pk_bf16((float)(x0 & 255u), (float)((x0 >> 8) & 255u)); o.y = cvt_pk_bf16((float)((x0 >> 16) & 255u), (float)(x0 >> 24));
    o.z = cvt_pk_bf16((float)(x1 & 255u), (float)((x1 >> 8) & 255u)); o.w = cvt_pk_bf16((float)((x1 >> 16) & 255u), (float)(x1 >> 24)); return o;
}
template <bool TAIL, bool Q8 = false>
__device__ __forceinline__ void tile(const Src& S, int b, int k0, LAS unsigned char* ldsu, char* lds, int wid, int lane, f32x16 (&o)[8], float& m_reg, float& l_reg, float* al_l, int tbase, float& lb, float cb) {
    asm volatile("" : "+v"(lane));
    const int r32 = lane & 31, hi = lane >> 5, h = r32 & 7;
    LAS unsigned char* tl = ldsu + tbase + wid * TILE; const char* tg = lds + tbase + wid * TILE;
    asm volatile("s_waitcnt lgkmcnt(0)" ::: "memory");
    {
        const int rlo = (lane >> 2) & 7, chh = lane >> 5, x4 = (lane >> 4) & 1;
        if constexpr (TAIL) {
            const char* ub = (const char*)(S.LATB + (size_t)(TP + 4 * b) * KVR);
#pragma unroll
            for (int P = 0; P < 16; ++P) { const int img = P >> 3, pp = P & 7, row = 8 * (pp >> 1) + rlo, ch = 8 * (pp & 1) + 4 * chh + ((lane & 3) ^ (2 * ((pp >> 1) & 1) + x4));
                const unsigned lo = (unsigned)((row < 3 ? row : 3) * (KVR * 2) + (128 * img + 8 * ch) * 2);
                __builtin_amdgcn_global_load_lds((const unsigned*)(ub + lo), (LAS unsigned*)(tl + P * 1024), 16, 0, 0); }
        } else if constexpr (Q8) {
            const char* ub = (const char*)S.CL8 + ((size_t)b * SEQ + k0) * KVR + 16 * lane;
#pragma unroll
            for (int P = 0; P < 8; ++P) __builtin_amdgcn_global_load_lds((const unsigned*)(ub + P * 1024), (LAS unsigned*)(tl + 8192 + P * 1024), 16, 0, 0);
        } else {
            const char* ub = (const char*)(S.CLB + ((size_t)b * SEQ + k0) * KVR);
            const unsigned loA = (unsigned)(rlo * 512 + 64 * chh + 16 * ((lane & 3) ^ x4)), loB = (unsigned)(rlo * 512 + 64 * chh + 16 * ((lane & 3) ^ (2 + x4)));
#pragma unroll
            for (int P = 0; P < 16; ++P) { const int img = P >> 3, pp = P & 7; const unsigned cst = (unsigned)((8 * (pp >> 1)) * 512 + 256 * img + 128 * (pp & 1));
                __builtin_amdgcn_global_load_lds((const unsigned*)(ub + cst + (((pp >> 1) & 1) ? loB : loA)), (LAS unsigned*)(tl + P * 1024), 16, 0, 0); }
        }
    }
    bf16x8 kp[4]; float rf[16];
    {
        if constexpr (TAIL) { const bf16_t* kr = S.KPEB + (size_t)(TP + 4 * b + (r32 < 3 ? r32 : 3)) * ROPE;
#pragma unroll
            for (int s = 0; s < 4; ++s) kp[s] = *reinterpret_cast<const bf16x8*>(kr + 16 * s + 8 * hi);
        } else {
            const int phys = S.PT[b * NPG + (k0 >> 7)];
            const float* kr = S.CKF + ((size_t)phys * PAGE + (k0 & (PAGE - 1)) + r32) * ROPE + 8 * hi;
#pragma unroll
            for (int s = 0; s < 4; ++s) { const f32x4 x0 = *(const f32x4*)(kr + 16 * s), x1 = *(const f32x4*)(kr + 16 * s + 4);
                u32x4 w = {cvt_pk_bf16(x0[0], x0[1]), cvt_pk_bf16(x0[2], x0[3]), cvt_pk_bf16(x1[0], x1[1]), cvt_pk_bf16(x1[2], x1[3])}; kp[s] = *reinterpret_cast<bf16x8*>(&w); }
        }
        if constexpr (TAIL) {
#pragma unroll
            for (int r = 0; r < 16; ++r) { const int j = crow(r, hi), jc = j < 3 ? j : 3; rf[r] = S.RTS[(4 * b + jc) * 8 + h]; }
        } else {
            const float* r0 = S.RP + (size_t)(2 * h) * NCK + (size_t)b * SEQ + k0 + 4 * hi;
#pragma unroll
            for (int j = 0; j < 4; ++j) { const f32x4 a = *(const f32x4*)(r0 + 8 * j) + *(const f32x4*)(r0 + NCK + 8 * j);
#pragma unroll
                for (int e = 0; e < 4; ++e) rf[4 * j + e] = a[e]; }
            if constexpr (Q8) {
                const float* s0 = S.SC2 + (size_t)b * SEQ + k0 + 4 * hi;
#pragma unroll
                for (int j = 0; j < 4; ++j) { f32x4 sv = *(const f32x4*)(s0 + 8 * j);
#pragma unroll
                    for (int e = 0; e < 4; ++e) { const float s2 = sv[e]; sv[e] = sqrtf(s2); rf[4 * j + e] = rsq(rf[4 * j + e] * s2 * (1.0f / 128) + EPS) * sv[e]; }
                    if (r32 == 0) *(f32x4*)(al_l + 32 + 8 * j + 4 * hi) = sv; }
            }
        }
    }
    asm volatile("s_waitcnt vmcnt(0)" ::: "memory");
    if constexpr (Q8 && !TAIL) {
        const int c8 = lane & 15, r0 = lane >> 4; const char* st = tg + 8192;
#pragma unroll
        for (int i = 0; i < 8; ++i) { const int row = r0 + 4 * i; *(v4u*)(const_cast<char*>(tg) + offa(row, c8)) = widen8(*(const u32x2*)(st + row * 256 + 8 * c8)); }
        u32x2 wb[8];
#pragma unroll
        for (int i = 0; i < 8; ++i) wb[i] = *(const u32x2*)(st + (r0 + 4 * i) * 256 + 128 + 8 * c8);
        asm volatile("s_waitcnt lgkmcnt(0)" ::: "memory");
#pragma unroll
        for (int i = 0; i < 8; ++i) *(v4u*)(const_cast<char*>(tg) + 8192 + offa(r0 + 4 * i, c8)) = widen8(wb[i]);
        asm volatile("s_waitcnt lgkmcnt(0)" ::: "memory");
    }
    f32x16 p = {}, pn = {};
    {
        const int x = (r32 >> 2) & 3; const char* kbase = tg + 2048 * (r32 >> 3) + 64 * (r32 & 7);
        const char* kE = kbase + 16 * (hi ^ x); const char* kO = kbase + 16 * ((2 + hi) ^ x);
        const char* qb = lds + QS_OFF + r32 * QS_STRIDE + hi * 16;
#pragma unroll
        for (int s = 0; s < 4; ++s) p = __builtin_amdgcn_mfma_f32_32x32x16_bf16(kp[s], *reinterpret_cast<const bf16x8*>(qb + (16 + s) * 32), p, 0, 0, 0);
#pragma unroll
        for (int s = 0; s < 16; ++s) { const int img = s >> 3, ss = s & 7; const char* a = ((ss & 1) ? kO : kE) + 8192 * img + 512 * (ss >> 1);
            pn = __builtin_amdgcn_mfma_f32_32x32x16_bf16(*reinterpret_cast<const bf16x8*>(a), *reinterpret_cast<const bf16x8*>(qb + s * 32), pn, 0, 0, 0); }
    }
#pragma unroll
    for (int r = 0; r < 16; ++r) p[r] = (Q8 && !TAIL) ? (pn[r] - cb) * rf[r] + p[r] : pn[r] * (TAIL ? rf[r] : rsq(rf[r] * (1.0f / 128) + EPS)) + p[r];
    if constexpr (TAIL) { const int q = r32 >> 3;
#pragma unroll
        for (int r = 0; r < 16; ++r) if (crow(r, hi) > q) p[r] = -__builtin_inff(); }
    float pmax = p[0];
#pragma unroll
    for (int r = 1; r < 16; ++r) pmax = fmaxf(pmax, p[r]);
    pmax = xmax32(pmax);
    float mn, alpha;
    if (__builtin_expect(__all((pmax - m_reg) <= THR), 1)) { mn = m_reg; alpha = 1.f; }
    else { mn = fmaxf(m_reg, pmax); alpha = __builtin_amdgcn_exp2f(m_reg - mn); m_reg = mn; }
    float ps = 0.f;
#pragma unroll
    for (int r = 0; r < 16; ++r) { p[r] = __builtin_amdgcn_exp2f(p[r] - mn); ps += p[r]; }
    ps = xsum32(ps); l_reg = l_reg * alpha + ps;
    if constexpr (Q8 && !TAIL) {
#pragma unroll
        for (int j = 0; j < 4; ++j) { const f32x4 sv = *(const f32x4*)(al_l + 32 + 8 * j + 4 * hi);
#pragma unroll
            for (int e = 0; e < 4; ++e) p[4 * j + e] *= sv[e]; }
    }
    bf16x8 pa0, pa1; PK4(p, 0, pa0); PK4(p, 8, pa1);
    if constexpr (Q8) {
        float bs = 0.f;
        if constexpr (!TAIL) { const u32x4 w0 = *reinterpret_cast<const u32x4*>(&pa0), w1 = *reinterpret_cast<const u32x4*>(&pa1);
#pragma unroll
            for (int e = 0; e < 4; ++e) bs += (bflo(w0[e]) + bfhi(w0[e])) + (bflo(w1[e]) + bfhi(w1[e]));
            bs = xsum32(bs); }
        lb = lb * alpha + bs;
    }
    if (__any(alpha < 1.f)) { if (hi == 0) al_l[r32] = alpha; asm volatile("s_waitcnt lgkmcnt(0)" ::: "memory");
#pragma unroll
        for (int c = 0; c < 8; ++c)
#pragma unroll
            for (int r = 0; r < 16; ++r) o[c][r] *= al_l[crow(r, hi)]; }
    {
        const int hh = lane >> 5, blk = (lane >> 4) & 1, q4 = (lane & 15) >> 2, pp = lane & 3;
        const int tb = (int)(uintptr_t)tg + 2048 * hh + 64 * q4 + 8 * (pp & 1);
        const int t0 = tb + 16 * ((2 * blk + (pp >> 1)) ^ (2 * hh)), t1 = tb + 256 + 16 * ((2 * blk + (pp >> 1)) ^ (2 * hh + 1));
#define TR0(dst, off) asm volatile("ds_read_b64_tr_b16 %0, %1 offset:%2" : "=&v"(dst) : "v"(t0), "i"(off) : "memory")
#define TR1(dst, off) asm volatile("ds_read_b64_tr_b16 %0, %1 offset:%2" : "=&v"(dst) : "v"(t1), "i"(off) : "memory")
#define PVC(c) do { s16x4 a0, a1, b0, b1; constexpr int f_ = 8192 * ((c) >> 2) + 512 * ((c) & 3);                               \
        TR0(a0, f_); TR1(a1, f_); TR0(b0, f_ + 4096); TR1(b1, f_ + 4096);                                                        \
        asm volatile("s_waitcnt lgkmcnt(0)" ::: "memory"); SBAR();                                                                \
        o[c] = __builtin_amdgcn_mfma_f32_32x32x16_bf16(pa0, (bf16x8){a0[0], a0[1], a0[2], a0[3], a1[0], a1[1], a1[2], a1[3]}, o[c], 0, 0, 0); \
        o[c] = __builtin_amdgcn_mfma_f32_32x32x16_bf16(pa1, (bf16x8){b0[0], b0[1], b0[2], b0[3], b1[0], b1[1], b1[2], b1[3]}, o[c], 0, 0, 0); } while (0)
        PVC(0); PVC(1); PVC(2); PVC(3); PVC(4); PVC(5); PVC(6); PVC(7);
#undef PVC
#undef TR0
#undef TR1
    }
}
__device__ __forceinline__ void unit(const Src& S, const bf16_t* QS, float* PO, float* PML, int b, int s, LAS unsigned char* ldsu, char* lds) {
    int tid = threadIdx.x; asm volatile("" : "+v"(tid));
    const int wid = __builtin_amdgcn_readfirstlane(tid >> 6), lane = tid & 63, r32 = lane & 31, hi = lane >> 5;
    for (int c = tid; c < 32 * 40; c += 512) { const int rho = c / 40, ch = c % 40; *(v4u*)(lds + QS_OFF + rho * QS_STRIDE + ch * 16) = *(const v4u*)(QS + ((size_t)b * 32 + rho) * 320 + ch * 8); }
    __syncthreads();
    float* al_l = (float*)(lds + SCR_OFF) + wid * 64;
    float m_reg = -1e30f, l_reg = 0.f, lb = 0.f, cb = 0.f; f32x16 o[8] = {};
    if (SA_INT8) { const char* qrow = lds + QS_OFF + r32 * QS_STRIDE;
#pragma unroll 8
        for (int ch = 0; ch < 32; ++ch) { const v4u q = *(const v4u*)(qrow + 16 * ch); cb += (bflo(q.x) + bfhi(q.x)) + (bflo(q.y) + bfhi(q.y)) + (bflo(q.z) + bfhi(q.z)) + (bflo(q.w) + bfhi(q.w)); }
        cb *= 128.0f; }
    const int kbase = (8 * s + wid) * 512;
    for (int i = 0; i < 16; ++i) tile<false, SA_INT8 != 0>(S, b, kbase + 32 * i, ldsu, lds, wid, lane, o, m_reg, l_reg, al_l, 0, lb, cb);
    if (s == 1 && wid == 7) tile<true, SA_INT8 != 0>(S, b, 0, ldsu, lds, wid, lane, o, m_reg, l_reg, al_l, 0, lb, cb);
    asm volatile("s_waitcnt lgkmcnt(0)" ::: "memory");
    if (SA_INT8) {
        if (hi == 0) al_l[r32] = lb; asm volatile("s_waitcnt lgkmcnt(0)" ::: "memory");
#pragma unroll
        for (int r = 0; r < 16; ++r) { const float corr = 128.0f * al_l[crow(r, hi)];
#pragma unroll
            for (int c = 0; c < 8; ++c) o[c][r] -= corr; }
        asm volatile("s_waitcnt lgkmcnt(0)" ::: "memory");
    }
    __syncthreads();
    float* ST = (float*)(lds + 32768);
    float* OL = (float*)lds;
    if (hi == 0) { ST[(wid * 32 + r32) * 2] = m_reg; ST[(wid * 32 + r32) * 2 + 1] = l_reg; }
    __syncthreads();
    float sc[16];
#pragma unroll
    for (int r = 0; r < 16; ++r) { const int row = crow(r, hi); float M = ST[row * 2];
#pragma unroll
        for (int w = 1; w < 8; ++w) M = fmaxf(M, ST[(w * 32 + row) * 2]);
        sc[r] = __builtin_amdgcn_exp2f(ST[(wid * 32 + row) * 2] - M); }
    for (int w = 0; w < 8; ++w) {
        if (wid == w) {
#pragma unroll
            for (int c = 0; c < 8; ++c)
#pragma unroll
                for (int r = 0; r < 16; ++r) { float* d = OL + crow(r, hi) * 256 + 32 * c + r32; const float v = o[c][r] * sc[r]; *d = (w == 0) ? v : *d + v; }
        }
        __syncthreads();
    }
    if (tid < 32) { float M = ST[tid * 2];
        for (int w = 1; w < 8; ++w) M = fmaxf(M, ST[(w * 32 + tid) * 2]);
        float L = 0.f; for (int w = 0; w < 8; ++w) L += ST[(w * 32 + tid) * 2 + 1] * __builtin_amdgcn_exp2f(ST[(w * 32 + tid) * 2] - M);
        PML[((size_t)(b * 2 + s) * 32 + tid) * 2] = M; PML[((size_t)(b * 2 + s) * 32 + tid) * 2 + 1] = L; }
    for (int c = tid; c < 32 * 64; c += 512) *((f32x4*)(PO + (size_t)(b * 2 + s) * 32 * 256) + c) = *((const f32x4*)OL + c);
    __syncthreads();
}
}

__device__ __forceinline__ void grp_barrier(volatile LAS unsigned* cnt, unsigned& epoch, unsigned nw, int lane) {
    asm volatile("s_waitcnt vmcnt(0) lgkmcnt(0)" ::: "memory");
    epoch += nw;
    if (lane == 0) __hip_atomic_fetch_add((LAS unsigned*)cnt, 1u, __ATOMIC_RELAXED, __HIP_MEMORY_SCOPE_WORKGROUP);
    while ((int)(*cnt - epoch) < 0) __builtin_amdgcn_s_sleep(0);
    asm volatile("" ::: "memory");
}
namespace pa4 {
using namespace pa;
constexpr int QB4 = 128, OFF_WS4 = SCR_OFF + 1024;
__device__ __forceinline__ void unit(int b, int h, int qb, const bf16_t* __restrict__ QF, const bf16_t* __restrict__ KN, const bf16_t* __restrict__ KPE, const bf16_t* __restrict__ VBg, bf16_t* OB,
                                     char* lds, LAS unsigned char* ldsu, volatile LAS unsigned* cnt, unsigned& epoch) {
    const int tid = threadIdx.x, wid = __builtin_amdgcn_readfirstlane(tid >> 6), lane = tid & 63, r32 = lane & 31, hi = lane >> 5;
    const size_t rowb = (size_t)b * SEQ; const int q0 = qb * QB4, qlo = q0 + wid * QBLK, qm = qlo + r32 - 4 * hi;
    const int NT = (q0 + QB4) / KVBLK;
    float* wsf = (float*)(lds + OFF_WS4) + wid * 64; float* li_l = wsf; float* al_l = wsf + 32;
    bf16x8 qr[12];
    { const bf16_t* qp = QF + (rowb + qlo + r32) * NQ + HD * h + hi * 8;
#pragma unroll
      for (int d0 = 0; d0 < 12; ++d0) qr[d0] = *reinterpret_cast<const bf16x8*>(qp + d0 * 16); }
    const char* Kb = (const char*)(KN + rowb * D + 128 * h); const char* Vb = (const char*)(VBg + rowb * D + 128 * h); const char* Rb = (const char*)(KPE + rowb * ROPE);
    unsigned kof[2], vof[4], rof[2];
#pragma unroll
    for (int e = 0; e < 2; ++e) { const int rw = 4 * e + (lane >> 4); kof[e] = (unsigned)((lane >> 4) * (D * 2) + 16 * ((lane & 15) ^ (rw & 7))); }
#pragma unroll
    for (int pi = 0; pi < 4; ++pi) { const int p = 4 * wid + pi, kk = 8 * (p >> 1) + ((lane & 31) >> 2), key = (kk & ~0xC) | ((kk & 4) << 1) | ((kk & 8) >> 1), col = 32 * (2 * (p & 1) + (lane >> 5)) + 8 * (lane & 3);
        vof[pi] = (unsigned)(key * (D * 2) + col * 2); }
#pragma unroll
    for (int pi = 0; pi < 2; ++pi) { const int p = 2 * wid + pi, row = 8 * p + (lane >> 3); rof[pi] = (unsigned)(row * (ROPE * 2) + 16 * ((lane & 7) ^ ((row >> 1) & 7))); }
#define DMA_TILE(t, bf) do { const size_t kb_ = (size_t)(t) * KVBLK * (D * 2);                                                                          \
        _Pragma("unroll") for (int pi = 0; pi < 4; ++pi) { const int p = 4 * wid + pi;                                                                 \
            __builtin_amdgcn_global_load_lds((const unsigned*)(Kb + kb_ + (size_t)(4 * p) * (D * 2) + kof[pi & 1]), (LAS unsigned*)(ldsu + OFF_K + (bf) * SHM_K + p * 1024), 16, 0, 0); \
            __builtin_amdgcn_global_load_lds((const unsigned*)(Vb + kb_ + vof[pi]), (LAS unsigned*)(ldsu + OFF_V + (bf) * SHM_V + p * 1024), 16, 0, 0); }  \
        _Pragma("unroll") for (int pi = 0; pi < 2; ++pi) { const int p = 2 * wid + pi;                                                                 \
            __builtin_amdgcn_global_load_lds((const unsigned*)(Rb + (size_t)(t) * KVBLK * (ROPE * 2) + rof[pi]), (LAS unsigned*)(ldsu + OFF_R + (bf) * SHM_R + p * 1024), 16, 0, 0); } } while (0)
    const int vb0 = (int)(uintptr_t)lds + v_rd_base(lane);
    float m_reg = -1e30f, l_reg = 0.f, alpha; f32x16 o[4] = {}; f32x16 p0, p1; bf16x8 pa0, pa1, pa2, pa3;
    DMA_TILE(0, 0); grp_barrier(cnt, epoch, 4u, lane);
#define STEP4(t, CB) do { if ((t) + 1 < NT) DMA_TILE((t) + 1, 1 - (CB));                                                      \
        qkt<CB>(p0, p1, lds, r32, hi, qr);                                                                                    \
        if (KVBLK * (t) + KVBLK - 1 > qlo) mask_tile(p0, p1, qm - KVBLK * (t));                                               \
        softmax_tile(p0, p1, m_reg, l_reg, alpha, pa0, pa1, pa2, pa3);                                                        \
        if (__any(alpha < 1.f)) { if (hi == 0) al_l[r32] = alpha; asm volatile("s_waitcnt lgkmcnt(0)" ::: "memory");         \
            _Pragma("unroll") for (int d_ = 0; d_ < 4; ++d_) _Pragma("unroll") for (int r = 0; r < 16; ++r) o[d_][r] *= al_l[crow(r, hi)]; } \
        pv_tile<CB>(o, vb0, pa0, pa1, pa2, pa3);                                                                      \
        grp_barrier(cnt, epoch, 4u, lane); } while (0)
    for (int t = 0; t < NT; t += 2) { STEP4(t, 0); STEP4(t + 1, 1); }
#undef STEP4
#undef DMA_TILE
    if (hi == 0) li_l[r32] = l_reg; asm volatile("s_waitcnt lgkmcnt(0)" ::: "memory");
    float rli[16];
#pragma unroll
    for (int r = 0; r < 16; ++r) rli[r] = __builtin_amdgcn_rcpf(li_l[crow(r, hi)]);
    bf16_t* Ow = OB + (rowb + qlo) * D + 128 * h;
#pragma unroll
    for (int r = 0; r < 16; ++r) { const int orow = crow(r, hi);
#pragma unroll
        for (int d0 = 0; d0 < 4; ++d0) { const float v = o[d0][r] * rli[r]; const float vn = __shfl_xor(v, 1);
            if ((r32 & 1) == 0) *(unsigned*)(Ow + (size_t)orow * D + d0 * 32 + r32) = cvtpk(v, vn); } }
    asm volatile("s_waitcnt lgkmcnt(0)" ::: "memory");
}
}
namespace sa3 {
using namespace sa;
constexpr int TB = 81920;
__device__ __forceinline__ void unit(const Src& S, const bf16_t* QS, float* PO, float* PML, int b, int s, LAS unsigned char* ldsu, char* lds, volatile LAS unsigned* cnt, unsigned& epoch) {
    const int tid = threadIdx.x - 256, j = __builtin_amdgcn_readfirstlane(tid >> 6), lane = tid & 63, r32 = lane & 31, hi = lane >> 5;
    for (int c = tid; c < 32 * 40; c += 192) { const int rho = c / 40, ch = c % 40; *(v4u*)(lds + QS_OFF + rho * QS_STRIDE + ch * 16) = *(const v4u*)(QS + ((size_t)b * 32 + rho) * 320 + ch * 8); }
    grp_barrier(cnt, epoch, 3u, lane);
    float* al_l = (float*)(lds + SCR_OFF) + j * 64;
    float m_reg = -1e30f, l_reg = 0.f; f32x16 o[8] = {};
    for (int i = j; i < 128; i += 3) { float lb_ = 0.f; tile<false>(S, b, s * 4096 + 32 * i, ldsu, lds, j, lane, o, m_reg, l_reg, al_l, TB, lb_, 0.f); }
    if (s == 1 && j == 2) { float lb_ = 0.f; tile<true>(S, b, 0, ldsu, lds, j, lane, o, m_reg, l_reg, al_l, TB, lb_, 0.f); }
    grp_barrier(cnt, epoch, 3u, lane);
    float* OL = (float*)(lds + TB);
    float* ST = (float*)(lds + TB + 32768);
    if (hi == 0) { ST[(j * 32 + r32) * 2] = m_reg; ST[(j * 32 + r32) * 2 + 1] = l_reg; }
    grp_barrier(cnt, epoch, 3u, lane);
    float sc[16];
#pragma unroll
    for (int r = 0; r < 16; ++r) { const int row = crow(r, hi); const float M = fmaxf(fmaxf(ST[row * 2], ST[(32 + row) * 2]), ST[(64 + row) * 2]);
        sc[r] = __builtin_amdgcn_exp2f(ST[(j * 32 + row) * 2] - M); }
    for (int w = 0; w < 3; ++w) {
        if (j == w) {
#pragma unroll
            for (int c = 0; c < 8; ++c)
#pragma unroll
                for (int r = 0; r < 16; ++r) { float* d = OL + crow(r, hi) * 256 + 32 * c + r32; const float v = o[c][r] * sc[r]; *d = (w == 0) ? v : *d + v; }
        }
        grp_barrier(cnt, epoch, 3u, lane);
    }
    if (tid < 32) { const float M = fmaxf(fmaxf(ST[tid * 2], ST[(32 + tid) * 2]), ST[(64 + tid) * 2]);
        float L = 0.f; for (int w = 0; w < 3; ++w) L += ST[(w * 32 + tid) * 2 + 1] * __builtin_amdgcn_exp2f(ST[(w * 32 + tid) * 2] - M);
        PML[((size_t)(b * 2 + s) * 32 + tid) * 2] = M; PML[((size_t)(b * 2 + s) * 32 + tid) * 2 + 1] = L; }
    for (int c = tid; c < 32 * 64; c += 192) *((f32x4*)(PO + (size_t)(b * 2 + s) * 32 * 256) + c) = *((const f32x4*)OL + c);
    grp_barrier(cnt, epoch, 3u, lane);
}
}
#undef SBAR
#undef PK4
}

#ifndef MK_SPLIT
#define MK_SPLIT 0
#endif
struct RangeOrder {
    int g0, n;
    __device__ __forceinline__ bool next(int i, pg8::Unit& u) const { if (i >= n) return false; const int g = g0 + i; u.pm = g >> 2; u.pn = g & 3; u.ko = 0; return true; }
    __device__ __forceinline__ void a_ready(const pg8::Unit&) const {}
    __device__ __forceinline__ void done(const pg8::Unit&) const {}
};
struct SplitOrder {
    int j, ns;
    __device__ __forceinline__ bool next(int i, pg8::Unit& u) const { if (i > 0 || j >= 8 * ns) return false; const int t = j / ns; u.pm = t >> 2; u.pn = t & 3; u.ko = (j % ns) * 512; return true; }
    __device__ __forceinline__ void a_ready(const pg8::Unit&) const {}
    __device__ __forceinline__ void done(const pg8::Unit&) const {}
};
constexpr int NSLOT = 11, R_UNITS = (NCK / 256) * 4;
constexpr int FILL_REM[NSLOT] = {172, 8, 24, 32, 172, 8, 48, 8, 132, 16, 140};
constexpr int FILL_PER[NSLOT] = {3, 17, 4, 1, 3, 17, 0, 17, 4, 0, 2};
constexpr int fill_start(int s) { int a = 0; for (int j = 0; j < s; ++j) a += (256 - FILL_REM[j]) * FILL_PER[j]; return a; }
static_assert(fill_start(NSLOT) <= R_UNITS, "filler");
#ifndef R_SP2
#define R_SP2 PG8_SP2
#endif
constexpr int NPHASE = 20;
struct Args { Ptrs P; int ph_lo, ph_hi; };
typedef const __attribute__((address_space(4))) Args CArgs;
__global__ void __launch_bounds__(NWAVES * 64, 2) fwd(Args args) {
    extern __shared__ __attribute__((aligned(16))) unsigned char lds[];
    Ctx C0; C0.lds = (LAS unsigned char*)lds; C0.tid = threadIdx.x; C0.lane = C0.tid & 63; C0.wave = __builtin_amdgcn_readfirstlane(C0.tid >> 6);
    C0.G = gridDim.x; { const int bx = blockIdx.x; C0.vcu = (C0.G % 8 == 0) ? (bx % 8) * (C0.G / 8) + bx / 8 : bx; }
    const Ctx& C = C0;
    volatile LAS unsigned* MISC = (volatile LAS unsigned*)(C.lds + MISC_OFF);
    if (C.tid < 32) MISC[C.tid] = 0u;
    __syncthreads();
    XcdBarrier bar; bar.bar = (unsigned*)(args.P.ws + WS_CTL) + CW_BAR; bar.x = 0; bar.st = nullptr;
    if (!MK_SPLIT) bar = xcd_barrier_post((unsigned*)(args.P.ws + WS_CTL) + CW_BAR, MISC + 8);
    const int lo = args.ph_lo, hi = args.ph_hi;
#ifndef PHASE_MASK
#define PHASE_MASK 0xFFFFFFFFu
#endif
#define IN(k) (((PHASE_MASK >> (k)) & 1u) && lo <= (k) && (k) < hi)
#define SEAM(k) do { if ((k) == 13 ? (IN(12) && IN(14)) : (IN(k) && IN((k) + 1))) { TP_A(5); xcd_barrier(bar); TP_B(5); TP_B(40 + PGRP(k)); TP_A(40 + PGRP((k) + 1)); } } while (0)
#define PH_BEGIN Ctx Cp_ = C0; { int t_ = threadIdx.x; asm volatile("" : "+v"(t_)); Cp_.tid = t_; Cp_.lane = t_ & 63; } const Ctx& C = Cp_;   \
        CArgs* ka_ = (CArgs*)__builtin_amdgcn_kernarg_segment_ptr(); asm volatile("" : "+s"(ka_)); CPtrs& P = ka_->P; unsigned char* ws = P.ws; float* ctl = (float*)(ws + WS_CTL); \
        bf16_t* XB = (bf16_t*)(ws + WS_XB); bf16_t* HB = (bf16_t*)(ws + WS_HB); float* X = P.out + OUT_Y; float* ssqx = ctl + F_SSQX; (void)XB; (void)HB; (void)X; (void)ssqx; (void)ctl;
    LAS unsigned char* ring = C.lds + RING_OFF;
    const int bx = (int)blockIdx.x;
#define GEMM(EPI, Aptr, Bptr, M_, N_, K_, Eobj) do { int k_ = (K_); asm volatile("" : "+s"(k_));   \
        pg8::Gemm g{(const bf16_t*)(Aptr), (const bf16_t*)(Bptr), (M_), (N_), k_, k_}; pg8::StaticOrder S; S.init((M_), (N_), C.G, bx); \
        pg8::gemm_phase<EPI, pg8::StaticOrder, PG8_ALIGN, PG8_SP2>(ring, g, S, Eobj); } while (0)

#define GEMM8(EPI, Aptr, Bptr, M_, N_, Eobj) do { int k_ = D / 2; asm volatile("" : "+s"(k_));   \
        pg8::Gemm g{(const bf16_t*)(Aptr), (const bf16_t*)(Bptr), (M_), (N_), k_, k_}; pg8::StaticOrder S; S.init((M_), (N_), C.G, bx); \
        pg8::gemm_phase<EPI, pg8::StaticOrder, PG8_ALIGN, PG8_SP2, true>(ring, g, S, Eobj); } while (0)
#define SA_PTR ((const float*)(ws + WS_SA))
#define TGU_PTR(i) ((const float*)(ws + WS_TGU) + (i) * 2 * FF)
#define W8GU_PTR(i) (ws + WS_W8GU0 + (size_t)(i) * WS_W8GU_STRIDE)
#define STAGE_T2() do { __syncthreads(); for (int i_ = C.tid; i_ < D / 4; i_ += NWAVES * 64) *((LAS f32x4*)(C.lds + QS_OFF) + i_) = *((const f32x4*)(ws + WS_T2) + i_); __syncthreads(); } while (0)
#define FILL(s) do { if (C.G == 256) { RangeOrder S; S.n = bx >= FILL_REM[s] ? FILL_PER[s] : 0; S.g0 = fill_start(s) + (bx - FILL_REM[s]) * FILL_PER[s]; \
        int k_ = KVR / 2; asm volatile("" : "+s"(k_)); pg8::Gemm g{(const bf16_t*)(ws + WS_CL8), (const bf16_t*)(ws + WS_W8), NCK, D, k_, k_}; STAGE_T2(); epi::Kv8 E_{(float*)(ws + WS_RP), (const float*)(ws + WS_SC2), (const LAS float*)(C.lds + QS_OFF), (size_t)NCK}; \
        pg8::gemm_phase<epi::Kv8, RangeOrder, PG8_ALIGN, R_SP2, true>(ring, g, S, E_); } } while (0)

#ifndef TPROBE
#define TPROBE 0
#endif
#ifdef PROBE_PHASE
#define PGRP(k) ((k) == PROBE_PHASE ? 7 : 0)
#else
#define PGRP(k) ((k) == 0 ? 1 : ((k) == 12 || (k) == 13) ? 2 : (k) == 14 ? 3 : ((k) == 4 || (k) == 15) ? 4 : 0)
#endif
    unsigned long long tp0_ = 0, tp1_ = 0, tpacc_ = 0;
#define TP_A(k) do { if (TPROBE == (k)) { __syncthreads(); tp0_ = __builtin_amdgcn_s_memrealtime(); } } while (0)
#define TP_B(k) do { if (TPROBE == (k)) { __syncthreads(); tp1_ = __builtin_amdgcn_s_memrealtime(); tpacc_ += tp1_ - tp0_; } } while (0)
#ifndef W8GU_FN
#define W8GU_FN phase_w8gu2
#endif
#ifndef DUP_SEL
#define DUP_SEL 0
#endif
    if (IN(0)) { PH_BEGIN phase_cacheconv(C, P, C.vcu, C.G); phase_w8(C, P); W8GU_FN(C, P); phase_prologue(C, P); if (DUP_SEL == 1) { __syncthreads(); phase_prologue(C, P); } } SEAM(0);
    if (IN(1)) { PH_BEGIN epi::Swiglu8 E{HB, ssqx + 0 * T, SA_PTR, TGU_PTR(0)}; TP_A(3); GEMM8(epi::Swiglu8, ws + WS_A8, W8GU_PTR(0), T, 2 * FF, E); TP_B(3); TP_A(4); FILL(0); TP_B(4); } SEAM(1);
    if (IN(2)) { PH_BEGIN epi::Resid E{XB, ssqx + 1 * T, 0.5f}; TP_A(2); GEMM(epi::Resid, HB, ws + WS_WDN0, T, D, FF, E); TP_B(2); TP_A(1); FILL(1); TP_B(1); } SEAM(2);
    if (IN(3)) { PH_BEGIN epi::ConvIn E{(bf16_t*)(ws + WS_BB), (bf16_t*)(ws + WS_UB), ssqx + 1 * T, P.out + OUT_CSP, P.out + OUT_CSS}; GEMM(epi::ConvIn, XB, ws + WS_WCI, T, 3 * D, D, E); FILL(2); } SEAM(3);
    if (IN(4)) { PH_BEGIN TP_A(8); phase_conv(C, P); TP_B(8); } SEAM(4);
    if (IN(5)) { PH_BEGIN epi::Resid E{XB, ssqx + 2 * T, 1.0f};
        if (C.G == 256) {
            GEMM(epi::Resid, ws + WS_ZB, ws + WS_WCO, TP, D, D, E);
            { int k_ = 256; asm volatile("" : "+s"(k_)); pg8::Gemm g{(const bf16_t*)(ws + WS_ZB) + (size_t)TP * D, (const bf16_t*)(ws + WS_WCO), TS, D, k_, D}; SplitOrder S{bx, 4}; epi::Slab E_{(float*)(ws + WS_SLAB)};
              pg8::gemm_phase<epi::Slab, SplitOrder, PG8_ALIGN, PG8_SP2>(ring, g, S, E_); }
        } else { GEMM(epi::Resid, ws + WS_ZB, ws + WS_WCO, T, D, D, E); }
        FILL(3); } SEAM(5);
    if (IN(6)) { PH_BEGIN if (C.G == 256) phase_quant(C, P, (const float*)(ws + WS_SLAB), 4, ssqx + 2 * T); else phase_quant(C, P); xcd_barrier(bar); epi::Swiglu8 E{HB, ssqx + 2 * T, SA_PTR, TGU_PTR(1)}; GEMM8(epi::Swiglu8, ws + WS_A8, W8GU_PTR(1), T, 2 * FF, E); FILL(4); } SEAM(6);
    if (IN(7)) { PH_BEGIN epi::Resid E{XB, ssqx + 3 * T, 0.5f}; GEMM(epi::Resid, HB, ws + WS_WDN1, T, D, FF, E); FILL(5); } SEAM(7);
    if (IN(8)) { PH_BEGIN phase_quant(C, P); xcd_barrier(bar); { epi::Swiglu8 E{HB, ssqx + 3 * T, SA_PTR, TGU_PTR(2)}; GEMM8(epi::Swiglu8, ws + WS_A8, W8GU_PTR(2), T, 2 * FF, E); }
        { epi::Dkv E{ssqx + 3 * T, (float*)(ws + WS_CKV), ctl + F_SSQLAT, ctl + F_SSQKPE}; int k_ = D; asm volatile("" : "+s"(k_)); pg8::Gemm g{(const bf16_t*)XB, (const bf16_t*)(ws + WS_WDKV), T, 512, k_, k_};
          pg8::StaticOrder S; S.init(T, 512, C.G, (bx + 84) % C.G); pg8::gemm_phase<epi::Dkv, pg8::StaticOrder, PG8_ALIGN, PG8_SP2>(ring, g, S, E); } } SEAM(8);
    if (IN(9)) { PH_BEGIN epi::Resid E{XB, ssqx + 4 * T, 0.5f}; GEMM(epi::Resid, HB, ws + WS_WDN2, T, D, FF, E); FILL(7); TP_A(8); phase_kvfin(C, P); TP_B(8); } SEAM(9);
    if (IN(10)) { PH_BEGIN { epi::Dq E{(bf16_t*)(ws + WS_CQB), ssqx + 4 * T, ctl + F_SSQCQ}; GEMM(epi::Dq, XB, ws + WS_WDQ, T, QRANK, D, E); } FILL(8);
                  { epi::Kv E{(bf16_t*)(ws + WS_KN), (bf16_t*)(ws + WS_VB), (float*)(ws + WS_RPT), (size_t)T}; GEMM(epi::Kv, ws + WS_LATB, ws + WS_WUKV, T, 2 * D, KVR, E); } FILL(9); } SEAM(10);
    if (IN(11)) { PH_BEGIN epi::Uq E{(bf16_t*)(ws + WS_QB), ctl + F_SSQCQ, ctl + F_SSQQ}; TP_A(13); GEMM(epi::Uq, ws + WS_CQB, ws + WS_WUQ, T, NQ, QRANK, E); TP_B(13); TP_A(14); FILL(10); TP_B(14); } SEAM(11);
    if (IN(12)) { PH_BEGIN const int r0_ = (C.G == 256) ? fill_start(NSLOT) : 0, base_ = (R_UNITS - r0_) / C.G, ext_ = (R_UNITS - r0_) % C.G;
        RangeOrder S; S.g0 = r0_ + bx * base_ + (bx < ext_ ? bx : ext_); S.n = base_ + (bx < ext_ ? 1 : 0);
        int k_ = KVR / 2; asm volatile("" : "+s"(k_)); pg8::Gemm g{(const bf16_t*)(ws + WS_CL8), (const bf16_t*)(ws + WS_W8), NCK, D, k_, k_}; STAGE_T2(); epi::Kv8 E_{(float*)(ws + WS_RP), (const float*)(ws + WS_SC2), (const LAS float*)(C.lds + QS_OFF), (size_t)NCK};
        pg8::gemm_phase<epi::Kv8, RangeOrder, PG8_ALIGN, R_SP2, true>(ring, g, S, E_);
        phase_qkfin(C, P); }
    SEAM(13);
    if (IN(14)) { PH_BEGIN
        const bf16_t* QF = (const bf16_t*)(ws + WS_QB); const bf16_t* KN = (const bf16_t*)(ws + WS_KN); const bf16_t* KPE = (const bf16_t*)(ws + WS_KPEB);
        const bf16_t* VBp = (const bf16_t*)(ws + WS_VB); bf16_t* OB = (bf16_t*)(ws + WS_OB);
#ifndef ATT_SEL
#define ATT_SEL 3
#endif
        att::sa::Src S{(const bf16_t*)(ws + WS_CLB), P.in[3], (const int*)P.in[5], (const float*)(ws + WS_RP), (const bf16_t*)(ws + WS_LATB), KPE, (const float*)(ws + WS_RTS), ws + WS_CL8, (const float*)(ws + WS_SC2)};
#ifndef ATT_OVERLAP
#define ATT_OVERLAP 0
#endif
        if (ATT_OVERLAP && C.G == 256) {
            volatile LAS unsigned* gcnt = (volatile LAS unsigned*)(C.lds + MISC_OFF) + 16;
            if (C.wave < 4) { unsigned ep = 0u; const int bh = C.vcu >> 4, s = C.vcu & 15;
                att::pa4::unit(bh >> 3, bh & 7, 63 - 2 * s, QF, KN, KPE, VBp, OB, (char*)lds, C.lds, gcnt, ep);
                att::pa4::unit(bh >> 3, bh & 7, 62 - 2 * s, QF, KN, KPE, VBp, OB, (char*)lds, C.lds, gcnt, ep);
                att::pa4::unit(bh >> 3, bh & 7, 2 * s + 1, QF, KN, KPE, VBp, OB, (char*)lds, C.lds, gcnt, ep);
                att::pa4::unit(bh >> 3, bh & 7, 2 * s, QF, KN, KPE, VBp, OB, (char*)lds, C.lds, gcnt, ep);
            } else if (C.wave < 7) { unsigned ep = 0u;
                att::sa3::unit(S, (const bf16_t*)(ws + WS_QS), (float*)(ws + WS_PO), (float*)(ws + WS_PML), C.vcu >> 1, C.vcu & 1, C.lds, (char*)lds, gcnt + 1, ep); }
        } else {
#define RUN_SA() do { for (int v = C.vcu; v < 2 * DB; v += C.G) att::sa::unit(S, (const bf16_t*)(ws + WS_QS), (float*)(ws + WS_PO), (float*)(ws + WS_PML), v >> 1, v & 1, C.lds, (char*)lds); } while (0)
#ifndef PA_REV2
#define PA_REV2 true
#endif
#ifndef PA_UNIT
#define PA_UNIT unit_dma
#endif
#define RUN_PA() do { for (int v = C.vcu; v < 256; v += C.G) { const int bh = v >> 4, s = v & 15; \
            att::pa::unit_dma<false>(bh >> 3, bh & 7, 31 - s, QF, KN, KPE, VBp, OB, (char*)lds, C.lds); att::pa::unit_dma<PA_REV2>(bh >> 3, bh & 7, s, QF, KN, KPE, VBp, OB, (char*)lds, C.lds); } } while (0)
        RUN_PA(); RUN_SA();
#undef RUN_SA
#undef RUN_PA
        }
    } SEAM(14);
    if (IN(15)) { PH_BEGIN TP_A(7); phase_scomb(C, P); TP_B(7); } SEAM(15);
    if (IN(16)) { PH_BEGIN epi::Resid E{XB, ssqx + 5 * T, 1.0f};
        if (C.G == 256) {
            GEMM(epi::Resid, ws + WS_OB, ws + WS_WO, TP, D, D, E);
            { int k_ = 256; asm volatile("" : "+s"(k_)); pg8::Gemm g{(const bf16_t*)(ws + WS_OB) + (size_t)TP * D, (const bf16_t*)(ws + WS_WO), TS, D, k_, D}; SplitOrder S{bx, 4}; epi::Slab E_{(float*)(ws + WS_SLAB)};
              pg8::gemm_phase<epi::Slab, SplitOrder, PG8_ALIGN, PG8_SP2>(ring, g, S, E_); }
        } else { GEMM(epi::Resid, ws + WS_OB, ws + WS_WO, T, D, D, E); } } SEAM(16);
    if (IN(17)) { PH_BEGIN if (C.G == 256) phase_quant(C, P, (const float*)(ws + WS_SLAB), 4, ssqx + 5 * T); else phase_quant(C, P); xcd_barrier(bar); epi::Swiglu8 E{HB, ssqx + 5 * T, SA_PTR, TGU_PTR(3)}; GEMM8(epi::Swiglu8, ws + WS_A8, W8GU_PTR(3), T, 2 * FF, E); } SEAM(17);
    if (IN(18)) { PH_BEGIN
        if (C.G == 256) { unsigned* cnt = (unsigned*)(ws + WS_CTL) + CW_SLC;
            { int k_ = 256; asm volatile("" : "+s"(k_)); pg8::Gemm g{(const bf16_t*)HB + (size_t)TP * FF, (const bf16_t*)(ws + WS_WDN3), TS, D, k_, FF}; SplitOrder S{bx, SPLITK}; epi::Slab E_{(float*)(ws + WS_SLAB)};
              pg8::gemm_phase<epi::Slab, SplitOrder, PG8_ALIGN, PG8_SP2>(ring, g, S, E_); }
            if (bx < 8 * SPLITK) { asm volatile("s_waitcnt vmcnt(0)" ::: "memory"); __syncthreads();
                if (threadIdx.x == 0) { __builtin_amdgcn_fence(__ATOMIC_RELEASE, "agent"); asm volatile("s_waitcnt vmcnt(0)" ::: "memory"); (void)xb_add(cnt, 1u); } }
            { epi::ResidY E{XB, X, 0.5f}; GEMM(epi::ResidY, HB, ws + WS_WDN3, TP, D, FF, E); }
            if (bx >= 8 * SPLITK) {
                if (threadIdx.x == 0) { XB_SPIN(xb_ld(cnt) < (unsigned)(8 * SPLITK), bar.bar); __builtin_amdgcn_fence(__ATOMIC_ACQUIRE, "agent"); asm volatile("s_waitcnt vmcnt(0)" ::: "memory"); }
                __syncthreads();
                const float* slab = (const float*)(ws + WS_SLAB);
                for (int i = (bx - 8 * SPLITK) * (NWAVES * 64) + C.tid; i < TS * D / 4; i += (256 - 8 * SPLITK) * (NWAVES * 64)) { f32x4 s = *((const f32x4*)slab + i);
#pragma unroll
                    for (int c = 1; c < SPLITK; ++c) s += *((const f32x4*)(slab + (size_t)c * TS * D) + i);
                    const u32x2 xw = *((const u32x2*)(XB + (size_t)TP * D) + i); *((f32x4*)(X + (size_t)TP * D) + i) = (f32x4){bflo(xw.x), bfhi(xw.x), bflo(xw.y), bfhi(xw.y)} + s * 0.5f; } }
        } else { epi::ResidY E{XB, X, 0.5f}; GEMM(epi::ResidY, HB, ws + WS_WDN3, T, D, FF, E); } }
#ifdef XBAR_PROBE
    for (int i_ = 0; i_ < XBAR_PROBE; ++i_) xcd_barrier(bar);
#endif
#ifndef PROBE_BLOCK
#define PROBE_BLOCK 255
#endif
    if (TPROBE && blockIdx.x == PROBE_BLOCK && C.wave == 0) { const unsigned long long te = __builtin_amdgcn_s_memrealtime(), span = tpacc_ * 32ull;
        while (__builtin_amdgcn_s_memrealtime() - te < span) __builtin_amdgcn_s_sleep(8); }
#undef IN
#undef SEAM
#undef GEMM
}

extern "C" void kernel_launch(void* const* d_in, const int* in_sizes, int n_in, void* d_out, int out_size, void* d_ws, size_t ws_size, hipStream_t stream) {
    static int grid = 0;
    if (grid == 0) {
        if (n_in != 29 || out_size != (int)OUT_TOTAL || ws_size < WS_END) { fprintf(stderr, "kernel_launch: unexpected shapes (n_in %d, out %d, ws %zu); nothing launched\n", n_in, out_size, ws_size); grid = -1; return; }
        int dev = 0, cus = 0, per_cu = 0;
        if (hipGetDevice(&dev) != hipSuccess || hipDeviceGetAttribute(&cus, hipDeviceAttributeMultiprocessorCount, dev) != hipSuccess) { grid = -1; return; }
        if (hipFuncSetAttribute((const void*)fwd, hipFuncAttributeMaxDynamicSharedMemorySize, LDS_BYTES) != hipSuccess) { fprintf(stderr, "kernel_launch: hipFuncSetAttribute failed\n"); grid = -1; return; }
        if (hipOccupancyMaxActiveBlocksPerMultiprocessor(&per_cu, (const void*)fwd, NWAVES * 64, LDS_BYTES) != hipSuccess || per_cu < 1)
            fprintf(stderr, "kernel_launch: note: occupancy query reports %d workgroups per CU\n", per_cu);
        (void)hipGetLastError();
        grid = cus;
    }
    if (grid < 0) return;
    if (hipMemsetAsync((char*)d_ws + WS_CTL, 0, CTL_BYTES, stream) != hipSuccess) { fprintf(stderr, "kernel_launch: memset failed\n"); return; }
    Args a{};
    for (int i = 0; i < 29; ++i) a.P.in[i] = (const float*)d_in[i];
    a.P.out = (float*)d_out; a.P.ws = (unsigned char*)d_ws;
#if MK_SPLIT
    for (int ph = 0; ph < NPHASE; ++ph) { a.ph_lo = ph; a.ph_hi = ph + 1; hipLaunchKernelGGL(fwd, dim3(grid), dim3(NWAVES * 64), LDS_BYTES, stream, a); }
#else
    a.ph_lo = 0; a.ph_hi = NPHASE;
    hipLaunchKernelGGL(fwd, dim3(grid), dim3(NWAVES * 64), LDS_BYTES, stream, a);
#endif
    const hipError_t le = hipPeekAtLastError();
    if (le != hipSuccess) fprintf(stderr, "kernel_launch: launch failed: %s\n", hipGetErrorName(le));
}
```

```cpp
#include <hip/hip_runtime.h>
#include <cstdio>
#include <cstdint>
namespace pg8 {
#define PG8_LAS __attribute__((address_space(3)))
typedef unsigned short bf16_t;
typedef short bf16x8 __attribute__((ext_vector_type(8)));
typedef float f32x4 __attribute__((ext_vector_type(4)));
typedef unsigned u32x4 __attribute__((ext_vector_type(4)));
constexpr int BM = 256, BK = 64, HALF = 128, HTB = HALF * BK * 2  , STAGE_BYTES = 8 * HTB, NXCD = 8, WGM = 8;

__host__ __device__ __forceinline__ int lds_byte(int r, int c) { const int st = (r >> 4) * 2 + (c >> 5), rr = r & 15, cc = c & 31, ob = rr * 64 + cc * 2; return st * 1024 + (ob ^ (((ob >> 9) & 1) << 5)); }
__host__ __device__ __forceinline__ void stage_rc(int b, int& R, int& C) { const int st = b / 1024, sb = b % 1024, swz = sb ^ (((sb >> 9) & 1) << 5); R = (st >> 1) * 16 + swz / 64; C = (st & 1) * 32 + (swz % 64) / 2; }
__host__ __device__ __forceinline__ int perm32(int rho) { const int n = rho >> 4, i = rho & 15; return 8 * (i >> 2) + 4 * n + (i & 3); }

struct Unit { int pm, pn; int ko; };
struct Gemm { const bf16_t* A; const bf16_t* Bt; int M, N, K; int ld; };

struct StaticOrder {
    int nM, nN, nwg, G, c;
    __host__ __device__ void init(int M, int N, int G_, int c_) { nM = M / BM; nN = N / BM; nwg = nM * nN; G = G_; c = c_; }
    __host__ __device__ bool next(int i, Unit& u) const {
        const long L = (long)i * G + c; if (L >= nwg) return false;
        int wgid = (int)L; { const int q = nwg / NXCD, r = nwg % NXCD, xcd = wgid % NXCD, off = wgid / NXCD; wgid = (xcd < r ? xcd * (q + 1) : r * (q + 1) + (xcd - r) * q) + off; }
        const int nig = WGM * nN, gid = wgid / nig, fm = gid * WGM, gsz = (nM - fm) < WGM ? (nM - fm) : WGM;
        u.pm = fm + ((wgid % nig) % gsz); u.pn = (wgid % nig) / gsz; u.ko = 0; return true;
    }
    __device__ __forceinline__ void a_ready(const Unit&) const {}
    __device__ __forceinline__ void done(const Unit&) const {}
};

__device__ __forceinline__ unsigned cvt_pk_bf16(float lo, float hi) { unsigned r; asm volatile("v_cvt_pk_bf16_f32 %0, %1, %2" : "=v"(r) : "v"(lo), "v"(hi)); return r; }
typedef float f32x2 __attribute__((ext_vector_type(2)));
typedef int i32x4 __attribute__((ext_vector_type(4)));
template <bool I8> __device__ __forceinline__ f32x4 mma16(bf16x8 b, bf16x8 a, f32x4 c) {
    if constexpr (I8) return __builtin_bit_cast(f32x4, __builtin_amdgcn_mfma_i32_16x16x64_i8(__builtin_bit_cast(i32x4, b), __builtin_bit_cast(i32x4, a), __builtin_bit_cast(i32x4, c), 0, 0, 0));
    else return __builtin_amdgcn_mfma_f32_16x16x32_bf16(b, a, c, 0, 0, 0);
}
template <class Epi, class Sched, bool ALIGN_EPI = false, bool SP2 = false, bool I8 = false>
__device__ __forceinline__ void gemm_phase(PG8_LAS unsigned char* lds, const Gemm g, const Sched& S, const Epi& E) {
    int tid_ = threadIdx.x; asm volatile("" : "+v"(tid_));
    const int tid = tid_, wid = __builtin_amdgcn_readfirstlane(tid >> 6), lane = tid & 63, wr = wid >> 2, wc = wid & 3, fr = lane & 15, fq = lane >> 4;
    const int K = g.K, nt = K / BK;
    unsigned voffA[2], voffB[2];
#pragma unroll
    for (int i = 0; i < 2; ++i) { int R, C; stage_rc(tid * 16 + i * 8192, R, C); const int Rb = Epi::PERM ? ((R & ~31) + perm32(R & 31)) : R;
        voffA[i] = (unsigned)(R * g.ld + C) * 2u; voffB[i] = (unsigned)(Rb * g.ld + C) * 2u; }
    const size_t kstep = (size_t)(BK * 2);
    const size_t hstep = (size_t)HALF * g.ld * 2;
    const size_t tstep = 2 * hstep;
    const unsigned ldsw = (unsigned)wid * 1024u;
    const int aoff = lds_byte(wr * 64 + fr, fq * 8), boff = lds_byte(wc * 32 + fr, fq * 8);
#define PG8_SA(b, h) (((b) * 2 + (h)) * HTB)
#define PG8_SB(b, h) ((4 + (b) * 2 + (h)) * HTB)
#define PG8_STAGE(bufoff, gbase, voff) do { _Pragma("unroll") for (int _i = 0; _i < 2; ++_i) \
        __builtin_amdgcn_global_load_lds((const unsigned*)((const char*)(gbase) + (voff)[_i]), (PG8_LAS unsigned*)(lds + (bufoff) + ldsw + _i * 8192), 16, 0, 0); } while (0)
#define PG8_LDA(dst, b, h) do { _Pragma("unroll") for (int m = 0; m < 4; ++m) _Pragma("unroll") for (int k = 0; k < 2; ++k) dst[m][k] = *(const PG8_LAS bf16x8*)(lds + PG8_SA(b, h) + aoff + m * 2048 + k * 1024); } while (0)
#define PG8_LDB(dst, b, h) do { _Pragma("unroll") for (int n = 0; n < 2; ++n) _Pragma("unroll") for (int k = 0; k < 2; ++k) dst[n][k] = *(const PG8_LAS bf16x8*)(lds + PG8_SB(b, h) + boff + n * 2048 + k * 1024); } while (0)
#define PG8_MMA(ai, bj, At, Bt) do { __builtin_amdgcn_s_setprio(1); _Pragma("unroll") for (int m = 0; m < 4; ++m) _Pragma("unroll") for (int n = 0; n < 2; ++n) _Pragma("unroll") for (int k = 0; k < 2; ++k) \
        acc[ai][bj][m][n] = mma16<I8>(Bt[n][k], At[m][k], acc[ai][bj][m][n]); __builtin_amdgcn_s_setprio(0); } while (0)
#define PG8_WAIT_V(n) asm volatile("s_waitcnt vmcnt(" #n ")" ::: "memory")
#define PG8_WAIT_L(n) asm volatile("s_waitcnt lgkmcnt(" #n ")" ::: "memory")
#define PG8_BAR __builtin_amdgcn_s_barrier()
#define PG8_SCHED __builtin_amdgcn_sched_barrier(0)
    Unit cur, nxt; int ui = 0;
    if (!S.next(0, cur)) return;
    f32x4 acc[2][2][4][2];
#pragma unroll
    for (int a = 0; a < 2; ++a)
#pragma unroll
        for (int b = 0; b < 2; ++b)
#pragma unroll
            for (int m = 0; m < 4; ++m)
#pragma unroll
                for (int n = 0; n < 2; ++n) acc[a][b][m][n] = (f32x4){0.f, 0.f, 0.f, 0.f};
    bf16x8 At[4][2], B0[2][2], B1[2][2];
    const char* cA = (const char*)g.A + (size_t)cur.pm * tstep + cur.ko; const char* cB = (const char*)g.Bt + (size_t)cur.pn * tstep + cur.ko;
    S.a_ready(cur);
    if constexpr (SP2) {
        PG8_STAGE(PG8_SB(0, 0), cB, voffB); PG8_STAGE(PG8_SB(0, 1), cB + hstep, voffB); PG8_STAGE(PG8_SA(0, 0), cA, voffA); PG8_STAGE(PG8_SA(0, 1), cA + hstep, voffA);
        if (wr == 1) PG8_BAR;
        PG8_WAIT_V(2); PG8_BAR;
        PG8_STAGE(PG8_SB(1, 0), cB + kstep, voffB); PG8_STAGE(PG8_SA(1, 0), cA + kstep, voffA); PG8_STAGE(PG8_SB(1, 1), cB + hstep + kstep, voffB);
        PG8_WAIT_V(6); PG8_BAR;
    } else {
        PG8_STAGE(PG8_SB(0, 0), cB, voffB); PG8_STAGE(PG8_SA(0, 0), cA, voffA); PG8_STAGE(PG8_SB(0, 1), cB + hstep, voffB); PG8_STAGE(PG8_SA(0, 1), cA + hstep, voffA);
        if (wr == 1) PG8_BAR;
        PG8_WAIT_V(4); PG8_BAR;
        PG8_STAGE(PG8_SB(1, 0), cB + kstep, voffB); PG8_STAGE(PG8_SA(1, 0), cA + kstep, voffA); PG8_STAGE(PG8_SB(1, 1), cB + hstep + kstep, voffB);
        PG8_WAIT_V(6); PG8_BAR;
    }
    for (;;) {
        const bool has_next = S.next(ui + 1, nxt);
        const char* nA = has_next ? (const char*)g.A + (size_t)nxt.pm * tstep + nxt.ko : cA; const char* nB = has_next ? (const char*)g.Bt + (size_t)nxt.pn * tstep + nxt.ko : cB;
        for (int t = 0; t < nt; t += 2) {
            const bool last = (t == nt - 2);
            const char* a1 = cA + (size_t)(t + 1) * kstep;
            const char* a2 = last ? nA : cA + (size_t)(t + 2) * kstep; const char* b2 = last ? nB : cB + (size_t)(t + 2) * kstep;
            const char* a3 = a2 + kstep; const char* b3 = b2 + kstep;
            if (last && has_next) S.a_ready(nxt);
            if constexpr (SP2) {
            PG8_LDB(B0, 0, 0); PG8_LDB(B1, 0, 1); PG8_SCHED; PG8_LDA(At, 0, 0); PG8_STAGE(PG8_SA(1, 1), a1 + hstep, voffA);
            PG8_WAIT_V(8); PG8_WAIT_L(0); PG8_BAR; PG8_MMA(0, 0, At, B0); PG8_MMA(0, 1, At, B1); PG8_BAR; PG8_SCHED;
            PG8_LDA(At, 0, 1); PG8_STAGE(PG8_SB(0, 0), b2, voffB); PG8_STAGE(PG8_SB(0, 1), b2 + hstep, voffB); PG8_STAGE(PG8_SA(0, 0), a2, voffA);
            PG8_WAIT_V(8); PG8_WAIT_L(0); PG8_BAR; PG8_MMA(1, 0, At, B0); PG8_MMA(1, 1, At, B1); PG8_BAR; PG8_SCHED;
            PG8_LDB(B0, 1, 0); PG8_LDB(B1, 1, 1); PG8_SCHED; PG8_LDA(At, 1, 0); PG8_STAGE(PG8_SA(0, 1), a2 + hstep, voffA);
            PG8_WAIT_V(8); PG8_WAIT_L(0); PG8_BAR; PG8_MMA(0, 0, At, B0); PG8_MMA(0, 1, At, B1); PG8_BAR; PG8_SCHED;
            PG8_LDA(At, 1, 1); PG8_STAGE(PG8_SB(1, 0), b3, voffB); PG8_STAGE(PG8_SB(1, 1), b3 + hstep, voffB); PG8_STAGE(PG8_SA(1, 0), a3, voffA);
            PG8_WAIT_V(8); PG8_WAIT_L(0); PG8_BAR; PG8_MMA(1, 0, At, B0); PG8_MMA(1, 1, At, B1); PG8_BAR; PG8_SCHED;
            } else {
            PG8_LDB(B0, 0, 0); PG8_SCHED; PG8_LDA(At, 0, 0); PG8_STAGE(PG8_SA(1, 1), a1 + hstep, voffA);
            PG8_WAIT_L(8); PG8_BAR; PG8_WAIT_L(0); PG8_MMA(0, 0, At, B0); PG8_BAR; PG8_SCHED;
            PG8_LDB(B1, 0, 1); PG8_STAGE(PG8_SB(0, 0), b2, voffB);
            PG8_BAR; PG8_WAIT_L(0); PG8_MMA(0, 1, At, B1); PG8_BAR;
            PG8_LDA(At, 0, 1); PG8_STAGE(PG8_SA(0, 0), a2, voffA);
            PG8_BAR; PG8_WAIT_L(0); PG8_MMA(1, 0, At, B0); PG8_BAR; PG8_SCHED;
            PG8_STAGE(PG8_SB(0, 1), b2 + hstep, voffB);
            PG8_WAIT_V(6); PG8_BAR; PG8_MMA(1, 1, At, B1); PG8_BAR;
            PG8_LDB(B0, 1, 0); PG8_SCHED; PG8_LDA(At, 1, 0); PG8_STAGE(PG8_SA(0, 1), a2 + hstep, voffA);
            PG8_WAIT_L(8); PG8_BAR; PG8_WAIT_L(0); PG8_MMA(0, 0, At, B0); PG8_BAR; PG8_SCHED;
            PG8_LDB(B1, 1, 1); PG8_STAGE(PG8_SB(1, 0), b3, voffB);
            PG8_BAR; PG8_WAIT_L(0); PG8_MMA(0, 1, At, B1); PG8_BAR;
            PG8_LDA(At, 1, 1); PG8_STAGE(PG8_SA(1, 0), a3, voffA);
            PG8_BAR; PG8_WAIT_L(0); PG8_MMA(1, 0, At, B0); PG8_BAR; PG8_SCHED;
            PG8_STAGE(PG8_SB(1, 1), b3 + hstep, voffB);
            PG8_WAIT_V(6); PG8_BAR; PG8_MMA(1, 1, At, B1); PG8_BAR;
            }
        }
        if constexpr (ALIGN_EPI) { if (wr == 0) PG8_BAR; }
        if constexpr (!Epi::AFTER_DRAIN) { E(acc, cur, wr, wc, fr, fq); S.done(cur); }
        if (!has_next) break;
#pragma unroll
        for (int a = 0; a < 2; ++a)
#pragma unroll
            for (int b = 0; b < 2; ++b)
#pragma unroll
                for (int m = 0; m < 4; ++m)
#pragma unroll
                    for (int n = 0; n < 2; ++n) acc[a][b][m][n] = (f32x4){0.f, 0.f, 0.f, 0.f};
        cur = nxt; cA = nA; cB = nB; ++ui;
        if constexpr (ALIGN_EPI) { if (wr == 1) PG8_BAR; }
    }
    PG8_WAIT_V(0);
    if constexpr (!ALIGN_EPI) { if (wr == 0) PG8_BAR; }
    PG8_BAR;
    if constexpr (Epi::AFTER_DRAIN) { E.fused(acc, cur, wr, wc, fr, fq, lds, wid, lane); S.done(cur); }
#undef PG8_SA
#undef PG8_SB
#undef PG8_STAGE
#undef PG8_LDA
#undef PG8_LDB
#undef PG8_MMA
#undef PG8_WAIT_V
#undef PG8_WAIT_L
#undef PG8_BAR
#undef PG8_SCHED
}
}
#define PG8_SP2 true
#define PG8_ALIGN true
#define GAS __attribute__((address_space(1)))
#define LAS __attribute__((address_space(3)))
typedef unsigned short bf16;
typedef unsigned v4u __attribute__((ext_vector_type(4)));
typedef float f32x4 __attribute__((ext_vector_type(4)));
typedef short bf16x8 __attribute__((ext_vector_type(8)));
typedef GAS unsigned gu32;
typedef GAS unsigned long long gu64;
#define RLX_AGENT __ATOMIC_RELAXED, __HIP_MEMORY_SCOPE_AGENT
#define LDS_WAIT() asm volatile("s_waitcnt lgkmcnt(0)" ::: "memory")
#define VM_WAIT() asm volatile("s_waitcnt vmcnt(0)" ::: "memory")
__device__ __forceinline__ unsigned long long rt() { return __builtin_amdgcn_s_memrealtime(); }
__device__ __forceinline__ unsigned f2bf(float f) { unsigned u = __builtin_bit_cast(unsigned, f); return (u + 0x7fffu + ((u >> 16) & 1u)) >> 16; }
__device__ __forceinline__ unsigned pk2(float lo, float hi) { return f2bf(lo) | (f2bf(hi) << 16); }
#define XB_TMO      128
#define XB_XCNT(j)  (256  + 64 * (j))
#define XB_XSUB(j)  (1280 + 64 * (j))
#define XB_XGEN(j)  (2304 + 64 * (j))
#define XB_TOP      3328
#define XB_TOPGEN   3392
#define XCD_BAR_WORDS 3456
#define XB_SPIN_CAP (1u << 18)

__device__ __forceinline__ unsigned xb_ld(unsigned* p)              { return __hip_atomic_load(p, __ATOMIC_RELAXED, __HIP_MEMORY_SCOPE_AGENT); }
__device__ __forceinline__ unsigned xb_add(unsigned* p, unsigned v) { return __hip_atomic_fetch_add(p, v, __ATOMIC_RELAXED, __HIP_MEMORY_SCOPE_AGENT); }
__device__ __forceinline__ unsigned xb_xcc_id() { return (unsigned)__builtin_amdgcn_s_getreg((3 << 11) | 20) & 0xFu; }
#define XB_SPIN(cond, bar) do { unsigned _sp = 0; while (cond) { __builtin_amdgcn_s_sleep(1); \
    if ((++_sp & 255u) == 0u) { if (xb_ld(&(bar)[XB_TMO])) break; if (_sp > XB_SPIN_CAP) { atomicAdd(&(bar)[XB_TMO], 1u); break; } } } } while (0)

struct XcdBarrier {
    unsigned* bar; unsigned x;
    volatile LAS unsigned* st;
};

__device__ __forceinline__ XcdBarrier xcd_barrier_post(unsigned* bar, volatile LAS unsigned* st) {
    XcdBarrier b; b.bar = bar; b.x = xb_xcc_id(); b.st = st;
    if (threadIdx.x == 0) (void)xb_add(&bar[XB_XCNT(b.x)], 1u);
    return b;
}
__device__ __forceinline__ void xcd_barrier_complete(unsigned* bar, unsigned x, unsigned& nloc, unsigned& nx) {
    const unsigned G = gridDim.x * gridDim.y * gridDim.z;
    unsigned sum, cnt, mine, sp = 0u;
    for (;;) {
        sum = 0u; cnt = 0u; mine = 0u;
#pragma unroll
        for (unsigned j = 0; j < 16; ++j) { const unsigned c = xb_ld(&bar[XB_XCNT(j)]); sum += c; cnt += (c > 0u) ? 1u : 0u; mine = (j == x) ? c : mine; }
        if (sum == G) break;
        __builtin_amdgcn_s_sleep(1);
        if ((++sp & 255u) == 0u) { if (xb_ld(&bar[XB_TMO])) break; if (sp > XB_SPIN_CAP) { atomicAdd(&bar[XB_TMO], 1u); break; } }
    }
    nloc = mine > 0u ? mine : 1u; nx = cnt > 0u ? cnt : 1u;
}

__device__ __forceinline__ void xcd_barrier(const XcdBarrier& b) {
    asm volatile("s_waitcnt vmcnt(0)" ::: "memory");
    __syncthreads();
    if (threadIdx.x == 0) {
        unsigned* bar = b.bar;
        __builtin_amdgcn_s_waitcnt(0);
        unsigned nloc = b.st[0], nx = b.st[1];
        if (nloc == 0u) { xcd_barrier_complete(bar, b.x, nloc, nx); b.st[0] = nloc; b.st[1] = nx; }
        const unsigned old = xb_add(&bar[XB_XSUB(b.x)], 1u);
        const unsigned gen = old / nloc;
        if (old + 1u == (gen + 1u) * nloc) {
            __builtin_amdgcn_fence(__ATOMIC_RELEASE, "agent");
            asm volatile("s_waitcnt vmcnt(0)" ::: "memory");
            const unsigned og = xb_add(&bar[XB_TOP], 1u);
            const unsigned tg = og / nx;
            if (og + 1u == (tg + 1u) * nx) xb_add(&bar[XB_TOPGEN], 1u);
            else XB_SPIN(xb_ld(&bar[XB_TOPGEN]) == tg, bar);
            __builtin_amdgcn_fence(__ATOMIC_ACQUIRE, "agent");
            xb_add(&bar[XB_XGEN(b.x)], 1u);
            asm volatile("s_waitcnt vmcnt(0)" ::: "memory");
        } else {
            XB_SPIN(xb_ld(&bar[XB_XGEN(b.x)]) == gen, bar);
            __builtin_amdgcn_fence(__ATOMIC_ACQUIRE, "agent");
            asm volatile("s_waitcnt vmcnt(0)" ::: "memory");
        }
    }
    __syncthreads();
}

constexpr int NWAVES = 8;
constexpr int D = 1024, TP = 16384, TS = 512, T = TP + TS, FF = 2816, NH = 8, KVR = 256, ROPE = 64, QRANK = 512, NQ = 1536, HD = 192;
constexpr int SEQ = 8192, DB = 128, DS = 4, PAGE = 128, NPG = 64, CKVW = 320;
constexpr int NCK = DB * SEQ;
constexpr float EPS = 1e-6f;
constexpr float QSCALE = 0.07216878364870322f * 1.4426950408889634f;
constexpr size_t OUT_Y = 0, OUT_CSP = 17301504, OUT_CSS = 17305600, OUT_LATP = 17567744, OUT_KPEP = 21762048, OUT_LATS = 22810624, OUT_KPES = 22941696, OUT_TOTAL = 22974464;
constexpr size_t MiB = 1u << 20;
constexpr size_t WS_CTL = 0, CTL_BYTES = 4 * MiB;
constexpr size_t WS_WGU0 = 4 * MiB, WS_WGU1 = 15 * MiB, WS_WGU2 = 26 * MiB, WS_WGU3 = 38 * MiB;
constexpr size_t WS_WDN0 = 49 * MiB, WS_WDN1 = 55 * MiB, WS_WDN2 = 61 * MiB, WS_WDN3 = 67 * MiB;
constexpr size_t WS_WCI = 73 * MiB, WS_WCO = 79 * MiB, WS_WDQ = 81 * MiB, WS_WUQ = 82 * MiB, WS_WO = 84 * MiB, WS_WUKV = 86 * MiB;
constexpr size_t WS_ROPE = 88 * MiB;
constexpr size_t WS_XB = 92 * MiB, WS_HB = 126 * MiB, WS_BB = 218 * MiB, WS_UB = 252 * MiB, WS_ZB = 286 * MiB, WS_CKV = 320 * MiB;
constexpr size_t WS_LATB = 342 * MiB, WS_KPEB = 352 * MiB, WS_KN = 356 * MiB, WS_VB = 390 * MiB, WS_CQB = 424 * MiB, WS_QB = 442 * MiB;
constexpr size_t WS_OB = 493 * MiB, WS_RPT = 527 * MiB, WS_RTS = 529 * MiB, WS_QS = 530 * MiB, WS_PO = 534 * MiB, WS_PML = 543 * MiB;
constexpr size_t WS_CLB = 544 * MiB, WS_CKB = 1056 * MiB, WS_RP = 1184 * MiB, WS_SLAB = 1248 * MiB;
constexpr size_t WS_CL8 = 1272 * MiB, WS_SC2 = 1528 * MiB, WS_W8 = 1532 * MiB, WS_T2 = 1533 * MiB;
constexpr size_t WS_A8 = 1534 * MiB, WS_SA = 1552 * MiB, WS_W8GU0 = 1553 * MiB, WS_W8GU_STRIDE = 6 * MiB, WS_TGU = 1577 * MiB, WS_WDKV = 1578 * MiB, WS_END = 1580 * MiB;
constexpr int SPLITK = 11;
constexpr int CW_BAR = 4096, CW_SLC = 8192, CW_SC = 8256;
constexpr int F_SSQX = 16384, F_SSQLAT = F_SSQX + 6 * T, F_SSQKPE = F_SSQX + 7 * T, F_SSQCQ = F_SSQX + 8 * T, F_SSQQ = F_SSQX + 9 * T;
static_assert((size_t)(F_SSQQ + 16 * T) * 4 <= CTL_BYTES, "ctl");
constexpr int RING_OFF = 0, RING_BYTES = 131072, MISC_OFF = 131072, QS_OFF = 131584, QS_STRIDE = 656, SCR_OFF = QS_OFF + 32 * QS_STRIDE, LDS_BYTES = 155648;
static_assert(SCR_OFF + 8 * 256 <= LDS_BYTES, "lds");

typedef unsigned short bf16_t;
typedef unsigned u32x2 __attribute__((ext_vector_type(2)));
typedef float f32x2 __attribute__((ext_vector_type(2)));
typedef __bf16 bf16x2_t __attribute__((ext_vector_type(2)));
__device__ __forceinline__ unsigned cvt_pk_bf16(float lo, float hi) { f32x2 v = {lo, hi}; bf16x2_t b = __builtin_convertvector(v, bf16x2_t); return __builtin_bit_cast(unsigned, b); }
__device__ __forceinline__ float bf2f(unsigned short h) { return __builtin_bit_cast(float, (unsigned)h << 16); }
__device__ __forceinline__ float bflo(unsigned w) { return __builtin_bit_cast(float, w << 16); }
__device__ __forceinline__ float bfhi(unsigned w) { return __builtin_bit_cast(float, w & 0xffff0000u); }
__device__ __forceinline__ v4u pack8f(const float* v) { v4u o; o.x = cvt_pk_bf16(v[0], v[1]); o.y = cvt_pk_bf16(v[2], v[3]); o.z = cvt_pk_bf16(v[4], v[5]); o.w = cvt_pk_bf16(v[6], v[7]); return o; }
__device__ __forceinline__ void unpack8f(v4u w, float* v) { v[0] = bflo(w.x); v[1] = bfhi(w.x); v[2] = bflo(w.y); v[3] = bfhi(w.y); v[4] = bflo(w.z); v[5] = bfhi(w.z); v[6] = bflo(w.w); v[7] = bfhi(w.w); }
__device__ __forceinline__ float fq_sum(float s) { s += __shfl_xor(s, 16); s += __shfl_xor(s, 32); return s; }
__device__ __forceinline__ float wave_sum(float v) {
#pragma unroll
    for (int o = 1; o < 64; o <<= 1) v += __shfl_xor(v, o);
    return v;
}
__device__ __forceinline__ float rsq(float x) { return 1.0f / sqrtf(x); }
__device__ __forceinline__ void atomic_addf(float* p, float v) { unsafeAtomicAdd(p, v); }

namespace epi {
using pg8::Unit; using pg8::f32x4; using pg8::BM; using pg8::HALF;
typedef f32x4 Acc[2][2][4][2];

struct Swiglu {
    static constexpr bool PERM = true, AFTER_DRAIN = false;
    bf16_t* HB; const float* ssq; float* ckv; float* ssq_lat; float* ssq_kpe; int ngu;
    __device__ __forceinline__ void operator()(const f32x4 (&acc)[2][2][4][2], const Unit& u, int wr, int wc, int fr, int fq) const {
        float sq8[2][4];
#pragma unroll
        for (int ai = 0; ai < 2; ++ai)
#pragma unroll
            for (int m = 0; m < 4; ++m) sq8[ai][m] = ssq[u.pm * BM + ai * HALF + wr * 64 + m * 16 + fr];
#pragma unroll
        for (int ai = 0; ai < 2; ++ai)
#pragma unroll
            for (int m = 0; m < 4; ++m) {
                const int row = u.pm * BM + ai * HALF + wr * 64 + m * 16 + fr;
                const float rs = rsq(sq8[ai][m] * (1.0f / D) + EPS);
                if (u.pn < ngu) {
                    float h[8];
#pragma unroll
                    for (int n = 0; n < 2; ++n)
#pragma unroll
                        for (int j = 0; j < 4; ++j) { const float g = acc[ai][0][m][n][j] * rs, up = acc[ai][1][m][n][j] * rs;
                            const float sg = g * __builtin_amdgcn_rcpf(1.0f + __builtin_amdgcn_exp2f(-1.4426950408889634f * g)); h[4 * n + j] = sg * up; }
                    *(v4u*)(HB + (size_t)row * FF + 128 * u.pn + 32 * wc + 8 * fq) = pack8f(h);
                } else if (u.pn == ngu) {
                    float ss = 0.f;
#pragma unroll
                    for (int bj = 0; bj < 2; ++bj)
#pragma unroll
                        for (int n = 0; n < 2; ++n) { const f32x4 v = acc[ai][bj][m][n] * rs; ss += (v[0] * v[0] + v[1] * v[1]) + (v[2] * v[2] + v[3] * v[3]);
                            *(f32x4*)(ckv + (size_t)row * CKVW + 128 * bj + 32 * wc + 8 * fq + 4 * n) = v; }
                    ss = fq_sum(ss); if (fq == 0) atomic_addf(ssq_lat + row, ss);
                } else {
                    if (wc < 2) { float ss = 0.f;
#pragma unroll
                        for (int n = 0; n < 2; ++n) { const f32x4 v = acc[ai][0][m][n] * rs; ss += (v[0] * v[0] + v[1] * v[1]) + (v[2] * v[2] + v[3] * v[3]);
                            *(f32x4*)(ckv + (size_t)row * CKVW + 256 + 32 * wc + 8 * fq + 4 * n) = v; }
                        ss = fq_sum(ss); if (fq == 0) atomic_addf(ssq_kpe + row, ss); }
                }
            }
    }
};
struct Swiglu8 {
    static constexpr bool PERM = true, AFTER_DRAIN = false;
    bf16_t* HB; const float* ssq; const float* sa; const float* tsc;
    __device__ __forceinline__ void operator()(const f32x4 (&acc)[2][2][4][2], const Unit& u, int wr, int wc, int fr, int fq) const {
        typedef int i32x4 __attribute__((ext_vector_type(4)));
        int fq_ = fq, fr_ = fr; asm volatile("" : "+v"(fq_), "+v"(fr_));
        float f8[2][4], s8[2][4]; f32x4 tg[2], tu[2];
#pragma unroll
        for (int ai = 0; ai < 2; ++ai)
#pragma unroll
            for (int m = 0; m < 4; ++m) { const int row = u.pm * BM + ai * HALF + wr * 64 + m * 16 + fr_; f8[ai][m] = ssq[row]; s8[ai][m] = sa[row]; }
#pragma unroll
        for (int n = 0; n < 2; ++n) { tg[n] = *(const f32x4*)(tsc + 256 * u.pn + 32 * wc + 8 * fq_ + 4 * n); tu[n] = *(const f32x4*)(tsc + 256 * u.pn + 128 + 32 * wc + 8 * fq_ + 4 * n); }
#pragma unroll
        for (int ai = 0; ai < 2; ++ai)
#pragma unroll
            for (int m = 0; m < 4; ++m) {
                const int row = u.pm * BM + ai * HALF + wr * 64 + m * 16 + fr;
                const float rs = rsq(f8[ai][m] * (1.0f / D) + EPS) * s8[ai][m];
                float h[8];
#pragma unroll
                for (int n = 0; n < 2; ++n) { const i32x4 ig = __builtin_bit_cast(i32x4, acc[ai][0][m][n]), iu = __builtin_bit_cast(i32x4, acc[ai][1][m][n]);
#pragma unroll
                    for (int j = 0; j < 4; ++j) { const float g = (float)ig[j] * (rs * tg[n][j]), up = (float)iu[j] * (rs * tu[n][j]);
                        const float sg = g * __builtin_amdgcn_rcpf(1.0f + __builtin_amdgcn_exp2f(-1.4426950408889634f * g)); h[4 * n + j] = sg * up; } }
                *(v4u*)(HB + (size_t)row * FF + 128 * u.pn + 32 * wc + 8 * fq) = pack8f(h);
            }
    }
};
struct Dkv {
    static constexpr bool PERM = true, AFTER_DRAIN = false;
    const float* ssq; float* ckv; float* ssq_lat; float* ssq_kpe;
    __device__ __forceinline__ void operator()(const f32x4 (&acc)[2][2][4][2], const Unit& u, int wr, int wc, int fr, int fq) const {
        float sq8[2][4];
#pragma unroll
        for (int ai = 0; ai < 2; ++ai)
#pragma unroll
            for (int m = 0; m < 4; ++m) sq8[ai][m] = ssq[u.pm * BM + ai * HALF + wr * 64 + m * 16 + fr];
#pragma unroll
        for (int ai = 0; ai < 2; ++ai)
#pragma unroll
            for (int m = 0; m < 4; ++m) {
                const int row = u.pm * BM + ai * HALF + wr * 64 + m * 16 + fr;
                const float rs = rsq(sq8[ai][m] * (1.0f / D) + EPS);
                if (u.pn == 0) {
                    float ss = 0.f;
#pragma unroll
                    for (int bj = 0; bj < 2; ++bj)
#pragma unroll
                        for (int n = 0; n < 2; ++n) { const f32x4 v = acc[ai][bj][m][n] * rs; ss += (v[0] * v[0] + v[1] * v[1]) + (v[2] * v[2] + v[3] * v[3]);
                            *(f32x4*)(ckv + (size_t)row * CKVW + 128 * bj + 32 * wc + 8 * fq + 4 * n) = v; }
                    ss = fq_sum(ss); if (fq == 0) atomic_addf(ssq_lat + row, ss);
                } else if (wc < 2) { float ss = 0.f;
#pragma unroll
                    for (int n = 0; n < 2; ++n) { const f32x4 v = acc[ai][0][m][n] * rs; ss += (v[0] * v[0] + v[1] * v[1]) + (v[2] * v[2] + v[3] * v[3]);
                        *(f32x4*)(ckv + (size_t)row * CKVW + 256 + 32 * wc + 8 * fq + 4 * n) = v; }
                    ss = fq_sum(ss); if (fq == 0) atomic_addf(ssq_kpe + row, ss); }
            }
    }
};
template <bool FINAL>
struct ResidT {
    static constexpr bool PERM = true, AFTER_DRAIN = false;
    bf16_t* XB; float* P; float alpha;
    __device__ __forceinline__ void operator()(const f32x4 (&acc)[2][2][4][2], const Unit& u, int wr, int wc, int fr, int fq) const {
        v4u xv[2][4][2];
#pragma unroll
        for (int ai = 0; ai < 2; ++ai)
#pragma unroll
            for (int m = 0; m < 4; ++m) { const bf16_t* xp = XB + (size_t)(u.pm * BM + ai * HALF + wr * 64 + m * 16 + fr) * D + 256 * u.pn + 32 * wc + 8 * fq;
#pragma unroll
                for (int bj = 0; bj < 2; ++bj) xv[ai][m][bj] = *(const v4u*)(xp + 128 * bj); }
#pragma unroll
        for (int ai = 0; ai < 2; ++ai)
#pragma unroll
            for (int m = 0; m < 4; ++m) { const int row = u.pm * BM + ai * HALF + wr * 64 + m * 16 + fr;
                const size_t off = (size_t)row * D + 256 * u.pn + 32 * wc + 8 * fq; float ss = 0.f;
#pragma unroll
                for (int bj = 0; bj < 2; ++bj) { const v4u xw = xv[ai][m][bj];
                    const f32x4 v0 = (f32x4){bflo(xw.x), bfhi(xw.x), bflo(xw.y), bfhi(xw.y)} + acc[ai][bj][m][0] * alpha, v1 = (f32x4){bflo(xw.z), bfhi(xw.z), bflo(xw.w), bfhi(xw.w)} + acc[ai][bj][m][1] * alpha;
                    if constexpr (FINAL) { float* yp = P + off + 128 * bj; *(f32x4*)yp = v0; *(f32x4*)(yp + 4) = v1; }
                    else { ss += (v0[0] * v0[0] + v0[1] * v0[1]) + (v0[2] * v0[2] + v0[3] * v0[3]) + (v1[0] * v1[0] + v1[1] * v1[1]) + (v1[2] * v1[2] + v1[3] * v1[3]);
                        v4u w; w.x = cvt_pk_bf16(v0[0], v0[1]); w.y = cvt_pk_bf16(v0[2], v0[3]); w.z = cvt_pk_bf16(v1[0], v1[1]); w.w = cvt_pk_bf16(v1[2], v1[3]); *(v4u*)(XB + off + 128 * bj) = w; } }
                if constexpr (!FINAL) { ss = fq_sum(ss); if (fq == 0) atomic_addf(P + row, ss); } }
    }
};
using Resid = ResidT<false>;
using ResidY = ResidT<true>;
struct ConvIn {
    static constexpr bool PERM = true, AFTER_DRAIN = false;
    bf16_t* BB; bf16_t* UB; const float* ssq; float* csp; float* css;
    __device__ __forceinline__ void operator()(const f32x4 (&acc)[2][2][4][2], const Unit& u, int wr, int wc, int fr, int fq) const {
        float sq8[2][4];
#pragma unroll
        for (int ai = 0; ai < 2; ++ai)
#pragma unroll
            for (int m = 0; m < 4; ++m) sq8[ai][m] = ssq[u.pm * BM + ai * HALF + wr * 64 + m * 16 + fr];
#pragma unroll
        for (int ai = 0; ai < 2; ++ai)
#pragma unroll
            for (int m = 0; m < 4; ++m) {
                const int row = u.pm * BM + ai * HALF + wr * 64 + m * 16 + fr;
                const float rs = rsq(sq8[ai][m] * (1.0f / D) + EPS);
                if (u.pn < 4) {
#pragma unroll
                    for (int bj = 0; bj < 2; ++bj) { const f32x4 v0 = acc[ai][bj][m][0] * rs, v1 = acc[ai][bj][m][1] * rs;
                        v4u w; w.x = cvt_pk_bf16(v0[0], v0[1]); w.y = cvt_pk_bf16(v0[2], v0[3]); w.z = cvt_pk_bf16(v1[0], v1[1]); w.w = cvt_pk_bf16(v1[2], v1[3]);
                        *(v4u*)(BB + (size_t)row * D + 256 * u.pn + 128 * bj + 32 * wc + 8 * fq) = w; }
                } else {
                    const int ch0 = 128 * (u.pn - 4) + 32 * wc + 8 * fq;
                    const f32x4 u0 = (acc[ai][0][m][0] * rs) * (acc[ai][1][m][0] * rs), u1 = (acc[ai][0][m][1] * rs) * (acc[ai][1][m][1] * rs);
                    v4u w; w.x = cvt_pk_bf16(u0[0], u0[1]); w.y = cvt_pk_bf16(u0[2], u0[3]); w.z = cvt_pk_bf16(u1[0], u1[1]); w.w = cvt_pk_bf16(u1[2], u1[3]);
                    *(v4u*)(UB + (size_t)row * D + ch0) = w;
                    float* dst = nullptr;
                    if (row < TP) { const int t = row & (SEQ - 1); if (t >= SEQ - 2) dst = csp + (size_t)((row >> 13) * 2 + (t - (SEQ - 2))) * D + ch0; }
                    else { const int rs_ = row - TP, i = rs_ & 3; if (i >= 2) dst = css + (size_t)((rs_ >> 2) * 2 + (i - 2)) * D + ch0; }
                    if (dst) { *(f32x4*)dst = u0; *(f32x4*)(dst + 4) = u1; }
                }
            }
    }
};
struct Dq {
    static constexpr bool PERM = true, AFTER_DRAIN = false;
    bf16_t* CQB; const float* ssq; float* ssq_out;
    __device__ __forceinline__ void operator()(const f32x4 (&acc)[2][2][4][2], const Unit& u, int wr, int wc, int fr, int fq) const {
        float sq8[2][4];
#pragma unroll
        for (int ai = 0; ai < 2; ++ai)
#pragma unroll
            for (int m = 0; m < 4; ++m) sq8[ai][m] = ssq[u.pm * BM + ai * HALF + wr * 64 + m * 16 + fr];
#pragma unroll
        for (int ai = 0; ai < 2; ++ai)
#pragma unroll
            for (int m = 0; m < 4; ++m) {
                const int row = u.pm * BM + ai * HALF + wr * 64 + m * 16 + fr;
                const float rs = rsq(sq8[ai][m] * (1.0f / D) + EPS);
                float ss = 0.f;
#pragma unroll
                for (int bj = 0; bj < 2; ++bj) { const f32x4 v0 = acc[ai][bj][m][0] * rs, v1 = acc[ai][bj][m][1] * rs;
                    ss += (v0[0] * v0[0] + v0[1] * v0[1]) + (v0[2] * v0[2] + v0[3] * v0[3]) + (v1[0] * v1[0] + v1[1] * v1[1]) + (v1[2] * v1[2] + v1[3] * v1[3]);
                    v4u w; w.x = cvt_pk_bf16(v0[0], v0[1]); w.y = cvt_pk_bf16(v0[2], v0[3]); w.z = cvt_pk_bf16(v1[0], v1[1]); w.w = cvt_pk_bf16(v1[2], v1[3]);
                    *(v4u*)(CQB + (size_t)row * QRANK + 256 * u.pn + 128 * bj + 32 * wc + 8 * fq) = w; }
                ss = fq_sum(ss); if (fq == 0) atomic_addf(ssq_out + row, ss);
            }
    }
};
struct Uq {
    static constexpr bool PERM = true, AFTER_DRAIN = false;
    bf16_t* QB; const float* ssq; float* ssq_q;
    __device__ __forceinline__ void operator()(const f32x4 (&acc)[2][2][4][2], const Unit& u, int wr, int wc, int fr, int fq) const {
        float sq8[2][4];
#pragma unroll
        for (int ai = 0; ai < 2; ++ai)
#pragma unroll
            for (int m = 0; m < 4; ++m) sq8[ai][m] = ssq[u.pm * BM + ai * HALF + wr * 64 + m * 16 + fr];
#pragma unroll
        for (int ai = 0; ai < 2; ++ai)
#pragma unroll
            for (int m = 0; m < 4; ++m) {
                const int row = u.pm * BM + ai * HALF + wr * 64 + m * 16 + fr;
                const float rs = rsq(sq8[ai][m] * (1.0f / QRANK) + EPS);
#pragma unroll
                for (int bj = 0; bj < 2; ++bj) { const f32x4 v0 = acc[ai][bj][m][0] * rs, v1 = acc[ai][bj][m][1] * rs;
                    float ss = (v0[0] * v0[0] + v0[1] * v0[1]) + (v0[2] * v0[2] + v0[3] * v0[3]) + (v1[0] * v1[0] + v1[1] * v1[1]) + (v1[2] * v1[2] + v1[3] * v1[3]);
                    const int cb = 256 * u.pn + 128 * bj + 32 * wc;
                    const int hh = cb / HD, seg = 2 * hh + ((cb - hh * HD) >= 128 ? 1 : 0);
                    v4u w; w.x = cvt_pk_bf16(v0[0], v0[1]); w.y = cvt_pk_bf16(v0[2], v0[3]); w.z = cvt_pk_bf16(v1[0], v1[1]); w.w = cvt_pk_bf16(v1[2], v1[3]);
                    *(v4u*)(QB + (size_t)row * NQ + cb + 8 * fq) = w;
                    ss = fq_sum(ss); if (fq == 0) atomic_addf(ssq_q + (size_t)seg * T + row, ss); }
            }
    }
};
struct Kv {
    static constexpr bool PERM = true, AFTER_DRAIN = false;
    bf16_t* KU; bf16_t* VB; float* RP; size_t nrows;
    __device__ __forceinline__ void operator()(const f32x4 (&acc)[2][2][4][2], const Unit& u, int wr, int wc, int fr, int fq) const {
#pragma unroll
        for (int ai = 0; ai < 2; ++ai)
#pragma unroll
            for (int m = 0; m < 4; ++m) {
                const unsigned row = (unsigned)(u.pm * BM + ai * HALF + wr * 64 + m * 16 + fr);
                if (u.pn < 4) {
                    const int head = 2 * u.pn + (wc >> 1);
                    float ss = 0.f;
#pragma unroll
                    for (int bj = 0; bj < 2; ++bj) { const f32x4 v0 = acc[ai][bj][m][0], v1 = acc[ai][bj][m][1];
                        ss += (v0[0] * v0[0] + v0[1] * v0[1]) + (v0[2] * v0[2] + v0[3] * v0[3]) + (v1[0] * v1[0] + v1[1] * v1[1]) + (v1[2] * v1[2] + v1[3] * v1[3]);
                        if (KU) { v4u w; w.x = cvt_pk_bf16(v0[0], v0[1]); w.y = cvt_pk_bf16(v0[2], v0[3]); w.z = cvt_pk_bf16(v1[0], v1[1]); w.w = cvt_pk_bf16(v1[2], v1[3]);
                            *(v4u*)(KU + (size_t)(row * D + 128 * head + 64 * (wc & 1) + 32 * bj + 8 * fq)) = w; } }
                    ss = fq_sum(ss); if (fq == 0) RP[(size_t)((unsigned)(2 * head + (wc & 1)) * (unsigned)nrows + row)] = ss;
                } else if (VB) {
#pragma unroll
                    for (int bj = 0; bj < 2; ++bj) { const f32x4 v0 = acc[ai][bj][m][0], v1 = acc[ai][bj][m][1];
                        v4u w; w.x = cvt_pk_bf16(v0[0], v0[1]); w.y = cvt_pk_bf16(v0[2], v0[3]); w.z = cvt_pk_bf16(v1[0], v1[1]); w.w = cvt_pk_bf16(v1[2], v1[3]);
                        *(v4u*)(VB + (size_t)(row * D + 256 * (u.pn - 4) + 128 * bj + 32 * wc + 8 * fq)) = w; }
                }
            }
    }
};
struct Kv8 {
    static constexpr bool PERM = true, AFTER_DRAIN = false;
    float* RP; const float* sc2; const LAS float* t2; size_t nrows;
    __device__ __forceinline__ void operator()(const f32x4 (&acc)[2][2][4][2], const Unit& u, int wr, int wc, int fr, int fq) const {
        typedef int i32x4 __attribute__((ext_vector_type(4)));
        const int head = 2 * u.pn + (wc >> 1);
        int fq_ = fq; asm volatile("" : "+v"(fq_));
        float ss[2][4];
#pragma unroll
        for (int ai = 0; ai < 2; ++ai)
#pragma unroll
            for (int m = 0; m < 4; ++m) ss[ai][m] = 0.f;
#pragma unroll
        for (int bj = 0; bj < 2; ++bj)
#pragma unroll
            for (int n = 0; n < 2; ++n) { const f32x4 tv = *(const LAS f32x4*)(t2 + 256 * u.pn + 128 * bj + 32 * wc + 8 * fq_ + 4 * n);
#pragma unroll
                for (int ai = 0; ai < 2; ++ai)
#pragma unroll
                    for (int m = 0; m < 4; ++m) { const i32x4 vi = __builtin_bit_cast(i32x4, acc[ai][bj][m][n]);
#pragma unroll
                        for (int j = 0; j < 4; ++j) { const float f = (float)vi[j]; ss[ai][m] += f * f * tv[j]; } } }
#pragma unroll
        for (int ai = 0; ai < 2; ++ai)
#pragma unroll
            for (int m = 0; m < 4; ++m) {
                const unsigned row = (unsigned)(u.pm * BM + ai * HALF + wr * 64 + m * 16 + fr);
                const float s_ = fq_sum(ss[ai][m]); if (fq == 0) RP[(size_t)((unsigned)(2 * head + (wc & 1)) * (unsigned)nrows + row)] = s_;
            }
    }
};
struct Slab {
    static constexpr bool PERM = true, AFTER_DRAIN = false;
    float* slab;
    __device__ __forceinline__ void operator()(const f32x4 (&acc)[2][2][4][2], const Unit& u, int wr, int wc, int fr, int fq) const {
        float* base = slab + (size_t)(u.ko >> 9) * TS * D;
#pragma unroll
        for (int ai = 0; ai < 2; ++ai)
#pragma unroll
            for (int m = 0; m < 4; ++m) { float* p = base + (size_t)(u.pm * BM + ai * HALF + wr * 64 + m * 16 + fr) * D + 256 * u.pn + 32 * wc + 8 * fq;
#pragma unroll
                for (int bj = 0; bj < 2; ++bj) { *(f32x4*)(p + 128 * bj) = acc[ai][bj][m][0]; *(f32x4*)(p + 128 * bj + 4) = acc[ai][bj][m][1]; } }
    }
};
}

struct Ctx {
    LAS unsigned char* lds;
    int tid, lane, wave, vcu, G;
};
struct PrepD { const float* W; const float* gain; bf16_t* WT; int K, N, drow0, k0, n0; };
__device__ __forceinline__ void prep_load(const PrepD& d, f32x4 (&v)[8], float (&gk)[8], int lane) {
    if (!d.W) return;
    const int r = lane >> 3, c4 = lane & 7;
#pragma unroll
    for (int i = 0; i < 8; ++i) { v[i] = *(const f32x4*)(d.W + (size_t)(d.k0 + 8 * i + r) * d.N + d.n0 + 4 * c4); gk[i] = d.gain ? d.gain[d.k0 + 8 * i + r] : 1.0f; }
}
__device__ __forceinline__ void prep_finish(const PrepD& d, const f32x4 (&v)[8], const float (&gk)[8], LAS float* scr, int lane) {
    if (!d.W) { const v4u z = {0u, 0u, 0u, 0u};
#pragma unroll
        for (int j = 0; j < 2; ++j) *(v4u*)(d.WT + 8 * (lane + 64 * j)) = z;
        return; }
    { const int r = lane >> 3, c4 = lane & 7;
#pragma unroll
      for (int i = 0; i < 8; ++i) { LAS float* sp = scr + (8 * i + r) * 33 + 4 * c4; sp[0] = v[i].x * gk[i]; sp[1] = v[i].y * gk[i]; sp[2] = v[i].z * gk[i]; sp[3] = v[i].w * gk[i]; } }
    LDS_WAIT(); asm volatile("" ::: "memory");
    const int c = lane & 7;
#pragma unroll
    for (int j = 0; j < 4; ++j) { const int n = (lane >> 3) + 8 * j; const LAS float* s = scr + (8 * c) * 33 + n;
        v4u o; o.x = cvt_pk_bf16(s[0 * 33], s[1 * 33]); o.y = cvt_pk_bf16(s[2 * 33], s[3 * 33]); o.z = cvt_pk_bf16(s[4 * 33], s[5 * 33]); o.w = cvt_pk_bf16(s[6 * 33], s[7 * 33]);
        *(v4u*)(d.WT + (size_t)(d.drow0 + n) * d.K + d.k0 + 8 * c) = o; }
    LDS_WAIT(); asm volatile("" ::: "memory");
}
__device__ __forceinline__ int gu_map(int nb) { const int up = nb >= 88 ? 1 : 0, hb = nb - 88 * up; return 256 * (hb >> 2) + 128 * up + 32 * (hb & 3); }
__device__ __forceinline__ int ci_map(int nb) { if (nb < 32) return 32 * nb; const int hh = nb >= 64 ? 1 : 0, cb = nb - 32 - 32 * hh; return 256 * (4 + (cb >> 2)) + 128 * hh + 32 * (cb & 3); }
__device__ __forceinline__ int uk_map(int nb) { const int h = nb >> 2, dq = nb & 3; return 256 * (h >> 1) + 128 * (dq & 1) + 32 * (2 * (h & 1) + (dq >> 1)); }
__device__ __forceinline__ int uk_row(int h, int d) { return 256 * (h >> 1) + 128 * ((d >> 5) & 1) + 32 * (2 * (h & 1) + (d >> 6)) + (d & 31); }

struct Ptrs {
    const float* in[29]; float* out; unsigned char* ws;
};
typedef const __attribute__((address_space(4))) Ptrs CPtrs;

__device__ __forceinline__ void phase_prologue(const Ctx& C, CPtrs& P) {
    unsigned char* ws = P.ws;
    LAS float* scr = (LAS float*)(C.lds + RING_OFF + C.wave * 16384);
    const int lane = C.lane;
    const int gw = C.vcu * NWAVES + C.wave, NGW = C.G * NWAVES;
    constexpr int I_GU = 16 * 176, I_DKV = 16 * 10, I_DN = 44 * 32, I_CI = 16 * 96, I_SQ = 16 * 32, I_DQ = 16 * 16, I_UQ = 8 * 48, I_UKV = 4 * 32, I_Z = 192;
    constexpr int NITEMS = I_DKV + 4 * I_DN + I_CI + I_SQ + I_DQ + I_UQ + I_SQ + 2 * I_UKV + I_Z;
    auto decode = [&](int it) -> PrepD {
        int r = it;
        if (r < I_DKV) { const int kb = r / 10, nb = r % 10; return PrepD{P.in[23], P.in[22], (bf16_t*)(ws + WS_WDKV), D, CKVW, 32 * nb, 64 * (kb), 32 * (nb)}; } r -= I_DKV;
        if (r < 4 * I_DN) { const int mi = r / I_DN; r -= mi * I_DN; const int kb = r / 32, nb = r % 32;
            const float* W = (mi & 1 ? P.in[12] : P.in[8]) + (size_t)(mi >> 1) * FF * D;
            bf16_t* dst = (bf16_t*)(ws + (mi == 0 ? WS_WDN0 : mi == 1 ? WS_WDN1 : mi == 2 ? WS_WDN2 : WS_WDN3));
            return PrepD{W, nullptr, dst, FF, D, 32 * nb, 64 * (kb), 32 * (nb)}; } r -= 4 * I_DN;
        if (r < I_CI) { const int kb = r / 96, nb = r % 96; return PrepD{P.in[13], P.in[9], (bf16_t*)(ws + WS_WCI), D, 3 * D, ci_map(nb), 64 * (kb), 32 * (nb)}; } r -= I_CI;
        if (r < I_SQ) { const int kb = r / 32, nb = r % 32; return PrepD{P.in[15], nullptr, (bf16_t*)(ws + WS_WCO), D, D, 32 * nb, 64 * (kb), 32 * (nb)}; } r -= I_SQ;
        if (r < I_DQ) { const int kb = r / 16, nb = r % 16; return PrepD{P.in[16], P.in[9] + D, (bf16_t*)(ws + WS_WDQ), D, QRANK, 32 * nb, 64 * (kb), 32 * (nb)}; } r -= I_DQ;
        if (r < I_UQ) { const int kb = r / 48, nb = r % 48; return PrepD{P.in[18], P.in[17], (bf16_t*)(ws + WS_WUQ), QRANK, NQ, 32 * nb, 64 * (kb), 32 * (nb)}; } r -= I_UQ;
        if (r < I_SQ) { const int kb = r / 32, nb = r % 32; return PrepD{P.in[21], nullptr, (bf16_t*)(ws + WS_WO), D, D, 32 * nb, 64 * (kb), 32 * (nb)}; } r -= I_SQ;
        if (r < I_UKV) { const int kb = r / 32, nb = r % 32; return PrepD{P.in[26], nullptr, (bf16_t*)(ws + WS_WUKV), KVR, D, uk_map(nb), 64 * (kb), 32 * (nb)}; } r -= I_UKV;
        if (r < I_UKV) { const int kb = r / 32, nb = r % 32; return PrepD{P.in[27], nullptr, (bf16_t*)(ws + WS_WUKV), KVR, D, 1024 + 32 * nb, 64 * (kb), 32 * (nb)}; } r -= I_UKV;
        return PrepD{nullptr, nullptr, (bf16_t*)(ws + WS_WDKV) + (size_t)(320 + r) * D, 0, 0, 0, 0, 0};
    };
    if (gw < NITEMS) {
        PrepD cur = decode(gw); f32x4 v[8]; float gk[8]; prep_load(cur, v, gk, lane);
        for (int it = gw; it < NITEMS; it += NGW) {
            PrepD nxt = cur; f32x4 vn[8]; float gn[8];
            if (it + NGW < NITEMS) { nxt = decode(it + NGW); prep_load(nxt, vn, gn, lane); }
            prep_finish(cur, v, gk, scr, lane);
            cur = nxt;
#pragma unroll
            for (int i = 0; i < 8; ++i) { v[i] = vn[i]; gk[i] = gn[i]; }
        }
    }
    {
        f32x2* tab = (f32x2*)(ws + WS_ROPE);
        for (int e = gw * 64 + lane; e < (SEQ + DS) * 32; e += NGW * 64) {
            const int pos = e >> 5, j = e & 31;
            double f = 1.0; for (int i = 0; i < j; ++i) f *= 0.74989420933245582730;
            const double ang = (double)pos * f;
            const double k = __builtin_rint(ang * 0.15915494309189533577);
            double r = __builtin_fma(-k, 6.283185307179586232, ang); r = __builtin_fma(-k, 2.4492935982947064e-16, r);
            const double r2 = r * r; double ts = 1.0, tc = 1.0, ss = 1.0, cs = 1.0;
#pragma unroll
            for (int q = 1; q <= 14; ++q) { tc *= -r2 / (double)((2 * q - 1) * (2 * q)); cs += tc; ts *= -r2 / (double)((2 * q) * (2 * q + 1)); ss += ts; }
            tab[e] = (f32x2){(float)cs, (float)(ss * r)};
        }
    }
    {
        bf16_t* XB = (bf16_t*)(ws + WS_XB); float* ssq = (float*)(ws + WS_CTL) + F_SSQX; unsigned char* A8 = ws + WS_A8; float* SA = (float*)(ws + WS_SA);
        for (int row0 = gw; row0 < T; row0 += 2 * NGW) {
            f32x4 v[2][4]; float s[2]; const int nr = row0 + NGW < T ? 2 : 1;
#pragma unroll
            for (int q = 0; q < 2; ++q) { const int row = row0 + (q < nr ? q * NGW : 0); const float* src = row < TP ? P.in[0] + (size_t)row * D : P.in[1] + (size_t)(row - TP) * D;
#pragma unroll
                for (int j = 0; j < 4; ++j) v[q][j] = *((const f32x4*)src + lane + 64 * j); }
#pragma unroll
            for (int q = 0; q < 2; ++q) { s[q] = 0.f;
#pragma unroll
                for (int j = 0; j < 4; ++j) s[q] += (v[q][j].x * v[q][j].x + v[q][j].y * v[q][j].y) + (v[q][j].z * v[q][j].z + v[q][j].w * v[q][j].w);
                s[q] = wave_sum(s[q]); }
#pragma unroll
            for (int q = 0; q < 2; ++q) if (q < nr) { const int row = row0 + q * NGW;
#pragma unroll
                for (int j = 0; j < 4; ++j) {
                    u32x2 w; w.x = cvt_pk_bf16(v[q][j].x, v[q][j].y); w.y = cvt_pk_bf16(v[q][j].z, v[q][j].w); *((u32x2*)(XB + (size_t)row * D) + lane + 64 * j) = w; }
                if (lane == 0) ssq[row] = s[q];
                float am = 0.f;
#pragma unroll
                for (int j = 0; j < 4; ++j) am = fmaxf(am, fmaxf(fmaxf(fabsf(v[q][j].x), fabsf(v[q][j].y)), fmaxf(fabsf(v[q][j].z), fabsf(v[q][j].w))));
#pragma unroll
                for (int o = 1; o < 64; o <<= 1) am = fmaxf(am, __shfl_xor(am, o));
                const float inv = am > 0.f ? 127.0f / am : 0.f;
#pragma unroll
                for (int j = 0; j < 4; ++j) { const int q0 = __float2int_rn(v[q][j].x * inv), q1 = __float2int_rn(v[q][j].y * inv), q2 = __float2int_rn(v[q][j].z * inv), q3 = __float2int_rn(v[q][j].w * inv);
                    *(unsigned*)(A8 + (size_t)row * D + 4 * (lane + 64 * j)) = (unsigned)(q0 & 255) | ((unsigned)(q1 & 255) << 8) | ((unsigned)(q2 & 255) << 16) | ((unsigned)q3 << 24); }
                if (lane == 0) SA[row] = am * (1.0f / 127.0f); }
        }
    }
}

#ifndef SA_INT8_COPY_ONLY
#define SA_INT8_COPY_ONLY 1
#endif
__device__ __forceinline__ void phase_cacheconv(const Ctx& C, CPtrs& P, int cw, int nconv) {
    unsigned char* ws = P.ws; const int lane = C.lane;
    const int* pt = (const int*)P.in[5]; bf16_t* CLB = (bf16_t*)(ws + WS_CLB); unsigned char* CL8 = ws + WS_CL8; float* SC2 = (float*)(ws + WS_SC2);
    for (int pg = cw * NWAVES + C.wave; pg < DB * NPG; pg += nconv * NWAVES) {
        const int phys = pt[pg];
        const float* sl = P.in[2] + (size_t)phys * PAGE * KVR; bf16_t* dl = CLB + (size_t)pg * PAGE * KVR;
        for (int i0 = 0; i0 < 64; i0 += 8) {
            f32x4 a[8], c[8];
#pragma unroll
            for (int j = 0; j < 8; ++j) { a[j] = *((const f32x4*)sl + 2 * (lane + 64 * (i0 + j))); c[j] = *((const f32x4*)sl + 2 * (lane + 64 * (i0 + j)) + 1); }
#pragma unroll
            for (int j = 0; j < 8; ++j) {
#if !SA_INT8_COPY_ONLY
                { v4u w; w.x = cvt_pk_bf16(a[j].x, a[j].y); w.y = cvt_pk_bf16(a[j].z, a[j].w); w.z = cvt_pk_bf16(c[j].x, c[j].y); w.w = cvt_pk_bf16(c[j].z, c[j].w); *((v4u*)dl + lane + 64 * (i0 + j)) = w; }
#endif
                float am = fmaxf(fmaxf(fmaxf(fabsf(a[j].x), fabsf(a[j].y)), fmaxf(fabsf(a[j].z), fabsf(a[j].w))), fmaxf(fmaxf(fabsf(c[j].x), fabsf(c[j].y)), fmaxf(fabsf(c[j].z), fabsf(c[j].w))));
#pragma unroll
                for (int o = 1; o < 32; o <<= 1) am = fmaxf(am, __shfl_xor(am, o));
                const float inv = am > 0.f ? 127.0f / am : 0.f;
                const int q0 = __float2int_rn(a[j].x * inv), q1 = __float2int_rn(a[j].y * inv), q2 = __float2int_rn(a[j].z * inv), q3 = __float2int_rn(a[j].w * inv);
                const int q4 = __float2int_rn(c[j].x * inv), q5 = __float2int_rn(c[j].y * inv), q6 = __float2int_rn(c[j].z * inv), q7 = __float2int_rn(c[j].w * inv);
                u32x2 qw; qw.x = (unsigned)(q0 & 255) | ((unsigned)(q1 & 255) << 8) | ((unsigned)(q2 & 255) << 16) | ((unsigned)q3 << 24);
                qw.y = (unsigned)(q4 & 255) | ((unsigned)(q5 & 255) << 8) | ((unsigned)(q6 & 255) << 16) | ((unsigned)q7 << 24);
                const size_t row = (size_t)pg * PAGE + 2 * (i0 + j) + (lane >> 5);
                *(u32x2*)(CL8 + row * KVR + 8 * (lane & 31)) = qw;
                if ((lane & 31) == 0) { const float sc = am * (1.0f / 127.0f); SC2[row] = sc * sc; } }
        }
    }
}

__device__ __forceinline__ void phase_w8(const Ctx& C, CPtrs& P) {
    unsigned char* ws = P.ws; const float* wuk = P.in[26]; unsigned char* W8 = ws + WS_W8; float* T2 = (float*)(ws + WS_T2); const int lane = C.lane;
    for (int r = C.vcu * NWAVES + C.wave; r < D; r += C.G * NWAVES) {
        const int pn = r >> 8, bj = (r >> 7) & 1, wc = (r >> 5) & 3, h = 2 * pn + (wc >> 1), d = 64 * (wc & 1) + 32 * bj + (r & 31), col = 128 * h + d;
        float x[4]; float am = 0.f;
#pragma unroll
        for (int e = 0; e < 4; ++e) { x[e] = wuk[(size_t)(4 * lane + e) * D + col]; am = fmaxf(am, fabsf(x[e])); }
#pragma unroll
        for (int o = 1; o < 64; o <<= 1) am = fmaxf(am, __shfl_xor(am, o));
        const float inv = am > 0.f ? 127.0f / am : 0.f;
        const int q0 = __float2int_rn(x[0] * inv), q1 = __float2int_rn(x[1] * inv), q2 = __float2int_rn(x[2] * inv), q3 = __float2int_rn(x[3] * inv);
        *(unsigned*)(W8 + (size_t)r * KVR + 4 * lane) = (unsigned)(q0 & 255) | ((unsigned)(q1 & 255) << 8) | ((unsigned)(q2 & 255) << 16) | ((unsigned)q3 << 24);
        if (lane == 0) { const float sc = am * (1.0f / 127.0f); T2[r] = sc * sc; }
    }
}

__device__ __forceinline__ void phase_quant(const Ctx& C, CPtrs& P, const float* slab = nullptr, int ns = 0, float* ssq_out = nullptr) {
    unsigned char* ws = P.ws; bf16_t* XB = (bf16_t*)(ws + WS_XB); unsigned char* A8 = ws + WS_A8; float* SA = (float*)(ws + WS_SA);
    const int gw = C.vcu * NWAVES + C.wave, NGW = C.G * NWAVES, lane = C.lane;
    if (slab) {
        for (int r = gw; r < TS; r += NGW) { const size_t row = (size_t)TP + r; f32x4 v[4]; float ss = 0.f, am = 0.f;
#pragma unroll
            for (int j = 0; j < 4; ++j) { const u32x2 xw = *((const u32x2*)(XB + row * D) + lane + 64 * j); f32x4 a = {bflo(xw.x), bfhi(xw.x), bflo(xw.y), bfhi(xw.y)};
                for (int c = 0; c < ns; ++c) a += *((const f32x4*)(slab + ((size_t)c * TS + r) * D) + lane + 64 * j);
                v[j] = a; ss += (a.x * a.x + a.y * a.y) + (a.z * a.z + a.w * a.w); am = fmaxf(am, fmaxf(fmaxf(fabsf(a.x), fabsf(a.y)), fmaxf(fabsf(a.z), fabsf(a.w)))); }
            ss = wave_sum(ss);
#pragma unroll
            for (int o = 1; o < 64; o <<= 1) am = fmaxf(am, __shfl_xor(am, o));
            const float inv = am > 0.f ? 127.0f / am : 0.f;
#pragma unroll
            for (int j = 0; j < 4; ++j) { u32x2 w; w.x = cvt_pk_bf16(v[j].x, v[j].y); w.y = cvt_pk_bf16(v[j].z, v[j].w); *((u32x2*)(XB + row * D) + lane + 64 * j) = w;
                const int q0 = __float2int_rn(v[j].x * inv), q1 = __float2int_rn(v[j].y * inv), q2 = __float2int_rn(v[j].z * inv), q3 = __float2int_rn(v[j].w * inv);
                *(unsigned*)(A8 + row * D + 4 * (lane + 64 * j)) = (unsigned)(q0 & 255) | ((unsigned)(q1 & 255) << 8) | ((unsigned)(q2 & 255) << 16) | ((unsigned)q3 << 24); }
            if (lane == 0) { ssq_out[row] = ss; SA[row] = am * (1.0f / 127.0f); } }
    }
    const int TQ = slab ? TP : T;
    constexpr int RPS = 4;
    for (int row0 = gw; row0 < TQ; row0 += RPS * NGW) {
        v4u w[RPS][2];
#pragma unroll
        for (int q = 0; q < RPS; ++q) { const int rq = row0 + q * NGW, row = rq < TQ ? rq : row0; w[q][0] = *((const v4u*)(XB + (size_t)row * D) + 2 * lane); w[q][1] = *((const v4u*)(XB + (size_t)row * D) + 2 * lane + 1); }
#pragma unroll
        for (int q = 0; q < RPS; ++q) if (row0 + q * NGW < TQ) { const int row = row0 + q * NGW; float x[16]; unpack8f(w[q][0], x); unpack8f(w[q][1], x + 8);
            float am = 0.f;
#pragma unroll
            for (int e = 0; e < 16; ++e) am = fmaxf(am, fabsf(x[e]));
#pragma unroll
            for (int o = 1; o < 64; o <<= 1) am = fmaxf(am, __shfl_xor(am, o));
            const float inv = am > 0.f ? 127.0f / am : 0.f; v4u o4; unsigned ww[4];
#pragma unroll
            for (int g = 0; g < 4; ++g) { const int q0 = __float2int_rn(x[4 * g] * inv), q1 = __float2int_rn(x[4 * g + 1] * inv), q2 = __float2int_rn(x[4 * g + 2] * inv), q3 = __float2int_rn(x[4 * g + 3] * inv);
                ww[g] = (unsigned)(q0 & 255) | ((unsigned)(q1 & 255) << 8) | ((unsigned)(q2 & 255) << 16) | ((unsigned)q3 << 24); }
            o4.x = ww[0]; o4.y = ww[1]; o4.z = ww[2]; o4.w = ww[3];
            *((v4u*)(A8 + (size_t)row * D) + lane) = o4;
            if (lane == 0) SA[row] = am * (1.0f / 127.0f); }
    }
}
__device__ __forceinline__ void phase_w8gu(const Ctx& C, CPtrs& P) {
    unsigned char* ws = P.ws; const int lane = C.lane, r = lane >> 3, c4 = lane & 7;
    LAS float* scr = (LAS float*)(C.lds + RING_OFF + C.wave * 16384);
    for (int item = C.vcu * NWAVES + C.wave; item < 4 * 176; item += C.G * NWAVES) {
        const int mi = item / 176, nb = item % 176, n0 = 32 * nb, N = 2 * FF;
        const float* W = (mi & 1 ? P.in[11] : P.in[7]) + (size_t)(mi >> 1) * D * N; const float* g = (mi & 1 ? P.in[10] : P.in[6]) + (mi >> 1) * D;
        unsigned char* W8 = ws + WS_W8GU0 + (size_t)mi * WS_W8GU_STRIDE; float* TS = (float*)(ws + WS_TGU) + mi * N;
        const int drow0 = gu_map(nb);
        float am[4] = {0.f, 0.f, 0.f, 0.f};
#pragma unroll 16
        for (int kb = 0; kb < D / 8; ++kb) { const int k = 8 * kb + r; const f32x4 v = *(const f32x4*)(W + (size_t)k * N + n0 + 4 * c4); const float gk = g[k];
            am[0] = fmaxf(am[0], fabsf(v.x * gk)); am[1] = fmaxf(am[1], fabsf(v.y * gk)); am[2] = fmaxf(am[2], fabsf(v.z * gk)); am[3] = fmaxf(am[3], fabsf(v.w * gk)); }
        float inv[4];
#pragma unroll
        for (int j = 0; j < 4; ++j) { float a = am[j]; a = fmaxf(a, __shfl_xor(a, 8)); a = fmaxf(a, __shfl_xor(a, 16)); a = fmaxf(a, __shfl_xor(a, 32)); inv[j] = a > 0.f ? 127.0f / a : 0.f; am[j] = a; }
        if (r == 0) *(f32x4*)(TS + drow0 + 4 * c4) = (f32x4){am[0] * (1.0f / 127.0f), am[1] * (1.0f / 127.0f), am[2] * (1.0f / 127.0f), am[3] * (1.0f / 127.0f)};
        for (int k0 = 0; k0 < D; k0 += 64) {
            f32x4 v[8]; float gk[8];
#pragma unroll
            for (int i = 0; i < 8; ++i) { v[i] = *(const f32x4*)(W + (size_t)(k0 + 8 * i + r) * N + n0 + 4 * c4); gk[i] = g[k0 + 8 * i + r]; }
#pragma unroll
            for (int i = 0; i < 8; ++i) { LAS float* sp = scr + (8 * i + r) * 33 + 4 * c4;
                sp[0] = __builtin_rintf(v[i].x * gk[i] * inv[0]); sp[1] = __builtin_rintf(v[i].y * gk[i] * inv[1]); sp[2] = __builtin_rintf(v[i].z * gk[i] * inv[2]); sp[3] = __builtin_rintf(v[i].w * gk[i] * inv[3]); }
            LDS_WAIT(); asm volatile("" ::: "memory");
            const int c = lane & 7;
#pragma unroll
            for (int j = 0; j < 4; ++j) { const int n = (lane >> 3) + 8 * j; const LAS float* s = scr + (8 * c) * 33 + n;
                const int q0 = (int)s[0 * 33], q1 = (int)s[1 * 33], q2 = (int)s[2 * 33], q3 = (int)s[3 * 33], q4 = (int)s[4 * 33], q5 = (int)s[5 * 33], q6 = (int)s[6 * 33], q7 = (int)s[7 * 33];
                u32x2 o; o.x = (unsigned)(q0 & 255) | ((unsigned)(q1 & 255) << 8) | ((unsigned)(q2 & 255) << 16) | ((unsigned)q3 << 24);
                o.y = (unsigned)(q4 & 255) | ((unsigned)(q5 & 255) << 8) | ((unsigned)(q6 & 255) << 16) | ((unsigned)q7 << 24);
                *(u32x2*)(W8 + (size_t)(drow0 + n) * D + k0 + 8 * c) = o; }
            LDS_WAIT(); asm volatile("" ::: "memory");
        }
    }
}

__device__ __forceinline__ void phase_w8gu2(const Ctx& C, CPtrs& P) {
    unsigned char* ws = P.ws; const int lane = C.lane, r = lane >> 3, c4 = lane & 7, w = C.wave;
    LAS float* S = (LAS float*)(C.lds + RING_OFF); LAS float* AM = (LAS float*)(C.lds + QS_OFF);
    __syncthreads();
    for (int item = C.vcu; item < 4 * 176; item += C.G) {
        const int mi = item / 176, nb = item % 176, n0 = 32 * nb, N = 2 * FF;
        const float* W = (mi & 1 ? P.in[11] : P.in[7]) + (size_t)(mi >> 1) * D * N; const float* g = (mi & 1 ? P.in[10] : P.in[6]) + (mi >> 1) * D;
        unsigned char* W8 = ws + WS_W8GU0 + (size_t)mi * WS_W8GU_STRIDE; float* TS = (float*)(ws + WS_TGU) + mi * N;
        const int drow0 = gu_map(nb);
        float am[4] = {0.f, 0.f, 0.f, 0.f};
#pragma unroll
        for (int hb = 0; hb < 2; ++hb) {
            f32x4 v[8]; float gk[8];
#pragma unroll
            for (int i = 0; i < 8; ++i) { const int k = 128 * w + 64 * hb + 8 * i + r; v[i] = *(const f32x4*)(W + (size_t)k * N + n0 + 4 * c4); gk[i] = g[k]; }
#pragma unroll
            for (int i = 0; i < 8; ++i) { const int k = 128 * w + 64 * hb + 8 * i + r, sw = k & 31; LAS float* sp = S + k * 32;
                const float x0 = v[i].x * gk[i], x1 = v[i].y * gk[i], x2 = v[i].z * gk[i], x3 = v[i].w * gk[i];
                am[0] = fmaxf(am[0], fabsf(x0)); am[1] = fmaxf(am[1], fabsf(x1)); am[2] = fmaxf(am[2], fabsf(x2)); am[3] = fmaxf(am[3], fabsf(x3));
                sp[(4 * c4 + 0) ^ sw] = x0; sp[(4 * c4 + 1) ^ sw] = x1; sp[(4 * c4 + 2) ^ sw] = x2; sp[(4 * c4 + 3) ^ sw] = x3; }
        }
#pragma unroll
        for (int j = 0; j < 4; ++j) { float a = am[j]; a = fmaxf(a, __shfl_xor(a, 8)); a = fmaxf(a, __shfl_xor(a, 16)); a = fmaxf(a, __shfl_xor(a, 32)); am[j] = a; }
        if (r == 0) { AM[w * 32 + 4 * c4 + 0] = am[0]; AM[w * 32 + 4 * c4 + 1] = am[1]; AM[w * 32 + 4 * c4 + 2] = am[2]; AM[w * 32 + 4 * c4 + 3] = am[3]; }
        __syncthreads();
        const int n = lane & 31, k0 = 128 * w + 64 * (lane >> 5);
        float a = 0.f;
#pragma unroll
        for (int ww = 0; ww < 8; ++ww) a = fmaxf(a, AM[ww * 32 + n]);
        const float inv = a > 0.f ? 127.0f / a : 0.f;
        if (w == 0 && lane < 32) TS[drow0 + lane] = a * (1.0f / 127.0f);
#pragma unroll
        for (int q = 0; q < 4; ++q) { unsigned o[4];
#pragma unroll
            for (int d = 0; d < 4; ++d) { unsigned wd = 0u;
#pragma unroll
                for (int e = 0; e < 4; ++e) { const int k = k0 + 16 * q + 4 * d + e; const int qi = (int)__builtin_rintf(S[k * 32 + (n ^ (k & 31))] * inv); wd |= (unsigned)(qi & 255) << (8 * e); }
                o[d] = wd; }
            v4u ov; ov.x = o[0]; ov.y = o[1]; ov.z = o[2]; ov.w = o[3]; *(v4u*)(W8 + (size_t)(drow0 + n) * D + k0 + 16 * q) = ov; }
        __syncthreads();
    }
}

__device__ __forceinline__ void phase_conv(const Ctx& C, CPtrs& P) {
    unsigned char* ws = P.ws; const bf16_t* BB = (const bf16_t*)(ws + WS_BB); const bf16_t* UB = (const bf16_t*)(ws + WS_UB); bf16_t* ZB = (bf16_t*)(ws + WS_ZB);
    const float* cw = P.in[14]; const float* st = P.in[4];
    const int gw = C.vcu * NWAVES + C.wave, NGW = C.G * NWAVES, lane = C.lane;
    for (int row = gw; row < T; row += NGW) {
        int have1, have2; const float* s1 = nullptr; const float* s2 = nullptr;
        if (row < TP) { const int t = row & (SEQ - 1); have1 = t >= 1; have2 = t >= 2; }
        else { const int r = row - TP, i = r & 3, b = r >> 2; have1 = i >= 1; have2 = i >= 2;
            if (!have1) s1 = st + (size_t)(b * 2 + 1) * D; if (!have2) s2 = st + (size_t)(b * 2 + i) * D; }
        v4u rb[2], r0[2], r1[2], r2[2];
#pragma unroll
        for (int j = 0; j < 2; ++j) { const int ch = 8 * lane + 512 * j; rb[j] = *(const v4u*)(BB + (size_t)row * D + ch); r0[j] = *(const v4u*)(UB + (size_t)row * D + ch);
            r1[j] = have1 ? *(const v4u*)(UB + (size_t)(row - 1) * D + ch) : (v4u){0u, 0u, 0u, 0u}; r2[j] = have2 ? *(const v4u*)(UB + (size_t)(row - 2) * D + ch) : (v4u){0u, 0u, 0u, 0u}; }
#pragma unroll
        for (int j = 0; j < 2; ++j) {
            const int ch = 8 * lane + 512 * j;
            float b8[8], u0[8], u1[8], u2[8], z[8];
            unpack8f(rb[j], b8); unpack8f(r0[j], u0); unpack8f(r1[j], u1); unpack8f(r2[j], u2);
            if (!have1 && s1) { const f32x4 a = *(const f32x4*)(s1 + ch), b = *(const f32x4*)(s1 + ch + 4); u1[0] = a.x; u1[1] = a.y; u1[2] = a.z; u1[3] = a.w; u1[4] = b.x; u1[5] = b.y; u1[6] = b.z; u1[7] = b.w; }
            if (!have2 && s2) { const f32x4 a = *(const f32x4*)(s2 + ch), b = *(const f32x4*)(s2 + ch + 4); u2[0] = a.x; u2[1] = a.y; u2[2] = a.z; u2[3] = a.w; u2[4] = b.x; u2[5] = b.y; u2[6] = b.z; u2[7] = b.w; }
#pragma unroll
            for (int e = 0; e < 8; ++e) z[e] = b8[e] * (cw[ch + e] * u2[e] + cw[D + ch + e] * u1[e] + cw[2 * D + ch + e] * u0[e]);
            *(v4u*)(ZB + (size_t)row * D + ch) = pack8f(z);
        }
    }
}

__device__ __forceinline__ void phase_kvfin(const Ctx& C, CPtrs& P) {
    unsigned char* ws = P.ws; const float* ckv = (const float*)(ws + WS_CKV); const float* ctl = (const float*)(ws + WS_CTL);
    bf16_t* LATB = (bf16_t*)(ws + WS_LATB); bf16_t* KPEB = (bf16_t*)(ws + WS_KPEB); const f32x2* tab = (const f32x2*)(ws + WS_ROPE);
    int lane = C.lane; asm volatile("" : "+v"(lane));
    const int gw = C.vcu * NWAVES + C.wave, NGW = C.G * NWAVES;
    const f32x4 gl = *((const f32x4*)P.in[24] + lane); const float gk = P.in[25][lane];
    for (int row0 = gw; row0 < T; row0 += 2 * NGW) {
        const int nr = row0 + NGW < T ? 2 : 1;
        float sl_[2], sk_[2], xk[2]; f32x4 vl[2]; f32x2 cs[2]; int rowq[2], posq[2];
#pragma unroll
        for (int q = 0; q < 2; ++q) { const int row = row0 + (q < nr ? q * NGW : 0); rowq[q] = row; posq[q] = row < TP ? (row & (SEQ - 1)) : SEQ + ((row - TP) & 3);
            sl_[q] = ctl[F_SSQLAT + row]; sk_[q] = ctl[F_SSQKPE + row]; vl[q] = *((const f32x4*)(ckv + (size_t)row * CKVW) + lane); xk[q] = ckv[(size_t)row * CKVW + KVR + lane]; cs[q] = tab[posq[q] * 32 + (lane & 31)]; }
#pragma unroll
        for (int q = 0; q < 2; ++q) if (q < nr) { const int row = rowq[q];
            const float rl = rsq(sl_[q] * (1.0f / KVR) + EPS), rk = rsq(sk_[q] * (1.0f / ROPE) + EPS);
            const f32x4 v = vl[q] * rl * gl;
            float* ol = row < TP ? P.out + OUT_LATP + (size_t)row * KVR : P.out + OUT_LATS + (size_t)(row - TP) * KVR;
            *((f32x4*)ol + lane) = v;
            u32x2 w; w.x = cvt_pk_bf16(v.x, v.y); w.y = cvt_pk_bf16(v.z, v.w); *((u32x2*)(LATB + (size_t)row * KVR) + lane) = w;
            const float xn = xk[q] * rk * gk, pr = __shfl_xor(xn, 32);
            const float o = lane < 32 ? xn * cs[q].x - pr * cs[q].y : xn * cs[q].x + pr * cs[q].y;
            float* ok = row < TP ? P.out + OUT_KPEP + (size_t)row * ROPE : P.out + OUT_KPES + (size_t)(row - TP) * ROPE;
            ok[lane] = o;
            const float on = __shfl_xor(o, 1);
            if ((lane & 1) == 0) *(unsigned*)(KPEB + (size_t)row * ROPE + lane) = cvt_pk_bf16(o, on); }
    }
}

__device__ __forceinline__ void phase_qkfin(const Ctx& C, CPtrs& P) {
    unsigned char* ws = P.ws; const float* ctl = (const float*)(ws + WS_CTL); bf16_t* QB = (bf16_t*)(ws + WS_QB); bf16_t* KN = (bf16_t*)(ws + WS_KN);
    const float* RPT = (const float*)(ws + WS_RPT); const f32x2* tab = (const f32x2*)(ws + WS_ROPE);
    const float* gqn = P.in[19]; const float* gqp = P.in[20]; const float* gkn = P.in[28];
    int lane = C.lane; asm volatile("" : "+v"(lane));
    const int gw = C.vcu * NWAVES + C.wave, NGW = C.G * NWAVES;
    for (int row0 = gw; row0 < TP; row0 += 2 * NGW) {
        bf16_t* pk[2][2]; v4u vk[2][2]; float rk[2][2]; const int nr = row0 + NGW < TP ? 2 : 1;
#pragma unroll
        for (int q = 0; q < 2; ++q) { const int row = row0 + (q < nr ? q * NGW : 0);
#pragma unroll
            for (int it = 0; it < 2; ++it) { const int ci = lane + 64 * it, hk = ci >> 4, ck = ci & 15; pk[q][it] = KN + (size_t)row * D + 128 * hk + 8 * ck; vk[q][it] = *(const v4u*)pk[q][it];
                rk[q][it] = RPT[(size_t)(2 * hk) * T + row] + RPT[(size_t)(2 * hk + 1) * T + row]; } }
#pragma unroll
        for (int q = 0; q < 2; ++q) if (q < nr) {
#pragma unroll
            for (int jj = 0; jj < 2; ++jj) { const int c = (lane + 64 * jj) & 15; const float rs = rsq(rk[q][jj] * (1.0f / 128) + EPS); float x[8]; unpack8f(vk[q][jj], x);
#pragma unroll
                for (int e = 0; e < 8; ++e) x[e] = x[e] * rs * gkn[8 * c + e];
                *(v4u*)pk[q][jj] = pack8f(x); } }
    }
    { float* RTS = (float*)(ws + WS_RTS);
      for (int i = C.vcu * (NWAVES * 64) + C.tid; i < TS * NH; i += C.G * (NWAVES * 64)) { const int rsi = i >> 3, h = i & 7; const size_t rw = (size_t)TP + rsi;
          RTS[i] = rsq((RPT[(size_t)(2 * h) * T + rw] + RPT[(size_t)(2 * h + 1) * T + rw]) * (1.0f / 128) + EPS); } }
    {
        LAS float* A = (LAS float*)(C.lds + RING_OFF + C.wave * 1024);
        const bf16_t* WUK = (const bf16_t*)(ws + WS_WUKV); bf16_t* QS = (bf16_t*)(ws + WS_QS);
        for (int item = gw; item < TS * NH; item += NGW) {
            const int rsi = item >> 3, h = item & 7, row = TP + rsi;
            const float* sq = ctl + F_SSQQ + row;
            { const unsigned w = *(const unsigned*)(QB + (size_t)row * NQ + HD * h + 2 * lane); const float rs = rsq(sq[(size_t)(2 * h) * T] * (1.0f / 128) + EPS);
              A[2 * lane] = bflo(w) * rs * gqn[2 * lane] * gkn[2 * lane]; A[2 * lane + 1] = bfhi(w) * rs * gqn[2 * lane + 1] * gkn[2 * lane + 1]; }
            { const float x = bf2f(QB[(size_t)row * NQ + HD * h + 128 + lane]) * rsq(sq[(size_t)(2 * h + 1) * T] * (1.0f / 64) + EPS) * gqp[lane], pr = __shfl_xor(x, 32);
              const f32x2 cs = tab[(SEQ + (rsi & 3)) * 32 + (lane & 31)];
              const float o = (lane < 32 ? x * cs.x - pr * cs.y : x * cs.x + pr * cs.y) * QSCALE, on = __shfl_xor(o, 1);
              if ((lane & 1) == 0) *(unsigned*)(QS + (size_t)item * 320 + 256 + lane) = cvt_pk_bf16(o, on); }
            LDS_WAIT(); asm volatile("" ::: "memory");
            float acc[4] = {0.f, 0.f, 0.f, 0.f};
#pragma unroll 32
            for (int d = 0; d < 128; ++d) { const u32x2 w = *(const u32x2*)(WUK + (size_t)uk_row(h, d) * KVR + 4 * lane); const float ad = A[d];
                acc[0] += bflo(w.x) * ad; acc[1] += bfhi(w.x) * ad; acc[2] += bflo(w.y) * ad; acc[3] += bfhi(w.y) * ad; }
            u32x2 o; o.x = cvt_pk_bf16(acc[0] * QSCALE, acc[1] * QSCALE); o.y = cvt_pk_bf16(acc[2] * QSCALE, acc[3] * QSCALE);
            *(u32x2*)(QS + (size_t)item * 320 + 4 * lane) = o;
            LDS_WAIT(); asm volatile("" ::: "memory");
        }
    }
}

__device__ __forceinline__ void phase_scomb(const Ctx& C, CPtrs& P) {
    unsigned char* ws = P.ws; const float* PO = (const float*)(ws + WS_PO); const float* PML = (const float*)(ws + WS_PML); bf16_t* OB = (bf16_t*)(ws + WS_OB);
    const float* wuv = P.in[27];
    const int gw = C.vcu * NWAVES + C.wave, NGW = C.G * NWAVES, lane = C.lane;
    LAS float* OL = (LAS float*)(C.lds + RING_OFF + C.wave * 1024);
    for (int item = gw; item < TS * NH; item += NGW) {
        const int rsi = item >> 3, h = item & 7, b = rsi >> 2, q = rsi & 3, rho = q * 8 + h;
        const size_t i0 = (size_t)(b * 2 + 0) * 32 + rho, i1 = (size_t)(b * 2 + 1) * 32 + rho;
        const float m0 = PML[i0 * 2], l0 = PML[i0 * 2 + 1], m1 = PML[i1 * 2], l1 = PML[i1 * 2 + 1];
        const float mm = fmaxf(m0, m1), f0 = __builtin_amdgcn_exp2f(m0 - mm), f1 = __builtin_amdgcn_exp2f(m1 - mm), inv = 1.0f / (l0 * f0 + l1 * f1);
        { const f32x4 a = *((const f32x4*)(PO + i0 * 256) + lane), c = *((const f32x4*)(PO + i1 * 256) + lane); *((LAS f32x4*)OL + lane) = (a * f0 + c * f1) * inv; }
        LDS_WAIT(); asm volatile("" ::: "memory");
        float a0 = 0.f, a1 = 0.f; const float* wp = wuv + 128 * h + 2 * lane;
#pragma unroll 32
        for (int n = 0; n < KVR; ++n) { const f32x2 w = *(const f32x2*)(wp + (size_t)n * D); const float on = OL[n]; a0 += on * w.x; a1 += on * w.y; }
        *(unsigned*)(OB + (size_t)(TP + rsi) * D + 128 * h + 2 * lane) = cvt_pk_bf16(a0, a1);
        LDS_WAIT(); asm volatile("" ::: "memory");
    }
}

namespace att {
typedef short bf16x8 __attribute__((ext_vector_type(8)));
typedef short s16x4 __attribute__((ext_vector_type(4)));
typedef float f32x16 __attribute__((ext_vector_type(16)));
typedef float f32x4 __attribute__((ext_vector_type(4)));
typedef unsigned u32x4 __attribute__((ext_vector_type(4)));
constexpr float THR = 11.5f;
#define SBAR() __builtin_amdgcn_sched_barrier(0)
__device__ __forceinline__ int crow(int r, int hi) { return (r & 3) + 8 * (r >> 2) + 4 * hi; }
__device__ __forceinline__ unsigned cvtpk(float lo, float hi) { unsigned r; asm volatile("v_cvt_pk_bf16_f32 %0, %1, %2" : "=v"(r) : "v"(lo), "v"(hi)); return r; }
__device__ __forceinline__ float xmax32(float v) { auto rr = __builtin_amdgcn_permlane32_swap(__float_as_uint(v), __float_as_uint(v), false, false); return fmaxf(__uint_as_float(rr[0]), __uint_as_float(rr[1])); }
__device__ __forceinline__ float xsum32(float v) { auto rr = __builtin_amdgcn_permlane32_swap(__float_as_uint(v), __float_as_uint(v), false, false); return __uint_as_float(rr[0]) + __uint_as_float(rr[1]); }
#define PK4(P, B_, OUT) do { unsigned a0 = cvtpk(P[B_+0], P[B_+1]), a1 = cvtpk(P[B_+2], P[B_+3]);                          \
        unsigned b0 = cvtpk(P[B_+4], P[B_+5]), b1 = cvtpk(P[B_+6], P[B_+7]);                                             \
        auto r0 = __builtin_amdgcn_permlane32_swap(a0, b0, false, false); auto r1 = __builtin_amdgcn_permlane32_swap(a1, b1, false, false); \
        u32x4 w = {r0[0], r1[0], r0[1], r1[1]}; OUT = *reinterpret_cast<bf16x8*>(&w); } while (0)

namespace pa {
constexpr int KVBLK = 64, QBLK = 32, QB = 256;
constexpr int SHM_V = 16384, SHM_K = 16384, SHM_R = 8192;
constexpr int OFF_V = 0, OFF_K = 2 * SHM_V, OFF_R = OFF_K + 2 * SHM_K, OFF_WS = OFF_R + 2 * SHM_R;
#define KSWZ(row, colB) ((row) * 256 + ((colB) ^ (((row) & 7) << 4)))
__device__ __forceinline__ int v_st(int k, int c) { const int kk = (k & ~0xC) | ((k & 4) << 1) | ((k & 8) >> 1); return ((kk >> 3) * 4 + (c >> 5)) * 512 + ((kk & 7) * 32 + (c & 31)) * 2; }
__device__ __forceinline__ int v_rd_base(int lane) { return ((lane & 3) << 3) | (((lane >> 2) & 3) << 6) | (((lane >> 4) & 1) << 5) | (((lane >> 5) & 1) << 8); }
constexpr int v_rd_off(int d0, int ks, int half) { return d0 * 512 + ks * 4096 + half * 2048; }
__device__ __forceinline__ void mask_tile(f32x16& p0, f32x16& p1, int dq) {
    const float NEG = -__builtin_inff();
#pragma unroll
    for (int r = 0; r < 16; ++r) { const int c = (r & 3) + 8 * (r >> 2); if (dq - c < 0) p0[r] = NEG; if (dq - c - 32 < 0) p1[r] = NEG; }
}
__device__ __forceinline__ void softmax_tile(f32x16& p0, f32x16& p1, float& m_reg, float& l_reg, float& alpha, bf16x8& pa0, bf16x8& pa1, bf16x8& pa2, bf16x8& pa3) {
    float pmax = p0[0];
#pragma unroll
    for (int r = 1; r < 16; ++r) pmax = fmaxf(pmax, p0[r]);
#pragma unroll
    for (int r = 0; r < 16; ++r) pmax = fmaxf(pmax, p1[r]);
    pmax = xmax32(pmax);
    float mn;
    if (__builtin_expect(__all((pmax - m_reg) <= THR), 1)) { mn = m_reg; alpha = 1.f; }
    else { mn = fmaxf(m_reg, pmax); alpha = __builtin_amdgcn_exp2f(m_reg - mn); m_reg = mn; }
#pragma unroll
    for (int r = 0; r < 16; ++r) { p0[r] = __builtin_amdgcn_exp2f(p0[r] - mn); p1[r] = __builtin_amdgcn_exp2f(p1[r] - mn); }
    float ps = 0.f;
#pragma unroll
    for (int r = 0; r < 16; ++r) ps += p0[r];
#pragma unroll
    for (int r = 0; r < 16; ++r) ps += p1[r];
    ps = xsum32(ps);
    l_reg = l_reg * alpha + ps;
    PK4(p0, 0, pa0); PK4(p0, 8, pa1); PK4(p1, 0, pa2); PK4(p1, 8, pa3);
}
template <int KB>
__device__ __forceinline__ void qkt(f32x16& p0, f32x16& p1, const char* lds, int r32, int hi, const bf16x8* qr) {
    p0 = f32x16{}; p1 = f32x16{};
    const char* kb[4];
#pragma unroll
    for (int dd = 0; dd < 4; ++dd) kb[dd] = lds + OFF_K + KB * SHM_K + KSWZ(r32, (dd * 16 + hi * 8) * 2);
#pragma unroll
    for (int d0 = 0; d0 < 8; ++d0) { const char* a = kb[d0 & 3] + (d0 >> 2) * 128;
        const bf16x8 b0 = *reinterpret_cast<const bf16x8*>(a), b1 = *reinterpret_cast<const bf16x8*>(a + 32 * 256);
        p0 = __builtin_amdgcn_mfma_f32_32x32x16_bf16(b0, qr[d0], p0, 0, 0, 0);
        p1 = __builtin_amdgcn_mfma_f32_32x32x16_bf16(b1, qr[d0], p1, 0, 0, 0); }
    const int sw = (r32 >> 1) & 7; const char* rb = lds + OFF_R + KB * SHM_R + r32 * 128;
#pragma unroll
    for (int s = 0; s < 4; ++s) { const char* a = rb + (((2 * s + hi) ^ sw) << 4);
        const bf16x8 b0 = *reinterpret_cast<const bf16x8*>(a), b1 = *reinterpret_cast<const bf16x8*>(a + 32 * 128);
        p0 = __builtin_amdgcn_mfma_f32_32x32x16_bf16(b0, qr[8 + s], p0, 0, 0, 0);
        p1 = __builtin_amdgcn_mfma_f32_32x32x16_bf16(b1, qr[8 + s], p1, 0, 0, 0); }
}
template <int VB>
__device__ __forceinline__ void pv_tile(f32x16* o, int vb0, bf16x8 pa0, bf16x8 pa1, bf16x8 pa2, bf16x8 pa3) {
#define TRRD(dst, off) asm volatile("ds_read_b64_tr_b16 %0, %1 offset:%2" : "=&v"(dst) : "v"(vb0), "i"(off) : "memory")
#define PV_KS(ks, PA) do { s16x4 l0, l1, l2, l3, h0, h1, h2, h3; constexpr int b_ = OFF_V + VB * SHM_V + v_rd_off(0, ks, 0);   \
        TRRD(l0, b_); TRRD(h0, b_ + 2048); TRRD(l1, b_ + 512); TRRD(h1, b_ + 512 + 2048); TRRD(l2, b_ + 1024); TRRD(h2, b_ + 1024 + 2048); TRRD(l3, b_ + 1536); TRRD(h3, b_ + 1536 + 2048); \
        asm volatile("s_waitcnt lgkmcnt(0)" ::: "memory"); SBAR();   \
        o[0] = __builtin_amdgcn_mfma_f32_32x32x16_bf16(PA, (bf16x8){l0[0], l0[1], l0[2], l0[3], h0[0], h0[1], h0[2], h0[3]}, o[0], 0, 0, 0);   \
        o[1] = __builtin_amdgcn_mfma_f32_32x32x16_bf16(PA, (bf16x8){l1[0], l1[1], l1[2], l1[3], h1[0], h1[1], h1[2], h1[3]}, o[1], 0, 0, 0);   \
        o[2] = __builtin_amdgcn_mfma_f32_32x32x16_bf16(PA, (bf16x8){l2[0], l2[1], l2[2], l2[3], h2[0], h2[1], h2[2], h2[3]}, o[2], 0, 0, 0);   \
        o[3] = __builtin_amdgcn_mfma_f32_32x32x16_bf16(PA, (bf16x8){l3[0], l3[1], l3[2], l3[3], h3[0], h3[1], h3[2], h3[3]}, o[3], 0, 0, 0); } while (0)
    PV_KS(0, pa0); PV_KS(1, pa1); PV_KS(2, pa2); PV_KS(3, pa3);
#undef PV_KS
#undef TRRD
}
__device__ __forceinline__ void unit(int b, int h, int qb, const bf16_t* __restrict__ QF, const bf16_t* __restrict__ KN, const bf16_t* __restrict__ KPE, const bf16_t* __restrict__ VBg, bf16_t* OB, char* lds) {
    const int tid = threadIdx.x, wid = __builtin_amdgcn_readfirstlane(tid >> 6), lane = tid & 63, r32 = lane & 31, hi = lane >> 5;
    const size_t rowb = (size_t)b * SEQ; const int q0 = qb * QB, qlo = q0 + wid * QBLK, qm = qlo + r32 - 4 * hi;
    const int NT = (q0 + QB) / KVBLK;
    float* wsf = (float*)(lds + OFF_WS) + wid * 64; float* li_l = wsf; float* al_l = wsf + 32;
    bf16x8 qr[12];
    { const bf16_t* qp = QF + (rowb + qlo + r32) * NQ + HD * h + hi * 8;
#pragma unroll
      for (int d0 = 0; d0 < 12; ++d0) qr[d0] = *reinterpret_cast<const bf16x8*>(qp + d0 * 16); }
    const int sr = tid >> 4, sc = (tid & 15) * 8, rr = tid >> 3, rc = tid & 7;
    const int kws = KSWZ(sr, sc * 2), vst0 = v_st(sr, sc), vst1 = v_st(32 + sr, sc), rws = rr * 128 + ((rc ^ ((rr >> 1) & 7)) << 4);
    const bf16_t* Kg = KN + (rowb + sr) * D + 128 * h + sc; const bf16_t* Vg = VBg + (rowb + sr) * D + 128 * h + sc; const bf16_t* Rg = KPE + (rowb + rr) * ROPE + rc * 8;
    bf16x8 st_k0, st_k1, st_v0, st_v1, st_r;
#define SLOAD(t) do { const size_t ko = (size_t)(t) * KVBLK * D; st_k0 = *reinterpret_cast<const bf16x8*>(Kg + ko); st_k1 = *reinterpret_cast<const bf16x8*>(Kg + ko + 32 * D); \
        st_v0 = *reinterpret_cast<const bf16x8*>(Vg + ko); st_v1 = *reinterpret_cast<const bf16x8*>(Vg + ko + 32 * D); st_r = *reinterpret_cast<const bf16x8*>(Rg + (size_t)(t) * KVBLK * ROPE); } while (0)
#define SWRITE(bf) do { *(bf16x8*)(lds + OFF_K + (bf) * SHM_K + kws) = st_k0; *(bf16x8*)(lds + OFF_K + (bf) * SHM_K + kws + 32 * 256) = st_k1; \
        *(bf16x8*)(lds + OFF_V + (bf) * SHM_V + vst0) = st_v0; *(bf16x8*)(lds + OFF_V + (bf) * SHM_V + vst1) = st_v1; *(bf16x8*)(lds + OFF_R + (bf) * SHM_R + rws) = st_r; } while (0)
    const int vb0 = (int)(uintptr_t)lds + v_rd_base(lane);
    float m_reg = -1e30f, l_reg = 0.f, alpha; f32x16 o[4] = {}; f32x16 p0, p1; bf16x8 pa0, pa1, pa2, pa3;
    SLOAD(0); SWRITE(0); __syncthreads();
#define STEP(t, CB) do { if ((t) + 1 < NT) SLOAD((t) + 1); SBAR();                                                            \
        qkt<CB>(p0, p1, lds, r32, hi, qr);                                                                                    \
        if (KVBLK * (t) + KVBLK - 1 > qlo) mask_tile(p0, p1, qm - KVBLK * (t));                                               \
        softmax_tile(p0, p1, m_reg, l_reg, alpha, pa0, pa1, pa2, pa3);                                                        \
        if (__any(alpha < 1.f)) { if (hi == 0) al_l[r32] = alpha; asm volatile("s_waitcnt lgkmcnt(0)" ::: "memory");         \
            _Pragma("unroll") for (int d_ = 0; d_ < 4; ++d_) _Pragma("unroll") for (int r = 0; r < 16; ++r) o[d_][r] *= al_l[crow(r, hi)]; } \
        SBAR(); pv_tile<CB>(o, vb0, pa0, pa1, pa2, pa3);                                                                      \
        if ((t) + 1 < NT) SWRITE(1 - (CB));                                                                                   \
        __syncthreads(); } while (0)
    for (int t = 0; t < NT; t += 2) { STEP(t, 0); STEP(t + 1, 1); }
#undef STEP
#undef SLOAD
#undef SWRITE
    if (hi == 0) li_l[r32] = l_reg; asm volatile("s_waitcnt lgkmcnt(0)" ::: "memory");
    float rli[16];
#pragma unroll
    for (int r = 0; r < 16; ++r) rli[r] = __builtin_amdgcn_rcpf(li_l[crow(r, hi)]);
    bf16_t* Ow = OB + (rowb + qlo) * D + 128 * h;
#pragma unroll
    for (int r = 0; r < 16; ++r) { const int orow = crow(r, hi);
#pragma unroll
        for (int d0 = 0; d0 < 4; ++d0) { const float v = o[d0][r] * rli[r]; const float vn = __shfl_xor(v, 1);
            if ((r32 & 1) == 0) *(unsigned*)(Ow + (size_t)orow * D + d0 * 32 + r32) = cvtpk(v, vn); } }
    __syncthreads();
}
constexpr int S4_R2 = 131584, S4_WS = S4_R2 + SHM_R;
static_assert(S4_WS + 2048 <= 155648, "lds");
constexpr int R3_V = 0, R3_K = 3 * SHM_V, R3_R = R3_K + 3 * SHM_K, R3_WS = R3_R + 3 * SHM_R;
__device__ __forceinline__ void qkt_rt(f32x16& p0, f32x16& p1, const char* lds, int kofs, int rofs, int r32, int hi, const bf16x8* qr) {
    p0 = f32x16{}; p1 = f32x16{};
    const char* kb[4];
#pragma unroll
    for (int dd = 0; dd < 4; ++dd) kb[dd] = lds + R3_K + kofs + KSWZ(r32, (dd * 16 + hi * 8) * 2);
#pragma unroll
    for (int d0 = 0; d0 < 8; ++d0) { const char* a = kb[d0 & 3] + (d0 >> 2) * 128;
        const bf16x8 b0 = *reinterpret_cast<const bf16x8*>(a), b1 = *reinterpret_cast<const bf16x8*>(a + 32 * 256);
        p0 = __builtin_amdgcn_mfma_f32_32x32x16_bf16(b0, qr[d0], p0, 0, 0, 0);
        p1 = __builtin_amdgcn_mfma_f32_32x32x16_bf16(b1, qr[d0], p1, 0, 0, 0); }
    const int sw = (r32 >> 1) & 7; const char* rb = lds + R3_R + rofs + r32 * 128;
#pragma unroll
    for (int s = 0; s < 4; ++s) { const char* a = rb + (((2 * s + hi) ^ sw) << 4);
        const bf16x8 b0 = *reinterpret_cast<const bf16x8*>(a), b1 = *reinterpret_cast<const bf16x8*>(a + 32 * 128);
        p0 = __builtin_amdgcn_mfma_f32_32x32x16_bf16(b0, qr[8 + s], p0, 0, 0, 0);
        p1 = __builtin_amdgcn_mfma_f32_32x32x16_bf16(b1, qr[8 + s], p1, 0, 0, 0); }
}
__device__ __forceinline__ void pv_rt(f32x16* o, int vb, bf16x8 pa0, bf16x8 pa1, bf16x8 pa2, bf16x8 pa3) {
#define TRRD(dst, off) asm volatile("ds_read_b64_tr_b16 %0, %1 offset:%2" : "=&v"(dst) : "v"(vb), "i"(off) : "memory")
#define PV_KS(ks, PA) do { s16x4 l0, l1, l2, l3, h0, h1, h2, h3; constexpr int b_ = R3_V + v_rd_off(0, ks, 0);   \
        TRRD(l0, b_); TRRD(h0, b_ + 2048); TRRD(l1, b_ + 512); TRRD(h1, b_ + 512 + 2048); TRRD(l2, b_ + 1024); TRRD(h2, b_ + 1024 + 2048); TRRD(l3, b_ + 1536); TRRD(h3, b_ + 1536 + 2048); \
        asm volatile("s_waitcnt lgkmcnt(0)" ::: "memory"); SBAR();   \
        o[0] = __builtin_amdgcn_mfma_f32_32x32x16_bf16(PA, (bf16x8){l0[0], l0[1], l0[2], l0[3], h0[0], h0[1], h0[2], h0[3]}, o[0], 0, 0, 0);   \
        o[1] = __builtin_amdgcn_mfma_f32_32x32x16_bf16(PA, (bf16x8){l1[0], l1[1], l1[2], l1[3], h1[0], h1[1], h1[2], h1[3]}, o[1], 0, 0, 0);   \
        o[2] = __builtin_amdgcn_mfma_f32_32x32x16_bf16(PA, (bf16x8){l2[0], l2[1], l2[2], l2[3], h2[0], h2[1], h2[2], h2[3]}, o[2], 0, 0, 0);   \
        o[3] = __builtin_amdgcn_mfma_f32_32x32x16_bf16(PA, (bf16x8){l3[0], l3[1], l3[2], l3[3], h3[0], h3[1], h3[2], h3[3]}, o[3], 0, 0, 0); } while (0)
    PV_KS(0, pa0); PV_KS(1, pa1); PV_KS(2, pa2); PV_KS(3, pa3);
#undef PV_KS
#undef TRRD
}
#ifndef PA_PF
#define PA_PF 5
#endif
__device__ __forceinline__ void qkt_pf(f32x16& p0, f32x16& p1, const char* lds, int kofs, int rofs, int r32, int hi, const bf16x8* qr) {
    p0 = f32x16{}; p1 = f32x16{};
    const char* kb[4];
#pragma unroll
    for (int dd = 0; dd < 4; ++dd) kb[dd] = lds + R3_K + kofs + KSWZ(r32, (dd * 16 + hi * 8) * 2);
    const int sw = (r32 >> 1) & 7; const char* rb = lds + R3_R + rofs + r32 * 128;
    bf16x8 f0[12], f1[12];
#define QK_LD(d) do { if ((d) < 8) { const char* a = kb[(d) & 3] + ((d) >> 2) * 128; f0[d] = *reinterpret_cast<const bf16x8*>(a); f1[d] = *reinterpret_cast<const bf16x8*>(a + 32 * 256); } \
                      else { const char* a = rb + (((2 * ((d) - 8) + hi) ^ sw) << 4); f0[d] = *reinterpret_cast<const bf16x8*>(a); f1[d] = *reinterpret_cast<const bf16x8*>(a + 32 * 128); } } while (0)
#pragma unroll
    for (int d = 0; d < PA_PF; ++d) QK_LD(d);
#pragma unroll
    for (int d = 0; d < 12; ++d) {
        if (d + PA_PF < 12) QK_LD(d + PA_PF);
        SBAR();
        p0 = __builtin_amdgcn_mfma_f32_32x32x16_bf16(f0[d], qr[d], p0, 0, 0, 0);
        p1 = __builtin_amdgcn_mfma_f32_32x32x16_bf16(f1[d], qr[d], p1, 0, 0, 0);
        SBAR(); }
#undef QK_LD
}
#define TRRD(dst, off) asm volatile("ds_read_b64_tr_b16 %0, %1 offset:%2" : "=&v"(dst) : "v"(vb_), "i"(off) : "memory")
#define PV_RD(ks, S) do { constexpr int b_ = R3_V + v_rd_off(0, ks, 0);   \
        TRRD(S[0], b_); TRRD(S[4], b_ + 2048); TRRD(S[1], b_ + 512); TRRD(S[5], b_ + 512 + 2048); TRRD(S[2], b_ + 1024); TRRD(S[6], b_ + 1024 + 2048); TRRD(S[3], b_ + 1536); TRRD(S[7], b_ + 1536 + 2048); } while (0)
#define PV_MM(PA, S) do { \
        o[0] = __builtin_amdgcn_mfma_f32_32x32x16_bf16(PA, (bf16x8){S[0][0], S[0][1], S[0][2], S[0][3], S[4][0], S[4][1], S[4][2], S[4][3]}, o[0], 0, 0, 0);   \
        o[1] = __builtin_amdgcn_mfma_f32_32x32x16_bf16(PA, (bf16x8){S[1][0], S[1][1], S[1][2], S[1][3], S[5][0], S[5][1], S[5][2], S[5][3]}, o[1], 0, 0, 0);   \
        o[2] = __builtin_amdgcn_mfma_f32_32x32x16_bf16(PA, (bf16x8){S[2][0], S[2][1], S[2][2], S[2][3], S[6][0], S[6][1], S[6][2], S[6][3]}, o[2], 0, 0, 0);   \
        o[3] = __builtin_amdgcn_mfma_f32_32x32x16_bf16(PA, (bf16x8){S[3][0], S[3][1], S[3][2], S[3][3], S[7][0], S[7][1], S[7][2], S[7][3]}, o[3], 0, 0, 0); } while (0)
#define PV_EARLY(VA, VB_) do { PV_RD(0, VA); PV_RD(1, VB_); } while (0)
#define PV_REST(VA, VB_) do {                                                                     \
    asm volatile("s_waitcnt lgkmcnt(8)" ::: "memory"); SBAR(); PV_MM(pa0, VA); SBAR();            \
    PV_RD(2, VA);                                                                                 \
    asm volatile("s_waitcnt lgkmcnt(8)" ::: "memory"); SBAR(); PV_MM(pa1, VB_); SBAR();           \
    PV_RD(3, VB_);                                                                                \
    asm volatile("s_waitcnt lgkmcnt(8)" ::: "memory"); SBAR(); PV_MM(pa2, VA); SBAR();            \
    asm volatile("s_waitcnt lgkmcnt(0)" ::: "memory"); SBAR(); PV_MM(pa3, VB_); } while (0)
#ifndef PA_QK
#define PA_QK qkt_pf
#endif
struct QFix { const float* sq; const float* gqn; const float* gqp; const f32x2* tab; };
template <bool REV>
__device__ __forceinline__ void unit_dma(int b, int h, int qb, const bf16_t* __restrict__ QF, const bf16_t* __restrict__ KN, const bf16_t* __restrict__ KPE, const bf16_t* __restrict__ VBg, bf16_t* OB, char* lds, LAS unsigned char* ldsu, const QFix qf) {
    int tid = threadIdx.x; asm volatile("" : "+v"(tid));
    const int wid = __builtin_amdgcn_readfirstlane(tid >> 6), lane = tid & 63, r32 = lane & 31, hi = lane >> 5;
    const size_t rowb = (size_t)b * SEQ; const int q0 = qb * QB, qlo = q0 + wid * QBLK, qm = qlo + r32 - 4 * hi;
    const int NT = (q0 + QB) / KVBLK;
    float* wsf = (float*)(lds + R3_WS) + wid * 64; float* li_l = wsf; float* al_l = wsf + 32;
    bf16x8 qr[12];
    { const bf16_t* qp = QF + (rowb + qlo + r32) * NQ + HD * h + hi * 8;
#pragma unroll
      for (int d0 = 0; d0 < 12; ++d0) qr[d0] = *reinterpret_cast<const bf16x8*>(qp + d0 * 16); }
    { const int row = (int)rowb + qlo + r32, pos = qlo + r32; const float* sq = qf.sq + row;
      const float rsn = rsq(sq[(size_t)(2 * h) * T] * (1.0f / 128) + EPS) * QSCALE, rsr = rsq(sq[(size_t)(2 * h + 1) * T] * (1.0f / 64) + EPS);
#pragma unroll
      for (int d0 = 0; d0 < 8; ++d0) { float x[8]; unpack8f(__builtin_bit_cast(v4u, qr[d0]), x); const float* gp = qf.gqn + hi * 8 + d0 * 16;
#pragma unroll
          for (int e = 0; e < 8; ++e) x[e] = x[e] * rsn * gp[e];
          qr[d0] = __builtin_bit_cast(bf16x8, pack8f(x)); }
#pragma unroll
      for (int d0 = 8; d0 < 10; ++d0) { const int j0 = hi * 8 + (d0 - 8) * 16; float xa[8], xb[8], ya[8], yb[8]; unpack8f(__builtin_bit_cast(v4u, qr[d0]), xa); unpack8f(__builtin_bit_cast(v4u, qr[d0 + 2]), xb);
#pragma unroll
          for (int e = 0; e < 8; ++e) { const float a = xa[e] * rsr * qf.gqp[j0 + e], bb = xb[e] * rsr * qf.gqp[j0 + 32 + e]; const f32x2 cs = qf.tab[pos * 32 + j0 + e];
              ya[e] = (a * cs.x - bb * cs.y) * QSCALE; yb[e] = (bb * cs.x + a * cs.y) * QSCALE; }
          qr[d0] = __builtin_bit_cast(bf16x8, pack8f(ya)); qr[d0 + 2] = __builtin_bit_cast(bf16x8, pack8f(yb)); } }
    const char* Kb = (const char*)(KN + rowb * D + 128 * h); const char* Vb = (const char*)(VBg + rowb * D + 128 * h); const char* Rb = (const char*)(KPE + rowb * ROPE);
    unsigned kof[2], vof[2], rof;
#pragma unroll
    for (int pi = 0; pi < 2; ++pi) { const int p = 2 * wid + pi, rw = 4 * pi + (lane >> 4);
        kof[pi] = (unsigned)((4 * p + (lane >> 4)) * (D * 2) + 16 * ((lane & 15) ^ (rw & 7)));
        const int kk = 8 * (p >> 1) + ((lane & 31) >> 2), key = (kk & ~0xC) | ((kk & 4) << 1) | ((kk & 8) >> 1), col = 32 * (2 * (p & 1) + (lane >> 5)) + 8 * (lane & 3);
        vof[pi] = (unsigned)(key * (D * 2) + col * 2); }
    { const int row = 8 * wid + (lane >> 3); rof = (unsigned)(row * (ROPE * 2) + 16 * ((lane & 7) ^ ((row >> 1) & 7))); }
#define DMA_TILE(t, ks_, vs_, rs_) do { const size_t kb_ = (size_t)(t) * KVBLK * (D * 2);                                                                \
        _Pragma("unroll") for (int pi = 0; pi < 2; ++pi) { const int p = 2 * wid + pi;                                                                 \
            __builtin_amdgcn_global_load_lds((const unsigned*)(Kb + kb_ + kof[pi]), (LAS unsigned*)(ldsu + R3_K + (ks_) + p * 1024), 16, 0, 0);        \
            __builtin_amdgcn_global_load_lds((const unsigned*)(Vb + kb_ + vof[pi]), (LAS unsigned*)(ldsu + R3_V + (vs_) + p * 1024), 16, 0, 0); }      \
        __builtin_amdgcn_global_load_lds((const unsigned*)(Rb + (size_t)(t) * KVBLK * (ROPE * 2) + rof), (LAS unsigned*)(ldsu + R3_R + (rs_) + wid * 1024), 16, 0, 0); } while (0)
    const int vb0 = (int)(uintptr_t)lds + v_rd_base(lane);
    float m_reg = -1e30f, l_reg = 0.f, alpha; f32x16 o[4] = {}; f32x16 p0, p1; bf16x8 pa0, pa1, pa2, pa3;
#define TID_(i) (REV ? NT - 1 - (i) : (i))
    DMA_TILE(TID_(0), 0, 0, 0); DMA_TILE(TID_(1), SHM_K, SHM_V, SHM_R);
    asm volatile("s_waitcnt vmcnt(5)" ::: "memory"); __builtin_amdgcn_s_barrier(); asm volatile("" ::: "memory");
    int s_cur = 0, s_nxt = 1, s_nn = 2;
    for (int t = 0; t < NT; ++t) {
        int kofs = s_cur * SHM_K, rofs = s_cur * SHM_R, vofs = s_cur * SHM_V; asm volatile("" : "+v"(kofs), "+v"(rofs), "+v"(vofs));
        if (t + 2 < NT) DMA_TILE(TID_(t + 2), s_nn * SHM_K, s_nn * SHM_V, s_nn * SHM_R);
        PA_QK(p0, p1, lds, kofs, rofs, r32, hi, qr);
        s16x4 VA[8], VB_[8]; const int vb_ = vb0 + vofs; SBAR(); PV_EARLY(VA, VB_); SBAR();
        { const int tq = TID_(t); if (KVBLK * tq + KVBLK - 1 > qlo) mask_tile(p0, p1, qm - KVBLK * tq); }
        softmax_tile(p0, p1, m_reg, l_reg, alpha, pa0, pa1, pa2, pa3);
        if (__any(alpha < 1.f)) { if (hi == 0) al_l[r32] = alpha; asm volatile("s_waitcnt lgkmcnt(0)" ::: "memory");
#pragma unroll
            for (int d_ = 0; d_ < 4; ++d_)
#pragma unroll
                for (int r = 0; r < 16; ++r) o[d_][r] *= al_l[crow(r, hi)]; }
        SBAR(); PV_REST(VA, VB_);
        if (t + 2 < NT) asm volatile("s_waitcnt vmcnt(5) lgkmcnt(0)" ::: "memory"); else asm volatile("s_waitcnt vmcnt(0) lgkmcnt(0)" ::: "memory");
        __builtin_amdgcn_s_barrier(); asm volatile("" ::: "memory");
        const int tmp = s_cur; s_cur = s_nxt; s_nxt = s_nn; s_nn = tmp;
    }
#undef DMA_TILE
#undef TID_
    if (hi == 0) li_l[r32] = l_reg; asm volatile("s_waitcnt lgkmcnt(0)" ::: "memory");
    float rli[16];
#pragma unroll
    for (int r = 0; r < 16; ++r) rli[r] = __builtin_amdgcn_rcpf(li_l[crow(r, hi)]);
    bf16_t* Ow = OB + (rowb + qlo) * D + 128 * h;
#pragma unroll
    for (int r = 0; r < 16; ++r) { const int orow = crow(r, hi);
#pragma unroll
        for (int d0 = 0; d0 < 4; ++d0) { const float v = o[d0][r] * rli[r]; const float vn = __shfl_xor(v, 1);
            if ((r32 & 1) == 0) *(unsigned*)(Ow + (size_t)orow * D + d0 * 32 + r32) = cvtpk(v, vn); } }
    asm volatile("s_waitcnt vmcnt(0) lgkmcnt(0)" ::: "memory"); __builtin_amdgcn_s_barrier(); asm volatile("" ::: "memory");
}
__device__ __forceinline__ void unit_stg(int b, int h, int qb, const bf16_t* __restrict__ QF, const bf16_t* __restrict__ KN, const bf16_t* __restrict__ KPE, const bf16_t* __restrict__ VBg, bf16_t* OB, char* lds, LAS unsigned char* ldsu) {
    int tid = threadIdx.x; asm volatile("" : "+v"(tid));
    const int wid = __builtin_amdgcn_readfirstlane(tid >> 6), lane = tid & 63, r32 = lane & 31, hi = lane >> 5;
    const size_t rowb = (size_t)b * SEQ; const int q0 = qb * QB, qlo = q0 + wid * QBLK, qm = qlo + r32 - 4 * hi;
    const int NT = (q0 + QB) / KVBLK;
    float* wsf = (float*)(lds + S4_WS) + wid * 64; float* li_l = wsf; float* al_l = wsf + 32;
    bf16x8 qr[12];
    { const bf16_t* qp = QF + (rowb + qlo + r32) * NQ + HD * h + hi * 8;
#pragma unroll
      for (int d0 = 0; d0 < 12; ++d0) qr[d0] = *reinterpret_cast<const bf16x8*>(qp + d0 * 16); }
    const char* Kb = (const char*)(KN + rowb * D + 128 * h); const char* Vb = (const char*)(VBg + rowb * D + 128 * h); const char* Rb = (const char*)(KPE + rowb * ROPE);
    unsigned kof[2], vof[2], rof;
#pragma unroll
    for (int pi = 0; pi < 2; ++pi) { const int p = 2 * wid + pi, rw = 4 * pi + (lane >> 4);
        kof[pi] = (unsigned)((4 * p + (lane >> 4)) * (D * 2) + 16 * ((lane & 15) ^ (rw & 7)));
        const int kk = 8 * (p >> 1) + ((lane & 31) >> 2), key = (kk & ~0xC) | ((kk & 4) << 1) | ((kk & 8) >> 1), col = 32 * (2 * (p & 1) + (lane >> 5)) + 8 * (lane & 3);
        vof[pi] = (unsigned)(key * (D * 2) + col * 2); }
    { const int row = 8 * wid + (lane >> 3); rof = (unsigned)(row * (ROPE * 2) + 16 * ((lane & 7) ^ ((row >> 1) & 7))); }
#define DMA_TILE(t, ks_, vs_, rs_) do { const size_t kb_ = (size_t)(t) * KVBLK * (D * 2);                                                                \
        _Pragma("unroll") for (int pi = 0; pi < 2; ++pi) { const int p = 2 * wid + pi;                                                                 \
            __builtin_amdgcn_global_load_lds((const unsigned*)(Kb + kb_ + kof[pi]), (LAS unsigned*)(ldsu + R3_K + (ks_) + p * 1024), 16, 0, 0);        \
            __builtin_amdgcn_global_load_lds((const unsigned*)(Vb + kb_ + vof[pi]), (LAS unsigned*)(ldsu + R3_V + (vs_) + p * 1024), 16, 0, 0); }      \
        __builtin_amdgcn_global_load_lds((const unsigned*)(Rb + (size_t)(t) * KVBLK * (ROPE * 2) + rof), (LAS unsigned*)(ldsu + R3_R + (rs_) + wid * 1024), 16, 0, 0); } while (0)
    const int vb0 = (int)(uintptr_t)lds + v_rd_base(lane);
    float m_reg = -1e30f, l_reg = 0.f, alpha; f32x16 o[4] = {}; f32x16 p0, p1; bf16x8 pa0, pa1, pa2, pa3;
#define S4_KOFS(sl_) (16384 + (sl_) * SHM_K)
#define S4_ROFS(sl_) ((sl_) == 0 ? 16384 : (sl_) == 1 ? 24576 : (S4_R2 - R3_R))
    const bool grpB = wid >= 4;
    DMA_TILE(0, S4_KOFS(0), 0, S4_ROFS(0)); DMA_TILE(1, S4_KOFS(1), SHM_V, S4_ROFS(1));
    asm volatile("s_waitcnt vmcnt(5)" ::: "memory"); __builtin_amdgcn_s_barrier(); asm volatile("" ::: "memory");
    int s_cur = 0, s_nxt = 1, s_nn = 2;
#define STG_WAIT(t) do { if ((t) + 2 < NT) asm volatile("s_waitcnt vmcnt(5) lgkmcnt(0)" ::: "memory"); else asm volatile("s_waitcnt vmcnt(0) lgkmcnt(0)" ::: "memory");   \
        __builtin_amdgcn_s_barrier(); asm volatile("" ::: "memory"); { const int tmp = s_cur; s_cur = s_nxt; s_nxt = s_nn; s_nn = tmp; } } while (0)
#define STG_RESCALE() do { if (__any(alpha < 1.f)) { if (hi == 0) al_l[r32] = alpha; asm volatile("s_waitcnt lgkmcnt(0)" ::: "memory");                    \
            _Pragma("unroll") for (int d_ = 0; d_ < 4; ++d_) _Pragma("unroll") for (int r = 0; r < 16; ++r) o[d_][r] *= al_l[crow(r, hi)]; } } while (0)
    if (!grpB) {
        for (int t = 0; t < NT; ++t) {
            int kofs = S4_KOFS(s_cur), rofs = S4_ROFS(s_cur), vofs = (t & 3) * SHM_V; asm volatile("" : "+v"(kofs), "+v"(rofs), "+v"(vofs));
            if (t + 2 < NT) DMA_TILE(t + 2, S4_KOFS(s_nn), ((t + 2) & 3) * SHM_V, S4_ROFS(s_nn));
            PA_QK(p0, p1, lds, kofs, rofs, r32, hi, qr);
            s16x4 VA[8], VB_[8]; const int vb_ = vb0 + vofs; SBAR(); PV_EARLY(VA, VB_); SBAR();
            if (KVBLK * t + KVBLK - 1 > qlo) mask_tile(p0, p1, qm - KVBLK * t);
            softmax_tile(p0, p1, m_reg, l_reg, alpha, pa0, pa1, pa2, pa3);
            STG_RESCALE();
            SBAR(); PV_REST(VA, VB_);
            STG_WAIT(t);
        }
    } else {
        for (int t = 0; t < NT; ++t) {
            int kofs = S4_KOFS(s_cur), rofs = S4_ROFS(s_cur), vofs = ((t + 3) & 3) * SHM_V; asm volatile("" : "+v"(kofs), "+v"(rofs), "+v"(vofs));
            if (t + 2 < NT) DMA_TILE(t + 2, S4_KOFS(s_nn), ((t + 2) & 3) * SHM_V, S4_ROFS(s_nn));
            if (t > 0) { s16x4 VA[8], VB_[8]; const int vb_ = vb0 + vofs; SBAR(); PV_EARLY(VA, VB_); SBAR(); PV_REST(VA, VB_); SBAR(); }
            PA_QK(p0, p1, lds, kofs, rofs, r32, hi, qr);
            if (KVBLK * t + KVBLK - 1 > qlo) mask_tile(p0, p1, qm - KVBLK * t);
            softmax_tile(p0, p1, m_reg, l_reg, alpha, pa0, pa1, pa2, pa3);
            STG_RESCALE();
            STG_WAIT(t);
        }
        { const int vofs = ((NT + 3) & 3) * SHM_V; s16x4 VA[8], VB_[8]; const int vb_ = vb0 + vofs; SBAR(); PV_EARLY(VA, VB_); SBAR(); PV_REST(VA, VB_); SBAR(); }
    }
#undef STG_WAIT
#undef STG_RESCALE
#undef S4_KOFS
#undef S4_ROFS
#undef DMA_TILE
    if (hi == 0) li_l[r32] = l_reg; asm volatile("s_waitcnt lgkmcnt(0)" ::: "memory");
    float rli[16];
#pragma unroll
    for (int r = 0; r < 16; ++r) rli[r] = __builtin_amdgcn_rcpf(li_l[crow(r, hi)]);
    bf16_t* Ow = OB + (rowb + qlo) * D + 128 * h;
#pragma unroll
    for (int r = 0; r < 16; ++r) { const int orow = crow(r, hi);
#pragma unroll
        for (int d0 = 0; d0 < 4; ++d0) { const float v = o[d0][r] * rli[r]; const float vn = __shfl_xor(v, 1);
            if ((r32 & 1) == 0) *(unsigned*)(Ow + (size_t)orow * D + d0 * 32 + r32) = cvtpk(v, vn); } }
    asm volatile("s_waitcnt vmcnt(0) lgkmcnt(0)" ::: "memory"); __builtin_amdgcn_s_barrier(); asm volatile("" ::: "memory");
}
}

namespace sa {
constexpr int TILE = 16384;
struct Src { const bf16_t* CLB; const float* CKF; const int* PT; const float* RP; const bf16_t* LATB; const bf16_t* KPEB; const float* RTS; const unsigned char* CL8; const float* SC2; };
#ifndef SA_INT8
#define SA_INT8 1
#endif
__device__ __forceinline__ int offa(int row, int ch) { return 2048 * (row >> 3) + 512 * (ch >> 2) + 64 * (row & 7) + 16 * ((ch & 3) ^ ((row >> 2) & 3)); }
__device__ __forceinline__ v4u widen8(u32x2 w) {
    const unsigned x0 = w.x ^ 0x80808080u, x1 = w.y ^ 0x80808080u; v4u o;
    o.x = cvt_pk_bf16((float)(x0 & 255u), (float)((x0 >> 8) & 255u)); o.y = cvt_pk_bf16((float)((x0 >> 16) & 255u), (float)(x0 >> 24));
    o.z = cvt_pk_bf16((float)(x1 & 255u), (float)((x1 >> 8) & 255u)); o.w = cvt_pk_bf16((float)((x1 >> 16) & 255u), (float)(x1 >> 24)); return o;
}
template <bool TAIL, bool Q8 = false>
__device__ __forceinline__ void tile(const Src& S, int b, int k0, LAS unsigned char* ldsu, char* lds, int wid, int lane, f32x16 (&o)[8], float& m_reg, float& l_reg, float* al_l, int tbase, float& lb, float cb) {
    asm volatile("" : "+v"(lane));
    const int r32 = lane & 31, hi = lane >> 5, h = r32 & 7;
    LAS unsigned char* tl = ldsu + tbase + wid * TILE; const char* tg = lds + tbase + wid * TILE;
    asm volatile("s_waitcnt lgkmcnt(0)" ::: "memory");
    {
        const int rlo = (lane >> 2) & 7, chh = lane >> 5, x4 = (lane >> 4) & 1;
        if constexpr (TAIL) {
            const char* ub = (const char*)(S.LATB + (size_t)(TP + 4 * b) * KVR);
#pragma unroll
            for (int P = 0; P < 16; ++P) { const int img = P >> 3, pp = P & 7, row = 8 * (pp >> 1) + rlo, ch = 8 * (pp & 1) + 4 * chh + ((lane & 3) ^ (2 * ((pp >> 1) & 1) + x4));
                const unsigned lo = (unsigned)((row < 3 ? row : 3) * (KVR * 2) + (128 * img + 8 * ch) * 2);
                __builtin_amdgcn_global_load_lds((const unsigned*)(ub + lo), (LAS unsigned*)(tl + P * 1024), 16, 0, 0); }
        } else if constexpr (Q8) {
            const char* ub = (const char*)S.CL8 + ((size_t)b * SEQ + k0) * KVR + 16 * lane;
#pragma unroll
            for (int P = 0; P < 8; ++P) __builtin_amdgcn_global_load_lds((const unsigned*)(ub + P * 1024), (LAS unsigned*)(tl + 8192 + P * 1024), 16, 0, 0);
        } else {
            const char* ub = (const char*)(S.CLB + ((size_t)b * SEQ + k0) * KVR);
            const unsigned loA = (unsigned)(rlo * 512 + 64 * chh + 16 * ((lane & 3) ^ x4)), loB = (unsigned)(rlo * 512 + 64 * chh + 16 * ((lane & 3) ^ (2 + x4)));
#pragma unroll
            for (int P = 0; P < 16; ++P) { const int img = P >> 3, pp = P & 7; const unsigned cst = (unsigned)((8 * (pp >> 1)) * 512 + 256 * img + 128 * (pp & 1));
                __builtin_amdgcn_global_load_lds((const unsigned*)(ub + cst + (((pp >> 1) & 1) ? loB : loA)), (LAS unsigned*)(tl + P * 1024), 16, 0, 0); }
        }
    }
    bf16x8 kp[4]; float rf[16];
    {
        if constexpr (TAIL) { const bf16_t* kr = S.KPEB + (size_t)(TP + 4 * b + (r32 < 3 ? r32 : 3)) * ROPE;
#pragma unroll
            for (int s = 0; s < 4; ++s) kp[s] = *reinterpret_cast<const bf16x8*>(kr + 16 * s + 8 * hi);
        } else {
            const int phys = S.PT[b * NPG + (k0 >> 7)];
            const float* kr = S.CKF + ((size_t)phys * PAGE + (k0 & (PAGE - 1)) + r32) * ROPE + 8 * hi;
#pragma unroll
            for (int s = 0; s < 4; ++s) { const f32x4 x0 = *(const f32x4*)(kr + 16 * s), x1 = *(const f32x4*)(kr + 16 * s + 4);
                u32x4 w = {cvt_pk_bf16(x0[0], x0[1]), cvt_pk_bf16(x0[2], x0[3]), cvt_pk_bf16(x1[0], x1[1]), cvt_pk_bf16(x1[2], x1[3])}; kp[s] = *reinterpret_cast<bf16x8*>(&w); }
        }
        if constexpr (TAIL) {
#pragma unroll
            for (int r = 0; r < 16; ++r) { const int j = crow(r, hi), jc = j < 3 ? j : 3; rf[r] = S.RTS[(4 * b + jc) * 8 + h]; }
        } else {
            const float* r0 = S.RP + (size_t)(2 * h) * NCK + (size_t)b * SEQ + k0 + 4 * hi;
#pragma unroll
            for (int j = 0; j < 4; ++j) { const f32x4 a = *(const f32x4*)(r0 + 8 * j) + *(const f32x4*)(r0 + NCK + 8 * j);
#pragma unroll
                for (int e = 0; e < 4; ++e) rf[4 * j + e] = a[e]; }
            if constexpr (Q8) {
                const float* s0 = S.SC2 + (size_t)b * SEQ + k0 + 4 * hi;
#pragma unroll
                for (int j = 0; j < 4; ++j) { f32x4 sv = *(const f32x4*)(s0 + 8 * j);
#pragma unroll
                    for (int e = 0; e < 4; ++e) { const float s2 = sv[e]; sv[e] = sqrtf(s2); rf[4 * j + e] = rsq(rf[4 * j + e] * s2 * (1.0f / 128) + EPS) * sv[e]; }
                    if (r32 == 0) *(f32x4*)(al_l + 32 + 8 * j + 4 * hi) = sv; }
            }
        }
    }
    asm volatile("s_waitcnt vmcnt(0)" ::: "memory");
    if constexpr (Q8 && !TAIL) {
        const int c8 = lane & 15, r0 = lane >> 4; const char* st = tg + 8192;
#pragma unroll
        for (int i = 0; i < 8; ++i) { const int row = r0 + 4 * i; *(v4u*)(const_cast<char*>(tg) + offa(row, c8)) = widen8(*(const u32x2*)(st + row * 256 + 8 * c8)); }
        u32x2 wb[8];
#pragma unroll
        for (int i = 0; i < 8; ++i) wb[i] = *(const u32x2*)(st + (r0 + 4 * i) * 256 + 128 + 8 * c8);
        asm volatile("s_waitcnt lgkmcnt(0)" ::: "memory");
#pragma unroll
        for (int i = 0; i < 8; ++i) *(v4u*)(const_cast<char*>(tg) + 8192 + offa(r0 + 4 * i, c8)) = widen8(wb[i]);
        asm volatile("s_waitcnt lgkmcnt(0)" ::: "memory");
    }
    f32x16 p = {}, pn = {};
    {
        const int x = (r32 >> 2) & 3; const char* kbase = tg + 2048 * (r32 >> 3) + 64 * (r32 & 7);
        const char* kE = kbase + 16 * (hi ^ x); const char* kO = kbase + 16 * ((2 + hi) ^ x);
        const char* qb = lds + QS_OFF + r32 * QS_STRIDE + hi * 16;
#pragma unroll
        for (int s = 0; s < 4; ++s) p = __builtin_amdgcn_mfma_f32_32x32x16_bf16(kp[s], *reinterpret_cast<const bf16x8*>(qb + (16 + s) * 32), p, 0, 0, 0);
#pragma unroll
        for (int s = 0; s < 16; ++s) { const int img = s >> 3, ss = s & 7; const char* a = ((ss & 1) ? kO : kE) + 8192 * img + 512 * (ss >> 1);
            pn = __builtin_amdgcn_mfma_f32_32x32x16_bf16(*reinterpret_cast<const bf16x8*>(a), *reinterpret_cast<const bf16x8*>(qb + s * 32), pn, 0, 0, 0); }
    }
#pragma unroll
    for (int r = 0; r < 16; ++r) p[r] = (Q8 && !TAIL) ? (pn[r] - cb) * rf[r] + p[r] : pn[r] * (TAIL ? rf[r] : rsq(rf[r] * (1.0f / 128) + EPS)) + p[r];
    if constexpr (TAIL) { const int q = r32 >> 3;
#pragma unroll
        for (int r = 0; r < 16; ++r) if (crow(r, hi) > q) p[r] = -__builtin_inff(); }
    float pmax = p[0];
#pragma unroll
    for (int r = 1; r < 16; ++r) pmax = fmaxf(pmax, p[r]);
    pmax = xmax32(pmax);
    float mn, alpha;
    if (__builtin_expect(__all((pmax - m_reg) <= THR), 1)) { mn = m_reg; alpha = 1.f; }
    else { mn = fmaxf(m_reg, pmax); alpha = __builtin_amdgcn_exp2f(m_reg - mn); m_reg = mn; }
    float ps = 0.f;
#pragma unroll
    for (int r = 0; r < 16; ++r) { p[r] = __builtin_amdgcn_exp2f(p[r] - mn); ps += p[r]; }
    ps = xsum32(ps); l_reg = l_reg * alpha + ps;
    if constexpr (Q8 && !TAIL) {
#pragma unroll
        for (int j = 0; j < 4; ++j) { const f32x4 sv = *(const f32x4*)(al_l + 32 + 8 * j + 4 * hi);
#pragma unroll
            for (int e = 0; e < 4; ++e) p[4 * j + e] *= sv[e]; }
    }
    bf16x8 pa0, pa1; PK4(p, 0, pa0); PK4(p, 8, pa1);
    if constexpr (Q8) {
        float bs = 0.f;
        if constexpr (!TAIL) { const u32x4 w0 = *reinterpret_cast<const u32x4*>(&pa0), w1 = *reinterpret_cast<const u32x4*>(&pa1);
#pragma unroll
            for (int e = 0; e < 4; ++e) bs += (bflo(w0[e]) + bfhi(w0[e])) + (bflo(w1[e]) + bfhi(w1[e]));
            bs = xsum32(bs); }
        lb = lb * alpha + bs;
    }
    if (__any(alpha < 1.f)) { if (hi == 0) al_l[r32] = alpha; asm volatile("s_waitcnt lgkmcnt(0)" ::: "memory");
#pragma unroll
        for (int c = 0; c < 8; ++c)
#pragma unroll
            for (int r = 0; r < 16; ++r) o[c][r] *= al_l[crow(r, hi)]; }
    {
        const int hh = lane >> 5, blk = (lane >> 4) & 1, q4 = (lane & 15) >> 2, pp = lane & 3;
        const int tb = (int)(uintptr_t)tg + 2048 * hh + 64 * q4 + 8 * (pp & 1);
        const int t0 = tb + 16 * ((2 * blk + (pp >> 1)) ^ (2 * hh)), t1 = tb + 256 + 16 * ((2 * blk + (pp >> 1)) ^ (2 * hh + 1));
#define TR0(dst, off) asm volatile("ds_read_b64_tr_b16 %0, %1 offset:%2" : "=&v"(dst) : "v"(t0), "i"(off) : "memory")
#define TR1(dst, off) asm volatile("ds_read_b64_tr_b16 %0, %1 offset:%2" : "=&v"(dst) : "v"(t1), "i"(off) : "memory")
#define PVC(c) do { s16x4 a0, a1, b0, b1; constexpr int f_ = 8192 * ((c) >> 2) + 512 * ((c) & 3);                               \
        TR0(a0, f_); TR1(a1, f_); TR0(b0, f_ + 4096); TR1(b1, f_ + 4096);                                                        \
        asm volatile("s_waitcnt lgkmcnt(0)" ::: "memory"); SBAR();                                                                \
        o[c] = __builtin_amdgcn_mfma_f32_32x32x16_bf16(pa0, (bf16x8){a0[0], a0[1], a0[2], a0[3], a1[0], a1[1], a1[2], a1[3]}, o[c], 0, 0, 0); \
        o[c] = __builtin_amdgcn_mfma_f32_32x32x16_bf16(pa1, (bf16x8){b0[0], b0[1], b0[2], b0[3], b1[0], b1[1], b1[2], b1[3]}, o[c], 0, 0, 0); } while (0)
        PVC(0); PVC(1); PVC(2); PVC(3); PVC(4); PVC(5); PVC(6); PVC(7);
#undef PVC
#undef TR0
#undef TR1
    }
}
__device__ __forceinline__ void unit(const Src& S, const bf16_t* QS, float* PO, float* PML, int b, int s, LAS unsigned char* ldsu, char* lds) {
    int tid = threadIdx.x; asm volatile("" : "+v"(tid));
    const int wid = __builtin_amdgcn_readfirstlane(tid >> 6), lane = tid & 63, r32 = lane & 31, hi = lane >> 5;
    for (int c = tid; c < 32 * 40; c += 512) { const int rho = c / 40, ch = c % 40; *(v4u*)(lds + QS_OFF + rho * QS_STRIDE + ch * 16) = *(const v4u*)(QS + ((size_t)b * 32 + rho) * 320 + ch * 8); }
    __syncthreads();
    float* al_l = (float*)(lds + SCR_OFF) + wid * 64;
    float m_reg = -1e30f, l_reg = 0.f, lb = 0.f, cb = 0.f; f32x16 o[8] = {};
    if (SA_INT8) { const char* qrow = lds + QS_OFF + r32 * QS_STRIDE;
#pragma unroll 8
        for (int ch = 0; ch < 32; ++ch) { const v4u q = *(const v4u*)(qrow + 16 * ch); cb += (bflo(q.x) + bfhi(q.x)) + (bflo(q.y) + bfhi(q.y)) + (bflo(q.z) + bfhi(q.z)) + (bflo(q.w) + bfhi(q.w)); }
        cb *= 128.0f; }
    const int kbase = (8 * s + wid) * 512;
    for (int i = 0; i < 16; ++i) tile<false, SA_INT8 != 0>(S, b, kbase + 32 * i, ldsu, lds, wid, lane, o, m_reg, l_reg, al_l, 0, lb, cb);
    if (s == 1 && wid == 7) tile<true, SA_INT8 != 0>(S, b, 0, ldsu, lds, wid, lane, o, m_reg, l_reg, al_l, 0, lb, cb);
    asm volatile("s_waitcnt lgkmcnt(0)" ::: "memory");
    if (SA_INT8) {
        if (hi == 0) al_l[r32] = lb; asm volatile("s_waitcnt lgkmcnt(0)" ::: "memory");
#pragma unroll
        for (int r = 0; r < 16; ++r) { const float corr = 128.0f * al_l[crow(r, hi)];
#pragma unroll
            for (int c = 0; c < 8; ++c) o[c][r] -= corr; }
        asm volatile("s_waitcnt lgkmcnt(0)" ::: "memory");
    }
    __syncthreads();
    float* ST = (float*)(lds + 32768);
    float* OL = (float*)lds;
    if (hi == 0) { ST[(wid * 32 + r32) * 2] = m_reg; ST[(wid * 32 + r32) * 2 + 1] = l_reg; }
    __syncthreads();
    float sc[16];
#pragma unroll
    for (int r = 0; r < 16; ++r) { const int row = crow(r, hi); float M = ST[row * 2];
#pragma unroll
        for (int w = 1; w < 8; ++w) M = fmaxf(M, ST[(w * 32 + row) * 2]);
        sc[r] = __builtin_amdgcn_exp2f(ST[(wid * 32 + row) * 2] - M); }
    for (int w = 0; w < 8; ++w) {
        if (wid == w) {
#pragma unroll
            for (int c = 0; c < 8; ++c)
#pragma unroll
                for (int r = 0; r < 16; ++r) { float* d = OL + crow(r, hi) * 256 + 32 * c + r32; const float v = o[c][r] * sc[r]; *d = (w == 0) ? v : *d + v; }
        }
        __syncthreads();
    }
    if (tid < 32) { float M = ST[tid * 2];
        for (int w = 1; w < 8; ++w) M = fmaxf(M, ST[(w * 32 + tid) * 2]);
        float L = 0.f; for (int w = 0; w < 8; ++w) L += ST[(w * 32 + tid) * 2 + 1] * __builtin_amdgcn_exp2f(ST[(w * 32 + tid) * 2] - M);
        PML[((size_t)(b * 2 + s) * 32 + tid) * 2] = M; PML[((size_t)(b * 2 + s) * 32 + tid) * 2 + 1] = L; }
    for (int c = tid; c < 32 * 64; c += 512) *((f32x4*)(PO + (size_t)(b * 2 + s) * 32 * 256) + c) = *((const f32x4*)OL + c);
    __syncthreads();
}
}

__device__ __forceinline__ void grp_barrier(volatile LAS unsigned* cnt, unsigned& epoch, unsigned nw, int lane) {
    asm volatile("s_waitcnt vmcnt(0) lgkmcnt(0)" ::: "memory");
    epoch += nw;
    if (lane == 0) __hip_atomic_fetch_add((LAS unsigned*)cnt, 1u, __ATOMIC_RELAXED, __HIP_MEMORY_SCOPE_WORKGROUP);
    while ((int)(*cnt - epoch) < 0) __builtin_amdgcn_s_sleep(0);
    asm volatile("" ::: "memory");
}
namespace pa4 {
using namespace pa;
constexpr int QB4 = 128, OFF_WS4 = SCR_OFF + 1024;
__device__ __forceinline__ void unit(int b, int h, int qb, const bf16_t* __restrict__ QF, const bf16_t* __restrict__ KN, const bf16_t* __restrict__ KPE, const bf16_t* __restrict__ VBg, bf16_t* OB,
                                     char* lds, LAS unsigned char* ldsu, volatile LAS unsigned* cnt, unsigned& epoch) {
    const int tid = threadIdx.x, wid = __builtin_amdgcn_readfirstlane(tid >> 6), lane = tid & 63, r32 = lane & 31, hi = lane >> 5;
    const size_t rowb = (size_t)b * SEQ; const int q0 = qb * QB4, qlo = q0 + wid * QBLK, qm = qlo + r32 - 4 * hi;
    const int NT = (q0 + QB4) / KVBLK;
    float* wsf = (float*)(lds + OFF_WS4) + wid * 64; float* li_l = wsf; float* al_l = wsf + 32;
    bf16x8 qr[12];
    { const bf16_t* qp = QF + (rowb + qlo + r32) * NQ + HD * h + hi * 8;
#pragma unroll
      for (int d0 = 0; d0 < 12; ++d0) qr[d0] = *reinterpret_cast<const bf16x8*>(qp + d0 * 16); }
    const char* Kb = (const char*)(KN + rowb * D + 128 * h); const char* Vb = (const char*)(VBg + rowb * D + 128 * h); const char* Rb = (const char*)(KPE + rowb * ROPE);
    unsigned kof[2], vof[4], rof[2];
#pragma unroll
    for (int e = 0; e < 2; ++e) { const int rw = 4 * e + (lane >> 4); kof[e] = (unsigned)((lane >> 4) * (D * 2) + 16 * ((lane & 15) ^ (rw & 7))); }
#pragma unroll
    for (int pi = 0; pi < 4; ++pi) { const int p = 4 * wid + pi, kk = 8 * (p >> 1) + ((lane & 31) >> 2), key = (kk & ~0xC) | ((kk & 4) << 1) | ((kk & 8) >> 1), col = 32 * (2 * (p & 1) + (lane >> 5)) + 8 * (lane & 3);
        vof[pi] = (unsigned)(key * (D * 2) + col * 2); }
#pragma unroll
    for (int pi = 0; pi < 2; ++pi) { const int p = 2 * wid + pi, row = 8 * p + (lane >> 3); rof[pi] = (unsigned)(row * (ROPE * 2) + 16 * ((lane & 7) ^ ((row >> 1) & 7))); }
#define DMA_TILE(t, bf) do { const size_t kb_ = (size_t)(t) * KVBLK * (D * 2);                                                                          \
        _Pragma("unroll") for (int pi = 0; pi < 4; ++pi) { const int p = 4 * wid + pi;                                                                 \
            __builtin_amdgcn_global_load_lds((const unsigned*)(Kb + kb_ + (size_t)(4 * p) * (D * 2) + kof[pi & 1]), (LAS unsigned*)(ldsu + OFF_K + (bf) * SHM_K + p * 1024), 16, 0, 0); \
            __builtin_amdgcn_global_load_lds((const unsigned*)(Vb + kb_ + vof[pi]), (LAS unsigned*)(ldsu + OFF_V + (bf) * SHM_V + p * 1024), 16, 0, 0); }  \
        _Pragma("unroll") for (int pi = 0; pi < 2; ++pi) { const int p = 2 * wid + pi;                                                                 \
            __builtin_amdgcn_global_load_lds((const unsigned*)(Rb + (size_t)(t) * KVBLK * (ROPE * 2) + rof[pi]), (LAS unsigned*)(ldsu + OFF_R + (bf) * SHM_R + p * 1024), 16, 0, 0); } } while (0)
    const int vb0 = (int)(uintptr_t)lds + v_rd_base(lane);
    float m_reg = -1e30f, l_reg = 0.f, alpha; f32x16 o[4] = {}; f32x16 p0, p1; bf16x8 pa0, pa1, pa2, pa3;
    DMA_TILE(0, 0); grp_barrier(cnt, epoch, 4u, lane);
#define STEP4(t, CB) do { if ((t) + 1 < NT) DMA_TILE((t) + 1, 1 - (CB));                                                      \
        qkt<CB>(p0, p1, lds, r32, hi, qr);                                                                                    \
        if (KVBLK * (t) + KVBLK - 1 > qlo) mask_tile(p0, p1, qm - KVBLK * (t));                                               \
        softmax_tile(p0, p1, m_reg, l_reg, alpha, pa0, pa1, pa2, pa3);                                                        \
        if (__any(alpha < 1.f)) { if (hi == 0) al_l[r32] = alpha; asm volatile("s_waitcnt lgkmcnt(0)" ::: "memory");         \
            _Pragma("unroll") for (int d_ = 0; d_ < 4; ++d_) _Pragma("unroll") for (int r = 0; r < 16; ++r) o[d_][r] *= al_l[crow(r, hi)]; } \
        pv_tile<CB>(o, vb0, pa0, pa1, pa2, pa3);                                                                      \
        grp_barrier(cnt, epoch, 4u, lane); } while (0)
    for (int t = 0; t < NT; t += 2) { STEP4(t, 0); STEP4(t + 1, 1); }
#undef STEP4
#undef DMA_TILE
    if (hi == 0) li_l[r32] = l_reg; asm volatile("s_waitcnt lgkmcnt(0)" ::: "memory");
    float rli[16];
#pragma unroll
    for (int r = 0; r < 16; ++r) rli[r] = __builtin_amdgcn_rcpf(li_l[crow(r, hi)]);
    bf16_t* Ow = OB + (rowb + qlo) * D + 128 * h;
#pragma unroll
    for (int r = 0; r < 16; ++r) { const int orow = crow(r, hi);
#pragma unroll
        for (int d0 = 0; d0 < 4; ++d0) { const float v = o[d0][r] * rli[r]; const float vn = __shfl_xor(v, 1);
            if ((r32 & 1) == 0) *(unsigned*)(Ow + (size_t)orow * D + d0 * 32 + r32) = cvtpk(v, vn); } }
    asm volatile("s_waitcnt lgkmcnt(0)" ::: "memory");
}
}
namespace sa3 {
using namespace sa;
constexpr int TB = 81920;
__device__ __forceinline__ void unit(const Src& S, const bf16_t* QS, float* PO, float* PML, int b, int s, LAS unsigned char* ldsu, char* lds, volatile LAS unsigned* cnt, unsigned& epoch) {
    const int tid = threadIdx.x - 256, j = __builtin_amdgcn_readfirstlane(tid >> 6), lane = tid & 63, r32 = lane & 31, hi = lane >> 5;
    for (int c = tid; c < 32 * 40; c += 192) { const int rho = c / 40, ch = c % 40; *(v4u*)(lds + QS_OFF + rho * QS_STRIDE + ch * 16) = *(const v4u*)(QS + ((size_t)b * 32 + rho) * 320 + ch * 8); }
    grp_barrier(cnt, epoch, 3u, lane);
    float* al_l = (float*)(lds + SCR_OFF) + j * 64;
    float m_reg = -1e30f, l_reg = 0.f; f32x16 o[8] = {};
    for (int i = j; i < 128; i += 3) { float lb_ = 0.f; tile<false>(S, b, s * 4096 + 32 * i, ldsu, lds, j, lane, o, m_reg, l_reg, al_l, TB, lb_, 0.f); }
    if (s == 1 && j == 2) { float lb_ = 0.f; tile<true>(S, b, 0, ldsu, lds, j, lane, o, m_reg, l_reg, al_l, TB, lb_, 0.f); }
    grp_barrier(cnt, epoch, 3u, lane);
    float* OL = (float*)(lds + TB);
    float* ST = (float*)(lds + TB + 32768);
    if (hi == 0) { ST[(j * 32 + r32) * 2] = m_reg; ST[(j * 32 + r32) * 2 + 1] = l_reg; }
    grp_barrier(cnt, epoch, 3u, lane);
    float sc[16];
#pragma unroll
    for (int r = 0; r < 16; ++r) { const int row = crow(r, hi); const float M = fmaxf(fmaxf(ST[row * 2], ST[(32 + row) * 2]), ST[(64 + row) * 2]);
        sc[r] = __builtin_amdgcn_exp2f(ST[(j * 32 + row) * 2] - M); }
    for (int w = 0; w < 3; ++w) {
        if (j == w) {
#pragma unroll
            for (int c = 0; c < 8; ++c)
#pragma unroll
                for (int r = 0; r < 16; ++r) { float* d = OL + crow(r, hi) * 256 + 32 * c + r32; const float v = o[c][r] * sc[r]; *d = (w == 0) ? v : *d + v; }
        }
        grp_barrier(cnt, epoch, 3u, lane);
    }
    if (tid < 32) { const float M = fmaxf(fmaxf(ST[tid * 2], ST[(32 + tid) * 2]), ST[(64 + tid) * 2]);
        float L = 0.f; for (int w = 0; w < 3; ++w) L += ST[(w * 32 + tid) * 2 + 1] * __builtin_amdgcn_exp2f(ST[(w * 32 + tid) * 2] - M);
        PML[((size_t)(b * 2 + s) * 32 + tid) * 2] = M; PML[((size_t)(b * 2 + s) * 32 + tid) * 2 + 1] = L; }
    for (int c = tid; c < 32 * 64; c += 192) *((f32x4*)(PO + (size_t)(b * 2 + s) * 32 * 256) + c) = *((const f32x4*)OL + c);
    grp_barrier(cnt, epoch, 3u, lane);
}
}
#undef SBAR
#undef PK4
}

#ifndef MK_SPLIT
#define MK_SPLIT 0
#endif
struct RangeOrder {
    int g0, n;
    __device__ __forceinline__ bool next(int i, pg8::Unit& u) const { if (i >= n) return false; const int g = g0 + i; u.pm = g >> 2; u.pn = g & 3; u.ko = 0; return true; }
    __device__ __forceinline__ void a_ready(const pg8::Unit&) const {}
    __device__ __forceinline__ void done(const pg8::Unit&) const {}
};
struct SplitOrder {
    int j, ns;
    __device__ __forceinline__ bool next(int i, pg8::Unit& u) const { if (i > 0 || j >= 8 * ns) return false; const int t = j / ns; u.pm = t >> 2; u.pn = t & 3; u.ko = (j % ns) * 512; return true; }
    __device__ __forceinline__ void a_ready(const pg8::Unit&) const {}
    __device__ __forceinline__ void done(const pg8::Unit&) const {}
};
constexpr int NSLOT = 11, R_UNITS = (NCK / 256) * 4;
constexpr int FILL_REM[NSLOT] = {172, 8, 24, 32, 172, 8, 48, 8, 132, 16, 140};
constexpr int FILL_PER[NSLOT] = {3, 17, 4, 1, 3, 17, 0, 17, 4, 0, 2};
constexpr int fill_start(int s) { int a = 0; for (int j = 0; j < s; ++j) a += (256 - FILL_REM[j]) * FILL_PER[j]; return a; }
static_assert(fill_start(NSLOT) <= R_UNITS, "filler");
#ifndef R_SP2
#define R_SP2 PG8_SP2
#endif
constexpr int NPHASE = 20;
struct Args { Ptrs P; int ph_lo, ph_hi; };
typedef const __attribute__((address_space(4))) Args CArgs;
__global__ void __launch_bounds__(NWAVES * 64, 2) fwd(Args args) {
    extern __shared__ __attribute__((aligned(16))) unsigned char lds[];
    Ctx C0; C0.lds = (LAS unsigned char*)lds; C0.tid = threadIdx.x; C0.lane = C0.tid & 63; C0.wave = __builtin_amdgcn_readfirstlane(C0.tid >> 6);
    C0.G = gridDim.x; { const int bx = blockIdx.x; C0.vcu = (C0.G % 8 == 0) ? (bx % 8) * (C0.G / 8) + bx / 8 : bx; }
    const Ctx& C = C0;
    volatile LAS unsigned* MISC = (volatile LAS unsigned*)(C.lds + MISC_OFF);
    if (C.tid < 32) MISC[C.tid] = 0u;
    __syncthreads();
    XcdBarrier bar; bar.bar = (unsigned*)(args.P.ws + WS_CTL) + CW_BAR; bar.x = 0; bar.st = nullptr;
    if (!MK_SPLIT) bar = xcd_barrier_post((unsigned*)(args.P.ws + WS_CTL) + CW_BAR, MISC + 8);
    const int lo = args.ph_lo, hi = args.ph_hi;
#ifndef PHASE_MASK
#define PHASE_MASK 0xFFFFFFFFu
#endif
#define IN(k) (((PHASE_MASK >> (k)) & 1u) && lo <= (k) && (k) < hi)
#define SEAM(k) do { if ((k) == 13 ? (IN(12) && IN(14)) : (IN(k) && IN((k) + 1))) { TP_A(5); xcd_barrier(bar); TP_B(5); TP_B(40 + PGRP(k)); TP_A(40 + PGRP((k) + 1)); } } while (0)
#define PH_BEGIN Ctx Cp_ = C0; { int t_ = threadIdx.x; asm volatile("" : "+v"(t_)); Cp_.tid = t_; Cp_.lane = t_ & 63; } const Ctx& C = Cp_;   \
        CArgs* ka_ = (CArgs*)__builtin_amdgcn_kernarg_segment_ptr(); asm volatile("" : "+s"(ka_)); CPtrs& P = ka_->P; unsigned char* ws = P.ws; float* ctl = (float*)(ws + WS_CTL); \
        bf16_t* XB = (bf16_t*)(ws + WS_XB); bf16_t* HB = (bf16_t*)(ws + WS_HB); float* X = P.out + OUT_Y; float* ssqx = ctl + F_SSQX; (void)XB; (void)HB; (void)X; (void)ssqx; (void)ctl;
    LAS unsigned char* ring = C.lds + RING_OFF;
    const int bx = (int)blockIdx.x;
#define GEMM(EPI, Aptr, Bptr, M_, N_, K_, Eobj) do { int k_ = (K_); asm volatile("" : "+s"(k_));   \
        pg8::Gemm g{(const bf16_t*)(Aptr), (const bf16_t*)(Bptr), (M_), (N_), k_, k_}; pg8::StaticOrder S; S.init((M_), (N_), C.G, bx); \
        pg8::gemm_phase<EPI, pg8::StaticOrder, PG8_ALIGN, PG8_SP2>(ring, g, S, Eobj); } while (0)

#define GEMM8(EPI, Aptr, Bptr, M_, N_, Eobj) do { int k_ = D / 2; asm volatile("" : "+s"(k_));   \
        pg8::Gemm g{(const bf16_t*)(Aptr), (const bf16_t*)(Bptr), (M_), (N_), k_, k_}; pg8::StaticOrder S; S.init((M_), (N_), C.G, bx); \
        pg8::gemm_phase<EPI, pg8::StaticOrder, PG8_ALIGN, PG8_SP2, true>(ring, g, S, Eobj); } while (0)
#define SA_PTR ((const float*)(ws + WS_SA))
#define TGU_PTR(i) ((const float*)(ws + WS_TGU) + (i) * 2 * FF)
#define W8GU_PTR(i) (ws + WS_W8GU0 + (size_t)(i) * WS_W8GU_STRIDE)
#define STAGE_T2() do { __syncthreads(); for (int i_ = C.tid; i_ < D / 4; i_ += NWAVES * 64) *((LAS f32x4*)(C.lds + QS_OFF) + i_) = *((const f32x4*)(ws + WS_T2) + i_); __syncthreads(); } while (0)
#define FILL(s) do { if (C.G == 256) { RangeOrder S; S.n = bx >= FILL_REM[s] ? FILL_PER[s] : 0; S.g0 = fill_start(s) + (bx - FILL_REM[s]) * FILL_PER[s]; \
        int k_ = KVR / 2; asm volatile("" : "+s"(k_)); pg8::Gemm g{(const bf16_t*)(ws + WS_CL8), (const bf16_t*)(ws + WS_W8), NCK, D, k_, k_}; STAGE_T2(); epi::Kv8 E_{(float*)(ws + WS_RP), (const float*)(ws + WS_SC2), (const LAS float*)(C.lds + QS_OFF), (size_t)NCK}; \
        pg8::gemm_phase<epi::Kv8, RangeOrder, PG8_ALIGN, R_SP2, true>(ring, g, S, E_); } } while (0)

#ifndef TPROBE
#define TPROBE 0
#endif
#ifdef PROBE_PHASE
#define PGRP(k) ((k) == PROBE_PHASE ? 7 : 0)
#else
#define PGRP(k) ((k) == 0 ? 1 : ((k) == 12 || (k) == 13) ? 2 : (k) == 14 ? 3 : ((k) == 4 || (k) == 15) ? 4 : 0)
#endif
    unsigned long long tp0_ = 0, tp1_ = 0, tpacc_ = 0;
#define TP_A(k) do { if (TPROBE == (k)) { __syncthreads(); tp0_ = __builtin_amdgcn_s_memrealtime(); } } while (0)
#define TP_B(k) do { if (TPROBE == (k)) { __syncthreads(); tp1_ = __builtin_amdgcn_s_memrealtime(); tpacc_ += tp1_ - tp0_; } } while (0)
#ifndef W8GU_FN
#define W8GU_FN phase_w8gu2
#endif
#ifndef DUP_SEL
#define DUP_SEL 0
#endif
    if (IN(0)) { PH_BEGIN phase_cacheconv(C, P, C.vcu, C.G); phase_w8(C, P); W8GU_FN(C, P); phase_prologue(C, P); if (DUP_SEL == 1) { __syncthreads(); phase_prologue(C, P); } } SEAM(0);
    if (IN(1)) { PH_BEGIN epi::Swiglu8 E{HB, ssqx + 0 * T, SA_PTR, TGU_PTR(0)}; TP_A(3); GEMM8(epi::Swiglu8, ws + WS_A8, W8GU_PTR(0), T, 2 * FF, E); TP_B(3); TP_A(4); FILL(0); TP_B(4); } SEAM(1);
    if (IN(2)) { PH_BEGIN epi::Resid E{XB, ssqx + 1 * T, 0.5f}; TP_A(2); GEMM(epi::Resid, HB, ws + WS_WDN0, T, D, FF, E); TP_B(2); TP_A(1); FILL(1); TP_B(1); } SEAM(2);
    if (IN(3)) { PH_BEGIN epi::ConvIn E{(bf16_t*)(ws + WS_BB), (bf16_t*)(ws + WS_UB), ssqx + 1 * T, P.out + OUT_CSP, P.out + OUT_CSS}; GEMM(epi::ConvIn, XB, ws + WS_WCI, T, 3 * D, D, E); FILL(2); } SEAM(3);
    if (IN(4)) { PH_BEGIN TP_A(8); phase_conv(C, P); TP_B(8); } SEAM(4);
    if (IN(5)) { PH_BEGIN epi::Resid E{XB, ssqx + 2 * T, 1.0f};
        if (C.G == 256) {
            GEMM(epi::Resid, ws + WS_ZB, ws + WS_WCO, TP, D, D, E);
            { int k_ = 256; asm volatile("" : "+s"(k_)); pg8::Gemm g{(const bf16_t*)(ws + WS_ZB) + (size_t)TP * D, (const bf16_t*)(ws + WS_WCO), TS, D, k_, D}; SplitOrder S{bx, 4}; epi::Slab E_{(float*)(ws + WS_SLAB)};
              pg8::gemm_phase<epi::Slab, SplitOrder, PG8_ALIGN, PG8_SP2>(ring, g, S, E_); }
        } else { GEMM(epi::Resid, ws + WS_ZB, ws + WS_WCO, T, D, D, E); }
        FILL(3); } SEAM(5);
    if (IN(6)) { PH_BEGIN if (C.G == 256) phase_quant(C, P, (const float*)(ws + WS_SLAB), 4, ssqx + 2 * T); else phase_quant(C, P); xcd_barrier(bar); epi::Swiglu8 E{HB, ssqx + 2 * T, SA_PTR, TGU_PTR(1)}; GEMM8(epi::Swiglu8, ws + WS_A8, W8GU_PTR(1), T, 2 * FF, E); FILL(4); } SEAM(6);
    if (IN(7)) { PH_BEGIN epi::Resid E{XB, ssqx + 3 * T, 0.5f}; GEMM(epi::Resid, HB, ws + WS_WDN1, T, D, FF, E); FILL(5); } SEAM(7);
    if (IN(8)) { PH_BEGIN phase_quant(C, P); xcd_barrier(bar); { epi::Swiglu8 E{HB, ssqx + 3 * T, SA_PTR, TGU_PTR(2)}; GEMM8(epi::Swiglu8, ws + WS_A8, W8GU_PTR(2), T, 2 * FF, E); }
        { epi::Dkv E{ssqx + 3 * T, (float*)(ws + WS_CKV), ctl + F_SSQLAT, ctl + F_SSQKPE}; int k_ = D; asm volatile("" : "+s"(k_)); pg8::Gemm g{(const bf16_t*)XB, (const bf16_t*)(ws + WS_WDKV), T, 512, k_, k_};
          pg8::StaticOrder S; S.init(T, 512, C.G, (bx + 84) % C.G); pg8::gemm_phase<epi::Dkv, pg8::StaticOrder, PG8_ALIGN, PG8_SP2>(ring, g, S, E); } } SEAM(8);
    if (IN(9)) { PH_BEGIN epi::Resid E{XB, ssqx + 4 * T, 0.5f}; GEMM(epi::Resid, HB, ws + WS_WDN2, T, D, FF, E); FILL(7); TP_A(8); phase_kvfin(C, P); TP_B(8); } SEAM(9);
    if (IN(10)) { PH_BEGIN { epi::Dq E{(bf16_t*)(ws + WS_CQB), ssqx + 4 * T, ctl + F_SSQCQ}; GEMM(epi::Dq, XB, ws + WS_WDQ, T, QRANK, D, E); } FILL(8);
                  { epi::Kv E{(bf16_t*)(ws + WS_KN), (bf16_t*)(ws + WS_VB), (float*)(ws + WS_RPT), (size_t)T}; GEMM(epi::Kv, ws + WS_LATB, ws + WS_WUKV, T, 2 * D, KVR, E); } FILL(9); } SEAM(10);
    if (IN(11)) { PH_BEGIN epi::Uq E{(bf16_t*)(ws + WS_QB), ctl + F_SSQCQ, ctl + F_SSQQ}; TP_A(13); GEMM(epi::Uq, ws + WS_CQB, ws + WS_WUQ, T, NQ, QRANK, E); TP_B(13); TP_A(14); FILL(10); TP_B(14); } SEAM(11);
    if (IN(12)) { PH_BEGIN const int r0_ = (C.G == 256) ? fill_start(NSLOT) : 0, base_ = (R_UNITS - r0_) / C.G, ext_ = (R_UNITS - r0_) % C.G;
        RangeOrder S; S.g0 = r0_ + bx * base_ + (bx < ext_ ? bx : ext_); S.n = base_ + (bx < ext_ ? 1 : 0);
        int k_ = KVR / 2; asm volatile("" : "+s"(k_)); pg8::Gemm g{(const bf16_t*)(ws + WS_CL8), (const bf16_t*)(ws + WS_W8), NCK, D, k_, k_}; STAGE_T2(); epi::Kv8 E_{(float*)(ws + WS_RP), (const float*)(ws + WS_SC2), (const LAS float*)(C.lds + QS_OFF), (size_t)NCK};
        pg8::gemm_phase<epi::Kv8, RangeOrder, PG8_ALIGN, R_SP2, true>(ring, g, S, E_);
        phase_qkfin(C, P); }
    SEAM(13);
    if (IN(14)) { PH_BEGIN
        const bf16_t* QF = (const bf16_t*)(ws + WS_QB); const bf16_t* KN = (const bf16_t*)(ws + WS_KN); const bf16_t* KPE = (const bf16_t*)(ws + WS_KPEB);
        const bf16_t* VBp = (const bf16_t*)(ws + WS_VB); bf16_t* OB = (bf16_t*)(ws + WS_OB);
#ifndef ATT_SEL
#define ATT_SEL 3
#endif
        att::sa::Src S{(const bf16_t*)(ws + WS_CLB), P.in[3], (const int*)P.in[5], (const float*)(ws + WS_RP), (const bf16_t*)(ws + WS_LATB), KPE, (const float*)(ws + WS_RTS), ws + WS_CL8, (const float*)(ws + WS_SC2)};
#ifndef ATT_OVERLAP
#define ATT_OVERLAP 0
#endif
        if (ATT_OVERLAP && C.G == 256) {
            volatile LAS unsigned* gcnt = (volatile LAS unsigned*)(C.lds + MISC_OFF) + 16;
            if (C.wave < 4) { unsigned ep = 0u; const int bh = C.vcu >> 4, s = C.vcu & 15;
                att::pa4::unit(bh >> 3, bh & 7, 63 - 2 * s, QF, KN, KPE, VBp, OB, (char*)lds, C.lds, gcnt, ep);
                att::pa4::unit(bh >> 3, bh & 7, 62 - 2 * s, QF, KN, KPE, VBp, OB, (char*)lds, C.lds, gcnt, ep);
                att::pa4::unit(bh >> 3, bh & 7, 2 * s + 1, QF, KN, KPE, VBp, OB, (char*)lds, C.lds, gcnt, ep);
                att::pa4::unit(bh >> 3, bh & 7, 2 * s, QF, KN, KPE, VBp, OB, (char*)lds, C.lds, gcnt, ep);
            } else if (C.wave < 7) { unsigned ep = 0u;
                att::sa3::unit(S, (const bf16_t*)(ws + WS_QS), (float*)(ws + WS_PO), (float*)(ws + WS_PML), C.vcu >> 1, C.vcu & 1, C.lds, (char*)lds, gcnt + 1, ep); }
        } else {
#define RUN_SA() do { for (int v = C.vcu; v < 2 * DB; v += C.G) att::sa::unit(S, (const bf16_t*)(ws + WS_QS), (float*)(ws + WS_PO), (float*)(ws + WS_PML), v >> 1, v & 1, C.lds, (char*)lds); } while (0)
#ifndef PA_REV2
#define PA_REV2 true
#endif
#ifndef PA_UNIT
#define PA_UNIT unit_dma
#endif
        const att::pa::QFix QFX{ctl + F_SSQQ, P.in[19], P.in[20], (const f32x2*)(ws + WS_ROPE)};
#define RUN_PA() do { for (int v = C.vcu; v < 256; v += C.G) { const int bh = v >> 4, s = v & 15; \
            att::pa::unit_dma<false>(bh >> 3, bh & 7, 31 - s, QF, KN, KPE, VBp, OB, (char*)lds, C.lds, QFX); att::pa::unit_dma<PA_REV2>(bh >> 3, bh & 7, s, QF, KN, KPE, VBp, OB, (char*)lds, C.lds, QFX); } } while (0)
        RUN_PA(); RUN_SA();
#undef RUN_SA
#undef RUN_PA
        }
    } SEAM(14);
    if (IN(15)) { PH_BEGIN TP_A(7); phase_scomb(C, P); TP_B(7); } SEAM(15);
    if (IN(16)) { PH_BEGIN epi::Resid E{XB, ssqx + 5 * T, 1.0f};
        if (C.G == 256) {
            GEMM(epi::Resid, ws + WS_OB, ws + WS_WO, TP, D, D, E);
            { int k_ = 256; asm volatile("" : "+s"(k_)); pg8::Gemm g{(const bf16_t*)(ws + WS_OB) + (size_t)TP * D, (const bf16_t*)(ws + WS_WO), TS, D, k_, D}; SplitOrder S{bx, 4}; epi::Slab E_{(float*)(ws + WS_SLAB)};
              pg8::gemm_phase<epi::Slab, SplitOrder, PG8_ALIGN, PG8_SP2>(ring, g, S, E_); }
        } else { GEMM(epi::Resid, ws + WS_OB, ws + WS_WO, T, D, D, E); } } SEAM(16);
    if (IN(17)) { PH_BEGIN if (C.G == 256) phase_quant(C, P, (const float*)(ws + WS_SLAB), 4, ssqx + 5 * T); else phase_quant(C, P); xcd_barrier(bar); epi::Swiglu8 E{HB, ssqx + 5 * T, SA_PTR, TGU_PTR(3)}; GEMM8(epi::Swiglu8, ws + WS_A8, W8GU_PTR(3), T, 2 * FF, E); } SEAM(17);
    if (IN(18)) { PH_BEGIN
        if (C.G == 256) { unsigned* cnt = (unsigned*)(ws + WS_CTL) + CW_SLC;
            { int k_ = 256; asm volatile("" : "+s"(k_)); pg8::Gemm g{(const bf16_t*)HB + (size_t)TP * FF, (const bf16_t*)(ws + WS_WDN3), TS, D, k_, FF}; SplitOrder S{bx, SPLITK}; epi::Slab E_{(float*)(ws + WS_SLAB)};
              pg8::gemm_phase<epi::Slab, SplitOrder, PG8_ALIGN, PG8_SP2>(ring, g, S, E_); }
            if (bx < 8 * SPLITK) { asm volatile("s_waitcnt vmcnt(0)" ::: "memory"); __syncthreads();
                if (threadIdx.x == 0) { __builtin_amdgcn_fence(__ATOMIC_RELEASE, "agent"); asm volatile("s_waitcnt vmcnt(0)" ::: "memory"); (void)xb_add(cnt, 1u); } }
            { epi::ResidY E{XB, X, 0.5f}; GEMM(epi::ResidY, HB, ws + WS_WDN3, TP, D, FF, E); }
            if (bx >= 8 * SPLITK) {
                if (threadIdx.x == 0) { XB_SPIN(xb_ld(cnt) < (unsigned)(8 * SPLITK), bar.bar); __builtin_amdgcn_fence(__ATOMIC_ACQUIRE, "agent"); asm volatile("s_waitcnt vmcnt(0)" ::: "memory"); }
                __syncthreads();
                const float* slab = (const float*)(ws + WS_SLAB);
                for (int i = (bx - 8 * SPLITK) * (NWAVES * 64) + C.tid; i < TS * D / 4; i += (256 - 8 * SPLITK) * (NWAVES * 64)) { f32x4 s = *((const f32x4*)slab + i);
#pragma unroll
                    for (int c = 1; c < SPLITK; ++c) s += *((const f32x4*)(slab + (size_t)c * TS * D) + i);
                    const u32x2 xw = *((const u32x2*)(XB + (size_t)TP * D) + i); *((f32x4*)(X + (size_t)TP * D) + i) = (f32x4){bflo(xw.x), bfhi(xw.x), bflo(xw.y), bfhi(xw.y)} + s * 0.5f; } }
        } else { epi::ResidY E{XB, X, 0.5f}; GEMM(epi::ResidY, HB, ws + WS_WDN3, T, D, FF, E); } }
#ifdef XBAR_PROBE
    for (int i_ = 0; i_ < XBAR_PROBE; ++i_) xcd_barrier(bar);
#endif
#ifndef PROBE_BLOCK
#define PROBE_BLOCK 255
#endif
    if (TPROBE && blockIdx.x == PROBE_BLOCK && C.wave == 0) { const unsigned long long te = __builtin_amdgcn_s_memrealtime(), span = tpacc_ * 32ull;
        while (__builtin_amdgcn_s_memrealtime() - te < span) __builtin_amdgcn_s_sleep(8); }
#undef IN
#undef SEAM
#undef GEMM
}

extern "C" void kernel_launch(void* const* d_in, const int* in_sizes, int n_in, void* d_out, int out_size, void* d_ws, size_t ws_size, hipStream_t stream) {
    static int grid = 0;
    if (grid == 0) {
        if (n_in != 29 || out_size != (int)OUT_TOTAL || ws_size < WS_END) { fprintf(stderr, "kernel_launch: unexpected shapes (n_in %d, out %d, ws %zu); nothing launched\n", n_in, out_size, ws_size); grid = -1; return; }
        int dev = 0, cus = 0, per_cu = 0;
        if (hipGetDevice(&dev) != hipSuccess || hipDeviceGetAttribute(&cus, hipDeviceAttributeMultiprocessorCount, dev) != hipSuccess) { grid = -1; return; }
        if (hipFuncSetAttribute((const void*)fwd, hipFuncAttributeMaxDynamicSharedMemorySize, LDS_BYTES) != hipSuccess) { fprintf(stderr, "kernel_launch: hipFuncSetAttribute failed\n"); grid = -1; return; }
        if (hipOccupancyMaxActiveBlocksPerMultiprocessor(&per_cu, (const void*)fwd, NWAVES * 64, LDS_BYTES) != hipSuccess || per_cu < 1)
            fprintf(stderr, "kernel_launch: note: occupancy query reports %d workgroups per CU\n", per_cu);
        (void)hipGetLastError();
        grid = cus;
    }
    if (grid < 0) return;
    if (hipMemsetAsync((char*)d_ws + WS_CTL, 0, CTL_BYTES, stream) != hipSuccess) { fprintf(stderr, "kernel_launch: memset failed\n"); return; }
    Args a{};
    for (int i = 0; i < 29; ++i) a.P.in[i] = (const float*)d_in[i];
    a.P.out = (float*)d_out; a.P.ws = (unsigned char*)d_ws;
#if MK_SPLIT
    for (int ph = 0; ph < NPHASE; ++ph) { a.ph_lo = ph; a.ph_hi = ph + 1; hipLaunchKernelGGL(fwd, dim3(grid), dim3(NWAVES * 64), LDS_BYTES, stream, a); }
#else
    a.ph_lo = 0; a.ph_hi = NPHASE;
    hipLaunchKernelGGL(fwd, dim3(grid), dim3(NWAVES * 64), LDS_BYTES, stream, a);
#endif
    const hipError_t le = hipPeekAtLastError();
    if (le != hipSuccess) fprintf(stderr, "kernel_launch: launch failed: %s\n", hipGetErrorName(le));
}
```

```cpp
#include <hip/hip_runtime.h>
#include <cstdio>
#include <cstdint>
namespace pg8 {
#define PG8_LAS __attribute__((address_space(3)))
typedef unsigned short bf16_t;
typedef short bf16x8 __attribute__((ext_vector_type(8)));
typedef float f32x4 __attribute__((ext_vector_type(4)));
typedef unsigned u32x4 __attribute__((ext_vector_type(4)));
constexpr int BM = 256, BK = 64, HALF = 128, HTB = HALF * BK * 2  , STAGE_BYTES = 8 * HTB, NXCD = 8, WGM = 8;

__host__ __device__ __forceinline__ int lds_byte(int r, int c) { const int st = (r >> 4) * 2 + (c >> 5), rr = r & 15, cc = c & 31, ob = rr * 64 + cc * 2; return st * 1024 + (ob ^ (((ob >> 9) & 1) << 5)); }
__host__ __device__ __forceinline__ void stage_rc(int b, int& R, int& C) { const int st = b / 1024, sb = b % 1024, swz = sb ^ (((sb >> 9) & 1) << 5); R = (st >> 1) * 16 + swz / 64; C = (st & 1) * 32 + (swz % 64) / 2; }
__host__ __device__ __forceinline__ int perm32(int rho) { const int n = rho >> 4, i = rho & 15; return 8 * (i >> 2) + 4 * n + (i & 3); }

struct Unit { int pm, pn; int ko; };
struct Gemm { const bf16_t* A; const bf16_t* Bt; int M, N, K; int ld; };

struct StaticOrder {
    int nM, nN, nwg, G, c;
    __host__ __device__ void init(int M, int N, int G_, int c_) { nM = M / BM; nN = N / BM; nwg = nM * nN; G = G_; c = c_; }
    __host__ __device__ bool next(int i, Unit& u) const {
        const long L = (long)i * G + c; if (L >= nwg) return false;
        int wgid = (int)L; { const int q = nwg / NXCD, r = nwg % NXCD, xcd = wgid % NXCD, off = wgid / NXCD; wgid = (xcd < r ? xcd * (q + 1) : r * (q + 1) + (xcd - r) * q) + off; }
        const int nig = WGM * nN, gid = wgid / nig, fm = gid * WGM, gsz = (nM - fm) < WGM ? (nM - fm) : WGM;
        u.pm = fm + ((wgid % nig) % gsz); u.pn = (wgid % nig) / gsz; u.ko = 0; return true;
    }
    __device__ __forceinline__ void a_ready(const Unit&) const {}
    __device__ __forceinline__ void done(const Unit&) const {}
};

__device__ __forceinline__ unsigned cvt_pk_bf16(float lo, float hi) { unsigned r; asm volatile("v_cvt_pk_bf16_f32 %0, %1, %2" : "=v"(r) : "v"(lo), "v"(hi)); return r; }
typedef float f32x2 __attribute__((ext_vector_type(2)));
typedef int i32x4 __attribute__((ext_vector_type(4)));
template <bool I8> __device__ __forceinline__ f32x4 mma16(bf16x8 b, bf16x8 a, f32x4 c) {
    if constexpr (I8) return __builtin_bit_cast(f32x4, __builtin_amdgcn_mfma_i32_16x16x64_i8(__builtin_bit_cast(i32x4, b), __builtin_bit_cast(i32x4, a), __builtin_bit_cast(i32x4, c), 0, 0, 0));
    else return __builtin_amdgcn_mfma_f32_16x16x32_bf16(b, a, c, 0, 0, 0);
}
template <class Epi, class Sched, bool ALIGN_EPI = false, bool SP2 = false, bool I8 = false>
__device__ __forceinline__ void gemm_phase(PG8_LAS unsigned char* lds, const Gemm g, const Sched& S, const Epi& E) {
    int tid_ = threadIdx.x; asm volatile("" : "+v"(tid_));
    const int tid = tid_, wid = __builtin_amdgcn_readfirstlane(tid >> 6), lane = tid & 63, wr = wid >> 2, wc = wid & 3, fr = lane & 15, fq = lane >> 4;
    const int K = g.K, nt = K / BK;
    unsigned voffA[2], voffB[2];
#pragma unroll
    for (int i = 0; i < 2; ++i) { int R, C; stage_rc(tid * 16 + i * 8192, R, C); const int Rb = Epi::PERM ? ((R & ~31) + perm32(R & 31)) : R;
        voffA[i] = (unsigned)(R * g.ld + C) * 2u; voffB[i] = (unsigned)(Rb * g.ld + C) * 2u; }
    const size_t kstep = (size_t)(BK * 2);
    const size_t hstep = (size_t)HALF * g.ld * 2;
    const size_t tstep = 2 * hstep;
    const unsigned ldsw = (unsigned)wid * 1024u;
    const int aoff = lds_byte(wr * 64 + fr, fq * 8), boff = lds_byte(wc * 32 + fr, fq * 8);
#define PG8_SA(b, h) (((b) * 2 + (h)) * HTB)
#define PG8_SB(b, h) ((4 + (b) * 2 + (h)) * HTB)
#define PG8_STAGE(bufoff, gbase, voff) do { _Pragma("unroll") for (int _i = 0; _i < 2; ++_i) \
        __builtin_amdgcn_global_load_lds((const unsigned*)((const char*)(gbase) + (voff)[_i]), (PG8_LAS unsigned*)(lds + (bufoff) + ldsw + _i * 8192), 16, 0, 0); } while (0)
#define PG8_LDA(dst, b, h) do { _Pragma("unroll") for (int m = 0; m < 4; ++m) _Pragma("unroll") for (int k = 0; k < 2; ++k) dst[m][k] = *(const PG8_LAS bf16x8*)(lds + PG8_SA(b, h) + aoff + m * 2048 + k * 1024); } while (0)
#define PG8_LDB(dst, b, h) do { _Pragma("unroll") for (int n = 0; n < 2; ++n) _Pragma("unroll") for (int k = 0; k < 2; ++k) dst[n][k] = *(const PG8_LAS bf16x8*)(lds + PG8_SB(b, h) + boff + n * 2048 + k * 1024); } while (0)
#define PG8_MMA(ai, bj, At, Bt) do { __builtin_amdgcn_s_setprio(1); _Pragma("unroll") for (int m = 0; m < 4; ++m) _Pragma("unroll") for (int n = 0; n < 2; ++n) _Pragma("unroll") for (int k = 0; k < 2; ++k) \
        acc[ai][bj][m][n] = mma16<I8>(Bt[n][k], At[m][k], acc[ai][bj][m][n]); __builtin_amdgcn_s_setprio(0); } while (0)
#define PG8_WAIT_V(n) asm volatile("s_waitcnt vmcnt(" #n ")" ::: "memory")
#define PG8_WAIT_L(n) asm volatile("s_waitcnt lgkmcnt(" #n ")" ::: "memory")
#define PG8_BAR __builtin_amdgcn_s_barrier()
#define PG8_SCHED __builtin_amdgcn_sched_barrier(0)
    Unit cur, nxt; int ui = 0;
    if (!S.next(0, cur)) return;
    f32x4 acc[2][2][4][2];
#pragma unroll
    for (int a = 0; a < 2; ++a)
#pragma unroll
        for (int b = 0; b < 2; ++b)
#pragma unroll
            for (int m = 0; m < 4; ++m)
#pragma unroll
                for (int n = 0; n < 2; ++n) acc[a][b][m][n] = (f32x4){0.f, 0.f, 0.f, 0.f};
    bf16x8 At[4][2], B0[2][2], B1[2][2];
    const char* cA = (const char*)g.A + (size_t)cur.pm * tstep + cur.ko; const char* cB = (const char*)g.Bt + (size_t)cur.pn * tstep + cur.ko;
    S.a_ready(cur);
    if constexpr (SP2) {
        PG8_STAGE(PG8_SB(0, 0), cB, voffB); PG8_STAGE(PG8_SB(0, 1), cB + hstep, voffB); PG8_STAGE(PG8_SA(0, 0), cA, voffA); PG8_STAGE(PG8_SA(0, 1), cA + hstep, voffA);
        if (wr == 1) PG8_BAR;
        PG8_WAIT_V(2); PG8_BAR;
        PG8_STAGE(PG8_SB(1, 0), cB + kstep, voffB); PG8_STAGE(PG8_SA(1, 0), cA + kstep, voffA); PG8_STAGE(PG8_SB(1, 1), cB + hstep + kstep, voffB);
        PG8_WAIT_V(6); PG8_BAR;
    } else {
        PG8_STAGE(PG8_SB(0, 0), cB, voffB); PG8_STAGE(PG8_SA(0, 0), cA, voffA); PG8_STAGE(PG8_SB(0, 1), cB + hstep, voffB); PG8_STAGE(PG8_SA(0, 1), cA + hstep, voffA);
        if (wr == 1) PG8_BAR;
        PG8_WAIT_V(4); PG8_BAR;
        PG8_STAGE(PG8_SB(1, 0), cB + kstep, voffB); PG8_STAGE(PG8_SA(1, 0), cA + kstep, voffA); PG8_STAGE(PG8_SB(1, 1), cB + hstep + kstep, voffB);
        PG8_WAIT_V(6); PG8_BAR;
    }
    for (;;) {
        const bool has_next = S.next(ui + 1, nxt);
        const char* nA = has_next ? (const char*)g.A + (size_t)nxt.pm * tstep + nxt.ko : cA; const char* nB = has_next ? (const char*)g.Bt + (size_t)nxt.pn * tstep + nxt.ko : cB;
        for (int t = 0; t < nt; t += 2) {
            const bool last = (t == nt - 2);
            const char* a1 = cA + (size_t)(t + 1) * kstep;
            const char* a2 = last ? nA : cA + (size_t)(t + 2) * kstep; const char* b2 = last ? nB : cB + (size_t)(t + 2) * kstep;
            const char* a3 = a2 + kstep; const char* b3 = b2 + kstep;
            if (last && has_next) S.a_ready(nxt);
            if constexpr (SP2) {
            PG8_LDB(B0, 0, 0); PG8_LDB(B1, 0, 1); PG8_SCHED; PG8_LDA(At, 0, 0); PG8_STAGE(PG8_SA(1, 1), a1 + hstep, voffA);
            PG8_WAIT_V(8); PG8_WAIT_L(0); PG8_BAR; PG8_MMA(0, 0, At, B0); PG8_MMA(0, 1, At, B1); PG8_BAR; PG8_SCHED;
            PG8_LDA(At, 0, 1); PG8_STAGE(PG8_SB(0, 0), b2, voffB); PG8_STAGE(PG8_SB(0, 1), b2 + hstep, voffB); PG8_STAGE(PG8_SA(0, 0), a2, voffA);
            PG8_WAIT_V(8); PG8_WAIT_L(0); PG8_BAR; PG8_MMA(1, 0, At, B0); PG8_MMA(1, 1, At, B1); PG8_BAR; PG8_SCHED;
            PG8_LDB(B0, 1, 0); PG8_LDB(B1, 1, 1); PG8_SCHED; PG8_LDA(At, 1, 0); PG8_STAGE(PG8_SA(0, 1), a2 + hstep, voffA);
            PG8_WAIT_V(8); PG8_WAIT_L(0); PG8_BAR; PG8_MMA(0, 0, At, B0); PG8_MMA(0, 1, At, B1); PG8_BAR; PG8_SCHED;
            PG8_LDA(At, 1, 1); PG8_STAGE(PG8_SB(1, 0), b3, voffB); PG8_STAGE(PG8_SB(1, 1), b3 + hstep, voffB); PG8_STAGE(PG8_SA(1, 0), a3, voffA);
            PG8_WAIT_V(8); PG8_WAIT_L(0); PG8_BAR; PG8_MMA(1, 0, At, B0); PG8_MMA(1, 1, At, B1); PG8_BAR; PG8_SCHED;
            } else {
            PG8_LDB(B0, 0, 0); PG8_SCHED; PG8_LDA(At, 0, 0); PG8_STAGE(PG8_SA(1, 1), a1 + hstep, voffA);
            PG8_WAIT_L(8); PG8_BAR; PG8_WAIT_L(0); PG8_MMA(0, 0, At, B0); PG8_BAR; PG8_SCHED;
            PG8_LDB(B1, 0, 1); PG8_STAGE(PG8_SB(0, 0), b2, voffB);
            PG8_BAR; PG8_WAIT_L(0); PG8_MMA(0, 1, At, B1); PG8_BAR;
            PG8_LDA(At, 0, 1); PG8_STAGE(PG8_SA(0, 0), a2, voffA);
            PG8_BAR; PG8_WAIT_L(0); PG8_MMA(1, 0, At, B0); PG8_BAR; PG8_SCHED;
            PG8_STAGE(PG8_SB(0, 1), b2 + hstep, voffB);
            PG8_WAIT_V(6); PG8_BAR; PG8_MMA(1, 1, At, B1); PG8_BAR;
            PG8_LDB(B0, 1, 0); PG8_SCHED; PG8_LDA(At, 1, 0); PG8_STAGE(PG8_SA(0, 1), a2 + hstep, voffA);
            PG8_WAIT_L(8); PG8_BAR; PG8_WAIT_L(0); PG8_MMA(0, 0, At, B0); PG8_BAR; PG8_SCHED;
            PG8_LDB(B1, 1, 1); PG8_STAGE(PG8_SB(1, 0), b3, voffB);
            PG8_BAR; PG8_WAIT_L(0); PG8_MMA(0, 1, At, B1); PG8_BAR;
            PG8_LDA(At, 1, 1); PG8_STAGE(PG8_SA(1, 0), a3, voffA);
            PG8_BAR; PG8_WAIT_L(0); PG8_MMA(1, 0, At, B0); PG8_BAR; PG8_SCHED;
            PG8_STAGE(PG8_SB(1, 1), b3 + hstep, voffB);
            PG8_WAIT_V(6); PG8_BAR; PG8_MMA(1, 1, At, B1); PG8_BAR;
            }
        }
        if constexpr (ALIGN_EPI) { if (wr == 0) PG8_BAR; }
        if constexpr (!Epi::AFTER_DRAIN) { E(acc, cur, wr, wc, fr, fq); S.done(cur); }
        if (!has_next) break;
#pragma unroll
        for (int a = 0; a < 2; ++a)
#pragma unroll
            for (int b = 0; b < 2; ++b)
#pragma unroll
                for (int m = 0; m < 4; ++m)
#pragma unroll
                    for (int n = 0; n < 2; ++n) acc[a][b][m][n] = (f32x4){0.f, 0.f, 0.f, 0.f};
        cur = nxt; cA = nA; cB = nB; ++ui;
        if constexpr (ALIGN_EPI) { if (wr == 1) PG8_BAR; }
    }
    PG8_WAIT_V(0);
    if constexpr (!ALIGN_EPI) { if (wr == 0) PG8_BAR; }
    PG8_BAR;
    if constexpr (Epi::AFTER_DRAIN) { E.fused(acc, cur, wr, wc, fr, fq, lds, wid, lane); S.done(cur); }
#undef PG8_SA
#undef PG8_SB
#undef PG8_STAGE
#undef PG8_LDA
#undef PG8_LDB
#undef PG8_MMA
#undef PG8_WAIT_V
#undef PG8_WAIT_L
#undef PG8_BAR
#undef PG8_SCHED
}
}
#define PG8_SP2 true
#define PG8_ALIGN true
#define GAS __attribute__((address_space(1)))
#define LAS __attribute__((address_space(3)))
typedef unsigned short bf16;
typedef unsigned v4u __attribute__((ext_vector_type(4)));
typedef float f32x4 __attribute__((ext_vector_type(4)));
typedef short bf16x8 __attribute__((ext_vector_type(8)));
typedef GAS unsigned gu32;
typedef GAS unsigned long long gu64;
#define RLX_AGENT __ATOMIC_RELAXED, __HIP_MEMORY_SCOPE_AGENT
#define LDS_WAIT() asm volatile("s_waitcnt lgkmcnt(0)" ::: "memory")
#define VM_WAIT() asm volatile("s_waitcnt vmcnt(0)" ::: "memory")
__device__ __forceinline__ unsigned long long rt() { return __builtin_amdgcn_s_memrealtime(); }
__device__ __forceinline__ unsigned f2bf(float f) { unsigned u = __builtin_bit_cast(unsigned, f); return (u + 0x7fffu + ((u >> 16) & 1u)) >> 16; }
__device__ __forceinline__ unsigned pk2(float lo, float hi) { return f2bf(lo) | (f2bf(hi) << 16); }
#define XB_TMO      128
#define XB_XCNT(j)  (256  + 64 * (j))
#define XB_XSUB(j)  (1280 + 64 * (j))
#define XB_XGEN(j)  (2304 + 64 * (j))
#define XB_TOP      3328
#define XB_TOPGEN   3392
#define XCD_BAR_WORDS 3456
#define XB_SPIN_CAP (1u << 18)

__device__ __forceinline__ unsigned xb_ld(unsigned* p)              { return __hip_atomic_load(p, __ATOMIC_RELAXED, __HIP_MEMORY_SCOPE_AGENT); }
__device__ __forceinline__ unsigned xb_add(unsigned* p, unsigned v) { return __hip_atomic_fetch_add(p, v, __ATOMIC_RELAXED, __HIP_MEMORY_SCOPE_AGENT); }
__device__ __forceinline__ unsigned xb_xcc_id() { return (unsigned)__builtin_amdgcn_s_getreg((3 << 11) | 20) & 0xFu; }
#define XB_SPIN(cond, bar) do { unsigned _sp = 0; while (cond) { __builtin_amdgcn_s_sleep(1); \
    if ((++_sp & 255u) == 0u) { if (xb_ld(&(bar)[XB_TMO])) break; if (_sp > XB_SPIN_CAP) { atomicAdd(&(bar)[XB_TMO], 1u); break; } } } } while (0)

struct XcdBarrier {
    unsigned* bar; unsigned x;
    volatile LAS unsigned* st;
};

__device__ __forceinline__ XcdBarrier xcd_barrier_post(unsigned* bar, volatile LAS unsigned* st) {
    XcdBarrier b; b.bar = bar; b.x = xb_xcc_id(); b.st = st;
    if (threadIdx.x == 0) (void)xb_add(&bar[XB_XCNT(b.x)], 1u);
    return b;
}
__device__ __forceinline__ void xcd_barrier_complete(unsigned* bar, unsigned x, unsigned& nloc, unsigned& nx) {
    const unsigned G = gridDim.x * gridDim.y * gridDim.z;
    unsigned sum, cnt, mine, sp = 0u;
    for (;;) {
        sum = 0u; cnt = 0u; mine = 0u;
#pragma unroll
        for (unsigned j = 0; j < 16; ++j) { const unsigned c = xb_ld(&bar[XB_XCNT(j)]); sum += c; cnt += (c > 0u) ? 1u : 0u; mine = (j == x) ? c : mine; }
        if (sum == G) break;
        __builtin_amdgcn_s_sleep(1);
        if ((++sp & 255u) == 0u) { if (xb_ld(&bar[XB_TMO])) break; if (sp > XB_SPIN_CAP) { atomicAdd(&bar[XB_TMO], 1u); break; } }
    }
    nloc = mine > 0u ? mine : 1u; nx = cnt > 0u ? cnt : 1u;
}

__device__ __forceinline__ void xcd_barrier(const XcdBarrier& b) {
    asm volatile("s_waitcnt vmcnt(0)" ::: "memory");
    __syncthreads();
    if (threadIdx.x == 0) {
        unsigned* bar = b.bar;
        __builtin_amdgcn_s_waitcnt(0);
        unsigned nloc = b.st[0], nx = b.st[1];
        if (nloc == 0u) { xcd_barrier_complete(bar, b.x, nloc, nx); b.st[0] = nloc; b.st[1] = nx; }
        const unsigned old = xb_add(&bar[XB_XSUB(b.x)], 1u);
        const unsigned gen = old / nloc;
        if (old + 1u == (gen + 1u) * nloc) {
            __builtin_amdgcn_fence(__ATOMIC_RELEASE, "agent");
            asm volatile("s_waitcnt vmcnt(0)" ::: "memory");
            const unsigned og = xb_add(&bar[XB_TOP], 1u);
            const unsigned tg = og / nx;
            if (og + 1u == (tg + 1u) * nx) xb_add(&bar[XB_TOPGEN], 1u);
            else XB_SPIN(xb_ld(&bar[XB_TOPGEN]) == tg, bar);
            __builtin_amdgcn_fence(__ATOMIC_ACQUIRE, "agent");
            xb_add(&bar[XB_XGEN(b.x)], 1u);
            asm volatile("s_waitcnt vmcnt(0)" ::: "memory");
        } else {
            XB_SPIN(xb_ld(&bar[XB_XGEN(b.x)]) == gen, bar);
            __builtin_amdgcn_fence(__ATOMIC_ACQUIRE, "agent");
            asm volatile("s_waitcnt vmcnt(0)" ::: "memory");
        }
    }
    __syncthreads();
}

constexpr int NWAVES = 8;
constexpr int D = 1024, TP = 16384, TS = 512, T = TP + TS, FF = 2816, NH = 8, KVR = 256, ROPE = 64, QRANK = 512, NQ = 1536, HD = 192;
constexpr int SEQ = 8192, DB = 128, DS = 4, PAGE = 128, NPG = 64, CKVW = 320;
constexpr int NCK = DB * SEQ;
constexpr float EPS = 1e-6f;
constexpr float QSCALE = 0.07216878364870322f * 1.4426950408889634f;
constexpr size_t OUT_Y = 0, OUT_CSP = 17301504, OUT_CSS = 17305600, OUT_LATP = 17567744, OUT_KPEP = 21762048, OUT_LATS = 22810624, OUT_KPES = 22941696, OUT_TOTAL = 22974464;
constexpr size_t MiB = 1u << 20;
constexpr size_t WS_CTL = 0, CTL_BYTES = 4 * MiB;
constexpr size_t WS_WGU0 = 4 * MiB, WS_WGU1 = 15 * MiB, WS_WGU2 = 26 * MiB, WS_WGU3 = 38 * MiB;
constexpr size_t WS_WDN0 = 49 * MiB, WS_WDN1 = 55 * MiB, WS_WDN2 = 61 * MiB, WS_WDN3 = 67 * MiB;
constexpr size_t WS_WCI = 73 * MiB, WS_WCO = 79 * MiB, WS_WDQ = 81 * MiB, WS_WUQ = 82 * MiB, WS_WO = 84 * MiB, WS_WUKV = 86 * MiB;
constexpr size_t WS_ROPE = 88 * MiB;
constexpr size_t WS_XB = 92 * MiB, WS_HB = 126 * MiB, WS_BB = 218 * MiB, WS_UB = 252 * MiB, WS_ZB = 286 * MiB, WS_CKV = 320 * MiB;
constexpr size_t WS_LATB = 342 * MiB, WS_KPEB = 352 * MiB, WS_KN = 356 * MiB, WS_VB = 390 * MiB, WS_CQB = 424 * MiB, WS_QB = 442 * MiB;
constexpr size_t WS_OB = 493 * MiB, WS_RPT = 527 * MiB, WS_RTS = 529 * MiB, WS_QS = 530 * MiB, WS_PO = 534 * MiB, WS_PML = 543 * MiB;
constexpr size_t WS_CLB = 544 * MiB, WS_CKB = 1056 * MiB, WS_RP = 1184 * MiB, WS_SLAB = 1248 * MiB;
constexpr size_t WS_CL8 = 1272 * MiB, WS_SC2 = 1528 * MiB, WS_W8 = 1532 * MiB, WS_T2 = 1533 * MiB;
constexpr size_t WS_A8 = 1534 * MiB, WS_SA = 1552 * MiB, WS_W8GU0 = 1553 * MiB, WS_W8GU_STRIDE = 6 * MiB, WS_TGU = 1577 * MiB, WS_WDKV = 1578 * MiB, WS_END = 1580 * MiB;
constexpr int SPLITK = 11;
constexpr int CW_BAR = 4096, CW_SLC = 8192, CW_SC = 8256;
constexpr int F_SSQX = 16384, F_SSQLAT = F_SSQX + 6 * T, F_SSQKPE = F_SSQX + 7 * T, F_SSQCQ = F_SSQX + 8 * T, F_SSQQ = F_SSQX + 9 * T;
static_assert((size_t)(F_SSQQ + 16 * T) * 4 <= CTL_BYTES, "ctl");
constexpr int RING_OFF = 0, RING_BYTES = 131072, MISC_OFF = 131072, QS_OFF = 131584, QS_STRIDE = 656, SCR_OFF = QS_OFF + 32 * QS_STRIDE, LDS_BYTES = 155648;
static_assert(SCR_OFF + 8 * 256 <= LDS_BYTES, "lds");

typedef unsigned short bf16_t;
typedef unsigned u32x2 __attribute__((ext_vector_type(2)));
typedef float f32x2 __attribute__((ext_vector_type(2)));
typedef __bf16 bf16x2_t __attribute__((ext_vector_type(2)));
__device__ __forceinline__ unsigned cvt_pk_bf16(float lo, float hi) { f32x2 v = {lo, hi}; bf16x2_t b = __builtin_convertvector(v, bf16x2_t); return __builtin_bit_cast(unsigned, b); }
__device__ __forceinline__ float bf2f(unsigned short h) { return __builtin_bit_cast(float, (unsigned)h << 16); }
__device__ __forceinline__ float bflo(unsigned w) { return __builtin_bit_cast(float, w << 16); }
__device__ __forceinline__ float bfhi(unsigned w) { return __builtin_bit_cast(float, w & 0xffff0000u); }
__device__ __forceinline__ v4u pack8f(const float* v) { v4u o; o.x = cvt_pk_bf16(v[0], v[1]); o.y = cvt_pk_bf16(v[2], v[3]); o.z = cvt_pk_bf16(v[4], v[5]); o.w = cvt_pk_bf16(v[6], v[7]); return o; }
__device__ __forceinline__ void unpack8f(v4u w, float* v) { v[0] = bflo(w.x); v[1] = bfhi(w.x); v[2] = bflo(w.y); v[3] = bfhi(w.y); v[4] = bflo(w.z); v[5] = bfhi(w.z); v[6] = bflo(w.w); v[7] = bfhi(w.w); }
__device__ __forceinline__ float fq_sum(float s) { s += __shfl_xor(s, 16); s += __shfl_xor(s, 32); return s; }
__device__ __forceinline__ float wave_sum(float v) {
#pragma unroll
    for (int o = 1; o < 64; o <<= 1) v += __shfl_xor(v, o);
    return v;
}
__device__ __forceinline__ float rsq(float x) { return 1.0f / sqrtf(x); }
__device__ __forceinline__ void atomic_addf(float* p, float v) { unsafeAtomicAdd(p, v); }

namespace epi {
using pg8::Unit; using pg8::f32x4; using pg8::BM; using pg8::HALF;
typedef f32x4 Acc[2][2][4][2];

struct Swiglu {
    static constexpr bool PERM = true, AFTER_DRAIN = false;
    bf16_t* HB; const float* ssq; float* ckv; float* ssq_lat; float* ssq_kpe; int ngu;
    __device__ __forceinline__ void operator()(const f32x4 (&acc)[2][2][4][2], const Unit& u, int wr, int wc, int fr, int fq) const {
        float sq8[2][4];
#pragma unroll
        for (int ai = 0; ai < 2; ++ai)
#pragma unroll
            for (int m = 0; m < 4; ++m) sq8[ai][m] = ssq[u.pm * BM + ai * HALF + wr * 64 + m * 16 + fr];
#pragma unroll
        for (int ai = 0; ai < 2; ++ai)
#pragma unroll
            for (int m = 0; m < 4; ++m) {
                const int row = u.pm * BM + ai * HALF + wr * 64 + m * 16 + fr;
                const float rs = rsq(sq8[ai][m] * (1.0f / D) + EPS);
                if (u.pn < ngu) {
                    float h[8];
#pragma unroll
                    for (int n = 0; n < 2; ++n)
#pragma unroll
                        for (int j = 0; j < 4; ++j) { const float g = acc[ai][0][m][n][j] * rs, up = acc[ai][1][m][n][j] * rs;
                            const float sg = g * __builtin_amdgcn_rcpf(1.0f + __builtin_amdgcn_exp2f(-1.4426950408889634f * g)); h[4 * n + j] = sg * up; }
                    *(v4u*)(HB + (size_t)row * FF + 128 * u.pn + 32 * wc + 8 * fq) = pack8f(h);
                } else if (u.pn == ngu) {
                    float ss = 0.f;
#pragma unroll
                    for (int bj = 0; bj < 2; ++bj)
#pragma unroll
                        for (int n = 0; n < 2; ++n) { const f32x4 v = acc[ai][bj][m][n] * rs; ss += (v[0] * v[0] + v[1] * v[1]) + (v[2] * v[2] + v[3] * v[3]);
                            *(f32x4*)(ckv + (size_t)row * CKVW + 128 * bj + 32 * wc + 8 * fq + 4 * n) = v; }
                    ss = fq_sum(ss); if (fq == 0) atomic_addf(ssq_lat + row, ss);
                } else {
                    if (wc < 2) { float ss = 0.f;
#pragma unroll
                        for (int n = 0; n < 2; ++n) { const f32x4 v = acc[ai][0][m][n] * rs; ss += (v[0] * v[0] + v[1] * v[1]) + (v[2] * v[2] + v[3] * v[3]);
                            *(f32x4*)(ckv + (size_t)row * CKVW + 256 + 32 * wc + 8 * fq + 4 * n) = v; }
                        ss = fq_sum(ss); if (fq == 0) atomic_addf(ssq_kpe + row, ss); }
                }
            }
    }
};
struct Swiglu8 {
    static constexpr bool PERM = true, AFTER_DRAIN = false;
    bf16_t* HB; const float* ssq; const float* sa; const float* tsc;
    __device__ __forceinline__ void operator()(const f32x4 (&acc)[2][2][4][2], const Unit& u, int wr, int wc, int fr, int fq) const {
        typedef int i32x4 __attribute__((ext_vector_type(4)));
        int fq_ = fq, fr_ = fr; asm volatile("" : "+v"(fq_), "+v"(fr_));
        float f8[2][4], s8[2][4]; f32x4 tg[2], tu[2];
#pragma unroll
        for (int ai = 0; ai < 2; ++ai)
#pragma unroll
            for (int m = 0; m < 4; ++m) { const int row = u.pm * BM + ai * HALF + wr * 64 + m * 16 + fr_; f8[ai][m] = ssq[row]; s8[ai][m] = sa[row]; }
#pragma unroll
        for (int n = 0; n < 2; ++n) { tg[n] = *(const f32x4*)(tsc + 256 * u.pn + 32 * wc + 8 * fq_ + 4 * n); tu[n] = *(const f32x4*)(tsc + 256 * u.pn + 128 + 32 * wc + 8 * fq_ + 4 * n); }
#pragma unroll
        for (int ai = 0; ai < 2; ++ai)
#pragma unroll
            for (int m = 0; m < 4; ++m) {
                const int row = u.pm * BM + ai * HALF + wr * 64 + m * 16 + fr;
                const float rs = rsq(f8[ai][m] * (1.0f / D) + EPS) * s8[ai][m];
                float h[8];
#pragma unroll
                for (int n = 0; n < 2; ++n) { const i32x4 ig = __builtin_bit_cast(i32x4, acc[ai][0][m][n]), iu = __builtin_bit_cast(i32x4, acc[ai][1][m][n]);
#pragma unroll
                    for (int j = 0; j < 4; ++j) { const float g = (float)ig[j] * (rs * tg[n][j]), up = (float)iu[j] * (rs * tu[n][j]);
                        const float sg = g * __builtin_amdgcn_rcpf(1.0f + __builtin_amdgcn_exp2f(-1.4426950408889634f * g)); h[4 * n + j] = sg * up; } }
                *(v4u*)(HB + (size_t)row * FF + 128 * u.pn + 32 * wc + 8 * fq) = pack8f(h);
            }
    }
};
struct Dkv {
    static constexpr bool PERM = true, AFTER_DRAIN = false;
    const float* ssq; float* ckv; float* ssq_lat; float* ssq_kpe;
    __device__ __forceinline__ void operator()(const f32x4 (&acc)[2][2][4][2], const Unit& u, int wr, int wc, int fr, int fq) const {
        float sq8[2][4];
#pragma unroll
        for (int ai = 0; ai < 2; ++ai)
#pragma unroll
            for (int m = 0; m < 4; ++m) sq8[ai][m] = ssq[u.pm * BM + ai * HALF + wr * 64 + m * 16 + fr];
#pragma unroll
        for (int ai = 0; ai < 2; ++ai)
#pragma unroll
            for (int m = 0; m < 4; ++m) {
                const int row = u.pm * BM + ai * HALF + wr * 64 + m * 16 + fr;
                const float rs = rsq(sq8[ai][m] * (1.0f / D) + EPS);
                if (u.pn == 0) {
                    float ss = 0.f;
#pragma unroll
                    for (int bj = 0; bj < 2; ++bj)
#pragma unroll
                        for (int n = 0; n < 2; ++n) { const f32x4 v = acc[ai][bj][m][n] * rs; ss += (v[0] * v[0] + v[1] * v[1]) + (v[2] * v[2] + v[3] * v[3]);
                            *(f32x4*)(ckv + (size_t)row * CKVW + 128 * bj + 32 * wc + 8 * fq + 4 * n) = v; }
                    ss = fq_sum(ss); if (fq == 0) atomic_addf(ssq_lat + row, ss);
                } else if (wc < 2) { float ss = 0.f;
#pragma unroll
                    for (int n = 0; n < 2; ++n) { const f32x4 v = acc[ai][0][m][n] * rs; ss += (v[0] * v[0] + v[1] * v[1]) + (v[2] * v[2] + v[3] * v[3]);
                        *(f32x4*)(ckv + (size_t)row * CKVW + 256 + 32 * wc + 8 * fq + 4 * n) = v; }
                    ss = fq_sum(ss); if (fq == 0) atomic_addf(ssq_kpe + row, ss); }
            }
    }
};
template <bool FINAL>
struct ResidT {
    static constexpr bool PERM = true, AFTER_DRAIN = false;
    bf16_t* XB; float* P; float alpha;
    __device__ __forceinline__ void operator()(const f32x4 (&acc)[2][2][4][2], const Unit& u, int wr, int wc, int fr, int fq) const {
        v4u xv[2][4][2];
#pragma unroll
        for (int ai = 0; ai < 2; ++ai)
#pragma unroll
            for (int m = 0; m < 4; ++m) { const bf16_t* xp = XB + (size_t)(u.pm * BM + ai * HALF + wr * 64 + m * 16 + fr) * D + 256 * u.pn + 32 * wc + 8 * fq;
#pragma unroll
                for (int bj = 0; bj < 2; ++bj) xv[ai][m][bj] = *(const v4u*)(xp + 128 * bj); }
#pragma unroll
        for (int ai = 0; ai < 2; ++ai)
#pragma unroll
            for (int m = 0; m < 4; ++m) { const int row = u.pm * BM + ai * HALF + wr * 64 + m * 16 + fr;
                const size_t off = (size_t)row * D + 256 * u.pn + 32 * wc + 8 * fq; float ss = 0.f;
#pragma unroll
                for (int bj = 0; bj < 2; ++bj) { const v4u xw = xv[ai][m][bj];
                    const f32x4 v0 = (f32x4){bflo(xw.x), bfhi(xw.x), bflo(xw.y), bfhi(xw.y)} + acc[ai][bj][m][0] * alpha, v1 = (f32x4){bflo(xw.z), bfhi(xw.z), bflo(xw.w), bfhi(xw.w)} + acc[ai][bj][m][1] * alpha;
                    if constexpr (FINAL) { float* yp = P + off + 128 * bj; *(f32x4*)yp = v0; *(f32x4*)(yp + 4) = v1; }
                    else { ss += (v0[0] * v0[0] + v0[1] * v0[1]) + (v0[2] * v0[2] + v0[3] * v0[3]) + (v1[0] * v1[0] + v1[1] * v1[1]) + (v1[2] * v1[2] + v1[3] * v1[3]);
                        v4u w; w.x = cvt_pk_bf16(v0[0], v0[1]); w.y = cvt_pk_bf16(v0[2], v0[3]); w.z = cvt_pk_bf16(v1[0], v1[1]); w.w = cvt_pk_bf16(v1[2], v1[3]); *(v4u*)(XB + off + 128 * bj) = w; } }
                if constexpr (!FINAL) { ss = fq_sum(ss); if (fq == 0) atomic_addf(P + row, ss); } }
    }
};
using Resid = ResidT<false>;
using ResidY = ResidT<true>;
struct ConvIn {
    static constexpr bool PERM = true, AFTER_DRAIN = false;
    bf16_t* BB; bf16_t* UB; const float* ssq; float* csp; float* css;
    __device__ __forceinline__ void operator()(const f32x4 (&acc)[2][2][4][2], const Unit& u, int wr, int wc, int fr, int fq) const {
        float sq8[2][4];
#pragma unroll
        for (int ai = 0; ai < 2; ++ai)
#pragma unroll
            for (int m = 0; m < 4; ++m) sq8[ai][m] = ssq[u.pm * BM + ai * HALF + wr * 64 + m * 16 + fr];
#pragma unroll
        for (int ai = 0; ai < 2; ++ai)
#pragma unroll
            for (int m = 0; m < 4; ++m) {
                const int row = u.pm * BM + ai * HALF + wr * 64 + m * 16 + fr;
                const float rs = rsq(sq8[ai][m] * (1.0f / D) + EPS);
                if (u.pn < 4) {
#pragma unroll
                    for (int bj = 0; bj < 2; ++bj) { const f32x4 v0 = acc[ai][bj][m][0] * rs, v1 = acc[ai][bj][m][1] * rs;
                        v4u w; w.x = cvt_pk_bf16(v0[0], v0[1]); w.y = cvt_pk_bf16(v0[2], v0[3]); w.z = cvt_pk_bf16(v1[0], v1[1]); w.w = cvt_pk_bf16(v1[2], v1[3]);
                        *(v4u*)(BB + (size_t)row * D + 256 * u.pn + 128 * bj + 32 * wc + 8 * fq) = w; }
                } else {
                    const int ch0 = 128 * (u.pn - 4) + 32 * wc + 8 * fq;
                    const f32x4 u0 = (acc[ai][0][m][0] * rs) * (acc[ai][1][m][0] * rs), u1 = (acc[ai][0][m][1] * rs) * (acc[ai][1][m][1] * rs);
                    v4u w; w.x = cvt_pk_bf16(u0[0], u0[1]); w.y = cvt_pk_bf16(u0[2], u0[3]); w.z = cvt_pk_bf16(u1[0], u1[1]); w.w = cvt_pk_bf16(u1[2], u1[3]);
                    *(v4u*)(UB + (size_t)row * D + ch0) = w;
                    float* dst = nullptr;
                    if (row < TP) { const int t = row & (SEQ - 1); if (t >= SEQ - 2) dst = csp + (size_t)((row >> 13) * 2 + (t - (SEQ - 2))) * D + ch0; }
                    else { const int rs_ = row - TP, i = rs_ & 3; if (i >= 2) dst = css + (size_t)((rs_ >> 2) * 2 + (i - 2)) * D + ch0; }
                    if (dst) { *(f32x4*)dst = u0; *(f32x4*)(dst + 4) = u1; }
                }
            }
    }
};
struct Dq {
    static constexpr bool PERM = true, AFTER_DRAIN = false;
    bf16_t* CQB; const float* ssq; float* ssq_out;
    __device__ __forceinline__ void operator()(const f32x4 (&acc)[2][2][4][2], const Unit& u, int wr, int wc, int fr, int fq) const {
        float sq8[2][4];
#pragma unroll
        for (int ai = 0; ai < 2; ++ai)
#pragma unroll
            for (int m = 0; m < 4; ++m) sq8[ai][m] = ssq[u.pm * BM + ai * HALF + wr * 64 + m * 16 + fr];
#pragma unroll
        for (int ai = 0; ai < 2; ++ai)
#pragma unroll
            for (int m = 0; m < 4; ++m) {
                const int row = u.pm * BM + ai * HALF + wr * 64 + m * 16 + fr;
                const float rs = rsq(sq8[ai][m] * (1.0f / D) + EPS);
                float ss = 0.f;
#pragma unroll
                for (int bj = 0; bj < 2; ++bj) { const f32x4 v0 = acc[ai][bj][m][0] * rs, v1 = acc[ai][bj][m][1] * rs;
                    ss += (v0[0] * v0[0] + v0[1] * v0[1]) + (v0[2] * v0[2] + v0[3] * v0[3]) + (v1[0] * v1[0] + v1[1] * v1[1]) + (v1[2] * v1[2] + v1[3] * v1[3]);
                    v4u w; w.x = cvt_pk_bf16(v0[0], v0[1]); w.y = cvt_pk_bf16(v0[2], v0[3]); w.z = cvt_pk_bf16(v1[0], v1[1]); w.w = cvt_pk_bf16(v1[2], v1[3]);
                    *(v4u*)(CQB + (size_t)row * QRANK + 256 * u.pn + 128 * bj + 32 * wc + 8 * fq) = w; }
                ss = fq_sum(ss); if (fq == 0) atomic_addf(ssq_out + row, ss);
            }
    }
};
struct Uq {
    static constexpr bool PERM = true, AFTER_DRAIN = false;
    bf16_t* QB; const float* ssq; float* ssq_q;
    __device__ __forceinline__ void operator()(const f32x4 (&acc)[2][2][4][2], const Unit& u, int wr, int wc, int fr, int fq) const {
        float sq8[2][4];
#pragma unroll
        for (int ai = 0; ai < 2; ++ai)
#pragma unroll
            for (int m = 0; m < 4; ++m) sq8[ai][m] = ssq[u.pm * BM + ai * HALF + wr * 64 + m * 16 + fr];
#pragma unroll
        for (int ai = 0; ai < 2; ++ai)
#pragma unroll
            for (int m = 0; m < 4; ++m) {
                const int row = u.pm * BM + ai * HALF + wr * 64 + m * 16 + fr;
                const float rs = rsq(sq8[ai][m] * (1.0f / QRANK) + EPS);
#pragma unroll
                for (int bj = 0; bj < 2; ++bj) { const f32x4 v0 = acc[ai][bj][m][0] * rs, v1 = acc[ai][bj][m][1] * rs;
                    float ss = (v0[0] * v0[0] + v0[1] * v0[1]) + (v0[2] * v0[2] + v0[3] * v0[3]) + (v1[0] * v1[0] + v1[1] * v1[1]) + (v1[2] * v1[2] + v1[3] * v1[3]);
                    const int cb = 256 * u.pn + 128 * bj + 32 * wc;
                    const int hh = cb / HD, seg = 2 * hh + ((cb - hh * HD) >= 128 ? 1 : 0);
                    v4u w; w.x = cvt_pk_bf16(v0[0], v0[1]); w.y = cvt_pk_bf16(v0[2], v0[3]); w.z = cvt_pk_bf16(v1[0], v1[1]); w.w = cvt_pk_bf16(v1[2], v1[3]);
                    *(v4u*)(QB + (size_t)row * NQ + cb + 8 * fq) = w;
                    ss = fq_sum(ss); if (fq == 0) atomic_addf(ssq_q + (size_t)seg * T + row, ss); }
            }
    }
};
struct Kv {
    static constexpr bool PERM = true, AFTER_DRAIN = false;
    bf16_t* KU; bf16_t* VB; float* RP; size_t nrows;
    __device__ __forceinline__ void operator()(const f32x4 (&acc)[2][2][4][2], const Unit& u, int wr, int wc, int fr, int fq) const {
#pragma unroll
        for (int ai = 0; ai < 2; ++ai)
#pragma unroll
            for (int m = 0; m < 4; ++m) {
                const unsigned row = (unsigned)(u.pm * BM + ai * HALF + wr * 64 + m * 16 + fr);
                if (u.pn < 4) {
                    const int head = 2 * u.pn + (wc >> 1);
                    float ss = 0.f;
#pragma unroll
                    for (int bj = 0; bj < 2; ++bj) { const f32x4 v0 = acc[ai][bj][m][0], v1 = acc[ai][bj][m][1];
                        ss += (v0[0] * v0[0] + v0[1] * v0[1]) + (v0[2] * v0[2] + v0[3] * v0[3]) + (v1[0] * v1[0] + v1[1] * v1[1]) + (v1[2] * v1[2] + v1[3] * v1[3]);
                        if (KU) { v4u w; w.x = cvt_pk_bf16(v0[0], v0[1]); w.y = cvt_pk_bf16(v0[2], v0[3]); w.z = cvt_pk_bf16(v1[0], v1[1]); w.w = cvt_pk_bf16(v1[2], v1[3]);
                            *(v4u*)(KU + (size_t)(row * D + 128 * head + 64 * (wc & 1) + 32 * bj + 8 * fq)) = w; } }
                    ss = fq_sum(ss); if (fq == 0) RP[(size_t)((unsigned)(2 * head + (wc & 1)) * (unsigned)nrows + row)] = ss;
                } else if (VB) {
#pragma unroll
                    for (int bj = 0; bj < 2; ++bj) { const f32x4 v0 = acc[ai][bj][m][0], v1 = acc[ai][bj][m][1];
                        v4u w; w.x = cvt_pk_bf16(v0[0], v0[1]); w.y = cvt_pk_bf16(v0[2], v0[3]); w.z = cvt_pk_bf16(v1[0], v1[1]); w.w = cvt_pk_bf16(v1[2], v1[3]);
                        *(v4u*)(VB + (size_t)(row * D + 256 * (u.pn - 4) + 128 * bj + 32 * wc + 8 * fq)) = w; }
                }
            }
    }
};
struct Kv8 {
    static constexpr bool PERM = true, AFTER_DRAIN = false;
    float* RP; const float* sc2; const LAS float* t2; size_t nrows;
    __device__ __forceinline__ void operator()(const f32x4 (&acc)[2][2][4][2], const Unit& u, int wr, int wc, int fr, int fq) const {
        typedef int i32x4 __attribute__((ext_vector_type(4)));
        const int head = 2 * u.pn + (wc >> 1);
        int fq_ = fq; asm volatile("" : "+v"(fq_));
        float ss[2][4];
#pragma unroll
        for (int ai = 0; ai < 2; ++ai)
#pragma unroll
            for (int m = 0; m < 4; ++m) ss[ai][m] = 0.f;
#pragma unroll
        for (int bj = 0; bj < 2; ++bj)
#pragma unroll
            for (int n = 0; n < 2; ++n) { const f32x4 tv = *(const LAS f32x4*)(t2 + 256 * u.pn + 128 * bj + 32 * wc + 8 * fq_ + 4 * n);
#pragma unroll
                for (int ai = 0; ai < 2; ++ai)
#pragma unroll
                    for (int m = 0; m < 4; ++m) { const i32x4 vi = __builtin_bit_cast(i32x4, acc[ai][bj][m][n]);
#pragma unroll
                        for (int j = 0; j < 4; ++j) { const float f = (float)vi[j]; ss[ai][m] += f * f * tv[j]; } } }
#pragma unroll
        for (int ai = 0; ai < 2; ++ai)
#pragma unroll
            for (int m = 0; m < 4; ++m) {
                const unsigned row = (unsigned)(u.pm * BM + ai * HALF + wr * 64 + m * 16 + fr);
                const float s_ = fq_sum(ss[ai][m]); if (fq == 0) RP[(size_t)((unsigned)(2 * head + (wc & 1)) * (unsigned)nrows + row)] = s_;
            }
    }
};
struct Slab {
    static constexpr bool PERM = true, AFTER_DRAIN = false;
    float* slab;
    __device__ __forceinline__ void operator()(const f32x4 (&acc)[2][2][4][2], const Unit& u, int wr, int wc, int fr, int fq) const {
        float* base = slab + (size_t)(u.ko >> 9) * TS * D;
#pragma unroll
        for (int ai = 0; ai < 2; ++ai)
#pragma unroll
            for (int m = 0; m < 4; ++m) { float* p = base + (size_t)(u.pm * BM + ai * HALF + wr * 64 + m * 16 + fr) * D + 256 * u.pn + 32 * wc + 8 * fq;
#pragma unroll
                for (int bj = 0; bj < 2; ++bj) { *(f32x4*)(p + 128 * bj) = acc[ai][bj][m][0]; *(f32x4*)(p + 128 * bj + 4) = acc[ai][bj][m][1]; } }
    }
};
}

struct Ctx {
    LAS unsigned char* lds;
    int tid, lane, wave, vcu, G;
};
struct PrepD { const float* W; const float* gain; bf16_t* WT; int K, N, drow0, k0, n0; };
__device__ __forceinline__ void prep_load(const PrepD& d, f32x4 (&v)[8], float (&gk)[8], int lane) {
    if (!d.W) return;
    const int r = lane >> 3, c4 = lane & 7;
#pragma unroll
    for (int i = 0; i < 8; ++i) { v[i] = *(const f32x4*)(d.W + (size_t)(d.k0 + 8 * i + r) * d.N + d.n0 + 4 * c4); gk[i] = d.gain ? d.gain[d.k0 + 8 * i + r] : 1.0f; }
}
__device__ __forceinline__ void prep_finish(const PrepD& d, const f32x4 (&v)[8], const float (&gk)[8], LAS float* scr, int lane) {
    if (!d.W) { const v4u z = {0u, 0u, 0u, 0u};
#pragma unroll
        for (int j = 0; j < 2; ++j) *(v4u*)(d.WT + 8 * (lane + 64 * j)) = z;
        return; }
    { const int r = lane >> 3, c4 = lane & 7;
#pragma unroll
      for (int i = 0; i < 8; ++i) { LAS float* sp = scr + (8 * i + r) * 33 + 4 * c4; sp[0] = v[i].x * gk[i]; sp[1] = v[i].y * gk[i]; sp[2] = v[i].z * gk[i]; sp[3] = v[i].w * gk[i]; } }
    LDS_WAIT(); asm volatile("" ::: "memory");
    const int c = lane & 7;
#pragma unroll
    for (int j = 0; j < 4; ++j) { const int n = (lane >> 3) + 8 * j; const LAS float* s = scr + (8 * c) * 33 + n;
        v4u o; o.x = cvt_pk_bf16(s[0 * 33], s[1 * 33]); o.y = cvt_pk_bf16(s[2 * 33], s[3 * 33]); o.z = cvt_pk_bf16(s[4 * 33], s[5 * 33]); o.w = cvt_pk_bf16(s[6 * 33], s[7 * 33]);
        *(v4u*)(d.WT + (size_t)(d.drow0 + n) * d.K + d.k0 + 8 * c) = o; }
    LDS_WAIT(); asm volatile("" ::: "memory");
}
__device__ __forceinline__ int gu_map(int nb) { const int up = nb >= 88 ? 1 : 0, hb = nb - 88 * up; return 256 * (hb >> 2) + 128 * up + 32 * (hb & 3); }
__device__ __forceinline__ int ci_map(int nb) { if (nb < 32) return 32 * nb; const int hh = nb >= 64 ? 1 : 0, cb = nb - 32 - 32 * hh; return 256 * (4 + (cb >> 2)) + 128 * hh + 32 * (cb & 3); }
__device__ __forceinline__ int uk_map(int nb) { const int h = nb >> 2, dq = nb & 3; return 256 * (h >> 1) + 128 * (dq & 1) + 32 * (2 * (h & 1) + (dq >> 1)); }
__device__ __forceinline__ int uk_row(int h, int d) { return 256 * (h >> 1) + 128 * ((d >> 5) & 1) + 32 * (2 * (h & 1) + (d >> 6)) + (d & 31); }

struct Ptrs {
    const float* in[29]; float* out; unsigned char* ws;
};
typedef const __attribute__((address_space(4))) Ptrs CPtrs;

__device__ __forceinline__ void phase_prologue(const Ctx& C, CPtrs& P) {
    unsigned char* ws = P.ws;
    LAS float* scr = (LAS float*)(C.lds + RING_OFF + C.wave * 16384);
    const int lane = C.lane;
    const int gw = C.vcu * NWAVES + C.wave, NGW = C.G * NWAVES;
    constexpr int I_GU = 16 * 176, I_DKV = 16 * 10, I_DN = 44 * 32, I_CI = 16 * 96, I_SQ = 16 * 32, I_DQ = 16 * 16, I_UQ = 8 * 48, I_UKV = 4 * 32, I_Z = 192;
    constexpr int NITEMS = I_DKV + 4 * I_DN + I_CI + I_SQ + I_DQ + I_UQ + I_SQ + 2 * I_UKV + I_Z;
    auto decode = [&](int it) -> PrepD {
        int r = it;
        if (r < I_DKV) { const int kb = r / 10, nb = r % 10; return PrepD{P.in[23], P.in[22], (bf16_t*)(ws + WS_WDKV), D, CKVW, 32 * nb, 64 * (kb), 32 * (nb)}; } r -= I_DKV;
        if (r < 4 * I_DN) { const int mi = r / I_DN; r -= mi * I_DN; const int kb = r / 32, nb = r % 32;
            const float* W = (mi & 1 ? P.in[12] : P.in[8]) + (size_t)(mi >> 1) * FF * D;
            bf16_t* dst = (bf16_t*)(ws + (mi == 0 ? WS_WDN0 : mi == 1 ? WS_WDN1 : mi == 2 ? WS_WDN2 : WS_WDN3));
            return PrepD{W, nullptr, dst, FF, D, 32 * nb, 64 * (kb), 32 * (nb)}; } r -= 4 * I_DN;
        if (r < I_CI) { const int kb = r / 96, nb = r % 96; return PrepD{P.in[13], P.in[9], (bf16_t*)(ws + WS_WCI), D, 3 * D, ci_map(nb), 64 * (kb), 32 * (nb)}; } r -= I_CI;
        if (r < I_SQ) { const int kb = r / 32, nb = r % 32; return PrepD{P.in[15], nullptr, (bf16_t*)(ws + WS_WCO), D, D, 32 * nb, 64 * (kb), 32 * (nb)}; } r -= I_SQ;
        if (r < I_DQ) { const int kb = r / 16, nb = r % 16; return PrepD{P.in[16], P.in[9] + D, (bf16_t*)(ws + WS_WDQ), D, QRANK, 32 * nb, 64 * (kb), 32 * (nb)}; } r -= I_DQ;
        if (r < I_UQ) { const int kb = r / 48, nb = r % 48; return PrepD{P.in[18], P.in[17], (bf16_t*)(ws + WS_WUQ), QRANK, NQ, 32 * nb, 64 * (kb), 32 * (nb)}; } r -= I_UQ;
        if (r < I_SQ) { const int kb = r / 32, nb = r % 32; return PrepD{P.in[21], nullptr, (bf16_t*)(ws + WS_WO), D, D, 32 * nb, 64 * (kb), 32 * (nb)}; } r -= I_SQ;
        if (r < I_UKV) { const int kb = r / 32, nb = r % 32; return PrepD{P.in[26], nullptr, (bf16_t*)(ws + WS_WUKV), KVR, D, uk_map(nb), 64 * (kb), 32 * (nb)}; } r -= I_UKV;
        if (r < I_UKV) { const int kb = r / 32, nb = r % 32; return PrepD{P.in[27], nullptr, (bf16_t*)(ws + WS_WUKV), KVR, D, 1024 + 32 * nb, 64 * (kb), 32 * (nb)}; } r -= I_UKV;
        return PrepD{nullptr, nullptr, (bf16_t*)(ws + WS_WDKV) + (size_t)(320 + r) * D, 0, 0, 0, 0, 0};
    };
    if (gw < NITEMS) {
        PrepD cur = decode(gw); f32x4 v[8]; float gk[8]; prep_load(cur, v, gk, lane);
        for (int it = gw; it < NITEMS; it += NGW) {
            PrepD nxt = cur; f32x4 vn[8]; float gn[8];
            if (it + NGW < NITEMS) { nxt = decode(it + NGW); prep_load(nxt, vn, gn, lane); }
            prep_finish(cur, v, gk, scr, lane);
            cur = nxt;
#pragma unroll
            for (int i = 0; i < 8; ++i) { v[i] = vn[i]; gk[i] = gn[i]; }
        }
    }
    {
        f32x2* tab = (f32x2*)(ws + WS_ROPE);
        for (int e = gw * 64 + lane; e < (SEQ + DS) * 32; e += NGW * 64) {
            const int pos = e >> 5, j = e & 31;
            double f = 1.0; for (int i = 0; i < j; ++i) f *= 0.74989420933245582730;
            const double ang = (double)pos * f;
            const double k = __builtin_rint(ang * 0.15915494309189533577);
            double r = __builtin_fma(-k, 6.283185307179586232, ang); r = __builtin_fma(-k, 2.4492935982947064e-16, r);
            const double r2 = r * r; double ts = 1.0, tc = 1.0, ss = 1.0, cs = 1.0;
#pragma unroll
            for (int q = 1; q <= 14; ++q) { tc *= -r2 / (double)((2 * q - 1) * (2 * q)); cs += tc; ts *= -r2 / (double)((2 * q) * (2 * q + 1)); ss += ts; }
            tab[e] = (f32x2){(float)cs, (float)(ss * r)};
        }
    }
    {
        bf16_t* XB = (bf16_t*)(ws + WS_XB); float* ssq = (float*)(ws + WS_CTL) + F_SSQX; unsigned char* A8 = ws + WS_A8; float* SA = (float*)(ws + WS_SA);
        for (int row0 = gw; row0 < T; row0 += 2 * NGW) {
            f32x4 v[2][4]; float s[2]; const int nr = row0 + NGW < T ? 2 : 1;
#pragma unroll
            for (int q = 0; q < 2; ++q) { const int row = row0 + (q < nr ? q * NGW : 0); const float* src = row < TP ? P.in[0] + (size_t)row * D : P.in[1] + (size_t)(row - TP) * D;
#pragma unroll
                for (int j = 0; j < 4; ++j) v[q][j] = *((const f32x4*)src + lane + 64 * j); }
#pragma unroll
            for (int q = 0; q < 2; ++q) { s[q] = 0.f;
#pragma unroll
                for (int j = 0; j < 4; ++j) s[q] += (v[q][j].x * v[q][j].x + v[q][j].y * v[q][j].y) + (v[q][j].z * v[q][j].z + v[q][j].w * v[q][j].w);
                s[q] = wave_sum(s[q]); }
#pragma unroll
            for (int q = 0; q < 2; ++q) if (q < nr) { const int row = row0 + q * NGW;
#pragma unroll
                for (int j = 0; j < 4; ++j) {
                    u32x2 w; w.x = cvt_pk_bf16(v[q][j].x, v[q][j].y); w.y = cvt_pk_bf16(v[q][j].z, v[q][j].w); *((u32x2*)(XB + (size_t)row * D) + lane + 64 * j) = w; }
                if (lane == 0) ssq[row] = s[q];
                float am = 0.f;
#pragma unroll
                for (int j = 0; j < 4; ++j) am = fmaxf(am, fmaxf(fmaxf(fabsf(v[q][j].x), fabsf(v[q][j].y)), fmaxf(fabsf(v[q][j].z), fabsf(v[q][j].w))));
#pragma unroll
                for (int o = 1; o < 64; o <<= 1) am = fmaxf(am, __shfl_xor(am, o));
                const float inv = am > 0.f ? 127.0f / am : 0.f;
#pragma unroll
                for (int j = 0; j < 4; ++j) { const int q0 = __float2int_rn(v[q][j].x * inv), q1 = __float2int_rn(v[q][j].y * inv), q2 = __float2int_rn(v[q][j].z * inv), q3 = __float2int_rn(v[q][j].w * inv);
                    *(unsigned*)(A8 + (size_t)row * D + 4 * (lane + 64 * j)) = (unsigned)(q0 & 255) | ((unsigned)(q1 & 255) << 8) | ((unsigned)(q2 & 255) << 16) | ((unsigned)q3 << 24); }
                if (lane == 0) SA[row] = am * (1.0f / 127.0f); }
        }
    }
}

#ifndef SA_INT8_COPY_ONLY
#define SA_INT8_COPY_ONLY 1
#endif
__device__ __forceinline__ void phase_cacheconv(const Ctx& C, CPtrs& P, int cw, int nconv) {
    unsigned char* ws = P.ws; const int lane = C.lane;
    const int* pt = (const int*)P.in[5]; bf16_t* CLB = (bf16_t*)(ws + WS_CLB); unsigned char* CL8 = ws + WS_CL8; float* SC2 = (float*)(ws + WS_SC2);
    for (int pg = cw * NWAVES + C.wave; pg < DB * NPG; pg += nconv * NWAVES) {
        const int phys = pt[pg];
        const float* sl = P.in[2] + (size_t)phys * PAGE * KVR; bf16_t* dl = CLB + (size_t)pg * PAGE * KVR;
        for (int i0 = 0; i0 < 64; i0 += 8) {
            f32x4 a[8], c[8];
#pragma unroll
            for (int j = 0; j < 8; ++j) { a[j] = *((const f32x4*)sl + 2 * (lane + 64 * (i0 + j))); c[j] = *((const f32x4*)sl + 2 * (lane + 64 * (i0 + j)) + 1); }
#pragma unroll
            for (int j = 0; j < 8; ++j) {
#if !SA_INT8_COPY_ONLY
                { v4u w; w.x = cvt_pk_bf16(a[j].x, a[j].y); w.y = cvt_pk_bf16(a[j].z, a[j].w); w.z = cvt_pk_bf16(c[j].x, c[j].y); w.w = cvt_pk_bf16(c[j].z, c[j].w); *((v4u*)dl + lane + 64 * (i0 + j)) = w; }
#endif
                float am = fmaxf(fmaxf(fmaxf(fabsf(a[j].x), fabsf(a[j].y)), fmaxf(fabsf(a[j].z), fabsf(a[j].w))), fmaxf(fmaxf(fabsf(c[j].x), fabsf(c[j].y)), fmaxf(fabsf(c[j].z), fabsf(c[j].w))));
#pragma unroll
                for (int o = 1; o < 32; o <<= 1) am = fmaxf(am, __shfl_xor(am, o));
                const float inv = am > 0.f ? 127.0f / am : 0.f;
                const int q0 = __float2int_rn(a[j].x * inv), q1 = __float2int_rn(a[j].y * inv), q2 = __float2int_rn(a[j].z * inv), q3 = __float2int_rn(a[j].w * inv);
                const int q4 = __float2int_rn(c[j].x * inv), q5 = __float2int_rn(c[j].y * inv), q6 = __float2int_rn(c[j].z * inv), q7 = __float2int_rn(c[j].w * inv);
                u32x2 qw; qw.x = (unsigned)(q0 & 255) | ((unsigned)(q1 & 255) << 8) | ((unsigned)(q2 & 255) << 16) | ((unsigned)q3 << 24);
                qw.y = (unsigned)(q4 & 255) | ((unsigned)(q5 & 255) << 8) | ((unsigned)(q6 & 255) << 16) | ((unsigned)q7 << 24);
                const size_t row = (size_t)pg * PAGE + 2 * (i0 + j) + (lane >> 5);
                *(u32x2*)(CL8 + row * KVR + 8 * (lane & 31)) = qw;
                if ((lane & 31) == 0) { const float sc = am * (1.0f / 127.0f); SC2[row] = sc * sc; } }
        }
    }
}

__device__ __forceinline__ void phase_w8(const Ctx& C, CPtrs& P) {
    unsigned char* ws = P.ws; const float* wuk = P.in[26]; unsigned char* W8 = ws + WS_W8; float* T2 = (float*)(ws + WS_T2); const int lane = C.lane;
    for (int r = C.vcu * NWAVES + C.wave; r < D; r += C.G * NWAVES) {
        const int pn = r >> 8, bj = (r >> 7) & 1, wc = (r >> 5) & 3, h = 2 * pn + (wc >> 1), d = 64 * (wc & 1) + 32 * bj + (r & 31), col = 128 * h + d;
        float x[4]; float am = 0.f;
#pragma unroll
        for (int e = 0; e < 4; ++e) { x[e] = wuk[(size_t)(4 * lane + e) * D + col]; am = fmaxf(am, fabsf(x[e])); }
#pragma unroll
        for (int o = 1; o < 64; o <<= 1) am = fmaxf(am, __shfl_xor(am, o));
        const float inv = am > 0.f ? 127.0f / am : 0.f;
        const int q0 = __float2int_rn(x[0] * inv), q1 = __float2int_rn(x[1] * inv), q2 = __float2int_rn(x[2] * inv), q3 = __float2int_rn(x[3] * inv);
        *(unsigned*)(W8 + (size_t)r * KVR + 4 * lane) = (unsigned)(q0 & 255) | ((unsigned)(q1 & 255) << 8) | ((unsigned)(q2 & 255) << 16) | ((unsigned)q3 << 24);
        if (lane == 0) { const float sc = am * (1.0f / 127.0f); T2[r] = sc * sc; }
    }
}

__device__ __forceinline__ void phase_quant(const Ctx& C, CPtrs& P, const float* slab = nullptr, int ns = 0, float* ssq_out = nullptr) {
    unsigned char* ws = P.ws; bf16_t* XB = (bf16_t*)(ws + WS_XB); unsigned char* A8 = ws + WS_A8; float* SA = (float*)(ws + WS_SA);
    const int gw = C.vcu * NWAVES + C.wave, NGW = C.G * NWAVES, lane = C.lane;
    if (slab) {
        for (int r = gw; r < TS; r += NGW) { const size_t row = (size_t)TP + r; f32x4 v[4]; float ss = 0.f, am = 0.f;
#pragma unroll
            for (int j = 0; j < 4; ++j) { const u32x2 xw = *((const u32x2*)(XB + row * D) + lane + 64 * j); f32x4 a = {bflo(xw.x), bfhi(xw.x), bflo(xw.y), bfhi(xw.y)};
                for (int c = 0; c < ns; ++c) a += *((const f32x4*)(slab + ((size_t)c * TS + r) * D) + lane + 64 * j);
                v[j] = a; ss += (a.x * a.x + a.y * a.y) + (a.z * a.z + a.w * a.w); am = fmaxf(am, fmaxf(fmaxf(fabsf(a.x), fabsf(a.y)), fmaxf(fabsf(a.z), fabsf(a.w)))); }
            ss = wave_sum(ss);
#pragma unroll
            for (int o = 1; o < 64; o <<= 1) am = fmaxf(am, __shfl_xor(am, o));
            const float inv = am > 0.f ? 127.0f / am : 0.f;
#pragma unroll
            for (int j = 0; j < 4; ++j) { u32x2 w; w.x = cvt_pk_bf16(v[j].x, v[j].y); w.y = cvt_pk_bf16(v[j].z, v[j].w); *((u32x2*)(XB + row * D) + lane + 64 * j) = w;
                const int q0 = __float2int_rn(v[j].x * inv), q1 = __float2int_rn(v[j].y * inv), q2 = __float2int_rn(v[j].z * inv), q3 = __float2int_rn(v[j].w * inv);
                *(unsigned*)(A8 + row * D + 4 * (lane + 64 * j)) = (unsigned)(q0 & 255) | ((unsigned)(q1 & 255) << 8) | ((unsigned)(q2 & 255) << 16) | ((unsigned)q3 << 24); }
            if (lane == 0) { ssq_out[row] = ss; SA[row] = am * (1.0f / 127.0f); } }
    }
    const int TQ = slab ? TP : T;
    constexpr int RPS = 4;
    for (int row0 = gw; row0 < TQ; row0 += RPS * NGW) {
        v4u w[RPS][2];
#pragma unroll
        for (int q = 0; q < RPS; ++q) { const int rq = row0 + q * NGW, row = rq < TQ ? rq : row0; w[q][0] = *((const v4u*)(XB + (size_t)row * D) + 2 * lane); w[q][1] = *((const v4u*)(XB + (size_t)row * D) + 2 * lane + 1); }
#pragma unroll
        for (int q = 0; q < RPS; ++q) if (row0 + q * NGW < TQ) { const int row = row0 + q * NGW; float x[16]; unpack8f(w[q][0], x); unpack8f(w[q][1], x + 8);
            float am = 0.f;
#pragma unroll
            for (int e = 0; e < 16; ++e) am = fmaxf(am, fabsf(x[e]));
#pragma unroll
            for (int o = 1; o < 64; o <<= 1) am = fmaxf(am, __shfl_xor(am, o));
            const float inv = am > 0.f ? 127.0f / am : 0.f; v4u o4; unsigned ww[4];
#pragma unroll
            for (int g = 0; g < 4; ++g) { const int q0 = __float2int_rn(x[4 * g] * inv), q1 = __float2int_rn(x[4 * g + 1] * inv), q2 = __float2int_rn(x[4 * g + 2] * inv), q3 = __float2int_rn(x[4 * g + 3] * inv);
                ww[g] = (unsigned)(q0 & 255) | ((unsigned)(q1 & 255) << 8) | ((unsigned)(q2 & 255) << 16) | ((unsigned)q3 << 24); }
            o4.x = ww[0]; o4.y = ww[1]; o4.z = ww[2]; o4.w = ww[3];
            *((v4u*)(A8 + (size_t)row * D) + lane) = o4;
            if (lane == 0) SA[row] = am * (1.0f / 127.0f); }
    }
}
__device__ __forceinline__ void phase_w8gu(const Ctx& C, CPtrs& P) {
    unsigned char* ws = P.ws; const int lane = C.lane, r = lane >> 3, c4 = lane & 7;
    LAS float* scr = (LAS float*)(C.lds + RING_OFF + C.wave * 16384);
    for (int item = C.vcu * NWAVES + C.wave; item < 4 * 176; item += C.G * NWAVES) {
        const int mi = item / 176, nb = item % 176, n0 = 32 * nb, N = 2 * FF;
        const float* W = (mi & 1 ? P.in[11] : P.in[7]) + (size_t)(mi >> 1) * D * N; const float* g = (mi & 1 ? P.in[10] : P.in[6]) + (mi >> 1) * D;
        unsigned char* W8 = ws + WS_W8GU0 + (size_t)mi * WS_W8GU_STRIDE; float* TS = (float*)(ws + WS_TGU) + mi * N;
        const int drow0 = gu_map(nb);
        float am[4] = {0.f, 0.f, 0.f, 0.f};
#pragma unroll 16
        for (int kb = 0; kb < D / 8; ++kb) { const int k = 8 * kb + r; const f32x4 v = *(const f32x4*)(W + (size_t)k * N + n0 + 4 * c4); const float gk = g[k];
            am[0] = fmaxf(am[0], fabsf(v.x * gk)); am[1] = fmaxf(am[1], fabsf(v.y * gk)); am[2] = fmaxf(am[2], fabsf(v.z * gk)); am[3] = fmaxf(am[3], fabsf(v.w * gk)); }
        float inv[4];
#pragma unroll
        for (int j = 0; j < 4; ++j) { float a = am[j]; a = fmaxf(a, __shfl_xor(a, 8)); a = fmaxf(a, __shfl_xor(a, 16)); a = fmaxf(a, __shfl_xor(a, 32)); inv[j] = a > 0.f ? 127.0f / a : 0.f; am[j] = a; }
        if (r == 0) *(f32x4*)(TS + drow0 + 4 * c4) = (f32x4){am[0] * (1.0f / 127.0f), am[1] * (1.0f / 127.0f), am[2] * (1.0f / 127.0f), am[3] * (1.0f / 127.0f)};
        for (int k0 = 0; k0 < D; k0 += 64) {
            f32x4 v[8]; float gk[8];
#pragma unroll
            for (int i = 0; i < 8; ++i) { v[i] = *(const f32x4*)(W + (size_t)(k0 + 8 * i + r) * N + n0 + 4 * c4); gk[i] = g[k0 + 8 * i + r]; }
#pragma unroll
            for (int i = 0; i < 8; ++i) { LAS float* sp = scr + (8 * i + r) * 33 + 4 * c4;
                sp[0] = __builtin_rintf(v[i].x * gk[i] * inv[0]); sp[1] = __builtin_rintf(v[i].y * gk[i] * inv[1]); sp[2] = __builtin_rintf(v[i].z * gk[i] * inv[2]); sp[3] = __builtin_rintf(v[i].w * gk[i] * inv[3]); }
            LDS_WAIT(); asm volatile("" ::: "memory");
            const int c = lane & 7;
#pragma unroll
            for (int j = 0; j < 4; ++j) { const int n = (lane >> 3) + 8 * j; const LAS float* s = scr + (8 * c) * 33 + n;
                const int q0 = (int)s[0 * 33], q1 = (int)s[1 * 33], q2 = (int)s[2 * 33], q3 = (int)s[3 * 33], q4 = (int)s[4 * 33], q5 = (int)s[5 * 33], q6 = (int)s[6 * 33], q7 = (int)s[7 * 33];
                u32x2 o; o.x = (unsigned)(q0 & 255) | ((unsigned)(q1 & 255) << 8) | ((unsigned)(q2 & 255) << 16) | ((unsigned)q3 << 24);
                o.y = (unsigned)(q4 & 255) | ((unsigned)(q5 & 255) << 8) | ((unsigned)(q6 & 255) << 16) | ((unsigned)q7 << 24);
                *(u32x2*)(W8 + (size_t)(drow0 + n) * D + k0 + 8 * c) = o; }
            LDS_WAIT(); asm volatile("" ::: "memory");
        }
    }
}

__device__ __forceinline__ void phase_w8gu2(const Ctx& C, CPtrs& P) {
    unsigned char* ws = P.ws; const int lane = C.lane, r = lane >> 3, c4 = lane & 7, w = C.wave;
    LAS float* S = (LAS float*)(C.lds + RING_OFF); LAS float* AM = (LAS float*)(C.lds + QS_OFF);
    __syncthreads();
    for (int item = C.vcu; item < 4 * 176; item += C.G) {
        const int mi = item / 176, nb = item % 176, n0 = 32 * nb, N = 2 * FF;
        const float* W = (mi & 1 ? P.in[11] : P.in[7]) + (size_t)(mi >> 1) * D * N; const float* g = (mi & 1 ? P.in[10] : P.in[6]) + (mi >> 1) * D;
        unsigned char* W8 = ws + WS_W8GU0 + (size_t)mi * WS_W8GU_STRIDE; float* TS = (float*)(ws + WS_TGU) + mi * N;
        const int drow0 = gu_map(nb);
        float am[4] = {0.f, 0.f, 0.f, 0.f};
#pragma unroll
        for (int hb = 0; hb < 2; ++hb) {
            f32x4 v[8]; float gk[8];
#pragma unroll
            for (int i = 0; i < 8; ++i) { const int k = 128 * w + 64 * hb + 8 * i + r; v[i] = *(const f32x4*)(W + (size_t)k * N + n0 + 4 * c4); gk[i] = g[k]; }
#pragma unroll
            for (int i = 0; i < 8; ++i) { const int k = 128 * w + 64 * hb + 8 * i + r, sw = k & 31; LAS float* sp = S + k * 32;
                const float x0 = v[i].x * gk[i], x1 = v[i].y * gk[i], x2 = v[i].z * gk[i], x3 = v[i].w * gk[i];
                am[0] = fmaxf(am[0], fabsf(x0)); am[1] = fmaxf(am[1], fabsf(x1)); am[2] = fmaxf(am[2], fabsf(x2)); am[3] = fmaxf(am[3], fabsf(x3));
                sp[(4 * c4 + 0) ^ sw] = x0; sp[(4 * c4 + 1) ^ sw] = x1; sp[(4 * c4 + 2) ^ sw] = x2; sp[(4 * c4 + 3) ^ sw] = x3; }
        }
#pragma unroll
        for (int j = 0; j < 4; ++j) { float a = am[j]; a = fmaxf(a, __shfl_xor(a, 8)); a = fmaxf(a, __shfl_xor(a, 16)); a = fmaxf(a, __shfl_xor(a, 32)); am[j] = a; }
        if (r == 0) { AM[w * 32 + 4 * c4 + 0] = am[0]; AM[w * 32 + 4 * c4 + 1] = am[1]; AM[w * 32 + 4 * c4 + 2] = am[2]; AM[w * 32 + 4 * c4 + 3] = am[3]; }
        __syncthreads();
        const int n = lane & 31, k0 = 128 * w + 64 * (lane >> 5);
        float a = 0.f;
#pragma unroll
        for (int ww = 0; ww < 8; ++ww) a = fmaxf(a, AM[ww * 32 + n]);
        const float inv = a > 0.f ? 127.0f / a : 0.f;
        if (w == 0 && lane < 32) TS[drow0 + lane] = a * (1.0f / 127.0f);
#pragma unroll
        for (int q = 0; q < 4; ++q) { unsigned o[4];
#pragma unroll
            for (int d = 0; d < 4; ++d) { unsigned wd = 0u;
#pragma unroll
                for (int e = 0; e < 4; ++e) { const int k = k0 + 16 * q + 4 * d + e; const int qi = (int)__builtin_rintf(S[k * 32 + (n ^ (k & 31))] * inv); wd |= (unsigned)(qi & 255) << (8 * e); }
                o[d] = wd; }
            v4u ov; ov.x = o[0]; ov.y = o[1]; ov.z = o[2]; ov.w = o[3]; *(v4u*)(W8 + (size_t)(drow0 + n) * D + k0 + 16 * q) = ov; }
        __syncthreads();
    }
}

__device__ __forceinline__ void phase_conv(const Ctx& C, CPtrs& P) {
    unsigned char* ws = P.ws; const bf16_t* BB = (const bf16_t*)(ws + WS_BB); const bf16_t* UB = (const bf16_t*)(ws + WS_UB); bf16_t* ZB = (bf16_t*)(ws + WS_ZB);
    const float* cw = P.in[14]; const float* st = P.in[4];
    const int gw = C.vcu * NWAVES + C.wave, NGW = C.G * NWAVES, lane = C.lane;
    for (int row = gw; row < T; row += NGW) {
        int have1, have2; const float* s1 = nullptr; const float* s2 = nullptr;
        if (row < TP) { const int t = row & (SEQ - 1); have1 = t >= 1; have2 = t >= 2; }
        else { const int r = row - TP, i = r & 3, b = r >> 2; have1 = i >= 1; have2 = i >= 2;
            if (!have1) s1 = st + (size_t)(b * 2 + 1) * D; if (!have2) s2 = st + (size_t)(b * 2 + i) * D; }
        v4u rb[2], r0[2], r1[2], r2[2];
#pragma unroll
        for (int j = 0; j < 2; ++j) { const int ch = 8 * lane + 512 * j; rb[j] = *(const v4u*)(BB + (size_t)row * D + ch); r0[j] = *(const v4u*)(UB + (size_t)row * D + ch);
            r1[j] = have1 ? *(const v4u*)(UB + (size_t)(row - 1) * D + ch) : (v4u){0u, 0u, 0u, 0u}; r2[j] = have2 ? *(const v4u*)(UB + (size_t)(row - 2) * D + ch) : (v4u){0u, 0u, 0u, 0u}; }
#pragma unroll
        for (int j = 0; j < 2; ++j) {
            const int ch = 8 * lane + 512 * j;
            float b8[8], u0[8], u1[8], u2[8], z[8];
            unpack8f(rb[j], b8); unpack8f(r0[j], u0); unpack8f(r1[j], u1); unpack8f(r2[j], u2);
            if (!have1 && s1) { const f32x4 a = *(const f32x4*)(s1 + ch), b = *(const f32x4*)(s1 + ch + 4); u1[0] = a.x; u1[1] = a.y; u1[2] = a.z; u1[3] = a.w; u1[4] = b.x; u1[5] = b.y; u1[6] = b.z; u1[7] = b.w; }
            if (!have2 && s2) { const f32x4 a = *(const f32x4*)(s2 + ch), b = *(const f32x4*)(s2 + ch + 4); u2[0] = a.x; u2[1] = a.y; u2[2] = a.z; u2[3] = a.w; u2[4] = b.x; u2[5] = b.y; u2[6] = b.z; u2[7] = b.w; }
#pragma unroll
            for (int e = 0; e < 8; ++e) z[e] = b8[e] * (cw[ch + e] * u2[e] + cw[D + ch + e] * u1[e] + cw[2 * D + ch + e] * u0[e]);
            *(v4u*)(ZB + (size_t)row * D + ch) = pack8f(z);
        }
    }
}

__device__ __forceinline__ void phase_kvfin(const Ctx& C, CPtrs& P) {
    unsigned char* ws = P.ws; const float* ckv = (const float*)(ws + WS_CKV); const float* ctl = (const float*)(ws + WS_CTL);
    bf16_t* LATB = (bf16_t*)(ws + WS_LATB); bf16_t* KPEB = (bf16_t*)(ws + WS_KPEB); const f32x2* tab = (const f32x2*)(ws + WS_ROPE);
    int lane = C.lane; asm volatile("" : "+v"(lane));
    const int gw = C.vcu * NWAVES + C.wave, NGW = C.G * NWAVES;
    const f32x4 gl = *((const f32x4*)P.in[24] + lane); const float gk = P.in[25][lane];
    for (int row0 = gw; row0 < T; row0 += 2 * NGW) {
        const int nr = row0 + NGW < T ? 2 : 1;
        float sl_[2], sk_[2], xk[2]; f32x4 vl[2]; f32x2 cs[2]; int rowq[2], posq[2];
#pragma unroll
        for (int q = 0; q < 2; ++q) { const int row = row0 + (q < nr ? q * NGW : 0); rowq[q] = row; posq[q] = row < TP ? (row & (SEQ - 1)) : SEQ + ((row - TP) & 3);
            sl_[q] = ctl[F_SSQLAT + row]; sk_[q] = ctl[F_SSQKPE + row]; vl[q] = *((const f32x4*)(ckv + (size_t)row * CKVW) + lane); xk[q] = ckv[(size_t)row * CKVW + KVR + lane]; cs[q] = tab[posq[q] * 32 + (lane & 31)]; }
#pragma unroll
        for (int q = 0; q < 2; ++q) if (q < nr) { const int row = rowq[q];
            const float rl = rsq(sl_[q] * (1.0f / KVR) + EPS), rk = rsq(sk_[q] * (1.0f / ROPE) + EPS);
            const f32x4 v = vl[q] * rl * gl;
            float* ol = row < TP ? P.out + OUT_LATP + (size_t)row * KVR : P.out + OUT_LATS + (size_t)(row - TP) * KVR;
            *((f32x4*)ol + lane) = v;
            u32x2 w; w.x = cvt_pk_bf16(v.x, v.y); w.y = cvt_pk_bf16(v.z, v.w); *((u32x2*)(LATB + (size_t)row * KVR) + lane) = w;
            const float xn = xk[q] * rk * gk, pr = __shfl_xor(xn, 32);
            const float o = lane < 32 ? xn * cs[q].x - pr * cs[q].y : xn * cs[q].x + pr * cs[q].y;
            float* ok = row < TP ? P.out + OUT_KPEP + (size_t)row * ROPE : P.out + OUT_KPES + (size_t)(row - TP) * ROPE;
            ok[lane] = o;
            const float on = __shfl_xor(o, 1);
            if ((lane & 1) == 0) *(unsigned*)(KPEB + (size_t)row * ROPE + lane) = cvt_pk_bf16(o, on); }
    }
}

__device__ __forceinline__ void phase_qkfin(const Ctx& C, CPtrs& P) {
    unsigned char* ws = P.ws; const float* ctl = (const float*)(ws + WS_CTL); bf16_t* QB = (bf16_t*)(ws + WS_QB); bf16_t* KN = (bf16_t*)(ws + WS_KN);
    const float* RPT = (const float*)(ws + WS_RPT); const f32x2* tab = (const f32x2*)(ws + WS_ROPE);
    const float* gqn = P.in[19]; const float* gqp = P.in[20]; const float* gkn = P.in[28];
    int lane = C.lane; asm volatile("" : "+v"(lane));
    const int gw = C.vcu * NWAVES + C.wave, NGW = C.G * NWAVES;
    for (int row0 = gw; row0 < TP; row0 += 2 * NGW) {
        bf16_t* pk[2][2]; v4u vk[2][2]; float rk[2][2]; const int nr = row0 + NGW < TP ? 2 : 1;
#pragma unroll
        for (int q = 0; q < 2; ++q) { const int row = row0 + (q < nr ? q * NGW : 0);
#pragma unroll
            for (int it = 0; it < 2; ++it) { const int ci = lane + 64 * it, hk = ci >> 4, ck = ci & 15; pk[q][it] = KN + (size_t)row * D + 128 * hk + 8 * ck; vk[q][it] = *(const v4u*)pk[q][it];
                rk[q][it] = RPT[(size_t)(2 * hk) * T + row] + RPT[(size_t)(2 * hk + 1) * T + row]; } }
#pragma unroll
        for (int q = 0; q < 2; ++q) if (q < nr) {
#pragma unroll
            for (int jj = 0; jj < 2; ++jj) { const int c = (lane + 64 * jj) & 15; const float rs = rsq(rk[q][jj] * (1.0f / 128) + EPS); float x[8]; unpack8f(vk[q][jj], x);
#pragma unroll
                for (int e = 0; e < 8; ++e) x[e] = x[e] * rs * gkn[8 * c + e];
                *(v4u*)pk[q][jj] = pack8f(x); } }
    }
    { float* RTS = (float*)(ws + WS_RTS);
      for (int i = C.vcu * (NWAVES * 64) + C.tid; i < TS * NH; i += C.G * (NWAVES * 64)) { const int rsi = i >> 3, h = i & 7; const size_t rw = (size_t)TP + rsi;
          RTS[i] = rsq((RPT[(size_t)(2 * h) * T + rw] + RPT[(size_t)(2 * h + 1) * T + rw]) * (1.0f / 128) + EPS); } }
    {
        LAS float* A = (LAS float*)(C.lds + RING_OFF + C.wave * 1024);
        const bf16_t* WUK = (const bf16_t*)(ws + WS_WUKV); bf16_t* QS = (bf16_t*)(ws + WS_QS);
        for (int item = gw; item < TS * NH; item += NGW) {
            const int rsi = item >> 3, h = item & 7, row = TP + rsi;
            const float* sq = ctl + F_SSQQ + row;
            { const unsigned w = *(const unsigned*)(QB + (size_t)row * NQ + HD * h + 2 * lane); const float rs = rsq(sq[(size_t)(2 * h) * T] * (1.0f / 128) + EPS);
              A[2 * lane] = bflo(w) * rs * gqn[2 * lane] * gkn[2 * lane]; A[2 * lane + 1] = bfhi(w) * rs * gqn[2 * lane + 1] * gkn[2 * lane + 1]; }
            { const float x = bf2f(QB[(size_t)row * NQ + HD * h + 128 + lane]) * rsq(sq[(size_t)(2 * h + 1) * T] * (1.0f / 64) + EPS) * gqp[lane], pr = __shfl_xor(x, 32);
              const f32x2 cs = tab[(SEQ + (rsi & 3)) * 32 + (lane & 31)];
              const float o = (lane < 32 ? x * cs.x - pr * cs.y : x * cs.x + pr * cs.y) * QSCALE, on = __shfl_xor(o, 1);
              if ((lane & 1) == 0) *(unsigned*)(QS + (size_t)item * 320 + 256 + lane) = cvt_pk_bf16(o, on); }
            LDS_WAIT(); asm volatile("" ::: "memory");
            float acc[4] = {0.f, 0.f, 0.f, 0.f};
#pragma unroll 32
            for (int d = 0; d < 128; ++d) { const u32x2 w = *(const u32x2*)(WUK + (size_t)uk_row(h, d) * KVR + 4 * lane); const float ad = A[d];
                acc[0] += bflo(w.x) * ad; acc[1] += bfhi(w.x) * ad; acc[2] += bflo(w.y) * ad; acc[3] += bfhi(w.y) * ad; }
            u32x2 o; o.x = cvt_pk_bf16(acc[0] * QSCALE, acc[1] * QSCALE); o.y = cvt_pk_bf16(acc[2] * QSCALE, acc[3] * QSCALE);
            *(u32x2*)(QS + (size_t)item * 320 + 4 * lane) = o;
            LDS_WAIT(); asm volatile("" ::: "memory");
        }
    }
}

__device__ __forceinline__ void phase_scomb(const Ctx& C, CPtrs& P) {
    unsigned char* ws = P.ws; const float* PO = (const float*)(ws + WS_PO); const float* PML = (const float*)(ws + WS_PML); bf16_t* OB = (bf16_t*)(ws + WS_OB);
    const float* wuv = P.in[27];
    const int gw = C.vcu * NWAVES + C.wave, NGW = C.G * NWAVES, lane = C.lane;
    LAS float* OL = (LAS float*)(C.lds + RING_OFF + C.wave * 1024);
    for (int item = gw; item < TS * NH; item += NGW) {
        const int rsi = item >> 3, h = item & 7, b = rsi >> 2, q = rsi & 3, rho = q * 8 + h;
        const size_t i0 = (size_t)(b * 2 + 0) * 32 + rho, i1 = (size_t)(b * 2 + 1) * 32 + rho;
        const float m0 = PML[i0 * 2], l0 = PML[i0 * 2 + 1], m1 = PML[i1 * 2], l1 = PML[i1 * 2 + 1];
        const float mm = fmaxf(m0, m1), f0 = __builtin_amdgcn_exp2f(m0 - mm), f1 = __builtin_amdgcn_exp2f(m1 - mm), inv = 1.0f / (l0 * f0 + l1 * f1);
        { const f32x4 a = *((const f32x4*)(PO + i0 * 256) + lane), c = *((const f32x4*)(PO + i1 * 256) + lane); *((LAS f32x4*)OL + lane) = (a * f0 + c * f1) * inv; }
        LDS_WAIT(); asm volatile("" ::: "memory");
        float a0 = 0.f, a1 = 0.f; const float* wp = wuv + 128 * h + 2 * lane;
#pragma unroll 32
        for (int n = 0; n < KVR; ++n) { const f32x2 w = *(const f32x2*)(wp + (size_t)n * D); const float on = OL[n]; a0 += on * w.x; a1 += on * w.y; }
        *(unsigned*)(OB + (size_t)(TP + rsi) * D + 128 * h + 2 * lane) = cvt_pk_bf16(a0, a1);
        LDS_WAIT(); asm volatile("" ::: "memory");
    }
}

namespace att {
typedef short bf16x8 __attribute__((ext_vector_type(8)));
typedef short s16x4 __attribute__((ext_vector_type(4)));
typedef float f32x16 __attribute__((ext_vector_type(16)));
typedef float f32x4 __attribute__((ext_vector_type(4)));
typedef unsigned u32x4 __attribute__((ext_vector_type(4)));
constexpr float THR = 11.5f;
#define SBAR() __builtin_amdgcn_sched_barrier(0)
__device__ __forceinline__ int crow(int r, int hi) { return (r & 3) + 8 * (r >> 2) + 4 * hi; }
__device__ __forceinline__ unsigned cvtpk(float lo, float hi) { unsigned r; asm volatile("v_cvt_pk_bf16_f32 %0, %1, %2" : "=v"(r) : "v"(lo), "v"(hi)); return r; }
__device__ __forceinline__ float xmax32(float v) { auto rr = __builtin_amdgcn_permlane32_swap(__float_as_uint(v), __float_as_uint(v), false, false); return fmaxf(__uint_as_float(rr[0]), __uint_as_float(rr[1])); }
__device__ __forceinline__ float xsum32(float v) { auto rr = __builtin_amdgcn_permlane32_swap(__float_as_uint(v), __float_as_uint(v), false, false); return __uint_as_float(rr[0]) + __uint_as_float(rr[1]); }
#define PK4(P, B_, OUT) do { unsigned a0 = cvtpk(P[B_+0], P[B_+1]), a1 = cvtpk(P[B_+2], P[B_+3]);                          \
        unsigned b0 = cvtpk(P[B_+4], P[B_+5]), b1 = cvtpk(P[B_+6], P[B_+7]);                                             \
        auto r0 = __builtin_amdgcn_permlane32_swap(a0, b0, false, false); auto r1 = __builtin_amdgcn_permlane32_swap(a1, b1, false, false); \
        u32x4 w = {r0[0], r1[0], r0[1], r1[1]}; OUT = *reinterpret_cast<bf16x8*>(&w); } while (0)

namespace pa {
constexpr int KVBLK = 64, QBLK = 32, QB = 256;
constexpr int SHM_V = 16384, SHM_K = 16384, SHM_R = 8192;
constexpr int OFF_V = 0, OFF_K = 2 * SHM_V, OFF_R = OFF_K + 2 * SHM_K, OFF_WS = OFF_R + 2 * SHM_R;
#define KSWZ(row, colB) ((row) * 256 + ((colB) ^ (((row) & 7) << 4)))
__device__ __forceinline__ int v_st(int k, int c) { const int kk = (k & ~0xC) | ((k & 4) << 1) | ((k & 8) >> 1); return ((kk >> 3) * 4 + (c >> 5)) * 512 + ((kk & 7) * 32 + (c & 31)) * 2; }
__device__ __forceinline__ int v_rd_base(int lane) { return ((lane & 3) << 3) | (((lane >> 2) & 3) << 6) | (((lane >> 4) & 1) << 5) | (((lane >> 5) & 1) << 8); }
constexpr int v_rd_off(int d0, int ks, int half) { return d0 * 512 + ks * 4096 + half * 2048; }
__device__ __forceinline__ void mask_tile(f32x16& p0, f32x16& p1, int dq) {
    const float NEG = -__builtin_inff();
#pragma unroll
    for (int r = 0; r < 16; ++r) { const int c = (r & 3) + 8 * (r >> 2); if (dq - c < 0) p0[r] = NEG; if (dq - c - 32 < 0) p1[r] = NEG; }
}
__device__ __forceinline__ void softmax_tile(f32x16& p0, f32x16& p1, float& m_reg, float& l_reg, float& alpha, bf16x8& pa0, bf16x8& pa1, bf16x8& pa2, bf16x8& pa3) {
    float pmax = p0[0];
#pragma unroll
    for (int r = 1; r < 16; ++r) pmax = fmaxf(pmax, p0[r]);
#pragma unroll
    for (int r = 0; r < 16; ++r) pmax = fmaxf(pmax, p1[r]);
    pmax = xmax32(pmax);
    float mn;
    if (__builtin_expect(__all((pmax - m_reg) <= THR), 1)) { mn = m_reg; alpha = 1.f; }
    else { mn = fmaxf(m_reg, pmax); alpha = __builtin_amdgcn_exp2f(m_reg - mn); m_reg = mn; }
#pragma unroll
    for (int r = 0; r < 16; ++r) { p0[r] = __builtin_amdgcn_exp2f(p0[r] - mn); p1[r] = __builtin_amdgcn_exp2f(p1[r] - mn); }
    float ps = 0.f;
#pragma unroll
    for (int r = 0; r < 16; ++r) ps += p0[r];
#pragma unroll
    for (int r = 0; r < 16; ++r) ps += p1[r];
    ps = xsum32(ps);
    l_reg = l_reg * alpha + ps;
    PK4(p0, 0, pa0); PK4(p0, 8, pa1); PK4(p1, 0, pa2); PK4(p1, 8, pa3);
}
template <int KB>
__device__ __forceinline__ void qkt(f32x16& p0, f32x16& p1, const char* lds, int r32, int hi, const bf16x8* qr) {
    p0 = f32x16{}; p1 = f32x16{};
    const char* kb[4];
#pragma unroll
    for (int dd = 0; dd < 4; ++dd) kb[dd] = lds + OFF_K + KB * SHM_K + KSWZ(r32, (dd * 16 + hi * 8) * 2);
#pragma unroll
    for (int d0 = 0; d0 < 8; ++d0) { const char* a = kb[d0 & 3] + (d0 >> 2) * 128;
        const bf16x8 b0 = *reinterpret_cast<const bf16x8*>(a), b1 = *reinterpret_cast<const bf16x8*>(a + 32 * 256);
        p0 = __builtin_amdgcn_mfma_f32_32x32x16_bf16(b0, qr[d0], p0, 0, 0, 0);
        p1 = __builtin_amdgcn_mfma_f32_32x32x16_bf16(b1, qr[d0], p1, 0, 0, 0); }
    const int sw = (r32 >> 1) & 7; const char* rb = lds + OFF_R + KB * SHM_R + r32 * 128;
#pragma unroll
    for (int s = 0; s < 4; ++s) { const char* a = rb + (((2 * s + hi) ^ sw) << 4);
        const bf16x8 b0 = *reinterpret_cast<const bf16x8*>(a), b1 = *reinterpret_cast<const bf16x8*>(a + 32 * 128);
        p0 = __builtin_amdgcn_mfma_f32_32x32x16_bf16(b0, qr[8 + s], p0, 0, 0, 0);
        p1 = __builtin_amdgcn_mfma_f32_32x32x16_bf16(b1, qr[8 + s], p1, 0, 0, 0); }
}
template <int VB>
__device__ __forceinline__ void pv_tile(f32x16* o, int vb0, bf16x8 pa0, bf16x8 pa1, bf16x8 pa2, bf16x8 pa3) {
#define TRRD(dst, off) asm volatile("ds_read_b64_tr_b16 %0, %1 offset:%2" : "=&v"(dst) : "v"(vb0), "i"(off) : "memory")
#define PV_KS(ks, PA) do { s16x4 l0, l1, l2, l3, h0, h1, h2, h3; constexpr int b_ = OFF_V + VB * SHM_V + v_rd_off(0, ks, 0);   \
        TRRD(l0, b_); TRRD(h0, b_ + 2048); TRRD(l1, b_ + 512); TRRD(h1, b_ + 512 + 2048); TRRD(l2, b_ + 1024); TRRD(h2, b_ + 1024 + 2048); TRRD(l3, b_ + 1536); TRRD(h3, b_ + 1536 + 2048); \
        asm volatile("s_waitcnt lgkmcnt(0)" ::: "memory"); SBAR();   \
        o[0] = __builtin_amdgcn_mfma_f32_32x32x16_bf16(PA, (bf16x8){l0[0], l0[1], l0[2], l0[3], h0[0], h0[1], h0[2], h0[3]}, o[0], 0, 0, 0);   \
        o[1] = __builtin_amdgcn_mfma_f32_32x32x16_bf16(PA, (bf16x8){l1[0], l1[1], l1[2], l1[3], h1[0], h1[1], h1[2], h1[3]}, o[1], 0, 0, 0);   \
        o[2] = __builtin_amdgcn_mfma_f32_32x32x16_bf16(PA, (bf16x8){l2[0], l2[1], l2[2], l2[3], h2[0], h2[1], h2[2], h2[3]}, o[2], 0, 0, 0);   \
        o[3] = __builtin_amdgcn_mfma_f32_32x32x16_bf16(PA, (bf16x8){l3[0], l3[1], l3[2], l3[3], h3[0], h3[1], h3[2], h3[3]}, o[3], 0, 0, 0); } while (0)
    PV_KS(0, pa0); PV_KS(1, pa1); PV_KS(2, pa2); PV_KS(3, pa3);
#undef PV_KS
#undef TRRD
}
__device__ __forceinline__ void unit(int b, int h, int qb, const bf16_t* __restrict__ QF, const bf16_t* __restrict__ KN, const bf16_t* __restrict__ KPE, const bf16_t* __restrict__ VBg, bf16_t* OB, char* lds) {
    const int tid = threadIdx.x, wid = __builtin_amdgcn_readfirstlane(tid >> 6), lane = tid & 63, r32 = lane & 31, hi = lane >> 5;
    const size_t rowb = (size_t)b * SEQ; const int q0 = qb * QB, qlo = q0 + wid * QBLK, qm = qlo + r32 - 4 * hi;
    const int NT = (q0 + QB) / KVBLK;
    float* wsf = (float*)(lds + OFF_WS) + wid * 64; float* li_l = wsf; float* al_l = wsf + 32;
    bf16x8 qr[12];
    { const bf16_t* qp = QF + (rowb + qlo + r32) * NQ + HD * h + hi * 8;
#pragma unroll
      for (int d0 = 0; d0 < 12; ++d0) qr[d0] = *reinterpret_cast<const bf16x8*>(qp + d0 * 16); }
    const int sr = tid >> 4, sc = (tid & 15) * 8, rr = tid >> 3, rc = tid & 7;
    const int kws = KSWZ(sr, sc * 2), vst0 = v_st(sr, sc), vst1 = v_st(32 + sr, sc), rws = rr * 128 + ((rc ^ ((rr >> 1) & 7)) << 4);
    const bf16_t* Kg = KN + (rowb + sr) * D + 128 * h + sc; const bf16_t* Vg = VBg + (rowb + sr) * D + 128 * h + sc; const bf16_t* Rg = KPE + (rowb + rr) * ROPE + rc * 8;
    bf16x8 st_k0, st_k1, st_v0, st_v1, st_r;
#define SLOAD(t) do { const size_t ko = (size_t)(t) * KVBLK * D; st_k0 = *reinterpret_cast<const bf16x8*>(Kg + ko); st_k1 = *reinterpret_cast<const bf16x8*>(Kg + ko + 32 * D); \
        st_v0 = *reinterpret_cast<const bf16x8*>(Vg + ko); st_v1 = *reinterpret_cast<const bf16x8*>(Vg + ko + 32 * D); st_r = *reinterpret_cast<const bf16x8*>(Rg + (size_t)(t) * KVBLK * ROPE); } while (0)
#define SWRITE(bf) do { *(bf16x8*)(lds + OFF_K + (bf) * SHM_K + kws) = st_k0; *(bf16x8*)(lds + OFF_K + (bf) * SHM_K + kws + 32 * 256) = st_k1; \
        *(bf16x8*)(lds + OFF_V + (bf) * SHM_V + vst0) = st_v0; *(bf16x8*)(lds + OFF_V + (bf) * SHM_V + vst1) = st_v1; *(bf16x8*)(lds + OFF_R + (bf) * SHM_R + rws) = st_r; } while (0)
    const int vb0 = (int)(uintptr_t)lds + v_rd_base(lane);
    float m_reg = -1e30f, l_reg = 0.f, alpha; f32x16 o[4] = {}; f32x16 p0, p1; bf16x8 pa0, pa1, pa2, pa3;
    SLOAD(0); SWRITE(0); __syncthreads();
#define STEP(t, CB) do { if ((t) + 1 < NT) SLOAD((t) + 1); SBAR();                                                            \
        qkt<CB>(p0, p1, lds, r32, hi, qr);                                                                                    \
        if (KVBLK * (t) + KVBLK - 1 > qlo) mask_tile(p0, p1, qm - KVBLK * (t));                                               \
        softmax_tile(p0, p1, m_reg, l_reg, alpha, pa0, pa1, pa2, pa3);                                                        \
        if (__any(alpha < 1.f)) { if (hi == 0) al_l[r32] = alpha; asm volatile("s_waitcnt lgkmcnt(0)" ::: "memory");         \
            _Pragma("unroll") for (int d_ = 0; d_ < 4; ++d_) _Pragma("unroll") for (int r = 0; r < 16; ++r) o[d_][r] *= al_l[crow(r, hi)]; } \
        SBAR(); pv_tile<CB>(o, vb0, pa0, pa1, pa2, pa3);                                                                      \
        if ((t) + 1 < NT) SWRITE(1 - (CB));                                                                                   \
        __syncthreads(); } while (0)
    for (int t = 0; t < NT; t += 2) { STEP(t, 0); STEP(t + 1, 1); }
#undef STEP
#undef SLOAD
#undef SWRITE
    if (hi == 0) li_l[r32] = l_reg; asm volatile("s_waitcnt lgkmcnt(0)" ::: "memory");
    float rli[16];
#pragma unroll
    for (int r = 0; r < 16; ++r) rli[r] = __builtin_amdgcn_rcpf(li_l[crow(r, hi)]);
    bf16_t* Ow = OB + (rowb + qlo) * D + 128 * h;
#pragma unroll
    for (int r = 0; r < 16; ++r) { const int orow = crow(r, hi);
#pragma unroll
        for (int d0 = 0; d0 < 4; ++d0) { const float v = o[d0][r] * rli[r]; const float vn = __shfl_xor(v, 1);
            if ((r32 & 1) == 0) *(unsigned*)(Ow + (size_t)orow * D + d0 * 32 + r32) = cvtpk(v, vn); } }
    __syncthreads();
}
constexpr int S4_R2 = 131584, S4_WS = S4_R2 + SHM_R;
static_assert(S4_WS + 2048 <= 155648, "lds");
constexpr int R3_V = 0, R3_K = 3 * SHM_V, R3_R = R3_K + 3 * SHM_K, R3_WS = R3_R + 3 * SHM_R;
__device__ __forceinline__ void qkt_rt(f32x16& p0, f32x16& p1, const char* lds, int kofs, int rofs, int r32, int hi, const bf16x8* qr) {
    p0 = f32x16{}; p1 = f32x16{};
    const char* kb[4];
#pragma unroll
    for (int dd = 0; dd < 4; ++dd) kb[dd] = lds + R3_K + kofs + KSWZ(r32, (dd * 16 + hi * 8) * 2);
#pragma unroll
    for (int d0 = 0; d0 < 8; ++d0) { const char* a = kb[d0 & 3] + (d0 >> 2) * 128;
        const bf16x8 b0 = *reinterpret_cast<const bf16x8*>(a), b1 = *reinterpret_cast<const bf16x8*>(a + 32 * 256);
        p0 = __builtin_amdgcn_mfma_f32_32x32x16_bf16(b0, qr[d0], p0, 0, 0, 0);
        p1 = __builtin_amdgcn_mfma_f32_32x32x16_bf16(b1, qr[d0], p1, 0, 0, 0); }
    const int sw = (r32 >> 1) & 7; const char* rb = lds + R3_R + rofs + r32 * 128;
#pragma unroll
    for (int s = 0; s < 4; ++s) { const char* a = rb + (((2 * s + hi) ^ sw) << 4);
        const bf16x8 b0 = *reinterpret_cast<const bf16x8*>(a), b1 = *reinterpret_cast<const bf16x8*>(a + 32 * 128);
        p0 = __builtin_amdgcn_mfma_f32_32x32x16_bf16(b0, qr[8 + s], p0, 0, 0, 0);
        p1 = __builtin_amdgcn_mfma_f32_32x32x16_bf16(b1, qr[8 + s], p1, 0, 0, 0); }
}
__device__ __forceinline__ void pv_rt(f32x16* o, int vb, bf16x8 pa0, bf16x8 pa1, bf16x8 pa2, bf16x8 pa3) {
#define TRRD(dst, off) asm volatile("ds_read_b64_tr_b16 %0, %1 offset:%2" : "=&v"(dst) : "v"(vb), "i"(off) : "memory")
#define PV_KS(ks, PA) do { s16x4 l0, l1, l2, l3, h0, h1, h2, h3; constexpr int b_ = R3_V + v_rd_off(0, ks, 0);   \
        TRRD(l0, b_); TRRD(h0, b_ + 2048); TRRD(l1, b_ + 512); TRRD(h1, b_ + 512 + 2048); TRRD(l2, b_ + 1024); TRRD(h2, b_ + 1024 + 2048); TRRD(l3, b_ + 1536); TRRD(h3, b_ + 1536 + 2048); \
        asm volatile("s_waitcnt lgkmcnt(0)" ::: "memory"); SBAR();   \
        o[0] = __builtin_amdgcn_mfma_f32_32x32x16_bf16(PA, (bf16x8){l0[0], l0[1], l0[2], l0[3], h0[0], h0[1], h0[2], h0[3]}, o[0], 0, 0, 0);   \
        o[1] = __builtin_amdgcn_mfma_f32_32x32x16_bf16(PA, (bf16x8){l1[0], l1[1], l1[2], l1[3], h1[0], h1[1], h1[2], h1[3]}, o[1], 0, 0, 0);   \
        o[2] = __builtin_amdgcn_mfma_f32_32x32x16_bf16(PA, (bf16x8){l2[0], l2[1], l2[2], l2[3], h2[0], h2[1], h2[2], h2[3]}, o[2], 0, 0, 0);   \
        o[3] = __builtin_amdgcn_mfma_f32_32x32x16_bf16(PA, (bf16x8){l3[0], l3[1], l3[2], l3[3], h3[0], h3[1], h3[2], h3[3]}, o[3], 0, 0, 0); } while (0)
    PV_KS(0, pa0); PV_KS(1, pa1); PV_KS(2, pa2); PV_KS(3, pa3);
#undef PV_KS
#undef TRRD
}
#ifndef PA_PF
#define PA_PF 5
#endif
__device__ __forceinline__ void qkt_pf(f32x16& p0, f32x16& p1, const char* lds, int kofs, int rofs, int r32, int hi, const bf16x8* qr) {
    p0 = f32x16{}; p1 = f32x16{};
    const char* kb[4];
#pragma unroll
    for (int dd = 0; dd < 4; ++dd) kb[dd] = lds + R3_K + kofs + KSWZ(r32, (dd * 16 + hi * 8) * 2);
    const int sw = (r32 >> 1) & 7; const char* rb = lds + R3_R + rofs + r32 * 128;
    bf16x8 f0[12], f1[12];
#define QK_LD(d) do { if ((d) < 8) { const char* a = kb[(d) & 3] + ((d) >> 2) * 128; f0[d] = *reinterpret_cast<const bf16x8*>(a); f1[d] = *reinterpret_cast<const bf16x8*>(a + 32 * 256); } \
                      else { const char* a = rb + (((2 * ((d) - 8) + hi) ^ sw) << 4); f0[d] = *reinterpret_cast<const bf16x8*>(a); f1[d] = *reinterpret_cast<const bf16x8*>(a + 32 * 128); } } while (0)
#pragma unroll
    for (int d = 0; d < PA_PF; ++d) QK_LD(d);
#pragma unroll
    for (int d = 0; d < 12; ++d) {
        if (d + PA_PF < 12) QK_LD(d + PA_PF);
        SBAR();
        p0 = __builtin_amdgcn_mfma_f32_32x32x16_bf16(f0[d], qr[d], p0, 0, 0, 0);
        p1 = __builtin_amdgcn_mfma_f32_32x32x16_bf16(f1[d], qr[d], p1, 0, 0, 0);
        SBAR(); }
#undef QK_LD
}
#define TRRD(dst, off) asm volatile("ds_read_b64_tr_b16 %0, %1 offset:%2" : "=&v"(dst) : "v"(vb_), "i"(off) : "memory")
#define PV_RD(ks, S) do { constexpr int b_ = R3_V + v_rd_off(0, ks, 0);   \
        TRRD(S[0], b_); TRRD(S[4], b_ + 2048); TRRD(S[1], b_ + 512); TRRD(S[5], b_ + 512 + 2048); TRRD(S[2], b_ + 1024); TRRD(S[6], b_ + 1024 + 2048); TRRD(S[3], b_ + 1536); TRRD(S[7], b_ + 1536 + 2048); } while (0)
#define PV_MM(PA, S) do { \
        o[0] = __builtin_amdgcn_mfma_f32_32x32x16_bf16(PA, (bf16x8){S[0][0], S[0][1], S[0][2], S[0][3], S[4][0], S[4][1], S[4][2], S[4][3]}, o[0], 0, 0, 0);   \
        o[1] = __builtin_amdgcn_mfma_f32_32x32x16_bf16(PA, (bf16x8){S[1][0], S[1][1], S[1][2], S[1][3], S[5][0], S[5][1], S[5][2], S[5][3]}, o[1], 0, 0, 0);   \
        o[2] = __builtin_amdgcn_mfma_f32_32x32x16_bf16(PA, (bf16x8){S[2][0], S[2][1], S[2][2], S[2][3], S[6][0], S[6][1], S[6][2], S[6][3]}, o[2], 0, 0, 0);   \
        o[3] = __builtin_amdgcn_mfma_f32_32x32x16_bf16(PA, (bf16x8){S[3][0], S[3][1], S[3][2], S[3][3], S[7][0], S[7][1], S[7][2], S[7][3]}, o[3], 0, 0, 0); } while (0)
#define PV_EARLY(VA, VB_) do { PV_RD(0, VA); PV_RD(1, VB_); } while (0)
#define PV_REST(VA, VB_) do {                                                                     \
    asm volatile("s_waitcnt lgkmcnt(8)" ::: "memory"); SBAR(); PV_MM(pa0, VA); SBAR();            \
    PV_RD(2, VA);                                                                                 \
    asm volatile("s_waitcnt lgkmcnt(8)" ::: "memory"); SBAR(); PV_MM(pa1, VB_); SBAR();           \
    PV_RD(3, VB_);                                                                                \
    asm volatile("s_waitcnt lgkmcnt(8)" ::: "memory"); SBAR(); PV_MM(pa2, VA); SBAR();            \
    asm volatile("s_waitcnt lgkmcnt(0)" ::: "memory"); SBAR(); PV_MM(pa3, VB_); } while (0)
#ifndef PA_QK
#define PA_QK qkt_pf
#endif
struct QFix { const float* sq; const float* gqn; const float* gqp; const f32x2* tab; };
template <bool REV>
__device__ __forceinline__ void unit_dma(int b, int h, int qb, const bf16_t* __restrict__ QF, const bf16_t* __restrict__ KN, const bf16_t* __restrict__ KPE, const bf16_t* __restrict__ VBg, bf16_t* OB, char* lds, LAS unsigned char* ldsu, const QFix qf) {
    int tid = threadIdx.x; asm volatile("" : "+v"(tid));
    const int wid = __builtin_amdgcn_readfirstlane(tid >> 6), lane = tid & 63, r32 = lane & 31, hi = lane >> 5;
    const size_t rowb = (size_t)b * SEQ; const int q0 = qb * QB, qlo = q0 + wid * QBLK, qm = qlo + r32 - 4 * hi;
    const int NT = (q0 + QB) / KVBLK;
    float* wsf = (float*)(lds + R3_WS) + wid * 64; float* li_l = wsf; float* al_l = wsf + 32;
    bf16x8 qr[12];
    { const bf16_t* qp = QF + (rowb + qlo + r32) * NQ + HD * h + hi * 8;
#pragma unroll
      for (int d0 = 0; d0 < 12; ++d0) qr[d0] = *reinterpret_cast<const bf16x8*>(qp + d0 * 16); }
    { const int row = (int)rowb + qlo + r32, pos = qlo + r32; const float* sq = qf.sq + row;
      const float rsn = rsq(sq[(size_t)(2 * h) * T] * (1.0f / 128) + EPS) * QSCALE, rsr = rsq(sq[(size_t)(2 * h + 1) * T] * (1.0f / 64) + EPS);
#pragma unroll
      for (int d0 = 0; d0 < 8; ++d0) { float x[8]; unpack8f(__builtin_bit_cast(v4u, qr[d0]), x); const float* gp = qf.gqn + hi * 8 + d0 * 16;
#pragma unroll
          for (int e = 0; e < 8; ++e) x[e] = x[e] * rsn * gp[e];
          qr[d0] = __builtin_bit_cast(bf16x8, pack8f(x)); }
#pragma unroll
      for (int d0 = 8; d0 < 10; ++d0) { const int j0 = hi * 8 + (d0 - 8) * 16; float xa[8], xb[8], ya[8], yb[8]; unpack8f(__builtin_bit_cast(v4u, qr[d0]), xa); unpack8f(__builtin_bit_cast(v4u, qr[d0 + 2]), xb);
#pragma unroll
          for (int e = 0; e < 8; ++e) { const float a = xa[e] * rsr * qf.gqp[j0 + e], bb = xb[e] * rsr * qf.gqp[j0 + 32 + e]; const f32x2 cs = qf.tab[pos * 32 + j0 + e];
              ya[e] = (a * cs.x - bb * cs.y) * QSCALE; yb[e] = (bb * cs.x + a * cs.y) * QSCALE; }
          qr[d0] = __builtin_bit_cast(bf16x8, pack8f(ya)); qr[d0 + 2] = __builtin_bit_cast(bf16x8, pack8f(yb)); } }
    const char* Kb = (const char*)(KN + rowb * D + 128 * h); const char* Vb = (const char*)(VBg + rowb * D + 128 * h); const char* Rb = (const char*)(KPE + rowb * ROPE);
    unsigned kof[2], vof[2], rof;
#pragma unroll
    for (int pi = 0; pi < 2; ++pi) { const int p = 2 * wid + pi, rw = 4 * pi + (lane >> 4);
        kof[pi] = (unsigned)((4 * p + (lane >> 4)) * (D * 2) + 16 * ((lane & 15) ^ (rw & 7)));
        const int kk = 8 * (p >> 1) + ((lane & 31) >> 2), key = (kk & ~0xC) | ((kk & 4) << 1) | ((kk & 8) >> 1), col = 32 * (2 * (p & 1) + (lane >> 5)) + 8 * (lane & 3);
        vof[pi] = (unsigned)(key * (D * 2) + col * 2); }
    { const int row = 8 * wid + (lane >> 3); rof = (unsigned)(row * (ROPE * 2) + 16 * ((lane & 7) ^ ((row >> 1) & 7))); }
#define DMA_TILE(t, ks_, vs_, rs_) do { const size_t kb_ = (size_t)(t) * KVBLK * (D * 2);                                                                \
        _Pragma("unroll") for (int pi = 0; pi < 2; ++pi) { const int p = 2 * wid + pi;                                                                 \
            __builtin_amdgcn_global_load_lds((const unsigned*)(Kb + kb_ + kof[pi]), (LAS unsigned*)(ldsu + R3_K + (ks_) + p * 1024), 16, 0, 0);        \
            __builtin_amdgcn_global_load_lds((const unsigned*)(Vb + kb_ + vof[pi]), (LAS unsigned*)(ldsu + R3_V + (vs_) + p * 1024), 16, 0, 0); }      \
        __builtin_amdgcn_global_load_lds((const unsigned*)(Rb + (size_t)(t) * KVBLK * (ROPE * 2) + rof), (LAS unsigned*)(ldsu + R3_R + (rs_) + wid * 1024), 16, 0, 0); } while (0)
    const int vb0 = (int)(uintptr_t)lds + v_rd_base(lane);
    float m_reg = -1e30f, l_reg = 0.f, alpha; f32x16 o[4] = {}; f32x16 p0, p1; bf16x8 pa0, pa1, pa2, pa3;
#define TID_(i) (REV ? NT - 1 - (i) : (i))
    DMA_TILE(TID_(0), 0, 0, 0); DMA_TILE(TID_(1), SHM_K, SHM_V, SHM_R);
    asm volatile("s_waitcnt vmcnt(5)" ::: "memory"); __builtin_amdgcn_s_barrier(); asm volatile("" ::: "memory");
    int s_cur = 0, s_nxt = 1, s_nn = 2;
    for (int t = 0; t < NT; ++t) {
        int kofs = s_cur * SHM_K, rofs = s_cur * SHM_R, vofs = s_cur * SHM_V; asm volatile("" : "+v"(kofs), "+v"(rofs), "+v"(vofs));
        if (t + 2 < NT) DMA_TILE(TID_(t + 2), s_nn * SHM_K, s_nn * SHM_V, s_nn * SHM_R);
        PA_QK(p0, p1, lds, kofs, rofs, r32, hi, qr);
        s16x4 VA[8], VB_[8]; const int vb_ = vb0 + vofs; SBAR(); PV_EARLY(VA, VB_); SBAR();
        { const int tq = TID_(t); if (KVBLK * tq + KVBLK - 1 > qlo) mask_tile(p0, p1, qm - KVBLK * tq); }
        softmax_tile(p0, p1, m_reg, l_reg, alpha, pa0, pa1, pa2, pa3);
        if (__any(alpha < 1.f)) { if (hi == 0) al_l[r32] = alpha; asm volatile("s_waitcnt lgkmcnt(0)" ::: "memory");
#pragma unroll
            for (int d_ = 0; d_ < 4; ++d_)
#pragma unroll
                for (int r = 0; r < 16; ++r) o[d_][r] *= al_l[crow(r, hi)]; }
        SBAR(); PV_REST(VA, VB_);
        if (t + 2 < NT) asm volatile("s_waitcnt vmcnt(5) lgkmcnt(0)" ::: "memory"); else asm volatile("s_waitcnt vmcnt(0) lgkmcnt(0)" ::: "memory");
        __builtin_amdgcn_s_barrier(); asm volatile("" ::: "memory");
        const int tmp = s_cur; s_cur = s_nxt; s_nxt = s_nn; s_nn = tmp;
    }
#undef DMA_TILE
#undef TID_
    if (hi == 0) li_l[r32] = l_reg; asm volatile("s_waitcnt lgkmcnt(0)" ::: "memory");
    float rli[16];
#pragma unroll
    for (int r = 0; r < 16; ++r) rli[r] = __builtin_amdgcn_rcpf(li_l[crow(r, hi)]);
    bf16_t* Ow = OB + (rowb + qlo) * D + 128 * h;
#pragma unroll
    for (int r = 0; r < 16; ++r) { const int orow = crow(r, hi);
#pragma unroll
        for (int d0 = 0; d0 < 4; ++d0) { const float v = o[d0][r] * rli[r]; const float vn = __shfl_xor(v, 1);
            if ((r32 & 1) == 0) *(unsigned*)(Ow + (size_t)orow * D + d0 * 32 + r32) = cvtpk(v, vn); } }
    asm volatile("s_waitcnt vmcnt(0) lgkmcnt(0)" ::: "memory"); __builtin_amdgcn_s_barrier(); asm volatile("" ::: "memory");
}
__device__ __forceinline__ void unit_stg(int b, int h, int qb, const bf16_t* __restrict__ QF, const bf16_t* __restrict__ KN, const bf16_t* __restrict__ KPE, const bf16_t* __restrict__ VBg, bf16_t* OB, char* lds, LAS unsigned char* ldsu) {
    int tid = threadIdx.x; asm volatile("" : "+v"(tid));
    const int wid = __builtin_amdgcn_readfirstlane(tid >> 6), lane = tid & 63, r32 = lane & 31, hi = lane >> 5;
    const size_t rowb = (size_t)b * SEQ; const int q0 = qb * QB, qlo = q0 + wid * QBLK, qm = qlo + r32 - 4 * hi;
    const int NT = (q0 + QB) / KVBLK;
    float* wsf = (float*)(lds + S4_WS) + wid * 64; float* li_l = wsf; float* al_l = wsf + 32;
    bf16x8 qr[12];
    { const bf16_t* qp = QF + (rowb + qlo + r32) * NQ + HD * h + hi * 8;
#pragma unroll
      for (int d0 = 0; d0 < 12; ++d0) qr[d0] = *reinterpret_cast<const bf16x8*>(qp + d0 * 16); }
    const char* Kb = (const char*)(KN + rowb * D + 128 * h); const char* Vb = (const char*)(VBg + rowb * D + 128 * h); const char* Rb = (const char*)(KPE + rowb * ROPE);
    unsigned kof[2], vof[2], rof;
#pragma unroll
    for (int pi = 0; pi < 2; ++pi) { const int p = 2 * wid + pi, rw = 4 * pi + (lane >> 4);
        kof[pi] = (unsigned)((4 * p + (lane >> 4)) * (D * 2) + 16 * ((lane & 15) ^ (rw & 7)));
        const int kk = 8 * (p >> 1) + ((lane & 31) >> 2), key = (kk & ~0xC) | ((kk & 4) << 1) | ((kk & 8) >> 1), col = 32 * (2 * (p & 1) + (lane >> 5)) + 8 * (lane & 3);
        vof[pi] = (unsigned)(key * (D * 2) + col * 2); }
    { const int row = 8 * wid + (lane >> 3); rof = (unsigned)(row * (ROPE * 2) + 16 * ((lane & 7) ^ ((row >> 1) & 7))); }
#define DMA_TILE(t, ks_, vs_, rs_) do { const size_t kb_ = (size_t)(t) * KVBLK * (D * 2);                                                                \
        _Pragma("unroll") for (int pi = 0; pi < 2; ++pi) { const int p = 2 * wid + pi;                                                                 \
            __builtin_amdgcn_global_load_lds((const unsigned*)(Kb + kb_ + kof[pi]), (LAS unsigned*)(ldsu + R3_K + (ks_) + p * 1024), 16, 0, 0);        \
            __builtin_amdgcn_global_load_lds((const unsigned*)(Vb + kb_ + vof[pi]), (LAS unsigned*)(ldsu + R3_V + (vs_) + p * 1024), 16, 0, 0); }      \
        __builtin_amdgcn_global_load_lds((const unsigned*)(Rb + (size_t)(t) * KVBLK * (ROPE * 2) + rof), (LAS unsigned*)(ldsu + R3_R + (rs_) + wid * 1024), 16, 0, 0); } while (0)
    const int vb0 = (int)(uintptr_t)lds + v_rd_base(lane);
    float m_reg = -1e30f, l_reg = 0.f, alpha; f32x16 o[4] = {}; f32x16 p0, p1; bf16x8 pa0, pa1, pa2, pa3;
#define S4_KOFS(sl_) (16384 + (sl_) * SHM_K)
#define S4_ROFS(sl_) ((sl_) == 0 ? 16384 : (sl_) == 1 ? 24576 : (S4_R2 - R3_R))
    const bool grpB = wid >= 4;
    DMA_TILE(0, S4_KOFS(0), 0, S4_ROFS(0)); DMA_TILE(1, S4_KOFS(1), SHM_V, S4_ROFS(1));
    asm volatile("s_waitcnt vmcnt(5)" ::: "memory"); __builtin_amdgcn_s_barrier(); asm volatile("" ::: "memory");
    int s_cur = 0, s_nxt = 1, s_nn = 2;
#define STG_WAIT(t) do { if ((t) + 2 < NT) asm volatile("s_waitcnt vmcnt(5) lgkmcnt(0)" ::: "memory"); else asm volatile("s_waitcnt vmcnt(0) lgkmcnt(0)" ::: "memory");   \
        __builtin_amdgcn_s_barrier(); asm volatile("" ::: "memory"); { const int tmp = s_cur; s_cur = s_nxt; s_nxt = s_nn; s_nn = tmp; } } while (0)
#define STG_RESCALE() do { if (__any(alpha < 1.f)) { if (hi == 0) al_l[r32] = alpha; asm volatile("s_waitcnt lgkmcnt(0)" ::: "memory");                    \
            _Pragma("unroll") for (int d_ = 0; d_ < 4; ++d_) _Pragma("unroll") for (int r = 0; r < 16; ++r) o[d_][r] *= al_l[crow(r, hi)]; } } while (0)
    if (!grpB) {
        for (int t = 0; t < NT; ++t) {
            int kofs = S4_KOFS(s_cur), rofs = S4_ROFS(s_cur), vofs = (t & 3) * SHM_V; asm volatile("" : "+v"(kofs), "+v"(rofs), "+v"(vofs));
            if (t + 2 < NT) DMA_TILE(t + 2, S4_KOFS(s_nn), ((t + 2) & 3) * SHM_V, S4_ROFS(s_nn));
            PA_QK(p0, p1, lds, kofs, rofs, r32, hi, qr);
            s16x4 VA[8], VB_[8]; const int vb_ = vb0 + vofs; SBAR(); PV_EARLY(VA, VB_); SBAR();
            if (KVBLK * t + KVBLK - 1 > qlo) mask_tile(p0, p1, qm - KVBLK * t);
            softmax_tile(p0, p1, m_reg, l_reg, alpha, pa0, pa1, pa2, pa3);
            STG_RESCALE();
            SBAR(); PV_REST(VA, VB_);
            STG_WAIT(t);
        }
    } else {
        for (int t = 0; t < NT; ++t) {
            int kofs = S4_KOFS(s_cur), rofs = S4_ROFS(s_cur), vofs = ((t + 3) & 3) * SHM_V; asm volatile("" : "+v"(kofs), "+v"(rofs), "+v"(vofs));
            if (t + 2 < NT) DMA_TILE(t + 2, S4_KOFS(s_nn), ((t + 2) & 3) * SHM_V, S4_ROFS(s_nn));
            if (t > 0) { s16x4 VA[8], VB_[8]; const int vb_ = vb0 + vofs; SBAR(); PV_EARLY(VA, VB_); SBAR(); PV_REST(VA, VB_); SBAR(); }
            PA_QK(p0, p1, lds, kofs, rofs, r32, hi, qr);
            if (KVBLK * t + KVBLK - 1 > qlo) mask_tile(p0, p1, qm - KVBLK * t);
            softmax_tile(p0, p1, m_reg, l_reg, alpha, pa0, pa1, pa2, pa3);
            STG_RESCALE();
            STG_WAIT(t);
        }
        { const int vofs = ((NT + 3) & 3) * SHM_V; s16x4 VA[8], VB_[8]; const int vb_ = vb0 + vofs; SBAR(); PV_EARLY(VA, VB_); SBAR(); PV_REST(VA, VB_); SBAR(); }
    }
#undef STG_WAIT
#undef STG_RESCALE
#undef S4_KOFS
#undef S4_ROFS
#undef DMA_TILE
    if (hi == 0) li_l[r32] = l_reg; asm volatile("s_waitcnt lgkmcnt(0)" ::: "memory");
    float rli[16];
#pragma unroll
    for (int r = 0; r < 16; ++r) rli[r] = __builtin_amdgcn_rcpf(li_l[crow(r, hi)]);
    bf16_t* Ow = OB + (rowb + qlo) * D + 128 * h;
#pragma unroll
    for (int r = 0; r < 16; ++r) { const int orow = crow(r, hi);
#pragma unroll
        for (int d0 = 0; d0 < 4; ++d0) { const float v = o[d0][r] * rli[r]; const float vn = __shfl_xor(v, 1);
            if ((r32 & 1) == 0) *(unsigned*)(Ow + (size_t)orow * D + d0 * 32 + r32) = cvtpk(v, vn); } }
    asm volatile("s_waitcnt vmcnt(0) lgkmcnt(0)" ::: "memory"); __builtin_amdgcn_s_barrier(); asm volatile("" ::: "memory");
}
}

namespace sa {
constexpr int TILE = 16384;
struct Src { const bf16_t* CLB; const float* CKF; const int* PT; const float* RP; const bf16_t* LATB; const bf16_t* KPEB; const float* RTS; const unsigned char* CL8; const float* SC2; };
#ifndef SA_INT8
#define SA_INT8 1
#endif
__device__ __forceinline__ int offa(int row, int ch) { return 2048 * (row >> 3) + 512 * (ch >> 2) + 64 * (row & 7) + 16 * ((ch & 3) ^ ((row >> 2) & 3)); }
__device__ __forceinline__ v4u widen8(u32x2 w) {
    const unsigned x0 = w.x ^ 0x80808080u, x1 = w.y ^ 0x80808080u; v4u o;
    o.x = cvt_pk_bf16((float)(x0 & 255u), (float)((x0 >> 8) & 255u)); o.y = cvt_pk_bf16((float)((x0 >> 16) & 255u), (float)(x0 >> 24));
    o.z = cvt_pk_bf16((float)(x1 & 255u), (float)((x1 >> 8) & 255u)); o.w = cvt_pk_bf16((float)((x1 >> 16) & 255u), (float)(x1 >> 24)); return o;
}
template <bool TAIL, bool Q8 = false>
__device__ __forceinline__ void tile(const Src& S, int b, int k0, LAS unsigned char* ldsu, char* lds, int wid, int lane, f32x16 (&o)[8], float& m_reg, float& l_reg, float* al_l, int tbase, float& lb, float cb) {
    asm volatile("" : "+v"(lane));
    const int r32 = lane & 31, hi = lane >> 5, h = r32 & 7;
    LAS unsigned char* tl = ldsu + tbase + wid * TILE; const char* tg = lds + tbase + wid * TILE;
    asm volatile("s_waitcnt lgkmcnt(0)" ::: "memory");
    {
        const int rlo = (lane >> 2) & 7, chh = lane >> 5, x4 = (lane >> 4) & 1;
        if constexpr (TAIL) {
            const char* ub = (const char*)(S.LATB + (size_t)(TP + 4 * b) * KVR);
#pragma unroll
            for (int P = 0; P < 16; ++P) { const int img = P >> 3, pp = P & 7, row = 8 * (pp >> 1) + rlo, ch = 8 * (pp & 1) + 4 * chh + ((lane & 3) ^ (2 * ((pp >> 1) & 1) + x4));
                const unsigned lo = (unsigned)((row < 3 ? row : 3) * (KVR * 2) + (128 * img + 8 * ch) * 2);
                __builtin_amdgcn_global_load_lds((const unsigned*)(ub + lo), (LAS unsigned*)(tl + P * 1024), 16, 0, 0); }
        } else if constexpr (Q8) {
            const char* ub = (const char*)S.CL8 + ((size_t)b * SEQ + k0) * KVR + 16 * lane;
#pragma unroll
            for (int P = 0; P < 8; ++P) __builtin_amdgcn_global_load_lds((const unsigned*)(ub + P * 1024), (LAS unsigned*)(tl + 8192 + P * 1024), 16, 0, 0);
        } else {
            const char* ub = (const char*)(S.CLB + ((size_t)b * SEQ + k0) * KVR);
            const unsigned loA = (unsigned)(rlo * 512 + 64 * chh + 16 * ((lane & 3) ^ x4)), loB = (unsigned)(rlo * 512 + 64 * chh + 16 * ((lane & 3) ^ (2 + x4)));
#pragma unroll
            for (int P = 0; P < 16; ++P) { const int img = P >> 3, pp = P & 7; const unsigned cst = (unsigned)((8 * (pp >> 1)) * 512 + 256 * img + 128 * (pp & 1));
                __builtin_amdgcn_global_load_lds((const unsigned*)(ub + cst + (((pp >> 1) & 1) ? loB : loA)), (LAS unsigned*)(tl + P * 1024), 16, 0, 0); }
        }
    }
    bf16x8 kp[4]; float rf[16];
    {
        if constexpr (TAIL) { const bf16_t* kr = S.KPEB + (size_t)(TP + 4 * b + (r32 < 3 ? r32 : 3)) * ROPE;
#pragma unroll
            for (int s = 0; s < 4; ++s) kp[s] = *reinterpret_cast<const bf16x8*>(kr + 16 * s + 8 * hi);
        } else {
            const int phys = S.PT[b * NPG + (k0 >> 7)];
            const float* kr = S.CKF + ((size_t)phys * PAGE + (k0 & (PAGE - 1)) + r32) * ROPE + 8 * hi;
#pragma unroll
            for (int s = 0; s < 4; ++s) { const f32x4 x0 = *(const f32x4*)(kr + 16 * s), x1 = *(const f32x4*)(kr + 16 * s + 4);
                u32x4 w = {cvt_pk_bf16(x0[0], x0[1]), cvt_pk_bf16(x0[2], x0[3]), cvt_pk_bf16(x1[0], x1[1]), cvt_pk_bf16(x1[2], x1[3])}; kp[s] = *reinterpret_cast<bf16x8*>(&w); }
        }
        if constexpr (TAIL) {
#pragma unroll
            for (int r = 0; r < 16; ++r) { const int j = crow(r, hi), jc = j < 3 ? j : 3; rf[r] = S.RTS[(4 * b + jc) * 8 + h]; }
        } else {
            const float* r0 = S.RP + (size_t)(2 * h) * NCK + (size_t)b * SEQ + k0 + 4 * hi;
#pragma unroll
            for (int j = 0; j < 4; ++j) { const f32x4 a = *(const f32x4*)(r0 + 8 * j) + *(const f32x4*)(r0 + NCK + 8 * j);
#pragma unroll
                for (int e = 0; e < 4; ++e) rf[4 * j + e] = a[e]; }
            if constexpr (Q8) {
                const float* s0 = S.SC2 + (size_t)b * SEQ + k0 + 4 * hi;
#pragma unroll
                for (int j = 0; j < 4; ++j) { f32x4 sv = *(const f32x4*)(s0 + 8 * j);
#pragma unroll
                    for (int e = 0; e < 4; ++e) { const float s2 = sv[e]; sv[e] = sqrtf(s2); rf[4 * j + e] = rsq(rf[4 * j + e] * s2 * (1.0f / 128) + EPS) * sv[e]; }
                    if (r32 == 0) *(f32x4*)(al_l + 32 + 8 * j + 4 * hi) = sv; }
            }
        }
    }
    asm volatile("s_waitcnt vmcnt(0)" ::: "memory");
    if constexpr (Q8 && !TAIL) {
        const int c8 = lane & 15, r0 = lane >> 4; const char* st = tg + 8192;
#pragma unroll
        for (int i = 0; i < 8; ++i) { const int row = r0 + 4 * i; *(v4u*)(const_cast<char*>(tg) + offa(row, c8)) = widen8(*(const u32x2*)(st + row * 256 + 8 * c8)); }
        u32x2 wb[8];
#pragma unroll
        for (int i = 0; i < 8; ++i) wb[i] = *(const u32x2*)(st + (r0 + 4 * i) * 256 + 128 + 8 * c8);
        asm volatile("s_waitcnt lgkmcnt(0)" ::: "memory");
#pragma unroll
        for (int i = 0; i < 8; ++i) *(v4u*)(const_cast<char*>(tg) + 8192 + offa(r0 + 4 * i, c8)) = widen8(wb[i]);
        asm volatile("s_waitcnt lgkmcnt(0)" ::: "memory");
    }
    f32x16 p = {}, pn = {};
    {
        const int x = (r32 >> 2) & 3; const char* kbase = tg + 2048 * (r32 >> 3) + 64 * (r32 & 7);
        const char* kE = kbase + 16 * (hi ^ x); const char* kO = kbase + 16 * ((2 + hi) ^ x);
        const char* qb = lds + QS_OFF + r32 * QS_STRIDE + hi * 16;
#pragma unroll
        for (int s = 0; s < 4; ++s) p = __builtin_amdgcn_mfma_f32_32x32x16_bf16(kp[s], *reinterpret_cast<const bf16x8*>(qb + (16 + s) * 32), p, 0, 0, 0);
#pragma unroll
        for (int s = 0; s < 16; ++s) { const int img = s >> 3, ss = s & 7; const char* a = ((ss & 1) ? kO : kE) + 8192 * img + 512 * (ss >> 1);
            pn = __builtin_amdgcn_mfma_f32_32x32x16_bf16(*reinterpret_cast<const bf16x8*>(a), *reinterpret_cast<const bf16x8*>(qb + s * 32), pn, 0, 0, 0); }
    }
#pragma unroll
    for (int r = 0; r < 16; ++r) p[r] = (Q8 && !TAIL) ? (pn[r] - cb) * rf[r] + p[r] : pn[r] * (TAIL ? rf[r] : rsq(rf[r] * (1.0f / 128) + EPS)) + p[r];
    if constexpr (TAIL) { const int q = r32 >> 3;
#pragma unroll
        for (int r = 0; r < 16; ++r) if (crow(r, hi) > q) p[r] = -__builtin_inff(); }
    float pmax = p[0];
#pragma unroll
    for (int r = 1; r < 16; ++r) pmax = fmaxf(pmax, p[r]);
    pmax = xmax32(pmax);
    float mn, alpha;
    if (__builtin_expect(__all((pmax - m_reg) <= THR), 1)) { mn = m_reg; alpha = 1.f; }
    else { mn = fmaxf(m_reg, pmax); alpha = __builtin_amdgcn_exp2f(m_reg - mn); m_reg = mn; }
    float ps = 0.f;
#pragma unroll
    for (int r = 0; r < 16; ++r) { p[r] = __builtin_amdgcn_exp2f(p[r] - mn); ps += p[r]; }
    ps = xsum32(ps); l_reg = l_reg * alpha + ps;
    if constexpr (Q8 && !TAIL) {
#pragma unroll
        for (int j = 0; j < 4; ++j) { const f32x4 sv = *(const f32x4*)(al_l + 32 + 8 * j + 4 * hi);
#pragma unroll
            for (int e = 0; e < 4; ++e) p[4 * j + e] *= sv[e]; }
    }
    bf16x8 pa0, pa1; PK4(p, 0, pa0); PK4(p, 8, pa1);
    if constexpr (Q8) {
        float bs = 0.f;
        if constexpr (!TAIL) { const u32x4 w0 = *reinterpret_cast<const u32x4*>(&pa0), w1 = *reinterpret_cast<const u32x4*>(&pa1);
#pragma unroll
            for (int e = 0; e < 4; ++e) bs += (bflo(w0[e]) + bfhi(w0[e])) + (bflo(w1[e]) + bfhi(w1[e]));
            bs = xsum32(bs); }
        lb = lb * alpha + bs;
    }
    if (__any(alpha < 1.f)) { if (hi == 0) al_l[r32] = alpha; asm volatile("s_waitcnt lgkmcnt(0)" ::: "memory");
#pragma unroll
        for (int c = 0; c < 8; ++c)
#pragma unroll
            for (int r = 0; r < 16; ++r) o[c][r] *= al_l[crow(r, hi)]; }
    {
        const int hh = lane >> 5, blk = (lane >> 4) & 1, q4 = (lane & 15) >> 2, pp = lane & 3;
        const int tb = (int)(uintptr_t)tg + 2048 * hh + 64 * q4 + 8 * (pp & 1);
        const int t0 = tb + 16 * ((2 * blk + (pp >> 1)) ^ (2 * hh)), t1 = tb + 256 + 16 * ((2 * blk + (pp >> 1)) ^ (2 * hh + 1));
#define TR0(dst, off) asm volatile("ds_read_b64_tr_b16 %0, %1 offset:%2" : "=&v"(dst) : "v"(t0), "i"(off) : "memory")
#define TR1(dst, off) asm volatile("ds_read_b64_tr_b16 %0, %1 offset:%2" : "=&v"(dst) : "v"(t1), "i"(off) : "memory")
#define PVC(c) do { s16x4 a0, a1, b0, b1; constexpr int f_ = 8192 * ((c) >> 2) + 512 * ((c) & 3);                               \
        TR0(a0, f_); TR1(a1, f_); TR0(b0, f_ + 4096); TR1(b1, f_ + 4096);                                                        \
        asm volatile("s_waitcnt lgkmcnt(0)" ::: "memory"); SBAR();                                                                \
        o[c] = __builtin_amdgcn_mfma_f32_32x32x16_bf16(pa0, (bf16x8){a0[0], a0[1], a0[2], a0[3], a1[0], a1[1], a1[2], a1[3]}, o[c], 0, 0, 0); \
        o[c] = __builtin_amdgcn_mfma_f32_32x32x16_bf16(pa1, (bf16x8){b0[0], b0[1], b0[2], b0[3], b1[0], b1[1], b1[2], b1[3]}, o[c], 0, 0, 0); } while (0)
        PVC(0); PVC(1); PVC(2); PVC(3); PVC(4); PVC(5); PVC(6); PVC(7);
#undef PVC
#undef TR0
#undef TR1
    }
}
__device__ __forceinline__ void unit(const Src& S, const bf16_t* QS, float* PO, float* PML, int b, int s, LAS unsigned char* ldsu, char* lds) {
    int tid = threadIdx.x; asm volatile("" : "+v"(tid));
    const int wid = __builtin_amdgcn_readfirstlane(tid >> 6), lane = tid & 63, r32 = lane & 31, hi = lane >> 5;
    for (int c = tid; c < 32 * 40; c += 512) { const int rho = c / 40, ch = c % 40; *(v4u*)(lds + QS_OFF + rho * QS_STRIDE + ch * 16) = *(const v4u*)(QS + ((size_t)b * 32 + rho) * 320 + ch * 8); }
    __syncthreads();
    float* al_l = (float*)(lds + SCR_OFF) + wid * 64;
    float m_reg = -1e30f, l_reg = 0.f, lb = 0.f, cb = 0.f; f32x16 o[8] = {};
    if (SA_INT8) { const char* qrow = lds + QS_OFF + r32 * QS_STRIDE;
#pragma unroll 8
        for (int ch = 0; ch < 32; ++ch) { const v4u q = *(const v4u*)(qrow + 16 * ch); cb += (bflo(q.x) + bfhi(q.x)) + (bflo(q.y) + bfhi(q.y)) + (bflo(q.z) + bfhi(q.z)) + (bflo(q.w) + bfhi(q.w)); }
        cb *= 128.0f; }
    const int kbase = (8 * s + wid) * 512;
    for (int i = 0; i < 16; ++i) tile<false, SA_INT8 != 0>(S, b, kbase + 32 * i, ldsu, lds, wid, lane, o, m_reg, l_reg, al_l, 0, lb, cb);
    if (s == 1 && wid == 7) tile<true, SA_INT8 != 0>(S, b, 0, ldsu, lds, wid, lane, o, m_reg, l_reg, al_l, 0, lb, cb);
    asm volatile("s_waitcnt lgkmcnt(0)" ::: "memory");
    if (SA_INT8) {
        if (hi == 0) al_l[r32] = lb; asm volatile("s_waitcnt lgkmcnt(0)" ::: "memory");
#pragma unroll
        for (int r = 0; r < 16; ++r) { const float corr = 128.0f * al_l[crow(r, hi)];
#pragma unroll
            for (int c = 0; c < 8; ++c) o[c][r] -= corr; }
        asm volatile("s_waitcnt lgkmcnt(0)" ::: "memory");
    }
    __syncthreads();
    float* ST = (float*)(lds + 32768);
    float* OL = (float*)lds;
    if (hi == 0) { ST[(wid * 32 + r32) * 2] = m_reg; ST[(wid * 32 + r32) * 2 + 1] = l_reg; }
    __syncthreads();
    float sc[16];
#pragma unroll
    for (int r = 0; r < 16; ++r) { const int row = crow(r, hi); float M = ST[row * 2];
#pragma unroll
        for (int w = 1; w < 8; ++w) M = fmaxf(M, ST[(w * 32 + row) * 2]);
        sc[r] = __builtin_amdgcn_exp2f(ST[(wid * 32 + row) * 2] - M); }
    for (int w = 0; w < 8; ++w) {
        if (wid == w) {
#pragma unroll
            for (int c = 0; c < 8; ++c)
#pragma unroll
                for (int r = 0; r < 16; ++r) { float* d = OL + crow(r, hi) * 256 + 32 * c + r32; const float v = o[c][r] * sc[r]; *d = (w == 0) ? v : *d + v; }
        }
        __syncthreads();
    }
    if (tid < 32) { float M = ST[tid * 2];
        for (int w = 1; w < 8; ++w) M = fmaxf(M, ST[(w * 32 + tid) * 2]);
        float L = 0.f; for (int w = 0; w < 8; ++w) L += ST[(w * 32 + tid) * 2 + 1] * __builtin_amdgcn_exp2f(ST[(w * 32 + tid) * 2] - M);
        PML[((size_t)(b * 2 + s) * 32 + tid) * 2] = M; PML[((size_t)(b * 2 + s) * 32 + tid) * 2 + 1] = L; }
    for (int c = tid; c < 32 * 64; c += 512) *((f32x4*)(PO + (size_t)(b * 2 + s) * 32 * 256) + c) = *((const f32x4*)OL + c);
    __syncthreads();
}
}

__device__ __forceinline__ void grp_barrier(volatile LAS unsigned* cnt, unsigned& epoch, unsigned nw, int lane) {
    asm volatile("s_waitcnt vmcnt(0) lgkmcnt(0)" ::: "memory");
    epoch += nw;
    if (lane == 0) __hip_atomic_fetch_add((LAS unsigned*)cnt, 1u, __ATOMIC_RELAXED, __HIP_MEMORY_SCOPE_WORKGROUP);
    while ((int)(*cnt - epoch) < 0) __builtin_amdgcn_s_sleep(0);
    asm volatile("" ::: "memory");
}
namespace pa4 {
using namespace pa;
constexpr int QB4 = 128, OFF_WS4 = SCR_OFF + 1024;
__device__ __forceinline__ void unit(int b, int h, int qb, const bf16_t* __restrict__ QF, const bf16_t* __restrict__ KN, const bf16_t* __restrict__ KPE, const bf16_t* __restrict__ VBg, bf16_t* OB,
                                     char* lds, LAS unsigned char* ldsu, volatile LAS unsigned* cnt, unsigned& epoch) {
    const int tid = threadIdx.x, wid = __builtin_amdgcn_readfirstlane(tid >> 6), lane = tid & 63, r32 = lane & 31, hi = lane >> 5;
    const size_t rowb = (size_t)b * SEQ; const int q0 = qb * QB4, qlo = q0 + wid * QBLK, qm = qlo + r32 - 4 * hi;
    const int NT = (q0 + QB4) / KVBLK;
    float* wsf = (float*)(lds + OFF_WS4) + wid * 64; float* li_l = wsf; float* al_l = wsf + 32;
    bf16x8 qr[12];
    { const bf16_t* qp = QF + (rowb + qlo + r32) * NQ + HD * h + hi * 8;
#pragma unroll
      for (int d0 = 0; d0 < 12; ++d0) qr[d0] = *reinterpret_cast<const bf16x8*>(qp + d0 * 16); }
    const char* Kb = (const char*)(KN + rowb * D + 128 * h); const char* Vb = (const char*)(VBg + rowb * D + 128 * h); const char* Rb = (const char*)(KPE + rowb * ROPE);
    unsigned kof[2], vof[4], rof[2];
#pragma unroll
    for (int e = 0; e < 2; ++e) { const int rw = 4 * e + (lane >> 4); kof[e] = (unsigned)((lane >> 4) * (D * 2) + 16 * ((lane & 15) ^ (rw & 7))); }
#pragma unroll
    for (int pi = 0; pi < 4; ++pi) { const int p = 4 * wid + pi, kk = 8 * (p >> 1) + ((lane & 31) >> 2), key = (kk & ~0xC) | ((kk & 4) << 1) | ((kk & 8) >> 1), col = 32 * (2 * (p & 1) + (lane >> 5)) + 8 * (lane & 3);
        vof[pi] = (unsigned)(key * (D * 2) + col * 2); }
#pragma unroll
    for (int pi = 0; pi < 2; ++pi) { const int p = 2 * wid + pi, row = 8 * p + (lane >> 3); rof[pi] = (unsigned)(row * (ROPE * 2) + 16 * ((lane & 7) ^ ((row >> 1) & 7))); }
#define DMA_TILE(t, bf) do { const size_t kb_ = (size_t)(t) * KVBLK * (D * 2);                                                                          \
        _Pragma("unroll") for (int pi = 0; pi < 4; ++pi) { const int p = 4 * wid + pi;                                                                 \
            __builtin_amdgcn_global_load_lds((const unsigned*)(Kb + kb_ + (size_t)(4 * p) * (D * 2) + kof[pi & 1]), (LAS unsigned*)(ldsu + OFF_K + (bf) * SHM_K + p * 1024), 16, 0, 0); \
            __builtin_amdgcn_global_load_lds((const unsigned*)(Vb + kb_ + vof[pi]), (LAS unsigned*)(ldsu + OFF_V + (bf) * SHM_V + p * 1024), 16, 0, 0); }  \
        _Pragma("unroll") for (int pi = 0; pi < 2; ++pi) { const int p = 2 * wid + pi;                                                                 \
            __builtin_amdgcn_global_load_lds((const unsigned*)(Rb + (size_t)(t) * KVBLK * (ROPE * 2) + rof[pi]), (LAS unsigned*)(ldsu + OFF_R + (bf) * SHM_R + p * 1024), 16, 0, 0); } } while (0)
    const int vb0 = (int)(uintptr_t)lds + v_rd_base(lane);
    float m_reg = -1e30f, l_reg = 0.f, alpha; f32x16 o[4] = {}; f32x16 p0, p1; bf16x8 pa0, pa1, pa2, pa3;
    DMA_TILE(0, 0); grp_barrier(cnt, epoch, 4u, lane);
#define STEP4(t, CB) do { if ((t) + 1 < NT) DMA_TILE((t) + 1, 1 - (CB));                                                      \
        qkt<CB>(p0, p1, lds, r32, hi, qr);                                                                                    \
        if (KVBLK * (t) + KVBLK - 1 > qlo) mask_tile(p0, p1, qm - KVBLK * (t));                                               \
        softmax_tile(p0, p1, m_reg, l_reg, alpha, pa0, pa1, pa2, pa3);                                                        \
        if (__any(alpha < 1.f)) { if (hi == 0) al_l[r32] = alpha; asm volatile("s_waitcnt lgkmcnt(0)" ::: "memory");         \
            _Pragma("unroll") for (int d_ = 0; d_ < 4; ++d_) _Pragma("unroll") for (int r = 0; r < 16; ++r) o[d_][r] *= al_l[crow(r, hi)]; } \
        pv_tile<CB>(o, vb0, pa0, pa1, pa2, pa3);                                                                      \
        grp_barrier(cnt, epoch, 4u, lane); } while (0)
    for (int t = 0; t < NT; t += 2) { STEP4(t, 0); STEP4(t + 1, 1); }
#undef STEP4
#undef DMA_TILE
    if (hi == 0) li_l[r32] = l_reg; asm volatile("s_waitcnt lgkmcnt(0)" ::: "memory");
    float rli[16];
#pragma unroll
    for (int r = 0; r < 16; ++r) rli[r] = __builtin_amdgcn_rcpf(li_l[crow(r, hi)]);
    bf16_t* Ow = OB + (rowb + qlo) * D + 128 * h;
#pragma unroll
    for (int r = 0; r < 16; ++r) { const int orow = crow(r, hi);
#pragma unroll
        for (int d0 = 0; d0 < 4; ++d0) { const float v = o[d0][r] * rli[r]; const float vn = __shfl_xor(v, 1);
            if ((r32 & 1) == 0) *(unsigned*)(Ow + (size_t)orow * D + d0 * 32 + r32) = cvtpk(v, vn); } }
    asm volatile("s_waitcnt lgkmcnt(0)" ::: "memory");
}
}
namespace sa3 {
using namespace sa;
constexpr int TB = 81920;
__device__ __forceinline__ void unit(const Src& S, const bf16_t* QS, float* PO, float* PML, int b, int s, LAS unsigned char* ldsu, char* lds, volatile LAS unsigned* cnt, unsigned& epoch) {
    const int tid = threadIdx.x - 256, j = __builtin_amdgcn_readfirstlane(tid >> 6), lane = tid & 63, r32 = lane & 31, hi = lane >> 5;
    for (int c = tid; c < 32 * 40; c += 192) { const int rho = c / 40, ch = c % 40; *(v4u*)(lds + QS_OFF + rho * QS_STRIDE + ch * 16) = *(const v4u*)(QS + ((size_t)b * 32 + rho) * 320 + ch * 8); }
    grp_barrier(cnt, epoch, 3u, lane);
    float* al_l = (float*)(lds + SCR_OFF) + j * 64;
    float m_reg = -1e30f, l_reg = 0.f; f32x16 o[8] = {};
    for (int i = j; i < 128; i += 3) { float lb_ = 0.f; tile<false>(S, b, s * 4096 + 32 * i, ldsu, lds, j, lane, o, m_reg, l_reg, al_l, TB, lb_, 0.f); }
    if (s == 1 && j == 2) { float lb_ = 0.f; tile<true>(S, b, 0, ldsu, lds, j, lane, o, m_reg, l_reg, al_l, TB, lb_, 0.f); }
    grp_barrier(cnt, epoch, 3u, lane);
    float* OL = (float*)(lds + TB);
    float* ST = (float*)(lds + TB + 32768);
    if (hi == 0) { ST[(j * 32 + r32) * 2] = m_reg; ST[(j * 32 + r32) * 2 + 1] = l_reg; }
    grp_barrier(cnt, epoch, 3u, lane);
    float sc[16];
#pragma unroll
    for (int r = 0; r < 16; ++r) { const int row = crow(r, hi); const float M = fmaxf(fmaxf(ST[row * 2], ST[(32 + row) * 2]), ST[(64 + row) * 2]);
        sc[r] = __builtin_amdgcn_exp2f(ST[(j * 32 + row) * 2] - M); }
    for (int w = 0; w < 3; ++w) {
        if (j == w) {
#pragma unroll
            for (int c = 0; c < 8; ++c)
#pragma unroll
                for (int r = 0; r < 16; ++r) { float* d = OL + crow(r, hi) * 256 + 32 * c + r32; const float v = o[c][r] * sc[r]; *d = (w == 0) ? v : *d + v; }
        }
        grp_barrier(cnt, epoch, 3u, lane);
    }
    if (tid < 32) { const float M = fmaxf(fmaxf(ST[tid * 2], ST[(32 + tid) * 2]), ST[(64 + tid) * 2]);
        float L = 0.f; for (int w = 0; w < 3; ++w) L += ST[(w * 32 + tid) * 2 + 1] * __builtin_amdgcn_exp2f(ST[(w * 32 + tid) * 2] - M);
        PML[((size_t)(b * 2 + s) * 32 + tid) * 2] = M; PML[((size_t)(b * 2 + s) * 32 + tid) * 2 + 1] = L; }
    for (int c = tid; c < 32 * 64; c += 192) *((f32x4*)(PO + (size_t)(b * 2 + s) * 32 * 256) + c) = *((const f32x4*)OL + c);
    grp_barrier(cnt, epoch, 3u, lane);
}
}
#undef SBAR
#undef PK4
}

#ifndef MK_SPLIT
#define MK_SPLIT 0
#endif
struct RangeOrder {
    int g0, n;
    __device__ __forceinline__ bool next(int i, pg8::Unit& u) const { if (i >= n) return false; const int g = g0 + i; u.pm = g >> 2; u.pn = g & 3; u.ko = 0; return true; }
    __device__ __forceinline__ void a_ready(const pg8::Unit&) const {}
    __device__ __forceinline__ void done(const pg8::Unit&) const {}
};
struct SplitOrder {
    int j, ns;
    __device__ __forceinline__ bool next(int i, pg8::Unit& u) const { if (i > 0 || j >= 8 * ns) return false; const int t = j / ns; u.pm = t >> 2; u.pn = t & 3; u.ko = (j % ns) * 512; return true; }
    __device__ __forceinline__ void a_ready(const pg8::Unit&) const {}
    __device__ __forceinline__ void done(const pg8::Unit&) const {}
};
constexpr int NSLOT = 11, R_UNITS = (NCK / 256) * 4;
constexpr int FILL_REM[NSLOT] = {172, 8, 24, 32, 172, 8, 48, 8, 132, 16, 140};
constexpr int FILL_PER[NSLOT] = {3, 17, 4, 1, 3, 17, 0, 17, 4, 0, 2};
constexpr int fill_start(int s) { int a = 0; for (int j = 0; j < s; ++j) a += (256 - FILL_REM[j]) * FILL_PER[j]; return a; }
static_assert(fill_start(NSLOT) <= R_UNITS, "filler");
#ifndef R_SP2
#define R_SP2 PG8_SP2
#endif
constexpr int NPHASE = 20;
struct Args { Ptrs P; int ph_lo, ph_hi; };
typedef const __attribute__((address_space(4))) Args CArgs;
__global__ void __launch_bounds__(NWAVES * 64, 2) fwd(Args args) {
    extern __shared__ __attribute__((aligned(16))) unsigned char lds[];
    Ctx C0; C0.lds = (LAS unsigned char*)lds; C0.tid = threadIdx.x; C0.lane = C0.tid & 63; C0.wave = __builtin_amdgcn_readfirstlane(C0.tid >> 6);
    C0.G = gridDim.x; { const int bx = blockIdx.x; C0.vcu = (C0.G % 8 == 0) ? (bx % 8) * (C0.G / 8) + bx / 8 : bx; }
    const Ctx& C = C0;
    volatile LAS unsigned* MISC = (volatile LAS unsigned*)(C.lds + MISC_OFF);
    if (C.tid < 32) MISC[C.tid] = 0u;
    __syncthreads();
    XcdBarrier bar; bar.bar = (unsigned*)(args.P.ws + WS_CTL) + CW_BAR; bar.x = 0; bar.st = nullptr;
    if (!MK_SPLIT) bar = xcd_barrier_post((unsigned*)(args.P.ws + WS_CTL) + CW_BAR, MISC + 8);
    const int lo = args.ph_lo, hi = args.ph_hi;
#ifndef PHASE_MASK
#define PHASE_MASK 0xFFFFFFFFu
#endif
#define IN(k) (((PHASE_MASK >> (k)) & 1u) && lo <= (k) && (k) < hi)
#define SEAM(k) do { if ((k) == 13 ? (IN(12) && IN(14)) : (IN(k) && IN((k) + 1))) { TP_A(5); xcd_barrier(bar); TP_B(5); TP_B(40 + PGRP(k)); TP_A(40 + PGRP((k) + 1)); } } while (0)
#define PH_BEGIN Ctx Cp_ = C0; { int t_ = threadIdx.x; asm volatile("" : "+v"(t_)); Cp_.tid = t_; Cp_.lane = t_ & 63; } const Ctx& C = Cp_;   \
        CArgs* ka_ = (CArgs*)__builtin_amdgcn_kernarg_segment_ptr(); asm volatile("" : "+s"(ka_)); CPtrs& P = ka_->P; unsigned char* ws = P.ws; float* ctl = (float*)(ws + WS_CTL); \
        bf16_t* XB = (bf16_t*)(ws + WS_XB); bf16_t* HB = (bf16_t*)(ws + WS_HB); float* X = P.out + OUT_Y; float* ssqx = ctl + F_SSQX; (void)XB; (void)HB; (void)X; (void)ssqx; (void)ctl;
    LAS unsigned char* ring = C.lds + RING_OFF;
    const int bx = (int)blockIdx.x;
#define GEMM(EPI, Aptr, Bptr, M_, N_, K_, Eobj) do { int k_ = (K_); asm volatile("" : "+s"(k_));   \
        pg8::Gemm g{(const bf16_t*)(Aptr), (const bf16_t*)(Bptr), (M_), (N_), k_, k_}; pg8::StaticOrder S; S.init((M_), (N_), C.G, bx); \
        pg8::gemm_phase<EPI, pg8::StaticOrder, PG8_ALIGN, PG8_SP2>(ring, g, S, Eobj); } while (0)

#define GEMM8(EPI, Aptr, Bptr, M_, N_, Eobj) do { int k_ = D / 2; asm volatile("" : "+s"(k_));   \
        pg8::Gemm g{(const bf16_t*)(Aptr), (const bf16_t*)(Bptr), (M_), (N_), k_, k_}; pg8::StaticOrder S; S.init((M_), (N_), C.G, bx); \
        pg8::gemm_phase<EPI, pg8::StaticOrder, PG8_ALIGN, PG8_SP2, true>(ring, g, S, Eobj); } while (0)
#define SA_PTR ((const float*)(ws + WS_SA))
#define TGU_PTR(i) ((const float*)(ws + WS_TGU) + (i) * 2 * FF)
#define W8GU_PTR(i) (ws + WS_W8GU0 + (size_t)(i) * WS_W8GU_STRIDE)
#define STAGE_T2() do { __syncthreads(); for (int i_ = C.tid; i_ < D / 4; i_ += NWAVES * 64) *((LAS f32x4*)(C.lds + QS_OFF) + i_) = *((const f32x4*)(ws + WS_T2) + i_); __syncthreads(); } while (0)
#define FILL(s) do { if (C.G == 256) { RangeOrder S; S.n = bx >= FILL_REM[s] ? FILL_PER[s] : 0; S.g0 = fill_start(s) + (bx - FILL_REM[s]) * FILL_PER[s]; \
        int k_ = KVR / 2; asm volatile("" : "+s"(k_)); pg8::Gemm g{(const bf16_t*)(ws + WS_CL8), (const bf16_t*)(ws + WS_W8), NCK, D, k_, k_}; if (MK_SPLIT) STAGE_T2();   epi::Kv8 E_{(float*)(ws + WS_RP), (const float*)(ws + WS_SC2), (const LAS float*)(C.lds + QS_OFF), (size_t)NCK}; \
        pg8::gemm_phase<epi::Kv8, RangeOrder, PG8_ALIGN, R_SP2, true>(ring, g, S, E_); } } while (0)

#ifndef TPROBE
#define TPROBE 0
#endif
#ifdef PROBE_PHASE
#define PGRP(k) ((k) == PROBE_PHASE ? 7 : 0)
#else
#define PGRP(k) ((k) == 0 ? 1 : ((k) == 12 || (k) == 13) ? 2 : (k) == 14 ? 3 : ((k) == 4 || (k) == 15) ? 4 : 0)
#endif
    unsigned long long tp0_ = 0, tp1_ = 0, tpacc_ = 0;
#define TP_A(k) do { if (TPROBE == (k)) { __syncthreads(); tp0_ = __builtin_amdgcn_s_memrealtime(); } } while (0)
#define TP_B(k) do { if (TPROBE == (k)) { __syncthreads(); tp1_ = __builtin_amdgcn_s_memrealtime(); tpacc_ += tp1_ - tp0_; } } while (0)
#ifndef W8GU_FN
#define W8GU_FN phase_w8gu2
#endif
#ifndef DUP_SEL
#define DUP_SEL 0
#endif
    if (IN(0)) { PH_BEGIN phase_cacheconv(C, P, C.vcu, C.G); phase_w8(C, P); W8GU_FN(C, P); phase_prologue(C, P); if (DUP_SEL == 1) { __syncthreads(); phase_prologue(C, P); } } SEAM(0);
    if (IN(1)) { PH_BEGIN if (!MK_SPLIT && C.G == 256) STAGE_T2();
        epi::Swiglu8 E{HB, ssqx + 0 * T, SA_PTR, TGU_PTR(0)}; TP_A(3); GEMM8(epi::Swiglu8, ws + WS_A8, W8GU_PTR(0), T, 2 * FF, E); TP_B(3); TP_A(4); FILL(0); TP_B(4); } SEAM(1);
    if (IN(2)) { PH_BEGIN epi::Resid E{XB, ssqx + 1 * T, 0.5f}; TP_A(2); GEMM(epi::Resid, HB, ws + WS_WDN0, T, D, FF, E); TP_B(2); TP_A(1); FILL(1); TP_B(1); } SEAM(2);
    if (IN(3)) { PH_BEGIN epi::ConvIn E{(bf16_t*)(ws + WS_BB), (bf16_t*)(ws + WS_UB), ssqx + 1 * T, P.out + OUT_CSP, P.out + OUT_CSS}; GEMM(epi::ConvIn, XB, ws + WS_WCI, T, 3 * D, D, E); FILL(2); } SEAM(3);
    if (IN(4)) { PH_BEGIN TP_A(8); phase_conv(C, P); TP_B(8); } SEAM(4);
    if (IN(5)) { PH_BEGIN epi::Resid E{XB, ssqx + 2 * T, 1.0f};
        if (C.G == 256) {
            GEMM(epi::Resid, ws + WS_ZB, ws + WS_WCO, TP, D, D, E);
            { int k_ = 256; asm volatile("" : "+s"(k_)); pg8::Gemm g{(const bf16_t*)(ws + WS_ZB) + (size_t)TP * D, (const bf16_t*)(ws + WS_WCO), TS, D, k_, D}; SplitOrder S{bx, 4}; epi::Slab E_{(float*)(ws + WS_SLAB)};
              pg8::gemm_phase<epi::Slab, SplitOrder, PG8_ALIGN, PG8_SP2>(ring, g, S, E_); }
        } else { GEMM(epi::Resid, ws + WS_ZB, ws + WS_WCO, T, D, D, E); }
        FILL(3); } SEAM(5);
    if (IN(6)) { PH_BEGIN if (C.G == 256) phase_quant(C, P, (const float*)(ws + WS_SLAB), 4, ssqx + 2 * T); else phase_quant(C, P); xcd_barrier(bar); epi::Swiglu8 E{HB, ssqx + 2 * T, SA_PTR, TGU_PTR(1)}; GEMM8(epi::Swiglu8, ws + WS_A8, W8GU_PTR(1), T, 2 * FF, E); FILL(4); } SEAM(6);
    if (IN(7)) { PH_BEGIN epi::Resid E{XB, ssqx + 3 * T, 0.5f}; GEMM(epi::Resid, HB, ws + WS_WDN1, T, D, FF, E); FILL(5); } SEAM(7);
    if (IN(8)) { PH_BEGIN phase_quant(C, P); xcd_barrier(bar); { epi::Swiglu8 E{HB, ssqx + 3 * T, SA_PTR, TGU_PTR(2)}; GEMM8(epi::Swiglu8, ws + WS_A8, W8GU_PTR(2), T, 2 * FF, E); }
        { epi::Dkv E{ssqx + 3 * T, (float*)(ws + WS_CKV), ctl + F_SSQLAT, ctl + F_SSQKPE}; int k_ = D; asm volatile("" : "+s"(k_)); pg8::Gemm g{(const bf16_t*)XB, (const bf16_t*)(ws + WS_WDKV), T, 512, k_, k_};
          pg8::StaticOrder S; S.init(T, 512, C.G, (bx + 84) % C.G); pg8::gemm_phase<epi::Dkv, pg8::StaticOrder, PG8_ALIGN, PG8_SP2>(ring, g, S, E); } } SEAM(8);
    if (IN(9)) { PH_BEGIN epi::Resid E{XB, ssqx + 4 * T, 0.5f}; GEMM(epi::Resid, HB, ws + WS_WDN2, T, D, FF, E); FILL(7); TP_A(8); phase_kvfin(C, P); TP_B(8); } SEAM(9);
    if (IN(10)) { PH_BEGIN { epi::Dq E{(bf16_t*)(ws + WS_CQB), ssqx + 4 * T, ctl + F_SSQCQ}; GEMM(epi::Dq, XB, ws + WS_WDQ, T, QRANK, D, E); } FILL(8);
                  { epi::Kv E{(bf16_t*)(ws + WS_KN), (bf16_t*)(ws + WS_VB), (float*)(ws + WS_RPT), (size_t)T}; GEMM(epi::Kv, ws + WS_LATB, ws + WS_WUKV, T, 2 * D, KVR, E); } FILL(9); } SEAM(10);
    if (IN(11)) { PH_BEGIN epi::Uq E{(bf16_t*)(ws + WS_QB), ctl + F_SSQCQ, ctl + F_SSQQ}; TP_A(13); GEMM(epi::Uq, ws + WS_CQB, ws + WS_WUQ, T, NQ, QRANK, E); TP_B(13); TP_A(14); FILL(10); TP_B(14); } SEAM(11);
    if (IN(12)) { PH_BEGIN const int r0_ = (C.G == 256) ? fill_start(NSLOT) : 0, base_ = (R_UNITS - r0_) / C.G, ext_ = (R_UNITS - r0_) % C.G;
        RangeOrder S; S.g0 = r0_ + bx * base_ + (bx < ext_ ? bx : ext_); S.n = base_ + (bx < ext_ ? 1 : 0);
        int k_ = KVR / 2; asm volatile("" : "+s"(k_)); pg8::Gemm g{(const bf16_t*)(ws + WS_CL8), (const bf16_t*)(ws + WS_W8), NCK, D, k_, k_}; if (MK_SPLIT || C.G != 256) STAGE_T2(); epi::Kv8 E_{(float*)(ws + WS_RP), (const float*)(ws + WS_SC2), (const LAS float*)(C.lds + QS_OFF), (size_t)NCK};
        pg8::gemm_phase<epi::Kv8, RangeOrder, PG8_ALIGN, R_SP2, true>(ring, g, S, E_);
        phase_qkfin(C, P); }
    SEAM(13);
    if (IN(14)) { PH_BEGIN
        const bf16_t* QF = (const bf16_t*)(ws + WS_QB); const bf16_t* KN = (const bf16_t*)(ws + WS_KN); const bf16_t* KPE = (const bf16_t*)(ws + WS_KPEB);
        const bf16_t* VBp = (const bf16_t*)(ws + WS_VB); bf16_t* OB = (bf16_t*)(ws + WS_OB);
#ifndef ATT_SEL
#define ATT_SEL 3
#endif
        att::sa::Src S{(const bf16_t*)(ws + WS_CLB), P.in[3], (const int*)P.in[5], (const float*)(ws + WS_RP), (const bf16_t*)(ws + WS_LATB), KPE, (const float*)(ws + WS_RTS), ws + WS_CL8, (const float*)(ws + WS_SC2)};
#ifndef ATT_OVERLAP
#define ATT_OVERLAP 0
#endif
        if (ATT_OVERLAP && C.G == 256) {
            volatile LAS unsigned* gcnt = (volatile LAS unsigned*)(C.lds + MISC_OFF) + 16;
            if (C.wave < 4) { unsigned ep = 0u; const int bh = C.vcu >> 4, s = C.vcu & 15;
                att::pa4::unit(bh >> 3, bh & 7, 63 - 2 * s, QF, KN, KPE, VBp, OB, (char*)lds, C.lds, gcnt, ep);
                att::pa4::unit(bh >> 3, bh & 7, 62 - 2 * s, QF, KN, KPE, VBp, OB, (char*)lds, C.lds, gcnt, ep);
                att::pa4::unit(bh >> 3, bh & 7, 2 * s + 1, QF, KN, KPE, VBp, OB, (char*)lds, C.lds, gcnt, ep);
                att::pa4::unit(bh >> 3, bh & 7, 2 * s, QF, KN, KPE, VBp, OB, (char*)lds, C.lds, gcnt, ep);
            } else if (C.wave < 7) { unsigned ep = 0u;
                att::sa3::unit(S, (const bf16_t*)(ws + WS_QS), (float*)(ws + WS_PO), (float*)(ws + WS_PML), C.vcu >> 1, C.vcu & 1, C.lds, (char*)lds, gcnt + 1, ep); }
        } else {
#define RUN_SA() do { for (int v = C.vcu; v < 2 * DB; v += C.G) att::sa::unit(S, (const bf16_t*)(ws + WS_QS), (float*)(ws + WS_PO), (float*)(ws + WS_PML), v >> 1, v & 1, C.lds, (char*)lds); } while (0)
#ifndef PA_REV2
#define PA_REV2 true
#endif
#ifndef PA_UNIT
#define PA_UNIT unit_dma
#endif
        const att::pa::QFix QFX{ctl + F_SSQQ, P.in[19], P.in[20], (const f32x2*)(ws + WS_ROPE)};
#define RUN_PA() do { for (int v = C.vcu; v < 256; v += C.G) { const int bh = v >> 4, s = v & 15; \
            att::pa::unit_dma<false>(bh >> 3, bh & 7, 31 - s, QF, KN, KPE, VBp, OB, (char*)lds, C.lds, QFX); att::pa::unit_dma<PA_REV2>(bh >> 3, bh & 7, s, QF, KN, KPE, VBp, OB, (char*)lds, C.lds, QFX); } } while (0)
        RUN_PA(); RUN_SA();
#undef RUN_SA
#undef RUN_PA
        }
    } SEAM(14);
    if (IN(15)) { PH_BEGIN TP_A(7); phase_scomb(C, P); TP_B(7); } SEAM(15);
    if (IN(16)) { PH_BEGIN epi::Resid E{XB, ssqx + 5 * T, 1.0f};
        if (C.G == 256) {
            GEMM(epi::Resid, ws + WS_OB, ws + WS_WO, TP, D, D, E);
            { int k_ = 256; asm volatile("" : "+s"(k_)); pg8::Gemm g{(const bf16_t*)(ws + WS_OB) + (size_t)TP * D, (const bf16_t*)(ws + WS_WO), TS, D, k_, D}; SplitOrder S{bx, 4}; epi::Slab E_{(float*)(ws + WS_SLAB)};
              pg8::gemm_phase<epi::Slab, SplitOrder, PG8_ALIGN, PG8_SP2>(ring, g, S, E_); }
        } else { GEMM(epi::Resid, ws + WS_OB, ws + WS_WO, T, D, D, E); } } SEAM(16);
    if (IN(17)) { PH_BEGIN if (C.G == 256) phase_quant(C, P, (const float*)(ws + WS_SLAB), 4, ssqx + 5 * T); else phase_quant(C, P); xcd_barrier(bar); epi::Swiglu8 E{HB, ssqx + 5 * T, SA_PTR, TGU_PTR(3)}; GEMM8(epi::Swiglu8, ws + WS_A8, W8GU_PTR(3), T, 2 * FF, E); } SEAM(17);
    if (IN(18)) { PH_BEGIN
        if (C.G == 256) { unsigned* cnt = (unsigned*)(ws + WS_CTL) + CW_SLC;
            { int k_ = 256; asm volatile("" : "+s"(k_)); pg8::Gemm g{(const bf16_t*)HB + (size_t)TP * FF, (const bf16_t*)(ws + WS_WDN3), TS, D, k_, FF}; SplitOrder S{bx, SPLITK}; epi::Slab E_{(float*)(ws + WS_SLAB)};
              pg8::gemm_phase<epi::Slab, SplitOrder, PG8_ALIGN, PG8_SP2>(ring, g, S, E_); }
            if (bx < 8 * SPLITK) { asm volatile("s_waitcnt vmcnt(0)" ::: "memory"); __syncthreads();
                if (threadIdx.x == 0) { __builtin_amdgcn_fence(__ATOMIC_RELEASE, "agent"); asm volatile("s_waitcnt vmcnt(0)" ::: "memory"); (void)xb_add(cnt, 1u); } }
            { epi::ResidY E{XB, X, 0.5f}; GEMM(epi::ResidY, HB, ws + WS_WDN3, TP, D, FF, E); }
            if (bx >= 8 * SPLITK) {
                if (threadIdx.x == 0) { XB_SPIN(xb_ld(cnt) < (unsigned)(8 * SPLITK), bar.bar); __builtin_amdgcn_fence(__ATOMIC_ACQUIRE, "agent"); asm volatile("s_waitcnt vmcnt(0)" ::: "memory"); }
                __syncthreads();
                const float* slab = (const float*)(ws + WS_SLAB);
                for (int i = (bx - 8 * SPLITK) * (NWAVES * 64) + C.tid; i < TS * D / 4; i += (256 - 8 * SPLITK) * (NWAVES * 64)) { f32x4 s = *((const f32x4*)slab + i);
#pragma unroll
                    for (int c = 1; c < SPLITK; ++c) s += *((const f32x4*)(slab + (size_t)c * TS * D) + i);
                    const u32x2 xw = *((const u32x2*)(XB + (size_t)TP * D) + i); *((f32x4*)(X + (size_t)TP * D) + i) = (f32x4){bflo(xw.x), bfhi(xw.x), bflo(xw.y), bfhi(xw.y)} + s * 0.5f; } }
        } else { epi::ResidY E{XB, X, 0.5f}; GEMM(epi::ResidY, HB, ws + WS_WDN3, T, D, FF, E); } }
#ifdef XBAR_PROBE
    for (int i_ = 0; i_ < XBAR_PROBE; ++i_) xcd_barrier(bar);
#endif
#ifndef PROBE_BLOCK
#define PROBE_BLOCK 255
#endif
    if (TPROBE && blockIdx.x == PROBE_BLOCK && C.wave == 0) { const unsigned long long te = __builtin_amdgcn_s_memrealtime(), span = tpacc_ * 32ull;
        while (__builtin_amdgcn_s_memrealtime() - te < span) __builtin_amdgcn_s_sleep(8); }
#undef IN
#undef SEAM
#undef GEMM
}

extern "C" void kernel_launch(void* const* d_in, const int* in_sizes, int n_in, void* d_out, int out_size, void* d_ws, size_t ws_size, hipStream_t stream) {
    static int grid = 0;
    if (grid == 0) {
        if (n_in != 29 || out_size != (int)OUT_TOTAL || ws_size < WS_END) { fprintf(stderr, "kernel_launch: unexpected shapes (n_in %d, out %d, ws %zu); nothing launched\n", n_in, out_size, ws_size); grid = -1; return; }
        int dev = 0, cus = 0, per_cu = 0;
        if (hipGetDevice(&dev) != hipSuccess || hipDeviceGetAttribute(&cus, hipDeviceAttributeMultiprocessorCount, dev) != hipSuccess) { grid = -1; return; }
        if (hipFuncSetAttribute((const void*)fwd, hipFuncAttributeMaxDynamicSharedMemorySize, LDS_BYTES) != hipSuccess) { fprintf(stderr, "kernel_launch: hipFuncSetAttribute failed\n"); grid = -1; return; }
        if (hipOccupancyMaxActiveBlocksPerMultiprocessor(&per_cu, (const void*)fwd, NWAVES * 64, LDS_BYTES) != hipSuccess || per_cu < 1)
            fprintf(stderr, "kernel_launch: note: occupancy query reports %d workgroups per CU\n", per_cu);
        (void)hipGetLastError();
        grid = cus;
    }
    if (grid < 0) return;
    if (hipMemsetAsync((char*)d_ws + WS_CTL, 0, CTL_BYTES, stream) != hipSuccess) { fprintf(stderr, "kernel_launch: memset failed\n"); return; }
    Args a{};
    for (int i = 0; i < 29; ++i) a.P.in[i] = (const float*)d_in[i];
    a.P.out = (float*)d_out; a.P.ws = (unsigned char*)d_ws;
#if MK_SPLIT
    for (int ph = 0; ph < NPHASE; ++ph) { a.ph_lo = ph; a.ph_hi = ph + 1; hipLaunchKernelGGL(fwd, dim3(grid), dim3(NWAVES * 64), LDS_BYTES, stream, a); }
#else
    a.ph_lo = 0; a.ph_hi = NPHASE;
    hipLaunchKernelGGL(fwd, dim3(grid), dim3(NWAVES * 64), LDS_BYTES, stream, a);
#endif
    const hipError_t le = hipPeekAtLastError();
    if (le != hipSuccess) fprintf(stderr, "kernel_launch: launch failed: %s\n", hipGetErrorName(le));
}
```
